# Optimizing an MI355X kernel written in HIP

```python
import jax, jax.numpy as jnp
from jax import lax
import numpy as np

D_MODEL = 1024
BATCH = 2
SEQ = 8192
DEPTH = 4

PLE_DIM = 256
RET_HEADS = 4
RET_HEAD_DIM = 128
SB_HEADS = 4
SB_HEAD_DIM = 128
RET_WIDTH = RET_HEADS * RET_HEAD_DIM
SB_WIDTH = SB_HEADS * SB_HEAD_DIM
EVEN_WIDTH = RET_WIDTH + SB_WIDTH
EVEN_PROJ = 4 * RET_WIDTH + 4 * SB_WIDTH
RET_CHUNK = 128
SB_BLOCK = 128
ROPE_BASE = 10000.0
RWKV_HEAD_DIM = 64
RWKV_HEADS = D_MODEL // RWKV_HEAD_DIM
DECAY_LORA = 64
ICLR_LORA = 64
VRES_LORA = 32
N_EVEN = (DEPTH + 1) // 2
N_ODD = DEPTH // 2
N_VRES = max(N_ODD - 1, 0)
RMS_EPS = 1e-6
GN_EPS = 1e-5
LNX_EPS = 64e-5

kernel_name = "hybrid_retention_stickbreak_rwkv7_ple"


def rmsnorm(x, gain):
    xf = x.astype(jnp.float32)
    y = xf * lax.rsqrt(jnp.mean(xf * xf, axis=-1, keepdims=True) + RMS_EPS)
    return (y * gain).astype(x.dtype)


def head_norm(y, eps):
    yf = y.astype(jnp.float32)
    mu = jnp.mean(yf, axis=-1, keepdims=True)
    var = jnp.mean(jnp.square(yf - mu), axis=-1, keepdims=True)
    out = (yf - mu) * lax.rsqrt(var + eps)
    return out.reshape(*y.shape[:-2], -1)


def rotary(x, pos):
    half = x.shape[-1] // 2
    inv_freq = ROPE_BASE ** (-jnp.arange(half, dtype=jnp.float32) / half)
    ang = pos.astype(jnp.float32)[:, None] * inv_freq[None, :]
    cos = jnp.cos(ang)[None, :, None, :]
    sin = jnp.sin(ang)[None, :, None, :]
    x1 = x[..., :half].astype(jnp.float32)
    x2 = x[..., half:].astype(jnp.float32)
    return jnp.concatenate([x1 * cos - x2 * sin, x1 * sin + x2 * cos], axis=-1).astype(x.dtype)


def retention(q, k, v, gn_gain):
    B, S, H, Dh = q.shape
    C = RET_CHUNK
    N = S // C
    pos = jnp.arange(S)
    q = rotary(q, pos)
    k = rotary(k, pos) * (Dh ** -0.5)
    lg = jnp.log(1.0 - 2.0 ** (-5.0 - jnp.arange(H, dtype=jnp.float32)))
    c = jnp.arange(C, dtype=jnp.float32)
    diff = c[:, None] - c[None, :]
    intra = jnp.where(diff[None] >= 0, jnp.exp(jnp.maximum(diff, 0.0)[None] * lg[:, None, None]), 0.0).astype(q.dtype)
    qc = q.reshape(B, N, C, H, Dh)
    kc = k.reshape(B, N, C, H, Dh)
    vc = v.reshape(B, N, C, H, Dh)
    scores = jnp.einsum('bnihd,bnjhd->bnhij', qc, kc) * intra
    out = jnp.einsum('bnhij,bnjhe->bnihe', scores, vc)
    k_dec = kc * jnp.exp((C - 1 - c)[:, None] * lg[None, :]).astype(q.dtype)[:, :, None]
    kv = jnp.einsum('bnjhd,bnjhe->nbhde', k_dec, vc)
    chunk_decay = jnp.exp(C * lg).astype(kv.dtype)[None, :, None, None]

    def carry_step(state, kv_n):
        return state * chunk_decay + kv_n, state

    _, prev = lax.scan(carry_step, jnp.zeros_like(kv[0]), kv)
    q_dec = qc * jnp.exp((c + 1)[:, None] * lg[None, :]).astype(q.dtype)[:, :, None]
    out = out + jnp.einsum('bnihd,nbhde->bnihe', q_dec, prev)
    out = out.reshape(B, S, H, Dh)
    return head_norm(out, GN_EPS) * gn_gain


def stick_breaking(q, k, v):
    B, S, H, Dh = q.shape
    nb = S // SB_BLOCK
    scale = Dh ** -0.5
    key_pos = jnp.arange(S)
    qb = q.reshape(B, nb, SB_BLOCK, H, Dh).transpose(1, 0, 2, 3, 4)

    def block(args):
        q_blk, b_idx = args
        z = jnp.einsum('bqhd,bkhd->bhqk', q_blk, k).astype(jnp.float32) * scale
        q_pos = b_idx * SB_BLOCK + jnp.arange(SB_BLOCK)
        mask = key_pos[None, :] < q_pos[:, None]
        log_1mb = jnp.where(mask, jax.nn.log_sigmoid(-z), 0.0)
        after = lax.cumsum(log_1mb, axis=3, reverse=True) - log_1mb
        w = jnp.where(mask, jnp.exp(jax.nn.log_sigmoid(z) + after), 0.0)
        return jnp.einsum('bhqk,bkhd->bqhd', w.astype(v.dtype), v)

    out = lax.map(block, (qb, jnp.arange(nb)))
    return out.transpose(1, 0, 2, 3, 4).reshape(B, S, H * Dh)


def even_mixer(hn, w_in, w_out, ret_gn_gain):
    B, S, _ = hn.shape
    z = jnp.einsum('bsd,df->bsf', hn, w_in)
    qa, ka, va, ga, qb, kb, vb, gb = jnp.split(z, 8, axis=-1)
    ra = lambda t: t.reshape(B, S, RET_HEADS, RET_HEAD_DIM)
    rb = lambda t: t.reshape(B, S, SB_HEADS, SB_HEAD_DIM)
    o_a = retention(ra(qa), ra(ka), ra(va), ret_gn_gain).astype(hn.dtype)
    o_b = stick_breaking(rb(qb), rb(kb), rb(vb))
    mixed = jnp.concatenate([o_a * jax.nn.silu(ga), o_b * jax.nn.silu(gb)], axis=-1)
    return jnp.einsum('bsf,fd->bsd', mixed, w_out)


def token_shift(x):
    return jnp.pad(x, ((0, 0), (1, 0), (0, 0)))[:, :-1]


def rwkv7_mixer(hn, mu, w_in, w_out, w0, w1, w2, a0, a1, a2, k_k, k_a, r_k, lnx_g, lnx_b, v_first, vres):
    B, S, D = hn.shape
    H, N = RWKV_HEADS, RWKV_HEAD_DIM
    xx = token_shift(hn) - hn
    xs = hn[None] + xx[None] * mu[:, None, None, :]
    r, k, v, g = jnp.einsum('pbsd,pdf->pbsf', xs[:4], w_in)
    xv, xw, xa = xs[2], xs[4], xs[5]
    w_log = -jax.nn.softplus(-(w0 + jnp.tanh(xw @ w1) @ w2)) - 0.5
    decay = jnp.exp(-jnp.exp(w_log.astype(jnp.float32)))
    a = jax.nn.sigmoid(a0 + (xa @ a1) @ a2)
    if v_first is None:
        v_first = v
    else:
        v0, v1, v2 = vres
        v = v + (v_first - v) * jax.nn.sigmoid(v0 + (xv @ v1) @ v2)
    kk = (k * k_k).reshape(B, S, H, N).astype(jnp.float32)
    kk = kk / jnp.maximum(jnp.linalg.norm(kk, axis=-1, keepdims=True), 1e-12)
    k = k * (1.0 + (a - 1.0) * k_a)
    heads = lambda t: t.reshape(B, S, H, N).astype(jnp.float32)
    rh, kh, vh, ah, wh = heads(r), heads(k), heads(v), heads(a), heads(decay)
    tm = lambda t: t.transpose(1, 0, 2, 3)

    def step(state, inp):
        r_t, w_t, k_t, v_t, kk_t, a_t = inp
        sk = jnp.einsum('bhvk,bhk->bhv', state, kk_t)
        state = state * w_t[:, :, None, :] - sk[..., None] * (kk_t * a_t)[:, :, None, :] + v_t[..., None] * k_t[:, :, None, :]
        return state, jnp.einsum('bhvk,bhk->bhv', state, r_t)

    s0 = jnp.zeros((B, H, N, N), jnp.float32)
    _, ys = lax.scan(step, s0, (tm(rh), tm(wh), tm(kh), tm(vh), tm(kk), tm(ah)))
    y = ys.transpose(1, 0, 2, 3)
    y = head_norm(y, LNX_EPS) * lnx_g + lnx_b
    bonus = jnp.sum(rh * kh * r_k, axis=-1, keepdims=True) * vh
    y = (y + bonus.reshape(B, S, D)).astype(hn.dtype)
    out = jnp.einsum('bsf,fd->bsd', y * jax.nn.silu(g), w_out)
    return out, v_first


def setup_inputs(seed: int = 0) -> dict:
    key = jax.random.key(seed)
    ks = jax.random.split(key, 32)
    nrm = lambda kk, shape, s: jax.random.normal(kk, shape, jnp.float32) * s
    uni = lambda kk, shape: jax.random.uniform(kk, shape, jnp.float32)
    D = D_MODEL
    return {
        "x": nrm(ks[0], (BATCH, SEQ, D), 1.0),
        "p": nrm(ks[1], (DEPTH, BATCH, SEQ, PLE_DIM), 1.0),
        "norm_gain": 1.0 + nrm(ks[2], (DEPTH, D), 0.1),
        "final_gain": 1.0 + nrm(ks[3], (D,), 0.1),
        "ple_proj": nrm(ks[4], (DEPTH, PLE_DIM, D), PLE_DIM ** -0.5),
        "ple_gate": nrm(ks[5], (DEPTH, D, D), D ** -0.5),
        "even_w_in": nrm(ks[6], (N_EVEN, D, EVEN_PROJ), D ** -0.5),
        "even_w_out": nrm(ks[7], (N_EVEN, EVEN_WIDTH, D), EVEN_WIDTH ** -0.5),
        "ret_gn_gain": 1.0 + nrm(ks[8], (N_EVEN, RET_WIDTH), 0.1),
        "odd_mu": uni(ks[9], (N_ODD, 6, D)),
        "odd_w_in": nrm(ks[10], (N_ODD, 4, D, D), D ** -0.5),
        "odd_w_out": nrm(ks[11], (N_ODD, D, D), D ** -0.5),
        "rwkv_w0": -6.0 + 5.0 * uni(ks[12], (N_ODD, D)),
        "rwkv_w1": nrm(ks[13], (N_ODD, D, DECAY_LORA), D ** -0.5),
        "rwkv_w2": nrm(ks[14], (N_ODD, DECAY_LORA, D), 0.1 * DECAY_LORA ** -0.5),
        "rwkv_a0": nrm(ks[15], (N_ODD, D), 0.1),
        "rwkv_a1": nrm(ks[16], (N_ODD, D, ICLR_LORA), D ** -0.5),
        "rwkv_a2": nrm(ks[17], (N_ODD, ICLR_LORA, D), 0.1 * ICLR_LORA ** -0.5),
        "rwkv_v0": 1.0 + nrm(ks[18], (N_VRES, D), 0.1),
        "rwkv_v1": nrm(ks[19], (N_VRES, D, VRES_LORA), D ** -0.5),
        "rwkv_v2": nrm(ks[20], (N_VRES, VRES_LORA, D), 0.1 * VRES_LORA ** -0.5),
        "rwkv_k_k": 0.85 + nrm(ks[21], (N_ODD, D), 0.1),
        "rwkv_k_a": 1.0 + nrm(ks[22], (N_ODD, D), 0.1),
        "rwkv_r_k": nrm(ks[23], (N_ODD, RWKV_HEADS, RWKV_HEAD_DIM), 0.1),
        "rwkv_lnx_gain": 1.0 + nrm(ks[24], (N_ODD, D), 0.1),
        "rwkv_lnx_bias": nrm(ks[25], (N_ODD, D), 0.02),
    }


def reference(x, p, norm_gain, final_gain, ple_proj, ple_gate, even_w_in, even_w_out, ret_gn_gain,
              odd_mu, odd_w_in, odd_w_out, rwkv_w0, rwkv_w1, rwkv_w2, rwkv_a0, rwkv_a1, rwkv_a2,
              rwkv_v0, rwkv_v1, rwkv_v2, rwkv_k_k, rwkv_k_a, rwkv_r_k, rwkv_lnx_gain, rwkv_lnx_bias):
    h = x
    v_first = None
    for i in range(DEPTH):
        hn = rmsnorm(h, norm_gain[i])
        if i % 2 == 0:
            e = i // 2
            h = h + even_mixer(hn, even_w_in[e], even_w_out[e], ret_gn_gain[e])
        else:
            o = i // 2
            vres = None if v_first is None else (rwkv_v0[o - 1], rwkv_v1[o - 1], rwkv_v2[o - 1])
            y, v_first = rwkv7_mixer(hn, odd_mu[o], odd_w_in[o], odd_w_out[o], rwkv_w0[o], rwkv_w1[o], rwkv_w2[o],
                                     rwkv_a0[o], rwkv_a1[o], rwkv_a2[o], rwkv_k_k[o], rwkv_k_a[o], rwkv_r_k[o],
                                     rwkv_lnx_gain[o], rwkv_lnx_bias[o], v_first, vres)
            h = h + y
        gate = jax.nn.sigmoid(jnp.einsum('bsd,de->bse', h, ple_gate[i]))
        h = h + gate * jnp.einsum('bsp,pd->bsd', p[i], ple_proj[i])
    return rmsnorm(h, final_gain)
```

```cpp
#include <hip/hip_runtime.h>
#include <cstdint>
#include <cstdio>

typedef unsigned short bf16_t;
__device__ __forceinline__ float bf2f(bf16_t v) { return __uint_as_float(((unsigned)v) << 16); }
__device__ __forceinline__ bf16_t f2bf(float f) { unsigned u = __float_as_uint(f); return (bf16_t)((u + 0x7fffu + ((u >> 16) & 1u)) >> 16); }
__device__ __forceinline__ float toF(float v) { return v; }
__device__ __forceinline__ float toF(bf16_t v) { return bf2f(v); }
__device__ __forceinline__ float wave_sum(float v) {
#pragma unroll
    for (int o = 1; o < 64; o <<= 1) v += __shfl_xor(v, o);
    return v;
}
__device__ __forceinline__ float sigmoidf_(float x) { return 1.f / (1.f + __expf(-x)); }
__device__ __forceinline__ float siluf_(float x) { return x / (1.f + __expf(-x)); }
__device__ __forceinline__ float softplusf_(float x) { return x > 20.f ? x : log1pf(expf(x)); }
__device__ __forceinline__ float logsigf_(float x) { return -(x < -20.f ? -x : log1pf(expf(-x))); }

constexpr int D = 1024, BATCH = 2, SEQ = 8192, T = BATCH * SEQ, PLE = 256;

template <typename TA, int MODE>
__global__ __launch_bounds__(256) void k_gemm(const TA* __restrict__ A, int lda, const float* __restrict__ W, int ldw, void* Cv, int ldc, int M, int N, int K) {
    __shared__ float As[16][132];
    __shared__ float Bs[16][132];
    const int tid = threadIdx.x, bm = blockIdx.y * 128, bn = blockIdx.x * 128, tx = tid & 15, ty = tid >> 4;
    float acc[8][8];
#pragma unroll
    for (int i = 0; i < 8; ++i)
#pragma unroll
        for (int j = 0; j < 8; ++j) acc[i][j] = 0.f;
    for (int k0 = 0; k0 < K; k0 += 16) {
        { const int r = tid >> 1, kk = (tid & 1) * 8; const TA* ap = A + (size_t)(bm + r) * lda + k0 + kk;
#pragma unroll
          for (int j = 0; j < 8; ++j) As[kk + j][r] = (bm + r < M) ? toF(ap[j]) : 0.f; }
        { const int kr = tid >> 4, c = (tid & 15) * 8; const float* wp = W + (size_t)(k0 + kr) * ldw + bn + c;
#pragma unroll
          for (int j = 0; j < 8; ++j) Bs[kr][c + j] = (bn + c + j < N) ? wp[j] : 0.f; }
        __syncthreads();
#pragma unroll
        for (int k = 0; k < 16; ++k) {
            float a[8], b[8];
#pragma unroll
            for (int i = 0; i < 8; ++i) a[i] = As[k][ty + 16 * i];
#pragma unroll
            for (int j = 0; j < 8; ++j) b[j] = Bs[k][tx + 16 * j];
#pragma unroll
            for (int i = 0; i < 8; ++i)
#pragma unroll
                for (int j = 0; j < 8; ++j) acc[i][j] += a[i] * b[j];
        }
        __syncthreads();
    }
#pragma unroll
    for (int i = 0; i < 8; ++i) {
        const int r = bm + ty + 16 * i; if (r >= M) continue;
#pragma unroll
        for (int j = 0; j < 8; ++j) {
            const int c = bn + tx + 16 * j; if (c >= N) continue;
            if (MODE == 0) ((float*)Cv)[(size_t)r * ldc + c] = acc[i][j];
            else if (MODE == 1) ((float*)Cv)[(size_t)r * ldc + c] += acc[i][j];
            else ((bf16_t*)Cv)[(size_t)r * ldc + c] = f2bf(acc[i][j]);
        }
    }
}

__global__ __launch_bounds__(256) void k_rmsnorm_bf16(const float* __restrict__ H, const float* __restrict__ gain, bf16_t* __restrict__ OUT, int rows) {
    const int row = blockIdx.x * 4 + (threadIdx.x >> 6), lane = threadIdx.x & 63; if (row >= rows) return;
    const float* h = H + (size_t)row * D; float v[16]; float s = 0.f;
#pragma unroll
    for (int j = 0; j < 16; ++j) { v[j] = h[lane + 64 * j]; s += v[j] * v[j]; }
    const float rs = rsqrtf(wave_sum(s) * (1.f / D) + 1e-6f);
#pragma unroll
    for (int j = 0; j < 16; ++j) OUT[(size_t)row * D + lane + 64 * j] = f2bf(v[j] * rs * gain[lane + 64 * j]);
}
__global__ __launch_bounds__(256) void k_rmsnorm_f32(float* __restrict__ H, const float* __restrict__ gain, int rows) {
    const int row = blockIdx.x * 4 + (threadIdx.x >> 6), lane = threadIdx.x & 63; if (row >= rows) return;
    float* h = H + (size_t)row * D; float v[16]; float s = 0.f;
#pragma unroll
    for (int j = 0; j < 16; ++j) { v[j] = h[lane + 64 * j]; s += v[j] * v[j]; }
    const float rs = rsqrtf(wave_sum(s) * (1.f / D) + 1e-6f);
#pragma unroll
    for (int j = 0; j < 16; ++j) h[lane + 64 * j] = v[j] * rs * gain[lane + 64 * j];
}
__global__ __launch_bounds__(256) void k_mix(const float* __restrict__ H, const float* __restrict__ gain, const float* __restrict__ mu, bf16_t* __restrict__ OUT, int row0, int rows) {
    const int lr = blockIdx.x * 4 + (threadIdx.x >> 6), lane = threadIdx.x & 63; if (lr >= rows) return;
    const int row = row0 + lr; const bool first = (row % SEQ) == 0;
    const float* h = H + (size_t)row * D; const float* hp = h - D;
    float v[16], u[16]; float s = 0.f, sp = 0.f;
#pragma unroll
    for (int j = 0; j < 16; ++j) { v[j] = h[lane + 64 * j]; s += v[j] * v[j]; u[j] = first ? 0.f : hp[lane + 64 * j]; sp += u[j] * u[j]; }
    const float rs = rsqrtf(wave_sum(s) * (1.f / D) + 1e-6f), rsp = rsqrtf(wave_sum(sp) * (1.f / D) + 1e-6f);
#pragma unroll
    for (int j = 0; j < 16; ++j) { const int c = lane + 64 * j; const float g = gain[c], a = v[j] * rs * g, b = first ? 0.f : u[j] * rsp * g;
        OUT[(size_t)lr * D + c] = f2bf(a + (b - a) * mu[c]); }
}

__global__ __launch_bounds__(256) void k_rotary(bf16_t* __restrict__ Z) {
    const size_t idx = (size_t)blockIdx.x * 256 + threadIdx.x;
    const int i = idx & 63; const int h = (idx >> 6) & 3; const int qk = (idx >> 8) & 1; const size_t t = idx >> 9; if (t >= (size_t)T) return;
    const int pos = (int)(t % SEQ);
    const float inv = powf(10000.f, -(float)i / 64.f); const float ang = (float)pos * inv; float sn, cs; sincosf(ang, &sn, &cs);
    bf16_t* p = Z + t * 4096 + qk * 512 + h * 128 + i;
    const float x1 = bf2f(p[0]), x2 = bf2f(p[64]); const float sc = qk ? 0.08838834764831845f : 1.f;
    p[0] = f2bf((x1 * cs - x2 * sn) * sc); p[64] = f2bf((x1 * sn + x2 * cs) * sc);
}
__global__ void k_tanh(float* x, size_t n) { const size_t i = (size_t)blockIdx.x * 256 + threadIdx.x; if (i < n) x[i] = tanhf(x[i]); }
__global__ void k_decay(float* x, const float* __restrict__ w0, size_t n) { const size_t i = (size_t)blockIdx.x * 256 + threadIdx.x; if (i < n) { const float u = w0[i & 1023] + x[i]; x[i] = -expf(-softplusf_(-u) - 0.5f); } }
__global__ void k_sigb(const float* __restrict__ x, const float* __restrict__ b0, bf16_t* __restrict__ out, size_t n) { const size_t i = (size_t)blockIdx.x * 256 + threadIdx.x; if (i < n) out[i] = f2bf(sigmoidf_(b0[i & 1023] + x[i])); }
__global__ void k_vmix(bf16_t* __restrict__ V, const bf16_t* __restrict__ VF, const float* __restrict__ x, const float* __restrict__ v0, size_t n) {
    const size_t i = (size_t)blockIdx.x * 256 + threadIdx.x; if (i < n) { const float v = bf2f(V[i]), vf = bf2f(VF[i]); V[i] = f2bf(v + (vf - v) * sigmoidf_(v0[i & 1023] + x[i])); } }
__global__ void k_copy16(const bf16_t* __restrict__ a, bf16_t* __restrict__ b, size_t n) { const size_t i = (size_t)blockIdx.x * 256 + threadIdx.x; if (i < n) b[i] = a[i]; }
__global__ void k_gate_mul(const bf16_t* __restrict__ Y, const bf16_t* __restrict__ G, bf16_t* __restrict__ out, size_t n) { const size_t i = (size_t)blockIdx.x * 256 + threadIdx.x; if (i < n) out[i] = f2bf(bf2f(Y[i]) * siluf_(bf2f(G[i]))); }
__global__ void k_ple(float* __restrict__ H, const float* __restrict__ G, const float* __restrict__ PP, size_t n) { const size_t i = (size_t)blockIdx.x * 256 + threadIdx.x; if (i < n) H[i] += sigmoidf_(G[i]) * PP[i]; }
__global__ __launch_bounds__(256) void k_ret_post(const float* __restrict__ O, const float* __restrict__ gng, const bf16_t* __restrict__ Z, bf16_t* __restrict__ MIX) {
    const size_t w = (size_t)blockIdx.x * 4 + (threadIdx.x >> 6); const int lane = threadIdx.x & 63; const size_t t = w >> 2; const int h = w & 3; if (t >= (size_t)T) return;
    const float* o = O + t * 512 + h * 128; const float a = o[lane], b = o[lane + 64];
    const float mu = wave_sum(a + b) * (1.f / 128.f); const float da = a - mu, db = b - mu; const float var = wave_sum(da * da + db * db) * (1.f / 128.f); const float rs = rsqrtf(var + 1e-5f);
    const bf16_t* ga = Z + t * 4096 + 1536 + h * 128;
    MIX[t * D + h * 128 + lane] = f2bf(da * rs * gng[h * 128 + lane] * siluf_(bf2f(ga[lane])));
    MIX[t * D + h * 128 + lane + 64] = f2bf(db * rs * gng[h * 128 + lane + 64] * siluf_(bf2f(ga[lane + 64])));
}
__global__ void k_sb_post(const float* __restrict__ O, const bf16_t* __restrict__ Z, bf16_t* __restrict__ MIX) {
    const size_t i = (size_t)blockIdx.x * 256 + threadIdx.x; const size_t t = i >> 9; const int c = i & 511; if (t >= (size_t)T) return;
    MIX[t * D + 512 + c] = f2bf(O[i] * siluf_(bf2f(Z[t * 4096 + 3584 + c])));
}

constexpr int ATT_LDS = (64 * 129 * 2 + 64 * 128 + 64 * 65) * 4;
template <int MODE>
__global__ __launch_bounds__(256) void k_attn(const bf16_t* __restrict__ Qg, const bf16_t* __restrict__ Kg, const bf16_t* __restrict__ Vg, float* __restrict__ O) {
    extern __shared__ float sm[];
    float* Qs = sm; float* Ks = Qs + 64 * 129; float* Vs = Ks + 64 * 129; float* Ws = Vs + 64 * 128;
    const int tid = threadIdx.x, tx = tid & 15, ty = tid >> 4, qt = blockIdx.x, bh = blockIdx.y, b = bh >> 2, h = bh & 3;
    const size_t rowb = (size_t)b * SEQ; const int q0 = qt * 64;
    for (int e = tid; e < 64 * 128; e += 256) { const int r = e >> 7, c = e & 127; Qs[r * 129 + c] = bf2f(Qg[(rowb + q0 + r) * 4096 + h * 128 + c]); }
    float acc[4][8];
#pragma unroll
    for (int i = 0; i < 4; ++i)
#pragma unroll
        for (int j = 0; j < 8; ++j) acc[i][j] = 0.f;
    float carry = 0.f;
    const float lg = logf(1.f - exp2f(-5.f - (float)h));
    for (int kt = qt; kt >= 0; --kt) {
        const int k0 = kt * 64;
        __syncthreads();
        for (int e = tid; e < 64 * 128; e += 256) { const int r = e >> 7, c = e & 127; const size_t g = (rowb + k0 + r) * 4096 + h * 128 + c; Ks[r * 129 + c] = bf2f(Kg[g]); Vs[r * 128 + c] = bf2f(Vg[g]); }
        __syncthreads();
        float z[4][4];
#pragma unroll
        for (int i = 0; i < 4; ++i)
#pragma unroll
            for (int j = 0; j < 4; ++j) z[i][j] = 0.f;
        for (int d = 0; d < 128; ++d) {
            float a[4], bb[4];
#pragma unroll
            for (int i = 0; i < 4; ++i) a[i] = Qs[(ty + 16 * i) * 129 + d];
#pragma unroll
            for (int j = 0; j < 4; ++j) bb[j] = Ks[(tx + 16 * j) * 129 + d];
#pragma unroll
            for (int i = 0; i < 4; ++i)
#pragma unroll
                for (int j = 0; j < 4; ++j) z[i][j] += a[i] * bb[j];
        }
#pragma unroll
        for (int i = 0; i < 4; ++i)
#pragma unroll
            for (int j = 0; j < 4; ++j) Ws[(ty + 16 * i) * 65 + tx + 16 * j] = z[i][j];
        __syncthreads();
        if (tid < 64) {
            const int tq = q0 + tid;
            if (MODE == 0) {
                for (int k = 0; k < 64; ++k) { const int s = k0 + k; const float zz = Ws[tid * 65 + k]; Ws[tid * 65 + k] = (s <= tq) ? zz * expf((float)(tq - s) * lg) : 0.f; }
            } else {
                float run = carry;
                for (int k = 63; k >= 0; --k) { const int s = k0 + k; const float zz = Ws[tid * 65 + k] * 0.08838834764831845f; float w = 0.f;
                    if (s < tq) { const float L = logsigf_(-zz); w = expf(zz + L + run); run += L; }
                    Ws[tid * 65 + k] = w; }
                carry = run;
            }
        }
        __syncthreads();
        for (int k = 0; k < 64; ++k) {
            float a[4], bb[8];
#pragma unroll
            for (int i = 0; i < 4; ++i) a[i] = Ws[(ty + 16 * i) * 65 + k];
#pragma unroll
            for (int j = 0; j < 8; ++j) bb[j] = Vs[k * 128 + tx + 16 * j];
#pragma unroll
            for (int i = 0; i < 4; ++i)
#pragma unroll
                for (int j = 0; j < 8; ++j) acc[i][j] += a[i] * bb[j];
        }
    }
#pragma unroll
    for (int i = 0; i < 4; ++i)
#pragma unroll
        for (int j = 0; j < 8; ++j) O[(rowb + q0 + ty + 16 * i) * 512 + h * 128 + tx + 16 * j] = acc[i][j];
}

__global__ __launch_bounds__(64) void k_rwkv_scan(const bf16_t* __restrict__ R, const bf16_t* __restrict__ Kk, const bf16_t* __restrict__ V, const float* __restrict__ LW, const bf16_t* __restrict__ A,
                                                   const float* __restrict__ k_k, const float* __restrict__ k_a, const float* __restrict__ r_k, const float* __restrict__ lg, const float* __restrict__ lb,
                                                   bf16_t* __restrict__ Y, int S) {
    __shared__ float s_r[64], s_w[64], s_k[64], s_kk[64], s_b[64];
    const int h = blockIdx.x, lane = threadIdx.x, c = h * 64 + lane;
    const float kkc = k_k[c], kac = k_a[c], rkc = r_k[c], lgc = lg[c], lbc = lb[c];
    float st[64];
#pragma unroll
    for (int k = 0; k < 64; ++k) st[k] = 0.f;
    for (int t = 0; t < S; ++t) {
        const size_t p = (size_t)t * D + c;
        const float r = bf2f(R[p]), k = bf2f(Kk[p]), v = bf2f(V[p]), a = bf2f(A[p]), w = expf(LW[p]);
        const float kr = k * kkc; const float nrm = sqrtf(wave_sum(kr * kr)); const float kk = kr / fmaxf(nrm, 1e-12f);
        const float km = k * (1.f + (a - 1.f) * kac);
        const float bonus = wave_sum(r * km * rkc);
        s_r[lane] = r; s_w[lane] = w; s_k[lane] = km; s_kk[lane] = kk; s_b[lane] = kk * a;
        __syncthreads();
        float sk0 = 0.f, sk1 = 0.f, sk2 = 0.f, sk3 = 0.f;
#pragma unroll
        for (int j = 0; j < 64; j += 4) { sk0 += st[j] * s_kk[j]; sk1 += st[j + 1] * s_kk[j + 1]; sk2 += st[j + 2] * s_kk[j + 2]; sk3 += st[j + 3] * s_kk[j + 3]; }
        const float sk = (sk0 + sk1) + (sk2 + sk3);
        float y0 = 0.f, y1 = 0.f, y2 = 0.f, y3 = 0.f;
#pragma unroll
        for (int j = 0; j < 64; j += 4) {
            st[j] = st[j] * s_w[j] - sk * s_b[j] + v * s_k[j]; y0 += st[j] * s_r[j];
            st[j + 1] = st[j + 1] * s_w[j + 1] - sk * s_b[j + 1] + v * s_k[j + 1]; y1 += st[j + 1] * s_r[j + 1];
            st[j + 2] = st[j + 2] * s_w[j + 2] - sk * s_b[j + 2] + v * s_k[j + 2]; y2 += st[j + 2] * s_r[j + 2];
            st[j + 3] = st[j + 3] * s_w[j + 3] - sk * s_b[j + 3] + v * s_k[j + 3]; y3 += st[j + 3] * s_r[j + 3];
        }
        const float y = (y0 + y1) + (y2 + y3);
        const float mu = wave_sum(y) * (1.f / 64.f); const float dy = y - mu; const float var = wave_sum(dy * dy) * (1.f / 64.f);
        Y[p] = f2bf(dy * rsqrtf(var + 64e-5f) * lgc + lbc + bonus * v);
        __syncthreads();
    }
}

template <typename TA, int MODE>
static void gemm(hipStream_t s, const TA* A, int lda, const float* W, int ldw, void* C, int ldc, int M, int N, int K) {
    dim3 g((N + 127) / 128, (M + 127) / 128); hipLaunchKernelGGL((k_gemm<TA, MODE>), g, dim3(256), 0, s, A, lda, W, ldw, C, ldc, M, N, K);
}
static inline unsigned nb(size_t n) { return (unsigned)((n + 255) / 256); }

extern "C" void kernel_launch(void* const* d_in, const int* in_sizes, int n_in, void* d_out, int out_size, void* d_ws, size_t ws_size, hipStream_t stream) {
    const float* x = (const float*)d_in[0]; const float* p = (const float*)d_in[1]; const float* norm_gain = (const float*)d_in[2]; const float* final_gain = (const float*)d_in[3];
    const float* ple_proj = (const float*)d_in[4]; const float* ple_gate = (const float*)d_in[5]; const float* even_w_in = (const float*)d_in[6]; const float* even_w_out = (const float*)d_in[7];
    const float* ret_gn = (const float*)d_in[8]; const float* odd_mu = (const float*)d_in[9]; const float* odd_w_in = (const float*)d_in[10]; const float* odd_w_out = (const float*)d_in[11];
    const float* w0 = (const float*)d_in[12]; const float* w1 = (const float*)d_in[13]; const float* w2 = (const float*)d_in[14];
    const float* a0 = (const float*)d_in[15]; const float* a1 = (const float*)d_in[16]; const float* a2 = (const float*)d_in[17];
    const float* v0 = (const float*)d_in[18]; const float* v1 = (const float*)d_in[19]; const float* v2 = (const float*)d_in[20];
    const float* k_k = (const float*)d_in[21]; const float* k_a = (const float*)d_in[22]; const float* r_k = (const float*)d_in[23];
    const float* lnx_g = (const float*)d_in[24]; const float* lnx_b = (const float*)d_in[25];
    static bool once = false;
    if (!once) { once = true;
        hipFuncSetAttribute((const void*)k_attn<0>, hipFuncAttributeMaxDynamicSharedMemorySize, ATT_LDS);
        hipFuncSetAttribute((const void*)k_attn<1>, hipFuncAttributeMaxDynamicSharedMemorySize, ATT_LDS); }
    float* H = (float*)d_out;
    unsigned char* ws = (unsigned char*)d_ws; const size_t MiB = 1u << 20;
    bf16_t* HN = (bf16_t*)(ws);
    unsigned char* BIG = ws + 32 * MiB;
    bf16_t* MIX = (bf16_t*)(ws + 160 * MiB);
    bf16_t* VF = (bf16_t*)(ws + 192 * MiB);
    float* TMP = (float*)(ws + 224 * MiB);
    hipMemcpyAsync(H, x, (size_t)T * D * 4, hipMemcpyDeviceToDevice, stream);
    for (int i = 0; i < 4; ++i) {
        if ((i & 1) == 0) {
            const int e = i >> 1; bf16_t* Z = (bf16_t*)BIG;
            hipLaunchKernelGGL(k_rmsnorm_bf16, dim3(T / 4), dim3(256), 0, stream, H, norm_gain + i * D, HN, T);
            gemm<bf16_t, 2>(stream, HN, D, even_w_in + (size_t)e * D * 4096, 4096, Z, 4096, T, 4096, D);
            hipLaunchKernelGGL(k_rotary, dim3(nb((size_t)T * 512)), dim3(256), 0, stream, Z);
            hipLaunchKernelGGL(k_attn<0>, dim3(128, 8), dim3(256), ATT_LDS, stream, Z, Z + 512, Z + 1024, TMP);
            hipLaunchKernelGGL(k_ret_post, dim3(T), dim3(256), 0, stream, TMP, ret_gn + e * 512, Z, MIX);
            hipLaunchKernelGGL(k_attn<1>, dim3(128, 8), dim3(256), ATT_LDS, stream, Z + 2048, Z + 2560, Z + 3072, TMP);
            hipLaunchKernelGGL(k_sb_post, dim3(nb((size_t)T * 512)), dim3(256), 0, stream, TMP, Z, MIX);
            gemm<bf16_t, 1>(stream, MIX, D, even_w_out + (size_t)e * D * D, D, H, D, T, D, D);
        } else {
            const int o = i >> 1;
            for (int b = 0; b < 2; ++b) {
                const int r0 = b * SEQ; const size_t n = (size_t)SEQ * D;
                bf16_t* XS = (bf16_t*)BIG; bf16_t* Rb = XS + n; bf16_t* Kb = Rb + n; bf16_t* Vb = Kb + n; bf16_t* Gb = Vb + n; bf16_t* Ab = Gb + n; float* LW = (float*)(Ab + n);
                float* LT = (float*)HN; float* L1 = TMP;
                const float* mu = odd_mu + (size_t)o * 6 * D; const float* gain = norm_gain + i * D; const float* win = odd_w_in + (size_t)o * 4 * D * D;
                hipLaunchKernelGGL(k_mix, dim3(SEQ / 4), dim3(256), 0, stream, H, gain, mu + 4 * D, XS, r0, SEQ);
                gemm<bf16_t, 0>(stream, XS, D, w1 + (size_t)o * D * 64, 64, L1, 64, SEQ, 64, D);
                hipLaunchKernelGGL(k_tanh, dim3(nb((size_t)SEQ * 64)), dim3(256), 0, stream, L1, (size_t)SEQ * 64);
                gemm<float, 0>(stream, L1, 64, w2 + (size_t)o * 64 * D, D, LW, D, SEQ, D, 64);
                hipLaunchKernelGGL(k_decay, dim3(nb(n)), dim3(256), 0, stream, LW, w0 + o * D, n);
                hipLaunchKernelGGL(k_mix, dim3(SEQ / 4), dim3(256), 0, stream, H, gain, mu + 5 * D, XS, r0, SEQ);
                gemm<bf16_t, 0>(stream, XS, D, a1 + (size_t)o * D * 64, 64, L1, 64, SEQ, 64, D);
                gemm<float, 0>(stream, L1, 64, a2 + (size_t)o * 64 * D, D, LT, D, SEQ, D, 64);
                hipLaunchKernelGGL(k_sigb, dim3(nb(n)), dim3(256), 0, stream, LT, a0 + o * D, Ab, n);
                hipLaunchKernelGGL(k_mix, dim3(SEQ / 4), dim3(256), 0, stream, H, gain, mu + 1 * D, XS, r0, SEQ);
                gemm<bf16_t, 2>(stream, XS, D, win + (size_t)1 * D * D, D, Kb, D, SEQ, D, D);
                hipLaunchKernelGGL(k_mix, dim3(SEQ / 4), dim3(256), 0, stream, H, gain, mu + 2 * D, XS, r0, SEQ);
                gemm<bf16_t, 2>(stream, XS, D, win + (size_t)2 * D * D, D, Vb, D, SEQ, D, D);
                if (o == 0) hipLaunchKernelGGL(k_copy16, dim3(nb(n)), dim3(256), 0, stream, Vb, VF + (size_t)r0 * D, n);
                else {
                    gemm<bf16_t, 0>(stream, XS, D, v1, 32, L1, 32, SEQ, 32, D);
                    gemm<float, 0>(stream, L1, 32, v2, D, LT, D, SEQ, D, 32);
                    hipLaunchKernelGGL(k_vmix, dim3(nb(n)), dim3(256), 0, stream, Vb, VF + (size_t)r0 * D, LT, v0, n);
                }
                hipLaunchKernelGGL(k_mix, dim3(SEQ / 4), dim3(256), 0, stream, H, gain, mu + 0 * D, XS, r0, SEQ);
                gemm<bf16_t, 2>(stream, XS, D, win, D, Rb, D, SEQ, D, D);
                hipLaunchKernelGGL(k_mix, dim3(SEQ / 4), dim3(256), 0, stream, H, gain, mu + 3 * D, XS, r0, SEQ);
                gemm<bf16_t, 2>(stream, XS, D, win + (size_t)3 * D * D, D, Gb, D, SEQ, D, D);
                hipLaunchKernelGGL(k_rwkv_scan, dim3(16), dim3(64), 0, stream, Rb, Kb, Vb, LW, Ab, k_k + o * D, k_a + o * D, r_k + o * D, lnx_g + o * D, lnx_b + o * D, XS, SEQ);
                hipLaunchKernelGGL(k_gate_mul, dim3(nb(n)), dim3(256), 0, stream, XS, Gb, MIX + (size_t)r0 * D, n);
            }
            gemm<bf16_t, 1>(stream, MIX, D, odd_w_out + (size_t)o * D * D, D, H, D, T, D, D);
        }
        float* G32 = (float*)BIG; float* PP32 = G32 + (size_t)T * D;
        gemm<float, 0>(stream, H, D, ple_gate + (size_t)i * D * D, D, G32, D, T, D, D);
        gemm<float, 0>(stream, p + (size_t)i * T * PLE, PLE, ple_proj + (size_t)i * PLE * D, D, PP32, D, T, D, PLE);
        hipLaunchKernelGGL(k_ple, dim3(nb((size_t)T * D)), dim3(256), 0, stream, H, G32, PP32, (size_t)T * D);
    }
    hipLaunchKernelGGL(k_rmsnorm_f32, dim3(T / 4), dim3(256), 0, stream, H, final_gain, T);
}
```

```cpp
#include <hip/hip_runtime.h>
#include <hip/hip_cooperative_groups.h>
#include <cstdint>
#include <cstdio>
namespace cg = cooperative_groups;

#ifndef MK_MULTI
#define MK_MULTI 0
#endif

#define LAS __attribute__((address_space(3)))
#define GAS __attribute__((address_space(1)))
typedef unsigned short bf16_t;
typedef short bf16x8 __attribute__((ext_vector_type(8)));
typedef float f32x4 __attribute__((ext_vector_type(4)));
typedef float f32x2 __attribute__((ext_vector_type(2)));
typedef unsigned u32x4 __attribute__((ext_vector_type(4)));
typedef unsigned u32x2 __attribute__((ext_vector_type(2)));

constexpr int D = 1024, BATCH = 2, SEQ = 8192, T = BATCH * SEQ, PLE = 256, ZW = 4096;
constexpr float QK_SCALE = 0.08838834764831845f;

__device__ __forceinline__ float bf2f(bf16_t v) { return __uint_as_float(((unsigned)v) << 16); }
__device__ __forceinline__ unsigned f2bf(float f) { unsigned u = __float_as_uint(f); return (u + 0x7fffu + ((u >> 16) & 1u)) >> 16; }
__device__ __forceinline__ unsigned pk2(float lo, float hi) { return f2bf(lo) | (f2bf(hi) << 16); }
__device__ __forceinline__ unsigned cvt_pk_bf16(float lo, float hi) { unsigned r; asm volatile("v_cvt_pk_bf16_f32 %0, %1, %2" : "=v"(r) : "v"(lo), "v"(hi)); return r; }
__device__ __forceinline__ float wave_sum(float v) {
#pragma unroll
    for (int o = 1; o < 64; o <<= 1) v += __shfl_xor(v, o);
    return v;
}
__device__ __forceinline__ float sigmoidf_(float x) { return 1.f / (1.f + __expf(-x)); }
__device__ __forceinline__ float siluf_(float x) { return x / (1.f + __expf(-x)); }
__device__ __forceinline__ float softplusf_(float x) { return x > 20.f ? x : log1pf(expf(x)); }
__device__ __forceinline__ float logsigf_(float x) { return -(x < -20.f ? -x : log1pf(expf(-x))); }
#define LDS_WAIT() asm volatile("s_waitcnt lgkmcnt(0)" ::: "memory")
#define VM_WAIT() asm volatile("s_waitcnt vmcnt(0)" ::: "memory")

namespace pg8 {
constexpr int BM = 256, BK = 64, HALF = 128, HTB = HALF * BK * 2, STAGE_BYTES = 8 * HTB, NXCD = 8, WGM = 8;
__host__ __device__ __forceinline__ int lds_byte(int r, int c) { const int st = (r >> 4) * 2 + (c >> 5), rr = r & 15, cc = c & 31, ob = rr * 64 + cc * 2; return st * 1024 + (ob ^ (((ob >> 9) & 1) << 5)); }
__host__ __device__ __forceinline__ void stage_rc(int b, int& R, int& C) { const int st = b / 1024, sb = b % 1024, swz = sb ^ (((sb >> 9) & 1) << 5); R = (st >> 1) * 16 + swz / 64; C = (st & 1) * 32 + (swz % 64) / 2; }
__host__ __device__ __forceinline__ int perm32(int rho) { const int n = rho >> 4, i = rho & 15; return 8 * (i >> 2) + 4 * n + (i & 3); }
struct Unit { int pm, pn; };
struct Gemm { const bf16_t* A; const bf16_t* Bt; };
struct StaticOrder {
    int nM, nN, nwg, G, c;
    __device__ void init(int nM_, int nN_, int G_, int c_) { nM = nM_; nN = nN_; nwg = nM * nN; G = G_; c = c_; }
    __device__ bool next(int i, Unit& u) const {
        const long L = (long)i * G + c; if (L >= nwg) return false;
        int wgid = (int)L; { const int q = nwg / NXCD, r = nwg % NXCD, xcd = wgid % NXCD, off = wgid / NXCD; wgid = (xcd < r ? xcd * (q + 1) : r * (q + 1) + (xcd - r) * q) + off; }
        const int nig = WGM * nN, gid = wgid / nig, fm = gid * WGM, gsz = (nM - fm) < WGM ? (nM - fm) : WGM;
        u.pm = fm + ((wgid % nig) % gsz); u.pn = (wgid % nig) / gsz; return true;
    }
};
template <class Epi, bool ALIGN_EPI, int LDA, int KK, int TSPLIT, long ASHIFT, long BROW>
__device__ __forceinline__ void gemm_phase(LAS unsigned char* lds, const int tid_in, const Gemm g, const StaticOrder& S, const Epi& E) {
    int tid = tid_in; asm volatile("" : "+v"(tid));
    const int wid = __builtin_amdgcn_readfirstlane(tid >> 6), lane = tid & 63, wr = wid >> 2, wc = wid & 3, fr = lane & 15, fq = lane >> 4;
    constexpr int K = KK, nt = K / BK, lda = LDA, tsplit = TSPLIT; constexpr long ashift = ASHIFT;
    unsigned voffA[2], voffB[2];
#pragma unroll
    for (int i = 0; i < 2; ++i) { int R, C; stage_rc(tid * 16 + i * 8192, R, C); const int Rb = (R & ~31) + perm32(R & 31);
        voffA[i] = (unsigned)(R * lda + C) * 2u; voffB[i] = (unsigned)(Rb * K + C) * 2u; }
    constexpr size_t kstep = (size_t)(BK * 2);
    constexpr size_t hstepA = (size_t)HALF * lda * 2, hstepB = (size_t)HALF * K * 2, tstepA = 2 * hstepA, tstepB = 2 * hstepB;
    const unsigned ldsw = (unsigned)wid * 1024u;
    const int aoff = lds_byte(wr * 64 + fr, fq * 8), boff = lds_byte(wc * 32 + fr, fq * 8);
#define PG8_AP(base, tt) ((base) + (((tt) < tsplit) ? (long)(tt) * 128 : ashift + (long)((tt) - tsplit) * 128))
#define PG8_ABASE(u) ((const char*)g.A + (size_t)(u).pm * tstepA + ((BROW != 0 && (u).pm >= 32) ? BROW : 0))
#define PG8_SA(b, h) (((b) * 2 + (h)) * HTB)
#define PG8_SB(b, h) ((4 + (b) * 2 + (h)) * HTB)
#define PG8_STAGE(bufoff, gbase, voff) do { _Pragma("unroll") for (int _i = 0; _i < 2; ++_i) \
        __builtin_amdgcn_global_load_lds((const unsigned*)((const char*)(gbase) + (voff)[_i]), (LAS unsigned*)(lds + (bufoff) + ldsw + _i * 8192), 16, 0, 0); } while (0)
#define PG8_LDA(dst, b, h) do { _Pragma("unroll") for (int m = 0; m < 4; ++m) _Pragma("unroll") for (int k = 0; k < 2; ++k) dst[m][k] = *(const LAS bf16x8*)(lds + PG8_SA(b, h) + aoff + m * 2048 + k * 1024); } while (0)
#define PG8_LDB(dst, b, h) do { _Pragma("unroll") for (int n = 0; n < 2; ++n) _Pragma("unroll") for (int k = 0; k < 2; ++k) dst[n][k] = *(const LAS bf16x8*)(lds + PG8_SB(b, h) + boff + n * 2048 + k * 1024); } while (0)
#define PG8_MMA(ai, bj, At, Bt) do { __builtin_amdgcn_s_setprio(1); _Pragma("unroll") for (int m = 0; m < 4; ++m) _Pragma("unroll") for (int n = 0; n < 2; ++n) _Pragma("unroll") for (int k = 0; k < 2; ++k) \
        acc[ai][bj][m][n] = __builtin_amdgcn_mfma_f32_16x16x32_bf16(Bt[n][k], At[m][k], acc[ai][bj][m][n], 0, 0, 0); __builtin_amdgcn_s_setprio(0); } while (0)
#define PG8_WAIT_V(n) asm volatile("s_waitcnt vmcnt(" #n ")" ::: "memory")
#define PG8_WAIT_L(n) asm volatile("s_waitcnt lgkmcnt(" #n ")" ::: "memory")
#define PG8_BAR __builtin_amdgcn_s_barrier()
#define PG8_SCHED __builtin_amdgcn_sched_barrier(0)
    Unit cur, nxt; int ui = 0;
    if (!S.next(0, cur)) return;
    f32x4 acc[2][2][4][2];
#pragma unroll
    for (int a = 0; a < 2; ++a)
#pragma unroll
        for (int b = 0; b < 2; ++b)
#pragma unroll
            for (int m = 0; m < 4; ++m)
#pragma unroll
                for (int n = 0; n < 2; ++n) acc[a][b][m][n] = (f32x4){0.f, 0.f, 0.f, 0.f};
    bf16x8 At[4][2], B0[2][2], B1[2][2];
    const char* cA = PG8_ABASE(cur); const char* cB = (const char*)g.Bt + (size_t)cur.pn * tstepB;
    {
        const char* a0 = PG8_AP(cA, 0); const char* a1 = PG8_AP(cA, 1);
        PG8_STAGE(PG8_SB(0, 0), cB, voffB); PG8_STAGE(PG8_SB(0, 1), cB + hstepB, voffB); PG8_STAGE(PG8_SA(0, 0), a0, voffA); PG8_STAGE(PG8_SA(0, 1), a0 + hstepA, voffA);
        if (wr == 1) PG8_BAR;
        PG8_WAIT_V(2); PG8_BAR;
        PG8_STAGE(PG8_SB(1, 0), cB + kstep, voffB); PG8_STAGE(PG8_SA(1, 0), a1, voffA); PG8_STAGE(PG8_SB(1, 1), cB + hstepB + kstep, voffB);
        PG8_WAIT_V(6); PG8_BAR;
    }
    for (;;) {
        const bool has_next = S.next(ui + 1, nxt);
        const char* nA = has_next ? PG8_ABASE(nxt) : cA; const char* nB = has_next ? (const char*)g.Bt + (size_t)nxt.pn * tstepB : cB;
        for (int t = 0; t < nt; t += 2) {
            const bool last = (t == nt - 2);
            const char* a1 = PG8_AP(cA, t + 1);
            const char* a2 = last ? PG8_AP(nA, 0) : PG8_AP(cA, t + 2); const char* b2 = last ? nB : cB + (size_t)(t + 2) * kstep;
            const char* a3 = last ? PG8_AP(nA, 1) : PG8_AP(cA, t + 3); const char* b3 = b2 + kstep;
            PG8_LDB(B0, 0, 0); PG8_LDB(B1, 0, 1); PG8_SCHED; PG8_LDA(At, 0, 0); PG8_STAGE(PG8_SA(1, 1), a1 + hstepA, voffA);
            PG8_WAIT_V(8); PG8_WAIT_L(0); PG8_BAR; PG8_MMA(0, 0, At, B0); PG8_MMA(0, 1, At, B1); PG8_BAR; PG8_SCHED;
            PG8_LDA(At, 0, 1); PG8_STAGE(PG8_SB(0, 0), b2, voffB); PG8_STAGE(PG8_SB(0, 1), b2 + hstepB, voffB); PG8_STAGE(PG8_SA(0, 0), a2, voffA);
            PG8_WAIT_V(8); PG8_WAIT_L(0); PG8_BAR; PG8_MMA(1, 0, At, B0); PG8_MMA(1, 1, At, B1); PG8_BAR; PG8_SCHED;
            PG8_LDB(B0, 1, 0); PG8_LDB(B1, 1, 1); PG8_SCHED; PG8_LDA(At, 1, 0); PG8_STAGE(PG8_SA(0, 1), a2 + hstepA, voffA);
            PG8_WAIT_V(8); PG8_WAIT_L(0); PG8_BAR; PG8_MMA(0, 0, At, B0); PG8_MMA(0, 1, At, B1); PG8_BAR; PG8_SCHED;
            PG8_LDA(At, 1, 1); PG8_STAGE(PG8_SB(1, 0), b3, voffB); PG8_STAGE(PG8_SB(1, 1), b3 + hstepB, voffB); PG8_STAGE(PG8_SA(1, 0), a3, voffA);
            PG8_WAIT_V(8); PG8_WAIT_L(0); PG8_BAR; PG8_MMA(1, 0, At, B0); PG8_MMA(1, 1, At, B1); PG8_BAR; PG8_SCHED;
        }
        if constexpr (ALIGN_EPI) { if (wr == 0) PG8_BAR; }
        E(acc, cur, wr, wc, fr, fq);
        if (!has_next) break;
#pragma unroll
        for (int a = 0; a < 2; ++a)
#pragma unroll
            for (int b = 0; b < 2; ++b)
#pragma unroll
                for (int m = 0; m < 4; ++m)
#pragma unroll
                    for (int n = 0; n < 2; ++n) acc[a][b][m][n] = (f32x4){0.f, 0.f, 0.f, 0.f};
        cur = nxt; cA = nA; cB = nB; ++ui;
        if constexpr (ALIGN_EPI) { if (wr == 1) PG8_BAR; }
    }
    PG8_WAIT_V(0);
    if constexpr (!ALIGN_EPI) { if (wr == 0) PG8_BAR; }
    PG8_BAR;
#undef PG8_AP
#undef PG8_ABASE
#undef PG8_SA
#undef PG8_SB
#undef PG8_STAGE
#undef PG8_LDA
#undef PG8_LDB
#undef PG8_MMA
#undef PG8_WAIT_V
#undef PG8_WAIT_L
#undef PG8_BAR
#undef PG8_SCHED
}
}

template <class Fn>
__device__ __forceinline__ void epi_for(const f32x4 (&acc)[2][2][4][2], const pg8::Unit& u, int wr, int wc, int fr, int fq, Fn fn) {
#pragma unroll
    for (int ai = 0; ai < 2; ++ai)
#pragma unroll
        for (int m = 0; m < 4; ++m) { const int row = u.pm * 256 + ai * 128 + wr * 64 + m * 16 + fr;
#pragma unroll
            for (int bj = 0; bj < 2; ++bj) { const int col = u.pn * 256 + bj * 128 + wc * 32 + 8 * fq; fn(row, col, acc[ai][bj][m][0], acc[ai][bj][m][1]); }
            asm volatile("" ::: "memory"); }
}
__device__ __forceinline__ u32x4 pack8(f32x4 v0, f32x4 v1) { u32x4 w; w.x = cvt_pk_bf16(v0[0], v0[1]); w.y = cvt_pk_bf16(v0[2], v0[3]); w.z = cvt_pk_bf16(v1[0], v1[1]); w.w = cvt_pk_bf16(v1[2], v1[3]); return w; }

struct EpiEvenIn {
    bf16_t* Z; const float* ssq;
    __device__ __forceinline__ void operator()(const f32x4 (&acc)[2][2][4][2], const pg8::Unit& u, int wr, int wc, int fr, int fq) const {
        const bool rot = u.pn < 4;
        epi_for(acc, u, wr, wc, fr, fq, [&](int row, int col, f32x4 v0, f32x4 v1) {
            const float rs = rsqrtf(ssq[row] * (1.f / D) + 1e-6f);
            v0 = v0 * rs; v1 = v1 * rs;
            if (rot) {
                const float pos = (float)(row & (SEQ - 1)); const int i0 = (col & 127) >> 1;
                float o[8] = {v0[0], v0[1], v0[2], v0[3], v1[0], v1[1], v1[2], v1[3]};
                _Pragma("unroll") for (int j = 0; j < 4; ++j) { const float inv = exp2f(-(float)(i0 + j) * (13.287712379549449f / 64.f)); float rev = pos * inv * 0.15915494309189535f; rev = rev - floorf(rev); const float sn = __builtin_amdgcn_sinf(rev), cs = __builtin_amdgcn_cosf(rev);
                    const float x1 = o[2 * j], x2 = o[2 * j + 1]; o[2 * j] = x1 * cs - x2 * sn; o[2 * j + 1] = x1 * sn + x2 * cs; }
                v0 = (f32x4){o[0], o[1], o[2], o[3]}; v1 = (f32x4){o[4], o[5], o[6], o[7]};
            }
            *(u32x4*)(Z + (size_t)row * ZW + col) = pack8(v0, v1);
        });
    }
};
struct EpiOddIn {
    bf16_t* Z; bf16_t* L1;
    __device__ __forceinline__ void operator()(const f32x4 (&acc)[2][2][4][2], const pg8::Unit& u, int wr, int wc, int fr, int fq) const {
        if (u.pn < 16) { epi_for(acc, u, wr, wc, fr, fq, [&](int row, int col, f32x4 v0, f32x4 v1) { *(u32x4*)(Z + (size_t)row * ZW + col) = pack8(v0, v1); }); }
        else { epi_for(acc, u, wr, wc, fr, fq, [&](int row, int col, f32x4 v0, f32x4 v1) { const int c = col - 4096; if (c < 64) {
                    _Pragma("unroll") for (int j = 0; j < 4; ++j) { v0[j] = tanhf(v0[j]); v1[j] = tanhf(v1[j]); } }
                *(u32x4*)(L1 + (size_t)row * 256 + c) = pack8(v0, v1); }); }
    }
};
struct EpiResid {
    float* H; bf16_t* HB; int ldb;
    __device__ __forceinline__ void operator()(const f32x4 (&acc)[2][2][4][2], const pg8::Unit& u, int wr, int wc, int fr, int fq) const {
        epi_for(acc, u, wr, wc, fr, fq, [&](int row, int col, f32x4 v0, f32x4 v1) { float* hp = H + (size_t)row * D + col; f32x4 h0 = *(const f32x4*)hp, h1 = *(const f32x4*)(hp + 4); h0 = h0 + v0; h1 = h1 + v1;
            *(f32x4*)hp = h0; *(f32x4*)(hp + 4) = h1; *(u32x4*)(HB + (size_t)row * ldb + col) = pack8(h0, h1); });
    }
};
struct EpiStore {
    bf16_t* O; int ldc;
    __device__ __forceinline__ void operator()(const f32x4 (&acc)[2][2][4][2], const pg8::Unit& u, int wr, int wc, int fr, int fq) const {
        epi_for(acc, u, wr, wc, fr, fq, [&](int row, int col, f32x4 v0, f32x4 v1) { *(u32x4*)(O + (size_t)row * ldc + col) = pack8(v0, v1); });
    }
};
struct EpiGate {
    float* H; const bf16_t* PP; int ldp; bf16_t* HB2; float* ssq;
    __device__ __forceinline__ void operator()(const f32x4 (&acc)[2][2][4][2], const pg8::Unit& u, int wr, int wc, int fr, int fq) const {
#pragma unroll
        for (int ai = 0; ai < 2; ++ai)
#pragma unroll
            for (int m = 0; m < 4; ++m) { const int row = u.pm * 256 + ai * 128 + wr * 64 + m * 16 + fr; float sq = 0.f;
#pragma unroll
                for (int bj = 0; bj < 2; ++bj) { const int col = u.pn * 256 + bj * 128 + wc * 32 + 8 * fq; const f32x4 v0 = acc[ai][bj][m][0], v1 = acc[ai][bj][m][1];
                    float* hp = H + (size_t)row * D + col; f32x4 h0 = *(const f32x4*)hp, h1 = *(const f32x4*)(hp + 4); const u32x4 pw = *(const u32x4*)(PP + (size_t)row * ldp + col);
                    const unsigned pwv[4] = {pw.x, pw.y, pw.z, pw.w};
                    float pp[8];
#pragma unroll
                    for (int j = 0; j < 4; ++j) { pp[2 * j] = __uint_as_float(pwv[j] << 16); pp[2 * j + 1] = __uint_as_float(pwv[j] & 0xffff0000u); }
#pragma unroll
                    for (int j = 0; j < 4; ++j) { h0[j] += sigmoidf_(v0[j]) * pp[j]; h1[j] += sigmoidf_(v1[j]) * pp[4 + j]; sq += h0[j] * h0[j] + h1[j] * h1[j]; }
                    *(f32x4*)hp = h0; *(f32x4*)(hp + 4) = h1; if (HB2) *(u32x4*)(HB2 + (size_t)row * D + col) = pack8(h0, h1); }
                sq += __shfl_xor(sq, 16); sq += __shfl_xor(sq, 32);
                if (fq == 0) atomicAdd(ssq + row, sq);
                asm volatile("" ::: "memory"); }
    }
};

#define XB_TMO      128
#define XB_XCNT(j)  (256  + 64 * (j))
#define XB_XSUB(j)  (1280 + 64 * (j))
#define XB_XGEN(j)  (2304 + 64 * (j))
#define XB_TOP      3328
#define XB_TOPGEN   3392
#define XCD_BAR_WORDS 3456
#define XB_SPIN_CAP (1u << 22)
__device__ __forceinline__ unsigned xb_ld(unsigned* p)              { return __hip_atomic_load(p, __ATOMIC_RELAXED, __HIP_MEMORY_SCOPE_AGENT); }
__device__ __forceinline__ unsigned xb_add(unsigned* p, unsigned v) { return __hip_atomic_fetch_add(p, v, __ATOMIC_RELAXED, __HIP_MEMORY_SCOPE_AGENT); }
__device__ __forceinline__ unsigned xb_xcc_id() { return (unsigned)__builtin_amdgcn_s_getreg((3 << 11) | 20) & 0xFu; }
#define XB_SPIN(cond, bar) do { unsigned _sp = 0; while (cond) { __builtin_amdgcn_s_sleep(1); \
    if ((++_sp & 255u) == 0u) { if (xb_ld(&(bar)[XB_TMO])) break; if (_sp > XB_SPIN_CAP) { atomicAdd(&(bar)[XB_TMO], 1u); break; } } } } while (0)
struct XcdBarrier { unsigned* bar; unsigned x; volatile LAS unsigned* st; };
__device__ __forceinline__ XcdBarrier xcd_barrier_post(unsigned* bar, volatile LAS unsigned* st) {
    XcdBarrier b; b.bar = bar; b.x = xb_xcc_id(); b.st = st;
    if (threadIdx.x == 0) (void)xb_add(&bar[XB_XCNT(b.x)], 1u);
    return b;
}
__device__ __forceinline__ void xcd_barrier_complete(unsigned* bar, unsigned x, unsigned& nloc, unsigned& nx) {
    const unsigned G = gridDim.x * gridDim.y * gridDim.z;
    unsigned sum, cnt, mine, sp = 0u;
    for (;;) {
        sum = 0u; cnt = 0u; mine = 0u;
#pragma unroll
        for (unsigned j = 0; j < 16; ++j) { const unsigned c = xb_ld(&bar[XB_XCNT(j)]); sum += c; cnt += (c > 0u) ? 1u : 0u; mine = (j == x) ? c : mine; }
        if (sum == G) break;
        __builtin_amdgcn_s_sleep(1);
        if ((++sp & 255u) == 0u) { if (xb_ld(&bar[XB_TMO])) break; if (sp > XB_SPIN_CAP) { atomicAdd(&bar[XB_TMO], 1u); break; } }
    }
    nloc = mine > 0u ? mine : 1u; nx = cnt > 0u ? cnt : 1u;
}
__device__ __forceinline__ void xcd_barrier(const XcdBarrier& b_in) {
    asm volatile("s_waitcnt vmcnt(0)" ::: "memory");
    __syncthreads();
    if (threadIdx.x == 0) {
        const XcdBarrier& b = b_in;
        unsigned* bar = b.bar;
        __builtin_amdgcn_s_waitcnt(0);
        unsigned nloc = b.st[0], nx = b.st[1];
        if (nloc == 0u) { xcd_barrier_complete(bar, b.x, nloc, nx); b.st[0] = nloc; b.st[1] = nx; }
        const unsigned old = xb_add(&bar[XB_XSUB(b.x)], 1u);
        const unsigned gen = old / nloc;
        if (old + 1u == (gen + 1u) * nloc) {
            __builtin_amdgcn_fence(__ATOMIC_RELEASE, "agent");
            asm volatile("s_waitcnt vmcnt(0)" ::: "memory");
            const unsigned og = xb_add(&bar[XB_TOP], 1u);
            const unsigned tg = og / nx;
            if (og + 1u == (tg + 1u) * nx) xb_add(&bar[XB_TOPGEN], 1u);
            else XB_SPIN(xb_ld(&bar[XB_TOPGEN]) == tg, bar);
            __builtin_amdgcn_fence(__ATOMIC_ACQUIRE, "agent");
            xb_add(&bar[XB_XGEN(b.x)], 1u);
            asm volatile("s_waitcnt vmcnt(0)" ::: "memory");
        } else {
            XB_SPIN(xb_ld(&bar[XB_XGEN(b.x)]) == gen, bar);
            __builtin_amdgcn_fence(__ATOMIC_ACQUIRE, "agent");
            asm volatile("s_waitcnt vmcnt(0)" ::: "memory");
        }
    }
    __syncthreads();
}

constexpr size_t MiB = 1u << 20;
constexpr size_t WS_CTL = 0, CTL_BYTES = 1 * MiB;
constexpr size_t WS_SSQ = 256 * 1024;
constexpr size_t WS_WIN = 2 * MiB;
constexpr size_t WS_WOUT = 19 * MiB, WS_WGATE = 21 * MiB, WS_WPROJ = 23 * MiB;
constexpr size_t WS_PB = 24 * MiB;
constexpr size_t WS_Z = 32 * MiB;
constexpr size_t WS_HB = 160 * MiB;
constexpr size_t WS_VF = 193 * MiB;
constexpr size_t WS_L1 = 225 * MiB;
constexpr size_t WS_SCR = 233 * MiB;
constexpr size_t WS_END = 256 * MiB;

constexpr int RING_BYTES = 131072, MISC_OFF = RING_BYTES + 320, LDS_BYTES = 147456;

struct Args { const float* in[26]; float* out; unsigned char* ws; int ph_lo, ph_hi; };

__device__ __forceinline__ const float* inptr(int i) { asm volatile("" : "+s"(i)); const char* ka = (const char*)__builtin_amdgcn_kernarg_segment_ptr(); return *(const float* const*)(ka + 8 * i); }
struct InTab { __device__ __forceinline__ const float* operator[](int i) const { return inptr(i); } };
struct Frame {
    LAS unsigned char* lds; unsigned char* ldsg;
    int tid, lane, wave, G, vcu;
    InTab in; float* H; unsigned char* ws;
    __device__ __forceinline__ void retid() { int l; asm volatile("v_mbcnt_lo_u32_b32 %0, -1, 0\n\tv_mbcnt_hi_u32_b32 %0, -1, %0" : "=v"(l)); lane = l; tid = wave * 64 + l; }
    __device__ __forceinline__ float* ssq(int l) const { return (float*)(ws + WS_SSQ) + (size_t)l * T; }
};

__device__ __forceinline__ void conv_item(const float* W, int ldw, int Kmax, int k0, int n0, bf16_t* dst, int ldd, int dr0, int drs, int dk0,
                                          const float* svec, float sa, float sb, float sc, LAS float* scr, int lane) {
#pragma unroll 8
    for (int i = 0; i < 32; ++i) { const int kk = 2 * i + (lane >> 5), k = k0 + kk; float v = 0.f;
        if (k < Kmax) { const float f = (sa + sb * (svec ? svec[k] : 0.f)) * sc; v = W[(size_t)k * ldw + n0 + (lane & 31)] * f; }
        scr[kk * 33 + (lane & 31)] = v; }
    LDS_WAIT(); asm volatile("" ::: "memory");
    const int c = lane & 7;
    if (k0 + 8 * c < Kmax) {
#pragma unroll
        for (int j = 0; j < 4; ++j) { const int n = (lane >> 3) + 8 * j; const LAS float* s = scr + (8 * c) * 33 + n;
            u32x4 o; o.x = pk2(s[0 * 33], s[1 * 33]); o.y = pk2(s[2 * 33], s[3 * 33]); o.z = pk2(s[4 * 33], s[5 * 33]); o.w = pk2(s[6 * 33], s[7 * 33]);
            *(GAS u32x4*)(dst + (size_t)(dr0 + n * drs) * ldd + dk0 + k0 + 8 * c) = o; }
    }
    LDS_WAIT(); asm volatile("" ::: "memory");
}
__device__ __forceinline__ void conv_win_even(Frame& F, int li) {
    const int e = li >> 1; const float* W = F.in[6] + (size_t)e * D * ZW; const float* gain = F.in[2] + li * D; bf16_t* dst = (bf16_t*)(F.ws + WS_WIN);
    LAS float* scr = (LAS float*)(F.lds + F.wave * 16384);
    const int gw = F.vcu * 8 + F.wave, NGW = F.G * 8;
    for (int it = gw; it < 16 * 128; it += NGW) { const int kb = it >> 7, nb = it & 127, n0 = nb * 32, g = n0 >> 9, hh = (n0 & 511) >> 7, d0 = n0 & 127;
        int dr0 = n0, drs = 1; if (g < 2) { dr0 = g * 512 + hh * 128 + (d0 < 64 ? 2 * d0 : 2 * (d0 - 64) + 1); drs = 2; }
        const float sc = (g == 1 || g == 5) ? QK_SCALE : 1.f;
        conv_item(W, ZW, D, kb * 64, n0, dst, D, dr0, drs, 0, gain, 0.f, 1.f, sc, scr, F.lane); }
}
__device__ __forceinline__ void conv_win_odd(Frame& F, int li) {
    const int o = li >> 1; const float* mu = F.in[9] + (size_t)o * 6 * D; bf16_t* dst = (bf16_t*)(F.ws + WS_WIN);
    LAS float* scr = (LAS float*)(F.lds + F.wave * 16384);
    const int gw = F.vcu * 8 + F.wave, NGW = F.G * 8;
    for (int it = gw; it < 4 * 2 * 512; it += NGW) { const int p = it >> 10, half = (it >> 9) & 1, r = it & 511, kb = r >> 5, nb = r & 31;
        const float* W = F.in[10] + ((size_t)o * 4 + p) * D * D;
        conv_item(W, D, D, kb * 64, nb * 32, dst, 2048, p * 1024 + nb * 32, 1, half * 1024, mu + p * D, half ? 0.f : 1.f, half ? 1.f : -1.f, 1.f, scr, F.lane); }
    for (int it = gw; it < 2 * (32 + 32 + 16); it += NGW) { const int half = it / 80, r = it % 80; const float* W; int ldw, n0, dr0, mi, kb;
        if (r < 32) { W = F.in[13] + (size_t)o * D * 64; ldw = 64; kb = r >> 1; n0 = (r & 1) * 32; dr0 = 4096 + n0; mi = 4; }
        else if (r < 64) { const int q = r - 32; W = F.in[16] + (size_t)o * D * 64; ldw = 64; kb = q >> 1; n0 = (q & 1) * 32; dr0 = 4160 + n0; mi = 5; }
        else { const int q = r - 64; W = F.in[19]; ldw = 32; kb = q; n0 = 0; dr0 = 4224; mi = 2; }
        const float sc = (r >= 64 && o == 0) ? 0.f : 1.f;
        conv_item(W, ldw, D, kb * 64, n0, dst, 2048, dr0, 1, half * 1024, mu + mi * D, half ? 0.f : 1.f, half ? 1.f : -1.f, sc, scr, F.lane); }
    { u32x4 z = {0u, 0u, 0u, 0u}; GAS u32x4* zp = (GAS u32x4*)(dst + (size_t)4256 * 2048); const int n16 = 96 * 2048 * 2 / 16;
      for (int i = (F.vcu * 512 + F.tid); i < n16; i += F.G * 512) zp[i] = z; }
}
__device__ __forceinline__ void conv_wrest(Frame& F, int li) {
    const bool even = (li & 1) == 0; const int e = li >> 1;
    const float* Wo = even ? F.in[7] + (size_t)e * D * D : F.in[11] + (size_t)e * D * D;
    const float* Wg = F.in[5] + (size_t)li * D * D; const float* Wp = F.in[4] + (size_t)li * PLE * D;
    LAS float* scr = (LAS float*)(F.lds + F.wave * 16384);
    const int gw = F.vcu * 8 + F.wave, NGW = F.G * 8;
    for (int it = gw; it < 512 + 512 + 128; it += NGW) {
        if (it < 512) conv_item(Wo, D, D, (it >> 5) * 64, (it & 31) * 32, (bf16_t*)(F.ws + WS_WOUT), D, (it & 31) * 32, 1, 0, nullptr, 1.f, 0.f, 1.f, scr, F.lane);
        else if (it < 1024) { const int r = it - 512; conv_item(Wg, D, D, (r >> 5) * 64, (r & 31) * 32, (bf16_t*)(F.ws + WS_WGATE), D, (r & 31) * 32, 1, 0, nullptr, 1.f, 0.f, 1.f, scr, F.lane); }
        else { const int r = it - 1024; conv_item(Wp, D, PLE, (r >> 5) * 64, (r & 31) * 32, (bf16_t*)(F.ws + WS_WPROJ), PLE, (r & 31) * 32, 1, 0, nullptr, 1.f, 0.f, 1.f, scr, F.lane); }
    }
    const float* P = F.in[1] + (size_t)li * T * PLE; GAS u32x4* pb = (GAS u32x4*)(F.ws + WS_PB); const int n8 = T * PLE / 8;
    for (int i = F.vcu * 512 + F.tid; i < n8; i += F.G * 512) { const f32x4 a = *(const f32x4*)(P + (size_t)i * 8), b = *(const f32x4*)(P + (size_t)i * 8 + 4);
        u32x4 o; o.x = pk2(a[0], a[1]); o.y = pk2(a[2], a[3]); o.z = pk2(b[0], b[1]); o.w = pk2(b[2], b[3]); pb[i] = o; }
}

__device__ __forceinline__ void rows_p0(Frame& F) {
    const float* x = F.in[0]; bf16_t* HB = (bf16_t*)(F.ws + WS_HB); float* s0 = F.ssq(0);
    for (int row = F.vcu * 8 + F.wave; row < T; row += F.G * 8) {
        const f32x4* xr = (const f32x4*)(x + (size_t)row * D) + F.lane; f32x4* hr = (f32x4*)(F.H + (size_t)row * D) + F.lane; u32x2* br = (u32x2*)(HB + (size_t)row * D) + F.lane; float s = 0.f;
#pragma unroll
        for (int j = 0; j < 4; ++j) { const f32x4 v = xr[64 * j]; s += (v[0] * v[0] + v[1] * v[1]) + (v[2] * v[2] + v[3] * v[3]); hr[64 * j] = v; u32x2 w; w.x = pk2(v[0], v[1]); w.y = pk2(v[2], v[3]); br[64 * j] = w; }
        s = wave_sum(s); if (F.lane == 0) s0[row] = s;
    }
}
__device__ __forceinline__ void rows_norm(Frame& F, int li) {
    const float* gain = F.in[2] + li * D; bf16_t* HN = (bf16_t*)(F.ws + WS_HB); const float* sq = F.ssq(li);
    f32x4 g[4];
#pragma unroll
    for (int j = 0; j < 4; ++j) g[j] = *((const f32x4*)gain + F.lane + 64 * j);
    for (int row = F.vcu * 8 + F.wave; row < T; row += F.G * 8) {
        const f32x4* hr = (const f32x4*)(F.H + (size_t)row * D) + F.lane; u32x2* br = (u32x2*)(HN + (size_t)(row + 1 + (row >= SEQ ? 1 : 0)) * D) + F.lane;
        const float rs = rsqrtf(sq[row] * (1.f / D) + 1e-6f);
#pragma unroll
        for (int j = 0; j < 4; ++j) { const f32x4 v = hr[64 * j] * rs * g[j]; u32x2 w; w.x = pk2(v[0], v[1]); w.y = pk2(v[2], v[3]); br[64 * j] = w; }
    }
    if (F.vcu == 0 && F.wave < 2) { u32x2* br = (u32x2*)(HN + (size_t)(F.wave ? SEQ + 1 : 0) * D) + F.lane; u32x2 z = {0u, 0u};
#pragma unroll
        for (int j = 0; j < 4; ++j) br[64 * j] = z; }
}
__device__ __forceinline__ void rows_final(Frame& F) {
    const float* gain = F.in[3]; const float* sq = F.ssq(4);
    f32x4 g[4];
#pragma unroll
    for (int j = 0; j < 4; ++j) g[j] = *((const f32x4*)gain + F.lane + 64 * j);
    for (int row = F.vcu * 8 + F.wave; row < T; row += F.G * 8) {
        f32x4* hr = (f32x4*)(F.H + (size_t)row * D) + F.lane; const float rs = rsqrtf(sq[row] * (1.f / D) + 1e-6f);
#pragma unroll
        for (int j = 0; j < 4; ++j) hr[64 * j] = hr[64 * j] * rs * g[j];
    }
}

__device__ __forceinline__ void attn_unit(Frame& F, int mode, int bh, int qt, const float* gng) {
    float* sm = (float*)F.ldsg;
    float* Qs = sm; float* Ks = Qs + 64 * 129; float* Vs = Ks + 64 * 129; float* Ws = Vs + 64 * 128;
    bf16_t* Z = (bf16_t*)(F.ws + WS_Z);
    const int tid = F.tid, tx = tid & 15, ty = (tid >> 4) & 15, b = bh >> 2, h = bh & 3; const bool comp = tid < 256;
    const int cq = mode * 2048 + h * 128, ck = cq + 512, cv = cq + 1024, cg_ = cq + 1536;
    const size_t rowb = (size_t)b * SEQ; const int q0 = qt * 64;
    __syncthreads();
    for (int e = tid; e < 64 * 128; e += 512) { const int r = e >> 7, c = e & 127; Qs[r * 129 + c] = bf2f(Z[(rowb + q0 + r) * ZW + cq + c]); }
    float acc[4][8];
#pragma unroll
    for (int i = 0; i < 4; ++i)
#pragma unroll
        for (int j = 0; j < 8; ++j) acc[i][j] = 0.f;
    float carry = 0.f;
    const float lg = logf(1.f - exp2f(-5.f - (float)h));
    for (int kt = qt; kt >= 0; --kt) {
        const int k0 = kt * 64;
        __syncthreads();
        for (int e = tid; e < 64 * 128; e += 512) { const int r = e >> 7, c = e & 127; const size_t gk = (rowb + k0 + r) * ZW; Ks[r * 129 + c] = bf2f(Z[gk + ck + c]); Vs[r * 128 + c] = bf2f(Z[gk + cv + c]); }
        __syncthreads();
        if (comp) {
            float z[4][4];
#pragma unroll
            for (int i = 0; i < 4; ++i)
#pragma unroll
                for (int j = 0; j < 4; ++j) z[i][j] = 0.f;
            for (int d = 0; d < 128; ++d) {
                float a[4], bb[4];
#pragma unroll
                for (int i = 0; i < 4; ++i) a[i] = Qs[(ty + 16 * i) * 129 + d];
#pragma unroll
                for (int j = 0; j < 4; ++j) bb[j] = Ks[(tx + 16 * j) * 129 + d];
#pragma unroll
                for (int i = 0; i < 4; ++i)
#pragma unroll
                    for (int j = 0; j < 4; ++j) z[i][j] += a[i] * bb[j];
            }
#pragma unroll
            for (int i = 0; i < 4; ++i)
#pragma unroll
                for (int j = 0; j < 4; ++j) Ws[(ty + 16 * i) * 65 + tx + 16 * j] = z[i][j];
        }
        __syncthreads();
        if (tid < 64) {
            const int tq = q0 + tid;
            if (mode == 0) {
                for (int k = 0; k < 64; ++k) { const int s = k0 + k; const float zz = Ws[tid * 65 + k]; Ws[tid * 65 + k] = (s <= tq) ? zz * expf((float)(tq - s) * lg) : 0.f; }
            } else {
                float run = carry;
                for (int k = 63; k >= 0; --k) { const int s = k0 + k; const float zz = Ws[tid * 65 + k]; float w = 0.f;
                    if (s < tq) { const float L = logsigf_(-zz); w = expf(zz + L + run); run += L; }
                    Ws[tid * 65 + k] = w; }
                carry = run;
            }
        }
        __syncthreads();
        if (comp) {
            for (int k = 0; k < 64; ++k) {
                float a[4], bb[8];
#pragma unroll
                for (int i = 0; i < 4; ++i) a[i] = Ws[(ty + 16 * i) * 65 + k];
#pragma unroll
                for (int j = 0; j < 8; ++j) bb[j] = Vs[k * 128 + tx + 16 * j];
#pragma unroll
                for (int i = 0; i < 4; ++i)
#pragma unroll
                    for (int j = 0; j < 8; ++j) acc[i][j] += a[i] * bb[j];
            }
        }
    }
    if (comp) {
#pragma unroll
        for (int i = 0; i < 4; ++i) {
            const size_t grow = (rowb + q0 + ty + 16 * i) * ZW + cg_;
            if (mode == 0) {
                float s = 0.f;
#pragma unroll
                for (int j = 0; j < 8; ++j) s += acc[i][j];
                s += __shfl_xor(s, 1); s += __shfl_xor(s, 2); s += __shfl_xor(s, 4); s += __shfl_xor(s, 8);
                const float mu = s * (1.f / 128.f); float q = 0.f;
#pragma unroll
                for (int j = 0; j < 8; ++j) { const float d = acc[i][j] - mu; q += d * d; }
                q += __shfl_xor(q, 1); q += __shfl_xor(q, 2); q += __shfl_xor(q, 4); q += __shfl_xor(q, 8);
                const float rs = rsqrtf(q * (1.f / 128.f) + 1e-5f);
#pragma unroll
                for (int j = 0; j < 8; ++j) { const int c = tx + 16 * j; const float ga = bf2f(Z[grow + c]); Z[grow + c] = (bf16_t)f2bf((acc[i][j] - mu) * rs * gng[h * 128 + c] * siluf_(ga)); }
            } else {
#pragma unroll
                for (int j = 0; j < 8; ++j) { const int c = tx + 16 * j; const float gb = bf2f(Z[grow + c]); Z[grow + c] = (bf16_t)f2bf(acc[i][j] * siluf_(gb)); }
            }
        }
    }
}
__device__ __forceinline__ void phase_attn_naive(Frame& F, int li) {
    const float* gng = F.in[8] + (li >> 1) * 512;
    for (int uidx = F.vcu; uidx < 2048; uidx += F.G) { const int qt = 127 - (uidx >> 4), r = uidx & 15; attn_unit(F, r >> 3, r & 7, qt, gng); }
    __syncthreads();
}

__device__ __forceinline__ void phase_scan_naive(Frame& F, int li) {
    const int o = li >> 1;
    if (F.vcu >= 4) return;
    const int b = F.vcu >> 1, h = (F.vcu & 1) * 8 + F.wave, lane = F.lane, c = h * 64 + lane;
    bf16_t* Z = (bf16_t*)(F.ws + WS_Z); const bf16_t* L1 = (const bf16_t*)(F.ws + WS_L1); bf16_t* VF = (bf16_t*)(F.ws + WS_VF);
    const float* w2 = F.in[14] + (size_t)o * 64 * D; const float* a2 = F.in[17] + (size_t)o * 64 * D; const float* v2 = F.in[20];
    const float w0c = F.in[12][o * D + c], a0c = F.in[15][o * D + c], v0c = o ? F.in[18][c] : 0.f;
    const float kkc = F.in[21][o * D + c], kac = F.in[22][o * D + c], rkc = F.in[23][o * D + c], lgc = F.in[24][o * D + c], lbc = F.in[25][o * D + c];
    LAS float* wl = (LAS float*)(F.lds + F.wave * 16384);
    LAS float* s_r = wl; LAS float* s_w = wl + 512; LAS float* s_k = wl + 1024; LAS float* s_a = wl + 1536; LAS float* s_v = wl + 2048; LAS float* s_l1 = wl + 2560;
    LAS float* c_kk = wl + 3840; LAS float* c_b = wl + 3904; LAS float* c_km = wl + 3968;
    float st[64];
#pragma unroll
    for (int k = 0; k < 64; ++k) st[k] = 0.f;
#pragma unroll 1
    for (int t0 = 0; t0 < SEQ; t0 += 8) {
        for (int e = lane; e < 8 * 160; e += 64) { const int s = e / 160, j = e % 160; s_l1[e] = bf2f(L1[((size_t)b * SEQ + t0 + s) * 256 + j]); }
        LDS_WAIT(); asm volatile("" ::: "memory");
        {
            float lw[8], la[8], lv[8];
#pragma unroll
            for (int s = 0; s < 8; ++s) { lw[s] = 0.f; la[s] = 0.f; lv[s] = 0.f; }
#pragma unroll 2
            for (int j = 0; j < 64; ++j) { const float wj = w2[(size_t)j * D + c], aj = a2[(size_t)j * D + c];
#pragma unroll
                for (int s = 0; s < 8; ++s) { lw[s] += s_l1[s * 160 + j] * wj; la[s] += s_l1[s * 160 + 64 + j] * aj; } }
            if (o) {
#pragma unroll 2
                for (int j = 0; j < 32; ++j) { const float vj = v2[(size_t)j * D + c];
#pragma unroll
                    for (int s = 0; s < 8; ++s) lv[s] += s_l1[s * 160 + 128 + j] * vj; } }
#pragma unroll
            for (int s = 0; s < 8; ++s) {
                const size_t row = (size_t)b * SEQ + t0 + s; const size_t p = row * ZW + c;
                const float r = bf2f(Z[p]), k = bf2f(Z[p + 1024]); float v = bf2f(Z[p + 2048]);
                const float w = expf(-expf(-softplusf_(-(w0c + lw[s])) - 0.5f)); const float a = sigmoidf_(a0c + la[s]);
                if (o) { const float vf = bf2f(VF[row * D + c]); v = v + (vf - v) * sigmoidf_(v0c + lv[s]); } else VF[row * D + c] = (bf16_t)f2bf(v);
                s_r[s * 64 + lane] = r; s_w[s * 64 + lane] = w; s_k[s * 64 + lane] = k; s_a[s * 64 + lane] = a; s_v[s * 64 + lane] = v;
            }
        }
        LDS_WAIT(); asm volatile("" ::: "memory");
#pragma unroll 1
        for (int s = 0; s < 8; ++s) {
            const float r = s_r[s * 64 + lane], k = s_k[s * 64 + lane], a = s_a[s * 64 + lane], v = s_v[s * 64 + lane];
            const float kr = k * kkc; const float nrm = sqrtf(wave_sum(kr * kr)); const float kk = kr / fmaxf(nrm, 1e-12f);
            const float km = k * (1.f + (a - 1.f) * kac);
            const float bonus = wave_sum(r * km * rkc);
            c_kk[lane] = kk; c_b[lane] = kk * a; c_km[lane] = km;
            LDS_WAIT(); asm volatile("" ::: "memory");
            const LAS float* pw = s_w + s * 64; const LAS float* pr = s_r + s * 64;
            float sk0 = 0.f, sk1 = 0.f, sk2 = 0.f, sk3 = 0.f;
#pragma unroll
            for (int j = 0; j < 64; j += 4) { sk0 += st[j] * c_kk[j]; sk1 += st[j + 1] * c_kk[j + 1]; sk2 += st[j + 2] * c_kk[j + 2]; sk3 += st[j + 3] * c_kk[j + 3]; }
            const float sk = (sk0 + sk1) + (sk2 + sk3);
            float y0 = 0.f, y1 = 0.f, y2 = 0.f, y3 = 0.f;
#pragma unroll
            for (int j = 0; j < 64; j += 4) {
                st[j] = st[j] * pw[j] - sk * c_b[j] + v * c_km[j]; y0 += st[j] * pr[j];
                st[j + 1] = st[j + 1] * pw[j + 1] - sk * c_b[j + 1] + v * c_km[j + 1]; y1 += st[j + 1] * pr[j + 1];
                st[j + 2] = st[j + 2] * pw[j + 2] - sk * c_b[j + 2] + v * c_km[j + 2]; y2 += st[j + 2] * pr[j + 2];
                st[j + 3] = st[j + 3] * pw[j + 3] - sk * c_b[j + 3] + v * c_km[j + 3]; y3 += st[j + 3] * pr[j + 3];
            }
            const float y = (y0 + y1) + (y2 + y3);
            const float mu = wave_sum(y) * (1.f / 64.f); const float dy = y - mu; const float var = wave_sum(dy * dy) * (1.f / 64.f);
            const float yo = dy * rsqrtf(var + 64e-5f) * lgc + lbc + bonus * v;
            const size_t pg = ((size_t)b * SEQ + t0 + s) * ZW + 3072 + c; const float g = bf2f(Z[pg]);
            Z[pg] = (bf16_t)f2bf(yo * siluf_(g));
            LDS_WAIT(); asm volatile("" ::: "memory");
        }
    }
}

enum { PH_P0 = 0, PH_FINAL = 19, N_PHASES = 20 };
#define IN(k) (lo <= (k) && (k) < hi)
#if MK_MULTI
#define SEAM(k) do { } while (0)
#else
#define SEAM(k) do { if (IN(k) && IN((k) + 1)) xcd_barrier(bar); } while (0)
#endif
template <int LI>
__device__ __forceinline__ void run_layer(Frame& F, const XcdBarrier& bar, const int lo, const int hi, const int bx) {
    constexpr bool even = (LI & 1) == 0;
    constexpr int base = 1 + (LI / 2) * 9 + (even ? 0 : 4);
    constexpr int p1 = base + (even ? 0 : 1);
    bf16_t* Zp = (bf16_t*)(F.ws + WS_Z);
    if constexpr (!even) { if (IN(base)) { F.retid(); rows_norm(F, LI); } SEAM(base); }
    if (IN(p1)) {
        F.retid(); pg8::StaticOrder S;
        if constexpr (even) { pg8::Gemm g{(const bf16_t*)(F.ws + WS_HB), (const bf16_t*)(F.ws + WS_WIN)}; S.init(64, 16, F.G, bx);
            EpiEvenIn E{Zp, F.ssq(LI)}; pg8::gemm_phase<EpiEvenIn, true, D, D, 1 << 20, 0, 0>(F.lds, F.tid, g, S, E); }
        else { pg8::Gemm g{(const bf16_t*)(F.ws + WS_HB) + D, (const bf16_t*)(F.ws + WS_WIN)}; S.init(64, 17, F.G, bx);
            EpiOddIn E{Zp, (bf16_t*)(F.ws + WS_L1)}; pg8::gemm_phase<EpiOddIn, true, D, 2048, 16, -(long)(D * 2), (long)(D * 2)>(F.lds, F.tid, g, S, E); }
    }
    SEAM(p1);
    if (IN(p1 + 1)) {
        F.retid();
#ifndef NO_CONV
        conv_wrest(F, LI);
        if constexpr (LI < 3) { if constexpr (even) conv_win_odd(F, LI + 1); else conv_win_even(F, LI + 1); }
#endif
        __syncthreads();
#ifndef NO_ATTN
        if constexpr (even) phase_attn_naive(F, LI);
#endif
#ifndef NO_SCAN
        if constexpr (!even) phase_scan_naive(F, LI);
#endif
    }
    SEAM(p1 + 1);
    if (IN(p1 + 2)) {
        F.retid(); pg8::StaticOrder S; S.init(64, 4, F.G, bx);
        { pg8::Gemm g{(const bf16_t*)(F.ws + WS_PB), (const bf16_t*)(F.ws + WS_WPROJ)};
          EpiStore E{Zp, ZW}; pg8::gemm_phase<EpiStore, false, PLE, PLE, 1 << 20, 0, 0>(F.lds, F.tid, g, S, E); }
        if constexpr (even) { pg8::Gemm g{Zp + 1536, (const bf16_t*)(F.ws + WS_WOUT)};
            EpiResid E{F.H, Zp + 2048, ZW}; pg8::gemm_phase<EpiResid, false, ZW, D, 8, (long)((3584 - 1536) * 2), 0>(F.lds, F.tid, g, S, E); }
        else { pg8::Gemm g{Zp + 3072, (const bf16_t*)(F.ws + WS_WOUT)};
            EpiResid E{F.H, Zp + 2048, ZW}; pg8::gemm_phase<EpiResid, false, ZW, D, 1 << 20, 0, 0>(F.lds, F.tid, g, S, E); }
    }
    SEAM(p1 + 2);
    if (IN(p1 + 3)) {
        F.retid(); pg8::StaticOrder S; S.init(64, 4, F.G, bx);
        pg8::Gemm g{Zp + 2048, (const bf16_t*)(F.ws + WS_WGATE)};
        EpiGate E{F.H, Zp, ZW, even ? nullptr : (bf16_t*)(F.ws + WS_HB), F.ssq(LI + 1)};
        pg8::gemm_phase<EpiGate, false, ZW, D, 1 << 20, 0, 0>(F.lds, F.tid, g, S, E);
    }
    SEAM(p1 + 3);
}
__global__ void __launch_bounds__(512, 2) mk_fwd(Args args) {
    extern __shared__ __attribute__((aligned(16))) unsigned char lds_raw[];
    Frame F;
    F.lds = (LAS unsigned char*)lds_raw; F.ldsg = lds_raw;
    F.tid = threadIdx.x; F.lane = F.tid & 63; F.wave = __builtin_amdgcn_readfirstlane(F.tid >> 6);
    F.G = gridDim.x; const int bx = blockIdx.x; F.vcu = (F.G % 8 == 0) ? (bx % 8) * (F.G / 8) + bx / 8 : bx;
    F.H = args.out; F.ws = args.ws;
    volatile LAS unsigned* MISC = (volatile LAS unsigned*)(F.lds + MISC_OFF);
    for (int u = F.tid; u < (LDS_BYTES - RING_BYTES) / 4; u += 512) ((LAS unsigned*)(F.lds + RING_BYTES))[u] = 0u;
    __syncthreads();
    XcdBarrier bar; bar.bar = (unsigned*)(F.ws + WS_CTL) + 4096; bar.x = 0; bar.st = nullptr;
#if !MK_MULTI
    bar = xcd_barrier_post((unsigned*)(F.ws + WS_CTL) + 4096, MISC + 8);
#endif
    const int lo = args.ph_lo, hi = args.ph_hi;
    if (IN(PH_P0)) { F.retid(); rows_p0(F); conv_win_even(F, 0); }
#if !MK_MULTI
    if (IN(0) && IN(1)) { VM_WAIT(); cg::this_grid().sync(); }
#endif
    run_layer<0>(F, bar, lo, hi, bx);
    run_layer<1>(F, bar, lo, hi, bx);
    run_layer<2>(F, bar, lo, hi, bx);
    run_layer<3>(F, bar, lo, hi, bx);
    if (IN(PH_FINAL)) { F.retid(); rows_final(F); }
}

extern "C" void kernel_launch(void* const* d_in, const int* in_sizes, int n_in, void* d_out, int out_size, void* d_ws, size_t ws_size, hipStream_t stream) {
    static int grid = 0;
    if (grid == 0) {
        int dev = 0, cus = 0, per_cu = 0;
        (void)hipGetDevice(&dev); (void)hipDeviceGetAttribute(&cus, hipDeviceAttributeMultiprocessorCount, dev);
        (void)hipFuncSetAttribute((const void*)mk_fwd, hipFuncAttributeMaxDynamicSharedMemorySize, LDS_BYTES);
        (void)hipOccupancyMaxActiveBlocksPerMultiprocessor(&per_cu, (const void*)mk_fwd, 512, LDS_BYTES);
        if (per_cu < 1) per_cu = 1;
        grid = cus * 1;
        if (n_in != 26 || ws_size < WS_END) fprintf(stderr, "kernel_launch: unexpected n_in %d / ws %zu\n", n_in, ws_size);
        (void)hipGetLastError();
    }
    (void)hipMemsetAsync((char*)d_ws + WS_CTL, 0, CTL_BYTES, stream);
    Args a{};
    for (int i = 0; i < 26; ++i) a.in[i] = (const float*)d_in[i];
    a.out = (float*)d_out; a.ws = (unsigned char*)d_ws;
#if MK_MULTI
    for (int ph = 0; ph < N_PHASES; ++ph) { a.ph_lo = ph; a.ph_hi = ph + 1; hipLaunchKernelGGL(mk_fwd, dim3(grid), dim3(512), LDS_BYTES, stream, a); }
#else
    a.ph_lo = 0; a.ph_hi = N_PHASES;
    void* kargs[] = {&a};
    hipError_t e = hipLaunchCooperativeKernel((const void*)mk_fwd, dim3(grid), dim3(512), kargs, LDS_BYTES, stream);
    if (e != hipSuccess) fprintf(stderr, "cooperative launch failed: %s (grid %d)\n", hipGetErrorString(e), grid);
#endif
}
```

```cpp
#include <hip/hip_runtime.h>
#include <hip/hip_cooperative_groups.h>
#include <cstdint>
#include <cstdio>
namespace cg = cooperative_groups;

#ifndef MK_MULTI
#define MK_MULTI 0
#endif

#define LAS __attribute__((address_space(3)))
#define GAS __attribute__((address_space(1)))
typedef unsigned short bf16_t;
typedef short bf16x8 __attribute__((ext_vector_type(8)));
typedef float f32x4 __attribute__((ext_vector_type(4)));
typedef float f32x2 __attribute__((ext_vector_type(2)));
typedef unsigned u32x4 __attribute__((ext_vector_type(4)));
typedef unsigned u32x2 __attribute__((ext_vector_type(2)));

constexpr int D = 1024, BATCH = 2, SEQ = 8192, T = BATCH * SEQ, PLE = 256, ZW = 4096, ZE = 3072;
constexpr float QK_SCALE = 0.08838834764831845f;

__device__ __forceinline__ float bf2f(bf16_t v) { return __uint_as_float(((unsigned)v) << 16); }
__device__ __forceinline__ unsigned f2bf(float f) { unsigned u = __float_as_uint(f); return (u + 0x7fffu + ((u >> 16) & 1u)) >> 16; }
__device__ __forceinline__ unsigned pk2(float lo, float hi) { return f2bf(lo) | (f2bf(hi) << 16); }
typedef __bf16 bf16x2_t __attribute__((ext_vector_type(2)));
__device__ __forceinline__ unsigned cvt_pk_bf16(float lo, float hi) { f32x2 v = {lo, hi}; bf16x2_t b = __builtin_convertvector(v, bf16x2_t); return __builtin_bit_cast(unsigned, b); }
__device__ __forceinline__ float wave_sum(float v) {
#pragma unroll
    for (int o = 1; o < 64; o <<= 1) v += __shfl_xor(v, o);
    return v;
}
__device__ __forceinline__ float sigmoidf_(float x) { return 1.f / (1.f + __expf(-x)); }
__device__ __forceinline__ float siluf_(float x) { return x / (1.f + __expf(-x)); }
__device__ __forceinline__ float softplusf_(float x) { return x > 20.f ? x : log1pf(expf(x)); }
__device__ __forceinline__ float logsigf_(float x) { return -(x < -20.f ? -x : log1pf(expf(-x))); }
__device__ __forceinline__ float ssq_sum(const float* sq, int row) { const f32x4* p = (const f32x4*)(sq + (size_t)row * 16); const f32x4 a = p[0], b = p[1], c = p[2], d = p[3];
    return (((a[0] + a[1]) + (a[2] + a[3])) + ((b[0] + b[1]) + (b[2] + b[3]))) + (((c[0] + c[1]) + (c[2] + c[3])) + ((d[0] + d[1]) + (d[2] + d[3]))); }
#define LDS_WAIT() asm volatile("s_waitcnt lgkmcnt(0)" ::: "memory")
#define VM_WAIT() asm volatile("s_waitcnt vmcnt(0)" ::: "memory")

namespace pg8 {
constexpr int BM = 256, BK = 64, HALF = 128, HTB = HALF * BK * 2, STAGE_BYTES = 8 * HTB, NXCD = 8, WGM = 8;
__host__ __device__ __forceinline__ int lds_byte(int r, int c) { const int st = (r >> 4) * 2 + (c >> 5), rr = r & 15, cc = c & 31, ob = rr * 64 + cc * 2; return st * 1024 + (ob ^ (((ob >> 9) & 1) << 5)); }
__host__ __device__ __forceinline__ void stage_rc(int b, int& R, int& C) { const int st = b / 1024, sb = b % 1024, swz = sb ^ (((sb >> 9) & 1) << 5); R = (st >> 1) * 16 + swz / 64; C = (st & 1) * 32 + (swz % 64) / 2; }
__host__ __device__ __forceinline__ int perm32(int rho) { const int n = rho >> 4, i = rho & 15; return 8 * (i >> 2) + 4 * n + (i & 3); }
struct Unit { int pm, pn; };
struct Gemm { const bf16_t* A; const bf16_t* Bt; };
struct StaticOrder {
    int nM, nN, nwg, G, c;
    __device__ void init(int nM_, int nN_, int G_, int c_) { nM = nM_; nN = nN_; nwg = nM * nN; G = G_; c = c_; }
    __device__ bool next(int i, Unit& u) const {
        const long L = (long)i * G + c; if (L >= nwg) return false;
        int wgid = (int)L; { const int q = nwg / NXCD, r = nwg % NXCD, xcd = wgid % NXCD, off = wgid / NXCD; wgid = (xcd < r ? xcd * (q + 1) : r * (q + 1) + (xcd - r) * q) + off; }
        const int nig = WGM * nN, gid = wgid / nig, fm = gid * WGM, gsz = (nM - fm) < WGM ? (nM - fm) : WGM;
        u.pm = fm + ((wgid % nig) % gsz); u.pn = (wgid % nig) / gsz; return true;
    }
};
template <class Epi, bool ALIGN_EPI, int LDA, int KK, int TSPLIT, long ASHIFT, long BROW>
__device__ __forceinline__ void gemm_phase(LAS unsigned char* lds, const int tid_in, const Gemm g, const StaticOrder& S, const Epi& E) {
    int tid = tid_in; asm volatile("" : "+v"(tid));
    const int wid = __builtin_amdgcn_readfirstlane(tid >> 6), lane = tid & 63, wr = wid >> 2, wc = wid & 3, fr = lane & 15, fq = lane >> 4;
    constexpr int K = KK, nt = K / BK, lda = LDA, tsplit = TSPLIT; constexpr long ashift = ASHIFT;
    unsigned voffA[2], voffB[2];
#pragma unroll
    for (int i = 0; i < 2; ++i) { int R, C; stage_rc(tid * 16 + i * 8192, R, C); const int Rb = (R & ~31) + perm32(R & 31);
        voffA[i] = (unsigned)(R * lda + C) * 2u; voffB[i] = (unsigned)(Rb * K + C) * 2u; }
    constexpr size_t kstep = (size_t)(BK * 2);
    constexpr size_t hstepA = (size_t)HALF * lda * 2, hstepB = (size_t)HALF * K * 2, tstepA = 2 * hstepA, tstepB = 2 * hstepB;
    const unsigned ldsw = (unsigned)wid * 1024u;
    const int aoff = lds_byte(wr * 64 + fr, fq * 8), boff = lds_byte(wc * 32 + fr, fq * 8);
#define PG8_AP(base, tt) ((base) + (((tt) < tsplit) ? (long)(tt) * 128 : ashift + (long)((tt) - tsplit) * 128))
#define PG8_ABASE(u) ((const char*)g.A + (size_t)(u).pm * tstepA + ((BROW != 0 && (u).pm >= 32) ? BROW : 0))
#define PG8_SA(b, h) (((b) * 2 + (h)) * HTB)
#define PG8_SB(b, h) ((4 + (b) * 2 + (h)) * HTB)
#define PG8_STAGE(bufoff, gbase, voff) do { const char* _gb = (const char*)(gbase); asm volatile("" : "+s"(_gb)); _Pragma("unroll") for (int _i = 0; _i < 2; ++_i) \
        __builtin_amdgcn_global_load_lds((const unsigned*)(_gb + (voff)[_i]), (LAS unsigned*)(lds + (bufoff) + ldsw + _i * 8192), 16, 0, 0); } while (0)
#define PG8_LDA(dst, b, h) do { _Pragma("unroll") for (int m = 0; m < 4; ++m) _Pragma("unroll") for (int k = 0; k < 2; ++k) dst[m][k] = *(const LAS bf16x8*)(lds + PG8_SA(b, h) + aoff + m * 2048 + k * 1024); } while (0)
#define PG8_LDB(dst, b, h) do { _Pragma("unroll") for (int n = 0; n < 2; ++n) _Pragma("unroll") for (int k = 0; k < 2; ++k) dst[n][k] = *(const LAS bf16x8*)(lds + PG8_SB(b, h) + boff + n * 2048 + k * 1024); } while (0)
#define PG8_MMA(ai, bj, At, Bt) do { __builtin_amdgcn_s_setprio(1); _Pragma("unroll") for (int m = 0; m < 4; ++m) _Pragma("unroll") for (int n = 0; n < 2; ++n) _Pragma("unroll") for (int k = 0; k < 2; ++k) \
        acc[ai][bj][m][n] = __builtin_amdgcn_mfma_f32_16x16x32_bf16(Bt[n][k], At[m][k], acc[ai][bj][m][n], 0, 0, 0); __builtin_amdgcn_s_setprio(0); } while (0)
#define PG8_WAIT_V(n) asm volatile("s_waitcnt vmcnt(" #n ")" ::: "memory")
#define PG8_WAIT_L(n) asm volatile("s_waitcnt lgkmcnt(" #n ")" ::: "memory")
#define PG8_BAR __builtin_amdgcn_s_barrier()
#define PG8_SCHED __builtin_amdgcn_sched_barrier(0)
    Unit cur, nxt; int ui = 0;
    if (!S.next(0, cur)) return;
    f32x4 acc[2][2][4][2];
#pragma unroll
    for (int a = 0; a < 2; ++a)
#pragma unroll
        for (int b = 0; b < 2; ++b)
#pragma unroll
            for (int m = 0; m < 4; ++m)
#pragma unroll
                for (int n = 0; n < 2; ++n) acc[a][b][m][n] = (f32x4){0.f, 0.f, 0.f, 0.f};
    bf16x8 At[4][2], B0[2][2], B1[2][2];
    const char* cA = PG8_ABASE(cur); const char* cB = (const char*)g.Bt + (size_t)cur.pn * tstepB;
    {
        const char* a0 = PG8_AP(cA, 0); const char* a1 = PG8_AP(cA, 1);
        PG8_STAGE(PG8_SB(0, 0), cB, voffB); PG8_STAGE(PG8_SB(0, 1), cB + hstepB, voffB); PG8_STAGE(PG8_SA(0, 0), a0, voffA); PG8_STAGE(PG8_SA(0, 1), a0 + hstepA, voffA);
        if (wr == 1) PG8_BAR;
        PG8_WAIT_V(2); PG8_BAR;
        PG8_STAGE(PG8_SB(1, 0), cB + kstep, voffB); PG8_STAGE(PG8_SA(1, 0), a1, voffA); PG8_STAGE(PG8_SB(1, 1), cB + hstepB + kstep, voffB);
        PG8_WAIT_V(6); PG8_BAR;
    }
    for (;;) {
        const bool has_next = S.next(ui + 1, nxt);
        const char* nA = has_next ? PG8_ABASE(nxt) : cA; const char* nB = has_next ? (const char*)g.Bt + (size_t)nxt.pn * tstepB : cB;
        for (int t = 0; t < nt; t += 2) {
            const bool last = (t == nt - 2);
            const char* a1 = PG8_AP(cA, t + 1);
            const char* a2 = last ? PG8_AP(nA, 0) : PG8_AP(cA, t + 2); const char* b2 = last ? nB : cB + (size_t)(t + 2) * kstep;
            const char* a3 = last ? PG8_AP(nA, 1) : PG8_AP(cA, t + 3); const char* b3 = b2 + kstep;
            PG8_LDB(B0, 0, 0); PG8_LDB(B1, 0, 1); PG8_SCHED; PG8_LDA(At, 0, 0); PG8_STAGE(PG8_SA(1, 1), a1 + hstepA, voffA);
            PG8_WAIT_V(8); PG8_WAIT_L(0); PG8_BAR; PG8_MMA(0, 0, At, B0); PG8_MMA(0, 1, At, B1); PG8_BAR; PG8_SCHED;
            PG8_LDA(At, 0, 1); PG8_STAGE(PG8_SB(0, 0), b2, voffB); PG8_STAGE(PG8_SB(0, 1), b2 + hstepB, voffB); PG8_STAGE(PG8_SA(0, 0), a2, voffA);
            PG8_WAIT_V(8); PG8_WAIT_L(0); PG8_BAR; PG8_MMA(1, 0, At, B0); PG8_MMA(1, 1, At, B1); PG8_BAR; PG8_SCHED;
            PG8_LDB(B0, 1, 0); PG8_LDB(B1, 1, 1); PG8_SCHED; PG8_LDA(At, 1, 0); PG8_STAGE(PG8_SA(0, 1), a2 + hstepA, voffA);
            PG8_WAIT_V(8); PG8_WAIT_L(0); PG8_BAR; PG8_MMA(0, 0, At, B0); PG8_MMA(0, 1, At, B1); PG8_BAR; PG8_SCHED;
            PG8_LDA(At, 1, 1); PG8_STAGE(PG8_SB(1, 0), b3, voffB); PG8_STAGE(PG8_SB(1, 1), b3 + hstepB, voffB); PG8_STAGE(PG8_SA(1, 0), a3, voffA);
            PG8_WAIT_V(8); PG8_WAIT_L(0); PG8_BAR; PG8_MMA(1, 0, At, B0); PG8_MMA(1, 1, At, B1); PG8_BAR; PG8_SCHED;
        }
        if constexpr (ALIGN_EPI) { if (wr == 0) PG8_BAR; }
        E(acc, cur, wr, wc, fr, fq);
        if (!has_next) break;
#pragma unroll
        for (int a = 0; a < 2; ++a)
#pragma unroll
            for (int b = 0; b < 2; ++b)
#pragma unroll
                for (int m = 0; m < 4; ++m)
#pragma unroll
                    for (int n = 0; n < 2; ++n) acc[a][b][m][n] = (f32x4){0.f, 0.f, 0.f, 0.f};
        cur = nxt; cA = nA; cB = nB; ++ui;
        if constexpr (ALIGN_EPI) { if (wr == 1) PG8_BAR; }
    }
    PG8_WAIT_V(0);
    if constexpr (!ALIGN_EPI) { if (wr == 0) PG8_BAR; }
    PG8_BAR;
#undef PG8_AP
#undef PG8_ABASE
#undef PG8_SA
#undef PG8_SB
#undef PG8_STAGE
#undef PG8_LDA
#undef PG8_LDB
#undef PG8_MMA
#undef PG8_WAIT_V
#undef PG8_WAIT_L
#undef PG8_BAR
#undef PG8_SCHED
}
}

template <class Fn>
__device__ __forceinline__ void epi_for(const f32x4 (&acc)[2][2][4][2], const pg8::Unit& u, int wr, int wc, int fr, int fq, Fn fn) {
#pragma unroll
    for (int ai = 0; ai < 2; ++ai)
#pragma unroll
        for (int m = 0; m < 4; ++m) { const int row = u.pm * 256 + ai * 128 + wr * 64 + m * 16 + fr;
#pragma unroll
            for (int bj = 0; bj < 2; ++bj) { const int col = u.pn * 256 + bj * 128 + wc * 32 + 8 * fq; fn(row, col, acc[ai][bj][m][0], acc[ai][bj][m][1]); }
            asm volatile("" ::: "memory"); }
}
__device__ __forceinline__ u32x4 pack8(f32x4 v0, f32x4 v1) { u32x4 w; w.x = cvt_pk_bf16(v0[0], v0[1]); w.y = cvt_pk_bf16(v0[2], v0[3]); w.z = cvt_pk_bf16(v1[0], v1[1]); w.w = cvt_pk_bf16(v1[2], v1[3]); return w; }

struct EpiEvenIn {
    bf16_t* Z; const float* ssq; bf16_t* VTa; bf16_t* VTb; bf16_t* KT;
    __device__ __forceinline__ void operator()(const f32x4 (&acc)[2][2][4][2], const pg8::Unit& u, int wr, int wc, int fr, int fq) const {
        const int g = u.pn >> 1;
        epi_for(acc, u, wr, wc, fr, fq, [&](int row, int col, f32x4 v0, f32x4 v1) {
            const float rs = rsqrtf(ssq_sum(ssq, row) * (1.f / D) + 1e-6f);
            v0 = v0 * rs; v1 = v1 * rs;
            const int cg = col & 511, t = row & (SEQ - 1), b = row >> 13;
            if (g == 2 || g == 6) {
                bf16_t* p = (g == 2 ? VTa : VTb) + ((size_t)(b * 512 + cg)) * SEQ + t;
                _Pragma("unroll") for (int j = 0; j < 4; ++j) { p[(size_t)j * SEQ] = (bf16_t)f2bf(v0[j]); p[(size_t)(4 + j) * SEQ] = (bf16_t)f2bf(v1[j]); }
            } else if (g < 2) {
                const float pos = (float)t; const int i0 = (cg & 127) >> 1;
                float o[8] = {v0[0], v0[1], v0[2], v0[3], v1[0], v1[1], v1[2], v1[3]};
                _Pragma("unroll") for (int j = 0; j < 4; ++j) { const float inv = exp2f(-(float)(i0 + j) * (13.287712379549449f / 64.f));
                    float rev = pos * inv * 0.15915494309189535f; rev = rev - floorf(rev); const float sn = __builtin_amdgcn_sinf(rev), cs = __builtin_amdgcn_cosf(rev);
                    const float x1 = o[2 * j], x2 = o[2 * j + 1]; o[2 * j] = x1 * cs - x2 * sn; o[2 * j + 1] = x1 * sn + x2 * cs; }
                const float lg2 = log2f(1.f - exp2f(-5.f - (float)(cg >> 7))); const float ip1 = (float)((t & 127) + 1);
                if (g == 0) { const float f = exp2f(ip1 * lg2);
                    *(u32x4*)(Z + (size_t)row * ZE + cg) = pack8((f32x4){o[0] * f, o[1] * f, o[2] * f, o[3] * f}, (f32x4){o[4] * f, o[5] * f, o[6] * f, o[7] * f}); }
                else { const float f = exp2f(-ip1 * lg2), f2 = exp2f((128.f - ip1) * lg2);
                    *(u32x4*)(Z + (size_t)row * ZE + 512 + cg) = pack8((f32x4){o[0] * f, o[1] * f, o[2] * f, o[3] * f}, (f32x4){o[4] * f, o[5] * f, o[6] * f, o[7] * f});
                    bf16_t* p = KT + ((size_t)(b * 512 + cg)) * SEQ + t;
                    _Pragma("unroll") for (int j = 0; j < 8; ++j) p[(size_t)j * SEQ] = (bf16_t)f2bf(o[j] * f2); }
            } else {
                const int zc = (g - 1 - (g > 6 ? 1 : 0)) * 512;
                *(u32x4*)(Z + (size_t)row * ZE + zc + cg) = pack8(v0, v1);
            }
        });
    }
};
struct EpiOddIn {
    bf16_t* Z; bf16_t* L1;
    __device__ __forceinline__ void operator()(const f32x4 (&acc)[2][2][4][2], const pg8::Unit& u, int wr, int wc, int fr, int fq) const {
        if (u.pn < 16) { epi_for(acc, u, wr, wc, fr, fq, [&](int row, int col, f32x4 v0, f32x4 v1) { *(u32x4*)(Z + (size_t)row * ZW + col) = pack8(v0, v1); }); }
        else { epi_for(acc, u, wr, wc, fr, fq, [&](int row, int col, f32x4 v0, f32x4 v1) { const int c = col - 4096; if (c < 64) {
                    _Pragma("unroll") for (int j = 0; j < 4; ++j) { v0[j] = tanhf(v0[j]); v1[j] = tanhf(v1[j]); } }
                *(u32x4*)(L1 + (size_t)row * 256 + c) = pack8(v0, v1); }); }
    }
};
struct EpiResid {
    float* H; bf16_t* HB; int ldb;
    __device__ __forceinline__ void operator()(const f32x4 (&acc)[2][2][4][2], const pg8::Unit& u, int wr, int wc, int fr, int fq) const {
        epi_for(acc, u, wr, wc, fr, fq, [&](int row, int col, f32x4 v0, f32x4 v1) { float* hp = H + (size_t)row * D + col; f32x4 h0 = *(const f32x4*)hp, h1 = *(const f32x4*)(hp + 4); h0 = h0 + v0; h1 = h1 + v1;
            *(f32x4*)hp = h0; *(f32x4*)(hp + 4) = h1; *(u32x4*)(HB + (size_t)row * ldb + col) = pack8(h0, h1); });
    }
};
struct EpiStore {
    bf16_t* O; int ldc;
    __device__ __forceinline__ void operator()(const f32x4 (&acc)[2][2][4][2], const pg8::Unit& u, int wr, int wc, int fr, int fq) const {
        epi_for(acc, u, wr, wc, fr, fq, [&](int row, int col, f32x4 v0, f32x4 v1) { *(u32x4*)(O + (size_t)row * ldc + col) = pack8(v0, v1); });
    }
};
struct EpiGate {
    float* H; const bf16_t* PP; int ldp; bf16_t* HB2; float* ssq;
    __device__ __forceinline__ void operator()(const f32x4 (&acc)[2][2][4][2], const pg8::Unit& u, int wr, int wc, int fr, int fq) const {
#pragma unroll
        for (int ai = 0; ai < 2; ++ai)
#pragma unroll
            for (int m = 0; m < 4; ++m) { const int row = u.pm * 256 + ai * 128 + wr * 64 + m * 16 + fr; float sq = 0.f;
#pragma unroll
                for (int bj = 0; bj < 2; ++bj) { const int col = u.pn * 256 + bj * 128 + wc * 32 + 8 * fq; const f32x4 v0 = acc[ai][bj][m][0], v1 = acc[ai][bj][m][1];
                    float* hp = H + (size_t)row * D + col; f32x4 h0 = *(const f32x4*)hp, h1 = *(const f32x4*)(hp + 4); const u32x4 pw = *(const u32x4*)(PP + (size_t)row * ldp + col);
                    const unsigned pwv[4] = {pw.x, pw.y, pw.z, pw.w};
                    float pp[8];
#pragma unroll
                    for (int j = 0; j < 4; ++j) { pp[2 * j] = __uint_as_float(pwv[j] << 16); pp[2 * j + 1] = __uint_as_float(pwv[j] & 0xffff0000u); }
#pragma unroll
                    for (int j = 0; j < 4; ++j) { h0[j] += sigmoidf_(v0[j]) * pp[j]; h1[j] += sigmoidf_(v1[j]) * pp[4 + j]; sq += h0[j] * h0[j] + h1[j] * h1[j]; }
                    *(f32x4*)hp = h0; *(f32x4*)(hp + 4) = h1; if (HB2) *(u32x4*)(HB2 + (size_t)row * D + col) = pack8(h0, h1); }
                sq += __shfl_xor(sq, 16); sq += __shfl_xor(sq, 32);
                if (fq == 0) ssq[(size_t)row * 16 + u.pn * 4 + wc] = sq;
                asm volatile("" ::: "memory"); }
    }
};

#define XB_TMO      128
#define XB_XCNT(j)  (256  + 64 * (j))
#define XB_XSUB(j)  (1280 + 64 * (j))
#define XB_XGEN(j)  (2304 + 64 * (j))
#define XB_TOP      3328
#define XB_TOPGEN   3392
#define XCD_BAR_WORDS 3456
#define XB_SPIN_CAP (1u << 22)
__device__ __forceinline__ unsigned xb_ld(unsigned* p)              { return __hip_atomic_load(p, __ATOMIC_RELAXED, __HIP_MEMORY_SCOPE_AGENT); }
__device__ __forceinline__ unsigned xb_add(unsigned* p, unsigned v) { return __hip_atomic_fetch_add(p, v, __ATOMIC_RELAXED, __HIP_MEMORY_SCOPE_AGENT); }
__device__ __forceinline__ unsigned xb_xcc_id() { return (unsigned)__builtin_amdgcn_s_getreg((3 << 11) | 20) & 0xFu; }
#define XB_SPIN(cond, bar) do { unsigned _sp = 0; while (cond) { __builtin_amdgcn_s_sleep(1); \
    if ((++_sp & 255u) == 0u) { if (xb_ld(&(bar)[XB_TMO])) break; if (_sp > XB_SPIN_CAP) { atomicAdd(&(bar)[XB_TMO], 1u); break; } } } } while (0)
struct XcdBarrier { unsigned* bar; unsigned x; volatile LAS unsigned* st; };
__device__ __forceinline__ XcdBarrier xcd_barrier_post(unsigned* bar, volatile LAS unsigned* st) {
    XcdBarrier b; b.bar = bar; b.x = xb_xcc_id(); b.st = st;
    if (threadIdx.x == 0) (void)xb_add(&bar[XB_XCNT(b.x)], 1u);
    return b;
}
__device__ __forceinline__ void xcd_barrier_complete(unsigned* bar, unsigned x, unsigned& nloc, unsigned& nx) {
    const unsigned G = gridDim.x * gridDim.y * gridDim.z;
    unsigned sum, cnt, mine, sp = 0u;
    for (;;) {
        sum = 0u; cnt = 0u; mine = 0u;
#pragma unroll
        for (unsigned j = 0; j < 16; ++j) { const unsigned c = xb_ld(&bar[XB_XCNT(j)]); sum += c; cnt += (c > 0u) ? 1u : 0u; mine = (j == x) ? c : mine; }
        if (sum == G) break;
        __builtin_amdgcn_s_sleep(1);
        if ((++sp & 255u) == 0u) { if (xb_ld(&bar[XB_TMO])) break; if (sp > XB_SPIN_CAP) { atomicAdd(&bar[XB_TMO], 1u); break; } }
    }
    nloc = mine > 0u ? mine : 1u; nx = cnt > 0u ? cnt : 1u;
}
__device__ __forceinline__ void xcd_barrier(const XcdBarrier& b_in) {
    asm volatile("s_waitcnt vmcnt(0)" ::: "memory");
    __syncthreads();
    if (threadIdx.x == 0) {
        const XcdBarrier& b = b_in;
        unsigned* bar = b.bar;
        __builtin_amdgcn_s_waitcnt(0);
        unsigned nloc = b.st[0], nx = b.st[1];
        if (nloc == 0u) { xcd_barrier_complete(bar, b.x, nloc, nx); b.st[0] = nloc; b.st[1] = nx; }
        const unsigned old = xb_add(&bar[XB_XSUB(b.x)], 1u);
        const unsigned gen = old / nloc;
        if (old + 1u == (gen + 1u) * nloc) {
            __builtin_amdgcn_fence(__ATOMIC_RELEASE, "agent");
            asm volatile("s_waitcnt vmcnt(0)" ::: "memory");
            const unsigned og = xb_add(&bar[XB_TOP], 1u);
            const unsigned tg = og / nx;
            if (og + 1u == (tg + 1u) * nx) xb_add(&bar[XB_TOPGEN], 1u);
            else XB_SPIN(xb_ld(&bar[XB_TOPGEN]) == tg, bar);
            __builtin_amdgcn_fence(__ATOMIC_ACQUIRE, "agent");
            xb_add(&bar[XB_XGEN(b.x)], 1u);
            asm volatile("s_waitcnt vmcnt(0)" ::: "memory");
        } else {
            XB_SPIN(xb_ld(&bar[XB_XGEN(b.x)]) == gen, bar);
            __builtin_amdgcn_fence(__ATOMIC_ACQUIRE, "agent");
            asm volatile("s_waitcnt vmcnt(0)" ::: "memory");
        }
    }
    __syncthreads();
}

constexpr size_t MiB = 1u << 20;
constexpr size_t WS_CTL = 0, CTL_BYTES = 1 * MiB;
constexpr size_t WS_SSQ = 241 * (size_t)(1u << 20);
constexpr size_t WS_WIN = 2 * MiB;
constexpr size_t WS_WOUT = 19 * MiB, WS_WGATE = 21 * MiB, WS_WPROJ = 23 * MiB;
constexpr size_t WS_PB = 24 * MiB;
constexpr size_t WS_Z = 32 * MiB;
constexpr size_t WS_HB = 160 * MiB;
constexpr size_t WS_VF = 193 * MiB;
constexpr size_t WS_L1 = 225 * MiB;
constexpr size_t WS_VTA = 128 * MiB;
constexpr size_t WS_VTB = 144 * MiB;
constexpr size_t WS_KT = 225 * MiB;
constexpr size_t WS_ST = 176 * MiB;
constexpr size_t WS_KV = 160 * MiB;
constexpr size_t WS_END = 256 * MiB;

constexpr int RING_BYTES = 131072, MISC_OFF = RING_BYTES + 320, LDS_BYTES = 147456;

struct Args { const float* in[26]; float* out; unsigned char* ws; int ph_lo, ph_hi; };

__device__ __forceinline__ const float* inptr(int i) { asm volatile("" : "+s"(i)); const char* ka = (const char*)__builtin_amdgcn_kernarg_segment_ptr(); return *(const float* const*)(ka + 8 * i); }
struct InTab { __device__ __forceinline__ const float* operator[](int i) const { return inptr(i); } };
struct Frame {
    LAS unsigned char* lds; unsigned char* ldsg;
    int tid, lane, wave, G, vcu;
    InTab in; float* H; unsigned char* ws;
    __device__ __forceinline__ void retid() { int l; asm volatile("v_mbcnt_lo_u32_b32 %0, -1, 0\n\tv_mbcnt_hi_u32_b32 %0, -1, %0" : "=v"(l)); lane = l; tid = wave * 64 + l; }
    __device__ __forceinline__ float* ssq(int l) const { return (float*)(ws + WS_SSQ) + (size_t)l * T * 16; }
};

__device__ __forceinline__ void conv_item(const float* W, int ldw, int Kmax, int k0, int n0, bf16_t* dst, int ldd, int dr0, int drs, int dk0,
                                          const float* svec, float sa, float sb, float sc, LAS float* scr, int lane) {
#pragma unroll 8
    for (int i = 0; i < 32; ++i) { const int kk = 2 * i + (lane >> 5), k = k0 + kk; float v = 0.f;
        if (k < Kmax) { const float f = (sa + sb * (svec ? svec[k] : 0.f)) * sc; v = W[(size_t)k * ldw + n0 + (lane & 31)] * f; }
        scr[kk * 33 + (lane & 31)] = v; }
    LDS_WAIT(); asm volatile("" ::: "memory");
    const int c = lane & 7;
    if (k0 + 8 * c < Kmax) {
#pragma unroll
        for (int j = 0; j < 4; ++j) { const int n = (lane >> 3) + 8 * j; const LAS float* s = scr + (8 * c) * 33 + n;
            u32x4 o; o.x = pk2(s[0 * 33], s[1 * 33]); o.y = pk2(s[2 * 33], s[3 * 33]); o.z = pk2(s[4 * 33], s[5 * 33]); o.w = pk2(s[6 * 33], s[7 * 33]);
            *(GAS u32x4*)(dst + (size_t)(dr0 + n * drs) * ldd + dk0 + k0 + 8 * c) = o; }
    }
    LDS_WAIT(); asm volatile("" ::: "memory");
}
__device__ __forceinline__ void conv_win_even(Frame& F, int li) {
    const int e = li >> 1; const float* W = F.in[6] + (size_t)e * D * ZW; const float* gain = F.in[2] + li * D; bf16_t* dst = (bf16_t*)(F.ws + WS_WIN);
    LAS float* scr = (LAS float*)(F.lds + F.wave * 16384);
    const int gw = F.vcu * 8 + F.wave, NGW = F.G * 8;
    for (int it = gw; it < 16 * 128; it += NGW) { const int kb = it >> 7, nb = it & 127, n0 = nb * 32, g = n0 >> 9, hh = (n0 & 511) >> 7, d0 = n0 & 127;
        int dr0 = n0, drs = 1; if (g < 2) { dr0 = g * 512 + hh * 128 + (d0 < 64 ? 2 * d0 : 2 * (d0 - 64) + 1); drs = 2; }
        const float sc = (g == 1 || g == 5) ? QK_SCALE : 1.f;
        conv_item(W, ZW, D, kb * 64, n0, dst, D, dr0, drs, 0, gain, 0.f, 1.f, sc, scr, F.lane); }
}
__device__ __forceinline__ void conv_win_odd(Frame& F, int li) {
    const int o = li >> 1; const float* mu = F.in[9] + (size_t)o * 6 * D; bf16_t* dst = (bf16_t*)(F.ws + WS_WIN);
    LAS float* scr = (LAS float*)(F.lds + F.wave * 16384);
    const int gw = F.vcu * 8 + F.wave, NGW = F.G * 8;
    for (int it = gw; it < 4 * 2 * 512; it += NGW) { const int p = it >> 10, half = (it >> 9) & 1, r = it & 511, kb = r >> 5, nb = r & 31;
        const float* W = F.in[10] + ((size_t)o * 4 + p) * D * D;
        conv_item(W, D, D, kb * 64, nb * 32, dst, 2048, p * 1024 + nb * 32, 1, half * 1024, mu + p * D, half ? 0.f : 1.f, half ? 1.f : -1.f, 1.f, scr, F.lane); }
    for (int it = gw; it < 2 * (32 + 32 + 16); it += NGW) { const int half = it / 80, r = it % 80; const float* W; int ldw, n0, dr0, mi, kb;
        if (r < 32) { W = F.in[13] + (size_t)o * D * 64; ldw = 64; kb = r >> 1; n0 = (r & 1) * 32; dr0 = 4096 + n0; mi = 4; }
        else if (r < 64) { const int q = r - 32; W = F.in[16] + (size_t)o * D * 64; ldw = 64; kb = q >> 1; n0 = (q & 1) * 32; dr0 = 4160 + n0; mi = 5; }
        else { const int q = r - 64; W = F.in[19]; ldw = 32; kb = q; n0 = 0; dr0 = 4224; mi = 2; }
        const float sc = (r >= 64 && o == 0) ? 0.f : 1.f;
        conv_item(W, ldw, D, kb * 64, n0, dst, 2048, dr0, 1, half * 1024, mu + mi * D, half ? 0.f : 1.f, half ? 1.f : -1.f, sc, scr, F.lane); }
    { u32x4 z = {0u, 0u, 0u, 0u}; GAS u32x4* zp = (GAS u32x4*)(dst + (size_t)4256 * 2048); const int n16 = 96 * 2048 * 2 / 16;
      for (int i = (F.vcu * 512 + F.tid); i < n16; i += F.G * 512) zp[i] = z; }
}
__device__ __forceinline__ void conv_wrest(Frame& F, int li) {
    const bool even = (li & 1) == 0; const int e = li >> 1;
    const float* Wo = even ? F.in[7] + (size_t)e * D * D : F.in[11] + (size_t)e * D * D;
    const float* Wg = F.in[5] + (size_t)li * D * D; const float* Wp = F.in[4] + (size_t)li * PLE * D;
    LAS float* scr = (LAS float*)(F.lds + F.wave * 16384);
    const int gw = F.vcu * 8 + F.wave, NGW = F.G * 8;
    for (int it = gw; it < 512 + 512 + 128; it += NGW) {
        if (it < 512) conv_item(Wo, D, D, (it >> 5) * 64, (it & 31) * 32, (bf16_t*)(F.ws + WS_WOUT), D, (it & 31) * 32, 1, 0, nullptr, 1.f, 0.f, 1.f, scr, F.lane);
        else if (it < 1024) { const int r = it - 512; conv_item(Wg, D, D, (r >> 5) * 64, (r & 31) * 32, (bf16_t*)(F.ws + WS_WGATE), D, (r & 31) * 32, 1, 0, nullptr, 1.f, 0.f, 1.f, scr, F.lane); }
        else { const int r = it - 1024; conv_item(Wp, D, PLE, (r >> 5) * 64, (r & 31) * 32, (bf16_t*)(F.ws + WS_WPROJ), PLE, (r & 31) * 32, 1, 0, nullptr, 1.f, 0.f, 1.f, scr, F.lane); }
    }
    const float* P = F.in[1] + (size_t)li * T * PLE; GAS u32x4* pb = (GAS u32x4*)(F.ws + WS_PB); const int n8 = T * PLE / 8;
    for (int i = F.vcu * 512 + F.tid; i < n8; i += F.G * 512) { const f32x4 a = *(const f32x4*)(P + (size_t)i * 8), b = *(const f32x4*)(P + (size_t)i * 8 + 4);
        u32x4 o; o.x = pk2(a[0], a[1]); o.y = pk2(a[2], a[3]); o.z = pk2(b[0], b[1]); o.w = pk2(b[2], b[3]); pb[i] = o; }
}

__device__ __forceinline__ void rows_p0(Frame& F) {
    const float* x = F.in[0]; bf16_t* HB = (bf16_t*)(F.ws + WS_HB); float* s0 = F.ssq(0);
    for (int row = F.vcu * 8 + F.wave; row < T; row += F.G * 8) {
        const f32x4* xr = (const f32x4*)(x + (size_t)row * D) + F.lane; f32x4* hr = (f32x4*)(F.H + (size_t)row * D) + F.lane; u32x2* br = (u32x2*)(HB + (size_t)row * D) + F.lane; float s = 0.f;
#pragma unroll
        for (int j = 0; j < 4; ++j) { const f32x4 v = xr[64 * j]; s += (v[0] * v[0] + v[1] * v[1]) + (v[2] * v[2] + v[3] * v[3]); hr[64 * j] = v; u32x2 w; w.x = pk2(v[0], v[1]); w.y = pk2(v[2], v[3]); br[64 * j] = w; }
        s = wave_sum(s); if (F.lane < 16) s0[(size_t)row * 16 + F.lane] = F.lane == 0 ? s : 0.f;
    }
}
__device__ __forceinline__ void rows_norm(Frame& F, int li) {
    const float* gain = F.in[2] + li * D; bf16_t* HN = (bf16_t*)(F.ws + WS_HB); const float* sq = F.ssq(li);
    f32x4 g[4];
#pragma unroll
    for (int j = 0; j < 4; ++j) g[j] = *((const f32x4*)gain + F.lane + 64 * j);
    for (int row = F.vcu * 8 + F.wave; row < T; row += F.G * 8) {
        const f32x4* hr = (const f32x4*)(F.H + (size_t)row * D) + F.lane; u32x2* br = (u32x2*)(HN + (size_t)(row + 1 + (row >= SEQ ? 1 : 0)) * D) + F.lane;
        const float rs = rsqrtf(ssq_sum(sq, row) * (1.f / D) + 1e-6f);
#pragma unroll
        for (int j = 0; j < 4; ++j) { const f32x4 v = hr[64 * j] * rs * g[j]; u32x2 w; w.x = pk2(v[0], v[1]); w.y = pk2(v[2], v[3]); br[64 * j] = w; }
    }
    if (F.vcu == 0 && F.wave < 2) { u32x2* br = (u32x2*)(HN + (size_t)(F.wave ? SEQ + 1 : 0) * D) + F.lane; u32x2 z = {0u, 0u};
#pragma unroll
        for (int j = 0; j < 4; ++j) br[64 * j] = z; }
}
__device__ __forceinline__ void rows_final(Frame& F) {
    const float* gain = F.in[3]; const float* sq = F.ssq(4);
    f32x4 g[4];
#pragma unroll
    for (int j = 0; j < 4; ++j) g[j] = *((const f32x4*)gain + F.lane + 64 * j);
    for (int row = F.vcu * 8 + F.wave; row < T; row += F.G * 8) {
        f32x4* hr = (f32x4*)(F.H + (size_t)row * D) + F.lane; const float rs = rsqrtf(ssq_sum(sq, row) * (1.f / D) + 1e-6f);
#pragma unroll
        for (int j = 0; j < 4; ++j) hr[64 * j] = hr[64 * j] * rs * g[j];
    }
}

typedef float f32x16 __attribute__((ext_vector_type(16)));
__device__ __forceinline__ void sb_unit(Frame& F, int bh, int qb) {
    const int lane = F.lane, l31 = lane & 31, hi = lane >> 5, b = bh >> 2, h = bh & 3;
    bf16_t* Z = (bf16_t*)(F.ws + WS_Z); const bf16_t* VT = (const bf16_t*)(F.ws + WS_VTB) + (size_t)bh * 128 * SEQ;
    const size_t rowb = (size_t)b * SEQ; const int q0 = qb * 32, tq = q0 + l31;
    bf16x8 qr[8];
    { const bf16_t* qp = Z + (rowb + tq) * ZE + 1536 + h * 128 + hi * 8;
#pragma unroll
      for (int ks = 0; ks < 8; ++ks) qr[ks] = *(const bf16x8*)(qp + 16 * ks); }
    f32x16 o[4];
#pragma unroll
    for (int d = 0; d < 4; ++d)
#pragma unroll
        for (int r = 0; r < 16; ++r) o[d][r] = 0.f;
    float carry = 1.f;
    const int pi = 16 * ((l31 >> 2) & 1) + (l31 & 3) + 4 * (l31 >> 3);
    const bf16_t* Kb = Z + rowb * ZE + 2048 + h * 128 + hi * 8;
    for (int kt = (q0 + 31) >> 6; kt >= 0; --kt) {
        const int kbase = kt * 64;
        const bf16_t* kp0 = Kb + (size_t)(kbase + pi) * ZE; const bf16_t* kp1 = kp0 + (size_t)32 * ZE;
        f32x16 p0, p1;
#pragma unroll
        for (int r = 0; r < 16; ++r) { p0[r] = 0.f; p1[r] = 0.f; }
#pragma unroll
        for (int ks = 0; ks < 8; ++ks) { const bf16x8 a0 = *(const bf16x8*)(kp0 + 16 * ks), a1 = *(const bf16x8*)(kp1 + 16 * ks);
            p0 = __builtin_amdgcn_mfma_f32_32x32x16_bf16(a0, qr[ks], p0, 0, 0, 0); p1 = __builtin_amdgcn_mfma_f32_32x32x16_bf16(a1, qr[ks], p1, 0, 0, 0); }
        float f1 = 1.f, f0 = 1.f;
        const int k1 = kbase + 32 + 16 * hi, k0 = kbase + 16 * hi;
#pragma unroll
        for (int r = 15; r >= 0; --r) { const float z = fminf(p1[r], 80.f); const float e = exp2f(z * 1.4426950408889634f); float rd = __builtin_amdgcn_rcpf(1.f + e); float be = e * rd;
            const bool valid = (k1 + r) < tq; be = valid ? be : 0.f; rd = valid ? rd : 1.f; p1[r] = be * f1; f1 *= rd; }
#pragma unroll
        for (int r = 15; r >= 0; --r) { const float z = fminf(p0[r], 80.f); const float e = exp2f(z * 1.4426950408889634f); float rd = __builtin_amdgcn_rcpf(1.f + e); float be = e * rd;
            const bool valid = (k0 + r) < tq; be = valid ? be : 0.f; rd = valid ? rd : 1.f; p0[r] = be * f0; f0 *= rd; }
        const float pf0 = __shfl_xor(f0, 32), pf1 = __shfl_xor(f1, 32);
        const float tail1 = hi ? 1.f : pf1;
        const float tail0 = hi ? (pf1 * f1) : (pf0 * f1 * pf1);
        const float s1 = tail1 * carry, s0 = tail0 * carry;
        carry *= (f0 * f1) * (pf0 * pf1);
        u32x4 pa[2][2];
#pragma unroll
        for (int s = 0; s < 2; ++s) {
            pa[0][s].x = cvt_pk_bf16(p0[8 * s + 0] * s0, p0[8 * s + 1] * s0); pa[0][s].y = cvt_pk_bf16(p0[8 * s + 2] * s0, p0[8 * s + 3] * s0);
            pa[0][s].z = cvt_pk_bf16(p0[8 * s + 4] * s0, p0[8 * s + 5] * s0); pa[0][s].w = cvt_pk_bf16(p0[8 * s + 6] * s0, p0[8 * s + 7] * s0);
            pa[1][s].x = cvt_pk_bf16(p1[8 * s + 0] * s1, p1[8 * s + 1] * s1); pa[1][s].y = cvt_pk_bf16(p1[8 * s + 2] * s1, p1[8 * s + 3] * s1);
            pa[1][s].z = cvt_pk_bf16(p1[8 * s + 4] * s1, p1[8 * s + 5] * s1); pa[1][s].w = cvt_pk_bf16(p1[8 * s + 6] * s1, p1[8 * s + 7] * s1);
        }
        const bf16_t* vp = VT + (size_t)l31 * SEQ + kbase + 16 * hi;
#pragma unroll
        for (int d = 0; d < 4; ++d)
#pragma unroll
            for (int blk = 0; blk < 2; ++blk)
#pragma unroll
                for (int s = 0; s < 2; ++s) { const bf16x8 vb = *(const bf16x8*)(vp + (size_t)(32 * d) * SEQ + 32 * blk + 8 * s);
                    o[d] = __builtin_amdgcn_mfma_f32_32x32x16_bf16(__builtin_bit_cast(bf16x8, pa[blk][s]), vb, o[d], 0, 0, 0); }
        if (__all(carry < 7.9e-31f)) break;
    }
#pragma unroll
    for (int r = 0; r < 16; ++r) { const int qrow = q0 + (r & 3) + 8 * (r >> 2) + 4 * hi; bf16_t* gp = Z + (rowb + qrow) * ZE + 2560 + h * 128 + l31;
#pragma unroll
        for (int d = 0; d < 4; ++d) { const float g = bf2f(gp[32 * d]); gp[32 * d] = (bf16_t)f2bf(o[d][r] * siluf_(g)); } }
}
__device__ __forceinline__ void ret_stage_a(Frame& F, int u) {
    const int l31 = F.lane & 31, hi = F.lane >> 5, cu = u >> 3, w8 = u & 7, bh = cu & 7, n = cu >> 3, dvb = w8 >> 1, dkp = w8 & 1;
    const bf16_t* vt = (const bf16_t*)(F.ws + WS_VTA) + ((size_t)(bh * 128 + 32 * dvb + l31)) * SEQ + n * 128 + 8 * hi;
    const bf16_t* kt = (const bf16_t*)(F.ws + WS_KT) + ((size_t)(bh * 128 + 64 * dkp + l31)) * SEQ + n * 128 + 8 * hi;
    f32x16 a0, a1;
#pragma unroll
    for (int r = 0; r < 16; ++r) { a0[r] = 0.f; a1[r] = 0.f; }
#pragma unroll
    for (int ks = 0; ks < 8; ++ks) { const bf16x8 va = *(const bf16x8*)(vt + 16 * ks), k0 = *(const bf16x8*)(kt + 16 * ks), k1 = *(const bf16x8*)(kt + (size_t)32 * SEQ + 16 * ks);
        a0 = __builtin_amdgcn_mfma_f32_32x32x16_bf16(va, k0, a0, 0, 0, 0); a1 = __builtin_amdgcn_mfma_f32_32x32x16_bf16(va, k1, a1, 0, 0, 0); }
    bf16_t* kv = (bf16_t*)(F.ws + WS_KV) + ((size_t)cu * 128 + 32 * dvb) * 128 + 64 * dkp + l31;
#pragma unroll
    for (int r = 0; r < 16; ++r) { const int dv = (r & 3) + 8 * (r >> 2) + 4 * hi; kv[dv * 128] = (bf16_t)f2bf(a0[r]); kv[dv * 128 + 32] = (bf16_t)f2bf(a1[r]); }
}
__device__ __forceinline__ void ret_stage_b(Frame& F) {
    const int e = F.vcu * 512 + F.tid; if (e >= 8 * 128 * 128) return;
    const int h = (e >> 14) & 3; const float g128 = exp2f(128.f * log2f(1.f - exp2f(-5.f - (float)h)));
    const bf16_t* p = (const bf16_t*)(F.ws + WS_KV) + e; bf16_t* q = (bf16_t*)(F.ws + WS_ST) + e; float S = 0.f;
#pragma unroll 4
    for (int n = 0; n < 64; ++n) { const float kv = bf2f(p[(size_t)n * 131072]); q[(size_t)n * 131072] = (bf16_t)f2bf(S); S = S * g128 + kv; }
}
__device__ __forceinline__ void ret_stage_c(Frame& F, int u, const float* gng) {
    const int lane = F.lane, l31 = lane & 31, hi = lane >> 5, cu = u >> 2, qblk = u & 3, bh = cu & 7, n = cu >> 3, b = bh >> 2, h = bh & 3;
    bf16_t* Z = (bf16_t*)(F.ws + WS_Z); const size_t rowb = (size_t)b * SEQ; const int t0 = n * 128, tq = t0 + 32 * qblk + l31;
    bf16x8 qr[8];
    { const bf16_t* qp = Z + (rowb + tq) * ZE + h * 128 + hi * 8;
#pragma unroll
      for (int ks = 0; ks < 8; ++ks) qr[ks] = *(const bf16x8*)(qp + 16 * ks); }
    f32x16 o[4];
#pragma unroll
    for (int d = 0; d < 4; ++d)
#pragma unroll
        for (int r = 0; r < 16; ++r) o[d][r] = 0.f;
    { const bf16_t* sp = (const bf16_t*)(F.ws + WS_ST) + ((size_t)cu * 128 + l31) * 128 + 8 * hi;
#pragma unroll
      for (int ks = 0; ks < 8; ++ks)
#pragma unroll
          for (int d = 0; d < 4; ++d) { const bf16x8 sb = *(const bf16x8*)(sp + (size_t)(32 * d) * 128 + 16 * ks); o[d] = __builtin_amdgcn_mfma_f32_32x32x16_bf16(qr[ks], sb, o[d], 0, 0, 0); } }
    const int pi = 16 * ((l31 >> 2) & 1) + (l31 & 3) + 4 * (l31 >> 3);
    const bf16_t* Kb = Z + rowb * ZE + 512 + h * 128 + hi * 8;
    const bf16_t* VT = (const bf16_t*)(F.ws + WS_VTA) + ((size_t)(bh * 128 + l31)) * SEQ + 16 * hi;
    for (int kb = 0; kb <= qblk; ++kb) {
        const int kbase = t0 + 32 * kb; const bf16_t* kp = Kb + (size_t)(kbase + pi) * ZE;
        f32x16 p;
#pragma unroll
        for (int r = 0; r < 16; ++r) p[r] = 0.f;
#pragma unroll
        for (int ks = 0; ks < 8; ++ks) { const bf16x8 a = *(const bf16x8*)(kp + 16 * ks); p = __builtin_amdgcn_mfma_f32_32x32x16_bf16(a, qr[ks], p, 0, 0, 0); }
        if (kb == qblk) {
#pragma unroll
            for (int r = 0; r < 16; ++r) p[r] = (kbase + 16 * hi + r <= tq) ? p[r] : 0.f; }
        u32x4 pa[2];
#pragma unroll
        for (int s = 0; s < 2; ++s) { pa[s].x = cvt_pk_bf16(p[8 * s], p[8 * s + 1]); pa[s].y = cvt_pk_bf16(p[8 * s + 2], p[8 * s + 3]); pa[s].z = cvt_pk_bf16(p[8 * s + 4], p[8 * s + 5]); pa[s].w = cvt_pk_bf16(p[8 * s + 6], p[8 * s + 7]); }
#pragma unroll
        for (int d = 0; d < 4; ++d)
#pragma unroll
            for (int s = 0; s < 2; ++s) { const bf16x8 vb = *(const bf16x8*)(VT + (size_t)(32 * d) * SEQ + kbase + 8 * s);
                o[d] = __builtin_amdgcn_mfma_f32_32x32x16_bf16(__builtin_bit_cast(bf16x8, pa[s]), vb, o[d], 0, 0, 0); }
    }
    float gg[4];
#pragma unroll
    for (int d = 0; d < 4; ++d) gg[d] = gng[h * 128 + 32 * d + l31];
#pragma unroll
    for (int r = 0; r < 16; ++r) {
        float sm = (o[0][r] + o[1][r]) + (o[2][r] + o[3][r]);
        sm += __shfl_xor(sm, 1); sm += __shfl_xor(sm, 2); sm += __shfl_xor(sm, 4); sm += __shfl_xor(sm, 8); sm += __shfl_xor(sm, 16);
        const float mu = sm * (1.f / 128.f); float q = 0.f;
#pragma unroll
        for (int d = 0; d < 4; ++d) { const float dd = o[d][r] - mu; q += dd * dd; }
        q += __shfl_xor(q, 1); q += __shfl_xor(q, 2); q += __shfl_xor(q, 4); q += __shfl_xor(q, 8); q += __shfl_xor(q, 16);
        const float rsd = rsqrtf(q * (1.f / 128.f) + 1e-5f);
        const int qrow = t0 + 32 * qblk + (r & 3) + 8 * (r >> 2) + 4 * hi; bf16_t* gp = Z + (rowb + qrow) * ZE + 1024 + h * 128 + l31;
#pragma unroll
        for (int d = 0; d < 4; ++d) { const float ga = bf2f(gp[32 * d]); gp[32 * d] = (bf16_t)f2bf((o[d][r] - mu) * rsd * gg[d] * siluf_(ga)); }
    }
}
__device__ __forceinline__ void phase_scan_naive(Frame& F, int li) {
    const int o = li >> 1;
    if (F.vcu >= 4) return;
    const int b = F.vcu >> 1, h = (F.vcu & 1) * 8 + F.wave, lane = F.lane, c = h * 64 + lane;
    bf16_t* Z = (bf16_t*)(F.ws + WS_Z); const bf16_t* L1 = (const bf16_t*)(F.ws + WS_L1); bf16_t* VF = (bf16_t*)(F.ws + WS_VF);
    const float* w2 = F.in[14] + (size_t)o * 64 * D; const float* a2 = F.in[17] + (size_t)o * 64 * D; const float* v2 = F.in[20];
    const float w0c = F.in[12][o * D + c], a0c = F.in[15][o * D + c], v0c = o ? F.in[18][c] : 0.f;
    const float kkc = F.in[21][o * D + c], kac = F.in[22][o * D + c], rkc = F.in[23][o * D + c], lgc = F.in[24][o * D + c], lbc = F.in[25][o * D + c];
    LAS float* wl = (LAS float*)(F.lds + F.wave * 16384);
    LAS float* s_r = wl; LAS float* s_w = wl + 512; LAS float* s_k = wl + 1024; LAS float* s_a = wl + 1536; LAS float* s_v = wl + 2048; LAS float* s_l1 = wl + 2560;
    LAS float* c_kk = wl + 3840; LAS float* c_b = wl + 3904; LAS float* c_km = wl + 3968;
    float st[64];
#pragma unroll
    for (int k = 0; k < 64; ++k) st[k] = 0.f;
#pragma unroll 1
    for (int t0 = 0; t0 < SEQ; t0 += 8) {
        for (int e = lane; e < 8 * 160; e += 64) { const int s = e / 160, j = e % 160; s_l1[e] = bf2f(L1[((size_t)b * SEQ + t0 + s) * 256 + j]); }
        LDS_WAIT(); asm volatile("" ::: "memory");
        {
            float lw[8], la[8], lv[8];
#pragma unroll
            for (int s = 0; s < 8; ++s) { lw[s] = 0.f; la[s] = 0.f; lv[s] = 0.f; }
#pragma unroll 2
            for (int j = 0; j < 64; ++j) { const float wj = w2[(size_t)j * D + c], aj = a2[(size_t)j * D + c];
#pragma unroll
                for (int s = 0; s < 8; ++s) { lw[s] += s_l1[s * 160 + j] * wj; la[s] += s_l1[s * 160 + 64 + j] * aj; } }
            if (o) {
#pragma unroll 2
                for (int j = 0; j < 32; ++j) { const float vj = v2[(size_t)j * D + c];
#pragma unroll
                    for (int s = 0; s < 8; ++s) lv[s] += s_l1[s * 160 + 128 + j] * vj; } }
#pragma unroll
            for (int s = 0; s < 8; ++s) {
                const size_t row = (size_t)b * SEQ + t0 + s; const size_t p = row * ZW + c;
                const float r = bf2f(Z[p]), k = bf2f(Z[p + 1024]); float v = bf2f(Z[p + 2048]);
                const float w = expf(-expf(-softplusf_(-(w0c + lw[s])) - 0.5f)); const float a = sigmoidf_(a0c + la[s]);
                if (o) { const float vf = bf2f(VF[row * D + c]); v = v + (vf - v) * sigmoidf_(v0c + lv[s]); } else VF[row * D + c] = (bf16_t)f2bf(v);
                s_r[s * 64 + lane] = r; s_w[s * 64 + lane] = w; s_k[s * 64 + lane] = k; s_a[s * 64 + lane] = a; s_v[s * 64 + lane] = v;
            }
        }
        LDS_WAIT(); asm volatile("" ::: "memory");
#pragma unroll 1
        for (int s = 0; s < 8; ++s) {
            const float r = s_r[s * 64 + lane], k = s_k[s * 64 + lane], a = s_a[s * 64 + lane], v = s_v[s * 64 + lane];
            const float kr = k * kkc; const float nrm = sqrtf(wave_sum(kr * kr)); const float kk = kr / fmaxf(nrm, 1e-12f);
            const float km = k * (1.f + (a - 1.f) * kac);
            const float bonus = wave_sum(r * km * rkc);
            c_kk[lane] = kk; c_b[lane] = kk * a; c_km[lane] = km;
            LDS_WAIT(); asm volatile("" ::: "memory");
            const LAS float* pw = s_w + s * 64; const LAS float* pr = s_r + s * 64;
            float sk0 = 0.f, sk1 = 0.f, sk2 = 0.f, sk3 = 0.f;
#pragma unroll
            for (int j = 0; j < 64; j += 4) { sk0 += st[j] * c_kk[j]; sk1 += st[j + 1] * c_kk[j + 1]; sk2 += st[j + 2] * c_kk[j + 2]; sk3 += st[j + 3] * c_kk[j + 3]; }
            const float sk = (sk0 + sk1) + (sk2 + sk3);
            float y0 = 0.f, y1 = 0.f, y2 = 0.f, y3 = 0.f;
#pragma unroll
            for (int j = 0; j < 64; j += 4) {
                st[j] = st[j] * pw[j] - sk * c_b[j] + v * c_km[j]; y0 += st[j] * pr[j];
                st[j + 1] = st[j + 1] * pw[j + 1] - sk * c_b[j + 1] + v * c_km[j + 1]; y1 += st[j + 1] * pr[j + 1];
                st[j + 2] = st[j + 2] * pw[j + 2] - sk * c_b[j + 2] + v * c_km[j + 2]; y2 += st[j + 2] * pr[j + 2];
                st[j + 3] = st[j + 3] * pw[j + 3] - sk * c_b[j + 3] + v * c_km[j + 3]; y3 += st[j + 3] * pr[j + 3];
            }
            const float y = (y0 + y1) + (y2 + y3);
            const float mu = wave_sum(y) * (1.f / 64.f); const float dy = y - mu; const float var = wave_sum(dy * dy) * (1.f / 64.f);
            const float yo = dy * rsqrtf(var + 64e-5f) * lgc + lbc + bonus * v;
            const size_t pg = ((size_t)b * SEQ + t0 + s) * ZW + 3072 + c; const float g = bf2f(Z[pg]);
            Z[pg] = (bf16_t)f2bf(yo * siluf_(g));
            LDS_WAIT(); asm volatile("" ::: "memory");
        }
    }
}

enum { PH_P0 = 0, PH_FINAL = 23, N_PHASES = 24 };
#define IN(k) (lo <= (k) && (k) < hi)
#if MK_MULTI
#define SEAM(k) do { } while (0)
#else
#define SEAM(k) do { if (IN(k) && IN((k) + 1)) xcd_barrier(bar); } while (0)
#endif
template <int LI>
__device__ __forceinline__ void run_layer(Frame& F, const XcdBarrier& bar, const int lo, const int hi, const int bx) {
    constexpr bool even = (LI & 1) == 0;
    constexpr int base = 1 + (LI / 2) * 11 + (even ? 0 : 6);
    bf16_t* Zp = (bf16_t*)(F.ws + WS_Z);
    if constexpr (even) {
        if (IN(base)) { F.retid(); pg8::StaticOrder S; S.init(64, 16, F.G, bx);
            pg8::Gemm g{(const bf16_t*)(F.ws + WS_HB), (const bf16_t*)(F.ws + WS_WIN)};
            EpiEvenIn E{Zp, F.ssq(LI), (bf16_t*)(F.ws + WS_VTA), (bf16_t*)(F.ws + WS_VTB), (bf16_t*)(F.ws + WS_KT)};
            pg8::gemm_phase<EpiEvenIn, true, D, D, 1 << 20, 0, 0>(F.lds, F.tid, g, S, E); }
        SEAM(base);
        if (IN(base + 1)) { F.retid();
            conv_wrest(F, LI);
            if constexpr (LI < 3) conv_win_odd(F, LI + 1);
            for (int u = F.vcu * 8 + F.wave; u < 4096; u += F.G * 8) ret_stage_a(F, u);
            for (int u = F.vcu * 8 + F.wave; u < 2048; u += F.G * 8) sb_unit(F, u >> 8, u & 255); }
        SEAM(base + 1);
        if (IN(base + 2)) { F.retid(); ret_stage_b(F); }
        SEAM(base + 2);
        if (IN(base + 3)) { F.retid(); const float* gng = F.in[8] + (LI >> 1) * 512;
            for (int u = F.vcu * 8 + F.wave; u < 2048; u += F.G * 8) ret_stage_c(F, u, gng); }
        SEAM(base + 3);
        if (IN(base + 4)) { F.retid(); pg8::StaticOrder S; S.init(64, 4, F.G, bx);
            { pg8::Gemm g{(const bf16_t*)(F.ws + WS_PB), (const bf16_t*)(F.ws + WS_WPROJ)};
              EpiStore E{Zp, ZE}; pg8::gemm_phase<EpiStore, false, PLE, PLE, 1 << 20, 0, 0>(F.lds, F.tid, g, S, E); }
            { pg8::Gemm g{Zp + 1024, (const bf16_t*)(F.ws + WS_WOUT)};
              EpiResid E{F.H, Zp + 1536, ZE}; pg8::gemm_phase<EpiResid, false, ZE, D, 8, (long)((2560 - 1024) * 2), 0>(F.lds, F.tid, g, S, E); } }
        SEAM(base + 4);
        if (IN(base + 5)) { F.retid(); pg8::StaticOrder S; S.init(64, 4, F.G, bx);
            pg8::Gemm g{Zp + 1536, (const bf16_t*)(F.ws + WS_WGATE)};
            EpiGate E{F.H, Zp, ZE, nullptr, F.ssq(LI + 1)};
            pg8::gemm_phase<EpiGate, false, ZE, D, 1 << 20, 0, 0>(F.lds, F.tid, g, S, E); }
        SEAM(base + 5);
    } else {
        if (IN(base)) { F.retid(); rows_norm(F, LI); }
        SEAM(base);
        if (IN(base + 1)) { F.retid(); pg8::StaticOrder S; S.init(64, 17, F.G, bx);
            pg8::Gemm g{(const bf16_t*)(F.ws + WS_HB) + D, (const bf16_t*)(F.ws + WS_WIN)};
            EpiOddIn E{Zp, (bf16_t*)(F.ws + WS_L1)}; pg8::gemm_phase<EpiOddIn, true, D, 2048, 16, -(long)(D * 2), (long)(D * 2)>(F.lds, F.tid, g, S, E); }
        SEAM(base + 1);
        if (IN(base + 2)) { F.retid();
            conv_wrest(F, LI);
            if constexpr (LI < 3) conv_win_even(F, LI + 1);
            __syncthreads();
            phase_scan_naive(F, LI); }
        SEAM(base + 2);
        if (IN(base + 3)) { F.retid(); pg8::StaticOrder S; S.init(64, 4, F.G, bx);
            { pg8::Gemm g{(const bf16_t*)(F.ws + WS_PB), (const bf16_t*)(F.ws + WS_WPROJ)};
              EpiStore E{Zp, ZW}; pg8::gemm_phase<EpiStore, false, PLE, PLE, 1 << 20, 0, 0>(F.lds, F.tid, g, S, E); }
            { pg8::Gemm g{Zp + 3072, (const bf16_t*)(F.ws + WS_WOUT)};
              EpiResid E{F.H, Zp + 2048, ZW}; pg8::gemm_phase<EpiResid, false, ZW, D, 1 << 20, 0, 0>(F.lds, F.tid, g, S, E); } }
        SEAM(base + 3);
        if (IN(base + 4)) { F.retid(); pg8::StaticOrder S; S.init(64, 4, F.G, bx);
            pg8::Gemm g{Zp + 2048, (const bf16_t*)(F.ws + WS_WGATE)};
            EpiGate E{F.H, Zp, ZW, (bf16_t*)(F.ws + WS_HB), F.ssq(LI + 1)};
            pg8::gemm_phase<EpiGate, false, ZW, D, 1 << 20, 0, 0>(F.lds, F.tid, g, S, E); }
        SEAM(base + 4);
    }
}
__global__ void __launch_bounds__(512, 2) mk_fwd(Args args) {
    extern __shared__ __attribute__((aligned(16))) unsigned char lds_raw[];
    Frame F;
    F.lds = (LAS unsigned char*)lds_raw; F.ldsg = lds_raw;
    F.tid = threadIdx.x; F.lane = F.tid & 63; F.wave = __builtin_amdgcn_readfirstlane(F.tid >> 6);
    F.G = gridDim.x; const int bx = blockIdx.x; F.vcu = (F.G % 8 == 0) ? (bx % 8) * (F.G / 8) + bx / 8 : bx;
    F.H = args.out; F.ws = args.ws;
    volatile LAS unsigned* MISC = (volatile LAS unsigned*)(F.lds + MISC_OFF);
    for (int u = F.tid; u < (LDS_BYTES - RING_BYTES) / 4; u += 512) ((LAS unsigned*)(F.lds + RING_BYTES))[u] = 0u;
    __syncthreads();
    XcdBarrier bar; bar.bar = (unsigned*)(F.ws + WS_CTL) + 4096; bar.x = 0; bar.st = nullptr;
#if !MK_MULTI
    bar = xcd_barrier_post((unsigned*)(F.ws + WS_CTL) + 4096, MISC + 8);
#endif
    const int lo = args.ph_lo, hi = args.ph_hi;
    if (IN(PH_P0)) { F.retid(); rows_p0(F); conv_win_even(F, 0); }
#if !MK_MULTI
    if (IN(0) && IN(1)) { VM_WAIT(); cg::this_grid().sync(); }
#endif
    run_layer<0>(F, bar, lo, hi, bx);
    run_layer<1>(F, bar, lo, hi, bx);
    run_layer<2>(F, bar, lo, hi, bx);
    run_layer<3>(F, bar, lo, hi, bx);
    if (IN(PH_FINAL)) { F.retid(); rows_final(F); }
}

extern "C" void kernel_launch(void* const* d_in, const int* in_sizes, int n_in, void* d_out, int out_size, void* d_ws, size_t ws_size, hipStream_t stream) {
    static int grid = 0;
    if (grid == 0) {
        int dev = 0, cus = 0, per_cu = 0;
        (void)hipGetDevice(&dev); (void)hipDeviceGetAttribute(&cus, hipDeviceAttributeMultiprocessorCount, dev);
        (void)hipFuncSetAttribute((const void*)mk_fwd, hipFuncAttributeMaxDynamicSharedMemorySize, LDS_BYTES);
        (void)hipOccupancyMaxActiveBlocksPerMultiprocessor(&per_cu, (const void*)mk_fwd, 512, LDS_BYTES);
        if (per_cu < 1) per_cu = 1;
        grid = cus * 1;
        if (n_in != 26 || ws_size < WS_END) fprintf(stderr, "kernel_launch: unexpected n_in %d / ws %zu\n", n_in, ws_size);
        (void)hipGetLastError();
    }
    (void)hipMemsetAsync((char*)d_ws + WS_CTL, 0, CTL_BYTES, stream);
    Args a{};
    for (int i = 0; i < 26; ++i) a.in[i] = (const float*)d_in[i];
    a.out = (float*)d_out; a.ws = (unsigned char*)d_ws;
#if MK_MULTI
    for (int ph = 0; ph < N_PHASES; ++ph) { a.ph_lo = ph; a.ph_hi = ph + 1; hipLaunchKernelGGL(mk_fwd, dim3(grid), dim3(512), LDS_BYTES, stream, a); }
#else
    a.ph_lo = 0; a.ph_hi = N_PHASES;
    void* kargs[] = {&a};
    hipError_t e = hipLaunchCooperativeKernel((const void*)mk_fwd, dim3(grid), dim3(512), kargs, LDS_BYTES, stream);
    if (e != hipSuccess) fprintf(stderr, "cooperative launch failed: %s (grid %d)\n", hipGetErrorString(e), grid);
#endif
}
```

```cpp
#include <hip/hip_runtime.h>
#include <hip/hip_cooperative_groups.h>
#include <cstdint>
#include <cstdio>
namespace cg = cooperative_groups;

#ifndef MK_MULTI
#define MK_MULTI 0
#endif

#define LAS __attribute__((address_space(3)))
#define GAS __attribute__((address_space(1)))
typedef unsigned short bf16_t;
typedef short bf16x8 __attribute__((ext_vector_type(8)));
typedef float f32x4 __attribute__((ext_vector_type(4)));
typedef float f32x2 __attribute__((ext_vector_type(2)));
typedef unsigned u32x4 __attribute__((ext_vector_type(4)));
typedef unsigned u32x2 __attribute__((ext_vector_type(2)));

constexpr int D = 1024, BATCH = 2, SEQ = 8192, T = BATCH * SEQ, PLE = 256, ZW = 4096, ZE = 3072;
constexpr float QK_SCALE = 0.08838834764831845f;

__device__ __forceinline__ float bf2f(bf16_t v) { return __uint_as_float(((unsigned)v) << 16); }
__device__ __forceinline__ unsigned f2bf(float f) { unsigned u = __float_as_uint(f); return (u + 0x7fffu + ((u >> 16) & 1u)) >> 16; }
__device__ __forceinline__ unsigned pk2(float lo, float hi) { return f2bf(lo) | (f2bf(hi) << 16); }
typedef __bf16 bf16x2_t __attribute__((ext_vector_type(2)));
__device__ __forceinline__ unsigned cvt_pk_bf16(float lo, float hi) { f32x2 v = {lo, hi}; bf16x2_t b = __builtin_convertvector(v, bf16x2_t); return __builtin_bit_cast(unsigned, b); }
__device__ __forceinline__ float wave_sum(float v) {
#pragma unroll
    for (int o = 1; o < 64; o <<= 1) v += __shfl_xor(v, o);
    return v;
}
__device__ __forceinline__ float sigmoidf_(float x) { return 1.f / (1.f + __expf(-x)); }
__device__ __forceinline__ float siluf_(float x) { return x / (1.f + __expf(-x)); }
__device__ __forceinline__ float softplusf_(float x) { return x > 20.f ? x : log1pf(expf(x)); }
__device__ __forceinline__ float logsigf_(float x) { return -(x < -20.f ? -x : log1pf(expf(-x))); }
__device__ __forceinline__ float ssq_sum(const float* sq, int row) { const f32x4* p = (const f32x4*)(sq + (size_t)row * 16); const f32x4 a = p[0], b = p[1], c = p[2], d = p[3];
    return (((a[0] + a[1]) + (a[2] + a[3])) + ((b[0] + b[1]) + (b[2] + b[3]))) + (((c[0] + c[1]) + (c[2] + c[3])) + ((d[0] + d[1]) + (d[2] + d[3]))); }
#define LDS_WAIT() asm volatile("s_waitcnt lgkmcnt(0)" ::: "memory")
#define VM_WAIT() asm volatile("s_waitcnt vmcnt(0)" ::: "memory")

namespace pg8 {
constexpr int BM = 256, BK = 64, HALF = 128, HTB = HALF * BK * 2, STAGE_BYTES = 8 * HTB, NXCD = 8, WGM = 8;
__host__ __device__ __forceinline__ int lds_byte(int r, int c) { const int st = (r >> 4) * 2 + (c >> 5), rr = r & 15, cc = c & 31, ob = rr * 64 + cc * 2; return st * 1024 + (ob ^ (((ob >> 9) & 1) << 5)); }
__host__ __device__ __forceinline__ void stage_rc(int b, int& R, int& C) { const int st = b / 1024, sb = b % 1024, swz = sb ^ (((sb >> 9) & 1) << 5); R = (st >> 1) * 16 + swz / 64; C = (st & 1) * 32 + (swz % 64) / 2; }
__host__ __device__ __forceinline__ int perm32(int rho) { const int n = rho >> 4, i = rho & 15; return 8 * (i >> 2) + 4 * n + (i & 3); }
struct Unit { int pm, pn; };
struct Gemm { const bf16_t* A; const bf16_t* Bt; };
struct StaticOrder {
    int nM, nN, nwg, G, c;
    __device__ void init(int nM_, int nN_, int G_, int c_) { nM = nM_; nN = nN_; nwg = nM * nN; G = G_; c = c_; }
    __device__ bool next(int i, Unit& u) const {
        const long L = (long)i * G + c; if (L >= nwg) return false;
        int wgid = (int)L; { const int q = nwg / NXCD, r = nwg % NXCD, xcd = wgid % NXCD, off = wgid / NXCD; wgid = (xcd < r ? xcd * (q + 1) : r * (q + 1) + (xcd - r) * q) + off; }
        const int nig = WGM * nN, gid = wgid / nig, fm = gid * WGM, gsz = (nM - fm) < WGM ? (nM - fm) : WGM;
        u.pm = fm + ((wgid % nig) % gsz); u.pn = (wgid % nig) / gsz; return true;
    }
};
template <class Epi, bool ALIGN_EPI, int LDA, int KK, int TSPLIT, long ASHIFT, long BROW>
__device__ __forceinline__ void gemm_phase(LAS unsigned char* lds, const int tid_in, const Gemm g, const StaticOrder& S, const Epi& E) {
    int tid = tid_in; asm volatile("" : "+v"(tid));
    const int wid = __builtin_amdgcn_readfirstlane(tid >> 6), lane = tid & 63, wr = wid >> 2, wc = wid & 3, fr = lane & 15, fq = lane >> 4;
    constexpr int K = KK, nt = K / BK, lda = LDA, tsplit = TSPLIT; constexpr long ashift = ASHIFT;
    unsigned voffA[2], voffB[2];
#pragma unroll
    for (int i = 0; i < 2; ++i) { int R, C; stage_rc(tid * 16 + i * 8192, R, C); const int Rb = (R & ~31) + perm32(R & 31);
        voffA[i] = (unsigned)(R * lda + C) * 2u; voffB[i] = (unsigned)(Rb * K + C) * 2u; }
    constexpr size_t kstep = (size_t)(BK * 2);
    constexpr size_t hstepA = (size_t)HALF * lda * 2, hstepB = (size_t)HALF * K * 2, tstepA = 2 * hstepA, tstepB = 2 * hstepB;
    const unsigned ldsw = (unsigned)wid * 1024u;
    const int aoff = lds_byte(wr * 64 + fr, fq * 8), boff = lds_byte(wc * 32 + fr, fq * 8);
#define PG8_AP(base, tt) ((base) + (((tt) < tsplit) ? (long)(tt) * 128 : ashift + (long)((tt) - tsplit) * 128))
#define PG8_ABASE(u) ((const char*)g.A + (size_t)(u).pm * tstepA + ((BROW != 0 && (u).pm >= 32) ? BROW : 0))
#define PG8_SA(b, h) (((b) * 2 + (h)) * HTB)
#define PG8_SB(b, h) ((4 + (b) * 2 + (h)) * HTB)
#define PG8_STAGE(bufoff, gbase, voff) do { const char* _gb = (const char*)(gbase); asm volatile("" : "+s"(_gb)); _Pragma("unroll") for (int _i = 0; _i < 2; ++_i) \
        __builtin_amdgcn_global_load_lds((const unsigned*)(_gb + (voff)[_i]), (LAS unsigned*)(lds + (bufoff) + ldsw + _i * 8192), 16, 0, 0); } while (0)
#define PG8_LDA(dst, b, h) do { _Pragma("unroll") for (int m = 0; m < 4; ++m) _Pragma("unroll") for (int k = 0; k < 2; ++k) dst[m][k] = *(const LAS bf16x8*)(lds + PG8_SA(b, h) + aoff + m * 2048 + k * 1024); } while (0)
#define PG8_LDB(dst, b, h) do { _Pragma("unroll") for (int n = 0; n < 2; ++n) _Pragma("unroll") for (int k = 0; k < 2; ++k) dst[n][k] = *(const LAS bf16x8*)(lds + PG8_SB(b, h) + boff + n * 2048 + k * 1024); } while (0)
#define PG8_MMA(ai, bj, At, Bt) do { __builtin_amdgcn_s_setprio(1); _Pragma("unroll") for (int m = 0; m < 4; ++m) _Pragma("unroll") for (int n = 0; n < 2; ++n) _Pragma("unroll") for (int k = 0; k < 2; ++k) \
        acc[ai][bj][m][n] = __builtin_amdgcn_mfma_f32_16x16x32_bf16(Bt[n][k], At[m][k], acc[ai][bj][m][n], 0, 0, 0); __builtin_amdgcn_s_setprio(0); } while (0)
#define PG8_WAIT_V(n) asm volatile("s_waitcnt vmcnt(" #n ")" ::: "memory")
#define PG8_WAIT_L(n) asm volatile("s_waitcnt lgkmcnt(" #n ")" ::: "memory")
#define PG8_BAR __builtin_amdgcn_s_barrier()
#define PG8_SCHED __builtin_amdgcn_sched_barrier(0)
    Unit cur, nxt; int ui = 0;
    if (!S.next(0, cur)) return;
    f32x4 acc[2][2][4][2];
#pragma unroll
    for (int a = 0; a < 2; ++a)
#pragma unroll
        for (int b = 0; b < 2; ++b)
#pragma unroll
            for (int m = 0; m < 4; ++m)
#pragma unroll
                for (int n = 0; n < 2; ++n) acc[a][b][m][n] = (f32x4){0.f, 0.f, 0.f, 0.f};
    bf16x8 At[4][2], B0[2][2], B1[2][2];
    const char* cA = PG8_ABASE(cur); const char* cB = (const char*)g.Bt + (size_t)cur.pn * tstepB;
    {
        const char* a0 = PG8_AP(cA, 0); const char* a1 = PG8_AP(cA, 1);
        PG8_STAGE(PG8_SB(0, 0), cB, voffB); PG8_STAGE(PG8_SB(0, 1), cB + hstepB, voffB); PG8_STAGE(PG8_SA(0, 0), a0, voffA); PG8_STAGE(PG8_SA(0, 1), a0 + hstepA, voffA);
        if (wr == 1) PG8_BAR;
        PG8_WAIT_V(2); PG8_BAR;
        PG8_STAGE(PG8_SB(1, 0), cB + kstep, voffB); PG8_STAGE(PG8_SA(1, 0), a1, voffA); PG8_STAGE(PG8_SB(1, 1), cB + hstepB + kstep, voffB);
        PG8_WAIT_V(6); PG8_BAR;
    }
    for (;;) {
        const bool has_next = S.next(ui + 1, nxt);
        const char* nA = has_next ? PG8_ABASE(nxt) : cA; const char* nB = has_next ? (const char*)g.Bt + (size_t)nxt.pn * tstepB : cB;
        for (int t = 0; t < nt; t += 2) {
            const bool last = (t == nt - 2);
            const char* a1 = PG8_AP(cA, t + 1);
            const char* a2 = last ? PG8_AP(nA, 0) : PG8_AP(cA, t + 2); const char* b2 = last ? nB : cB + (size_t)(t + 2) * kstep;
            const char* a3 = last ? PG8_AP(nA, 1) : PG8_AP(cA, t + 3); const char* b3 = b2 + kstep;
            PG8_LDB(B0, 0, 0); PG8_LDB(B1, 0, 1); PG8_SCHED; PG8_LDA(At, 0, 0); PG8_STAGE(PG8_SA(1, 1), a1 + hstepA, voffA);
            PG8_WAIT_V(8); PG8_WAIT_L(0); PG8_BAR; PG8_MMA(0, 0, At, B0); PG8_MMA(0, 1, At, B1); PG8_BAR; PG8_SCHED;
            PG8_LDA(At, 0, 1); PG8_STAGE(PG8_SB(0, 0), b2, voffB); PG8_STAGE(PG8_SB(0, 1), b2 + hstepB, voffB); PG8_STAGE(PG8_SA(0, 0), a2, voffA);
            PG8_WAIT_V(8); PG8_WAIT_L(0); PG8_BAR; PG8_MMA(1, 0, At, B0); PG8_MMA(1, 1, At, B1); PG8_BAR; PG8_SCHED;
            PG8_LDB(B0, 1, 0); PG8_LDB(B1, 1, 1); PG8_SCHED; PG8_LDA(At, 1, 0); PG8_STAGE(PG8_SA(0, 1), a2 + hstepA, voffA);
            PG8_WAIT_V(8); PG8_WAIT_L(0); PG8_BAR; PG8_MMA(0, 0, At, B0); PG8_MMA(0, 1, At, B1); PG8_BAR; PG8_SCHED;
            PG8_LDA(At, 1, 1); PG8_STAGE(PG8_SB(1, 0), b3, voffB); PG8_STAGE(PG8_SB(1, 1), b3 + hstepB, voffB); PG8_STAGE(PG8_SA(1, 0), a3, voffA);
            PG8_WAIT_V(8); PG8_WAIT_L(0); PG8_BAR; PG8_MMA(1, 0, At, B0); PG8_MMA(1, 1, At, B1); PG8_BAR; PG8_SCHED;
        }
        if constexpr (ALIGN_EPI) { if (wr == 0) PG8_BAR; }
        E(acc, cur, wr, wc, fr, fq);
        if (!has_next) break;
#pragma unroll
        for (int a = 0; a < 2; ++a)
#pragma unroll
            for (int b = 0; b < 2; ++b)
#pragma unroll
                for (int m = 0; m < 4; ++m)
#pragma unroll
                    for (int n = 0; n < 2; ++n) acc[a][b][m][n] = (f32x4){0.f, 0.f, 0.f, 0.f};
        cur = nxt; cA = nA; cB = nB; ++ui;
        if constexpr (ALIGN_EPI) { if (wr == 1) PG8_BAR; }
    }
    PG8_WAIT_V(0);
    if constexpr (!ALIGN_EPI) { if (wr == 0) PG8_BAR; }
    PG8_BAR;
#undef PG8_AP
#undef PG8_ABASE
#undef PG8_SA
#undef PG8_SB
#undef PG8_STAGE
#undef PG8_LDA
#undef PG8_LDB
#undef PG8_MMA
#undef PG8_WAIT_V
#undef PG8_WAIT_L
#undef PG8_BAR
#undef PG8_SCHED
}
}

template <class Fn>
__device__ __forceinline__ void epi_for(const f32x4 (&acc)[2][2][4][2], const pg8::Unit& u, int wr, int wc, int fr, int fq, Fn fn) {
#pragma unroll
    for (int ai = 0; ai < 2; ++ai)
#pragma unroll
        for (int m = 0; m < 4; ++m) { const int row = u.pm * 256 + ai * 128 + wr * 64 + m * 16 + fr;
#pragma unroll
            for (int bj = 0; bj < 2; ++bj) { const int col = u.pn * 256 + bj * 128 + wc * 32 + 8 * fq; fn(row, col, acc[ai][bj][m][0], acc[ai][bj][m][1]); }
            asm volatile("" ::: "memory"); }
}
__device__ __forceinline__ u32x4 pack8(f32x4 v0, f32x4 v1) { u32x4 w; w.x = cvt_pk_bf16(v0[0], v0[1]); w.y = cvt_pk_bf16(v0[2], v0[3]); w.z = cvt_pk_bf16(v1[0], v1[1]); w.w = cvt_pk_bf16(v1[2], v1[3]); return w; }

struct EpiEvenIn {
    bf16_t* Z; const float* ssq; bf16_t* VTa; bf16_t* VTb; bf16_t* KT;
    __device__ __forceinline__ void operator()(const f32x4 (&acc)[2][2][4][2], const pg8::Unit& u, int wr, int wc, int fr, int fq) const {
        const int g = u.pn >> 1;
        epi_for(acc, u, wr, wc, fr, fq, [&](int row, int col, f32x4 v0, f32x4 v1) {
            const float rs = rsqrtf(ssq_sum(ssq, row) * (1.f / D) + 1e-6f);
            v0 = v0 * rs; v1 = v1 * rs;
            const int cg = col & 511, t = row & (SEQ - 1), b = row >> 13;
            if (g == 2 || g == 6) {
                bf16_t* p = (g == 2 ? VTa : VTb) + ((size_t)(b * 512 + cg)) * SEQ + t;
                _Pragma("unroll") for (int j = 0; j < 4; ++j) { p[(size_t)j * SEQ] = (bf16_t)f2bf(v0[j]); p[(size_t)(4 + j) * SEQ] = (bf16_t)f2bf(v1[j]); }
            } else if (g < 2) {
                const float pos = (float)t; const int i0 = (cg & 127) >> 1;
                float o[8] = {v0[0], v0[1], v0[2], v0[3], v1[0], v1[1], v1[2], v1[3]};
                _Pragma("unroll") for (int j = 0; j < 4; ++j) { const float inv = exp2f(-(float)(i0 + j) * (13.287712379549449f / 64.f));
                    float rev = pos * inv * 0.15915494309189535f; rev = rev - floorf(rev); const float sn = __builtin_amdgcn_sinf(rev), cs = __builtin_amdgcn_cosf(rev);
                    const float x1 = o[2 * j], x2 = o[2 * j + 1]; o[2 * j] = x1 * cs - x2 * sn; o[2 * j + 1] = x1 * sn + x2 * cs; }
                const float lg2 = log2f(1.f - exp2f(-5.f - (float)(cg >> 7))); const float ip1 = (float)((t & 127) + 1);
                if (g == 0) { const float f = exp2f(ip1 * lg2);
                    *(u32x4*)(Z + (size_t)row * ZE + cg) = pack8((f32x4){o[0] * f, o[1] * f, o[2] * f, o[3] * f}, (f32x4){o[4] * f, o[5] * f, o[6] * f, o[7] * f}); }
                else { const float f = exp2f(-ip1 * lg2), f2 = exp2f((128.f - ip1) * lg2);
                    *(u32x4*)(Z + (size_t)row * ZE + 512 + cg) = pack8((f32x4){o[0] * f, o[1] * f, o[2] * f, o[3] * f}, (f32x4){o[4] * f, o[5] * f, o[6] * f, o[7] * f});
                    bf16_t* p = KT + ((size_t)(b * 512 + cg)) * SEQ + t;
                    _Pragma("unroll") for (int j = 0; j < 8; ++j) p[(size_t)j * SEQ] = (bf16_t)f2bf(o[j] * f2); }
            } else {
                const int zc = (g - 1 - (g > 6 ? 1 : 0)) * 512;
                *(u32x4*)(Z + (size_t)row * ZE + zc + cg) = pack8(v0, v1);
            }
        });
    }
};
struct EpiOddIn {
    bf16_t* Z; bf16_t* L1;
    __device__ __forceinline__ void operator()(const f32x4 (&acc)[2][2][4][2], const pg8::Unit& u, int wr, int wc, int fr, int fq) const {
        if (u.pn < 16) { epi_for(acc, u, wr, wc, fr, fq, [&](int row, int col, f32x4 v0, f32x4 v1) { *(u32x4*)(Z + (size_t)row * ZW + col) = pack8(v0, v1); }); }
        else { epi_for(acc, u, wr, wc, fr, fq, [&](int row, int col, f32x4 v0, f32x4 v1) { const int c = col - 4096; if (c < 64) {
                    _Pragma("unroll") for (int j = 0; j < 4; ++j) { v0[j] = tanhf(v0[j]); v1[j] = tanhf(v1[j]); } }
                *(u32x4*)(L1 + (size_t)row * 256 + c) = pack8(v0, v1); }); }
    }
};
struct EpiResid {
    float* H; bf16_t* HB; int ldb;
    __device__ __forceinline__ void operator()(const f32x4 (&acc)[2][2][4][2], const pg8::Unit& u, int wr, int wc, int fr, int fq) const {
        epi_for(acc, u, wr, wc, fr, fq, [&](int row, int col, f32x4 v0, f32x4 v1) { float* hp = H + (size_t)row * D + col; f32x4 h0 = *(const f32x4*)hp, h1 = *(const f32x4*)(hp + 4); h0 = h0 + v0; h1 = h1 + v1;
            *(f32x4*)hp = h0; *(f32x4*)(hp + 4) = h1; *(u32x4*)(HB + (size_t)row * ldb + col) = pack8(h0, h1); });
    }
};
struct EpiStore {
    bf16_t* O; int ldc;
    __device__ __forceinline__ void operator()(const f32x4 (&acc)[2][2][4][2], const pg8::Unit& u, int wr, int wc, int fr, int fq) const {
        epi_for(acc, u, wr, wc, fr, fq, [&](int row, int col, f32x4 v0, f32x4 v1) { *(u32x4*)(O + (size_t)row * ldc + col) = pack8(v0, v1); });
    }
};
struct EpiGate {
    float* H; const bf16_t* PP; int ldp; bf16_t* HB2; float* ssq;
    __device__ __forceinline__ void operator()(const f32x4 (&acc)[2][2][4][2], const pg8::Unit& u, int wr, int wc, int fr, int fq) const {
#pragma unroll
        for (int ai = 0; ai < 2; ++ai)
#pragma unroll
            for (int m = 0; m < 4; ++m) { const int row = u.pm * 256 + ai * 128 + wr * 64 + m * 16 + fr; float sq = 0.f;
#pragma unroll
                for (int bj = 0; bj < 2; ++bj) { const int col = u.pn * 256 + bj * 128 + wc * 32 + 8 * fq; const f32x4 v0 = acc[ai][bj][m][0], v1 = acc[ai][bj][m][1];
                    float* hp = H + (size_t)row * D + col; f32x4 h0 = *(const f32x4*)hp, h1 = *(const f32x4*)(hp + 4); const u32x4 pw = *(const u32x4*)(PP + (size_t)row * ldp + col);
                    const unsigned pwv[4] = {pw.x, pw.y, pw.z, pw.w};
                    float pp[8];
#pragma unroll
                    for (int j = 0; j < 4; ++j) { pp[2 * j] = __uint_as_float(pwv[j] << 16); pp[2 * j + 1] = __uint_as_float(pwv[j] & 0xffff0000u); }
#pragma unroll
                    for (int j = 0; j < 4; ++j) { h0[j] += sigmoidf_(v0[j]) * pp[j]; h1[j] += sigmoidf_(v1[j]) * pp[4 + j]; sq += h0[j] * h0[j] + h1[j] * h1[j]; }
                    *(f32x4*)hp = h0; *(f32x4*)(hp + 4) = h1; if (HB2) *(u32x4*)(HB2 + (size_t)row * D + col) = pack8(h0, h1); }
                sq += __shfl_xor(sq, 16); sq += __shfl_xor(sq, 32);
                if (fq == 0) ssq[(size_t)row * 16 + u.pn * 4 + wc] = sq;
                asm volatile("" ::: "memory"); }
    }
};

#define XB_TMO      128
#define XB_XCNT(j)  (256  + 64 * (j))
#define XB_XSUB(j)  (1280 + 64 * (j))
#define XB_XGEN(j)  (2304 + 64 * (j))
#define XB_TOP      3328
#define XB_TOPGEN   3392
#define XCD_BAR_WORDS 3456
#define XB_SPIN_CAP (1u << 22)
__device__ __forceinline__ unsigned xb_ld(unsigned* p)              { return __hip_atomic_load(p, __ATOMIC_RELAXED, __HIP_MEMORY_SCOPE_AGENT); }
__device__ __forceinline__ unsigned xb_add(unsigned* p, unsigned v) { return __hip_atomic_fetch_add(p, v, __ATOMIC_RELAXED, __HIP_MEMORY_SCOPE_AGENT); }
__device__ __forceinline__ unsigned xb_xcc_id() { return (unsigned)__builtin_amdgcn_s_getreg((3 << 11) | 20) & 0xFu; }
#define XB_SPIN(cond, bar) do { unsigned _sp = 0; while (cond) { __builtin_amdgcn_s_sleep(1); \
    if ((++_sp & 255u) == 0u) { if (xb_ld(&(bar)[XB_TMO])) break; if (_sp > XB_SPIN_CAP) { atomicAdd(&(bar)[XB_TMO], 1u); break; } } } } while (0)
struct XcdBarrier { unsigned* bar; unsigned x; volatile LAS unsigned* st; };
__device__ __forceinline__ XcdBarrier xcd_barrier_post(unsigned* bar, volatile LAS unsigned* st) {
    XcdBarrier b; b.bar = bar; b.x = xb_xcc_id(); b.st = st;
    if (threadIdx.x == 0) (void)xb_add(&bar[XB_XCNT(b.x)], 1u);
    return b;
}
__device__ __forceinline__ void xcd_barrier_complete(unsigned* bar, unsigned x, unsigned& nloc, unsigned& nx) {
    const unsigned G = gridDim.x * gridDim.y * gridDim.z;
    unsigned sum, cnt, mine, sp = 0u;
    for (;;) {
        sum = 0u; cnt = 0u; mine = 0u;
#pragma unroll
        for (unsigned j = 0; j < 16; ++j) { const unsigned c = xb_ld(&bar[XB_XCNT(j)]); sum += c; cnt += (c > 0u) ? 1u : 0u; mine = (j == x) ? c : mine; }
        if (sum == G) break;
        __builtin_amdgcn_s_sleep(1);
        if ((++sp & 255u) == 0u) { if (xb_ld(&bar[XB_TMO])) break; if (sp > XB_SPIN_CAP) { atomicAdd(&bar[XB_TMO], 1u); break; } }
    }
    nloc = mine > 0u ? mine : 1u; nx = cnt > 0u ? cnt : 1u;
}
__device__ __forceinline__ void xcd_barrier(const XcdBarrier& b_in) {
    asm volatile("s_waitcnt vmcnt(0)" ::: "memory");
    __syncthreads();
    if (threadIdx.x == 0) {
        const XcdBarrier& b = b_in;
        unsigned* bar = b.bar;
        __builtin_amdgcn_s_waitcnt(0);
        unsigned nloc = b.st[0], nx = b.st[1];
        if (nloc == 0u) { xcd_barrier_complete(bar, b.x, nloc, nx); b.st[0] = nloc; b.st[1] = nx; }
        const unsigned old = xb_add(&bar[XB_XSUB(b.x)], 1u);
        const unsigned gen = old / nloc;
        if (old + 1u == (gen + 1u) * nloc) {
            __builtin_amdgcn_fence(__ATOMIC_RELEASE, "agent");
            asm volatile("s_waitcnt vmcnt(0)" ::: "memory");
            const unsigned og = xb_add(&bar[XB_TOP], 1u);
            const unsigned tg = og / nx;
            if (og + 1u == (tg + 1u) * nx) xb_add(&bar[XB_TOPGEN], 1u);
            else XB_SPIN(xb_ld(&bar[XB_TOPGEN]) == tg, bar);
            __builtin_amdgcn_fence(__ATOMIC_ACQUIRE, "agent");
            xb_add(&bar[XB_XGEN(b.x)], 1u);
            asm volatile("s_waitcnt vmcnt(0)" ::: "memory");
        } else {
            XB_SPIN(xb_ld(&bar[XB_XGEN(b.x)]) == gen, bar);
            __builtin_amdgcn_fence(__ATOMIC_ACQUIRE, "agent");
            asm volatile("s_waitcnt vmcnt(0)" ::: "memory");
        }
    }
    __syncthreads();
}

constexpr size_t MiB = 1u << 20;
constexpr size_t WS_CTL = 0, CTL_BYTES = 1 * MiB;
constexpr size_t WS_SSQ = 241 * (size_t)(1u << 20);
constexpr size_t WS_WIN = 2 * MiB;
constexpr size_t WS_WOUT = 19 * MiB, WS_WGATE = 21 * MiB, WS_WPROJ = 23 * MiB;
constexpr size_t WS_PB = 24 * MiB;
constexpr size_t WS_Z = 32 * MiB;
constexpr size_t WS_HB = 160 * MiB;
constexpr size_t WS_VF = 193 * MiB;
constexpr size_t WS_L1 = 225 * MiB;
constexpr size_t WS_VTA = 128 * MiB;
constexpr size_t WS_VTB = 144 * MiB;
constexpr size_t WS_KT = 225 * MiB;
constexpr size_t WS_LORA2 = 23 * MiB + 512 * 1024;
constexpr size_t WS_PG = 160 * MiB;
constexpr size_t WS_BON = 233 * MiB;
constexpr size_t WS_ST = 176 * MiB;
constexpr size_t WS_KV = 160 * MiB;
constexpr size_t WS_END = 256 * MiB;

constexpr int RING_BYTES = 131072, LDS_BYTES = 163840, MISC_OFF = LDS_BYTES - 512;

struct Args { const float* in[26]; float* out; unsigned char* ws; int ph_lo, ph_hi; };

__device__ __forceinline__ const float* inptr(int i) { asm volatile("" : "+s"(i)); const char* ka = (const char*)__builtin_amdgcn_kernarg_segment_ptr(); return *(const float* const*)(ka + 8 * i); }
struct InTab { __device__ __forceinline__ const float* operator[](int i) const { return inptr(i); } };
struct Frame {
    LAS unsigned char* lds; unsigned char* ldsg;
    int tid, lane, wave, G, vcu;
    InTab in; float* H; unsigned char* ws;
    __device__ __forceinline__ void retid() { int l; asm volatile("v_mbcnt_lo_u32_b32 %0, -1, 0\n\tv_mbcnt_hi_u32_b32 %0, -1, %0" : "=v"(l)); lane = l; tid = wave * 64 + l; }
    __device__ __forceinline__ float* ssq(int l) const { return (float*)(ws + WS_SSQ) + (size_t)l * T * 16; }
};

__device__ __forceinline__ void conv_item(const float* W, int ldw, int Kmax, int k0, int n0, bf16_t* dst, int ldd, int dr0, int drs, int dk0,
                                          const float* svec, float sa, float sb, float sc, LAS float* scr, int lane) {
#pragma unroll 8
    for (int i = 0; i < 32; ++i) { const int kk = 2 * i + (lane >> 5), k = k0 + kk; float v = 0.f;
        if (k < Kmax) { const float f = (sa + sb * (svec ? svec[k] : 0.f)) * sc; v = W[(size_t)k * ldw + n0 + (lane & 31)] * f; }
        scr[kk * 33 + (lane & 31)] = v; }
    LDS_WAIT(); asm volatile("" ::: "memory");
    const int c = lane & 7;
    if (k0 + 8 * c < Kmax) {
#pragma unroll
        for (int j = 0; j < 4; ++j) { const int n = (lane >> 3) + 8 * j; const LAS float* s = scr + (8 * c) * 33 + n;
            u32x4 o; o.x = pk2(s[0 * 33], s[1 * 33]); o.y = pk2(s[2 * 33], s[3 * 33]); o.z = pk2(s[4 * 33], s[5 * 33]); o.w = pk2(s[6 * 33], s[7 * 33]);
            *(GAS u32x4*)(dst + (size_t)(dr0 + n * drs) * ldd + dk0 + k0 + 8 * c) = o; }
    }
    LDS_WAIT(); asm volatile("" ::: "memory");
}
__device__ __forceinline__ void conv_win_even(Frame& F, int li) {
    const int e = li >> 1; const float* W = F.in[6] + (size_t)e * D * ZW; const float* gain = F.in[2] + li * D; bf16_t* dst = (bf16_t*)(F.ws + WS_WIN);
    LAS float* scr = (LAS float*)(F.lds + F.wave * 16384);
    const int gw = F.vcu * 8 + F.wave, NGW = F.G * 8;
    for (int it = gw; it < 16 * 128; it += NGW) { const int kb = it >> 7, nb = it & 127, n0 = nb * 32, g = n0 >> 9, hh = (n0 & 511) >> 7, d0 = n0 & 127;
        int dr0 = n0, drs = 1; if (g < 2) { dr0 = g * 512 + hh * 128 + (d0 < 64 ? 2 * d0 : 2 * (d0 - 64) + 1); drs = 2; }
        const float sc = (g == 1 || g == 5) ? QK_SCALE : 1.f;
        conv_item(W, ZW, D, kb * 64, n0, dst, D, dr0, drs, 0, gain, 0.f, 1.f, sc, scr, F.lane); }
}
__device__ __forceinline__ void conv_win_odd(Frame& F, int li) {
    const int o = li >> 1; const float* mu = F.in[9] + (size_t)o * 6 * D; bf16_t* dst = (bf16_t*)(F.ws + WS_WIN);
    LAS float* scr = (LAS float*)(F.lds + F.wave * 16384);
    const int gw = F.vcu * 8 + F.wave, NGW = F.G * 8;
    for (int it = gw; it < 4 * 2 * 512; it += NGW) { const int p = it >> 10, half = (it >> 9) & 1, r = it & 511, kb = r >> 5, nb = r & 31;
        const float* W = F.in[10] + ((size_t)o * 4 + p) * D * D;
        conv_item(W, D, D, kb * 64, nb * 32, dst, 2048, p * 1024 + nb * 32, 1, half * 1024, mu + p * D, half ? 0.f : 1.f, half ? 1.f : -1.f, 1.f, scr, F.lane); }
    for (int it = gw; it < 2 * (32 + 32 + 16); it += NGW) { const int half = it / 80, r = it % 80; const float* W; int ldw, n0, dr0, mi, kb;
        if (r < 32) { W = F.in[13] + (size_t)o * D * 64; ldw = 64; kb = r >> 1; n0 = (r & 1) * 32; dr0 = 4096 + n0; mi = 4; }
        else if (r < 64) { const int q = r - 32; W = F.in[16] + (size_t)o * D * 64; ldw = 64; kb = q >> 1; n0 = (q & 1) * 32; dr0 = 4160 + n0; mi = 5; }
        else { const int q = r - 64; W = F.in[19]; ldw = 32; kb = q; n0 = 0; dr0 = 4224; mi = 2; }
        const float sc = (r >= 64 && o == 0) ? 0.f : 1.f;
        conv_item(W, ldw, D, kb * 64, n0, dst, 2048, dr0, 1, half * 1024, mu + mi * D, half ? 0.f : 1.f, half ? 1.f : -1.f, sc, scr, F.lane); }
    { u32x4 z = {0u, 0u, 0u, 0u}; GAS u32x4* zp = (GAS u32x4*)(dst + (size_t)4256 * 2048); const int n16 = 96 * 2048 * 2 / 16;
      for (int i = (F.vcu * 512 + F.tid); i < n16; i += F.G * 512) zp[i] = z; }
}
__device__ __forceinline__ void conv_wrest(Frame& F, int li) {
    const bool even = (li & 1) == 0; const int e = li >> 1;
    const float* Wo = even ? F.in[7] + (size_t)e * D * D : F.in[11] + (size_t)e * D * D;
    const float* Wg = F.in[5] + (size_t)li * D * D; const float* Wp = F.in[4] + (size_t)li * PLE * D;
    LAS float* scr = (LAS float*)(F.lds + F.wave * 16384);
    const int gw = F.vcu * 8 + F.wave, NGW = F.G * 8;
    for (int it = gw; it < 512 + 512 + 128; it += NGW) {
        if (it < 512) conv_item(Wo, D, D, (it >> 5) * 64, (it & 31) * 32, (bf16_t*)(F.ws + WS_WOUT), D, (it & 31) * 32, 1, 0, nullptr, 1.f, 0.f, 1.f, scr, F.lane);
        else if (it < 1024) { const int r = it - 512; conv_item(Wg, D, D, (r >> 5) * 64, (r & 31) * 32, (bf16_t*)(F.ws + WS_WGATE), D, (r & 31) * 32, 1, 0, nullptr, 1.f, 0.f, 1.f, scr, F.lane); }
        else { const int r = it - 1024; conv_item(Wp, D, PLE, (r >> 5) * 64, (r & 31) * 32, (bf16_t*)(F.ws + WS_WPROJ), PLE, (r & 31) * 32, 1, 0, nullptr, 1.f, 0.f, 1.f, scr, F.lane); }
    }
    const float* P = F.in[1] + (size_t)li * T * PLE; GAS u32x4* pb = (GAS u32x4*)(F.ws + WS_PB); const int n8 = T * PLE / 8;
    for (int i = F.vcu * 512 + F.tid; i < n8; i += F.G * 512) { const f32x4 a = *(const f32x4*)(P + (size_t)i * 8), b = *(const f32x4*)(P + (size_t)i * 8 + 4);
        u32x4 o; o.x = pk2(a[0], a[1]); o.y = pk2(a[2], a[3]); o.z = pk2(b[0], b[1]); o.w = pk2(b[2], b[3]); pb[i] = o; }
}

__device__ __forceinline__ void conv_lora2(Frame& F, int li) {
    const int o = li >> 1; LAS float* scr = (LAS float*)(F.lds + F.wave * 16384);
    bf16_t* W2T = (bf16_t*)(F.ws + WS_LORA2); bf16_t* A2T = W2T + 1024 * 64; bf16_t* V2T = A2T + 1024 * 64;
    const int gw = F.vcu * 8 + F.wave, NGW = F.G * 8;
    for (int it = gw; it < 96; it += NGW) {
        if (it < 32) conv_item(F.in[14] + (size_t)o * 64 * D, D, 64, 0, it * 32, W2T, 64, it * 32, 1, 0, nullptr, 1.f, 0.f, 1.f, scr, F.lane);
        else if (it < 64) conv_item(F.in[17] + (size_t)o * 64 * D, D, 64, 0, (it - 32) * 32, A2T, 64, (it - 32) * 32, 1, 0, nullptr, 1.f, 0.f, 1.f, scr, F.lane);
        else conv_item(F.in[20], D, 32, 0, (it - 64) * 32, V2T, 32, (it - 64) * 32, 1, 0, nullptr, 1.f, 0.f, 1.f, scr, F.lane);
    }
}
__device__ __forceinline__ void rows_p0(Frame& F) {
    const float* x = F.in[0]; bf16_t* HB = (bf16_t*)(F.ws + WS_HB); float* s0 = F.ssq(0);
    for (int row = F.vcu * 8 + F.wave; row < T; row += F.G * 8) {
        const f32x4* xr = (const f32x4*)(x + (size_t)row * D) + F.lane; f32x4* hr = (f32x4*)(F.H + (size_t)row * D) + F.lane; u32x2* br = (u32x2*)(HB + (size_t)row * D) + F.lane; float s = 0.f;
#pragma unroll
        for (int j = 0; j < 4; ++j) { const f32x4 v = xr[64 * j]; s += (v[0] * v[0] + v[1] * v[1]) + (v[2] * v[2] + v[3] * v[3]); hr[64 * j] = v; u32x2 w; w.x = pk2(v[0], v[1]); w.y = pk2(v[2], v[3]); br[64 * j] = w; }
        s = wave_sum(s); if (F.lane < 16) s0[(size_t)row * 16 + F.lane] = F.lane == 0 ? s : 0.f;
    }
}
__device__ __forceinline__ void rows_norm(Frame& F, int li) {
    const float* gain = F.in[2] + li * D; bf16_t* HN = (bf16_t*)(F.ws + WS_HB); const float* sq = F.ssq(li);
    f32x4 g[4];
#pragma unroll
    for (int j = 0; j < 4; ++j) g[j] = *((const f32x4*)gain + F.lane + 64 * j);
    for (int row = F.vcu * 8 + F.wave; row < T; row += F.G * 8) {
        const f32x4* hr = (const f32x4*)(F.H + (size_t)row * D) + F.lane; u32x2* br = (u32x2*)(HN + (size_t)(row + 1 + (row >= SEQ ? 1 : 0)) * D) + F.lane;
        const float rs = rsqrtf(ssq_sum(sq, row) * (1.f / D) + 1e-6f);
#pragma unroll
        for (int j = 0; j < 4; ++j) { const f32x4 v = hr[64 * j] * rs * g[j]; u32x2 w; w.x = pk2(v[0], v[1]); w.y = pk2(v[2], v[3]); br[64 * j] = w; }
    }
    if (F.vcu == 0 && F.wave < 2) { u32x2* br = (u32x2*)(HN + (size_t)(F.wave ? SEQ + 1 : 0) * D) + F.lane; u32x2 z = {0u, 0u};
#pragma unroll
        for (int j = 0; j < 4; ++j) br[64 * j] = z; }
}
__device__ __forceinline__ void rows_final(Frame& F) {
    const float* gain = F.in[3]; const float* sq = F.ssq(4);
    f32x4 g[4];
#pragma unroll
    for (int j = 0; j < 4; ++j) g[j] = *((const f32x4*)gain + F.lane + 64 * j);
    for (int row = F.vcu * 8 + F.wave; row < T; row += F.G * 8) {
        f32x4* hr = (f32x4*)(F.H + (size_t)row * D) + F.lane; const float rs = rsqrtf(ssq_sum(sq, row) * (1.f / D) + 1e-6f);
#pragma unroll
        for (int j = 0; j < 4; ++j) hr[64 * j] = hr[64 * j] * rs * g[j];
    }
}

typedef float f32x16 __attribute__((ext_vector_type(16)));
__device__ __forceinline__ void sb_unit(Frame& F, int bh, int qb) {
    const int lane = F.lane, l31 = lane & 31, hi = lane >> 5, b = bh >> 2, h = bh & 3;
    bf16_t* Z = (bf16_t*)(F.ws + WS_Z); const bf16_t* VT = (const bf16_t*)(F.ws + WS_VTB) + (size_t)bh * 128 * SEQ;
    const size_t rowb = (size_t)b * SEQ; const int q0 = qb * 32, tq = q0 + l31;
    bf16x8 qr[8];
    { const bf16_t* qp = Z + (rowb + tq) * ZE + 1536 + h * 128 + hi * 8;
#pragma unroll
      for (int ks = 0; ks < 8; ++ks) qr[ks] = *(const bf16x8*)(qp + 16 * ks); }
    f32x16 o[4];
#pragma unroll
    for (int d = 0; d < 4; ++d)
#pragma unroll
        for (int r = 0; r < 16; ++r) o[d][r] = 0.f;
    float carry = 1.f;
    const int pi = 16 * ((l31 >> 2) & 1) + (l31 & 3) + 4 * (l31 >> 3);
    const bf16_t* Kb = Z + rowb * ZE + 2048 + h * 128 + hi * 8;
    for (int kt = (q0 + 31) >> 6; kt >= 0; --kt) {
        const int kbase = kt * 64;
        const bf16_t* kp0 = Kb + (size_t)(kbase + pi) * ZE; const bf16_t* kp1 = kp0 + (size_t)32 * ZE;
        f32x16 p0, p1;
#pragma unroll
        for (int r = 0; r < 16; ++r) { p0[r] = 0.f; p1[r] = 0.f; }
#pragma unroll
        for (int ks = 0; ks < 8; ++ks) { const bf16x8 a0 = *(const bf16x8*)(kp0 + 16 * ks), a1 = *(const bf16x8*)(kp1 + 16 * ks);
            p0 = __builtin_amdgcn_mfma_f32_32x32x16_bf16(a0, qr[ks], p0, 0, 0, 0); p1 = __builtin_amdgcn_mfma_f32_32x32x16_bf16(a1, qr[ks], p1, 0, 0, 0); }
        float f1 = 1.f, f0 = 1.f;
        const int k1 = kbase + 32 + 16 * hi, k0 = kbase + 16 * hi;
#pragma unroll
        for (int r = 15; r >= 0; --r) { const float z = fminf(p1[r], 80.f); const float e = exp2f(z * 1.4426950408889634f); float rd = __builtin_amdgcn_rcpf(1.f + e); float be = e * rd;
            const bool valid = (k1 + r) < tq; be = valid ? be : 0.f; rd = valid ? rd : 1.f; p1[r] = be * f1; f1 *= rd; }
#pragma unroll
        for (int r = 15; r >= 0; --r) { const float z = fminf(p0[r], 80.f); const float e = exp2f(z * 1.4426950408889634f); float rd = __builtin_amdgcn_rcpf(1.f + e); float be = e * rd;
            const bool valid = (k0 + r) < tq; be = valid ? be : 0.f; rd = valid ? rd : 1.f; p0[r] = be * f0; f0 *= rd; }
        const float pf0 = __shfl_xor(f0, 32), pf1 = __shfl_xor(f1, 32);
        const float tail1 = hi ? 1.f : pf1;
        const float tail0 = hi ? (pf1 * f1) : (pf0 * f1 * pf1);
        const float s1 = tail1 * carry, s0 = tail0 * carry;
        carry *= (f0 * f1) * (pf0 * pf1);
        u32x4 pa[2][2];
#pragma unroll
        for (int s = 0; s < 2; ++s) {
            pa[0][s].x = cvt_pk_bf16(p0[8 * s + 0] * s0, p0[8 * s + 1] * s0); pa[0][s].y = cvt_pk_bf16(p0[8 * s + 2] * s0, p0[8 * s + 3] * s0);
            pa[0][s].z = cvt_pk_bf16(p0[8 * s + 4] * s0, p0[8 * s + 5] * s0); pa[0][s].w = cvt_pk_bf16(p0[8 * s + 6] * s0, p0[8 * s + 7] * s0);
            pa[1][s].x = cvt_pk_bf16(p1[8 * s + 0] * s1, p1[8 * s + 1] * s1); pa[1][s].y = cvt_pk_bf16(p1[8 * s + 2] * s1, p1[8 * s + 3] * s1);
            pa[1][s].z = cvt_pk_bf16(p1[8 * s + 4] * s1, p1[8 * s + 5] * s1); pa[1][s].w = cvt_pk_bf16(p1[8 * s + 6] * s1, p1[8 * s + 7] * s1);
        }
        const bf16_t* vp = VT + (size_t)l31 * SEQ + kbase + 16 * hi;
#pragma unroll
        for (int d = 0; d < 4; ++d)
#pragma unroll
            for (int blk = 0; blk < 2; ++blk)
#pragma unroll
                for (int s = 0; s < 2; ++s) { const bf16x8 vb = *(const bf16x8*)(vp + (size_t)(32 * d) * SEQ + 32 * blk + 8 * s);
                    o[d] = __builtin_amdgcn_mfma_f32_32x32x16_bf16(__builtin_bit_cast(bf16x8, pa[blk][s]), vb, o[d], 0, 0, 0); }
        if (__all(carry < 7.9e-31f)) break;
    }
#pragma unroll
    for (int r = 0; r < 16; ++r) { const int qrow = q0 + (r & 3) + 8 * (r >> 2) + 4 * hi; bf16_t* gp = Z + (rowb + qrow) * ZE + 2560 + h * 128 + l31;
#pragma unroll
        for (int d = 0; d < 4; ++d) { const float g = bf2f(gp[32 * d]); gp[32 * d] = (bf16_t)f2bf(o[d][r] * siluf_(g)); } }
}
__device__ __forceinline__ void ret_stage_a(Frame& F, int u) {
    const int l31 = F.lane & 31, hi = F.lane >> 5, cu = u >> 3, w8 = u & 7, bh = cu & 7, n = cu >> 3, dvb = w8 >> 1, dkp = w8 & 1;
    const bf16_t* vt = (const bf16_t*)(F.ws + WS_VTA) + ((size_t)(bh * 128 + 32 * dvb + l31)) * SEQ + n * 128 + 8 * hi;
    const bf16_t* kt = (const bf16_t*)(F.ws + WS_KT) + ((size_t)(bh * 128 + 64 * dkp + l31)) * SEQ + n * 128 + 8 * hi;
    f32x16 a0, a1;
#pragma unroll
    for (int r = 0; r < 16; ++r) { a0[r] = 0.f; a1[r] = 0.f; }
#pragma unroll
    for (int ks = 0; ks < 8; ++ks) { const bf16x8 va = *(const bf16x8*)(vt + 16 * ks), k0 = *(const bf16x8*)(kt + 16 * ks), k1 = *(const bf16x8*)(kt + (size_t)32 * SEQ + 16 * ks);
        a0 = __builtin_amdgcn_mfma_f32_32x32x16_bf16(va, k0, a0, 0, 0, 0); a1 = __builtin_amdgcn_mfma_f32_32x32x16_bf16(va, k1, a1, 0, 0, 0); }
    bf16_t* kv = (bf16_t*)(F.ws + WS_KV) + ((size_t)cu * 128 + 32 * dvb) * 128 + 64 * dkp + l31;
#pragma unroll
    for (int r = 0; r < 16; ++r) { const int dv = (r & 3) + 8 * (r >> 2) + 4 * hi; kv[dv * 128] = (bf16_t)f2bf(a0[r]); kv[dv * 128 + 32] = (bf16_t)f2bf(a1[r]); }
}
__device__ __forceinline__ void ret_stage_b(Frame& F) {
    const int e = F.vcu * 512 + F.tid; if (e >= 8 * 128 * 128) return;
    const int h = (e >> 14) & 3; const float g128 = exp2f(128.f * log2f(1.f - exp2f(-5.f - (float)h)));
    const bf16_t* p = (const bf16_t*)(F.ws + WS_KV) + e; bf16_t* q = (bf16_t*)(F.ws + WS_ST) + e; float S = 0.f;
#pragma unroll 4
    for (int n = 0; n < 64; ++n) { const float kv = bf2f(p[(size_t)n * 131072]); q[(size_t)n * 131072] = (bf16_t)f2bf(S); S = S * g128 + kv; }
}
__device__ __forceinline__ void ret_stage_c(Frame& F, int u, const float* gng) {
    const int lane = F.lane, l31 = lane & 31, hi = lane >> 5, cu = u >> 2, qblk = u & 3, bh = cu & 7, n = cu >> 3, b = bh >> 2, h = bh & 3;
    bf16_t* Z = (bf16_t*)(F.ws + WS_Z); const size_t rowb = (size_t)b * SEQ; const int t0 = n * 128, tq = t0 + 32 * qblk + l31;
    bf16x8 qr[8];
    { const bf16_t* qp = Z + (rowb + tq) * ZE + h * 128 + hi * 8;
#pragma unroll
      for (int ks = 0; ks < 8; ++ks) qr[ks] = *(const bf16x8*)(qp + 16 * ks); }
    f32x16 o[4];
#pragma unroll
    for (int d = 0; d < 4; ++d)
#pragma unroll
        for (int r = 0; r < 16; ++r) o[d][r] = 0.f;
    { const bf16_t* sp = (const bf16_t*)(F.ws + WS_ST) + ((size_t)cu * 128 + l31) * 128 + 8 * hi;
#pragma unroll
      for (int ks = 0; ks < 8; ++ks)
#pragma unroll
          for (int d = 0; d < 4; ++d) { const bf16x8 sb = *(const bf16x8*)(sp + (size_t)(32 * d) * 128 + 16 * ks); o[d] = __builtin_amdgcn_mfma_f32_32x32x16_bf16(qr[ks], sb, o[d], 0, 0, 0); } }
    const int pi = 16 * ((l31 >> 2) & 1) + (l31 & 3) + 4 * (l31 >> 3);
    const bf16_t* Kb = Z + rowb * ZE + 512 + h * 128 + hi * 8;
    const bf16_t* VT = (const bf16_t*)(F.ws + WS_VTA) + ((size_t)(bh * 128 + l31)) * SEQ + 16 * hi;
    for (int kb = 0; kb <= qblk; ++kb) {
        const int kbase = t0 + 32 * kb; const bf16_t* kp = Kb + (size_t)(kbase + pi) * ZE;
        f32x16 p;
#pragma unroll
        for (int r = 0; r < 16; ++r) p[r] = 0.f;
#pragma unroll
        for (int ks = 0; ks < 8; ++ks) { const bf16x8 a = *(const bf16x8*)(kp + 16 * ks); p = __builtin_amdgcn_mfma_f32_32x32x16_bf16(a, qr[ks], p, 0, 0, 0); }
        if (kb == qblk) {
#pragma unroll
            for (int r = 0; r < 16; ++r) p[r] = (kbase + 16 * hi + r <= tq) ? p[r] : 0.f; }
        u32x4 pa[2];
#pragma unroll
        for (int s = 0; s < 2; ++s) { pa[s].x = cvt_pk_bf16(p[8 * s], p[8 * s + 1]); pa[s].y = cvt_pk_bf16(p[8 * s + 2], p[8 * s + 3]); pa[s].z = cvt_pk_bf16(p[8 * s + 4], p[8 * s + 5]); pa[s].w = cvt_pk_bf16(p[8 * s + 6], p[8 * s + 7]); }
#pragma unroll
        for (int d = 0; d < 4; ++d)
#pragma unroll
            for (int s = 0; s < 2; ++s) { const bf16x8 vb = *(const bf16x8*)(VT + (size_t)(32 * d) * SEQ + kbase + 8 * s);
                o[d] = __builtin_amdgcn_mfma_f32_32x32x16_bf16(__builtin_bit_cast(bf16x8, pa[s]), vb, o[d], 0, 0, 0); }
    }
    float gg[4];
#pragma unroll
    for (int d = 0; d < 4; ++d) gg[d] = gng[h * 128 + 32 * d + l31];
#pragma unroll
    for (int r = 0; r < 16; ++r) {
        float sm = (o[0][r] + o[1][r]) + (o[2][r] + o[3][r]);
        sm += __shfl_xor(sm, 1); sm += __shfl_xor(sm, 2); sm += __shfl_xor(sm, 4); sm += __shfl_xor(sm, 8); sm += __shfl_xor(sm, 16);
        const float mu = sm * (1.f / 128.f); float q = 0.f;
#pragma unroll
        for (int d = 0; d < 4; ++d) { const float dd = o[d][r] - mu; q += dd * dd; }
        q += __shfl_xor(q, 1); q += __shfl_xor(q, 2); q += __shfl_xor(q, 4); q += __shfl_xor(q, 8); q += __shfl_xor(q, 16);
        const float rsd = rsqrtf(q * (1.f / 128.f) + 1e-5f);
        const int qrow = t0 + 32 * qblk + (r & 3) + 8 * (r >> 2) + 4 * hi; bf16_t* gp = Z + (rowb + qrow) * ZE + 1024 + h * 128 + l31;
#pragma unroll
        for (int d = 0; d < 4; ++d) { const float ga = bf2f(gp[32 * d]); gp[32 * d] = (bf16_t)f2bf((o[d][r] - mu) * rsd * gg[d] * siluf_(ga)); }
    }
}
__device__ __forceinline__ bf16x8 ld8p(const bf16_t* p) { return *(const bf16x8*)p; }
namespace rw {
constexpr int S64 = 72, S128 = 136;
constexpr int O_AT = 0, O_RT = O_AT + 9216, O_E = O_RT + 9216, O_ET = O_E + 18432, O_AM = O_ET + 17408, O_X0 = O_AM + 18432, O_LF = O_X0 + 17408, O_MM = O_LF + 16640,
              O_NN = O_MM + 9216, O_PC = O_NN + 17408, O_GC = O_PC + 9216, O_SM = O_GC + 9216, O_END = O_SM + 4096;
static_assert(O_END <= 160 * 1024 - 1024, "rwkv stage X LDS map");
typedef __attribute__((address_space(3))) bf16_t lbf;
typedef __attribute__((address_space(3))) float lf32;
__device__ __forceinline__ bf16x8 ld8(const bf16_t* p) { return *(const bf16x8*)p; }
template <int MT, int NT, int KS, class Epi>
__device__ __forceinline__ void mm(const bf16_t* A, int lda, const bf16_t* B, int ldb, int wave, int lane, Epi epi) {
    const int fr = lane & 15, g = lane >> 4;
    static_assert((MT * NT) % 8 == 0, "mm: tile count must be a multiple of the 8 waves");
#pragma unroll
    for (int ti = 0; ti < MT * NT / 8; ++ti) { const int tile = wave + 8 * ti; const int mt = tile / NT, nt = tile % NT;
        f32x4 acc = {0.f, 0.f, 0.f, 0.f};
        const bf16_t* ap = A + (mt * 16 + fr) * lda + 8 * g; const bf16_t* bp = B + (nt * 16 + fr) * ldb + 8 * g;
#pragma unroll
        for (int ks = 0; ks < KS; ++ks) acc = __builtin_amdgcn_mfma_f32_16x16x32_bf16(ld8(ap + 32 * ks), ld8(bp + 32 * ks), acc, 0, 0, 0);
        epi(ti, mt * 16 + 4 * g, nt * 16 + fr, acc);
    }
}
__device__ __forceinline__ unsigned short bfs(float f) { return (unsigned short)f2bf(f); }
__device__ __forceinline__ void st4(bf16_t* p, f32x4 v) { u32x2 w; w.x = cvt_pk_bf16(v[0], v[1]); w.y = cvt_pk_bf16(v[2], v[3]); *(u32x2*)p = w; }
}

__device__ __forceinline__ void rwkv_stage_x(Frame& F, int li) {
    using namespace rw;
    const int o = li >> 1;
    unsigned char* L = F.ldsg;
    bf16_t* At = (bf16_t*)(L + O_AT); bf16_t* Rt = (bf16_t*)(L + O_RT); bf16_t* E = (bf16_t*)(L + O_E); bf16_t* ET = (bf16_t*)(L + O_ET); bf16_t* AM = (bf16_t*)(L + O_AM);
    bf16_t* X0T = (bf16_t*)(L + O_X0); float* Lf = (float*)(L + O_LF); bf16_t* Mm = (bf16_t*)(L + O_MM); bf16_t* NN = (bf16_t*)(L + O_NN); float* CS = (float*)(L + O_NN);
    bf16_t* Pc = (bf16_t*)(L + O_PC); bf16_t* Gc = (bf16_t*)(L + O_GC); float* gamC = (float*)(L + O_SM); float* SEGT = gamC + 64;
    bf16_t* Tm = At; bf16_t* Qh = AM; bf16_t* PT = AM + 64 * S64; bf16_t* WT = Mm;
    bf16_t* Z = (bf16_t*)(F.ws + WS_Z); const bf16_t* L1g = (const bf16_t*)(F.ws + WS_L1); bf16_t* VF = (bf16_t*)(F.ws + WS_VF);
    const bf16_t* W2T = (const bf16_t*)(F.ws + WS_LORA2); const bf16_t* A2T = W2T + 1024 * 64; const bf16_t* V2T = A2T + 1024 * 64;
    bf16_t* PG = (bf16_t*)(F.ws + WS_PG); float* BON = (float*)(F.ws + WS_BON);
    const float* w0p = F.in[12] + o * D; const float* a0p = F.in[15] + o * D; const float* v0p = F.in[18]; const float* kkp = F.in[21] + o * D; const float* kap = F.in[22] + o * D; const float* rkp = F.in[23] + o * D;
#pragma unroll 1
    for (int u = F.vcu; u < 2048; u += F.G) {
        const int bh = u & 31, blk = u >> 5, b = bh >> 4, h = bh & 15; const size_t row0 = (size_t)b * SEQ + (size_t)blk * 128;
        int tid = F.tid; asm volatile("" : "+v"(tid));
        __syncthreads();
        for (int e = tid; e < 64 * 64; e += 512) { const int i = e >> 6, j = e & 63; Pc[i * S64 + j] = (i == j) ? (bf16_t)0x3f80 : (bf16_t)0; Gc[i * S64 + j] = 0; }
#pragma unroll 1
        for (int c = 0; c < 2; ++c) {
            const size_t rows = row0 + 64 * c;
            asm volatile("" : "+v"(tid));
            const int lane = tid & 63; int wave = F.wave; asm volatile("" : "+s"(wave));
            const int pt = tid >> 3, pc0 = (tid & 7) * 8;
            __syncthreads();
            mm<4, 4, 2>(L1g + rows * 256, 256, W2T + (size_t)h * 64 * 64, 64, wave, lane, [&](int, int r0, int col, f32x4 a) {
#pragma unroll
                for (int j = 0; j < 4; ++j) Lf[(r0 + j) * 65 + col] = a[j]; });
            mm<4, 4, 2>(L1g + rows * 256 + 64, 256, A2T + (size_t)h * 64 * 64, 64, wave, lane, [&](int, int r0, int col, f32x4 a) {
#pragma unroll
                for (int j = 0; j < 4; ++j) Mm[(r0 + j) * S64 + col] = bfs(a[j]); });
            if (o) mm<4, 4, 1>(L1g + rows * 256 + 128, 256, V2T + (size_t)h * 64 * 32, 32, wave, lane, [&](int, int r0, int col, f32x4 a) {
#pragma unroll
                for (int j = 0; j < 4; ++j) AM[(64 + r0 + j) * S64 + col] = bfs(a[j]); });
            __syncthreads();
            float pr[8], pkk[8], pkm[8], pb[8], pv[8];
            {
                const size_t row = rows + pt; bf16_t* zp = Z + row * ZW + h * 64 + pc0; const int cc = h * 64 + pc0;
                const bf16x8 r8 = ld8(zp), k8 = ld8(zp + 1024), v8 = ld8(zp + 2048);
                float ss = 0.f, bon = 0.f, dec[8];
#pragma unroll
                for (int j = 0; j < 8; ++j) {
                    const float r = bf2f((bf16_t)r8[j]), k = bf2f((bf16_t)k8[j]); float v = bf2f((bf16_t)v8[j]);
                    const float lw = Lf[pt * 65 + pc0 + j], la = bf2f(Mm[pt * S64 + pc0 + j]);
                    dec[j] = -expf(-softplusf_(-(w0p[cc + j] + lw)) - 0.5f);
                    const float a = sigmoidf_(a0p[cc + j] + la);
                    if (o) { const float lv = bf2f(AM[(64 + pt) * S64 + pc0 + j]); const float vf = bf2f(VF[row * D + cc + j]); v = v + (vf - v) * sigmoidf_(v0p[cc + j] + lv); v = bf2f((bf16_t)f2bf(v)); }
                    const float kr = k * kkp[cc + j]; ss += kr * kr; pkk[j] = kr;
                    const float km = k * (1.f + (a - 1.f) * kap[cc + j]); pkm[j] = km; pb[j] = a; pr[j] = r; pv[j] = v; bon += r * km * rkp[cc + j];
                }
                if (o) { u32x4 w; w.x = pk2(pv[0], pv[1]); w.y = pk2(pv[2], pv[3]); w.z = pk2(pv[4], pv[5]); w.w = pk2(pv[6], pv[7]); *(u32x4*)(zp + 2048) = w; }
                else *(bf16x8*)(VF + row * D + cc) = v8;
                ss += __shfl_xor(ss, 1); ss += __shfl_xor(ss, 2); ss += __shfl_xor(ss, 4);
                bon += __shfl_xor(bon, 1); bon += __shfl_xor(bon, 2); bon += __shfl_xor(bon, 4);
                const float inv = 1.f / fmaxf(sqrtf(ss), 1e-12f);
#pragma unroll
                for (int j = 0; j < 8; ++j) { pkk[j] *= inv; pb[j] *= pkk[j]; }
                if ((tid & 7) == 0) BON[row * 16 + h] = bon;
                __syncthreads();
#pragma unroll
                for (int j = 0; j < 8; ++j) CS[pt * 65 + pc0 + j] = dec[j];
            }
            __syncthreads();
            { const int ch = tid & 63, sg = tid >> 6; float run = 0.f;
#pragma unroll
              for (int q = 0; q < 8; ++q) { run += CS[(sg * 8 + q) * 65 + ch]; CS[(sg * 8 + q) * 65 + ch] = run; }
              SEGT[sg * 64 + ch] = run;
              __syncthreads();
              float pre = 0.f;
              for (int q = 0; q < sg; ++q) pre += SEGT[q * 64 + ch];
#pragma unroll
              for (int q = 0; q < 8; ++q) CS[(sg * 8 + q) * 65 + ch] += pre; }
            __syncthreads();
            {
                unsigned short at[8], bt[8], kt[8], rt[8], vt[8];
#pragma unroll
                for (int j = 0; j < 8; ++j) { const float g = CS[pt * 65 + pc0 + j], gp = pt ? CS[(pt - 1) * 65 + pc0 + j] : 0.f; const float eg = expf(g), egp = expf(gp), ieg = expf(-g);
                    at[j] = bfs(egp * pkk[j]); bt[j] = bfs(pb[j] * ieg); kt[j] = bfs(pkm[j] * ieg); rt[j] = bfs(pr[j] * eg); vt[j] = bfs(pv[j]);
                    if (pt == 63) gamC[pc0 + j] = eg; }
#define RW_PK4(x) (u32x4){(unsigned)x[0] | ((unsigned)x[1] << 16), (unsigned)x[2] | ((unsigned)x[3] << 16), (unsigned)x[4] | ((unsigned)x[5] << 16), (unsigned)x[6] | ((unsigned)x[7] << 16)}
                *(u32x4*)(At + pt * S64 + pc0) = RW_PK4(at); *(u32x4*)(Rt + pt * S64 + pc0) = RW_PK4(rt); *(u32x4*)(E + pt * S64 + pc0) = RW_PK4(bt); *(u32x4*)(E + (64 + pt) * S64 + pc0) = RW_PK4(kt);
#undef RW_PK4
#pragma unroll
                for (int j = 0; j < 8; ++j) { AM[(pc0 + j) * S64 + pt] = at[j]; ET[(pc0 + j) * S128 + pt] = bt[j]; ET[(pc0 + j) * S128 + 64 + pt] = kt[j]; X0T[(pc0 + j) * S128 + 64 + pt] = vt[j]; }
            }
            __syncthreads();
            mm<4, 8, 2>(At, S64, E, S64, wave, lane, [&](int, int r0, int col, f32x4 a) {
                const int i = col & 63;
#pragma unroll
                for (int j = 0; j < 4; ++j) { const float v = (i < r0 + j) ? a[j] : 0.f; if (col < 64) Lf[(r0 + j) * 65 + i] = v; else Mm[(r0 + j) * S64 + i] = bfs(v); } });
            mm<4, 8, 2>(Rt, S64, E, S64, wave, lane, [&](int, int r0, int col, f32x4 a) {
                const int i = col & 63;
#pragma unroll
                for (int j = 0; j < 4; ++j) NN[(r0 + j) * S128 + col] = bfs((i <= r0 + j) ? a[j] : 0.f); });
            __syncthreads();
            mm<4, 4, 2>(Mm, S64, X0T + 64, S128, wave, lane, [&](int, int r0, int col, f32x4 a) { st4(AM + (64 + col) * S64 + r0, (f32x4){-a[0], -a[1], -a[2], -a[3]}); });
            for (int e = tid; e < 64 * 64; e += 512) { const int t = e >> 6, i = e & 63; const float lv = Lf[t * 65 + i]; const int tb = t >> 4, ib = i >> 4;
                E[t * S64 + i] = ((tb == 1 && ib == 0) || (tb == 3 && ib == 2)) ? bfs(lv) : (bf16_t)0;
                E[(64 + t) * S64 + i] = (t >= 32 && i < 32) ? bfs(lv) : (bf16_t)0;
                Tm[t * S64 + i] = 0; X0T[t * S128 + i] = 0; }
            __syncthreads();
            if (wave < 4 && lane < 16) { const int bb = wave * 16; float x[16];
#pragma unroll
                for (int r = 0; r < 16; ++r) { float s = (r == lane) ? 1.f : 0.f;
#pragma unroll
                    for (int i = 0; i < r; ++i) s -= Lf[(bb + r) * 65 + bb + i] * x[i];
                    x[r] = s; }
#pragma unroll
                for (int r = 0; r < 16; ++r) { const unsigned short xv = bfs(x[r]); Tm[(bb + r) * S64 + bb + lane] = xv; X0T[(bb + lane) * S128 + bb + r] = xv; } }
            __syncthreads();
            mm<4, 4, 2>(E, S64, X0T, S128, wave, lane, [&](int, int r0, int col, f32x4 a) { st4(Mm + col * S64 + r0, a); });
            __syncthreads();
            mm<4, 4, 2>(Tm, S64, Mm, S64, wave, lane, [&](int, int r0, int col, f32x4 a) {
                const int tb = r0 >> 4, jb = col >> 4; if ((tb == 1 && jb == 0) || (tb == 3 && jb == 2)) st4(X0T + col * S128 + r0, (f32x4){-a[0], -a[1], -a[2], -a[3]}); });
            __syncthreads();
            { const int p = tid >> 8, tt = (tid >> 4) & 15, jj = tid & 15, t = 16 * (2 * p + 1) + tt, j = 32 * p + jj; Tm[t * S64 + j] = X0T[j * S128 + t]; }
            __syncthreads();
            mm<4, 4, 2>(E + 64 * S64, S64, X0T, S128, wave, lane, [&](int, int r0, int col, f32x4 a) { st4(Mm + col * S64 + r0, a); });
            __syncthreads();
            mm<4, 4, 2>(Tm, S64, Mm, S64, wave, lane, [&](int, int r0, int col, f32x4 a) {
                if (r0 >= 32 && col < 32) {
#pragma unroll
                    for (int j = 0; j < 4; ++j) E[(r0 + j) * S64 + col] = bfs(-a[j]); } });
            __syncthreads();
            for (int e = tid; e < 32 * 32; e += 512) { const int t = 32 + (e >> 5), j = e & 31; Tm[t * S64 + j] = E[t * S64 + j]; }
            __syncthreads();
            mm<4, 8, 2>(Tm, S64, AM, S64, wave, lane, [&](int, int r0, int col, f32x4 a) { if (col < 64) st4(WT + col * S64 + r0, a); else st4(X0T + (col - 64) * S128 + r0, a); });
            __syncthreads();
            f32x4 gt[2], y0t[2];
            mm<4, 4, 2>(WT, S64, ET, S128, wave, lane, [&](int, int r0, int col, f32x4 a) { const float gc = gamC[col];
                f32x4 p;
#pragma unroll
                for (int j = 0; j < 4; ++j) p[j] = (((r0 + j) == col ? 1.f : 0.f) - a[j]) * gc;
                st4(PT + col * S64 + r0, p); });
            mm<4, 4, 4>(X0T, S128, ET, S128, wave, lane, [&](int ti, int, int col, f32x4 a) { const float gc = gamC[col]; gt[ti] = a * gc; });
            mm<4, 4, 4>(NN, S128, X0T, S128, wave, lane, [&](int ti, int, int, f32x4 a) { y0t[ti] = a; });
            mm<4, 4, 2>(NN, S128, WT, S64, wave, lane, [&](int, int r0, int col, f32x4 a) {
#pragma unroll
                for (int j = 0; j < 4; ++j) Qh[(r0 + j) * S64 + col] = bfs(bf2f(Rt[(r0 + j) * S64 + col]) - a[j]); });
            __syncthreads();
            bf16_t* rslot = Z + row0 * ZW + h * 64; bf16_t* kslot = rslot + 1024;
            mm<4, 4, 2>(Qh, S64, Pc, S64, wave, lane, [&](int, int r0, int col, f32x4 a) {
                const int kt_ = col >> 5, rho = col & 31, s = rho >> 4, jj = ((rho >> 3) & 1) * 4 + (rho & 3), hh = (rho >> 2) & 1;
#pragma unroll
                for (int j = 0; j < 4; ++j) { const int t = 64 * c + r0 + j, tt_ = t >> 5, ln = 32 * hh + (t & 31); const int e = ((((tt_ * 2 + kt_) * 2 + s) * 64 + ln) << 3) + jj;
                    rslot[(size_t)(e >> 6) * ZW + (e & 63)] = bfs(a[j]); } });
            mm<4, 4, 2>(Qh, S64, Gc, S64, wave, lane, [&](int ti, int r0, int col, f32x4 a) {
                const int vt_ = col >> 5, v31 = col & 31;
#pragma unroll
                for (int j = 0; j < 4; ++j) { const int t = 64 * c + r0 + j, tt_ = t >> 5, x = t & 31, hh = (x >> 2) & 1, r = (x & 3) + 4 * (x >> 3); const int e = (((tt_ * 2 + vt_) * 64 + 32 * hh + v31) << 4) + r;
                    kslot[(size_t)(e >> 6) * ZW + (e & 63)] = bfs(a[j] + y0t[ti][j]); } });
            f32x4 pn[2], gn[2];
            mm<4, 4, 2>(Pc, S64, PT, S64, wave, lane, [&](int ti, int, int, f32x4 a) { pn[ti] = a; });
            mm<4, 4, 2>(Gc, S64, PT, S64, wave, lane, [&](int ti, int, int, f32x4 a) { gn[ti] = a + gt[ti]; });
            __syncthreads();
            { const int fr = lane & 15, g = lane >> 4;
#pragma unroll
              for (int ti = 0; ti < 2; ++ti) { const int tile = wave + 8 * ti, mt = tile >> 2, nt = tile & 3;
#pragma unroll
                  for (int j = 0; j < 4; ++j) { Pc[(mt * 16 + 4 * g + j) * S64 + nt * 16 + fr] = bfs(pn[ti][j]); Gc[(mt * 16 + 4 * g + j) * S64 + nt * 16 + fr] = bfs(gn[ti][j]); } } }
        }
        __syncthreads();
        { bf16_t* pg = PG + (size_t)u * 8192;
          { const int f = tid >> 6, ln = tid & 63, s = f & 1, kit = (f >> 1) & 1, kot = f >> 2, hh = ln >> 5, r31 = ln & 31; unsigned short w[8];
#pragma unroll
            for (int j = 0; j < 8; ++j) { const int rho = 16 * s + 8 * (j >> 2) + 4 * hh + (j & 3); w[j] = Pc[(32 * kit + rho) * S64 + 32 * kot + r31]; }
            *(u32x4*)(pg + (size_t)tid * 8) = (u32x4){(unsigned)w[0] | ((unsigned)w[1] << 16), (unsigned)w[2] | ((unsigned)w[3] << 16), (unsigned)w[4] | ((unsigned)w[5] << 16), (unsigned)w[6] | ((unsigned)w[7] << 16)}; }
          { const int tile = tid >> 7, ln = (tid >> 1) & 63, half = tid & 1, kot = tile >> 1, vt_ = tile & 1, hh = ln >> 5, v31 = ln & 31; unsigned short w[8];
#pragma unroll
            for (int q = 0; q < 8; ++q) { const int r = 8 * half + q; const int ko = 32 * kot + (r & 3) + 8 * (r >> 2) + 4 * hh; w[q] = Gc[(32 * vt_ + v31) * S64 + ko]; }
            *(u32x4*)(pg + 4096 + ((size_t)(tile * 64 + ln) << 4) + 8 * half) = (u32x4){(unsigned)w[0] | ((unsigned)w[1] << 16), (unsigned)w[2] | ((unsigned)w[3] << 16), (unsigned)w[4] | ((unsigned)w[5] << 16), (unsigned)w[6] | ((unsigned)w[7] << 16)}; } }
    }
    __syncthreads();
}

__device__ __forceinline__ void rwkv_stage_y(Frame& F) {
    if (F.vcu >= 64 || F.wave != 0) return;
    const int lane = F.lane, bh = F.vcu >> 1, vt = F.vcu & 1, b = bh >> 4, h = bh & 15;
    bf16_t* Z = (bf16_t*)(F.ws + WS_Z); const bf16_t* PG = (const bf16_t*)(F.ws + WS_PG);
    f32x16 X0, X1;
#pragma unroll
    for (int r = 0; r < 16; ++r) { X0[r] = 0.f; X1[r] = 0.f; }
#pragma unroll 1
    for (int blk = 0; blk < 64; ++blk) {
        const int u = blk * 32 + bh; const bf16_t* pg = PG + (size_t)u * 8192; const size_t row0 = (size_t)b * SEQ + (size_t)blk * 128;
        const bf16_t* rslot = Z + row0 * ZW + h * 64; bf16_t* kslot = Z + row0 * ZW + 1024 + h * 64;
        u32x4 xb[2][2];
#pragma unroll
        for (int s = 0; s < 2; ++s) {
            xb[0][s] = (u32x4){cvt_pk_bf16(X0[8 * s], X0[8 * s + 1]), cvt_pk_bf16(X0[8 * s + 2], X0[8 * s + 3]), cvt_pk_bf16(X0[8 * s + 4], X0[8 * s + 5]), cvt_pk_bf16(X0[8 * s + 6], X0[8 * s + 7])};
            xb[1][s] = (u32x4){cvt_pk_bf16(X1[8 * s], X1[8 * s + 1]), cvt_pk_bf16(X1[8 * s + 2], X1[8 * s + 3]), cvt_pk_bf16(X1[8 * s + 4], X1[8 * s + 5]), cvt_pk_bf16(X1[8 * s + 6], X1[8 * s + 7])}; }
        f32x16 n0, n1;
        { const bf16_t* gp = pg + 4096 + (((size_t)(0 * 2 + vt) * 64 + lane) << 4); const bf16x8 ga = ld8p(gp), gb = ld8p(gp + 8);
#pragma unroll
          for (int r = 0; r < 8; ++r) { n0[r] = bf2f((bf16_t)ga[r]); n0[8 + r] = bf2f((bf16_t)gb[r]); } }
        { const bf16_t* gp = pg + 4096 + (((size_t)(1 * 2 + vt) * 64 + lane) << 4); const bf16x8 ga = ld8p(gp), gb = ld8p(gp + 8);
#pragma unroll
          for (int r = 0; r < 8; ++r) { n1[r] = bf2f((bf16_t)ga[r]); n1[8 + r] = bf2f((bf16_t)gb[r]); } }
#pragma unroll
        for (int kit = 0; kit < 2; ++kit)
#pragma unroll
            for (int s = 0; s < 2; ++s) {
                const bf16x8 a0 = ld8p(pg + (((size_t)((0 * 2 + kit) * 2 + s) * 64 + lane) << 3)), a1 = ld8p(pg + (((size_t)((1 * 2 + kit) * 2 + s) * 64 + lane) << 3));
                n0 = __builtin_amdgcn_mfma_f32_32x32x16_bf16(a0, __builtin_bit_cast(bf16x8, xb[kit][s]), n0, 0, 0, 0);
                n1 = __builtin_amdgcn_mfma_f32_32x32x16_bf16(a1, __builtin_bit_cast(bf16x8, xb[kit][s]), n1, 0, 0, 0); }
#pragma unroll
        for (int tt = 0; tt < 4; ++tt) {
            const int e0 = ((tt * 2 + vt) * 64 + lane) << 4; bf16_t* yp = kslot + (size_t)(e0 >> 6) * ZW + (e0 & 63);
            const bf16x8 ya = ld8p(yp), yb = ld8p(yp + 8); f32x16 acc;
#pragma unroll
            for (int r = 0; r < 8; ++r) { acc[r] = bf2f((bf16_t)ya[r]); acc[8 + r] = bf2f((bf16_t)yb[r]); }
#pragma unroll
            for (int kt_ = 0; kt_ < 2; ++kt_)
#pragma unroll
                for (int s = 0; s < 2; ++s) { const int e = ((((tt * 2 + kt_) * 2 + s) * 64 + lane) << 3); const bf16x8 a = ld8p(rslot + (size_t)(e >> 6) * ZW + (e & 63));
                    acc = __builtin_amdgcn_mfma_f32_32x32x16_bf16(a, __builtin_bit_cast(bf16x8, xb[kt_][s]), acc, 0, 0, 0); }
            u32x4 w0 = {cvt_pk_bf16(acc[0], acc[1]), cvt_pk_bf16(acc[2], acc[3]), cvt_pk_bf16(acc[4], acc[5]), cvt_pk_bf16(acc[6], acc[7])};
            u32x4 w1 = {cvt_pk_bf16(acc[8], acc[9]), cvt_pk_bf16(acc[10], acc[11]), cvt_pk_bf16(acc[12], acc[13]), cvt_pk_bf16(acc[14], acc[15])};
            *(u32x4*)yp = w0; *(u32x4*)(yp + 8) = w1;
        }
        X0 = n0; X1 = n1;
    }
}

__device__ __forceinline__ void rwkv_stage_z(Frame& F, int li) {
    const int o = li >> 1, lane = F.lane, v31 = lane & 31, hh = lane >> 5;
    bf16_t* Z = (bf16_t*)(F.ws + WS_Z); const float* BON = (const float*)(F.ws + WS_BON);
    const float* lgp = F.in[24] + o * D; const float* lbp = F.in[25] + o * D;
#pragma unroll 1
    for (int w = F.vcu * 8 + F.wave; w < 8192; w += F.G * 8) {
        const int u = w >> 2, tt = w & 3, bh = u & 31, blk = u >> 5, b = bh >> 4, h = bh & 15; const size_t row0 = (size_t)b * SEQ + (size_t)blk * 128;
        const bf16_t* kslot = Z + row0 * ZW + 1024 + h * 64;
        float y[2][16];
#pragma unroll
        for (int vt = 0; vt < 2; ++vt) { const int e0 = ((tt * 2 + vt) * 64 + lane) << 4; const bf16_t* yp = kslot + (size_t)(e0 >> 6) * ZW + (e0 & 63); const bf16x8 ya = ld8p(yp), yb = ld8p(yp + 8);
#pragma unroll
            for (int r = 0; r < 8; ++r) { y[vt][r] = bf2f((bf16_t)ya[r]); y[vt][8 + r] = bf2f((bf16_t)yb[r]); } }
        const float lg0 = lgp[h * 64 + v31], lg1 = lgp[h * 64 + 32 + v31], lb0 = lbp[h * 64 + v31], lb1 = lbp[h * 64 + 32 + v31];
#pragma unroll
        for (int r = 0; r < 16; ++r) {
            float sm = y[0][r] + y[1][r];
            sm += __shfl_xor(sm, 1); sm += __shfl_xor(sm, 2); sm += __shfl_xor(sm, 4); sm += __shfl_xor(sm, 8); sm += __shfl_xor(sm, 16);
            const float mu = sm * (1.f / 64.f); const float d0 = y[0][r] - mu, d1 = y[1][r] - mu; float q = d0 * d0 + d1 * d1;
            q += __shfl_xor(q, 1); q += __shfl_xor(q, 2); q += __shfl_xor(q, 4); q += __shfl_xor(q, 8); q += __shfl_xor(q, 16);
            const float rsd = rsqrtf(q * (1.f / 64.f) + 64e-5f);
            const size_t row = row0 + 32 * tt + (r & 3) + 8 * (r >> 2) + 4 * hh; bf16_t* zp = Z + row * ZW + h * 64 + v31; const float bon = BON[row * 16 + h];
            const float va = bf2f(zp[2048]), vb = bf2f(zp[2048 + 32]), ga = bf2f(zp[3072]), gb = bf2f(zp[3072 + 32]);
            zp[3072] = (bf16_t)f2bf((d0 * rsd * lg0 + lb0 + bon * va) * siluf_(ga));
            zp[3072 + 32] = (bf16_t)f2bf((d1 * rsd * lg1 + lb1 + bon * vb) * siluf_(gb));
        }
    }
}

enum { PH_P0 = 0, PH_FINAL = 27, N_PHASES = 28 };
#define IN(k) (lo <= (k) && (k) < hi)
#if MK_MULTI
#define SEAM(k) do { } while (0)
#else
#define SEAM(k) do { if (IN(k) && IN((k) + 1)) xcd_barrier(bar); } while (0)
#endif
template <int LI>
__device__ __forceinline__ void run_layer(Frame& F, const XcdBarrier& bar, const int lo, const int hi, const int bx) {
    constexpr bool even = (LI & 1) == 0;
    constexpr int base = 1 + (LI / 2) * 13 + (even ? 0 : 6);
    bf16_t* Zp = (bf16_t*)(F.ws + WS_Z);
    if constexpr (even) {
        if (IN(base)) { F.retid(); pg8::StaticOrder S; S.init(64, 16, F.G, bx);
            pg8::Gemm g{(const bf16_t*)(F.ws + WS_HB), (const bf16_t*)(F.ws + WS_WIN)};
            EpiEvenIn E{Zp, F.ssq(LI), (bf16_t*)(F.ws + WS_VTA), (bf16_t*)(F.ws + WS_VTB), (bf16_t*)(F.ws + WS_KT)};
            pg8::gemm_phase<EpiEvenIn, true, D, D, 1 << 20, 0, 0>(F.lds, F.tid, g, S, E); }
        SEAM(base);
        if (IN(base + 1)) { F.retid();
            conv_wrest(F, LI);
            if constexpr (LI < 3) conv_win_odd(F, LI + 1);
            for (int u = F.vcu * 8 + F.wave; u < 4096; u += F.G * 8) ret_stage_a(F, u);
            for (int u = F.vcu * 8 + F.wave; u < 2048; u += F.G * 8) sb_unit(F, u >> 8, u & 255); }
        SEAM(base + 1);
        if (IN(base + 2)) { F.retid(); ret_stage_b(F); }
        SEAM(base + 2);
        if (IN(base + 3)) { F.retid(); const float* gng = F.in[8] + (LI >> 1) * 512;
            for (int u = F.vcu * 8 + F.wave; u < 2048; u += F.G * 8) ret_stage_c(F, u, gng); }
        SEAM(base + 3);
        if (IN(base + 4)) { F.retid(); pg8::StaticOrder S; S.init(64, 4, F.G, bx);
            { pg8::Gemm g{(const bf16_t*)(F.ws + WS_PB), (const bf16_t*)(F.ws + WS_WPROJ)};
              EpiStore E{Zp, ZE}; pg8::gemm_phase<EpiStore, false, PLE, PLE, 1 << 20, 0, 0>(F.lds, F.tid, g, S, E); }
            { pg8::Gemm g{Zp + 1024, (const bf16_t*)(F.ws + WS_WOUT)};
              EpiResid E{F.H, Zp + 1536, ZE}; pg8::gemm_phase<EpiResid, false, ZE, D, 8, (long)((2560 - 1024) * 2), 0>(F.lds, F.tid, g, S, E); } }
        SEAM(base + 4);
        if (IN(base + 5)) { F.retid(); pg8::StaticOrder S; S.init(64, 4, F.G, bx);
            pg8::Gemm g{Zp + 1536, (const bf16_t*)(F.ws + WS_WGATE)};
            EpiGate E{F.H, Zp, ZE, nullptr, F.ssq(LI + 1)};
            pg8::gemm_phase<EpiGate, false, ZE, D, 1 << 20, 0, 0>(F.lds, F.tid, g, S, E); }
        SEAM(base + 5);
    } else {
        if (IN(base)) { F.retid(); conv_lora2(F, LI); rows_norm(F, LI); }
        SEAM(base);
        if (IN(base + 1)) { F.retid(); pg8::StaticOrder S; S.init(64, 17, F.G, bx);
            pg8::Gemm g{(const bf16_t*)(F.ws + WS_HB) + D, (const bf16_t*)(F.ws + WS_WIN)};
            EpiOddIn E{Zp, (bf16_t*)(F.ws + WS_L1)}; pg8::gemm_phase<EpiOddIn, true, D, 2048, 16, -(long)(D * 2), (long)(D * 2)>(F.lds, F.tid, g, S, E); }
        SEAM(base + 1);
        if (IN(base + 2)) { F.retid();
            conv_wrest(F, LI);
            if constexpr (LI < 3) conv_win_even(F, LI + 1);
            __syncthreads();
            rwkv_stage_x(F, LI); }
        SEAM(base + 2);
        if (IN(base + 3)) { F.retid(); rwkv_stage_y(F); }
        SEAM(base + 3);
        if (IN(base + 4)) { F.retid(); rwkv_stage_z(F, LI); }
        SEAM(base + 4);
        if (IN(base + 5)) { F.retid(); pg8::StaticOrder S; S.init(64, 4, F.G, bx);
            { pg8::Gemm g{(const bf16_t*)(F.ws + WS_PB), (const bf16_t*)(F.ws + WS_WPROJ)};
              EpiStore E{Zp, ZW}; pg8::gemm_phase<EpiStore, false, PLE, PLE, 1 << 20, 0, 0>(F.lds, F.tid, g, S, E); }
            { pg8::Gemm g{Zp + 3072, (const bf16_t*)(F.ws + WS_WOUT)};
              EpiResid E{F.H, Zp + 2048, ZW}; pg8::gemm_phase<EpiResid, false, ZW, D, 1 << 20, 0, 0>(F.lds, F.tid, g, S, E); } }
        SEAM(base + 5);
        if (IN(base + 6)) { F.retid(); pg8::StaticOrder S; S.init(64, 4, F.G, bx);
            pg8::Gemm g{Zp + 2048, (const bf16_t*)(F.ws + WS_WGATE)};
            EpiGate E{F.H, Zp, ZW, (bf16_t*)(F.ws + WS_HB), F.ssq(LI + 1)};
            pg8::gemm_phase<EpiGate, false, ZW, D, 1 << 20, 0, 0>(F.lds, F.tid, g, S, E); }
        SEAM(base + 6);
    }
}
__global__ void __launch_bounds__(512, 2) mk_fwd(Args args) {
    extern __shared__ __attribute__((aligned(16))) unsigned char lds_raw[];
    Frame F;
    F.lds = (LAS unsigned char*)lds_raw; F.ldsg = lds_raw;
    F.tid = threadIdx.x; F.lane = F.tid & 63; F.wave = __builtin_amdgcn_readfirstlane(F.tid >> 6);
    F.G = gridDim.x; const int bx = blockIdx.x; F.vcu = (F.G % 8 == 0) ? (bx % 8) * (F.G / 8) + bx / 8 : bx;
    F.H = args.out; F.ws = args.ws;
    volatile LAS unsigned* MISC = (volatile LAS unsigned*)(F.lds + MISC_OFF);
    for (int u = F.tid; u < 128; u += 512) ((LAS unsigned*)(F.lds + MISC_OFF))[u] = 0u;
    __syncthreads();
    XcdBarrier bar; bar.bar = (unsigned*)(F.ws + WS_CTL) + 4096; bar.x = 0; bar.st = nullptr;
#if !MK_MULTI
    bar = xcd_barrier_post((unsigned*)(F.ws + WS_CTL) + 4096, MISC + 8);
#endif
    const int lo = args.ph_lo, hi = args.ph_hi;
    if (IN(PH_P0)) { F.retid(); rows_p0(F); conv_win_even(F, 0); }
#if !MK_MULTI
    if (IN(0) && IN(1)) { VM_WAIT(); cg::this_grid().sync(); }
#endif
    run_layer<0>(F, bar, lo, hi, bx);
    run_layer<1>(F, bar, lo, hi, bx);
    run_layer<2>(F, bar, lo, hi, bx);
    run_layer<3>(F, bar, lo, hi, bx);
    if (IN(PH_FINAL)) { F.retid(); rows_final(F); }
}

extern "C" void kernel_launch(void* const* d_in, const int* in_sizes, int n_in, void* d_out, int out_size, void* d_ws, size_t ws_size, hipStream_t stream) {
    static int grid = 0;
    if (grid == 0) {
        int dev = 0, cus = 0, per_cu = 0;
        (void)hipGetDevice(&dev); (void)hipDeviceGetAttribute(&cus, hipDeviceAttributeMultiprocessorCount, dev);
        (void)hipFuncSetAttribute((const void*)mk_fwd, hipFuncAttributeMaxDynamicSharedMemorySize, LDS_BYTES);
        (void)hipOccupancyMaxActiveBlocksPerMultiprocessor(&per_cu, (const void*)mk_fwd, 512, LDS_BYTES);
        if (per_cu < 1) per_cu = 1;
        grid = cus * 1;
        if (n_in != 26 || ws_size < WS_END) fprintf(stderr, "kernel_launch: unexpected n_in %d / ws %zu\n", n_in, ws_size);
        (void)hipGetLastError();
    }
    (void)hipMemsetAsync((char*)d_ws + WS_CTL, 0, CTL_BYTES, stream);
    Args a{};
    for (int i = 0; i < 26; ++i) a.in[i] = (const float*)d_in[i];
    a.out = (float*)d_out; a.ws = (unsigned char*)d_ws;
#if MK_MULTI
    for (int ph = 0; ph < N_PHASES; ++ph) { a.ph_lo = ph; a.ph_hi = ph + 1; hipLaunchKernelGGL(mk_fwd, dim3(grid), dim3(512), LDS_BYTES, stream, a); }
#else
    a.ph_lo = 0; a.ph_hi = N_PHASES;
    void* kargs[] = {&a};
    hipError_t e = hipLaunchCooperativeKernel((const void*)mk_fwd, dim3(grid), dim3(512), kargs, LDS_BYTES, stream);
    if (e != hipSuccess) fprintf(stderr, "cooperative launch failed: %s (grid %d)\n", hipGetErrorString(e), grid);
#endif
}
```

```cpp
#include <hip/hip_runtime.h>
#include <hip/hip_cooperative_groups.h>
#include <cstdint>
#include <cstdio>
namespace cg = cooperative_groups;

#ifndef MK_PROBE
#define MK_PROBE 0
#endif
#ifndef MK_TPA
#define MK_TPA -1
#define MK_TPB -1
#endif
#ifndef MK_XA
#define MK_XA -1
#define MK_XB -1
#endif
#ifndef MK_MULTI
#define MK_MULTI 0
#endif

#define LAS __attribute__((address_space(3)))
#define GAS __attribute__((address_space(1)))
typedef unsigned short bf16_t;
typedef short bf16x8 __attribute__((ext_vector_type(8)));
typedef float f32x4 __attribute__((ext_vector_type(4)));
typedef float f32x2 __attribute__((ext_vector_type(2)));
typedef unsigned u32x4 __attribute__((ext_vector_type(4)));
typedef unsigned u32x2 __attribute__((ext_vector_type(2)));

constexpr int D = 1024, BATCH = 2, SEQ = 8192, T = BATCH * SEQ, PLE = 256, ZW = 4096, ZE = 3072;
constexpr float QK_SCALE = 0.08838834764831845f;

__device__ __forceinline__ float bf2f(bf16_t v) { return __uint_as_float(((unsigned)v) << 16); }
__device__ __forceinline__ unsigned f2bf(float f) { unsigned u = __float_as_uint(f); return (u + 0x7fffu + ((u >> 16) & 1u)) >> 16; }
__device__ __forceinline__ unsigned pk2(float lo, float hi) { return f2bf(lo) | (f2bf(hi) << 16); }
typedef __bf16 bf16x2_t __attribute__((ext_vector_type(2)));
__device__ __forceinline__ unsigned cvt_pk_bf16(float lo, float hi) { f32x2 v = {lo, hi}; bf16x2_t b = __builtin_convertvector(v, bf16x2_t); return __builtin_bit_cast(unsigned, b); }
__device__ __forceinline__ float wave_sum(float v) {
#pragma unroll
    for (int o = 1; o < 64; o <<= 1) v += __shfl_xor(v, o);
    return v;
}
__device__ __forceinline__ float sigmoidf_(float x) { return 1.f / (1.f + __expf(-x)); }
__device__ __forceinline__ float siluf_(float x) { return x / (1.f + __expf(-x)); }
__device__ __forceinline__ float softplusf_(float x) { return x > 20.f ? x : log1pf(expf(x)); }
__device__ __forceinline__ float logsigf_(float x) { return -(x < -20.f ? -x : log1pf(expf(-x))); }
__device__ __forceinline__ float ssq_sum(const float* sq, int row) { const f32x4* p = (const f32x4*)(sq + (size_t)row * 16); const f32x4 a = p[0], b = p[1], c = p[2], d = p[3];
    return (((a[0] + a[1]) + (a[2] + a[3])) + ((b[0] + b[1]) + (b[2] + b[3]))) + (((c[0] + c[1]) + (c[2] + c[3])) + ((d[0] + d[1]) + (d[2] + d[3]))); }
#define LDS_WAIT() asm volatile("s_waitcnt lgkmcnt(0)" ::: "memory")
#define VM_WAIT() asm volatile("s_waitcnt vmcnt(0)" ::: "memory")

namespace pg8 {
constexpr int BM = 256, BK = 64, HALF = 128, HTB = HALF * BK * 2, STAGE_BYTES = 8 * HTB, NXCD = 8, WGM = 8;
__host__ __device__ __forceinline__ int lds_byte(int r, int c) { const int st = (r >> 4) * 2 + (c >> 5), rr = r & 15, cc = c & 31, ob = rr * 64 + cc * 2; return st * 1024 + (ob ^ (((ob >> 9) & 1) << 5)); }
__host__ __device__ __forceinline__ void stage_rc(int b, int& R, int& C) { const int st = b / 1024, sb = b % 1024, swz = sb ^ (((sb >> 9) & 1) << 5); R = (st >> 1) * 16 + swz / 64; C = (st & 1) * 32 + (swz % 64) / 2; }
__host__ __device__ __forceinline__ int perm32(int rho) { const int n = rho >> 4, i = rho & 15; return 8 * (i >> 2) + 4 * n + (i & 3); }
struct Unit { int pm, pn; };
struct Gemm { const bf16_t* A; const bf16_t* Bt; };
struct StaticOrder {
    int nM, nN, nwg, G, c;
    __device__ void init(int nM_, int nN_, int G_, int c_) { nM = nM_; nN = nN_; nwg = nM * nN; G = G_; c = c_; }
    __device__ bool next(int i, Unit& u) const {
        const long L = (long)i * G + c; if (L >= nwg) return false;
        int wgid = (int)L; { const int q = nwg / NXCD, r = nwg % NXCD, xcd = wgid % NXCD, off = wgid / NXCD; wgid = (xcd < r ? xcd * (q + 1) : r * (q + 1) + (xcd - r) * q) + off; }
        const int nig = WGM * nN, gid = wgid / nig, fm = gid * WGM, gsz = (nM - fm) < WGM ? (nM - fm) : WGM;
        u.pm = fm + ((wgid % nig) % gsz); u.pn = (wgid % nig) / gsz; return true;
    }
};
template <class Epi, bool ALIGN_EPI, int LDA, int KK, int TSPLIT, long ASHIFT, long BROW>
__device__ __forceinline__ void gemm_phase(LAS unsigned char* lds, const int tid_in, const Gemm g, const StaticOrder& S, const Epi& E) {
    int tid = tid_in; asm volatile("" : "+v"(tid));
    const int wid = __builtin_amdgcn_readfirstlane(tid >> 6), lane = tid & 63, wr = wid >> 2, wc = wid & 3, fr = lane & 15, fq = lane >> 4;
    constexpr int K = KK, nt = K / BK, lda = LDA, tsplit = TSPLIT; constexpr long ashift = ASHIFT;
    unsigned voffA[2], voffB[2];
#pragma unroll
    for (int i = 0; i < 2; ++i) { int R, C; stage_rc(tid * 16 + i * 8192, R, C); const int Rb = (R & ~31) + perm32(R & 31);
        voffA[i] = (unsigned)(R * lda + C) * 2u; voffB[i] = (unsigned)(Rb * K + C) * 2u; }
    constexpr size_t kstep = (size_t)(BK * 2);
    constexpr size_t hstepA = (size_t)HALF * lda * 2, hstepB = (size_t)HALF * K * 2, tstepA = 2 * hstepA, tstepB = 2 * hstepB;
    const unsigned ldsw = (unsigned)wid * 1024u;
    const int aoff = lds_byte(wr * 64 + fr, fq * 8), boff = lds_byte(wc * 32 + fr, fq * 8);
#define PG8_AP(base, tt) ((base) + (((tt) < tsplit) ? (long)(tt) * 128 : ashift + (long)((tt) - tsplit) * 128))
#define PG8_ABASE(u) ((const char*)g.A + (size_t)(u).pm * tstepA + ((BROW != 0 && (u).pm >= 32) ? BROW : 0))
#define PG8_SA(b, h) (((b) * 2 + (h)) * HTB)
#define PG8_SB(b, h) ((4 + (b) * 2 + (h)) * HTB)
#define PG8_STAGE(bufoff, gbase, voff) do { const char* _gb = (const char*)(gbase); asm volatile("" : "+s"(_gb)); _Pragma("unroll") for (int _i = 0; _i < 2; ++_i) \
        __builtin_amdgcn_global_load_lds((const unsigned*)(_gb + (voff)[_i]), (LAS unsigned*)(lds + (bufoff) + ldsw + _i * 8192), 16, 0, 0); } while (0)
#define PG8_LDA(dst, b, h) do { _Pragma("unroll") for (int m = 0; m < 4; ++m) _Pragma("unroll") for (int k = 0; k < 2; ++k) dst[m][k] = *(const LAS bf16x8*)(lds + PG8_SA(b, h) + aoff + m * 2048 + k * 1024); } while (0)
#define PG8_LDB(dst, b, h) do { _Pragma("unroll") for (int n = 0; n < 2; ++n) _Pragma("unroll") for (int k = 0; k < 2; ++k) dst[n][k] = *(const LAS bf16x8*)(lds + PG8_SB(b, h) + boff + n * 2048 + k * 1024); } while (0)
#define PG8_MMA(ai, bj, At, Bt) do { __builtin_amdgcn_s_setprio(1); _Pragma("unroll") for (int m = 0; m < 4; ++m) _Pragma("unroll") for (int n = 0; n < 2; ++n) _Pragma("unroll") for (int k = 0; k < 2; ++k) \
        acc[ai][bj][m][n] = __builtin_amdgcn_mfma_f32_16x16x32_bf16(Bt[n][k], At[m][k], acc[ai][bj][m][n], 0, 0, 0); __builtin_amdgcn_s_setprio(0); } while (0)
#define PG8_WAIT_V(n) asm volatile("s_waitcnt vmcnt(" #n ")" ::: "memory")
#define PG8_WAIT_L(n) asm volatile("s_waitcnt lgkmcnt(" #n ")" ::: "memory")
#define PG8_BAR __builtin_amdgcn_s_barrier()
#define PG8_SCHED __builtin_amdgcn_sched_barrier(0)
    Unit cur, nxt; int ui = 0;
    if (!S.next(0, cur)) return;
    f32x4 acc[2][2][4][2];
#pragma unroll
    for (int a = 0; a < 2; ++a)
#pragma unroll
        for (int b = 0; b < 2; ++b)
#pragma unroll
            for (int m = 0; m < 4; ++m)
#pragma unroll
                for (int n = 0; n < 2; ++n) acc[a][b][m][n] = (f32x4){0.f, 0.f, 0.f, 0.f};
    bf16x8 At[4][2], B0[2][2], B1[2][2];
    const char* cA = PG8_ABASE(cur); const char* cB = (const char*)g.Bt + (size_t)cur.pn * tstepB;
    {
        const char* a0 = PG8_AP(cA, 0); const char* a1 = PG8_AP(cA, 1);
        PG8_STAGE(PG8_SB(0, 0), cB, voffB); PG8_STAGE(PG8_SB(0, 1), cB + hstepB, voffB); PG8_STAGE(PG8_SA(0, 0), a0, voffA); PG8_STAGE(PG8_SA(0, 1), a0 + hstepA, voffA);
        if (wr == 1) PG8_BAR;
        PG8_WAIT_V(2); PG8_BAR;
        PG8_STAGE(PG8_SB(1, 0), cB + kstep, voffB); PG8_STAGE(PG8_SA(1, 0), a1, voffA); PG8_STAGE(PG8_SB(1, 1), cB + hstepB + kstep, voffB);
        PG8_WAIT_V(6); PG8_BAR;
    }
    for (;;) {
        const bool has_next = S.next(ui + 1, nxt);
        const char* nA = has_next ? PG8_ABASE(nxt) : cA; const char* nB = has_next ? (const char*)g.Bt + (size_t)nxt.pn * tstepB : cB;
        for (int t = 0; t < nt; t += 2) {
            const bool last = (t == nt - 2);
            const char* a1 = PG8_AP(cA, t + 1);
            const char* a2 = last ? PG8_AP(nA, 0) : PG8_AP(cA, t + 2); const char* b2 = last ? nB : cB + (size_t)(t + 2) * kstep;
            const char* a3 = last ? PG8_AP(nA, 1) : PG8_AP(cA, t + 3); const char* b3 = b2 + kstep;
            PG8_LDB(B0, 0, 0); PG8_LDB(B1, 0, 1); PG8_SCHED; PG8_LDA(At, 0, 0); PG8_STAGE(PG8_SA(1, 1), a1 + hstepA, voffA);
            PG8_WAIT_V(8); PG8_WAIT_L(0); PG8_BAR; PG8_MMA(0, 0, At, B0); PG8_MMA(0, 1, At, B1); PG8_BAR; PG8_SCHED;
            PG8_LDA(At, 0, 1); PG8_STAGE(PG8_SB(0, 0), b2, voffB); PG8_STAGE(PG8_SB(0, 1), b2 + hstepB, voffB); PG8_STAGE(PG8_SA(0, 0), a2, voffA);
            PG8_WAIT_V(8); PG8_WAIT_L(0); PG8_BAR; PG8_MMA(1, 0, At, B0); PG8_MMA(1, 1, At, B1); PG8_BAR; PG8_SCHED;
            PG8_LDB(B0, 1, 0); PG8_LDB(B1, 1, 1); PG8_SCHED; PG8_LDA(At, 1, 0); PG8_STAGE(PG8_SA(0, 1), a2 + hstepA, voffA);
            PG8_WAIT_V(8); PG8_WAIT_L(0); PG8_BAR; PG8_MMA(0, 0, At, B0); PG8_MMA(0, 1, At, B1); PG8_BAR; PG8_SCHED;
            PG8_LDA(At, 1, 1); PG8_STAGE(PG8_SB(1, 0), b3, voffB); PG8_STAGE(PG8_SB(1, 1), b3 + hstepB, voffB); PG8_STAGE(PG8_SA(1, 0), a3, voffA);
            PG8_WAIT_V(8); PG8_WAIT_L(0); PG8_BAR; PG8_MMA(1, 0, At, B0); PG8_MMA(1, 1, At, B1); PG8_BAR; PG8_SCHED;
        }
        if constexpr (ALIGN_EPI) { if (wr == 0) PG8_BAR; }
        E(acc, cur, wr, wc, fr, fq);
        if (!has_next) break;
#pragma unroll
        for (int a = 0; a < 2; ++a)
#pragma unroll
            for (int b = 0; b < 2; ++b)
#pragma unroll
                for (int m = 0; m < 4; ++m)
#pragma unroll
                    for (int n = 0; n < 2; ++n) acc[a][b][m][n] = (f32x4){0.f, 0.f, 0.f, 0.f};
        cur = nxt; cA = nA; cB = nB; ++ui;
        if constexpr (ALIGN_EPI) { if (wr == 1) PG8_BAR; }
    }
    PG8_WAIT_V(0);
    if constexpr (!ALIGN_EPI) { if (wr == 0) PG8_BAR; }
    PG8_BAR;
#undef PG8_AP
#undef PG8_ABASE
#undef PG8_SA
#undef PG8_SB
#undef PG8_STAGE
#undef PG8_LDA
#undef PG8_LDB
#undef PG8_MMA
#undef PG8_WAIT_V
#undef PG8_WAIT_L
#undef PG8_BAR
#undef PG8_SCHED
}
}

template <class Fn>
__device__ __forceinline__ void epi_for(const f32x4 (&acc)[2][2][4][2], const pg8::Unit& u, int wr, int wc, int fr, int fq, Fn fn) {
#pragma unroll
    for (int ai = 0; ai < 2; ++ai)
#pragma unroll
        for (int m = 0; m < 4; ++m) { const int row = u.pm * 256 + ai * 128 + wr * 64 + m * 16 + fr;
#pragma unroll
            for (int bj = 0; bj < 2; ++bj) { const int col = u.pn * 256 + bj * 128 + wc * 32 + 8 * fq; fn(row, col, acc[ai][bj][m][0], acc[ai][bj][m][1]); }
            if (m & 1) asm volatile("" ::: "memory"); }
}
__device__ __forceinline__ u32x4 pack8(f32x4 v0, f32x4 v1) { u32x4 w; w.x = cvt_pk_bf16(v0[0], v0[1]); w.y = cvt_pk_bf16(v0[2], v0[3]); w.z = cvt_pk_bf16(v1[0], v1[1]); w.w = cvt_pk_bf16(v1[2], v1[3]); return w; }

struct EpiEvenIn {
    bf16_t* Z; const float* ssq; bf16_t* VTa; bf16_t* VTb; bf16_t* KT;
    __device__ __forceinline__ void operator()(const f32x4 (&acc)[2][2][4][2], const pg8::Unit& u, int wr, int wc, int fr, int fq) const {
        const int g = u.pn >> 1;
        epi_for(acc, u, wr, wc, fr, fq, [&](int row, int col, f32x4 v0, f32x4 v1) {
            const float rs = rsqrtf(ssq_sum(ssq, row) * (1.f / D) + 1e-6f);
            v0 = v0 * rs; v1 = v1 * rs;
            const int cg = col & 511, t = row & (SEQ - 1), b = row >> 13;
            if (g == 2 || g == 6) {
                bf16_t* p = (g == 2 ? VTa : VTb) + ((size_t)(b * 512 + cg)) * SEQ + t;
                _Pragma("unroll") for (int j = 0; j < 4; ++j) { p[(size_t)j * SEQ] = (bf16_t)f2bf(v0[j]); p[(size_t)(4 + j) * SEQ] = (bf16_t)f2bf(v1[j]); }
            } else if (g < 2) {
                const float pos = (float)t; const int i0 = (cg & 127) >> 1;
                float o[8] = {v0[0], v0[1], v0[2], v0[3], v1[0], v1[1], v1[2], v1[3]};
                _Pragma("unroll") for (int j = 0; j < 4; ++j) { const float inv = exp2f(-(float)(i0 + j) * (13.287712379549449f / 64.f));
                    float rev = pos * inv * 0.15915494309189535f; rev = rev - floorf(rev); const float sn = __builtin_amdgcn_sinf(rev), cs = __builtin_amdgcn_cosf(rev);
                    const float x1 = o[2 * j], x2 = o[2 * j + 1]; o[2 * j] = x1 * cs - x2 * sn; o[2 * j + 1] = x1 * sn + x2 * cs; }
                const float lg2 = log2f(1.f - exp2f(-5.f - (float)(cg >> 7))); const float ip1 = (float)((t & 127) + 1);
                if (g == 0) { const float f = exp2f(ip1 * lg2);
                    *(u32x4*)(Z + (size_t)row * ZE + cg) = pack8((f32x4){o[0] * f, o[1] * f, o[2] * f, o[3] * f}, (f32x4){o[4] * f, o[5] * f, o[6] * f, o[7] * f}); }
                else { const float f = exp2f(-ip1 * lg2), f2 = exp2f((128.f - ip1) * lg2);
                    *(u32x4*)(Z + (size_t)row * ZE + 512 + cg) = pack8((f32x4){o[0] * f, o[1] * f, o[2] * f, o[3] * f}, (f32x4){o[4] * f, o[5] * f, o[6] * f, o[7] * f});
                    bf16_t* p = KT + ((size_t)(b * 512 + cg)) * SEQ + t;
                    _Pragma("unroll") for (int j = 0; j < 8; ++j) p[(size_t)j * SEQ] = (bf16_t)f2bf(o[j] * f2); }
            } else {
                const int zc = (g - 1 - (g > 6 ? 1 : 0)) * 512;
                *(u32x4*)(Z + (size_t)row * ZE + zc + cg) = pack8(v0, v1);
            }
        });
    }
};
struct EpiOddIn {
    bf16_t* Z; bf16_t* L1;
    __device__ __forceinline__ void operator()(const f32x4 (&acc)[2][2][4][2], const pg8::Unit& u, int wr, int wc, int fr, int fq) const {
        if (u.pn < 16) { epi_for(acc, u, wr, wc, fr, fq, [&](int row, int col, f32x4 v0, f32x4 v1) { *(u32x4*)(Z + (size_t)row * ZW + col) = pack8(v0, v1); }); }
        else { epi_for(acc, u, wr, wc, fr, fq, [&](int row, int col, f32x4 v0, f32x4 v1) { const int c = col - 4096; if (c < 64) {
                    _Pragma("unroll") for (int j = 0; j < 4; ++j) { v0[j] = tanhf(v0[j]); v1[j] = tanhf(v1[j]); } }
                *(u32x4*)(L1 + (size_t)row * 256 + c) = pack8(v0, v1); }); }
    }
};
struct EpiResid {
    float* H; bf16_t* HB; int ldb;
    __device__ __forceinline__ void operator()(const f32x4 (&acc)[2][2][4][2], const pg8::Unit& u, int wr, int wc, int fr, int fq) const {
        epi_for(acc, u, wr, wc, fr, fq, [&](int row, int col, f32x4 v0, f32x4 v1) { float* hp = H + (size_t)row * D + col; f32x4 h0 = *(const f32x4*)hp, h1 = *(const f32x4*)(hp + 4); h0 = h0 + v0; h1 = h1 + v1;
            *(f32x4*)hp = h0; *(f32x4*)(hp + 4) = h1; *(u32x4*)(HB + (size_t)row * ldb + col) = pack8(h0, h1); });
    }
};
struct EpiStore {
    bf16_t* O; int ldc;
    __device__ __forceinline__ void operator()(const f32x4 (&acc)[2][2][4][2], const pg8::Unit& u, int wr, int wc, int fr, int fq) const {
        epi_for(acc, u, wr, wc, fr, fq, [&](int row, int col, f32x4 v0, f32x4 v1) { *(u32x4*)(O + (size_t)row * ldc + col) = pack8(v0, v1); });
    }
};
struct EpiGate {
    float* H; const bf16_t* PP; int ldp; bf16_t* HB2; float* ssq;
    __device__ __forceinline__ void operator()(const f32x4 (&acc)[2][2][4][2], const pg8::Unit& u, int wr, int wc, int fr, int fq) const {
#pragma unroll
        for (int ai = 0; ai < 2; ++ai)
#pragma unroll
            for (int m = 0; m < 4; ++m) { const int row = u.pm * 256 + ai * 128 + wr * 64 + m * 16 + fr; float sq = 0.f;
#pragma unroll
                for (int bj = 0; bj < 2; ++bj) { const int col = u.pn * 256 + bj * 128 + wc * 32 + 8 * fq; const f32x4 v0 = acc[ai][bj][m][0], v1 = acc[ai][bj][m][1];
                    float* hp = H + (size_t)row * D + col; f32x4 h0 = *(const f32x4*)hp, h1 = *(const f32x4*)(hp + 4); const u32x4 pw = *(const u32x4*)(PP + (size_t)row * ldp + col);
                    const unsigned pwv[4] = {pw.x, pw.y, pw.z, pw.w};
                    float pp[8];
#pragma unroll
                    for (int j = 0; j < 4; ++j) { pp[2 * j] = __uint_as_float(pwv[j] << 16); pp[2 * j + 1] = __uint_as_float(pwv[j] & 0xffff0000u); }
#pragma unroll
                    for (int j = 0; j < 4; ++j) { h0[j] += sigmoidf_(v0[j]) * pp[j]; h1[j] += sigmoidf_(v1[j]) * pp[4 + j]; sq += h0[j] * h0[j] + h1[j] * h1[j]; }
                    *(f32x4*)hp = h0; *(f32x4*)(hp + 4) = h1; if (HB2) *(u32x4*)(HB2 + (size_t)row * D + col) = pack8(h0, h1); }
                sq += __shfl_xor(sq, 16); sq += __shfl_xor(sq, 32);
                if (fq == 0) ssq[(size_t)row * 16 + u.pn * 4 + wc] = sq;
                if (m & 1) asm volatile("" ::: "memory"); }
    }
};

#define XB_TMO      128
#define XB_XCNT(j)  (256  + 64 * (j))
#define XB_XSUB(j)  (1280 + 64 * (j))
#define XB_XGEN(j)  (2304 + 64 * (j))
#define XB_TOP      3328
#define XB_TOPGEN   3392
#define XCD_BAR_WORDS 3456
#define XB_SPIN_CAP (1u << 22)
__device__ __forceinline__ unsigned xb_ld(unsigned* p)              { return __hip_atomic_load(p, __ATOMIC_RELAXED, __HIP_MEMORY_SCOPE_AGENT); }
__device__ __forceinline__ unsigned xb_add(unsigned* p, unsigned v) { return __hip_atomic_fetch_add(p, v, __ATOMIC_RELAXED, __HIP_MEMORY_SCOPE_AGENT); }
__device__ __forceinline__ unsigned xb_xcc_id() { return (unsigned)__builtin_amdgcn_s_getreg((3 << 11) | 20) & 0xFu; }
#define XB_SPIN(cond, bar) do { unsigned _sp = 0; while (cond) { __builtin_amdgcn_s_sleep(1); \
    if ((++_sp & 255u) == 0u) { if (xb_ld(&(bar)[XB_TMO])) break; if (_sp > XB_SPIN_CAP) { atomicAdd(&(bar)[XB_TMO], 1u); break; } } } } while (0)
struct XcdBarrier { unsigned* bar; unsigned x; volatile LAS unsigned* st; };
__device__ __forceinline__ XcdBarrier xcd_barrier_post(unsigned* bar, volatile LAS unsigned* st) {
    XcdBarrier b; b.bar = bar; b.x = xb_xcc_id(); b.st = st;
    if (threadIdx.x == 0) (void)xb_add(&bar[XB_XCNT(b.x)], 1u);
    return b;
}
__device__ __forceinline__ void xcd_barrier_complete(unsigned* bar, unsigned x, unsigned& nloc, unsigned& nx) {
    const unsigned G = gridDim.x * gridDim.y * gridDim.z;
    unsigned sum, cnt, mine, sp = 0u;
    for (;;) {
        sum = 0u; cnt = 0u; mine = 0u;
#pragma unroll
        for (unsigned j = 0; j < 16; ++j) { const unsigned c = xb_ld(&bar[XB_XCNT(j)]); sum += c; cnt += (c > 0u) ? 1u : 0u; mine = (j == x) ? c : mine; }
        if (sum == G) break;
        __builtin_amdgcn_s_sleep(1);
        if ((++sp & 255u) == 0u) { if (xb_ld(&bar[XB_TMO])) break; if (sp > XB_SPIN_CAP) { atomicAdd(&bar[XB_TMO], 1u); break; } }
    }
    nloc = mine > 0u ? mine : 1u; nx = cnt > 0u ? cnt : 1u;
}
__device__ __forceinline__ void xcd_barrier(const XcdBarrier& b_in) {
    asm volatile("s_waitcnt vmcnt(0)" ::: "memory");
    __syncthreads();
    if (threadIdx.x == 0) {
        const XcdBarrier& b = b_in;
        unsigned* bar = b.bar;
        __builtin_amdgcn_s_waitcnt(0);
        unsigned nloc = b.st[0], nx = b.st[1];
        if (nloc == 0u) { xcd_barrier_complete(bar, b.x, nloc, nx); b.st[0] = nloc; b.st[1] = nx; }
        const unsigned old = xb_add(&bar[XB_XSUB(b.x)], 1u);
        const unsigned gen = old / nloc;
        if (old + 1u == (gen + 1u) * nloc) {
            __builtin_amdgcn_fence(__ATOMIC_RELEASE, "agent");
            asm volatile("s_waitcnt vmcnt(0)" ::: "memory");
            const unsigned og = xb_add(&bar[XB_TOP], 1u);
            const unsigned tg = og / nx;
            if (og + 1u == (tg + 1u) * nx) xb_add(&bar[XB_TOPGEN], 1u);
            else XB_SPIN(xb_ld(&bar[XB_TOPGEN]) == tg, bar);
            __builtin_amdgcn_fence(__ATOMIC_ACQUIRE, "agent");
            xb_add(&bar[XB_XGEN(b.x)], 1u);
            asm volatile("s_waitcnt vmcnt(0)" ::: "memory");
        } else {
            XB_SPIN(xb_ld(&bar[XB_XGEN(b.x)]) == gen, bar);
            __builtin_amdgcn_fence(__ATOMIC_ACQUIRE, "agent");
            asm volatile("s_waitcnt vmcnt(0)" ::: "memory");
        }
    }
    __syncthreads();
}

constexpr size_t MiB = 1u << 20;
constexpr size_t WS_CTL = 0, CTL_BYTES = 1 * MiB;
constexpr size_t WS_SSQ = 241 * (size_t)(1u << 20);
constexpr size_t WS_WIN = 2 * MiB;
constexpr size_t WS_WOUT = 19 * MiB, WS_WGATE = 21 * MiB, WS_WPROJ = 23 * MiB;
constexpr size_t WS_PB = 24 * MiB;
constexpr size_t WS_Z = 32 * MiB;
constexpr size_t WS_HB = 160 * MiB;
constexpr size_t WS_VF = 193 * MiB;
constexpr size_t WS_L1 = 225 * MiB;
constexpr size_t WS_VTA = 128 * MiB;
constexpr size_t WS_VTB = 144 * MiB;
constexpr size_t WS_KT = 225 * MiB;
constexpr size_t WS_LORA2 = 23 * MiB + 512 * 1024;
constexpr size_t WS_PG = 160 * MiB;
constexpr size_t WS_BON = 233 * MiB;
constexpr size_t WS_ST = 176 * MiB;
constexpr size_t WS_KV = 160 * MiB;
constexpr size_t WS_END = 256 * MiB;

constexpr int RING_BYTES = 131072, LDS_BYTES = 163840, MISC_OFF = LDS_BYTES - 512;

struct Args { const float* in[26]; float* out; unsigned char* ws; int ph_lo, ph_hi; };

__device__ __forceinline__ const float* inptr(int i) { asm volatile("" : "+s"(i)); const char* ka = (const char*)__builtin_amdgcn_kernarg_segment_ptr(); return *(const float* const*)(ka + 8 * i); }
struct InTab { __device__ __forceinline__ const float* operator[](int i) const { return inptr(i); } };
struct Frame {
    LAS unsigned char* lds; unsigned char* ldsg;
    int tid, lane, wave, G, vcu;
    InTab in; float* H; unsigned char* ws;
    __device__ __forceinline__ void retid() { int l; asm volatile("v_mbcnt_lo_u32_b32 %0, -1, 0\n\tv_mbcnt_hi_u32_b32 %0, -1, %0" : "=v"(l)); lane = l; tid = wave * 64 + l; }
    __device__ __forceinline__ float* ssq(int l) const { return (float*)(ws + WS_SSQ) + (size_t)l * T * 16; }
};

__device__ __forceinline__ void conv_item(const float* W, int ldw, int Kmax, int k0, int n0, bf16_t* dst, int ldd, int dr0, int drs, int dk0,
                                          const float* svec, float sa, float sb, float sc, LAS float* scr, int lane) {
#pragma unroll 8
    for (int i = 0; i < 32; ++i) { const int kk = 2 * i + (lane >> 5), k = k0 + kk; float v = 0.f;
        if (k < Kmax) { const float f = (sa + sb * (svec ? svec[k] : 0.f)) * sc; v = W[(size_t)k * ldw + n0 + (lane & 31)] * f; }
        scr[kk * 33 + (lane & 31)] = v; }
    LDS_WAIT(); asm volatile("" ::: "memory");
    const int c = lane & 7;
    if (k0 + 8 * c < Kmax) {
#pragma unroll
        for (int j = 0; j < 4; ++j) { const int n = (lane >> 3) + 8 * j; const LAS float* s = scr + (8 * c) * 33 + n;
            u32x4 o; o.x = pk2(s[0 * 33], s[1 * 33]); o.y = pk2(s[2 * 33], s[3 * 33]); o.z = pk2(s[4 * 33], s[5 * 33]); o.w = pk2(s[6 * 33], s[7 * 33]);
            *(GAS u32x4*)(dst + (size_t)(dr0 + n * drs) * ldd + dk0 + k0 + 8 * c) = o; }
    }
    LDS_WAIT(); asm volatile("" ::: "memory");
}
__device__ __forceinline__ void conv_win_even(Frame& F, int li) {
    const int e = li >> 1; const float* W = F.in[6] + (size_t)e * D * ZW; const float* gain = F.in[2] + li * D; bf16_t* dst = (bf16_t*)(F.ws + WS_WIN);
    LAS float* scr = (LAS float*)(F.lds + F.wave * 16384);
    const int gw = F.vcu * 8 + F.wave, NGW = F.G * 8;
    for (int it = gw; it < 16 * 128; it += NGW) { const int kb = it >> 7, nb = it & 127, n0 = nb * 32, g = n0 >> 9, hh = (n0 & 511) >> 7, d0 = n0 & 127;
        int dr0 = n0, drs = 1; if (g < 2) { dr0 = g * 512 + hh * 128 + (d0 < 64 ? 2 * d0 : 2 * (d0 - 64) + 1); drs = 2; }
        const float sc = (g == 1 || g == 5) ? QK_SCALE : 1.f;
        conv_item(W, ZW, D, kb * 64, n0, dst, D, dr0, drs, 0, gain, 0.f, 1.f, sc, scr, F.lane); }
}
__device__ __forceinline__ void conv_win_odd(Frame& F, int li) {
    const int o = li >> 1; const float* mu = F.in[9] + (size_t)o * 6 * D; bf16_t* dst = (bf16_t*)(F.ws + WS_WIN);
    LAS float* scr = (LAS float*)(F.lds + F.wave * 16384);
    const int gw = F.vcu * 8 + F.wave, NGW = F.G * 8;
    for (int it = gw; it < 4 * 2 * 512; it += NGW) { const int p = it >> 10, half = (it >> 9) & 1, r = it & 511, kb = r >> 5, nb = r & 31;
        const float* W = F.in[10] + ((size_t)o * 4 + p) * D * D;
        conv_item(W, D, D, kb * 64, nb * 32, dst, 2048, p * 1024 + nb * 32, 1, half * 1024, mu + p * D, half ? 0.f : 1.f, half ? 1.f : -1.f, 1.f, scr, F.lane); }
    for (int it = gw; it < 2 * (32 + 32 + 16); it += NGW) { const int half = it / 80, r = it % 80; const float* W; int ldw, n0, dr0, mi, kb;
        if (r < 32) { W = F.in[13] + (size_t)o * D * 64; ldw = 64; kb = r >> 1; n0 = (r & 1) * 32; dr0 = 4096 + n0; mi = 4; }
        else if (r < 64) { const int q = r - 32; W = F.in[16] + (size_t)o * D * 64; ldw = 64; kb = q >> 1; n0 = (q & 1) * 32; dr0 = 4160 + n0; mi = 5; }
        else { const int q = r - 64; W = F.in[19]; ldw = 32; kb = q; n0 = 0; dr0 = 4224; mi = 2; }
        const float sc = (r >= 64 && o == 0) ? 0.f : 1.f;
        conv_item(W, ldw, D, kb * 64, n0, dst, 2048, dr0, 1, half * 1024, mu + mi * D, half ? 0.f : 1.f, half ? 1.f : -1.f, sc, scr, F.lane); }
    { u32x4 z = {0u, 0u, 0u, 0u}; GAS u32x4* zp = (GAS u32x4*)(dst + (size_t)4256 * 2048); const int n16 = 96 * 2048 * 2 / 16;
      for (int i = (F.vcu * 512 + F.tid); i < n16; i += F.G * 512) zp[i] = z; }
}
__device__ __forceinline__ void conv_wrest(Frame& F, int li) {
    const bool even = (li & 1) == 0; const int e = li >> 1;
    const float* Wo = even ? F.in[7] + (size_t)e * D * D : F.in[11] + (size_t)e * D * D;
    const float* Wg = F.in[5] + (size_t)li * D * D; const float* Wp = F.in[4] + (size_t)li * PLE * D;
    LAS float* scr = (LAS float*)(F.lds + F.wave * 16384);
    const int gw = F.vcu * 8 + F.wave, NGW = F.G * 8;
    for (int it = gw; it < 512 + 512 + 128; it += NGW) {
        if (it < 512) conv_item(Wo, D, D, (it >> 5) * 64, (it & 31) * 32, (bf16_t*)(F.ws + WS_WOUT), D, (it & 31) * 32, 1, 0, nullptr, 1.f, 0.f, 1.f, scr, F.lane);
        else if (it < 1024) { const int r = it - 512; conv_item(Wg, D, D, (r >> 5) * 64, (r & 31) * 32, (bf16_t*)(F.ws + WS_WGATE), D, (r & 31) * 32, 1, 0, nullptr, 1.f, 0.f, 1.f, scr, F.lane); }
        else { const int r = it - 1024; conv_item(Wp, D, PLE, (r >> 5) * 64, (r & 31) * 32, (bf16_t*)(F.ws + WS_WPROJ), PLE, (r & 31) * 32, 1, 0, nullptr, 1.f, 0.f, 1.f, scr, F.lane); }
    }
    const float* P = F.in[1] + (size_t)li * T * PLE; GAS u32x4* pb = (GAS u32x4*)(F.ws + WS_PB); const int n8 = T * PLE / 8;
    for (int i = F.vcu * 512 + F.tid; i < n8; i += F.G * 512) { const f32x4 a = *(const f32x4*)(P + (size_t)i * 8), b = *(const f32x4*)(P + (size_t)i * 8 + 4);
        u32x4 o; o.x = pk2(a[0], a[1]); o.y = pk2(a[2], a[3]); o.z = pk2(b[0], b[1]); o.w = pk2(b[2], b[3]); pb[i] = o; }
}

__device__ __forceinline__ void conv_lora2(Frame& F, int li) {
    const int o = li >> 1; LAS float* scr = (LAS float*)(F.lds + F.wave * 16384);
    bf16_t* W2T = (bf16_t*)(F.ws + WS_LORA2); bf16_t* A2T = W2T + 1024 * 64; bf16_t* V2T = A2T + 1024 * 64;
    const int gw = F.vcu * 8 + F.wave, NGW = F.G * 8;
    for (int it = gw; it < 96; it += NGW) {
        if (it < 32) conv_item(F.in[14] + (size_t)o * 64 * D, D, 64, 0, it * 32, W2T, 64, it * 32, 1, 0, nullptr, 1.f, 0.f, 1.f, scr, F.lane);
        else if (it < 64) conv_item(F.in[17] + (size_t)o * 64 * D, D, 64, 0, (it - 32) * 32, A2T, 64, (it - 32) * 32, 1, 0, nullptr, 1.f, 0.f, 1.f, scr, F.lane);
        else conv_item(F.in[20], D, 32, 0, (it - 64) * 32, V2T, 32, (it - 64) * 32, 1, 0, nullptr, 1.f, 0.f, 1.f, scr, F.lane);
    }
}
__device__ __forceinline__ void rows_p0(Frame& F) {
    const float* x = F.in[0]; bf16_t* HB = (bf16_t*)(F.ws + WS_HB); float* s0 = F.ssq(0);
    for (int row = F.vcu * 8 + F.wave; row < T; row += F.G * 8) {
        const f32x4* xr = (const f32x4*)(x + (size_t)row * D) + F.lane; f32x4* hr = (f32x4*)(F.H + (size_t)row * D) + F.lane; u32x2* br = (u32x2*)(HB + (size_t)row * D) + F.lane; float s = 0.f;
#pragma unroll
        for (int j = 0; j < 4; ++j) { const f32x4 v = xr[64 * j]; s += (v[0] * v[0] + v[1] * v[1]) + (v[2] * v[2] + v[3] * v[3]); hr[64 * j] = v; u32x2 w; w.x = pk2(v[0], v[1]); w.y = pk2(v[2], v[3]); br[64 * j] = w; }
        s = wave_sum(s); if (F.lane < 16) s0[(size_t)row * 16 + F.lane] = F.lane == 0 ? s : 0.f;
    }
}
__device__ __forceinline__ void rows_norm(Frame& F, int li) {
    const float* gain = F.in[2] + li * D; bf16_t* HN = (bf16_t*)(F.ws + WS_HB); const float* sq = F.ssq(li);
    f32x4 g[4];
#pragma unroll
    for (int j = 0; j < 4; ++j) g[j] = *((const f32x4*)gain + F.lane + 64 * j);
    for (int row = F.vcu * 8 + F.wave; row < T; row += F.G * 8) {
        const f32x4* hr = (const f32x4*)(F.H + (size_t)row * D) + F.lane; u32x2* br = (u32x2*)(HN + (size_t)(row + 1 + (row >= SEQ ? 1 : 0)) * D) + F.lane;
        const float rs = rsqrtf(ssq_sum(sq, row) * (1.f / D) + 1e-6f);
#pragma unroll
        for (int j = 0; j < 4; ++j) { const f32x4 v = hr[64 * j] * rs * g[j]; u32x2 w; w.x = pk2(v[0], v[1]); w.y = pk2(v[2], v[3]); br[64 * j] = w; }
    }
    if (F.vcu == 0 && F.wave < 2) { u32x2* br = (u32x2*)(HN + (size_t)(F.wave ? SEQ + 1 : 0) * D) + F.lane; u32x2 z = {0u, 0u};
#pragma unroll
        for (int j = 0; j < 4; ++j) br[64 * j] = z; }
}
__device__ __forceinline__ void rows_final(Frame& F) {
    const float* gain = F.in[3]; const float* sq = F.ssq(4);
    f32x4 g[4];
#pragma unroll
    for (int j = 0; j < 4; ++j) g[j] = *((const f32x4*)gain + F.lane + 64 * j);
    for (int row = F.vcu * 8 + F.wave; row < T; row += F.G * 8) {
        f32x4* hr = (f32x4*)(F.H + (size_t)row * D) + F.lane; const float rs = rsqrtf(ssq_sum(sq, row) * (1.f / D) + 1e-6f);
#pragma unroll
        for (int j = 0; j < 4; ++j) hr[64 * j] = hr[64 * j] * rs * g[j];
    }
}

typedef float f32x16 __attribute__((ext_vector_type(16)));
template <bool DUMMY>
__device__ __forceinline__ void sb_unit(Frame& F, int bh, int qb) {
    const int lane = F.lane, l31 = lane & 31, hi = lane >> 5, b = bh >> 2, h = bh & 3;
    bf16_t* Z = (bf16_t*)(F.ws + WS_Z); const bf16_t* VT = (const bf16_t*)(F.ws + WS_VTB) + (size_t)bh * 128 * SEQ;
    const size_t rowb = (size_t)b * SEQ; const int q0 = qb * 32, tq = q0 + l31;
    bf16x8 qr[8];
    { const bf16_t* qp = Z + (rowb + tq) * ZE + 1536 + h * 128 + hi * 8;
#pragma unroll
      for (int ks = 0; ks < 8; ++ks) qr[ks] = *(const bf16x8*)(qp + 16 * ks); }
    f32x16 o[4];
#pragma unroll
    for (int d = 0; d < 4; ++d)
#pragma unroll
        for (int r = 0; r < 16; ++r) o[d][r] = 0.f;
    float carry = 1.f;
    const int pi = 16 * ((l31 >> 2) & 1) + (l31 & 3) + 4 * (l31 >> 3);
    const bf16_t* Kb = Z + rowb * ZE + 2048 + h * 128 + hi * 8;
    for (int kt = (q0 + 31) >> 6; kt >= 0; --kt) {
        const int kbase = kt * 64;
        const bf16_t* kp0 = Kb + (size_t)(kbase + pi) * ZE; const bf16_t* kp1 = kp0 + (size_t)32 * ZE;
        f32x16 p0, p1;
#pragma unroll
        for (int r = 0; r < 16; ++r) { p0[r] = 0.f; p1[r] = 0.f; }
#pragma unroll
        for (int ks = 0; ks < 8; ++ks) { const bf16x8 a0 = *(const bf16x8*)(kp0 + 16 * ks), a1 = *(const bf16x8*)(kp1 + 16 * ks);
            p0 = __builtin_amdgcn_mfma_f32_32x32x16_bf16(a0, qr[ks], p0, 0, 0, 0); p1 = __builtin_amdgcn_mfma_f32_32x32x16_bf16(a1, qr[ks], p1, 0, 0, 0); }
        float f1 = 1.f, f0 = 1.f;
        const int k1 = kbase + 32 + 16 * hi, k0 = kbase + 16 * hi;
#pragma unroll
        for (int r = 15; r >= 0; --r) { const float z = fminf(p1[r], 80.f); const float e = exp2f(z * 1.4426950408889634f); float rd = __builtin_amdgcn_rcpf(1.f + e); float be = e * rd;
            const bool valid = (k1 + r) < tq; be = valid ? be : 0.f; rd = valid ? rd : 1.f; p1[r] = be * f1; f1 *= rd; }
#pragma unroll
        for (int r = 15; r >= 0; --r) { const float z = fminf(p0[r], 80.f); const float e = exp2f(z * 1.4426950408889634f); float rd = __builtin_amdgcn_rcpf(1.f + e); float be = e * rd;
            const bool valid = (k0 + r) < tq; be = valid ? be : 0.f; rd = valid ? rd : 1.f; p0[r] = be * f0; f0 *= rd; }
        const float pf0 = __shfl_xor(f0, 32), pf1 = __shfl_xor(f1, 32);
        const float tail1 = hi ? 1.f : pf1;
        const float tail0 = hi ? (pf1 * f1) : (pf0 * f1 * pf1);
        const float s1 = tail1 * carry, s0 = tail0 * carry;
        carry *= (f0 * f1) * (pf0 * pf1);
        u32x4 pa[2][2];
#pragma unroll
        for (int s = 0; s < 2; ++s) {
            pa[0][s].x = cvt_pk_bf16(p0[8 * s + 0] * s0, p0[8 * s + 1] * s0); pa[0][s].y = cvt_pk_bf16(p0[8 * s + 2] * s0, p0[8 * s + 3] * s0);
            pa[0][s].z = cvt_pk_bf16(p0[8 * s + 4] * s0, p0[8 * s + 5] * s0); pa[0][s].w = cvt_pk_bf16(p0[8 * s + 6] * s0, p0[8 * s + 7] * s0);
            pa[1][s].x = cvt_pk_bf16(p1[8 * s + 0] * s1, p1[8 * s + 1] * s1); pa[1][s].y = cvt_pk_bf16(p1[8 * s + 2] * s1, p1[8 * s + 3] * s1);
            pa[1][s].z = cvt_pk_bf16(p1[8 * s + 4] * s1, p1[8 * s + 5] * s1); pa[1][s].w = cvt_pk_bf16(p1[8 * s + 6] * s1, p1[8 * s + 7] * s1);
        }
        const bf16_t* vp = VT + (size_t)l31 * SEQ + kbase + 16 * hi;
#pragma unroll
        for (int d = 0; d < 4; ++d)
#pragma unroll
            for (int blk = 0; blk < 2; ++blk)
#pragma unroll
                for (int s = 0; s < 2; ++s) { const bf16x8 vb = *(const bf16x8*)(vp + (size_t)(32 * d) * SEQ + 32 * blk + 8 * s);
                    o[d] = __builtin_amdgcn_mfma_f32_32x32x16_bf16(__builtin_bit_cast(bf16x8, pa[blk][s]), vb, o[d], 0, 0, 0); }
        if (__all(carry < 7.9e-31f)) break;
    }
#pragma unroll
    for (int r = 0; r < 16; ++r) { const int qrow = q0 + (r & 3) + 8 * (r >> 2) + 4 * hi; bf16_t* gp = Z + (rowb + qrow) * ZE + 2560 + h * 128 + l31;
#pragma unroll
        for (int d = 0; d < 4; ++d) { const float g = bf2f(gp[32 * d]); const float ov = o[d][r] * siluf_(g); if (!DUMMY) gp[32 * d] = (bf16_t)f2bf(ov); else asm volatile("" :: "v"(ov)); } }
}
__device__ __forceinline__ void ret_stage_a(Frame& F, int u) {
    const int l31 = F.lane & 31, hi = F.lane >> 5, cu = u >> 3, w8 = u & 7, bh = cu & 7, n = cu >> 3, dvb = w8 >> 1, dkp = w8 & 1;
    const bf16_t* vt = (const bf16_t*)(F.ws + WS_VTA) + ((size_t)(bh * 128 + 32 * dvb + l31)) * SEQ + n * 128 + 8 * hi;
    const bf16_t* kt = (const bf16_t*)(F.ws + WS_KT) + ((size_t)(bh * 128 + 64 * dkp + l31)) * SEQ + n * 128 + 8 * hi;
    f32x16 a0, a1;
#pragma unroll
    for (int r = 0; r < 16; ++r) { a0[r] = 0.f; a1[r] = 0.f; }
#pragma unroll
    for (int ks = 0; ks < 8; ++ks) { const bf16x8 va = *(const bf16x8*)(vt + 16 * ks), k0 = *(const bf16x8*)(kt + 16 * ks), k1 = *(const bf16x8*)(kt + (size_t)32 * SEQ + 16 * ks);
        a0 = __builtin_amdgcn_mfma_f32_32x32x16_bf16(va, k0, a0, 0, 0, 0); a1 = __builtin_amdgcn_mfma_f32_32x32x16_bf16(va, k1, a1, 0, 0, 0); }
    bf16_t* kv = (bf16_t*)(F.ws + WS_KV) + ((size_t)cu * 128 + 32 * dvb) * 128 + 64 * dkp + l31;
#pragma unroll
    for (int r = 0; r < 16; ++r) { const int dv = (r & 3) + 8 * (r >> 2) + 4 * hi; kv[dv * 128] = (bf16_t)f2bf(a0[r]); kv[dv * 128 + 32] = (bf16_t)f2bf(a1[r]); }
}
__device__ __forceinline__ void ret_stage_b(Frame& F) {
    const int e = F.vcu * 512 + F.tid; if (e >= 8 * 128 * 128) return;
    const int h = (e >> 14) & 3; const float g128 = exp2f(128.f * log2f(1.f - exp2f(-5.f - (float)h)));
    const bf16_t* p = (const bf16_t*)(F.ws + WS_KV) + e; bf16_t* q = (bf16_t*)(F.ws + WS_ST) + e; float S = 0.f;
#pragma unroll 4
    for (int n = 0; n < 64; ++n) { const float kv = bf2f(p[(size_t)n * 131072]); q[(size_t)n * 131072] = (bf16_t)f2bf(S); S = S * g128 + kv; }
}
template <bool DUMMY>
__device__ __forceinline__ void ret_stage_c(Frame& F, int u, const float* gng) {
    const int lane = F.lane, l31 = lane & 31, hi = lane >> 5, cu = u >> 2, qblk = u & 3, bh = cu & 7, n = cu >> 3, b = bh >> 2, h = bh & 3;
    bf16_t* Z = (bf16_t*)(F.ws + WS_Z); const size_t rowb = (size_t)b * SEQ; const int t0 = n * 128, tq = t0 + 32 * qblk + l31;
    bf16x8 qr[8];
    { const bf16_t* qp = Z + (rowb + tq) * ZE + h * 128 + hi * 8;
#pragma unroll
      for (int ks = 0; ks < 8; ++ks) qr[ks] = *(const bf16x8*)(qp + 16 * ks); }
    f32x16 o[4];
#pragma unroll
    for (int d = 0; d < 4; ++d)
#pragma unroll
        for (int r = 0; r < 16; ++r) o[d][r] = 0.f;
    { const bf16_t* sp = (const bf16_t*)(F.ws + WS_ST) + ((size_t)cu * 128 + l31) * 128 + 8 * hi;
#pragma unroll
      for (int ks = 0; ks < 8; ++ks)
#pragma unroll
          for (int d = 0; d < 4; ++d) { const bf16x8 sb = *(const bf16x8*)(sp + (size_t)(32 * d) * 128 + 16 * ks); o[d] = __builtin_amdgcn_mfma_f32_32x32x16_bf16(qr[ks], sb, o[d], 0, 0, 0); } }
    const int pi = 16 * ((l31 >> 2) & 1) + (l31 & 3) + 4 * (l31 >> 3);
    const bf16_t* Kb = Z + rowb * ZE + 512 + h * 128 + hi * 8;
    const bf16_t* VT = (const bf16_t*)(F.ws + WS_VTA) + ((size_t)(bh * 128 + l31)) * SEQ + 16 * hi;
    for (int kb = 0; kb <= qblk; ++kb) {
        const int kbase = t0 + 32 * kb; const bf16_t* kp = Kb + (size_t)(kbase + pi) * ZE;
        f32x16 p;
#pragma unroll
        for (int r = 0; r < 16; ++r) p[r] = 0.f;
#pragma unroll
        for (int ks = 0; ks < 8; ++ks) { const bf16x8 a = *(const bf16x8*)(kp + 16 * ks); p = __builtin_amdgcn_mfma_f32_32x32x16_bf16(a, qr[ks], p, 0, 0, 0); }
        if (kb == qblk) {
#pragma unroll
            for (int r = 0; r < 16; ++r) p[r] = (kbase + 16 * hi + r <= tq) ? p[r] : 0.f; }
        u32x4 pa[2];
#pragma unroll
        for (int s = 0; s < 2; ++s) { pa[s].x = cvt_pk_bf16(p[8 * s], p[8 * s + 1]); pa[s].y = cvt_pk_bf16(p[8 * s + 2], p[8 * s + 3]); pa[s].z = cvt_pk_bf16(p[8 * s + 4], p[8 * s + 5]); pa[s].w = cvt_pk_bf16(p[8 * s + 6], p[8 * s + 7]); }
#pragma unroll
        for (int d = 0; d < 4; ++d)
#pragma unroll
            for (int s = 0; s < 2; ++s) { const bf16x8 vb = *(const bf16x8*)(VT + (size_t)(32 * d) * SEQ + kbase + 8 * s);
                o[d] = __builtin_amdgcn_mfma_f32_32x32x16_bf16(__builtin_bit_cast(bf16x8, pa[s]), vb, o[d], 0, 0, 0); }
    }
    float gg[4];
#pragma unroll
    for (int d = 0; d < 4; ++d) gg[d] = gng[h * 128 + 32 * d + l31];
#pragma unroll
    for (int r = 0; r < 16; ++r) {
        float sm = (o[0][r] + o[1][r]) + (o[2][r] + o[3][r]);
        sm += __shfl_xor(sm, 1); sm += __shfl_xor(sm, 2); sm += __shfl_xor(sm, 4); sm += __shfl_xor(sm, 8); sm += __shfl_xor(sm, 16);
        const float mu = sm * (1.f / 128.f); float q = 0.f;
#pragma unroll
        for (int d = 0; d < 4; ++d) { const float dd = o[d][r] - mu; q += dd * dd; }
        q += __shfl_xor(q, 1); q += __shfl_xor(q, 2); q += __shfl_xor(q, 4); q += __shfl_xor(q, 8); q += __shfl_xor(q, 16);
        const float rsd = rsqrtf(q * (1.f / 128.f) + 1e-5f);
        const int qrow = t0 + 32 * qblk + (r & 3) + 8 * (r >> 2) + 4 * hi; bf16_t* gp = Z + (rowb + qrow) * ZE + 1024 + h * 128 + l31;
#pragma unroll
        for (int d = 0; d < 4; ++d) { const float ga = bf2f(gp[32 * d]); const float ov = (o[d][r] - mu) * rsd * gg[d] * siluf_(ga); if (!DUMMY) gp[32 * d] = (bf16_t)f2bf(ov); else asm volatile("" :: "v"(ov)); }
    }
}
__device__ __forceinline__ bf16x8 ld8p(const bf16_t* p) { return *(const bf16x8*)p; }
namespace rw {
constexpr int S64 = 72, S128 = 136;
constexpr int O_AT = 0, O_RT = O_AT + 9216, O_E = O_RT + 9216, O_ET = O_E + 18432, O_AM = O_ET + 17408, O_X0 = O_AM + 18432, O_LF = O_X0 + 17408, O_MM = O_LF + 16640,
              O_NN = O_MM + 9216, O_PC = O_NN + 17408, O_GC = O_PC + 9216, O_SM = O_GC + 9216, O_END = O_SM + 4096;
static_assert(O_END <= 160 * 1024 - 1024, "rwkv stage X LDS map");
typedef __attribute__((address_space(3))) bf16_t lbf;
typedef __attribute__((address_space(3))) float lf32;
__device__ __forceinline__ bf16x8 ld8(const bf16_t* p) { return *(const bf16x8*)p; }
__device__ __forceinline__ bf16x8 ld8(const LAS bf16_t* p) { return *(const LAS bf16x8*)p; }
template <int MT, int NT, int KS, class PA, class PB, class Epi>
__device__ __forceinline__ void mm(PA A, int lda, PB B, int ldb, int wave, int lane, Epi epi) {
    const int fr = lane & 15, g = lane >> 4;
    static_assert((MT * NT) % 8 == 0, "mm: tile count must be a multiple of the 8 waves");
#pragma unroll
    for (int ti = 0; ti < MT * NT / 8; ++ti) { const int tile = wave + 8 * ti; const int mt = tile / NT, nt = tile % NT;
        f32x4 acc = {0.f, 0.f, 0.f, 0.f};
        PA ap = A + (mt * 16 + fr) * lda + 8 * g; PB bp = B + (nt * 16 + fr) * ldb + 8 * g;
#pragma unroll
        for (int ks = 0; ks < KS; ++ks) acc = __builtin_amdgcn_mfma_f32_16x16x32_bf16(ld8(ap + 32 * ks), ld8(bp + 32 * ks), acc, 0, 0, 0);
        epi(ti, mt * 16 + 4 * g, nt * 16 + fr, acc);
    }
}
__device__ __forceinline__ unsigned short bfs(float f) { return (unsigned short)f2bf(f); }
__device__ __forceinline__ void st4(LAS bf16_t* p, f32x4 v) { u32x2 w; w.x = cvt_pk_bf16(v[0], v[1]); w.y = cvt_pk_bf16(v[2], v[3]); *(LAS u32x2*)p = w; }
}

template <bool DUMMY>
__device__ __forceinline__ void rwkv_stage_x(Frame& F, int li, unsigned long long& xacc) {
    using namespace rw;
    unsigned long long xt0 = 0;
#define TSX(k) do { if (MK_XA == (k)) xt0 = __builtin_amdgcn_s_memrealtime(); if (MK_XB == (k)) xacc += __builtin_amdgcn_s_memrealtime() - xt0; } while (0)
    const int o = li >> 1;
    LAS unsigned char* L = F.lds;
    LAS bf16_t* At = (LAS bf16_t*)(L + O_AT); LAS bf16_t* Rt = (LAS bf16_t*)(L + O_RT); LAS bf16_t* E = (LAS bf16_t*)(L + O_E); LAS bf16_t* ET = (LAS bf16_t*)(L + O_ET); LAS bf16_t* AM = (LAS bf16_t*)(L + O_AM);
    LAS bf16_t* X0T = (LAS bf16_t*)(L + O_X0); LAS float* Lf = (LAS float*)(L + O_LF); LAS bf16_t* Mm = (LAS bf16_t*)(L + O_MM); LAS bf16_t* NN = (LAS bf16_t*)(L + O_NN); LAS float* CS = (LAS float*)(L + O_NN);
    LAS bf16_t* Pc = (LAS bf16_t*)(L + O_PC); LAS bf16_t* Gc = (LAS bf16_t*)(L + O_GC); LAS float* gamC = (LAS float*)(L + O_SM); LAS float* SEGT = gamC + 64; LAS float* PRM = gamC + 64 + 512;
    LAS bf16_t* Tm = At; LAS bf16_t* Qh = AM; LAS bf16_t* PT = AM + 64 * S64; LAS bf16_t* WT = Mm;
    bf16_t* Z = (bf16_t*)(F.ws + WS_Z); const bf16_t* L1g = (const bf16_t*)(F.ws + WS_L1); bf16_t* VF = (bf16_t*)(F.ws + WS_VF);
    const bf16_t* W2T = (const bf16_t*)(F.ws + WS_LORA2); const bf16_t* A2T = W2T + 1024 * 64; const bf16_t* V2T = A2T + 1024 * 64;
    bf16_t* PG = (bf16_t*)(F.ws + WS_PG); float* BON = (float*)(F.ws + WS_BON);
    const float* w0p = F.in[12] + o * D; const float* a0p = F.in[15] + o * D; const float* v0p = F.in[18]; const float* kkp = F.in[21] + o * D; const float* kap = F.in[22] + o * D; const float* rkp = F.in[23] + o * D;
#pragma unroll 1
    for (int u = F.vcu; u < 2048; u += F.G) {
        const int bh = u & 31, blk = u >> 5, b = bh >> 4, h = bh & 15; const size_t row0 = (size_t)b * SEQ + (size_t)blk * 128;
        int tid = F.tid; asm volatile("" : "+v"(tid));
        __syncthreads();
        if (tid < 384) { const int a_ = tid >> 6, ch = tid & 63; const float* src = a_ == 0 ? w0p : a_ == 1 ? a0p : a_ == 2 ? v0p : a_ == 3 ? kkp : a_ == 4 ? kap : rkp; PRM[tid] = src[h * 64 + ch]; }
        for (int e = tid; e < 64 * 64; e += 512) { const int i = e >> 6, j = e & 63; Pc[i * S64 + j] = (i == j) ? (bf16_t)0x3f80 : (bf16_t)0; Gc[i * S64 + j] = 0; }
#pragma unroll 1
        for (int c = 0; c < 2; ++c) {
            const size_t rows = row0 + 64 * c;
            asm volatile("" : "+v"(tid));
            const int lane = tid & 63; int wave = F.wave; asm volatile("" : "+s"(wave));
            const int pt = tid >> 3, pc0 = (tid & 7) * 8;
            __syncthreads();
            TSX(0);
            mm<4, 4, 2>(L1g + rows * 256, 256, W2T + (size_t)h * 64 * 64, 64, wave, lane, [&](int, int r0, int col, f32x4 a) {
#pragma unroll
                for (int j = 0; j < 4; ++j) Lf[(r0 + j) * 65 + col] = a[j]; });
            mm<4, 4, 2>(L1g + rows * 256 + 64, 256, A2T + (size_t)h * 64 * 64, 64, wave, lane, [&](int, int r0, int col, f32x4 a) {
#pragma unroll
                for (int j = 0; j < 4; ++j) Mm[(r0 + j) * S64 + col] = bfs(a[j]); });
            if (o) mm<4, 4, 1>(L1g + rows * 256 + 128, 256, V2T + (size_t)h * 64 * 32, 32, wave, lane, [&](int, int r0, int col, f32x4 a) {
#pragma unroll
                for (int j = 0; j < 4; ++j) AM[(64 + r0 + j) * S64 + col] = bfs(a[j]); });
            __syncthreads();
            TSX(1);
            float pr[8], pkk[8], pkm[8], pb[8], pv[8];
            {
                const size_t row = rows + pt; bf16_t* zp = Z + row * ZW + h * 64 + pc0; const int cc = h * 64 + pc0;
                const bf16x8 r8 = ld8p(zp), k8 = ld8p(zp + 1024), v8 = ld8p(zp + 2048); bf16x8 vf8 = v8; if (o) vf8 = ld8p(VF + row * D + cc);
                float ss = 0.f, bon = 0.f, dec[8];
#pragma unroll
                for (int j = 0; j < 8; ++j) {
                    const float r = bf2f((bf16_t)r8[j]), k = bf2f((bf16_t)k8[j]); float v = bf2f((bf16_t)v8[j]);
                    const float lw = Lf[pt * 65 + pc0 + j], la = bf2f(Mm[pt * S64 + pc0 + j]);
                    dec[j] = -0.6065306597126334f * sigmoidf_(PRM[pc0 + j] + lw);
                    const float a = sigmoidf_(PRM[64 + pc0 + j] + la);
                    if (o) { const float lv = bf2f(AM[(64 + pt) * S64 + pc0 + j]); const float vf = bf2f((bf16_t)vf8[j]); v = v + (vf - v) * sigmoidf_(PRM[128 + pc0 + j] + lv); v = bf2f((bf16_t)f2bf(v)); }
                    const float kr = k * PRM[192 + pc0 + j]; ss += kr * kr; pkk[j] = kr;
                    const float km = k * (1.f + (a - 1.f) * PRM[256 + pc0 + j]); pkm[j] = km; pb[j] = a; pr[j] = r; pv[j] = v; bon += r * km * PRM[320 + pc0 + j];
                }
                if (!DUMMY) { if (o) { u32x4 w; w.x = pk2(pv[0], pv[1]); w.y = pk2(pv[2], pv[3]); w.z = pk2(pv[4], pv[5]); w.w = pk2(pv[6], pv[7]); *(u32x4*)(zp + 2048) = w; }
                else *(bf16x8*)(VF + row * D + cc) = v8; }
                ss += __shfl_xor(ss, 1); ss += __shfl_xor(ss, 2); ss += __shfl_xor(ss, 4);
                bon += __shfl_xor(bon, 1); bon += __shfl_xor(bon, 2); bon += __shfl_xor(bon, 4);
                const float inv = 1.f / fmaxf(sqrtf(ss), 1e-12f);
#pragma unroll
                for (int j = 0; j < 8; ++j) { pkk[j] *= inv; pb[j] *= pkk[j]; }
                if (!DUMMY && (tid & 7) == 0) BON[row * 16 + h] = bon;
                __syncthreads();
#pragma unroll
                for (int j = 0; j < 8; ++j) CS[pt * 65 + pc0 + j] = dec[j];
            }
            __syncthreads();
            TSX(2);
            { const int ch = tid & 63, sg = tid >> 6; float run = 0.f;
#pragma unroll
              for (int q = 0; q < 8; ++q) { run += CS[(sg * 8 + q) * 65 + ch]; CS[(sg * 8 + q) * 65 + ch] = run; }
              SEGT[sg * 64 + ch] = run;
              __syncthreads();
              float pre = 0.f;
              for (int q = 0; q < sg; ++q) pre += SEGT[q * 64 + ch];
#pragma unroll
              for (int q = 0; q < 8; ++q) CS[(sg * 8 + q) * 65 + ch] += pre; }
            __syncthreads();
            TSX(3);
            {
                unsigned short at[8], bt[8], kt[8], rt[8], vt[8];
#pragma unroll
                for (int j = 0; j < 8; ++j) { const float g = CS[pt * 65 + pc0 + j], gp = pt ? CS[(pt - 1) * 65 + pc0 + j] : 0.f; const float eg = __expf(g), egp = __expf(gp), ieg = __builtin_amdgcn_rcpf(eg);
                    at[j] = bfs(egp * pkk[j]); bt[j] = bfs(pb[j] * ieg); kt[j] = bfs(pkm[j] * ieg); rt[j] = bfs(pr[j] * eg); vt[j] = bfs(pv[j]);
                    if (pt == 63) gamC[pc0 + j] = eg; }
#define RW_PK4(x) (u32x4){(unsigned)x[0] | ((unsigned)x[1] << 16), (unsigned)x[2] | ((unsigned)x[3] << 16), (unsigned)x[4] | ((unsigned)x[5] << 16), (unsigned)x[6] | ((unsigned)x[7] << 16)}
                *(LAS u32x4*)(At + pt * S64 + pc0) = RW_PK4(at); *(LAS u32x4*)(Rt + pt * S64 + pc0) = RW_PK4(rt); *(LAS u32x4*)(E + pt * S64 + pc0) = RW_PK4(bt); *(LAS u32x4*)(E + (64 + pt) * S64 + pc0) = RW_PK4(kt);
#undef RW_PK4
#pragma unroll
                for (int j = 0; j < 8; ++j) { AM[(pc0 + j) * S64 + pt] = at[j]; ET[(pc0 + j) * S128 + pt] = bt[j]; ET[(pc0 + j) * S128 + 64 + pt] = kt[j]; X0T[(pc0 + j) * S128 + 64 + pt] = vt[j]; }
            }
            __syncthreads();
            TSX(4);
            mm<4, 8, 2>(At, S64, E, S64, wave, lane, [&](int, int r0, int col, f32x4 a) {
                const int i = col & 63;
#pragma unroll
                for (int j = 0; j < 4; ++j) { const float v = (i < r0 + j) ? a[j] : 0.f; if (col < 64) Lf[(r0 + j) * 65 + i] = v; else Mm[(r0 + j) * S64 + i] = bfs(v); } });
            mm<4, 8, 2>(Rt, S64, E, S64, wave, lane, [&](int, int r0, int col, f32x4 a) {
                const int i = col & 63;
#pragma unroll
                for (int j = 0; j < 4; ++j) NN[(r0 + j) * S128 + col] = bfs((i <= r0 + j) ? a[j] : 0.f); });
            __syncthreads();
            TSX(5);
            mm<4, 4, 2>(Mm, S64, X0T + 64, S128, wave, lane, [&](int, int r0, int col, f32x4 a) { st4(AM + (64 + col) * S64 + r0, (f32x4){-a[0], -a[1], -a[2], -a[3]}); });
            for (int e = tid; e < 64 * 64; e += 512) { const int t = e >> 6, i = e & 63; const float lv = Lf[t * 65 + i]; const int tb = t >> 4, ib = i >> 4;
                E[t * S64 + i] = ((tb == 1 && ib == 0) || (tb == 3 && ib == 2)) ? bfs(lv) : (bf16_t)0;
                E[(64 + t) * S64 + i] = (t >= 32 && i < 32) ? bfs(lv) : (bf16_t)0;
                Tm[t * S64 + i] = 0; X0T[t * S128 + i] = 0; }
            __syncthreads();
            TSX(6);
            if (wave < 4 && lane < 16) { const int bb = wave * 16; float x[16];
#pragma unroll
                for (int r = 0; r < 16; ++r) { float s = (r == lane) ? 1.f : 0.f;
#pragma unroll
                    for (int i = 0; i < r; ++i) s -= Lf[(bb + r) * 65 + bb + i] * x[i];
                    x[r] = s; }
#pragma unroll
                for (int r = 0; r < 16; ++r) { const unsigned short xv = bfs(x[r]); Tm[(bb + r) * S64 + bb + lane] = xv; X0T[(bb + lane) * S128 + bb + r] = xv; } }
            __syncthreads();
            mm<4, 4, 2>(E, S64, X0T, S128, wave, lane, [&](int, int r0, int col, f32x4 a) { st4(Mm + col * S64 + r0, a); });
            __syncthreads();
            mm<4, 4, 2>(Tm, S64, Mm, S64, wave, lane, [&](int, int r0, int col, f32x4 a) {
                const int tb = r0 >> 4, jb = col >> 4; if ((tb == 1 && jb == 0) || (tb == 3 && jb == 2)) st4(X0T + col * S128 + r0, (f32x4){-a[0], -a[1], -a[2], -a[3]}); });
            __syncthreads();
            { const int p = tid >> 8, tt = (tid >> 4) & 15, jj = tid & 15, t = 16 * (2 * p + 1) + tt, j = 32 * p + jj; Tm[t * S64 + j] = X0T[j * S128 + t]; }
            __syncthreads();
            mm<4, 4, 2>(E + 64 * S64, S64, X0T, S128, wave, lane, [&](int, int r0, int col, f32x4 a) { st4(Mm + col * S64 + r0, a); });
            __syncthreads();
            mm<4, 4, 2>(Tm, S64, Mm, S64, wave, lane, [&](int, int r0, int col, f32x4 a) {
                if (r0 >= 32 && col < 32) {
#pragma unroll
                    for (int j = 0; j < 4; ++j) E[(r0 + j) * S64 + col] = bfs(-a[j]); } });
            __syncthreads();
            for (int e = tid; e < 32 * 32; e += 512) { const int t = 32 + (e >> 5), j = e & 31; Tm[t * S64 + j] = E[t * S64 + j]; }
            __syncthreads();
            TSX(7);
            mm<4, 8, 2>(Tm, S64, AM, S64, wave, lane, [&](int, int r0, int col, f32x4 a) { if (col < 64) st4(WT + col * S64 + r0, a); else st4(X0T + (col - 64) * S128 + r0, a); });
            __syncthreads();
            TSX(8);
            f32x4 gt[2], y0t[2];
            mm<4, 4, 2>(WT, S64, ET, S128, wave, lane, [&](int, int r0, int col, f32x4 a) { const float gc = gamC[col];
                f32x4 p;
#pragma unroll
                for (int j = 0; j < 4; ++j) p[j] = (((r0 + j) == col ? 1.f : 0.f) - a[j]) * gc;
                st4(PT + col * S64 + r0, p); });
            mm<4, 4, 4>(X0T, S128, ET, S128, wave, lane, [&](int ti, int, int col, f32x4 a) { const float gc = gamC[col]; gt[ti] = a * gc; });
            mm<4, 4, 4>(NN, S128, X0T, S128, wave, lane, [&](int ti, int, int, f32x4 a) { y0t[ti] = a; });
            mm<4, 4, 2>(NN, S128, WT, S64, wave, lane, [&](int, int r0, int col, f32x4 a) {
#pragma unroll
                for (int j = 0; j < 4; ++j) Qh[(r0 + j) * S64 + col] = bfs(bf2f(Rt[(r0 + j) * S64 + col]) - a[j]); });
            __syncthreads();
            TSX(9);
            bf16_t* rslot = Z + row0 * ZW + h * 64; bf16_t* kslot = rslot + 1024;
            mm<4, 4, 2>(Qh, S64, Pc, S64, wave, lane, [&](int, int r0, int col, f32x4 a) {
                const int kt_ = col >> 5, rho = col & 31, s = rho >> 4, jj = ((rho >> 3) & 1) * 4 + (rho & 3), hh = (rho >> 2) & 1;
#pragma unroll
                for (int j = 0; j < 4; ++j) { const int t = 64 * c + r0 + j, tt_ = t >> 5, ln = 32 * hh + (t & 31); const int e = ((((tt_ * 2 + kt_) * 2 + s) * 64 + ln) << 3) + jj;
                    if (!DUMMY) rslot[(size_t)(e >> 6) * ZW + (e & 63)] = bfs(a[j]); else asm volatile("" :: "v"(a[j])); } });
            mm<4, 4, 2>(Qh, S64, Gc, S64, wave, lane, [&](int ti, int r0, int col, f32x4 a) {
                const int vt_ = col >> 5, v31 = col & 31;
#pragma unroll
                for (int j = 0; j < 4; ++j) { const int t = 64 * c + r0 + j, tt_ = t >> 5, x = t & 31, hh = (x >> 2) & 1, r = (x & 3) + 4 * (x >> 3); const int e = (((tt_ * 2 + vt_) * 64 + 32 * hh + v31) << 4) + r;
                    if (!DUMMY) kslot[(size_t)(e >> 6) * ZW + (e & 63)] = bfs(a[j] + y0t[ti][j]); else asm volatile("" :: "v"(a[j] + y0t[ti][j])); } });
            f32x4 pn[2], gn[2];
            mm<4, 4, 2>(Pc, S64, PT, S64, wave, lane, [&](int ti, int, int, f32x4 a) { pn[ti] = a; });
            mm<4, 4, 2>(Gc, S64, PT, S64, wave, lane, [&](int ti, int, int, f32x4 a) { gn[ti] = a + gt[ti]; });
            __syncthreads();
            { const int fr = lane & 15, g = lane >> 4;
#pragma unroll
              for (int ti = 0; ti < 2; ++ti) { const int tile = wave + 8 * ti, mt = tile >> 2, nt = tile & 3;
#pragma unroll
                  for (int j = 0; j < 4; ++j) { Pc[(mt * 16 + 4 * g + j) * S64 + nt * 16 + fr] = bfs(pn[ti][j]); Gc[(mt * 16 + 4 * g + j) * S64 + nt * 16 + fr] = bfs(gn[ti][j]); } } }
            TSX(10);
        }
        __syncthreads();
        if (!DUMMY) { bf16_t* pg = PG + (size_t)u * 8192;
          { const int f = tid >> 6, ln = tid & 63, s = f & 1, kit = (f >> 1) & 1, kot = f >> 2, hh = ln >> 5, r31 = ln & 31; unsigned short w[8];
#pragma unroll
            for (int j = 0; j < 8; ++j) { const int rho = 16 * s + 8 * (j >> 2) + 4 * hh + (j & 3); w[j] = Pc[(32 * kit + rho) * S64 + 32 * kot + r31]; }
            *(u32x4*)(pg + (size_t)tid * 8) = (u32x4){(unsigned)w[0] | ((unsigned)w[1] << 16), (unsigned)w[2] | ((unsigned)w[3] << 16), (unsigned)w[4] | ((unsigned)w[5] << 16), (unsigned)w[6] | ((unsigned)w[7] << 16)}; }
          { const int tile = tid >> 7, ln = (tid >> 1) & 63, half = tid & 1, kot = tile >> 1, vt_ = tile & 1, hh = ln >> 5, v31 = ln & 31; unsigned short w[8];
#pragma unroll
            for (int q = 0; q < 8; ++q) { const int r = 8 * half + q; const int ko = 32 * kot + (r & 3) + 8 * (r >> 2) + 4 * hh; w[q] = Gc[(32 * vt_ + v31) * S64 + ko]; }
            *(u32x4*)(pg + 4096 + ((size_t)(tile * 64 + ln) << 4) + 8 * half) = (u32x4){(unsigned)w[0] | ((unsigned)w[1] << 16), (unsigned)w[2] | ((unsigned)w[3] << 16), (unsigned)w[4] | ((unsigned)w[5] << 16), (unsigned)w[6] | ((unsigned)w[7] << 16)}; } }
    }
    __syncthreads();
}

struct RwPre { bf16x8 q[4], ya, yb, ga, gb; };
__device__ __forceinline__ void rwkv_stage_y(Frame& F, const bool DUMMY) {
    if (F.vcu >= 32) return;
    const int lane = F.lane, wave = F.wave, bh = F.vcu, tt = wave & 3, vt = wave >> 2, b = bh >> 4, h = bh & 15; const bool st = (tt == 0);
    bf16_t* Z = (bf16_t*)(F.ws + WS_Z); const bf16_t* PG = (const bf16_t*)(F.ws + WS_PG);
    LAS u32x4* xbuf = (LAS u32x4*)F.lds;
    LAS bf16x8* pgbuf = (LAS bf16x8*)(F.lds + 16384);
    f32x16 X0, X1;
#pragma unroll
    for (int r = 0; r < 16; ++r) { X0[r] = 0.f; X1[r] = 0.f; }
    if (st) {
#pragma unroll
        for (int q = 0; q < 4; ++q) xbuf[((0 * 2 + vt) * 4 + q) * 64 + lane] = (u32x4){0u, 0u, 0u, 0u}; }
    auto issue = [&](RwPre& R, int blk) {
        const int u = blk * 32 + bh; const bf16_t* pg = PG + (size_t)u * 8192; const size_t row0 = (size_t)b * SEQ + (size_t)blk * 128;
        const bf16_t* rslot = Z + row0 * ZW + h * 64; const bf16_t* kslot = Z + row0 * ZW + 1024 + h * 64;
#pragma unroll
        for (int q = 0; q < 4; ++q) { const int e = (((tt * 4 + q) * 64 + lane) << 3); R.q[q] = ld8p(rslot + (size_t)(e >> 6) * ZW + (e & 63)); }
        { const int e0 = ((tt * 2 + vt) * 64 + lane) << 4; const bf16_t* yp = kslot + (size_t)(e0 >> 6) * ZW + (e0 & 63); R.ya = ld8p(yp); R.yb = ld8p(yp + 8); }
        R.ga = ld8p(pg + (((size_t)(wave * 2 + 0) * 64 + lane) << 3)); R.gb = ld8p(pg + (((size_t)(wave * 2 + 1) * 64 + lane) << 3));
    };
    auto step = [&](RwPre& Rc, RwPre& Rn, int blk) {
        const size_t row0 = (size_t)b * SEQ + (size_t)blk * 128; bf16_t* kslot = Z + row0 * ZW + 1024 + h * 64;
        const int e0 = ((tt * 2 + vt) * 64 + lane) << 4; bf16_t* yp = kslot + (size_t)(e0 >> 6) * ZW + (e0 & 63);
        bf16x8 cq[4], cya = Rc.ya, cyb = Rc.yb;
#pragma unroll
        for (int q = 0; q < 4; ++q) cq[q] = Rc.q[q];
        const bf16x8 nga = Rn.ga, ngb = Rn.gb;
        issue(Rc, blk + 3 < 64 ? blk + 3 : 63);
        asm volatile("s_waitcnt lgkmcnt(0)" ::: "memory"); __builtin_amdgcn_s_barrier(); asm volatile("" ::: "memory");
        if (blk + 1 < 64) { pgbuf[((blk + 1) & 1) * 1024 + (wave * 2 + 0) * 64 + lane] = nga; pgbuf[((blk + 1) & 1) * 1024 + (wave * 2 + 1) * 64 + lane] = ngb; }
        u32x4 xb[4];
#pragma unroll
        for (int q = 0; q < 4; ++q) xb[q] = xbuf[(((blk & 1) * 2 + vt) * 4 + q) * 64 + lane];
        if (st) {
            const LAS bf16x8* pb = pgbuf + (blk & 1) * 1024;
            f32x16 n0, n1;
            { const bf16x8 c0a = pb[512 + ((0 * 2 + vt) * 64 + lane) * 2], c0b = pb[512 + ((0 * 2 + vt) * 64 + lane) * 2 + 1], c1a = pb[512 + ((1 * 2 + vt) * 64 + lane) * 2], c1b = pb[512 + ((1 * 2 + vt) * 64 + lane) * 2 + 1];
#pragma unroll
              for (int r = 0; r < 8; ++r) { n0[r] = bf2f((bf16_t)c0a[r]); n0[8 + r] = bf2f((bf16_t)c0b[r]); n1[r] = bf2f((bf16_t)c1a[r]); n1[8 + r] = bf2f((bf16_t)c1b[r]); } }
#pragma unroll
            for (int q = 0; q < 4; ++q) {
                n0 = __builtin_amdgcn_mfma_f32_32x32x16_bf16(pb[q * 64 + lane], __builtin_bit_cast(bf16x8, xb[q]), n0, 0, 0, 0);
                n1 = __builtin_amdgcn_mfma_f32_32x32x16_bf16(pb[(4 + q) * 64 + lane], __builtin_bit_cast(bf16x8, xb[q]), n1, 0, 0, 0); }
            X0 = n0; X1 = n1;
            LAS u32x4* xo = xbuf + ((((blk + 1) & 1) * 2 + vt) * 4) * 64 + lane;
#pragma unroll
            for (int s = 0; s < 2; ++s) {
                xo[(0 * 2 + s) * 64] = (u32x4){cvt_pk_bf16(X0[8 * s], X0[8 * s + 1]), cvt_pk_bf16(X0[8 * s + 2], X0[8 * s + 3]), cvt_pk_bf16(X0[8 * s + 4], X0[8 * s + 5]), cvt_pk_bf16(X0[8 * s + 6], X0[8 * s + 7])};
                xo[(1 * 2 + s) * 64] = (u32x4){cvt_pk_bf16(X1[8 * s], X1[8 * s + 1]), cvt_pk_bf16(X1[8 * s + 2], X1[8 * s + 3]), cvt_pk_bf16(X1[8 * s + 4], X1[8 * s + 5]), cvt_pk_bf16(X1[8 * s + 6], X1[8 * s + 7])}; }
        }
        f32x16 acc;
#pragma unroll
        for (int r = 0; r < 8; ++r) { acc[r] = bf2f((bf16_t)cya[r]); acc[8 + r] = bf2f((bf16_t)cyb[r]); }
#pragma unroll
        for (int q = 0; q < 4; ++q) acc = __builtin_amdgcn_mfma_f32_32x32x16_bf16(cq[q], __builtin_bit_cast(bf16x8, xb[q]), acc, 0, 0, 0);
        const u32x4 w0 = {cvt_pk_bf16(acc[0], acc[1]), cvt_pk_bf16(acc[2], acc[3]), cvt_pk_bf16(acc[4], acc[5]), cvt_pk_bf16(acc[6], acc[7])};
        const u32x4 w1 = {cvt_pk_bf16(acc[8], acc[9]), cvt_pk_bf16(acc[10], acc[11]), cvt_pk_bf16(acc[12], acc[13]), cvt_pk_bf16(acc[14], acc[15])};
        if (!DUMMY) { *(u32x4*)yp = w0; *(u32x4*)(yp + 8) = w1; } else asm volatile("" :: "v"(w0), "v"(w1));
    };
    RwPre R0, R1, R2;
    issue(R0, 0); issue(R1, 1); issue(R2, 2);
    pgbuf[(wave * 2 + 0) * 64 + lane] = R0.ga; pgbuf[(wave * 2 + 1) * 64 + lane] = R0.gb;
#pragma unroll 1
    for (int blk = 0; blk < 63; blk += 3) { step(R0, R1, blk); step(R1, R2, blk + 1); step(R2, R0, blk + 2); }
    step(R0, R1, 63);
    __syncthreads();
}

template <bool DUMMY>
__device__ __forceinline__ void rwkv_stage_z(Frame& F, int li) {
    const int o = li >> 1;
    bf16_t* Z = (bf16_t*)(F.ws + WS_Z); const float* BON = (const float*)(F.ws + WS_BON);
    const float* lgp = F.in[24] + o * D; const float* lbp = F.in[25] + o * D;
    LAS float* tile = (LAS float*)(F.lds + F.wave * 9216);
    int lane_ = F.lane;
#pragma unroll 1
    for (int w = F.vcu * 8 + F.wave; w < 8192; w += F.G * 8) {
        asm volatile("" : "+v"(lane_)); const int lane = lane_, v31 = lane & 31, hh = lane >> 5, tl = lane >> 1, hf = lane & 1;
        const int u = w >> 2, tt = w & 3, bh = u & 31, blk = u >> 5, b = bh >> 4, h = bh & 15; const size_t row0 = (size_t)b * SEQ + (size_t)blk * 128;
        const bf16_t* kslot = Z + row0 * ZW + 1024 + h * 64;
        const size_t row = row0 + 32 * tt + tl; bf16_t* zp = Z + row * ZW + h * 64 + 32 * hf;
        bf16x8 vv[4], gg[4];
#pragma unroll
        for (int q = 0; q < 4; ++q) { vv[q] = ld8p(zp + 2048 + 8 * q); gg[q] = ld8p(zp + 3072 + 8 * q); }
        const float bon = BON[row * 16 + h];
#pragma unroll
        for (int vt = 0; vt < 2; ++vt) { const int e0 = ((tt * 2 + vt) * 64 + lane) << 4; const bf16_t* yp = kslot + (size_t)(e0 >> 6) * ZW + (e0 & 63); const bf16x8 ya = ld8p(yp), yb = ld8p(yp + 8);
#pragma unroll
            for (int r = 0; r < 8; ++r) { const int t0 = (r & 3) + 8 * (r >> 2) + 4 * hh, t1 = ((8 + r) & 3) + 8 * ((8 + r) >> 2) + 4 * hh;
                tile[t0 * 72 + 36 * vt + v31] = bf2f((bf16_t)ya[r]); tile[t1 * 72 + 36 * vt + v31] = bf2f((bf16_t)yb[r]); } }
        LDS_WAIT(); asm volatile("" ::: "memory");
        float y[32]; float sm = 0.f;
#pragma unroll
        for (int q = 0; q < 8; ++q) { const f32x4 t4 = *(const LAS f32x4*)(tile + tl * 72 + 36 * hf + 4 * q); y[4 * q] = t4[0]; y[4 * q + 1] = t4[1]; y[4 * q + 2] = t4[2]; y[4 * q + 3] = t4[3]; sm += (t4[0] + t4[1]) + (t4[2] + t4[3]); }
        sm += __shfl_xor(sm, 1);
        const float mu = sm * (1.f / 64.f); float qq = 0.f;
#pragma unroll
        for (int j = 0; j < 32; ++j) { y[j] -= mu; qq += y[j] * y[j]; }
        qq += __shfl_xor(qq, 1);
        const float rsd = rsqrtf(qq * (1.f / 64.f) + 64e-5f);
        const float* lg = lgp + h * 64 + 32 * hf; const float* lb = lbp + h * 64 + 32 * hf;
#pragma unroll
        for (int q = 0; q < 4; ++q) { float ov[8];
#pragma unroll
            for (int j = 0; j < 8; ++j) { const int c = 8 * q + j; const float va = bf2f((bf16_t)vv[q][j]), ga = bf2f((bf16_t)gg[q][j]); ov[j] = (y[c] * rsd * lg[c] + lb[c] + bon * va) * siluf_(ga); }
            const u32x4 wv = {cvt_pk_bf16(ov[0], ov[1]), cvt_pk_bf16(ov[2], ov[3]), cvt_pk_bf16(ov[4], ov[5]), cvt_pk_bf16(ov[6], ov[7])};
            if (!DUMMY) *(u32x4*)(zp + 3072 + 8 * q) = wv; else asm volatile("" :: "v"(wv)); }
        LDS_WAIT(); asm volatile("" ::: "memory");
    }
}

enum { PH_P0 = 0, PH_FINAL = 27, N_PHASES = 28 };
#define IN(k) (lo <= (k) && (k) < hi)
#define TS(k) do { if (MK_TPA == (k)) tA = __builtin_amdgcn_s_memrealtime(); if (MK_TPB == (k)) tB = __builtin_amdgcn_s_memrealtime(); } while (0)
#if MK_MULTI
#define SEAM(k) do { } while (0)
#else
#define SEAM(k) do { if (IN(k) && IN((k) + 1)) xcd_barrier(bar); } while (0)
#endif
template <int LI>
__device__ __forceinline__ void run_layer(Frame& F, const XcdBarrier& bar, const int lo, const int hi, const int bx, unsigned long long& tA, unsigned long long& tB) {
    constexpr bool even = (LI & 1) == 0;
    constexpr int base = 1 + (LI / 2) * 13 + (even ? 0 : 6);
    bf16_t* Zp = (bf16_t*)(F.ws + WS_Z);
    if constexpr (even) {
        TS(base); if (IN(base)) { F.retid(); pg8::StaticOrder S; S.init(64, 16, F.G, bx);
            pg8::Gemm g{(const bf16_t*)(F.ws + WS_HB), (const bf16_t*)(F.ws + WS_WIN)};
            EpiEvenIn E{Zp, F.ssq(LI), (bf16_t*)(F.ws + WS_VTA), (bf16_t*)(F.ws + WS_VTB), (bf16_t*)(F.ws + WS_KT)};
            if (MK_PROBE == 1) pg8::gemm_phase<EpiEvenIn, true, D, D, 1 << 20, 0, 0>(F.lds, F.tid, g, S, E);
            pg8::gemm_phase<EpiEvenIn, true, D, D, 1 << 20, 0, 0>(F.lds, F.tid, g, S, E); }
        SEAM(base);
        TS(base + 1); if (IN(base + 1)) { F.retid();
            conv_wrest(F, LI);
            if constexpr (LI < 3) conv_win_odd(F, LI + 1);
            if (MK_PROBE == 5) { for (int u = F.vcu * 8 + F.wave; u < 4096; u += F.G * 8) ret_stage_a(F, u);
                for (int u = F.vcu * 8 + F.wave; u < 2048; u += F.G * 8) sb_unit<true>(F, u >> 8, u & 255); }
            for (int u = F.vcu * 8 + F.wave; u < 4096; u += F.G * 8) ret_stage_a(F, u);
            for (int u = F.vcu * 8 + F.wave; u < 2048; u += F.G * 8) sb_unit<false>(F, u >> 8, u & 255); }
        SEAM(base + 1);
        TS(base + 2); if (IN(base + 2)) { F.retid(); ret_stage_b(F); }
        SEAM(base + 2);
        TS(base + 3); if (IN(base + 3)) { F.retid(); const float* gng = F.in[8] + (LI >> 1) * 512;
            if (MK_PROBE == 6) for (int u = F.vcu * 8 + F.wave; u < 2048; u += F.G * 8) ret_stage_c<true>(F, u, gng);
            for (int u = F.vcu * 8 + F.wave; u < 2048; u += F.G * 8) ret_stage_c<false>(F, u, gng); }
        SEAM(base + 3);
        TS(base + 4); if (IN(base + 4)) { F.retid(); pg8::StaticOrder S; S.init(64, 4, F.G, bx);
            { pg8::Gemm g{(const bf16_t*)(F.ws + WS_PB), (const bf16_t*)(F.ws + WS_WPROJ)};
              EpiStore E{Zp, ZE}; pg8::gemm_phase<EpiStore, false, PLE, PLE, 1 << 20, 0, 0>(F.lds, F.tid, g, S, E); }
            { pg8::Gemm g{Zp + 1024, (const bf16_t*)(F.ws + WS_WOUT)};
              EpiResid E{F.H, Zp + 1536, ZE}; pg8::gemm_phase<EpiResid, false, ZE, D, 8, (long)((2560 - 1024) * 2), 0>(F.lds, F.tid, g, S, E); } }
        SEAM(base + 4);
        TS(base + 5); if (IN(base + 5)) { F.retid(); pg8::StaticOrder S; S.init(64, 4, F.G, bx);
            pg8::Gemm g{Zp + 1536, (const bf16_t*)(F.ws + WS_WGATE)};
            EpiGate E{F.H, Zp, ZE, nullptr, F.ssq(LI + 1)};
            pg8::gemm_phase<EpiGate, false, ZE, D, 1 << 20, 0, 0>(F.lds, F.tid, g, S, E); }
        SEAM(base + 5);
    } else {
        TS(base); if (IN(base)) { F.retid(); conv_lora2(F, LI); rows_norm(F, LI); }
        SEAM(base);
        TS(base + 1); if (IN(base + 1)) { F.retid(); pg8::StaticOrder S; S.init(64, 17, F.G, bx);
            pg8::Gemm g{(const bf16_t*)(F.ws + WS_HB) + D, (const bf16_t*)(F.ws + WS_WIN)};
            EpiOddIn E{Zp, (bf16_t*)(F.ws + WS_L1)};
            if (MK_PROBE == 2) pg8::gemm_phase<EpiOddIn, true, D, 2048, 16, -(long)(D * 2), (long)(D * 2)>(F.lds, F.tid, g, S, E);
            pg8::gemm_phase<EpiOddIn, true, D, 2048, 16, -(long)(D * 2), (long)(D * 2)>(F.lds, F.tid, g, S, E); }
        SEAM(base + 1);
        TS(base + 2); if (IN(base + 2)) { F.retid();
            conv_wrest(F, LI);
            if constexpr (LI < 3) conv_win_even(F, LI + 1);
            __syncthreads();
            { unsigned long long xa = 0; rwkv_stage_x<false>(F, LI, xa); if (LI == 1 && MK_XA >= 0) { tA = 0; tB = xa; } } }
        SEAM(base + 2);
        TS(base + 3); if (IN(base + 3)) { F.retid();
            rwkv_stage_y(F, false); }
        SEAM(base + 3);
        TS(base + 4); if (IN(base + 4)) { F.retid(); if (MK_PROBE == 7) rwkv_stage_z<true>(F, LI); rwkv_stage_z<false>(F, LI); }
        SEAM(base + 4);
        TS(base + 5); if (IN(base + 5)) { F.retid(); pg8::StaticOrder S; S.init(64, 4, F.G, bx);
            { pg8::Gemm g{(const bf16_t*)(F.ws + WS_PB), (const bf16_t*)(F.ws + WS_WPROJ)};
              EpiStore E{Zp, ZW}; pg8::gemm_phase<EpiStore, false, PLE, PLE, 1 << 20, 0, 0>(F.lds, F.tid, g, S, E); }
            { pg8::Gemm g{Zp + 3072, (const bf16_t*)(F.ws + WS_WOUT)};
              EpiResid E{F.H, Zp + 2048, ZW}; pg8::gemm_phase<EpiResid, false, ZW, D, 1 << 20, 0, 0>(F.lds, F.tid, g, S, E); } }
        SEAM(base + 5);
        TS(base + 6); if (IN(base + 6)) { F.retid(); pg8::StaticOrder S; S.init(64, 4, F.G, bx);
            pg8::Gemm g{Zp + 2048, (const bf16_t*)(F.ws + WS_WGATE)};
            EpiGate E{F.H, Zp, ZW, (bf16_t*)(F.ws + WS_HB), F.ssq(LI + 1)};
            pg8::gemm_phase<EpiGate, false, ZW, D, 1 << 20, 0, 0>(F.lds, F.tid, g, S, E); }
        SEAM(base + 6);
    }
}
__global__ void __launch_bounds__(512, 2) mk_fwd(Args args) {
    extern __shared__ __attribute__((aligned(16))) unsigned char lds_raw[];
    Frame F;
    F.lds = (LAS unsigned char*)lds_raw; F.ldsg = lds_raw;
    F.tid = threadIdx.x; F.lane = F.tid & 63; F.wave = __builtin_amdgcn_readfirstlane(F.tid >> 6);
    F.G = gridDim.x; const int bx = blockIdx.x; F.vcu = (F.G % 8 == 0) ? (bx % 8) * (F.G / 8) + bx / 8 : bx;
    F.H = args.out; F.ws = args.ws;
    volatile LAS unsigned* MISC = (volatile LAS unsigned*)(F.lds + MISC_OFF);
    for (int u = F.tid; u < 128; u += 512) ((LAS unsigned*)(F.lds + MISC_OFF))[u] = 0u;
    __syncthreads();
    XcdBarrier bar; bar.bar = (unsigned*)(F.ws + WS_CTL) + 4096; bar.x = 0; bar.st = nullptr;
#if !MK_MULTI
    bar = xcd_barrier_post((unsigned*)(F.ws + WS_CTL) + 4096, MISC + 8);
#endif
    const int lo = args.ph_lo, hi = args.ph_hi;
    if (IN(PH_P0)) { F.retid(); rows_p0(F); conv_win_even(F, 0); }
#if !MK_MULTI
    if (IN(0) && IN(1)) { VM_WAIT(); cg::this_grid().sync(); }
#endif
    unsigned long long tA = 0, tB = 0;
    TS(0);
    run_layer<0>(F, bar, lo, hi, bx, tA, tB);
    run_layer<1>(F, bar, lo, hi, bx, tA, tB);
    run_layer<2>(F, bar, lo, hi, bx, tA, tB);
    run_layer<3>(F, bar, lo, hi, bx, tA, tB);
    TS(PH_FINAL);
    if (IN(PH_FINAL)) { F.retid(); rows_final(F); }
    TS(PH_FINAL + 1);
    if ((MK_TPA >= 0 || MK_XA >= 0) && blockIdx.x == 0 && threadIdx.x == 0) { const unsigned long long t0 = __builtin_amdgcn_s_memrealtime(), span = 4ull * (tB - tA); while (__builtin_amdgcn_s_memrealtime() - t0 < span) __builtin_amdgcn_s_sleep(8); }
}

extern "C" void kernel_launch(void* const* d_in, const int* in_sizes, int n_in, void* d_out, int out_size, void* d_ws, size_t ws_size, hipStream_t stream) {
    static int grid = 0;
    if (grid == 0) {
        int dev = 0, cus = 0, per_cu = 0;
        (void)hipGetDevice(&dev); (void)hipDeviceGetAttribute(&cus, hipDeviceAttributeMultiprocessorCount, dev);
        (void)hipFuncSetAttribute((const void*)mk_fwd, hipFuncAttributeMaxDynamicSharedMemorySize, LDS_BYTES);
        (void)hipOccupancyMaxActiveBlocksPerMultiprocessor(&per_cu, (const void*)mk_fwd, 512, LDS_BYTES);
        if (per_cu < 1) per_cu = 1;
        grid = cus * 1;
        if (n_in != 26 || ws_size < WS_END) fprintf(stderr, "kernel_launch: unexpected n_in %d / ws %zu\n", n_in, ws_size);
        (void)hipGetLastError();
    }
    (void)hipMemsetAsync((char*)d_ws + WS_CTL, 0, CTL_BYTES, stream);
    Args a{};
    for (int i = 0; i < 26; ++i) a.in[i] = (const float*)d_in[i];
    a.out = (float*)d_out; a.ws = (unsigned char*)d_ws;
#if MK_MULTI
    for (int ph = 0; ph < N_PHASES; ++ph) { a.ph_lo = ph; a.ph_hi = ph + 1; hipLaunchKernelGGL(mk_fwd, dim3(grid), dim3(512), LDS_BYTES, stream, a); }
#else
    a.ph_lo = 0; a.ph_hi = N_PHASES;
    void* kargs[] = {&a};
    hipError_t e = hipLaunchCooperativeKernel((const void*)mk_fwd, dim3(grid), dim3(512), kargs, LDS_BYTES, stream);
    if (e != hipSuccess) fprintf(stderr, "cooperative launch failed: %s (grid %d)\n", hipGetErrorString(e), grid);
#endif
}
```

```cpp
#include <hip/hip_runtime.h>
#include <hip/hip_cooperative_groups.h>
#include <cstdint>
#include <cstdio>
namespace cg = cooperative_groups;

#ifndef MK_PROBE
#define MK_PROBE 0
#endif
#ifndef MK_TPA
#define MK_TPA -1
#define MK_TPB -1
#endif
#ifndef MK_XA
#define MK_XA -1
#define MK_XB -1
#endif
#ifndef MK_GA
#define MK_GA -1
#define MK_GB -1
#endif
#ifndef MK_MULTI
#define MK_MULTI 0
#endif

#define LAS __attribute__((address_space(3)))
#define GAS __attribute__((address_space(1)))
typedef unsigned short bf16_t;
typedef short bf16x8 __attribute__((ext_vector_type(8)));
typedef float f32x4 __attribute__((ext_vector_type(4)));
typedef float f32x2 __attribute__((ext_vector_type(2)));
typedef unsigned u32x4 __attribute__((ext_vector_type(4)));
typedef unsigned u32x2 __attribute__((ext_vector_type(2)));

constexpr int D = 1024, BATCH = 2, SEQ = 8192, T = BATCH * SEQ, PLE = 256, ZW = 4096, ZE = 3072;
constexpr float QK_SCALE = 0.08838834764831845f;

__device__ __forceinline__ float bf2f(bf16_t v) { return __uint_as_float(((unsigned)v) << 16); }
__device__ __forceinline__ unsigned f2bf(float f) { unsigned u = __float_as_uint(f); return (u + 0x7fffu + ((u >> 16) & 1u)) >> 16; }
__device__ __forceinline__ unsigned pk2(float lo, float hi) { return f2bf(lo) | (f2bf(hi) << 16); }
typedef __bf16 bf16x2_t __attribute__((ext_vector_type(2)));
__device__ __forceinline__ unsigned cvt_pk_bf16(float lo, float hi) { f32x2 v = {lo, hi}; bf16x2_t b = __builtin_convertvector(v, bf16x2_t); return __builtin_bit_cast(unsigned, b); }
__device__ __forceinline__ float wave_sum(float v) {
#pragma unroll
    for (int o = 1; o < 64; o <<= 1) v += __shfl_xor(v, o);
    return v;
}
__device__ __forceinline__ float sigmoidf_(float x) { return 1.f / (1.f + __expf(-x)); }
__device__ __forceinline__ float siluf_(float x) { return x / (1.f + __expf(-x)); }
__device__ __forceinline__ float softplusf_(float x) { return x > 20.f ? x : log1pf(expf(x)); }
__device__ __forceinline__ float logsigf_(float x) { return -(x < -20.f ? -x : log1pf(expf(-x))); }
__device__ __forceinline__ float ssq_sum(const float* sq, int row) { const f32x4* p = (const f32x4*)(sq + (size_t)row * 16); const f32x4 a = p[0], b = p[1], c = p[2], d = p[3];
    return (((a[0] + a[1]) + (a[2] + a[3])) + ((b[0] + b[1]) + (b[2] + b[3]))) + (((c[0] + c[1]) + (c[2] + c[3])) + ((d[0] + d[1]) + (d[2] + d[3]))); }
#define LDS_WAIT() asm volatile("s_waitcnt lgkmcnt(0)" ::: "memory")
#define VM_WAIT() asm volatile("s_waitcnt vmcnt(0)" ::: "memory")

namespace pg8 {
constexpr int BM = 256, BK = 64, HALF = 128, HTB = HALF * BK * 2, STAGE_BYTES = 8 * HTB, NXCD = 8, WGM = 8;
__host__ __device__ __forceinline__ int lds_byte(int r, int c) { const int st = (r >> 4) * 2 + (c >> 5), rr = r & 15, cc = c & 31, ob = rr * 64 + cc * 2; return st * 1024 + (ob ^ (((ob >> 9) & 1) << 5)); }
__host__ __device__ __forceinline__ void stage_rc(int b, int& R, int& C) { const int st = b / 1024, sb = b % 1024, swz = sb ^ (((sb >> 9) & 1) << 5); R = (st >> 1) * 16 + swz / 64; C = (st & 1) * 32 + (swz % 64) / 2; }
__host__ __device__ __forceinline__ int perm32(int rho) { const int n = rho >> 4, i = rho & 15; return 8 * (i >> 2) + 4 * n + (i & 3); }
struct Unit { int pm, pn; };
struct Gemm { const bf16_t* A; const bf16_t* Bt; };
struct StaticOrder {
    int nM, nN, nwg, G, c;
    __device__ void init(int nM_, int nN_, int G_, int c_) { nM = nM_; nN = nN_; nwg = nM * nN; G = G_; c = c_; }
    __device__ bool next(int i, Unit& u) const {
        const long L = (long)i * G + c; if (L >= nwg) return false;
        int wgid = (int)L; { const int q = nwg / NXCD, r = nwg % NXCD, xcd = wgid % NXCD, off = wgid / NXCD; wgid = (xcd < r ? xcd * (q + 1) : r * (q + 1) + (xcd - r) * q) + off; }
        const int nig = WGM * nN, gid = wgid / nig, fm = gid * WGM, gsz = (nM - fm) < WGM ? (nM - fm) : WGM;
        u.pm = fm + ((wgid % nig) % gsz); u.pn = (wgid % nig) / gsz; return true;
    }
};
template <class Epi, bool ALIGN_EPI, int LDA, int KK, int TSPLIT, long ASHIFT, long BROW>
__device__ __forceinline__ void gemm_phase(LAS unsigned char* lds, const int tid_in, const Gemm g, const StaticOrder& S, const Epi& E) {
    int tid = tid_in; asm volatile("" : "+v"(tid));
    const int wid = __builtin_amdgcn_readfirstlane(tid >> 6), lane = tid & 63, wr = wid >> 2, wc = wid & 3, fr = lane & 15, fq = lane >> 4;
    constexpr int K = KK, nt = K / BK, lda = LDA, tsplit = TSPLIT; constexpr long ashift = ASHIFT;
    unsigned voffA[2], voffB[2];
#pragma unroll
    for (int i = 0; i < 2; ++i) { int R, C; stage_rc(tid * 16 + i * 8192, R, C); const int Rb = (R & ~31) + perm32(R & 31);
        voffA[i] = (unsigned)(R * lda + C) * 2u; voffB[i] = (unsigned)(Rb * K + C) * 2u; }
    constexpr size_t kstep = (size_t)(BK * 2);
    constexpr size_t hstepA = (size_t)HALF * lda * 2, hstepB = (size_t)HALF * K * 2, tstepA = 2 * hstepA, tstepB = 2 * hstepB;
    const unsigned ldsw = (unsigned)wid * 1024u;
    const int aoff = lds_byte(wr * 64 + fr, fq * 8), boff = lds_byte(wc * 32 + fr, fq * 8);
#define PG8_AP(base, tt) ((base) + (((tt) < tsplit) ? (long)(tt) * 128 : ashift + (long)((tt) - tsplit) * 128))
#define PG8_ABASE(u) ((const char*)g.A + (size_t)(u).pm * tstepA + ((BROW != 0 && (u).pm >= 32) ? BROW : 0))
#define PG8_SA(b, h) (((b) * 2 + (h)) * HTB)
#define PG8_SB(b, h) ((4 + (b) * 2 + (h)) * HTB)
#define PG8_STAGE(bufoff, gbase, voff) do { const char* _gb = (const char*)(gbase); asm volatile("" : "+s"(_gb)); _Pragma("unroll") for (int _i = 0; _i < 2; ++_i) \
        __builtin_amdgcn_global_load_lds((const unsigned*)(_gb + (voff)[_i]), (LAS unsigned*)(lds + (bufoff) + ldsw + _i * 8192), 16, 0, 0); } while (0)
#define PG8_LDA(dst, b, h) do { _Pragma("unroll") for (int m = 0; m < 4; ++m) _Pragma("unroll") for (int k = 0; k < 2; ++k) dst[m][k] = *(const LAS bf16x8*)(lds + PG8_SA(b, h) + aoff + m * 2048 + k * 1024); } while (0)
#define PG8_LDB(dst, b, h) do { _Pragma("unroll") for (int n = 0; n < 2; ++n) _Pragma("unroll") for (int k = 0; k < 2; ++k) dst[n][k] = *(const LAS bf16x8*)(lds + PG8_SB(b, h) + boff + n * 2048 + k * 1024); } while (0)
#define PG8_MMA(ai, bj, At, Bt) do { __builtin_amdgcn_s_setprio(1); _Pragma("unroll") for (int m = 0; m < 4; ++m) _Pragma("unroll") for (int n = 0; n < 2; ++n) _Pragma("unroll") for (int k = 0; k < 2; ++k) \
        acc[ai][bj][m][n] = __builtin_amdgcn_mfma_f32_16x16x32_bf16(Bt[n][k], At[m][k], acc[ai][bj][m][n], 0, 0, 0); __builtin_amdgcn_s_setprio(0); } while (0)
#define PG8_WAIT_V(n) asm volatile("s_waitcnt vmcnt(" #n ")" ::: "memory")
#define PG8_WAIT_L(n) asm volatile("s_waitcnt lgkmcnt(" #n ")" ::: "memory")
#define PG8_BAR __builtin_amdgcn_s_barrier()
#define PG8_SCHED __builtin_amdgcn_sched_barrier(0)
    Unit cur, nxt; int ui = 0;
    if (!S.next(0, cur)) return;
    f32x4 acc[2][2][4][2];
#pragma unroll
    for (int a = 0; a < 2; ++a)
#pragma unroll
        for (int b = 0; b < 2; ++b)
#pragma unroll
            for (int m = 0; m < 4; ++m)
#pragma unroll
                for (int n = 0; n < 2; ++n) acc[a][b][m][n] = (f32x4){0.f, 0.f, 0.f, 0.f};
    bf16x8 At[4][2], B0[2][2], B1[2][2];
    const char* cA = PG8_ABASE(cur); const char* cB = (const char*)g.Bt + (size_t)cur.pn * tstepB;
    {
        const char* a0 = PG8_AP(cA, 0); const char* a1 = PG8_AP(cA, 1);
        PG8_STAGE(PG8_SB(0, 0), cB, voffB); PG8_STAGE(PG8_SB(0, 1), cB + hstepB, voffB); PG8_STAGE(PG8_SA(0, 0), a0, voffA); PG8_STAGE(PG8_SA(0, 1), a0 + hstepA, voffA);
        if (wr == 1) PG8_BAR;
        PG8_WAIT_V(2); PG8_BAR;
        PG8_STAGE(PG8_SB(1, 0), cB + kstep, voffB); PG8_STAGE(PG8_SA(1, 0), a1, voffA); PG8_STAGE(PG8_SB(1, 1), cB + hstepB + kstep, voffB);
        PG8_WAIT_V(6); PG8_BAR;
    }
    for (;;) {
        const bool has_next = S.next(ui + 1, nxt);
        const char* nA = has_next ? PG8_ABASE(nxt) : cA; const char* nB = has_next ? (const char*)g.Bt + (size_t)nxt.pn * tstepB : cB;
        for (int t = 0; t < nt; t += 2) {
            const bool last = (t == nt - 2);
            const char* a1 = PG8_AP(cA, t + 1);
            const char* a2 = last ? PG8_AP(nA, 0) : PG8_AP(cA, t + 2); const char* b2 = last ? nB : cB + (size_t)(t + 2) * kstep;
            const char* a3 = last ? PG8_AP(nA, 1) : PG8_AP(cA, t + 3); const char* b3 = b2 + kstep;
            PG8_LDB(B0, 0, 0); PG8_LDB(B1, 0, 1); PG8_SCHED; PG8_LDA(At, 0, 0); PG8_STAGE(PG8_SA(1, 1), a1 + hstepA, voffA);
            PG8_WAIT_V(8); PG8_WAIT_L(0); PG8_BAR; PG8_MMA(0, 0, At, B0); PG8_MMA(0, 1, At, B1); PG8_BAR; PG8_SCHED;
            PG8_LDA(At, 0, 1); PG8_STAGE(PG8_SB(0, 0), b2, voffB); PG8_STAGE(PG8_SB(0, 1), b2 + hstepB, voffB); PG8_STAGE(PG8_SA(0, 0), a2, voffA);
            PG8_WAIT_V(8); PG8_WAIT_L(0); PG8_BAR; PG8_MMA(1, 0, At, B0); PG8_MMA(1, 1, At, B1); PG8_BAR; PG8_SCHED;
            PG8_LDB(B0, 1, 0); PG8_LDB(B1, 1, 1); PG8_SCHED; PG8_LDA(At, 1, 0); PG8_STAGE(PG8_SA(0, 1), a2 + hstepA, voffA);
            PG8_WAIT_V(8); PG8_WAIT_L(0); PG8_BAR; PG8_MMA(0, 0, At, B0); PG8_MMA(0, 1, At, B1); PG8_BAR; PG8_SCHED;
            PG8_LDA(At, 1, 1); PG8_STAGE(PG8_SB(1, 0), b3, voffB); PG8_STAGE(PG8_SB(1, 1), b3 + hstepB, voffB); PG8_STAGE(PG8_SA(1, 0), a3, voffA);
            PG8_WAIT_V(8); PG8_WAIT_L(0); PG8_BAR; PG8_MMA(1, 0, At, B0); PG8_MMA(1, 1, At, B1); PG8_BAR; PG8_SCHED;
        }
        if constexpr (ALIGN_EPI) { if (wr == 0) PG8_BAR; }
        E(acc, cur, wr, wc, fr, fq);
        if (!has_next) break;
#pragma unroll
        for (int a = 0; a < 2; ++a)
#pragma unroll
            for (int b = 0; b < 2; ++b)
#pragma unroll
                for (int m = 0; m < 4; ++m)
#pragma unroll
                    for (int n = 0; n < 2; ++n) acc[a][b][m][n] = (f32x4){0.f, 0.f, 0.f, 0.f};
        cur = nxt; cA = nA; cB = nB; ++ui;
        if constexpr (ALIGN_EPI) { if (wr == 1) PG8_BAR; }
    }
    PG8_WAIT_V(0);
    if constexpr (!ALIGN_EPI) { if (wr == 0) PG8_BAR; }
    PG8_BAR;
#undef PG8_AP
#undef PG8_ABASE
#undef PG8_SA
#undef PG8_SB
#undef PG8_STAGE
#undef PG8_LDA
#undef PG8_LDB
#undef PG8_MMA
#undef PG8_WAIT_V
#undef PG8_WAIT_L
#undef PG8_BAR
#undef PG8_SCHED
}
}

template <class Fn>
__device__ __forceinline__ void epi_for(const f32x4 (&acc)[2][2][4][2], const pg8::Unit& u, int wr, int wc, int fr, int fq, Fn fn) {
#pragma unroll
    for (int ai = 0; ai < 2; ++ai)
#pragma unroll
        for (int m = 0; m < 4; ++m) { const int row = u.pm * 256 + ai * 128 + wr * 64 + m * 16 + fr;
#pragma unroll
            for (int bj = 0; bj < 2; ++bj) { const int col = u.pn * 256 + bj * 128 + wc * 32 + 8 * fq; fn(row, col, acc[ai][bj][m][0], acc[ai][bj][m][1]); }
            if (m & 1) asm volatile("" ::: "memory"); }
}
__device__ __forceinline__ u32x4 pack8(f32x4 v0, f32x4 v1) { u32x4 w; w.x = cvt_pk_bf16(v0[0], v0[1]); w.y = cvt_pk_bf16(v0[2], v0[3]); w.z = cvt_pk_bf16(v1[0], v1[1]); w.w = cvt_pk_bf16(v1[2], v1[3]); return w; }

struct EpiEvenIn {
    bf16_t* Z; const float* ssq; bf16_t* VTa; bf16_t* VTb; bf16_t* KT;
    __device__ __forceinline__ void operator()(const f32x4 (&acc)[2][2][4][2], const pg8::Unit& u, int wr, int wc, int fr, int fq) const {
        const int g = u.pn >> 1;
        epi_for(acc, u, wr, wc, fr, fq, [&](int row, int col, f32x4 v0, f32x4 v1) {
            const float rs = rsqrtf(ssq_sum(ssq, row) * (1.f / D) + 1e-6f);
            v0 = v0 * rs; v1 = v1 * rs;
            const int cg = col & 511, t = row & (SEQ - 1), b = row >> 13;
            if (g == 2 || g == 6) {
                bf16_t* p = (g == 2 ? VTa : VTb) + ((size_t)(b * 512 + cg)) * SEQ + t;
                _Pragma("unroll") for (int j = 0; j < 4; ++j) { p[(size_t)j * SEQ] = (bf16_t)f2bf(v0[j]); p[(size_t)(4 + j) * SEQ] = (bf16_t)f2bf(v1[j]); }
            } else if (g < 2) {
                const float pos = (float)t; const int i0 = (cg & 127) >> 1;
                float o[8] = {v0[0], v0[1], v0[2], v0[3], v1[0], v1[1], v1[2], v1[3]};
                _Pragma("unroll") for (int j = 0; j < 4; ++j) { const float inv = exp2f(-(float)(i0 + j) * (13.287712379549449f / 64.f));
                    float rev = pos * inv * 0.15915494309189535f; rev = rev - floorf(rev); const float sn = __builtin_amdgcn_sinf(rev), cs = __builtin_amdgcn_cosf(rev);
                    const float x1 = o[2 * j], x2 = o[2 * j + 1]; o[2 * j] = x1 * cs - x2 * sn; o[2 * j + 1] = x1 * sn + x2 * cs; }
                const float lg2 = log2f(1.f - exp2f(-5.f - (float)(cg >> 7))); const float ip1 = (float)((t & 127) + 1);
                if (g == 0) { const float f = exp2f(ip1 * lg2);
                    *(u32x4*)(Z + (size_t)row * ZE + cg) = pack8((f32x4){o[0] * f, o[1] * f, o[2] * f, o[3] * f}, (f32x4){o[4] * f, o[5] * f, o[6] * f, o[7] * f}); }
                else { const float f = exp2f(-ip1 * lg2), f2 = exp2f((128.f - ip1) * lg2);
                    *(u32x4*)(Z + (size_t)row * ZE + 512 + cg) = pack8((f32x4){o[0] * f, o[1] * f, o[2] * f, o[3] * f}, (f32x4){o[4] * f, o[5] * f, o[6] * f, o[7] * f});
                    bf16_t* p = KT + ((size_t)(b * 512 + cg)) * SEQ + t;
                    _Pragma("unroll") for (int j = 0; j < 8; ++j) p[(size_t)j * SEQ] = (bf16_t)f2bf(o[j] * f2); }
            } else {
                const int zc = (g - 1 - (g > 6 ? 1 : 0)) * 512;
                *(u32x4*)(Z + (size_t)row * ZE + zc + cg) = pack8(v0, v1);
            }
        });
    }
};
struct EpiOddIn {
    bf16_t* Z; bf16_t* L1;
    __device__ __forceinline__ void operator()(const f32x4 (&acc)[2][2][4][2], const pg8::Unit& u, int wr, int wc, int fr, int fq) const {
        if (u.pn < 16) { epi_for(acc, u, wr, wc, fr, fq, [&](int row, int col, f32x4 v0, f32x4 v1) { *(u32x4*)(Z + (size_t)row * ZW + col) = pack8(v0, v1); }); }
        else { epi_for(acc, u, wr, wc, fr, fq, [&](int row, int col, f32x4 v0, f32x4 v1) { const int c = col - 4096; if (c < 64) {
                    _Pragma("unroll") for (int j = 0; j < 4; ++j) { v0[j] = tanhf(v0[j]); v1[j] = tanhf(v1[j]); } }
                *(u32x4*)(L1 + (size_t)row * 256 + c) = pack8(v0, v1); }); }
    }
};
struct EpiResid {
    float* H; bf16_t* HB; int ldb;
    __device__ __forceinline__ void operator()(const f32x4 (&acc)[2][2][4][2], const pg8::Unit& u, int wr, int wc, int fr, int fq) const {
        epi_for(acc, u, wr, wc, fr, fq, [&](int row, int col, f32x4 v0, f32x4 v1) { float* hp = H + (size_t)row * D + col; f32x4 h0 = *(const f32x4*)hp, h1 = *(const f32x4*)(hp + 4); h0 = h0 + v0; h1 = h1 + v1;
            *(f32x4*)hp = h0; *(f32x4*)(hp + 4) = h1; *(u32x4*)(HB + (size_t)row * ldb + col) = pack8(h0, h1); });
    }
};
struct EpiStore {
    bf16_t* O; int ldc;
    __device__ __forceinline__ void operator()(const f32x4 (&acc)[2][2][4][2], const pg8::Unit& u, int wr, int wc, int fr, int fq) const {
        epi_for(acc, u, wr, wc, fr, fq, [&](int row, int col, f32x4 v0, f32x4 v1) { *(u32x4*)(O + (size_t)row * ldc + col) = pack8(v0, v1); });
    }
};
struct EpiGate {
    float* H; const bf16_t* PP; int ldp; bf16_t* HB2; float* ssq;
    __device__ __forceinline__ void operator()(const f32x4 (&acc)[2][2][4][2], const pg8::Unit& u, int wr, int wc, int fr, int fq) const {
#pragma unroll
        for (int ai = 0; ai < 2; ++ai)
#pragma unroll
            for (int m = 0; m < 4; ++m) { const int row = u.pm * 256 + ai * 128 + wr * 64 + m * 16 + fr; float sq = 0.f;
#pragma unroll
                for (int bj = 0; bj < 2; ++bj) { const int col = u.pn * 256 + bj * 128 + wc * 32 + 8 * fq; const f32x4 v0 = acc[ai][bj][m][0], v1 = acc[ai][bj][m][1];
                    float* hp = H + (size_t)row * D + col; f32x4 h0 = *(const f32x4*)hp, h1 = *(const f32x4*)(hp + 4); const u32x4 pw = *(const u32x4*)(PP + (size_t)row * ldp + col);
                    const unsigned pwv[4] = {pw.x, pw.y, pw.z, pw.w};
                    float pp[8];
#pragma unroll
                    for (int j = 0; j < 4; ++j) { pp[2 * j] = __uint_as_float(pwv[j] << 16); pp[2 * j + 1] = __uint_as_float(pwv[j] & 0xffff0000u); }
#pragma unroll
                    for (int j = 0; j < 4; ++j) { h0[j] += sigmoidf_(v0[j]) * pp[j]; h1[j] += sigmoidf_(v1[j]) * pp[4 + j]; sq += h0[j] * h0[j] + h1[j] * h1[j]; }
                    *(f32x4*)hp = h0; *(f32x4*)(hp + 4) = h1; if (HB2) *(u32x4*)(HB2 + (size_t)row * D + col) = pack8(h0, h1); }
                sq += __shfl_xor(sq, 16); sq += __shfl_xor(sq, 32);
                if (fq == 0) ssq[(size_t)row * 16 + u.pn * 4 + wc] = sq;
                if (m & 1) asm volatile("" ::: "memory"); }
    }
};

#define XB_TMO      128
#define XB_XCNT(j)  (256  + 64 * (j))
#define XB_XSUB(j)  (1280 + 64 * (j))
#define XB_XGEN(j)  (2304 + 64 * (j))
#define XB_TOP      3328
#define XB_TOPGEN   3392
#define XCD_BAR_WORDS 3456
#define XB_SPIN_CAP (1u << 22)
__device__ __forceinline__ unsigned xb_ld(unsigned* p)              { return __hip_atomic_load(p, __ATOMIC_RELAXED, __HIP_MEMORY_SCOPE_AGENT); }
__device__ __forceinline__ unsigned xb_add(unsigned* p, unsigned v) { return __hip_atomic_fetch_add(p, v, __ATOMIC_RELAXED, __HIP_MEMORY_SCOPE_AGENT); }
__device__ __forceinline__ unsigned xb_xcc_id() { return (unsigned)__builtin_amdgcn_s_getreg((3 << 11) | 20) & 0xFu; }
#define XB_SPIN(cond, bar) do { unsigned _sp = 0; while (cond) { __builtin_amdgcn_s_sleep(1); \
    if ((++_sp & 255u) == 0u) { if (xb_ld(&(bar)[XB_TMO])) break; if (_sp > XB_SPIN_CAP) { atomicAdd(&(bar)[XB_TMO], 1u); break; } } } } while (0)
struct XcdBarrier { unsigned* bar; unsigned x; volatile LAS unsigned* st; };
__device__ __forceinline__ XcdBarrier xcd_barrier_post(unsigned* bar, volatile LAS unsigned* st) {
    XcdBarrier b; b.bar = bar; b.x = xb_xcc_id(); b.st = st;
    if (threadIdx.x == 0) (void)xb_add(&bar[XB_XCNT(b.x)], 1u);
    return b;
}
__device__ __forceinline__ void xcd_barrier_complete(unsigned* bar, unsigned x, unsigned& nloc, unsigned& nx) {
    const unsigned G = gridDim.x * gridDim.y * gridDim.z;
    unsigned sum, cnt, mine, sp = 0u;
    for (;;) {
        sum = 0u; cnt = 0u; mine = 0u;
#pragma unroll
        for (unsigned j = 0; j < 16; ++j) { const unsigned c = xb_ld(&bar[XB_XCNT(j)]); sum += c; cnt += (c > 0u) ? 1u : 0u; mine = (j == x) ? c : mine; }
        if (sum == G) break;
        __builtin_amdgcn_s_sleep(1);
        if ((++sp & 255u) == 0u) { if (xb_ld(&bar[XB_TMO])) break; if (sp > XB_SPIN_CAP) { atomicAdd(&bar[XB_TMO], 1u); break; } }
    }
    nloc = mine > 0u ? mine : 1u; nx = cnt > 0u ? cnt : 1u;
}
__device__ __forceinline__ void xcd_barrier(const XcdBarrier& b_in) {
    asm volatile("s_waitcnt vmcnt(0)" ::: "memory");
    __syncthreads();
    if (threadIdx.x == 0) {
        const XcdBarrier& b = b_in;
        unsigned* bar = b.bar;
        __builtin_amdgcn_s_waitcnt(0);
        unsigned nloc = b.st[0], nx = b.st[1];
        if (nloc == 0u) { xcd_barrier_complete(bar, b.x, nloc, nx); b.st[0] = nloc; b.st[1] = nx; }
        const unsigned old = xb_add(&bar[XB_XSUB(b.x)], 1u);
        const unsigned gen = old / nloc;
        if (old + 1u == (gen + 1u) * nloc) {
            __builtin_amdgcn_fence(__ATOMIC_RELEASE, "agent");
            asm volatile("s_waitcnt vmcnt(0)" ::: "memory");
            const unsigned og = xb_add(&bar[XB_TOP], 1u);
            const unsigned tg = og / nx;
            if (og + 1u == (tg + 1u) * nx) xb_add(&bar[XB_TOPGEN], 1u);
            else XB_SPIN(xb_ld(&bar[XB_TOPGEN]) == tg, bar);
            __builtin_amdgcn_fence(__ATOMIC_ACQUIRE, "agent");
            xb_add(&bar[XB_XGEN(b.x)], 1u);
            asm volatile("s_waitcnt vmcnt(0)" ::: "memory");
        } else {
            XB_SPIN(xb_ld(&bar[XB_XGEN(b.x)]) == gen, bar);
            __builtin_amdgcn_fence(__ATOMIC_ACQUIRE, "agent");
            asm volatile("s_waitcnt vmcnt(0)" ::: "memory");
        }
    }
    __syncthreads();
}

constexpr size_t MiB = 1u << 20;
constexpr size_t WS_CTL = 0, CTL_BYTES = 1 * MiB;
constexpr size_t WS_SSQ = 241 * (size_t)(1u << 20);
constexpr size_t WS_WIN = 2 * MiB;
constexpr size_t WS_WOUT = 19 * MiB, WS_WGATE = 21 * MiB, WS_WPROJ = 23 * MiB;
constexpr size_t WS_PB = 24 * MiB;
constexpr size_t WS_Z = 32 * MiB;
constexpr size_t WS_HB = 160 * MiB;
constexpr size_t WS_VF = 193 * MiB;
constexpr size_t WS_L1 = 225 * MiB;
constexpr size_t WS_VTA = 128 * MiB;
constexpr size_t WS_VTB = 144 * MiB;
constexpr size_t WS_KT = 225 * MiB;
constexpr size_t WS_LORA2 = 23 * MiB + 512 * 1024;
constexpr size_t WS_PG = 160 * MiB;
constexpr size_t WS_SB = 2 * MiB;
constexpr size_t WS_BON = 233 * MiB;
constexpr size_t WS_ST = 176 * MiB;
constexpr size_t WS_KV = 160 * MiB;
constexpr size_t WS_END = 256 * MiB;

constexpr int RING_BYTES = 131072, LDS_BYTES = 163840, MISC_OFF = LDS_BYTES - 512;

struct Args { const float* in[26]; float* out; unsigned char* ws; int ph_lo, ph_hi; };

__device__ __forceinline__ const float* inptr(int i) { asm volatile("" : "+s"(i)); const char* ka = (const char*)__builtin_amdgcn_kernarg_segment_ptr(); return *(const float* const*)(ka + 8 * i); }
struct InTab { __device__ __forceinline__ const float* operator[](int i) const { return inptr(i); } };
struct Frame {
    LAS unsigned char* lds; unsigned char* ldsg;
    int tid, lane, wave, G, vcu;
    InTab in; float* H; unsigned char* ws;
    __device__ __forceinline__ void retid() { int l; asm volatile("v_mbcnt_lo_u32_b32 %0, -1, 0\n\tv_mbcnt_hi_u32_b32 %0, -1, %0" : "=v"(l)); lane = l; tid = wave * 64 + l; }
    __device__ __forceinline__ float* ssq(int l) const { return (float*)(ws + WS_SSQ) + (size_t)l * T * 16; }
};

__device__ __forceinline__ void conv_item(const float* W, int ldw, int Kmax, int k0, int n0, bf16_t* dst, int ldd, int dr0, int drs, int dk0,
                                          const float* svec, float sa, float sb, float sc, LAS float* scr, int lane) {
    float wv[32];
#pragma unroll
    for (int i = 0; i < 32; ++i) { const int k = k0 + 2 * i + (lane >> 5); wv[i] = (k < Kmax) ? W[(size_t)k * ldw + n0 + (lane & 31)] : 0.f; }
#pragma unroll
    for (int i = 0; i < 32; ++i) { const int kk = 2 * i + (lane >> 5), k = k0 + kk; const float f = (k < Kmax) ? (sa + sb * (svec ? svec[k] : 0.f)) * sc : 0.f;
        scr[kk * 33 + (lane & 31)] = wv[i] * f; }
    LDS_WAIT(); asm volatile("" ::: "memory");
    const int c = lane & 7;
    if (k0 + 8 * c < Kmax) {
#pragma unroll
        for (int j = 0; j < 4; ++j) { const int n = (lane >> 3) + 8 * j; const LAS float* s = scr + (8 * c) * 33 + n;
            u32x4 o; o.x = pk2(s[0 * 33], s[1 * 33]); o.y = pk2(s[2 * 33], s[3 * 33]); o.z = pk2(s[4 * 33], s[5 * 33]); o.w = pk2(s[6 * 33], s[7 * 33]);
            *(GAS u32x4*)(dst + (size_t)(dr0 + n * drs) * ldd + dk0 + k0 + 8 * c) = o; }
    }
    LDS_WAIT(); asm volatile("" ::: "memory");
}
__device__ __forceinline__ void conv_item2(const float* W, int ldw, int k0, int n0, bf16_t* dst, int dr0, const float* mu, float sc, LAS float* scr, int lane) {
    float wv[32];
#pragma unroll
    for (int i = 0; i < 32; ++i) wv[i] = W[(size_t)(k0 + 2 * i + (lane >> 5)) * ldw + n0 + (lane & 31)];
#pragma unroll
    for (int half = 0; half < 2; ++half) {
#pragma unroll
        for (int i = 0; i < 32; ++i) { const int kk = 2 * i + (lane >> 5); const float m = mu[k0 + kk]; scr[kk * 33 + (lane & 31)] = wv[i] * ((half ? m : 1.f - m) * sc); }
        LDS_WAIT(); asm volatile("" ::: "memory");
        const int c = lane & 7;
#pragma unroll
        for (int j = 0; j < 4; ++j) { const int n = (lane >> 3) + 8 * j; const LAS float* s_ = scr + (8 * c) * 33 + n;
            u32x4 o; o.x = pk2(s_[0 * 33], s_[1 * 33]); o.y = pk2(s_[2 * 33], s_[3 * 33]); o.z = pk2(s_[4 * 33], s_[5 * 33]); o.w = pk2(s_[6 * 33], s_[7 * 33]);
            *(GAS u32x4*)(dst + (size_t)(dr0 + n) * 2048 + half * 1024 + k0 + 8 * c) = o; }
        LDS_WAIT(); asm volatile("" ::: "memory");
    }
}
__device__ __forceinline__ void conv_win_even(Frame& F, int li) {
    const int e = li >> 1; const float* W = F.in[6] + (size_t)e * D * ZW; const float* gain = F.in[2] + li * D; bf16_t* dst = (bf16_t*)(F.ws + WS_WIN);
    LAS float* scr = (LAS float*)(F.lds + F.wave * 16384);
    const int gw = F.vcu * 8 + F.wave, NGW = F.G * 8;
    for (int it = gw; it < 16 * 128; it += NGW) { const int kb = it >> 7, nb = it & 127, n0 = nb * 32, g = n0 >> 9, hh = (n0 & 511) >> 7, d0 = n0 & 127;
        int dr0 = n0, drs = 1; if (g < 2) { dr0 = g * 512 + hh * 128 + (d0 < 64 ? 2 * d0 : 2 * (d0 - 64) + 1); drs = 2; }
        const float sc = (g == 1 || g == 5) ? QK_SCALE : 1.f;
        conv_item(W, ZW, D, kb * 64, n0, dst, D, dr0, drs, 0, gain, 0.f, 1.f, sc, scr, F.lane); }
}
__device__ __forceinline__ void conv_win_odd(Frame& F, int li) {
    const int o = li >> 1; const float* mu = F.in[9] + (size_t)o * 6 * D; bf16_t* dst = (bf16_t*)(F.ws + WS_WIN);
    LAS float* scr = (LAS float*)(F.lds + F.wave * 16384);
    const int gw = F.vcu * 8 + F.wave, NGW = F.G * 8;
    for (int it = gw; it < 4 * 512; it += NGW) { const int p = it >> 9, r = it & 511, kb = r >> 5, nb = r & 31;
        conv_item2(F.in[10] + ((size_t)o * 4 + p) * D * D, D, kb * 64, nb * 32, dst, p * 1024 + nb * 32, mu + p * D, 1.f, scr, F.lane); }
    for (int it = gw; it < 32 + 32 + 16; it += NGW) { const float* W; int ldw, n0, dr0, mi, kb; const int r = it;
        if (r < 32) { W = F.in[13] + (size_t)o * D * 64; ldw = 64; kb = r >> 1; n0 = (r & 1) * 32; dr0 = 4096 + n0; mi = 4; }
        else if (r < 64) { const int q = r - 32; W = F.in[16] + (size_t)o * D * 64; ldw = 64; kb = q >> 1; n0 = (q & 1) * 32; dr0 = 4160 + n0; mi = 5; }
        else { const int q = r - 64; W = F.in[19]; ldw = 32; kb = q; n0 = 0; dr0 = 4224; mi = 2; }
        conv_item2(W, ldw, kb * 64, n0, dst, dr0, mu + mi * D, (r >= 64 && o == 0) ? 0.f : 1.f, scr, F.lane); }
    { u32x4 z = {0u, 0u, 0u, 0u}; GAS u32x4* zp = (GAS u32x4*)(dst + (size_t)4256 * 2048); const int n16 = 96 * 2048 * 2 / 16;
      for (int i = (F.vcu * 512 + F.tid); i < n16; i += F.G * 512) zp[i] = z; }
}
__device__ __forceinline__ void conv_wrest(Frame& F, int li) {
    const bool even = (li & 1) == 0; const int e = li >> 1;
    const float* Wo = even ? F.in[7] + (size_t)e * D * D : F.in[11] + (size_t)e * D * D;
    const float* Wg = F.in[5] + (size_t)li * D * D; const float* Wp = F.in[4] + (size_t)li * PLE * D;
    LAS float* scr = (LAS float*)(F.lds + F.wave * 16384);
    const int gw = F.vcu * 8 + F.wave, NGW = F.G * 8;
    for (int it = gw; it < 512 + 512 + 128; it += NGW) {
        if (it < 512) conv_item(Wo, D, D, (it >> 5) * 64, (it & 31) * 32, (bf16_t*)(F.ws + WS_WOUT), D, (it & 31) * 32, 1, 0, nullptr, 1.f, 0.f, 1.f, scr, F.lane);
        else if (it < 1024) { const int r = it - 512; conv_item(Wg, D, D, (r >> 5) * 64, (r & 31) * 32, (bf16_t*)(F.ws + WS_WGATE), D, (r & 31) * 32, 1, 0, nullptr, 1.f, 0.f, 1.f, scr, F.lane); }
        else { const int r = it - 1024; conv_item(Wp, D, PLE, (r >> 5) * 64, (r & 31) * 32, (bf16_t*)(F.ws + WS_WPROJ), PLE, (r & 31) * 32, 1, 0, nullptr, 1.f, 0.f, 1.f, scr, F.lane); }
    }
    const float* P = F.in[1] + (size_t)li * T * PLE; GAS u32x4* pb = (GAS u32x4*)(F.ws + WS_PB); const int n8 = T * PLE / 8;
    for (int i = F.vcu * 512 + F.tid; i < n8; i += F.G * 512) { const f32x4 a = *(const f32x4*)(P + (size_t)i * 8), b = *(const f32x4*)(P + (size_t)i * 8 + 4);
        u32x4 o; o.x = pk2(a[0], a[1]); o.y = pk2(a[2], a[3]); o.z = pk2(b[0], b[1]); o.w = pk2(b[2], b[3]); pb[i] = o; }
}

__device__ __forceinline__ void conv_lora2(Frame& F, int li) {
    const int o = li >> 1; LAS float* scr = (LAS float*)(F.lds + F.wave * 16384);
    bf16_t* W2T = (bf16_t*)(F.ws + WS_LORA2); bf16_t* A2T = W2T + 1024 * 64; bf16_t* V2T = A2T + 1024 * 64;
    const int gw = F.vcu * 8 + F.wave, NGW = F.G * 8;
    for (int it = gw; it < 96; it += NGW) {
        if (it < 32) conv_item(F.in[14] + (size_t)o * 64 * D, D, 64, 0, it * 32, W2T, 64, it * 32, 1, 0, nullptr, 1.f, 0.f, 1.f, scr, F.lane);
        else if (it < 64) conv_item(F.in[17] + (size_t)o * 64 * D, D, 64, 0, (it - 32) * 32, A2T, 64, (it - 32) * 32, 1, 0, nullptr, 1.f, 0.f, 1.f, scr, F.lane);
        else conv_item(F.in[20], D, 32, 0, (it - 64) * 32, V2T, 32, (it - 64) * 32, 1, 0, nullptr, 1.f, 0.f, 1.f, scr, F.lane);
    }
}
__device__ __forceinline__ void rows_p0(Frame& F) {
    const float* x = F.in[0]; bf16_t* HB = (bf16_t*)(F.ws + WS_HB); float* s0 = F.ssq(0);
    for (int row = F.vcu * 8 + F.wave; row < T; row += F.G * 8) {
        const f32x4* xr = (const f32x4*)(x + (size_t)row * D) + F.lane; f32x4* hr = (f32x4*)(F.H + (size_t)row * D) + F.lane; u32x2* br = (u32x2*)(HB + (size_t)row * D) + F.lane; float s = 0.f;
#pragma unroll
        for (int j = 0; j < 4; ++j) { const f32x4 v = xr[64 * j]; s += (v[0] * v[0] + v[1] * v[1]) + (v[2] * v[2] + v[3] * v[3]); hr[64 * j] = v; u32x2 w; w.x = pk2(v[0], v[1]); w.y = pk2(v[2], v[3]); br[64 * j] = w; }
        s = wave_sum(s); if (F.lane < 16) s0[(size_t)row * 16 + F.lane] = F.lane == 0 ? s : 0.f;
    }
}
__device__ __forceinline__ void rows_norm(Frame& F, int li) {
    const float* gain = F.in[2] + li * D; bf16_t* HN = (bf16_t*)(F.ws + WS_HB); const float* sq = F.ssq(li);
    f32x4 g[4];
#pragma unroll
    for (int j = 0; j < 4; ++j) g[j] = *((const f32x4*)gain + F.lane + 64 * j);
    for (int row = F.vcu * 8 + F.wave; row < T; row += F.G * 8) {
        const f32x4* hr = (const f32x4*)(F.H + (size_t)row * D) + F.lane; u32x2* br = (u32x2*)(HN + (size_t)(row + 1 + (row >= SEQ ? 1 : 0)) * D) + F.lane;
        const float rs = rsqrtf(ssq_sum(sq, row) * (1.f / D) + 1e-6f);
#pragma unroll
        for (int j = 0; j < 4; ++j) { const f32x4 v = hr[64 * j] * rs * g[j]; u32x2 w; w.x = pk2(v[0], v[1]); w.y = pk2(v[2], v[3]); br[64 * j] = w; }
    }
    if (F.vcu == 0 && F.wave < 2) { u32x2* br = (u32x2*)(HN + (size_t)(F.wave ? SEQ + 1 : 0) * D) + F.lane; u32x2 z = {0u, 0u};
#pragma unroll
        for (int j = 0; j < 4; ++j) br[64 * j] = z; }
}
__device__ __forceinline__ void rows_final(Frame& F) {
    const float* gain = F.in[3]; const float* sq = F.ssq(4);
    f32x4 g[4];
#pragma unroll
    for (int j = 0; j < 4; ++j) g[j] = *((const f32x4*)gain + F.lane + 64 * j);
    for (int row = F.vcu * 8 + F.wave; row < T; row += F.G * 8) {
        f32x4* hr = (f32x4*)(F.H + (size_t)row * D) + F.lane; const float rs = rsqrtf(ssq_sum(sq, row) * (1.f / D) + 1e-6f);
#pragma unroll
        for (int j = 0; j < 4; ++j) hr[64 * j] = hr[64 * j] * rs * g[j];
    }
}

typedef float f32x16 __attribute__((ext_vector_type(16)));
template <bool DUMMY>
__device__ __forceinline__ void sb_unit(Frame& F, int bh, int qb) {
    const int lane = F.lane, l31 = lane & 31, hi = lane >> 5, b = bh >> 2, h = bh & 3;
    bf16_t* Z = (bf16_t*)(F.ws + WS_Z); const bf16_t* VT = (const bf16_t*)(F.ws + WS_VTB) + (size_t)bh * 128 * SEQ;
    const size_t rowb = (size_t)b * SEQ; const int q0 = qb * 32, tq = q0 + l31;
    bf16x8 qr[8];
    { const bf16_t* qp = Z + (rowb + tq) * ZE + 1536 + h * 128 + hi * 8;
#pragma unroll
      for (int ks = 0; ks < 8; ++ks) qr[ks] = *(const bf16x8*)(qp + 16 * ks); }
    f32x16 o[4];
#pragma unroll
    for (int d = 0; d < 4; ++d)
#pragma unroll
        for (int r = 0; r < 16; ++r) o[d][r] = 0.f;
    float carry = 1.f;
    const int pi = 16 * ((l31 >> 2) & 1) + (l31 & 3) + 4 * (l31 >> 3);
    const bf16_t* Kb = Z + rowb * ZE + 2048 + h * 128 + hi * 8;
    for (int kt = (q0 + 31) >> 6; kt >= 0; --kt) {
        const int kbase = kt * 64;
        const bf16_t* kp0 = Kb + (size_t)(kbase + pi) * ZE; const bf16_t* kp1 = kp0 + (size_t)32 * ZE;
        f32x16 p0, p1;
#pragma unroll
        for (int r = 0; r < 16; ++r) { p0[r] = 0.f; p1[r] = 0.f; }
#pragma unroll
        for (int ks = 0; ks < 8; ++ks) { const bf16x8 a0 = *(const bf16x8*)(kp0 + 16 * ks), a1 = *(const bf16x8*)(kp1 + 16 * ks);
            p0 = __builtin_amdgcn_mfma_f32_32x32x16_bf16(a0, qr[ks], p0, 0, 0, 0); p1 = __builtin_amdgcn_mfma_f32_32x32x16_bf16(a1, qr[ks], p1, 0, 0, 0); }
        float f1 = 1.f, f0 = 1.f;
        const int k1 = kbase + 32 + 16 * hi, k0 = kbase + 16 * hi;
#pragma unroll
        for (int r = 15; r >= 0; --r) { const float z = fminf(p1[r], 80.f); const float e = exp2f(z * 1.4426950408889634f); float rd = __builtin_amdgcn_rcpf(1.f + e); float be = e * rd;
            const bool valid = (k1 + r) < tq; be = valid ? be : 0.f; rd = valid ? rd : 1.f; p1[r] = be * f1; f1 *= rd; }
#pragma unroll
        for (int r = 15; r >= 0; --r) { const float z = fminf(p0[r], 80.f); const float e = exp2f(z * 1.4426950408889634f); float rd = __builtin_amdgcn_rcpf(1.f + e); float be = e * rd;
            const bool valid = (k0 + r) < tq; be = valid ? be : 0.f; rd = valid ? rd : 1.f; p0[r] = be * f0; f0 *= rd; }
        const float pf0 = __shfl_xor(f0, 32), pf1 = __shfl_xor(f1, 32);
        const float tail1 = hi ? 1.f : pf1;
        const float tail0 = hi ? (pf1 * f1) : (pf0 * f1 * pf1);
        const float s1 = tail1 * carry, s0 = tail0 * carry;
        carry *= (f0 * f1) * (pf0 * pf1);
        u32x4 pa[2][2];
#pragma unroll
        for (int s = 0; s < 2; ++s) {
            pa[0][s].x = cvt_pk_bf16(p0[8 * s + 0] * s0, p0[8 * s + 1] * s0); pa[0][s].y = cvt_pk_bf16(p0[8 * s + 2] * s0, p0[8 * s + 3] * s0);
            pa[0][s].z = cvt_pk_bf16(p0[8 * s + 4] * s0, p0[8 * s + 5] * s0); pa[0][s].w = cvt_pk_bf16(p0[8 * s + 6] * s0, p0[8 * s + 7] * s0);
            pa[1][s].x = cvt_pk_bf16(p1[8 * s + 0] * s1, p1[8 * s + 1] * s1); pa[1][s].y = cvt_pk_bf16(p1[8 * s + 2] * s1, p1[8 * s + 3] * s1);
            pa[1][s].z = cvt_pk_bf16(p1[8 * s + 4] * s1, p1[8 * s + 5] * s1); pa[1][s].w = cvt_pk_bf16(p1[8 * s + 6] * s1, p1[8 * s + 7] * s1);
        }
        const bf16_t* vp = VT + (size_t)l31 * SEQ + kbase + 16 * hi;
#pragma unroll
        for (int d = 0; d < 4; ++d)
#pragma unroll
            for (int blk = 0; blk < 2; ++blk)
#pragma unroll
                for (int s = 0; s < 2; ++s) { const bf16x8 vb = *(const bf16x8*)(vp + (size_t)(32 * d) * SEQ + 32 * blk + 8 * s);
                    o[d] = __builtin_amdgcn_mfma_f32_32x32x16_bf16(__builtin_bit_cast(bf16x8, pa[blk][s]), vb, o[d], 0, 0, 0); }
        if (__all(carry < 7.9e-31f)) break;
    }
#pragma unroll
    for (int r = 0; r < 16; ++r) { const int qrow = q0 + (r & 3) + 8 * (r >> 2) + 4 * hi; bf16_t* gp = Z + (rowb + qrow) * ZE + 2560 + h * 128 + l31;
#pragma unroll
        for (int d = 0; d < 4; ++d) { const float g = bf2f(gp[32 * d]); const float ov = o[d][r] * siluf_(g); if (!DUMMY) gp[32 * d] = (bf16_t)f2bf(ov); else asm volatile("" :: "v"(ov)); } }
}
__device__ __forceinline__ void ret_stage_a(Frame& F, int u) {
    const int l31 = F.lane & 31, hi = F.lane >> 5, cu = u >> 3, w8 = u & 7, bh = cu & 7, n = cu >> 3, dvb = w8 >> 1, dkp = w8 & 1;
    const bf16_t* vt = (const bf16_t*)(F.ws + WS_VTA) + ((size_t)(bh * 128 + 32 * dvb + l31)) * SEQ + n * 128 + 8 * hi;
    const bf16_t* kt = (const bf16_t*)(F.ws + WS_KT) + ((size_t)(bh * 128 + 64 * dkp + l31)) * SEQ + n * 128 + 8 * hi;
    f32x16 a0, a1;
#pragma unroll
    for (int r = 0; r < 16; ++r) { a0[r] = 0.f; a1[r] = 0.f; }
#pragma unroll
    for (int ks = 0; ks < 8; ++ks) { const bf16x8 va = *(const bf16x8*)(vt + 16 * ks), k0 = *(const bf16x8*)(kt + 16 * ks), k1 = *(const bf16x8*)(kt + (size_t)32 * SEQ + 16 * ks);
        a0 = __builtin_amdgcn_mfma_f32_32x32x16_bf16(va, k0, a0, 0, 0, 0); a1 = __builtin_amdgcn_mfma_f32_32x32x16_bf16(va, k1, a1, 0, 0, 0); }
    bf16_t* kv = (bf16_t*)(F.ws + WS_KV) + ((size_t)cu * 128 + 32 * dvb) * 128 + 64 * dkp + l31;
#pragma unroll
    for (int r = 0; r < 16; ++r) { const int dv = (r & 3) + 8 * (r >> 2) + 4 * hi; kv[dv * 128] = (bf16_t)f2bf(a0[r]); kv[dv * 128 + 32] = (bf16_t)f2bf(a1[r]); }
}
__device__ __forceinline__ void ret_stage_b(Frame& F) {
    const int e = F.vcu * 512 + F.tid; if (e >= 8 * 128 * 128) return;
    const int h = (e >> 14) & 3; const float g128 = exp2f(128.f * log2f(1.f - exp2f(-5.f - (float)h)));
    const bf16_t* p = (const bf16_t*)(F.ws + WS_KV) + e; bf16_t* q = (bf16_t*)(F.ws + WS_ST) + e; float S = 0.f;
#pragma unroll 4
    for (int n = 0; n < 64; ++n) { const float kv = bf2f(p[(size_t)n * 131072]); q[(size_t)n * 131072] = (bf16_t)f2bf(S); S = S * g128 + kv; }
}
template <bool DUMMY>
__device__ __forceinline__ void ret_stage_c(Frame& F, int u, const float* gng) {
    const int lane = F.lane, l31 = lane & 31, hi = lane >> 5, cu = u >> 2, qblk = u & 3, bh = cu & 7, n = cu >> 3, b = bh >> 2, h = bh & 3;
    bf16_t* Z = (bf16_t*)(F.ws + WS_Z); const size_t rowb = (size_t)b * SEQ; const int t0 = n * 128, tq = t0 + 32 * qblk + l31;
    bf16x8 qr[8];
    { const bf16_t* qp = Z + (rowb + tq) * ZE + h * 128 + hi * 8;
#pragma unroll
      for (int ks = 0; ks < 8; ++ks) qr[ks] = *(const bf16x8*)(qp + 16 * ks); }
    f32x16 o[4];
#pragma unroll
    for (int d = 0; d < 4; ++d)
#pragma unroll
        for (int r = 0; r < 16; ++r) o[d][r] = 0.f;
    { const bf16_t* sp = (const bf16_t*)(F.ws + WS_ST) + ((size_t)cu * 128 + l31) * 128 + 8 * hi;
#pragma unroll
      for (int ks = 0; ks < 8; ++ks)
#pragma unroll
          for (int d = 0; d < 4; ++d) { const bf16x8 sb = *(const bf16x8*)(sp + (size_t)(32 * d) * 128 + 16 * ks); o[d] = __builtin_amdgcn_mfma_f32_32x32x16_bf16(qr[ks], sb, o[d], 0, 0, 0); } }
    const int pi = 16 * ((l31 >> 2) & 1) + (l31 & 3) + 4 * (l31 >> 3);
    const bf16_t* Kb = Z + rowb * ZE + 512 + h * 128 + hi * 8;
    const bf16_t* VT = (const bf16_t*)(F.ws + WS_VTA) + ((size_t)(bh * 128 + l31)) * SEQ + 16 * hi;
    for (int kb = 0; kb <= qblk; ++kb) {
        const int kbase = t0 + 32 * kb; const bf16_t* kp = Kb + (size_t)(kbase + pi) * ZE;
        f32x16 p;
#pragma unroll
        for (int r = 0; r < 16; ++r) p[r] = 0.f;
#pragma unroll
        for (int ks = 0; ks < 8; ++ks) { const bf16x8 a = *(const bf16x8*)(kp + 16 * ks); p = __builtin_amdgcn_mfma_f32_32x32x16_bf16(a, qr[ks], p, 0, 0, 0); }
        if (kb == qblk) {
#pragma unroll
            for (int r = 0; r < 16; ++r) p[r] = (kbase + 16 * hi + r <= tq) ? p[r] : 0.f; }
        u32x4 pa[2];
#pragma unroll
        for (int s = 0; s < 2; ++s) { pa[s].x = cvt_pk_bf16(p[8 * s], p[8 * s + 1]); pa[s].y = cvt_pk_bf16(p[8 * s + 2], p[8 * s + 3]); pa[s].z = cvt_pk_bf16(p[8 * s + 4], p[8 * s + 5]); pa[s].w = cvt_pk_bf16(p[8 * s + 6], p[8 * s + 7]); }
#pragma unroll
        for (int d = 0; d < 4; ++d)
#pragma unroll
            for (int s = 0; s < 2; ++s) { const bf16x8 vb = *(const bf16x8*)(VT + (size_t)(32 * d) * SEQ + kbase + 8 * s);
                o[d] = __builtin_amdgcn_mfma_f32_32x32x16_bf16(__builtin_bit_cast(bf16x8, pa[s]), vb, o[d], 0, 0, 0); }
    }
    float gg[4];
#pragma unroll
    for (int d = 0; d < 4; ++d) gg[d] = gng[h * 128 + 32 * d + l31];
#pragma unroll
    for (int r = 0; r < 16; ++r) {
        float sm = (o[0][r] + o[1][r]) + (o[2][r] + o[3][r]);
        sm += __shfl_xor(sm, 1); sm += __shfl_xor(sm, 2); sm += __shfl_xor(sm, 4); sm += __shfl_xor(sm, 8); sm += __shfl_xor(sm, 16);
        const float mu = sm * (1.f / 128.f); float q = 0.f;
#pragma unroll
        for (int d = 0; d < 4; ++d) { const float dd = o[d][r] - mu; q += dd * dd; }
        q += __shfl_xor(q, 1); q += __shfl_xor(q, 2); q += __shfl_xor(q, 4); q += __shfl_xor(q, 8); q += __shfl_xor(q, 16);
        const float rsd = rsqrtf(q * (1.f / 128.f) + 1e-5f);
        const int qrow = t0 + 32 * qblk + (r & 3) + 8 * (r >> 2) + 4 * hi; bf16_t* gp = Z + (rowb + qrow) * ZE + 1024 + h * 128 + l31;
#pragma unroll
        for (int d = 0; d < 4; ++d) { const float ga = bf2f(gp[32 * d]); const float ov = (o[d][r] - mu) * rsd * gg[d] * siluf_(ga); if (!DUMMY) gp[32 * d] = (bf16_t)f2bf(ov); else asm volatile("" :: "v"(ov)); }
    }
}
__device__ __forceinline__ bf16x8 ld8p(const bf16_t* p) { return *(const bf16x8*)p; }
namespace rw {
constexpr int S64 = 72, S128 = 136;
constexpr int O_AT = 0, O_RT = O_AT + 9216, O_E = O_RT + 9216, O_ET = O_E + 18432, O_AM = O_ET + 17408, O_X0 = O_AM + 18432, O_LF = O_X0 + 17408, O_MM = O_LF + 16640,
              O_NN = O_MM + 9216, O_PC = O_NN + 17408, O_GC = O_PC + 9216, O_SM = O_GC + 9216, O_END = O_SM + 4096;
static_assert(O_END <= 160 * 1024 - 1024, "rwkv stage X LDS map");
typedef __attribute__((address_space(3))) bf16_t lbf;
typedef __attribute__((address_space(3))) float lf32;
__device__ __forceinline__ bf16x8 ld8(const bf16_t* p) { return *(const bf16x8*)p; }
__device__ __forceinline__ bf16x8 ld8(const LAS bf16_t* p) { return *(const LAS bf16x8*)p; }
__device__ __forceinline__ bf16x8 ld8(const GAS bf16_t* p) { return *(const GAS bf16x8*)p; }
template <int MT, int NT, int KS, class PA, class PB, class Epi>
__device__ __forceinline__ void mm(PA A, int lda, PB B, int ldb, int wave, int lane, Epi epi) {
    const int fr = lane & 15, g = lane >> 4;
    static_assert((MT * NT) % 8 == 0, "mm: tile count must be a multiple of the 8 waves");
#pragma unroll
    for (int ti = 0; ti < MT * NT / 8; ++ti) { const int tile = wave + 8 * ti; const int mt = tile / NT, nt = tile % NT;
        f32x4 acc = {0.f, 0.f, 0.f, 0.f};
        PA ap = A + (mt * 16 + fr) * lda + 8 * g; PB bp = B + (nt * 16 + fr) * ldb + 8 * g;
#pragma unroll
        for (int ks = 0; ks < KS; ++ks) acc = __builtin_amdgcn_mfma_f32_16x16x32_bf16(ld8(ap + 32 * ks), ld8(bp + 32 * ks), acc, 0, 0, 0);
        epi(ti, mt * 16 + 4 * g, nt * 16 + fr, acc);
    }
}
__device__ __forceinline__ unsigned short bfs(float f) { return (unsigned short)f2bf(f); }
__device__ __forceinline__ void st4(LAS bf16_t* p, f32x4 v) { u32x2 w; w.x = cvt_pk_bf16(v[0], v[1]); w.y = cvt_pk_bf16(v[2], v[3]); *(LAS u32x2*)p = w; }
}

template <bool DUMMY>
__device__ __forceinline__ void rwkv_stage_x(Frame& F, int li, unsigned long long& xacc) {
    using namespace rw;
    unsigned long long xt0 = 0;
#define TSX(k) do { if (MK_XA == (k)) xt0 = __builtin_amdgcn_s_memrealtime(); if (MK_XB == (k)) xacc += __builtin_amdgcn_s_memrealtime() - xt0; } while (0)
    const int o = li >> 1;
    LAS unsigned char* L = F.lds;
    LAS bf16_t* At = (LAS bf16_t*)(L + O_AT); LAS bf16_t* Rt = (LAS bf16_t*)(L + O_RT); LAS bf16_t* E = (LAS bf16_t*)(L + O_E); LAS bf16_t* ET = (LAS bf16_t*)(L + O_ET); LAS bf16_t* AM = (LAS bf16_t*)(L + O_AM);
    LAS bf16_t* X0T = (LAS bf16_t*)(L + O_X0); LAS float* Lf = (LAS float*)(L + O_LF); LAS bf16_t* Mm = (LAS bf16_t*)(L + O_MM); LAS bf16_t* NN = (LAS bf16_t*)(L + O_NN); LAS float* CS = (LAS float*)(L + O_NN);
    LAS bf16_t* Pc = (LAS bf16_t*)(L + O_PC); LAS bf16_t* Gc = (LAS bf16_t*)(L + O_GC); LAS float* gamC = (LAS float*)(L + O_SM); LAS float* SEGT = gamC + 64; LAS float* PRM = gamC + 64 + 512;
    LAS bf16_t* Tm = At; LAS bf16_t* Qh = AM; LAS bf16_t* PT = AM + 64 * S64; LAS bf16_t* WT = Mm;
    GAS bf16_t* Z = (GAS bf16_t*)(F.ws + WS_Z); const GAS bf16_t* L1g = (const GAS bf16_t*)(F.ws + WS_L1); GAS bf16_t* VF = (GAS bf16_t*)(F.ws + WS_VF);
    const GAS bf16_t* W2T = (const GAS bf16_t*)(F.ws + WS_LORA2); const GAS bf16_t* A2T = W2T + 1024 * 64; const GAS bf16_t* V2T = A2T + 1024 * 64;
    GAS bf16_t* PG = (GAS bf16_t*)(F.ws + WS_PG); GAS float* BON = (GAS float*)(F.ws + WS_BON);
    const float* w0p = F.in[12] + o * D; const float* a0p = F.in[15] + o * D; const float* v0p = F.in[18]; const float* kkp = F.in[21] + o * D; const float* kap = F.in[22] + o * D; const float* rkp = F.in[23] + o * D;
#pragma unroll 1
    for (int u = F.vcu; u < 2048; u += F.G) {
        const int bh = u & 31, blk = u >> 5, b = bh >> 4, h = bh & 15; const size_t row0 = (size_t)b * SEQ + (size_t)blk * 128;
        int tid = F.tid; asm volatile("" : "+v"(tid));
        __syncthreads();
        if (tid < 384) { const int a_ = tid >> 6, ch = tid & 63; const float* src = a_ == 0 ? w0p : a_ == 1 ? a0p : a_ == 2 ? v0p : a_ == 3 ? kkp : a_ == 4 ? kap : rkp; PRM[tid] = src[h * 64 + ch]; }
        for (int e = tid; e < 64 * 64; e += 512) { const int i = e >> 6, j = e & 63; Pc[i * S64 + j] = (i == j) ? (bf16_t)0x3f80 : (bf16_t)0; Gc[i * S64 + j] = 0; }
#pragma unroll 1
        for (int c = 0; c < 2; ++c) {
            const size_t rows = row0 + 64 * c;
            asm volatile("" : "+v"(tid));
            const int lane = tid & 63; int wave = F.wave; asm volatile("" : "+s"(wave));
            const int pt = tid >> 3, pc0 = (tid & 7) * 8;
            __syncthreads();
            TSX(0);
            const size_t prow = rows + pt; GAS bf16_t* zp = Z + prow * ZW + h * 64 + pc0;
            const bf16x8 r8 = ld8(zp), k8 = ld8(zp + 1024), v8 = ld8(zp + 2048); bf16x8 vf8 = v8; if (o) vf8 = ld8(VF + prow * D + h * 64 + pc0);
            mm<4, 4, 2>(L1g + rows * 256, 256, W2T + (size_t)h * 64 * 64, 64, wave, lane, [&](int, int r0, int col, f32x4 a) {
#pragma unroll
                for (int j = 0; j < 4; ++j) Lf[(r0 + j) * 65 + col] = a[j]; });
            mm<4, 4, 2>(L1g + rows * 256 + 64, 256, A2T + (size_t)h * 64 * 64, 64, wave, lane, [&](int, int r0, int col, f32x4 a) {
#pragma unroll
                for (int j = 0; j < 4; ++j) Mm[(r0 + j) * S64 + col] = bfs(a[j]); });
            if (o) mm<4, 4, 1>(L1g + rows * 256 + 128, 256, V2T + (size_t)h * 64 * 32, 32, wave, lane, [&](int, int r0, int col, f32x4 a) {
#pragma unroll
                for (int j = 0; j < 4; ++j) AM[(64 + r0 + j) * S64 + col] = bfs(a[j]); });
            __syncthreads();
            TSX(1);
            float pr[8], pkk[8], pkm[8], pb[8], pv[8];
            {
                const size_t row = prow; const int cc = h * 64 + pc0;
                float ss = 0.f, bon = 0.f, dec[8];
#pragma unroll
                for (int j = 0; j < 8; ++j) {
                    const float r = bf2f((bf16_t)r8[j]), k = bf2f((bf16_t)k8[j]); float v = bf2f((bf16_t)v8[j]);
                    const float lw = Lf[pt * 65 + pc0 + j], la = bf2f(Mm[pt * S64 + pc0 + j]);
                    dec[j] = -0.6065306597126334f * sigmoidf_(PRM[pc0 + j] + lw);
                    const float a = sigmoidf_(PRM[64 + pc0 + j] + la);
                    if (o) { const float lv = bf2f(AM[(64 + pt) * S64 + pc0 + j]); const float vf = bf2f((bf16_t)vf8[j]); v = v + (vf - v) * sigmoidf_(PRM[128 + pc0 + j] + lv); v = bf2f((bf16_t)f2bf(v)); }
                    const float kr = k * PRM[192 + pc0 + j]; ss += kr * kr; pkk[j] = kr;
                    const float km = k * (1.f + (a - 1.f) * PRM[256 + pc0 + j]); pkm[j] = km; pb[j] = a; pr[j] = r; pv[j] = v; bon += r * km * PRM[320 + pc0 + j];
                }
                if (!DUMMY) { if (o) { u32x4 w; w.x = pk2(pv[0], pv[1]); w.y = pk2(pv[2], pv[3]); w.z = pk2(pv[4], pv[5]); w.w = pk2(pv[6], pv[7]); *(GAS u32x4*)(zp + 2048) = w; }
                else *(GAS bf16x8*)(VF + row * D + cc) = v8; }
                ss += __shfl_xor(ss, 1); ss += __shfl_xor(ss, 2); ss += __shfl_xor(ss, 4);
                bon += __shfl_xor(bon, 1); bon += __shfl_xor(bon, 2); bon += __shfl_xor(bon, 4);
                const float inv = 1.f / fmaxf(sqrtf(ss), 1e-12f);
#pragma unroll
                for (int j = 0; j < 8; ++j) { pkk[j] *= inv; pb[j] *= pkk[j]; }
                if (!DUMMY && (tid & 7) == 0) BON[row * 16 + h] = bon;
                __syncthreads();
#pragma unroll
                for (int j = 0; j < 8; ++j) CS[pt * 65 + pc0 + j] = dec[j];
            }
            __syncthreads();
            TSX(2);
            { const int ch = tid & 63, sg = tid >> 6; float run = 0.f;
#pragma unroll
              for (int q = 0; q < 8; ++q) { run += CS[(sg * 8 + q) * 65 + ch]; CS[(sg * 8 + q) * 65 + ch] = run; }
              SEGT[sg * 64 + ch] = run;
              __syncthreads();
              float pre = 0.f;
              for (int q = 0; q < sg; ++q) pre += SEGT[q * 64 + ch];
#pragma unroll
              for (int q = 0; q < 8; ++q) CS[(sg * 8 + q) * 65 + ch] += pre; }
            __syncthreads();
            TSX(3);
            {
                unsigned short at[8], bt[8], kt[8], rt[8], vt[8];
#pragma unroll
                for (int j = 0; j < 8; ++j) { const float g = CS[pt * 65 + pc0 + j], gp = pt ? CS[(pt - 1) * 65 + pc0 + j] : 0.f; const float eg = __expf(g), egp = __expf(gp), ieg = __builtin_amdgcn_rcpf(eg);
                    at[j] = bfs(egp * pkk[j]); bt[j] = bfs(pb[j] * ieg); kt[j] = bfs(pkm[j] * ieg); rt[j] = bfs(pr[j] * eg); vt[j] = bfs(pv[j]);
                    if (pt == 63) gamC[pc0 + j] = eg; }
#define RW_PK4(x) (u32x4){(unsigned)x[0] | ((unsigned)x[1] << 16), (unsigned)x[2] | ((unsigned)x[3] << 16), (unsigned)x[4] | ((unsigned)x[5] << 16), (unsigned)x[6] | ((unsigned)x[7] << 16)}
                *(LAS u32x4*)(At + pt * S64 + pc0) = RW_PK4(at); *(LAS u32x4*)(Rt + pt * S64 + pc0) = RW_PK4(rt); *(LAS u32x4*)(E + pt * S64 + pc0) = RW_PK4(bt); *(LAS u32x4*)(E + (64 + pt) * S64 + pc0) = RW_PK4(kt);
#undef RW_PK4
#pragma unroll
                for (int j = 0; j < 8; ++j) { AM[(pc0 + j) * S64 + pt] = at[j]; ET[(pc0 + j) * S128 + pt] = bt[j]; ET[(pc0 + j) * S128 + 64 + pt] = kt[j]; X0T[(pc0 + j) * S128 + 64 + pt] = vt[j]; }
            }
            __syncthreads();
            TSX(4);
            mm<4, 8, 2>(At, S64, E, S64, wave, lane, [&](int, int r0, int col, f32x4 a) {
                const int i = col & 63;
#pragma unroll
                for (int j = 0; j < 4; ++j) { const float v = (i < r0 + j) ? a[j] : 0.f; if (col < 64) Lf[(r0 + j) * 65 + i] = v; else Mm[(r0 + j) * S64 + i] = bfs(v); } });
            mm<4, 8, 2>(Rt, S64, E, S64, wave, lane, [&](int, int r0, int col, f32x4 a) {
                const int i = col & 63;
#pragma unroll
                for (int j = 0; j < 4; ++j) NN[(r0 + j) * S128 + col] = bfs((i <= r0 + j) ? a[j] : 0.f); });
            __syncthreads();
            TSX(5);
            mm<4, 4, 2>(Mm, S64, X0T + 64, S128, wave, lane, [&](int, int r0, int col, f32x4 a) { st4(AM + (64 + col) * S64 + r0, (f32x4){-a[0], -a[1], -a[2], -a[3]}); });
            for (int e = tid; e < 64 * 64; e += 512) { const int t = e >> 6, i = e & 63; const float lv = Lf[t * 65 + i]; const int tb = t >> 4, ib = i >> 4;
                E[t * S64 + i] = ((tb == 1 && ib == 0) || (tb == 3 && ib == 2)) ? bfs(lv) : (bf16_t)0;
                E[(64 + t) * S64 + i] = (t >= 32 && i < 32) ? bfs(lv) : (bf16_t)0;
                Tm[t * S64 + i] = 0; X0T[t * S128 + i] = 0; }
            __syncthreads();
            TSX(6);
            if (wave < 4 && lane < 16) { const int bb = wave * 16; float x[16];
#pragma unroll
                for (int r = 0; r < 16; ++r) { float s = (r == lane) ? 1.f : 0.f;
#pragma unroll
                    for (int i = 0; i < r; ++i) s -= Lf[(bb + r) * 65 + bb + i] * x[i];
                    x[r] = s; }
#pragma unroll
                for (int r = 0; r < 16; ++r) { const unsigned short xv = bfs(x[r]); Tm[(bb + r) * S64 + bb + lane] = xv; X0T[(bb + lane) * S128 + bb + r] = xv; } }
            __syncthreads();
            mm<4, 4, 2>(E, S64, X0T, S128, wave, lane, [&](int, int r0, int col, f32x4 a) { st4(Mm + col * S64 + r0, a); });
            __syncthreads();
            mm<4, 4, 2>(Tm, S64, Mm, S64, wave, lane, [&](int, int r0, int col, f32x4 a) {
                const int tb = r0 >> 4, jb = col >> 4; if ((tb == 1 && jb == 0) || (tb == 3 && jb == 2)) st4(X0T + col * S128 + r0, (f32x4){-a[0], -a[1], -a[2], -a[3]}); });
            __syncthreads();
            { const int p = tid >> 8, tt = (tid >> 4) & 15, jj = tid & 15, t = 16 * (2 * p + 1) + tt, j = 32 * p + jj; Tm[t * S64 + j] = X0T[j * S128 + t]; }
            __syncthreads();
            mm<4, 4, 2>(E + 64 * S64, S64, X0T, S128, wave, lane, [&](int, int r0, int col, f32x4 a) { st4(Mm + col * S64 + r0, a); });
            __syncthreads();
            mm<4, 4, 2>(Tm, S64, Mm, S64, wave, lane, [&](int, int r0, int col, f32x4 a) {
                if (r0 >= 32 && col < 32) {
#pragma unroll
                    for (int j = 0; j < 4; ++j) E[(r0 + j) * S64 + col] = bfs(-a[j]); } });
            __syncthreads();
            for (int e = tid; e < 32 * 32; e += 512) { const int t = 32 + (e >> 5), j = e & 31; Tm[t * S64 + j] = E[t * S64 + j]; }
            __syncthreads();
            TSX(7);
            mm<4, 8, 2>(Tm, S64, AM, S64, wave, lane, [&](int, int r0, int col, f32x4 a) { if (col < 64) st4(WT + col * S64 + r0, a); else st4(X0T + (col - 64) * S128 + r0, a); });
            __syncthreads();
            TSX(8);
            f32x4 gt[2], y0t[2];
            mm<4, 4, 2>(WT, S64, ET, S128, wave, lane, [&](int, int r0, int col, f32x4 a) { const float gc = gamC[col];
                f32x4 p;
#pragma unroll
                for (int j = 0; j < 4; ++j) p[j] = (((r0 + j) == col ? 1.f : 0.f) - a[j]) * gc;
                st4(PT + col * S64 + r0, p); });
            mm<4, 4, 4>(X0T, S128, ET, S128, wave, lane, [&](int ti, int, int col, f32x4 a) { const float gc = gamC[col]; gt[ti] = a * gc; });
            mm<4, 4, 4>(NN, S128, X0T, S128, wave, lane, [&](int ti, int, int, f32x4 a) { y0t[ti] = a; });
            mm<4, 4, 2>(NN, S128, WT, S64, wave, lane, [&](int, int r0, int col, f32x4 a) {
#pragma unroll
                for (int j = 0; j < 4; ++j) Qh[(r0 + j) * S64 + col] = bfs(bf2f(Rt[(r0 + j) * S64 + col]) - a[j]); });
            __syncthreads();
            TSX(9);
            GAS bf16_t* rslot = Z + row0 * ZW + h * 64; GAS bf16_t* kslot = rslot + 1024;
            mm<4, 4, 2>(Qh, S64, Pc, S64, wave, lane, [&](int, int r0, int col, f32x4 a) {
                const int kt_ = col >> 5, rho = col & 31, s = rho >> 4, jj = ((rho >> 3) & 1) * 4 + (rho & 3), hh = (rho >> 2) & 1;
#pragma unroll
                for (int j = 0; j < 4; ++j) { const int t = 64 * c + r0 + j, tt_ = t >> 5, ln = 32 * hh + (t & 31); const int e = ((((tt_ * 2 + kt_) * 2 + s) * 64 + ln) << 3) + jj;
                    if (!DUMMY) rslot[(size_t)(e >> 6) * ZW + (e & 63)] = bfs(a[j]); else asm volatile("" :: "v"(a[j])); } });
            mm<4, 4, 2>(Qh, S64, Gc, S64, wave, lane, [&](int ti, int r0, int col, f32x4 a) {
                const int vt_ = col >> 5, v31 = col & 31;
#pragma unroll
                for (int j = 0; j < 4; ++j) { const int t = 64 * c + r0 + j, tt_ = t >> 5, x = t & 31, hh = (x >> 2) & 1, r = (x & 3) + 4 * (x >> 3); const int e = (((tt_ * 2 + vt_) * 64 + 32 * hh + v31) << 4) + r;
                    if (!DUMMY) kslot[(size_t)(e >> 6) * ZW + (e & 63)] = bfs(a[j] + y0t[ti][j]); else asm volatile("" :: "v"(a[j] + y0t[ti][j])); } });
            f32x4 pn[2], gn[2];
            mm<4, 4, 2>(Pc, S64, PT, S64, wave, lane, [&](int ti, int, int, f32x4 a) { pn[ti] = a; });
            mm<4, 4, 2>(Gc, S64, PT, S64, wave, lane, [&](int ti, int, int, f32x4 a) { gn[ti] = a + gt[ti]; });
            __syncthreads();
            { const int fr = lane & 15, g = lane >> 4;
#pragma unroll
              for (int ti = 0; ti < 2; ++ti) { const int tile = wave + 8 * ti, mt = tile >> 2, nt = tile & 3;
#pragma unroll
                  for (int j = 0; j < 4; ++j) { Pc[(mt * 16 + 4 * g + j) * S64 + nt * 16 + fr] = bfs(pn[ti][j]); Gc[(mt * 16 + 4 * g + j) * S64 + nt * 16 + fr] = bfs(gn[ti][j]); } } }
            TSX(10);
        }
        __syncthreads();
        if (!DUMMY) { GAS bf16_t* pg = PG + (size_t)u * 8192;
          { const int f = tid >> 6, ln = tid & 63, s = f & 1, kit = (f >> 1) & 1, kot = f >> 2, hh = ln >> 5, r31 = ln & 31; unsigned short w[8];
#pragma unroll
            for (int j = 0; j < 8; ++j) { const int rho = 16 * s + 8 * (j >> 2) + 4 * hh + (j & 3); w[j] = Pc[(32 * kit + rho) * S64 + 32 * kot + r31]; }
            *(GAS u32x4*)(pg + (size_t)tid * 8) = (u32x4){(unsigned)w[0] | ((unsigned)w[1] << 16), (unsigned)w[2] | ((unsigned)w[3] << 16), (unsigned)w[4] | ((unsigned)w[5] << 16), (unsigned)w[6] | ((unsigned)w[7] << 16)}; }
          { const int tile = tid >> 7, ln = (tid >> 1) & 63, half = tid & 1, kot = tile >> 1, vt_ = tile & 1, hh = ln >> 5, v31 = ln & 31; unsigned short w[8];
#pragma unroll
            for (int q = 0; q < 8; ++q) { const int r = 8 * half + q; const int ko = 32 * kot + (r & 3) + 8 * (r >> 2) + 4 * hh; w[q] = Gc[(32 * vt_ + v31) * S64 + ko]; }
            *(GAS u32x4*)(pg + 4096 + ((size_t)(tile * 64 + ln) << 4) + 8 * half) = (u32x4){(unsigned)w[0] | ((unsigned)w[1] << 16), (unsigned)w[2] | ((unsigned)w[3] << 16), (unsigned)w[4] | ((unsigned)w[5] << 16), (unsigned)w[6] | ((unsigned)w[7] << 16)}; } }
    }
    __syncthreads();
}

__device__ __forceinline__ void rwkv_stage_y(Frame& F) {
    if (F.vcu >= 32) return;
    const int lane = F.lane, wave = F.wave, bh = F.vcu, vt = wave >> 2; const bool st = ((wave & 3) == 0);
    const bf16_t* PG = (const bf16_t*)(F.ws + WS_PG); u32x4* SB = (u32x4*)(F.ws + WS_SB);
    LAS bf16x8* pgbuf = (LAS bf16x8*)F.lds;
    f32x16 X0, X1;
#pragma unroll
    for (int r = 0; r < 16; ++r) { X0[r] = 0.f; X1[r] = 0.f; }
    bf16x8 Ra0, Ra1, Rb0, Rb1, Rc0, Rc1;
    auto issue = [&](bf16x8& r0, bf16x8& r1, int blk) { const bf16_t* pg = PG + (size_t)(blk * 32 + bh) * 8192;
        r0 = ld8p(pg + (((size_t)(wave * 2 + 0) * 64 + lane) << 3)); r1 = ld8p(pg + (((size_t)(wave * 2 + 1) * 64 + lane) << 3)); };
    auto step = [&](bf16x8& c0, bf16x8& c1, bf16x8& n0r, bf16x8& n1r, int blk) {
        const bf16x8 nga = n0r, ngb = n1r;
        issue(c0, c1, blk + 3 < 64 ? blk + 3 : 63);
        asm volatile("s_waitcnt lgkmcnt(0)" ::: "memory"); __builtin_amdgcn_s_barrier(); asm volatile("" ::: "memory");
        pgbuf[((blk + 1) & 1) * 1024 + (wave * 2 + 0) * 64 + lane] = nga; pgbuf[((blk + 1) & 1) * 1024 + (wave * 2 + 1) * 64 + lane] = ngb;
        if (st) {
            u32x4 xb[4];
#pragma unroll
            for (int s = 0; s < 2; ++s) {
                xb[s] = (u32x4){cvt_pk_bf16(X0[8 * s], X0[8 * s + 1]), cvt_pk_bf16(X0[8 * s + 2], X0[8 * s + 3]), cvt_pk_bf16(X0[8 * s + 4], X0[8 * s + 5]), cvt_pk_bf16(X0[8 * s + 6], X0[8 * s + 7])};
                xb[2 + s] = (u32x4){cvt_pk_bf16(X1[8 * s], X1[8 * s + 1]), cvt_pk_bf16(X1[8 * s + 2], X1[8 * s + 3]), cvt_pk_bf16(X1[8 * s + 4], X1[8 * s + 5]), cvt_pk_bf16(X1[8 * s + 6], X1[8 * s + 7])}; }
            u32x4* sb = SB + ((size_t)(blk * 32 + bh) * 8 + vt * 4) * 64 + lane;
#pragma unroll
            for (int q = 0; q < 4; ++q) sb[q * 64] = xb[q];
            const LAS bf16x8* pb = pgbuf + (blk & 1) * 1024;
            f32x16 n0, n1;
            { const bf16x8 c0a = pb[512 + ((0 * 2 + vt) * 64 + lane) * 2], c0b = pb[512 + ((0 * 2 + vt) * 64 + lane) * 2 + 1], c1a = pb[512 + ((1 * 2 + vt) * 64 + lane) * 2], c1b = pb[512 + ((1 * 2 + vt) * 64 + lane) * 2 + 1];
#pragma unroll
              for (int r = 0; r < 8; ++r) { n0[r] = bf2f((bf16_t)c0a[r]); n0[8 + r] = bf2f((bf16_t)c0b[r]); n1[r] = bf2f((bf16_t)c1a[r]); n1[8 + r] = bf2f((bf16_t)c1b[r]); } }
#pragma unroll
            for (int q = 0; q < 4; ++q) {
                n0 = __builtin_amdgcn_mfma_f32_32x32x16_bf16(pb[q * 64 + lane], __builtin_bit_cast(bf16x8, xb[q]), n0, 0, 0, 0);
                n1 = __builtin_amdgcn_mfma_f32_32x32x16_bf16(pb[(4 + q) * 64 + lane], __builtin_bit_cast(bf16x8, xb[q]), n1, 0, 0, 0); }
            X0 = n0; X1 = n1;
        }
    };
    issue(Ra0, Ra1, 0); issue(Rb0, Rb1, 1); issue(Rc0, Rc1, 2);
    pgbuf[(wave * 2 + 0) * 64 + lane] = Ra0; pgbuf[(wave * 2 + 1) * 64 + lane] = Ra1;
#pragma unroll 1
    for (int blk = 0; blk < 63; blk += 3) { step(Ra0, Ra1, Rb0, Rb1, blk); step(Rb0, Rb1, Rc0, Rc1, blk + 1); step(Rc0, Rc1, Ra0, Ra1, blk + 2); }
    step(Ra0, Ra1, Rb0, Rb1, 63);
    __syncthreads();
}

template <bool DUMMY>
__device__ __forceinline__ void rwkv_stage_z(Frame& F, int li) {
    const int o = li >> 1;
    bf16_t* Z = (bf16_t*)(F.ws + WS_Z); const float* BON = (const float*)(F.ws + WS_BON); const u32x4* SB = (const u32x4*)(F.ws + WS_SB);
    const float* lgp = F.in[24] + o * D; const float* lbp = F.in[25] + o * D;
    LAS float* tile = (LAS float*)(F.lds + F.wave * 9216);
    int lane_ = F.lane;
#pragma unroll 1
    for (int w = F.vcu * 8 + F.wave; w < 8192; w += F.G * 8) {
        asm volatile("" : "+v"(lane_)); const int lane = lane_, v31 = lane & 31, hh = lane >> 5, tl = lane >> 1, hf = lane & 1;
        const int u = w >> 2, tt = w & 3, bh = u & 31, blk = u >> 5, b = bh >> 4, h = bh & 15; const size_t row0 = (size_t)b * SEQ + (size_t)blk * 128;
        const bf16_t* rslot = Z + row0 * ZW + h * 64; const bf16_t* kslot = rslot + 1024;
        const size_t row = row0 + 32 * tt + tl; bf16_t* zp = Z + row * ZW + h * 64 + 32 * hf;
        bf16x8 vv[4], gg[4];
#pragma unroll
        for (int q = 0; q < 4; ++q) { vv[q] = ld8p(zp + 2048 + 8 * q); gg[q] = ld8p(zp + 3072 + 8 * q); }
        const float bon = BON[row * 16 + h];
        bf16x8 qf[4]; u32x4 xb[2][4];
#pragma unroll
        for (int q = 0; q < 4; ++q) { const int e = (((tt * 4 + q) * 64 + lane) << 3); qf[q] = ld8p(rslot + (size_t)(e >> 6) * ZW + (e & 63)); }
#pragma unroll
        for (int vt = 0; vt < 2; ++vt)
#pragma unroll
            for (int q = 0; q < 4; ++q) xb[vt][q] = SB[((size_t)u * 8 + vt * 4 + q) * 64 + lane];
#pragma unroll
        for (int vt = 0; vt < 2; ++vt) { const int e0 = ((tt * 2 + vt) * 64 + lane) << 4; const bf16_t* yp = kslot + (size_t)(e0 >> 6) * ZW + (e0 & 63); const bf16x8 ya = ld8p(yp), yb = ld8p(yp + 8);
            f32x16 acc;
#pragma unroll
            for (int r = 0; r < 8; ++r) { acc[r] = bf2f((bf16_t)ya[r]); acc[8 + r] = bf2f((bf16_t)yb[r]); }
#pragma unroll
            for (int q = 0; q < 4; ++q) acc = __builtin_amdgcn_mfma_f32_32x32x16_bf16(qf[q], __builtin_bit_cast(bf16x8, xb[vt][q]), acc, 0, 0, 0);
#pragma unroll
            for (int r = 0; r < 16; ++r) tile[((r & 3) + 8 * (r >> 2) + 4 * hh) * 72 + 36 * vt + v31] = acc[r]; }
        LDS_WAIT(); asm volatile("" ::: "memory");
        float y[32]; float sm = 0.f;
#pragma unroll
        for (int q = 0; q < 8; ++q) { const f32x4 t4 = *(const LAS f32x4*)(tile + tl * 72 + 36 * hf + 4 * q); y[4 * q] = t4[0]; y[4 * q + 1] = t4[1]; y[4 * q + 2] = t4[2]; y[4 * q + 3] = t4[3]; sm += (t4[0] + t4[1]) + (t4[2] + t4[3]); }
        sm += __shfl_xor(sm, 1);
        const float mu = sm * (1.f / 64.f); float qq = 0.f;
#pragma unroll
        for (int j = 0; j < 32; ++j) { y[j] -= mu; qq += y[j] * y[j]; }
        qq += __shfl_xor(qq, 1);
        const float rsd = rsqrtf(qq * (1.f / 64.f) + 64e-5f);
        const float* lg = lgp + h * 64 + 32 * hf; const float* lb = lbp + h * 64 + 32 * hf;
#pragma unroll
        for (int q = 0; q < 4; ++q) { float ov[8];
#pragma unroll
            for (int j = 0; j < 8; ++j) { const int c = 8 * q + j; const float va = bf2f((bf16_t)vv[q][j]), ga = bf2f((bf16_t)gg[q][j]); ov[j] = (y[c] * rsd * lg[c] + lb[c] + bon * va) * siluf_(ga); }
            const u32x4 wv = {cvt_pk_bf16(ov[0], ov[1]), cvt_pk_bf16(ov[2], ov[3]), cvt_pk_bf16(ov[4], ov[5]), cvt_pk_bf16(ov[6], ov[7])};
            if (!DUMMY) *(u32x4*)(zp + 3072 + 8 * q) = wv; else asm volatile("" :: "v"(wv)); }
        LDS_WAIT(); asm volatile("" ::: "memory");
    }
}

enum { PH_P0 = 0, PH_FINAL = 27, N_PHASES = 28 };
#define IN(k) (lo <= (k) && (k) < hi)
#define TSG(k) do { if (LI == 0) { if (MK_GA == (k)) tA = __builtin_amdgcn_s_memrealtime(); if (MK_GB == (k)) tB = __builtin_amdgcn_s_memrealtime(); } } while (0)
#define TS(k) do { if (MK_TPA == (k)) tA = __builtin_amdgcn_s_memrealtime(); if (MK_TPB == (k)) tB = __builtin_amdgcn_s_memrealtime(); } while (0)
#if MK_MULTI
#define SEAM(k) do { } while (0)
#else
#define SEAM(k) do { if (IN(k) && IN((k) + 1)) xcd_barrier(bar); } while (0)
#endif
template <int LI>
__device__ __forceinline__ void run_layer(Frame& F, const XcdBarrier& bar, const int lo, const int hi, const int bx, unsigned long long& tA, unsigned long long& tB) {
    constexpr bool even = (LI & 1) == 0;
    constexpr int base = 1 + (LI / 2) * 13 + (even ? 0 : 6);
    bf16_t* Zp = (bf16_t*)(F.ws + WS_Z);
    if constexpr (even) {
        TS(base); if (IN(base)) { F.retid(); pg8::StaticOrder S; S.init(64, 16, F.G, bx);
            pg8::Gemm g{(const bf16_t*)(F.ws + WS_HB), (const bf16_t*)(F.ws + WS_WIN)};
            EpiEvenIn E{Zp, F.ssq(LI), (bf16_t*)(F.ws + WS_VTA), (bf16_t*)(F.ws + WS_VTB), (bf16_t*)(F.ws + WS_KT)};
            if (MK_PROBE == 1) pg8::gemm_phase<EpiEvenIn, true, D, D, 1 << 20, 0, 0>(F.lds, F.tid, g, S, E);
            pg8::gemm_phase<EpiEvenIn, true, D, D, 1 << 20, 0, 0>(F.lds, F.tid, g, S, E); }
        SEAM(base);
        TS(base + 1); if (IN(base + 1)) { F.retid();
            TSG(0); conv_wrest(F, LI); TSG(1);
            if constexpr (LI < 3) conv_win_odd(F, LI + 1);
            TSG(2);
            if (MK_PROBE == 5) { for (int u = F.vcu * 8 + F.wave; u < 4096; u += F.G * 8) ret_stage_a(F, u);
                for (int u = F.vcu * 8 + F.wave; u < 2048; u += F.G * 8) sb_unit<true>(F, u >> 8, u & 255); }
            for (int u = F.vcu * 8 + F.wave; u < 4096; u += F.G * 8) ret_stage_a(F, u);
            __syncthreads(); TSG(3);
            for (int u = F.vcu * 8 + F.wave; u < 2048; u += F.G * 8) sb_unit<false>(F, u >> 8, u & 255);
            __syncthreads(); TSG(4); }
        SEAM(base + 1);
        TS(base + 2); if (IN(base + 2)) { F.retid(); ret_stage_b(F); }
        SEAM(base + 2);
        TS(base + 3); if (IN(base + 3)) { F.retid(); const float* gng = F.in[8] + (LI >> 1) * 512;
            if (MK_PROBE == 6) for (int u = F.vcu * 8 + F.wave; u < 2048; u += F.G * 8) ret_stage_c<true>(F, u, gng);
            for (int u = F.vcu * 8 + F.wave; u < 2048; u += F.G * 8) ret_stage_c<false>(F, u, gng); }
        SEAM(base + 3);
        TS(base + 4); if (IN(base + 4)) { F.retid(); pg8::StaticOrder S; S.init(64, 4, F.G, bx);
            { pg8::Gemm g{(const bf16_t*)(F.ws + WS_PB), (const bf16_t*)(F.ws + WS_WPROJ)};
              EpiStore E{Zp, ZE}; pg8::gemm_phase<EpiStore, false, PLE, PLE, 1 << 20, 0, 0>(F.lds, F.tid, g, S, E); }
            { pg8::Gemm g{Zp + 1024, (const bf16_t*)(F.ws + WS_WOUT)};
              EpiResid E{F.H, Zp + 1536, ZE}; pg8::gemm_phase<EpiResid, false, ZE, D, 8, (long)((2560 - 1024) * 2), 0>(F.lds, F.tid, g, S, E); } }
        SEAM(base + 4);
        TS(base + 5); if (IN(base + 5)) { F.retid(); pg8::StaticOrder S; S.init(64, 4, F.G, bx);
            pg8::Gemm g{Zp + 1536, (const bf16_t*)(F.ws + WS_WGATE)};
            EpiGate E{F.H, Zp, ZE, nullptr, F.ssq(LI + 1)};
            pg8::gemm_phase<EpiGate, false, ZE, D, 1 << 20, 0, 0>(F.lds, F.tid, g, S, E); }
        SEAM(base + 5);
    } else {
        TS(base); if (IN(base)) { F.retid(); conv_lora2(F, LI); rows_norm(F, LI); }
        SEAM(base);
        TS(base + 1); if (IN(base + 1)) { F.retid(); pg8::StaticOrder S; S.init(64, 17, F.G, bx);
            pg8::Gemm g{(const bf16_t*)(F.ws + WS_HB) + D, (const bf16_t*)(F.ws + WS_WIN)};
            EpiOddIn E{Zp, (bf16_t*)(F.ws + WS_L1)};
            if (MK_PROBE == 2) pg8::gemm_phase<EpiOddIn, true, D, 2048, 16, -(long)(D * 2), (long)(D * 2)>(F.lds, F.tid, g, S, E);
            pg8::gemm_phase<EpiOddIn, true, D, 2048, 16, -(long)(D * 2), (long)(D * 2)>(F.lds, F.tid, g, S, E); }
        SEAM(base + 1);
        TS(base + 2); if (IN(base + 2)) { F.retid();
            conv_wrest(F, LI);
            __syncthreads();
            { unsigned long long xa = 0; rwkv_stage_x<false>(F, LI, xa); if (LI == 1 && MK_XA >= 0) { tA = 0; tB = xa; } } }
        SEAM(base + 2);
        TS(base + 3); if (IN(base + 3)) { F.retid();
            rwkv_stage_y(F); }
        SEAM(base + 3);
        TS(base + 4); if (IN(base + 4)) { F.retid(); rwkv_stage_z<false>(F, LI); }
        SEAM(base + 4);
        TS(base + 5); if (IN(base + 5)) { F.retid(); pg8::StaticOrder S; S.init(64, 4, F.G, bx);
            if constexpr (LI < 3) { conv_win_even(F, LI + 1); __syncthreads(); }
            { pg8::Gemm g{(const bf16_t*)(F.ws + WS_PB), (const bf16_t*)(F.ws + WS_WPROJ)};
              EpiStore E{Zp, ZW}; pg8::gemm_phase<EpiStore, false, PLE, PLE, 1 << 20, 0, 0>(F.lds, F.tid, g, S, E); }
            { pg8::Gemm g{Zp + 3072, (const bf16_t*)(F.ws + WS_WOUT)};
              EpiResid E{F.H, Zp + 2048, ZW}; pg8::gemm_phase<EpiResid, false, ZW, D, 1 << 20, 0, 0>(F.lds, F.tid, g, S, E); } }
        SEAM(base + 5);
        TS(base + 6); if (IN(base + 6)) { F.retid(); pg8::StaticOrder S; S.init(64, 4, F.G, bx);
            pg8::Gemm g{Zp + 2048, (const bf16_t*)(F.ws + WS_WGATE)};
            EpiGate E{F.H, Zp, ZW, (bf16_t*)(F.ws + WS_HB), F.ssq(LI + 1)};
            pg8::gemm_phase<EpiGate, false, ZW, D, 1 << 20, 0, 0>(F.lds, F.tid, g, S, E); }
        SEAM(base + 6);
    }
}
__global__ void __launch_bounds__(512, 2) mk_fwd(Args args) {
    extern __shared__ __attribute__((aligned(16))) unsigned char lds_raw[];
    Frame F;
    F.lds = (LAS unsigned char*)lds_raw; F.ldsg = lds_raw;
    F.tid = threadIdx.x; F.lane = F.tid & 63; F.wave = __builtin_amdgcn_readfirstlane(F.tid >> 6);
    F.G = gridDim.x; const int bx = blockIdx.x; F.vcu = (F.G % 8 == 0) ? (bx % 8) * (F.G / 8) + bx / 8 : bx;
    F.H = args.out; F.ws = args.ws;
    volatile LAS unsigned* MISC = (volatile LAS unsigned*)(F.lds + MISC_OFF);
    for (int u = F.tid; u < 128; u += 512) ((LAS unsigned*)(F.lds + MISC_OFF))[u] = 0u;
    __syncthreads();
    XcdBarrier bar; bar.bar = (unsigned*)(F.ws + WS_CTL) + 4096; bar.x = 0; bar.st = nullptr;
#if !MK_MULTI
    bar = xcd_barrier_post((unsigned*)(F.ws + WS_CTL) + 4096, MISC + 8);
#endif
    const int lo = args.ph_lo, hi = args.ph_hi;
    if (IN(PH_P0)) { F.retid(); rows_p0(F); conv_win_even(F, 0); }
#if !MK_MULTI
    if (IN(0) && IN(1)) { VM_WAIT(); cg::this_grid().sync(); }
#endif
    unsigned long long tA = 0, tB = 0;
    TS(0);
    run_layer<0>(F, bar, lo, hi, bx, tA, tB);
    run_layer<1>(F, bar, lo, hi, bx, tA, tB);
    run_layer<2>(F, bar, lo, hi, bx, tA, tB);
    run_layer<3>(F, bar, lo, hi, bx, tA, tB);
    TS(PH_FINAL);
    if (IN(PH_FINAL)) { F.retid(); rows_final(F); }
    TS(PH_FINAL + 1);
    if ((MK_TPA >= 0 || MK_XA >= 0 || MK_GA >= 0) && blockIdx.x == 0 && threadIdx.x == 0) { const unsigned long long t0 = __builtin_amdgcn_s_memrealtime(), span = 4ull * (tB - tA); while (__builtin_amdgcn_s_memrealtime() - t0 < span) __builtin_amdgcn_s_sleep(8); }
}

extern "C" void kernel_launch(void* const* d_in, const int* in_sizes, int n_in, void* d_out, int out_size, void* d_ws, size_t ws_size, hipStream_t stream) {
    static int grid = 0;
    if (grid == 0) {
        int dev = 0, cus = 0, per_cu = 0;
        (void)hipGetDevice(&dev); (void)hipDeviceGetAttribute(&cus, hipDeviceAttributeMultiprocessorCount, dev);
        (void)hipFuncSetAttribute((const void*)mk_fwd, hipFuncAttributeMaxDynamicSharedMemorySize, LDS_BYTES);
        (void)hipOccupancyMaxActiveBlocksPerMultiprocessor(&per_cu, (const void*)mk_fwd, 512, LDS_BYTES);
        if (per_cu < 1) per_cu = 1;
        grid = cus * 1;
        if (n_in != 26 || ws_size < WS_END) fprintf(stderr, "kernel_launch: unexpected n_in %d / ws %zu\n", n_in, ws_size);
        (void)hipGetLastError();
    }
    (void)hipMemsetAsync((char*)d_ws + WS_CTL, 0, CTL_BYTES, stream);
    Args a{};
    for (int i = 0; i < 26; ++i) a.in[i] = (const float*)d_in[i];
    a.out = (float*)d_out; a.ws = (unsigned char*)d_ws;
#if MK_MULTI
    for (int ph = 0; ph < N_PHASES; ++ph) { a.ph_lo = ph; a.ph_hi = ph + 1; hipLaunchKernelGGL(mk_fwd, dim3(grid), dim3(512), LDS_BYTES, stream, a); }
#else
    a.ph_lo = 0; a.ph_hi = N_PHASES;
    void* kargs[] = {&a};
    hipError_t e = hipLaunchCooperativeKernel((const void*)mk_fwd, dim3(grid), dim3(512), kargs, LDS_BYTES, stream);
    if (e != hipSuccess) fprintf(stderr, "cooperative launch failed: %s (grid %d)\n", hipGetErrorString(e), grid);
#endif
}
```

```cpp
#include <hip/hip_runtime.h>
#include <hip/hip_cooperative_groups.h>
#include <cstdint>
#include <cstdio>
namespace cg = cooperative_groups;

#ifndef MK_PROBE
#define MK_PROBE 0
#endif
#ifndef MK_TPA
#define MK_TPA -1
#define MK_TPB -1
#endif
#ifndef MK_XA
#define MK_XA -1
#define MK_XB -1
#endif
#ifndef MK_GA
#define MK_GA -1
#define MK_GB -1
#endif
#ifndef MK_MULTI
#define MK_MULTI 0
#endif

#define LAS __attribute__((address_space(3)))
#define GAS __attribute__((address_space(1)))
typedef unsigned short bf16_t;
typedef short bf16x8 __attribute__((ext_vector_type(8)));
typedef float f32x4 __attribute__((ext_vector_type(4)));
typedef float f32x2 __attribute__((ext_vector_type(2)));
typedef unsigned u32x4 __attribute__((ext_vector_type(4)));
typedef unsigned u32x2 __attribute__((ext_vector_type(2)));

constexpr int D = 1024, BATCH = 2, SEQ = 8192, T = BATCH * SEQ, PLE = 256, ZW = 4096, ZE = 3072;
constexpr float QK_SCALE = 0.08838834764831845f;

__device__ __forceinline__ float bf2f(bf16_t v) { return __uint_as_float(((unsigned)v) << 16); }
__device__ __forceinline__ unsigned f2bf(float f) { unsigned u = __float_as_uint(f); return (u + 0x7fffu + ((u >> 16) & 1u)) >> 16; }
__device__ __forceinline__ unsigned pk2(float lo, float hi) { return f2bf(lo) | (f2bf(hi) << 16); }
typedef __bf16 bf16x2_t __attribute__((ext_vector_type(2)));
__device__ __forceinline__ unsigned cvt_pk_bf16(float lo, float hi) { f32x2 v = {lo, hi}; bf16x2_t b = __builtin_convertvector(v, bf16x2_t); return __builtin_bit_cast(unsigned, b); }
__device__ __forceinline__ float wave_sum(float v) {
#pragma unroll
    for (int o = 1; o < 64; o <<= 1) v += __shfl_xor(v, o);
    return v;
}
__device__ __forceinline__ float sigmoidf_(float x) { return __builtin_amdgcn_rcpf(1.f + __expf(-x)); }
__device__ __forceinline__ float siluf_(float x) { return x * __builtin_amdgcn_rcpf(1.f + __expf(-x)); }
__device__ __forceinline__ float softplusf_(float x) { return x > 20.f ? x : log1pf(expf(x)); }
__device__ __forceinline__ float logsigf_(float x) { return -(x < -20.f ? -x : log1pf(expf(-x))); }
__device__ __forceinline__ float ssq_sum(const float* sq, int row) { const f32x4* p = (const f32x4*)(sq + (size_t)row * 16); const f32x4 a = p[0], b = p[1], c = p[2], d = p[3];
    return (((a[0] + a[1]) + (a[2] + a[3])) + ((b[0] + b[1]) + (b[2] + b[3]))) + (((c[0] + c[1]) + (c[2] + c[3])) + ((d[0] + d[1]) + (d[2] + d[3]))); }
#define LDS_WAIT() asm volatile("s_waitcnt lgkmcnt(0)" ::: "memory")
#define VM_WAIT() asm volatile("s_waitcnt vmcnt(0)" ::: "memory")

namespace pg8 {
constexpr int BM = 256, BK = 64, HALF = 128, HTB = HALF * BK * 2, STAGE_BYTES = 8 * HTB, NXCD = 8, WGM = 8;
__host__ __device__ __forceinline__ int lds_byte(int r, int c) { const int st = (r >> 4) * 2 + (c >> 5), rr = r & 15, cc = c & 31, ob = rr * 64 + cc * 2; return st * 1024 + (ob ^ (((ob >> 9) & 1) << 5)); }
__host__ __device__ __forceinline__ void stage_rc(int b, int& R, int& C) { const int st = b / 1024, sb = b % 1024, swz = sb ^ (((sb >> 9) & 1) << 5); R = (st >> 1) * 16 + swz / 64; C = (st & 1) * 32 + (swz % 64) / 2; }
__host__ __device__ __forceinline__ int perm32(int rho) { const int n = rho >> 4, i = rho & 15; return 8 * (i >> 2) + 4 * n + (i & 3); }
struct Unit { int pm, pn; };
struct Gemm { const bf16_t* A; const bf16_t* Bt; };
struct StaticOrder {
    int nM, nN, nwg, G, c;
    __device__ void init(int nM_, int nN_, int G_, int c_) { nM = nM_; nN = nN_; nwg = nM * nN; G = G_; c = c_; }
    __device__ bool next(int i, Unit& u) const {
        const long L = (long)i * G + c; if (L >= nwg) return false;
        int wgid = (int)L; { const int q = nwg / NXCD, r = nwg % NXCD, xcd = wgid % NXCD, off = wgid / NXCD; wgid = (xcd < r ? xcd * (q + 1) : r * (q + 1) + (xcd - r) * q) + off; }
        const int nig = WGM * nN, gid = wgid / nig, fm = gid * WGM, gsz = (nM - fm) < WGM ? (nM - fm) : WGM;
        u.pm = fm + ((wgid % nig) % gsz); u.pn = (wgid % nig) / gsz; return true;
    }
};
template <class Epi, bool ALIGN_EPI, int LDA, int KK, int TSPLIT, long ASHIFT, long BROW>
__device__ __forceinline__ void gemm_phase(LAS unsigned char* lds, const int tid_in, const Gemm g, const StaticOrder& S, const Epi& E) {
    int tid = tid_in; asm volatile("" : "+v"(tid));
    const int wid = __builtin_amdgcn_readfirstlane(tid >> 6), lane = tid & 63, wr = wid >> 2, wc = wid & 3, fr = lane & 15, fq = lane >> 4;
    constexpr int K = KK, nt = K / BK, lda = LDA, tsplit = TSPLIT; constexpr long ashift = ASHIFT;
    unsigned voffA[2], voffB[2];
#pragma unroll
    for (int i = 0; i < 2; ++i) { int R, C; stage_rc(tid * 16 + i * 8192, R, C); const int Rb = (R & ~31) + perm32(R & 31);
        voffA[i] = (unsigned)(R * lda + C) * 2u; voffB[i] = (unsigned)(Rb * K + C) * 2u; }
    constexpr size_t kstep = (size_t)(BK * 2);
    constexpr size_t hstepA = (size_t)HALF * lda * 2, hstepB = (size_t)HALF * K * 2, tstepA = 2 * hstepA, tstepB = 2 * hstepB;
    const unsigned ldsw = (unsigned)wid * 1024u;
    const int aoff = lds_byte(wr * 64 + fr, fq * 8), boff = lds_byte(wc * 32 + fr, fq * 8);
#define PG8_AP(base, tt) ((base) + (((tt) < tsplit) ? (long)(tt) * 128 : ashift + (long)((tt) - tsplit) * 128))
#define PG8_ABASE(u) ((const char*)g.A + (size_t)(u).pm * tstepA + ((BROW != 0 && (u).pm >= 32) ? BROW : 0))
#define PG8_SA(b, h) (((b) * 2 + (h)) * HTB)
#define PG8_SB(b, h) ((4 + (b) * 2 + (h)) * HTB)
#define PG8_STAGE(bufoff, gbase, voff) do { const char* _gb = (const char*)(gbase); asm volatile("" : "+s"(_gb)); _Pragma("unroll") for (int _i = 0; _i < 2; ++_i) \
        __builtin_amdgcn_global_load_lds((const unsigned*)(_gb + (voff)[_i]), (LAS unsigned*)(lds + (bufoff) + ldsw + _i * 8192), 16, 0, 0); } while (0)
#define PG8_LDA(dst, b, h) do { _Pragma("unroll") for (int m = 0; m < 4; ++m) _Pragma("unroll") for (int k = 0; k < 2; ++k) dst[m][k] = *(const LAS bf16x8*)(lds + PG8_SA(b, h) + aoff + m * 2048 + k * 1024); } while (0)
#define PG8_LDB(dst, b, h) do { _Pragma("unroll") for (int n = 0; n < 2; ++n) _Pragma("unroll") for (int k = 0; k < 2; ++k) dst[n][k] = *(const LAS bf16x8*)(lds + PG8_SB(b, h) + boff + n * 2048 + k * 1024); } while (0)
#define PG8_MMA(ai, bj, At, Bt) do { __builtin_amdgcn_s_setprio(1); _Pragma("unroll") for (int m = 0; m < 4; ++m) _Pragma("unroll") for (int n = 0; n < 2; ++n) _Pragma("unroll") for (int k = 0; k < 2; ++k) \
        acc[ai][bj][m][n] = __builtin_amdgcn_mfma_f32_16x16x32_bf16(Bt[n][k], At[m][k], acc[ai][bj][m][n], 0, 0, 0); __builtin_amdgcn_s_setprio(0); } while (0)
#define PG8_WAIT_V(n) asm volatile("s_waitcnt vmcnt(" #n ")" ::: "memory")
#define PG8_WAIT_L(n) asm volatile("s_waitcnt lgkmcnt(" #n ")" ::: "memory")
#define PG8_BAR __builtin_amdgcn_s_barrier()
#define PG8_SCHED __builtin_amdgcn_sched_barrier(0)
    Unit cur, nxt; int ui = 0;
    if (!S.next(0, cur)) return;
    f32x4 acc[2][2][4][2];
#pragma unroll
    for (int a = 0; a < 2; ++a)
#pragma unroll
        for (int b = 0; b < 2; ++b)
#pragma unroll
            for (int m = 0; m < 4; ++m)
#pragma unroll
                for (int n = 0; n < 2; ++n) acc[a][b][m][n] = (f32x4){0.f, 0.f, 0.f, 0.f};
    bf16x8 At[4][2], B0[2][2], B1[2][2];
    const char* cA = PG8_ABASE(cur); const char* cB = (const char*)g.Bt + (size_t)cur.pn * tstepB;
    {
        const char* a0 = PG8_AP(cA, 0); const char* a1 = PG8_AP(cA, 1);
        PG8_STAGE(PG8_SB(0, 0), cB, voffB); PG8_STAGE(PG8_SB(0, 1), cB + hstepB, voffB); PG8_STAGE(PG8_SA(0, 0), a0, voffA); PG8_STAGE(PG8_SA(0, 1), a0 + hstepA, voffA);
        if (wr == 1) PG8_BAR;
        PG8_WAIT_V(2); PG8_BAR;
        PG8_STAGE(PG8_SB(1, 0), cB + kstep, voffB); PG8_STAGE(PG8_SA(1, 0), a1, voffA); PG8_STAGE(PG8_SB(1, 1), cB + hstepB + kstep, voffB);
        PG8_WAIT_V(6); PG8_BAR;
    }
    for (;;) {
        const bool has_next = S.next(ui + 1, nxt);
        const char* nA = has_next ? PG8_ABASE(nxt) : cA; const char* nB = has_next ? (const char*)g.Bt + (size_t)nxt.pn * tstepB : cB;
        for (int t = 0; t < nt; t += 2) {
            const bool last = (t == nt - 2);
            const char* a1 = PG8_AP(cA, t + 1);
            const char* a2 = last ? PG8_AP(nA, 0) : PG8_AP(cA, t + 2); const char* b2 = last ? nB : cB + (size_t)(t + 2) * kstep;
            const char* a3 = last ? PG8_AP(nA, 1) : PG8_AP(cA, t + 3); const char* b3 = b2 + kstep;
            PG8_LDB(B0, 0, 0); PG8_LDB(B1, 0, 1); PG8_SCHED; PG8_LDA(At, 0, 0); PG8_STAGE(PG8_SA(1, 1), a1 + hstepA, voffA);
            PG8_WAIT_V(8); PG8_WAIT_L(0); PG8_BAR; PG8_MMA(0, 0, At, B0); PG8_MMA(0, 1, At, B1); PG8_BAR; PG8_SCHED;
            PG8_LDA(At, 0, 1); PG8_STAGE(PG8_SB(0, 0), b2, voffB); PG8_STAGE(PG8_SB(0, 1), b2 + hstepB, voffB); PG8_STAGE(PG8_SA(0, 0), a2, voffA);
            PG8_WAIT_V(8); PG8_WAIT_L(0); PG8_BAR; PG8_MMA(1, 0, At, B0); PG8_MMA(1, 1, At, B1); PG8_BAR; PG8_SCHED;
            PG8_LDB(B0, 1, 0); PG8_LDB(B1, 1, 1); PG8_SCHED; PG8_LDA(At, 1, 0); PG8_STAGE(PG8_SA(0, 1), a2 + hstepA, voffA);
            PG8_WAIT_V(8); PG8_WAIT_L(0); PG8_BAR; PG8_MMA(0, 0, At, B0); PG8_MMA(0, 1, At, B1); PG8_BAR; PG8_SCHED;
            PG8_LDA(At, 1, 1); PG8_STAGE(PG8_SB(1, 0), b3, voffB); PG8_STAGE(PG8_SB(1, 1), b3 + hstepB, voffB); PG8_STAGE(PG8_SA(1, 0), a3, voffA);
            PG8_WAIT_V(8); PG8_WAIT_L(0); PG8_BAR; PG8_MMA(1, 0, At, B0); PG8_MMA(1, 1, At, B1); PG8_BAR; PG8_SCHED;
        }
        if constexpr (ALIGN_EPI) { if (wr == 0) PG8_BAR; }
        E(acc, cur, wr, wc, fr, fq);
        if (!has_next) break;
#pragma unroll
        for (int a = 0; a < 2; ++a)
#pragma unroll
            for (int b = 0; b < 2; ++b)
#pragma unroll
                for (int m = 0; m < 4; ++m)
#pragma unroll
                    for (int n = 0; n < 2; ++n) acc[a][b][m][n] = (f32x4){0.f, 0.f, 0.f, 0.f};
        cur = nxt; cA = nA; cB = nB; ++ui;
        if constexpr (ALIGN_EPI) { if (wr == 1) PG8_BAR; }
    }
    PG8_WAIT_V(0);
    if constexpr (!ALIGN_EPI) { if (wr == 0) PG8_BAR; }
    PG8_BAR;
#undef PG8_AP
#undef PG8_ABASE
#undef PG8_SA
#undef PG8_SB
#undef PG8_STAGE
#undef PG8_LDA
#undef PG8_LDB
#undef PG8_MMA
#undef PG8_WAIT_V
#undef PG8_WAIT_L
#undef PG8_BAR
#undef PG8_SCHED
}
}

template <class Fn>
__device__ __forceinline__ void epi_for(const f32x4 (&acc)[2][2][4][2], const pg8::Unit& u, int wr, int wc, int fr, int fq, Fn fn) {
#pragma unroll
    for (int ai = 0; ai < 2; ++ai)
#pragma unroll
        for (int m = 0; m < 4; ++m) { const int row = u.pm * 256 + ai * 128 + wr * 64 + m * 16 + fr;
#pragma unroll
            for (int bj = 0; bj < 2; ++bj) { const int col = u.pn * 256 + bj * 128 + wc * 32 + 8 * fq; fn(row, col, acc[ai][bj][m][0], acc[ai][bj][m][1]); }
            if (m & 1) asm volatile("" ::: "memory"); }
}
__device__ __forceinline__ u32x4 pack8(f32x4 v0, f32x4 v1) { u32x4 w; w.x = cvt_pk_bf16(v0[0], v0[1]); w.y = cvt_pk_bf16(v0[2], v0[3]); w.z = cvt_pk_bf16(v1[0], v1[1]); w.w = cvt_pk_bf16(v1[2], v1[3]); return w; }

struct EpiEvenIn {
    bf16_t* Z; const float* ssq; bf16_t* VTa; bf16_t* VTb; bf16_t* KT;
    __device__ __forceinline__ void operator()(const f32x4 (&acc)[2][2][4][2], const pg8::Unit& u, int wr, int wc, int fr, int fq) const {
        const int g = u.pn >> 1;
        epi_for(acc, u, wr, wc, fr, fq, [&](int row, int col, f32x4 v0, f32x4 v1) {
            const float rs = rsqrtf(ssq_sum(ssq, row) * (1.f / D) + 1e-6f);
            v0 = v0 * rs; v1 = v1 * rs;
            const int cg = col & 511, t = row & (SEQ - 1), b = row >> 13;
            if (g == 2 || g == 6) {
                bf16_t* p = (g == 2 ? VTa : VTb) + ((size_t)(b * 512 + cg)) * SEQ + t;
                _Pragma("unroll") for (int j = 0; j < 4; ++j) { p[(size_t)j * SEQ] = (bf16_t)f2bf(v0[j]); p[(size_t)(4 + j) * SEQ] = (bf16_t)f2bf(v1[j]); }
            } else if (g < 2) {
                const float pos = (float)t; const int i0 = (cg & 127) >> 1;
                float o[8] = {v0[0], v0[1], v0[2], v0[3], v1[0], v1[1], v1[2], v1[3]};
                _Pragma("unroll") for (int j = 0; j < 4; ++j) { const float inv = exp2f(-(float)(i0 + j) * (13.287712379549449f / 64.f));
                    float rev = pos * inv * 0.15915494309189535f; rev = rev - floorf(rev); const float sn = __builtin_amdgcn_sinf(rev), cs = __builtin_amdgcn_cosf(rev);
                    const float x1 = o[2 * j], x2 = o[2 * j + 1]; o[2 * j] = x1 * cs - x2 * sn; o[2 * j + 1] = x1 * sn + x2 * cs; }
                const float lg2 = log2f(1.f - exp2f(-5.f - (float)(cg >> 7))); const float ip1 = (float)((t & 127) + 1);
                if (g == 0) { const float f = exp2f(ip1 * lg2);
                    *(u32x4*)(Z + (size_t)row * ZE + cg) = pack8((f32x4){o[0] * f, o[1] * f, o[2] * f, o[3] * f}, (f32x4){o[4] * f, o[5] * f, o[6] * f, o[7] * f}); }
                else { const float f = exp2f(-ip1 * lg2), f2 = exp2f((128.f - ip1) * lg2);
                    *(u32x4*)(Z + (size_t)row * ZE + 512 + cg) = pack8((f32x4){o[0] * f, o[1] * f, o[2] * f, o[3] * f}, (f32x4){o[4] * f, o[5] * f, o[6] * f, o[7] * f});
                    bf16_t* p = KT + ((size_t)(b * 512 + cg)) * SEQ + t;
                    _Pragma("unroll") for (int j = 0; j < 8; ++j) p[(size_t)j * SEQ] = (bf16_t)f2bf(o[j] * f2); }
            } else {
                const int zc = (g - 1 - (g > 6 ? 1 : 0)) * 512;
                *(u32x4*)(Z + (size_t)row * ZE + zc + cg) = pack8(v0, v1);
            }
        });
    }
};
struct EpiOddIn {
    bf16_t* Z; bf16_t* L1;
    __device__ __forceinline__ void operator()(const f32x4 (&acc)[2][2][4][2], const pg8::Unit& u, int wr, int wc, int fr, int fq) const {
        if (u.pn < 16) { epi_for(acc, u, wr, wc, fr, fq, [&](int row, int col, f32x4 v0, f32x4 v1) { *(u32x4*)(Z + (size_t)row * ZW + col) = pack8(v0, v1); }); }
        else { epi_for(acc, u, wr, wc, fr, fq, [&](int row, int col, f32x4 v0, f32x4 v1) { const int c = col - 4096; if (c < 64) {
                    _Pragma("unroll") for (int j = 0; j < 4; ++j) { v0[j] = tanhf(v0[j]); v1[j] = tanhf(v1[j]); } }
                *(u32x4*)(L1 + (size_t)row * 256 + c) = pack8(v0, v1); }); }
    }
};
__device__ __forceinline__ void unpack8(const u32x4 w, f32x4& a, f32x4& b) {
    a = (f32x4){__uint_as_float(w.x << 16), __uint_as_float(w.x & 0xffff0000u), __uint_as_float(w.y << 16), __uint_as_float(w.y & 0xffff0000u)};
    b = (f32x4){__uint_as_float(w.z << 16), __uint_as_float(w.z & 0xffff0000u), __uint_as_float(w.w << 16), __uint_as_float(w.w & 0xffff0000u)}; }
struct EpiResid {
    const bf16_t* Ha; bf16_t* HB; int ldb;
    __device__ __forceinline__ void operator()(const f32x4 (&acc)[2][2][4][2], const pg8::Unit& u, int wr, int wc, int fr, int fq) const {
        epi_for(acc, u, wr, wc, fr, fq, [&](int row, int col, f32x4 v0, f32x4 v1) { f32x4 h0, h1; unpack8(*(const u32x4*)(Ha + (size_t)row * D + col), h0, h1); h0 = h0 + v0; h1 = h1 + v1;
            *(u32x4*)(HB + (size_t)row * ldb + col) = pack8(h0, h1); });
    }
};
struct EpiStore {
    bf16_t* O; int ldc;
    __device__ __forceinline__ void operator()(const f32x4 (&acc)[2][2][4][2], const pg8::Unit& u, int wr, int wc, int fr, int fq) const {
        epi_for(acc, u, wr, wc, fr, fq, [&](int row, int col, f32x4 v0, f32x4 v1) { *(u32x4*)(O + (size_t)row * ldc + col) = pack8(v0, v1); });
    }
};
struct EpiGate {
    const bf16_t* Hb; int ldh; const bf16_t* PP; int ldp; bf16_t* Ha; float* ssq;
    __device__ __forceinline__ void operator()(const f32x4 (&acc)[2][2][4][2], const pg8::Unit& u, int wr, int wc, int fr, int fq) const {
#pragma unroll
        for (int ai = 0; ai < 2; ++ai)
#pragma unroll
            for (int m = 0; m < 4; ++m) { const int row = u.pm * 256 + ai * 128 + wr * 64 + m * 16 + fr; float sq = 0.f;
#pragma unroll
                for (int bj = 0; bj < 2; ++bj) { const int col = u.pn * 256 + bj * 128 + wc * 32 + 8 * fq; const f32x4 v0 = acc[ai][bj][m][0], v1 = acc[ai][bj][m][1];
                    f32x4 h0, h1, p0, p1; unpack8(*(const u32x4*)(Hb + (size_t)row * ldh + col), h0, h1); unpack8(*(const u32x4*)(PP + (size_t)row * ldp + col), p0, p1);
#pragma unroll
                    for (int j = 0; j < 4; ++j) { h0[j] += sigmoidf_(v0[j]) * p0[j]; h1[j] += sigmoidf_(v1[j]) * p1[j]; sq += h0[j] * h0[j] + h1[j] * h1[j]; }
                    *(u32x4*)(Ha + (size_t)row * D + col) = pack8(h0, h1); }
                sq += __shfl_xor(sq, 16); sq += __shfl_xor(sq, 32);
                if (fq == 0) ssq[(size_t)row * 16 + u.pn * 4 + wc] = sq;
                if (m & 1) asm volatile("" ::: "memory"); }
    }
};

#define XB_TMO      128
#define XB_XCNT(j)  (256  + 64 * (j))
#define XB_XSUB(j)  (1280 + 64 * (j))
#define XB_XGEN(j)  (2304 + 64 * (j))
#define XB_TOP      3328
#define XB_TOPGEN   3392
#define XCD_BAR_WORDS 3456
#define XB_SPIN_CAP (1u << 22)
__device__ __forceinline__ unsigned xb_ld(unsigned* p)              { return __hip_atomic_load(p, __ATOMIC_RELAXED, __HIP_MEMORY_SCOPE_AGENT); }
__device__ __forceinline__ unsigned xb_add(unsigned* p, unsigned v) { return __hip_atomic_fetch_add(p, v, __ATOMIC_RELAXED, __HIP_MEMORY_SCOPE_AGENT); }
__device__ __forceinline__ unsigned xb_xcc_id() { return (unsigned)__builtin_amdgcn_s_getreg((3 << 11) | 20) & 0xFu; }
#define XB_SPIN(cond, bar) do { unsigned _sp = 0; while (cond) { __builtin_amdgcn_s_sleep(1); \
    if ((++_sp & 255u) == 0u) { if (xb_ld(&(bar)[XB_TMO])) break; if (_sp > XB_SPIN_CAP) { atomicAdd(&(bar)[XB_TMO], 1u); break; } } } } while (0)
struct XcdBarrier { unsigned* bar; unsigned x; volatile LAS unsigned* st; };
__device__ __forceinline__ XcdBarrier xcd_barrier_post(unsigned* bar, volatile LAS unsigned* st) {
    XcdBarrier b; b.bar = bar; b.x = xb_xcc_id(); b.st = st;
    if (threadIdx.x == 0) (void)xb_add(&bar[XB_XCNT(b.x)], 1u);
    return b;
}
__device__ __forceinline__ void xcd_barrier_complete(unsigned* bar, unsigned x, unsigned& nloc, unsigned& nx) {
    const unsigned G = gridDim.x * gridDim.y * gridDim.z;
    unsigned sum, cnt, mine, sp = 0u;
    for (;;) {
        sum = 0u; cnt = 0u; mine = 0u;
#pragma unroll
        for (unsigned j = 0; j < 16; ++j) { const unsigned c = xb_ld(&bar[XB_XCNT(j)]); sum += c; cnt += (c > 0u) ? 1u : 0u; mine = (j == x) ? c : mine; }
        if (sum == G) break;
        __builtin_amdgcn_s_sleep(1);
        if ((++sp & 255u) == 0u) { if (xb_ld(&bar[XB_TMO])) break; if (sp > XB_SPIN_CAP) { atomicAdd(&bar[XB_TMO], 1u); break; } }
    }
    nloc = mine > 0u ? mine : 1u; nx = cnt > 0u ? cnt : 1u;
}
__device__ __forceinline__ void xcd_barrier(const XcdBarrier& b_in) {
    asm volatile("s_waitcnt vmcnt(0)" ::: "memory");
    __syncthreads();
    if (threadIdx.x == 0) {
        const XcdBarrier& b = b_in;
        unsigned* bar = b.bar;
        __builtin_amdgcn_s_waitcnt(0);
        unsigned nloc = b.st[0], nx = b.st[1];
        if (nloc == 0u) { xcd_barrier_complete(bar, b.x, nloc, nx); b.st[0] = nloc; b.st[1] = nx; }
        const unsigned old = xb_add(&bar[XB_XSUB(b.x)], 1u);
        const unsigned gen = old / nloc;
        if (old + 1u == (gen + 1u) * nloc) {
            __builtin_amdgcn_fence(__ATOMIC_RELEASE, "agent");
            asm volatile("s_waitcnt vmcnt(0)" ::: "memory");
            const unsigned og = xb_add(&bar[XB_TOP], 1u);
            const unsigned tg = og / nx;
            if (og + 1u == (tg + 1u) * nx) xb_add(&bar[XB_TOPGEN], 1u);
            else XB_SPIN(xb_ld(&bar[XB_TOPGEN]) == tg, bar);
            __builtin_amdgcn_fence(__ATOMIC_ACQUIRE, "agent");
            xb_add(&bar[XB_XGEN(b.x)], 1u);
            asm volatile("s_waitcnt vmcnt(0)" ::: "memory");
        } else {
            XB_SPIN(xb_ld(&bar[XB_XGEN(b.x)]) == gen, bar);
            __builtin_amdgcn_fence(__ATOMIC_ACQUIRE, "agent");
            asm volatile("s_waitcnt vmcnt(0)" ::: "memory");
        }
    }
    __syncthreads();
}

constexpr size_t MiB = 1u << 20;
constexpr size_t WS_CTL = 0, CTL_BYTES = 1 * MiB;
constexpr size_t WS_SSQ = 241 * (size_t)(1u << 20);
constexpr size_t WS_WIN = 2 * MiB;
constexpr size_t WS_WOUT = 19 * MiB, WS_WGATE = 21 * MiB, WS_WPROJ = 23 * MiB;
constexpr size_t WS_PB = 24 * MiB;
constexpr size_t WS_Z = 32 * MiB;
constexpr size_t WS_HB = 160 * MiB;
constexpr size_t WS_VF = 193 * MiB;
constexpr size_t WS_L1 = 225 * MiB;
constexpr size_t WS_VTA = 128 * MiB;
constexpr size_t WS_VTB = 144 * MiB;
constexpr size_t WS_KT = 225 * MiB;
constexpr size_t WS_LORA2 = 23 * MiB + 512 * 1024;
constexpr size_t WS_PG = 160 * MiB;
constexpr size_t WS_SB = 2 * MiB;
constexpr size_t WS_BON = 233 * MiB;
constexpr size_t WS_ST = 176 * MiB;
constexpr size_t WS_KV = 160 * MiB;
constexpr size_t WS_END = 256 * MiB;

constexpr int RING_BYTES = 131072, LDS_BYTES = 163840, MISC_OFF = LDS_BYTES - 512;

struct Args { const float* in[26]; float* out; unsigned char* ws; int ph_lo, ph_hi; };

__device__ __forceinline__ const float* inptr(int i) { asm volatile("" : "+s"(i)); const char* ka = (const char*)__builtin_amdgcn_kernarg_segment_ptr(); return *(const float* const*)(ka + 8 * i); }
struct InTab { __device__ __forceinline__ const float* operator[](int i) const { return inptr(i); } };
struct Frame {
    LAS unsigned char* lds; unsigned char* ldsg;
    int tid, lane, wave, G, vcu;
    InTab in; float* H; unsigned char* ws;
    __device__ __forceinline__ void retid() { int l; asm volatile("v_mbcnt_lo_u32_b32 %0, -1, 0\n\tv_mbcnt_hi_u32_b32 %0, -1, %0" : "=v"(l)); lane = l; tid = wave * 64 + l; }
    __device__ __forceinline__ float* ssq(int l) const { return (float*)(ws + WS_SSQ) + (size_t)l * T * 16; }
};

__device__ __forceinline__ void conv_item(const float* W, int ldw, int Kmax, int k0, int n0, bf16_t* dst, int ldd, int dr0, int drs, int dk0,
                                          const float* svec, float sa, float sb, float sc, LAS float* scr, int lane) {
    float wv[32];
#pragma unroll
    for (int i = 0; i < 32; ++i) { const int k = k0 + 2 * i + (lane >> 5); wv[i] = (k < Kmax) ? W[(size_t)k * ldw + n0 + (lane & 31)] : 0.f; }
#pragma unroll
    for (int i = 0; i < 32; ++i) { const int kk = 2 * i + (lane >> 5), k = k0 + kk; const float f = (k < Kmax) ? (sa + sb * (svec ? svec[k] : 0.f)) * sc : 0.f;
        scr[kk * 33 + (lane & 31)] = wv[i] * f; }
    LDS_WAIT(); asm volatile("" ::: "memory");
    const int c = lane & 7;
    if (k0 + 8 * c < Kmax) {
#pragma unroll
        for (int j = 0; j < 4; ++j) { const int n = (lane >> 3) + 8 * j; const LAS float* s = scr + (8 * c) * 33 + n;
            u32x4 o; o.x = pk2(s[0 * 33], s[1 * 33]); o.y = pk2(s[2 * 33], s[3 * 33]); o.z = pk2(s[4 * 33], s[5 * 33]); o.w = pk2(s[6 * 33], s[7 * 33]);
            *(GAS u32x4*)(dst + (size_t)(dr0 + n * drs) * ldd + dk0 + k0 + 8 * c) = o; }
    }
    LDS_WAIT(); asm volatile("" ::: "memory");
}
__device__ __forceinline__ void conv_item2(const float* W, int ldw, int k0, int n0, bf16_t* dst, int dr0, const float* mu, float sc, LAS float* scr, int lane) {
    float wv[32];
#pragma unroll
    for (int i = 0; i < 32; ++i) wv[i] = W[(size_t)(k0 + 2 * i + (lane >> 5)) * ldw + n0 + (lane & 31)];
#pragma unroll
    for (int half = 0; half < 2; ++half) {
#pragma unroll
        for (int i = 0; i < 32; ++i) { const int kk = 2 * i + (lane >> 5); const float m = mu[k0 + kk]; scr[kk * 33 + (lane & 31)] = wv[i] * ((half ? m : 1.f - m) * sc); }
        LDS_WAIT(); asm volatile("" ::: "memory");
        const int c = lane & 7;
#pragma unroll
        for (int j = 0; j < 4; ++j) { const int n = (lane >> 3) + 8 * j; const LAS float* s_ = scr + (8 * c) * 33 + n;
            u32x4 o; o.x = pk2(s_[0 * 33], s_[1 * 33]); o.y = pk2(s_[2 * 33], s_[3 * 33]); o.z = pk2(s_[4 * 33], s_[5 * 33]); o.w = pk2(s_[6 * 33], s_[7 * 33]);
            *(GAS u32x4*)(dst + (size_t)(dr0 + n) * 2048 + half * 1024 + k0 + 8 * c) = o; }
        LDS_WAIT(); asm volatile("" ::: "memory");
    }
}
__device__ __forceinline__ void conv_win_even(Frame& F, int li) {
    const int e = li >> 1; const float* W = F.in[6] + (size_t)e * D * ZW; const float* gain = F.in[2] + li * D; bf16_t* dst = (bf16_t*)(F.ws + WS_WIN);
    LAS float* scr = (LAS float*)(F.lds + F.wave * 16384);
    const int gw = F.vcu * 8 + F.wave, NGW = F.G * 8;
    for (int it = gw; it < 16 * 128; it += NGW) { const int kb = it >> 7, nb = it & 127, n0 = nb * 32, g = n0 >> 9, hh = (n0 & 511) >> 7, d0 = n0 & 127;
        int dr0 = n0, drs = 1; if (g < 2) { dr0 = g * 512 + hh * 128 + (d0 < 64 ? 2 * d0 : 2 * (d0 - 64) + 1); drs = 2; }
        const float sc = (g == 1 || g == 5) ? QK_SCALE : 1.f;
        conv_item(W, ZW, D, kb * 64, n0, dst, D, dr0, drs, 0, gain, 0.f, 1.f, sc, scr, F.lane); }
}
__device__ __forceinline__ void conv_win_odd(Frame& F, int li) {
    const int o = li >> 1; const float* mu = F.in[9] + (size_t)o * 6 * D; bf16_t* dst = (bf16_t*)(F.ws + WS_WIN);
    LAS float* scr = (LAS float*)(F.lds + F.wave * 16384);
    const int gw = F.vcu * 8 + F.wave, NGW = F.G * 8;
    for (int it = gw; it < 4 * 512; it += NGW) { const int p = it >> 9, r = it & 511, kb = r >> 5, nb = r & 31;
        conv_item2(F.in[10] + ((size_t)o * 4 + p) * D * D, D, kb * 64, nb * 32, dst, p * 1024 + nb * 32, mu + p * D, 1.f, scr, F.lane); }
    for (int it = gw; it < 32 + 32 + 16; it += NGW) { const float* W; int ldw, n0, dr0, mi, kb; const int r = it;
        if (r < 32) { W = F.in[13] + (size_t)o * D * 64; ldw = 64; kb = r >> 1; n0 = (r & 1) * 32; dr0 = 4096 + n0; mi = 4; }
        else if (r < 64) { const int q = r - 32; W = F.in[16] + (size_t)o * D * 64; ldw = 64; kb = q >> 1; n0 = (q & 1) * 32; dr0 = 4160 + n0; mi = 5; }
        else { const int q = r - 64; W = F.in[19]; ldw = 32; kb = q; n0 = 0; dr0 = 4224; mi = 2; }
        conv_item2(W, ldw, kb * 64, n0, dst, dr0, mu + mi * D, (r >= 64 && o == 0) ? 0.f : 1.f, scr, F.lane); }
    { u32x4 z = {0u, 0u, 0u, 0u}; GAS u32x4* zp = (GAS u32x4*)(dst + (size_t)4256 * 2048); const int n16 = 96 * 2048 * 2 / 16;
      for (int i = (F.vcu * 512 + F.tid); i < n16; i += F.G * 512) zp[i] = z; }
}
__device__ __forceinline__ void conv_wrest(Frame& F, int li) {
    const bool even = (li & 1) == 0; const int e = li >> 1;
    const float* Wo = even ? F.in[7] + (size_t)e * D * D : F.in[11] + (size_t)e * D * D;
    const float* Wg = F.in[5] + (size_t)li * D * D; const float* Wp = F.in[4] + (size_t)li * PLE * D;
    LAS float* scr = (LAS float*)(F.lds + F.wave * 16384);
    const int gw = F.vcu * 8 + F.wave, NGW = F.G * 8;
    for (int it = gw; it < 512 + 512 + 128; it += NGW) {
        if (it < 512) conv_item(Wo, D, D, (it >> 5) * 64, (it & 31) * 32, (bf16_t*)(F.ws + WS_WOUT), D, (it & 31) * 32, 1, 0, nullptr, 1.f, 0.f, 1.f, scr, F.lane);
        else if (it < 1024) { const int r = it - 512; conv_item(Wg, D, D, (r >> 5) * 64, (r & 31) * 32, (bf16_t*)(F.ws + WS_WGATE), D, (r & 31) * 32, 1, 0, nullptr, 1.f, 0.f, 1.f, scr, F.lane); }
        else { const int r = it - 1024; conv_item(Wp, D, PLE, (r >> 5) * 64, (r & 31) * 32, (bf16_t*)(F.ws + WS_WPROJ), PLE, (r & 31) * 32, 1, 0, nullptr, 1.f, 0.f, 1.f, scr, F.lane); }
    }
    const float* P = F.in[1] + (size_t)li * T * PLE; GAS u32x4* pb = (GAS u32x4*)(F.ws + WS_PB); const int n8 = T * PLE / 8;
    for (int i = F.vcu * 512 + F.tid; i < n8; i += F.G * 512) { const f32x4 a = *(const f32x4*)(P + (size_t)i * 8), b = *(const f32x4*)(P + (size_t)i * 8 + 4);
        u32x4 o; o.x = pk2(a[0], a[1]); o.y = pk2(a[2], a[3]); o.z = pk2(b[0], b[1]); o.w = pk2(b[2], b[3]); pb[i] = o; }
}

__device__ __forceinline__ void conv_lora2(Frame& F, int li) {
    const int o = li >> 1; LAS float* scr = (LAS float*)(F.lds + F.wave * 16384);
    bf16_t* W2T = (bf16_t*)(F.ws + WS_LORA2); bf16_t* A2T = W2T + 1024 * 64; bf16_t* V2T = A2T + 1024 * 64;
    const int gw = F.vcu * 8 + F.wave, NGW = F.G * 8;
    for (int it = gw; it < 96; it += NGW) {
        if (it < 32) conv_item(F.in[14] + (size_t)o * 64 * D, D, 64, 0, it * 32, W2T, 64, it * 32, 1, 0, nullptr, 1.f, 0.f, 1.f, scr, F.lane);
        else if (it < 64) conv_item(F.in[17] + (size_t)o * 64 * D, D, 64, 0, (it - 32) * 32, A2T, 64, (it - 32) * 32, 1, 0, nullptr, 1.f, 0.f, 1.f, scr, F.lane);
        else conv_item(F.in[20], D, 32, 0, (it - 64) * 32, V2T, 32, (it - 64) * 32, 1, 0, nullptr, 1.f, 0.f, 1.f, scr, F.lane);
    }
}
__device__ __forceinline__ void rows_p0(Frame& F) {
    const float* x = F.in[0]; bf16_t* HB = (bf16_t*)(F.ws + WS_HB); float* s0 = F.ssq(0);
    for (int row = F.vcu * 8 + F.wave; row < T; row += F.G * 8) {
        const f32x4* xr = (const f32x4*)(x + (size_t)row * D) + F.lane; u32x2* br = (u32x2*)(HB + (size_t)row * D) + F.lane; float s = 0.f;
#pragma unroll
        for (int j = 0; j < 4; ++j) { const f32x4 v = xr[64 * j]; s += (v[0] * v[0] + v[1] * v[1]) + (v[2] * v[2] + v[3] * v[3]); u32x2 w; w.x = pk2(v[0], v[1]); w.y = pk2(v[2], v[3]); br[64 * j] = w; }
        s = wave_sum(s); if (F.lane < 16) s0[(size_t)row * 16 + F.lane] = F.lane == 0 ? s : 0.f;
    }
}
__device__ __forceinline__ void rows_norm(Frame& F, int li) {
    const float* gain = F.in[2] + li * D; bf16_t* HN = (bf16_t*)(F.H); const bf16_t* Ha = (const bf16_t*)(F.ws + WS_HB); const float* sq = F.ssq(li);
    f32x4 g[4];
#pragma unroll
    for (int j = 0; j < 4; ++j) g[j] = *((const f32x4*)gain + F.lane + 64 * j);
    for (int row = F.vcu * 8 + F.wave; row < T; row += F.G * 8) {
        const u32x2* hr = (const u32x2*)(Ha + (size_t)row * D) + F.lane; u32x2* br = (u32x2*)(HN + (size_t)(row + 1 + (row >= SEQ ? 1 : 0)) * D) + F.lane;
        const float rs = rsqrtf(ssq_sum(sq, row) * (1.f / D) + 1e-6f);
#pragma unroll
        for (int j = 0; j < 4; ++j) { const u32x2 hw = hr[64 * j]; const f32x4 h4 = {__uint_as_float(hw.x << 16), __uint_as_float(hw.x & 0xffff0000u), __uint_as_float(hw.y << 16), __uint_as_float(hw.y & 0xffff0000u)};
            const f32x4 v = h4 * rs * g[j]; u32x2 w; w.x = pk2(v[0], v[1]); w.y = pk2(v[2], v[3]); br[64 * j] = w; }
    }
    if (F.vcu == 0 && F.wave < 2) { u32x2* br = (u32x2*)(HN + (size_t)(F.wave ? SEQ + 1 : 0) * D) + F.lane; u32x2 z = {0u, 0u};
#pragma unroll
        for (int j = 0; j < 4; ++j) br[64 * j] = z; }
}
__device__ __forceinline__ void rows_final(Frame& F) {
    const float* gain = F.in[3]; const float* sq = F.ssq(4); const bf16_t* Ha = (const bf16_t*)(F.ws + WS_HB);
    f32x4 g[4];
#pragma unroll
    for (int j = 0; j < 4; ++j) g[j] = *((const f32x4*)gain + F.lane + 64 * j);
    for (int row = F.vcu * 8 + F.wave; row < T; row += F.G * 8) {
        const u32x2* hr = (const u32x2*)(Ha + (size_t)row * D) + F.lane; f32x4* orow = (f32x4*)(F.H + (size_t)row * D) + F.lane; const float rs = rsqrtf(ssq_sum(sq, row) * (1.f / D) + 1e-6f);
#pragma unroll
        for (int j = 0; j < 4; ++j) { const u32x2 hw = hr[64 * j]; const f32x4 h4 = {__uint_as_float(hw.x << 16), __uint_as_float(hw.x & 0xffff0000u), __uint_as_float(hw.y << 16), __uint_as_float(hw.y & 0xffff0000u)};
            orow[64 * j] = h4 * rs * g[j]; }
    }
}

typedef float f32x16 __attribute__((ext_vector_type(16)));
template <bool DUMMY>
__device__ __forceinline__ void sb_unit(Frame& F, int bh, int qb) {
    const int lane = F.lane, l31 = lane & 31, hi = lane >> 5, b = bh >> 2, h = bh & 3;
    bf16_t* Z = (bf16_t*)(F.ws + WS_Z); const bf16_t* VT = (const bf16_t*)(F.ws + WS_VTB) + (size_t)bh * 128 * SEQ;
    const size_t rowb = (size_t)b * SEQ; const int q0 = qb * 32, tq = q0 + l31;
    bf16x8 qr[8];
    { const bf16_t* qp = Z + (rowb + tq) * ZE + 1536 + h * 128 + hi * 8;
#pragma unroll
      for (int ks = 0; ks < 8; ++ks) qr[ks] = *(const bf16x8*)(qp + 16 * ks); }
    f32x16 o[4];
#pragma unroll
    for (int d = 0; d < 4; ++d)
#pragma unroll
        for (int r = 0; r < 16; ++r) o[d][r] = 0.f;
    float carry = 1.f;
    const int pi = 16 * ((l31 >> 2) & 1) + (l31 & 3) + 4 * (l31 >> 3);
    const bf16_t* Kb = Z + rowb * ZE + 2048 + h * 128 + hi * 8;
    for (int kt = (q0 + 31) >> 6; kt >= 0; --kt) {
        const int kbase = kt * 64;
        const bf16_t* kp0 = Kb + (size_t)(kbase + pi) * ZE; const bf16_t* kp1 = kp0 + (size_t)32 * ZE;
        f32x16 p0, p1;
#pragma unroll
        for (int r = 0; r < 16; ++r) { p0[r] = 0.f; p1[r] = 0.f; }
#pragma unroll
        for (int ks = 0; ks < 8; ++ks) { const bf16x8 a0 = *(const bf16x8*)(kp0 + 16 * ks), a1 = *(const bf16x8*)(kp1 + 16 * ks);
            p0 = __builtin_amdgcn_mfma_f32_32x32x16_bf16(a0, qr[ks], p0, 0, 0, 0); p1 = __builtin_amdgcn_mfma_f32_32x32x16_bf16(a1, qr[ks], p1, 0, 0, 0); }
        float f1 = 1.f, f0 = 1.f;
        const int k1 = kbase + 32 + 16 * hi, k0 = kbase + 16 * hi;
#pragma unroll
        for (int r = 15; r >= 0; --r) { const float z = fminf(p1[r], 80.f); const float e = exp2f(z * 1.4426950408889634f); float rd = __builtin_amdgcn_rcpf(1.f + e); float be = e * rd;
            const bool valid = (k1 + r) < tq; be = valid ? be : 0.f; rd = valid ? rd : 1.f; p1[r] = be * f1; f1 *= rd; }
#pragma unroll
        for (int r = 15; r >= 0; --r) { const float z = fminf(p0[r], 80.f); const float e = exp2f(z * 1.4426950408889634f); float rd = __builtin_amdgcn_rcpf(1.f + e); float be = e * rd;
            const bool valid = (k0 + r) < tq; be = valid ? be : 0.f; rd = valid ? rd : 1.f; p0[r] = be * f0; f0 *= rd; }
        const float pf0 = __shfl_xor(f0, 32), pf1 = __shfl_xor(f1, 32);
        const float tail1 = hi ? 1.f : pf1;
        const float tail0 = hi ? (pf1 * f1) : (pf0 * f1 * pf1);
        const float s1 = tail1 * carry, s0 = tail0 * carry;
        carry *= (f0 * f1) * (pf0 * pf1);
        u32x4 pa[2][2];
#pragma unroll
        for (int s = 0; s < 2; ++s) {
            pa[0][s].x = cvt_pk_bf16(p0[8 * s + 0] * s0, p0[8 * s + 1] * s0); pa[0][s].y = cvt_pk_bf16(p0[8 * s + 2] * s0, p0[8 * s + 3] * s0);
            pa[0][s].z = cvt_pk_bf16(p0[8 * s + 4] * s0, p0[8 * s + 5] * s0); pa[0][s].w = cvt_pk_bf16(p0[8 * s + 6] * s0, p0[8 * s + 7] * s0);
            pa[1][s].x = cvt_pk_bf16(p1[8 * s + 0] * s1, p1[8 * s + 1] * s1); pa[1][s].y = cvt_pk_bf16(p1[8 * s + 2] * s1, p1[8 * s + 3] * s1);
            pa[1][s].z = cvt_pk_bf16(p1[8 * s + 4] * s1, p1[8 * s + 5] * s1); pa[1][s].w = cvt_pk_bf16(p1[8 * s + 6] * s1, p1[8 * s + 7] * s1);
        }
        const bf16_t* vp = VT + (size_t)l31 * SEQ + kbase + 16 * hi;
#pragma unroll
        for (int d = 0; d < 4; ++d)
#pragma unroll
            for (int blk = 0; blk < 2; ++blk)
#pragma unroll
                for (int s = 0; s < 2; ++s) { const bf16x8 vb = *(const bf16x8*)(vp + (size_t)(32 * d) * SEQ + 32 * blk + 8 * s);
                    o[d] = __builtin_amdgcn_mfma_f32_32x32x16_bf16(__builtin_bit_cast(bf16x8, pa[blk][s]), vb, o[d], 0, 0, 0); }
        if (__all(carry < 7.9e-31f)) break;
    }
#pragma unroll
    for (int r = 0; r < 16; ++r) { const int qrow = q0 + (r & 3) + 8 * (r >> 2) + 4 * hi; bf16_t* gp = Z + (rowb + qrow) * ZE + 2560 + h * 128 + l31;
#pragma unroll
        for (int d = 0; d < 4; ++d) { const float g = bf2f(gp[32 * d]); const float ov = o[d][r] * siluf_(g); if (!DUMMY) gp[32 * d] = (bf16_t)f2bf(ov); else asm volatile("" :: "v"(ov)); } }
}
__device__ __forceinline__ void ret_stage_a(Frame& F, int u) {
    const int l31 = F.lane & 31, hi = F.lane >> 5, cu = u >> 3, w8 = u & 7, bh = cu & 7, n = cu >> 3, dvb = w8 >> 1, dkp = w8 & 1;
    const bf16_t* vt = (const bf16_t*)(F.ws + WS_VTA) + ((size_t)(bh * 128 + 32 * dvb + l31)) * SEQ + n * 128 + 8 * hi;
    const bf16_t* kt = (const bf16_t*)(F.ws + WS_KT) + ((size_t)(bh * 128 + 64 * dkp + l31)) * SEQ + n * 128 + 8 * hi;
    f32x16 a0, a1;
#pragma unroll
    for (int r = 0; r < 16; ++r) { a0[r] = 0.f; a1[r] = 0.f; }
#pragma unroll
    for (int ks = 0; ks < 8; ++ks) { const bf16x8 va = *(const bf16x8*)(vt + 16 * ks), k0 = *(const bf16x8*)(kt + 16 * ks), k1 = *(const bf16x8*)(kt + (size_t)32 * SEQ + 16 * ks);
        a0 = __builtin_amdgcn_mfma_f32_32x32x16_bf16(va, k0, a0, 0, 0, 0); a1 = __builtin_amdgcn_mfma_f32_32x32x16_bf16(va, k1, a1, 0, 0, 0); }
    bf16_t* kv = (bf16_t*)(F.H) + ((size_t)cu * 128 + 32 * dvb) * 128 + 64 * dkp + l31;
#pragma unroll
    for (int r = 0; r < 16; ++r) { const int dv = (r & 3) + 8 * (r >> 2) + 4 * hi; kv[dv * 128] = (bf16_t)f2bf(a0[r]); kv[dv * 128 + 32] = (bf16_t)f2bf(a1[r]); }
}
__device__ __forceinline__ void ret_stage_b(Frame& F) {
    const int e = F.vcu * 512 + F.tid; if (e >= 8 * 128 * 128) return;
    const int h = (e >> 14) & 3; const float g128 = exp2f(128.f * log2f(1.f - exp2f(-5.f - (float)h)));
    const bf16_t* p = (const bf16_t*)(F.H) + e; bf16_t* q = (bf16_t*)(F.H) + (size_t)8 * 1024 * 1024 + e; float S = 0.f;
#pragma unroll 4
    for (int n = 0; n < 64; ++n) { const float kv = bf2f(p[(size_t)n * 131072]); q[(size_t)n * 131072] = (bf16_t)f2bf(S); S = S * g128 + kv; }
}
template <bool DUMMY>
__device__ __forceinline__ void ret_stage_c(Frame& F, int u, const float* gng) {
    const int lane = F.lane, l31 = lane & 31, hi = lane >> 5, cu = u >> 2, qblk = u & 3, bh = cu & 7, n = cu >> 3, b = bh >> 2, h = bh & 3;
    bf16_t* Z = (bf16_t*)(F.ws + WS_Z); const size_t rowb = (size_t)b * SEQ; const int t0 = n * 128, tq = t0 + 32 * qblk + l31;
    bf16x8 qr[8];
    { const bf16_t* qp = Z + (rowb + tq) * ZE + h * 128 + hi * 8;
#pragma unroll
      for (int ks = 0; ks < 8; ++ks) qr[ks] = *(const bf16x8*)(qp + 16 * ks); }
    f32x16 o[4];
#pragma unroll
    for (int d = 0; d < 4; ++d)
#pragma unroll
        for (int r = 0; r < 16; ++r) o[d][r] = 0.f;
    { const bf16_t* sp = (const bf16_t*)(F.H) + (size_t)8 * 1024 * 1024 + ((size_t)cu * 128 + l31) * 128 + 8 * hi;
#pragma unroll
      for (int ks = 0; ks < 8; ++ks)
#pragma unroll
          for (int d = 0; d < 4; ++d) { const bf16x8 sb = *(const bf16x8*)(sp + (size_t)(32 * d) * 128 + 16 * ks); o[d] = __builtin_amdgcn_mfma_f32_32x32x16_bf16(qr[ks], sb, o[d], 0, 0, 0); } }
    const int pi = 16 * ((l31 >> 2) & 1) + (l31 & 3) + 4 * (l31 >> 3);
    const bf16_t* Kb = Z + rowb * ZE + 512 + h * 128 + hi * 8;
    const bf16_t* VT = (const bf16_t*)(F.ws + WS_VTA) + ((size_t)(bh * 128 + l31)) * SEQ + 16 * hi;
    for (int kb = 0; kb <= qblk; ++kb) {
        const int kbase = t0 + 32 * kb; const bf16_t* kp = Kb + (size_t)(kbase + pi) * ZE;
        f32x16 p;
#pragma unroll
        for (int r = 0; r < 16; ++r) p[r] = 0.f;
#pragma unroll
        for (int ks = 0; ks < 8; ++ks) { const bf16x8 a = *(const bf16x8*)(kp + 16 * ks); p = __builtin_amdgcn_mfma_f32_32x32x16_bf16(a, qr[ks], p, 0, 0, 0); }
        if (kb == qblk) {
#pragma unroll
            for (int r = 0; r < 16; ++r) p[r] = (kbase + 16 * hi + r <= tq) ? p[r] : 0.f; }
        u32x4 pa[2];
#pragma unroll
        for (int s = 0; s < 2; ++s) { pa[s].x = cvt_pk_bf16(p[8 * s], p[8 * s + 1]); pa[s].y = cvt_pk_bf16(p[8 * s + 2], p[8 * s + 3]); pa[s].z = cvt_pk_bf16(p[8 * s + 4], p[8 * s + 5]); pa[s].w = cvt_pk_bf16(p[8 * s + 6], p[8 * s + 7]); }
#pragma unroll
        for (int d = 0; d < 4; ++d)
#pragma unroll
            for (int s = 0; s < 2; ++s) { const bf16x8 vb = *(const bf16x8*)(VT + (size_t)(32 * d) * SEQ + kbase + 8 * s);
                o[d] = __builtin_amdgcn_mfma_f32_32x32x16_bf16(__builtin_bit_cast(bf16x8, pa[s]), vb, o[d], 0, 0, 0); }
    }
    float gg[4];
#pragma unroll
    for (int d = 0; d < 4; ++d) gg[d] = gng[h * 128 + 32 * d + l31];
#pragma unroll
    for (int r = 0; r < 16; ++r) {
        float sm = (o[0][r] + o[1][r]) + (o[2][r] + o[3][r]);
        sm += __shfl_xor(sm, 1); sm += __shfl_xor(sm, 2); sm += __shfl_xor(sm, 4); sm += __shfl_xor(sm, 8); sm += __shfl_xor(sm, 16);
        const float mu = sm * (1.f / 128.f); float q = 0.f;
#pragma unroll
        for (int d = 0; d < 4; ++d) { const float dd = o[d][r] - mu; q += dd * dd; }
        q += __shfl_xor(q, 1); q += __shfl_xor(q, 2); q += __shfl_xor(q, 4); q += __shfl_xor(q, 8); q += __shfl_xor(q, 16);
        const float rsd = rsqrtf(q * (1.f / 128.f) + 1e-5f);
        const int qrow = t0 + 32 * qblk + (r & 3) + 8 * (r >> 2) + 4 * hi; bf16_t* gp = Z + (rowb + qrow) * ZE + 1024 + h * 128 + l31;
#pragma unroll
        for (int d = 0; d < 4; ++d) { const float ga = bf2f(gp[32 * d]); const float ov = (o[d][r] - mu) * rsd * gg[d] * siluf_(ga); if (!DUMMY) gp[32 * d] = (bf16_t)f2bf(ov); else asm volatile("" :: "v"(ov)); }
    }
}
__device__ __forceinline__ bf16x8 ld8p(const bf16_t* p) { return *(const bf16x8*)p; }
namespace rw {
constexpr int S64 = 72, S128 = 136;
constexpr int O_AT = 0, O_RT = O_AT + 9216, O_E = O_RT + 9216, O_ET = O_E + 18432, O_AM = O_ET + 17408, O_X0 = O_AM + 18432, O_LF = O_X0 + 17408, O_MM = O_LF + 16640,
              O_NN = O_MM + 9216, O_PC = O_NN + 17408, O_GC = O_PC + 9216, O_SM = O_GC + 9216, O_END = O_SM + 4096;
static_assert(O_END <= 160 * 1024 - 1024, "rwkv stage X LDS map");
typedef __attribute__((address_space(3))) bf16_t lbf;
typedef __attribute__((address_space(3))) float lf32;
__device__ __forceinline__ bf16x8 ld8(const bf16_t* p) { return *(const bf16x8*)p; }
__device__ __forceinline__ bf16x8 ld8(const LAS bf16_t* p) { return *(const LAS bf16x8*)p; }
__device__ __forceinline__ bf16x8 ld8(const GAS bf16_t* p) { return *(const GAS bf16x8*)p; }
template <int MT, int NT, int KS, class PA, class PB, class Epi>
__device__ __forceinline__ void mm(PA A, int lda, PB B, int ldb, int wave, int lane, Epi epi) {
    const int fr = lane & 15, g = lane >> 4;
    static_assert((MT * NT) % 8 == 0, "mm: tile count must be a multiple of the 8 waves");
#pragma unroll
    for (int ti = 0; ti < MT * NT / 8; ++ti) { const int tile = wave + 8 * ti; const int mt = tile / NT, nt = tile % NT;
        f32x4 acc = {0.f, 0.f, 0.f, 0.f};
        PA ap = A + (mt * 16 + fr) * lda + 8 * g; PB bp = B + (nt * 16 + fr) * ldb + 8 * g;
#pragma unroll
        for (int ks = 0; ks < KS; ++ks) acc = __builtin_amdgcn_mfma_f32_16x16x32_bf16(ld8(ap + 32 * ks), ld8(bp + 32 * ks), acc, 0, 0, 0);
        epi(ti, mt * 16 + 4 * g, nt * 16 + fr, acc);
    }
}
__device__ __forceinline__ unsigned short bfs(float f) { return (unsigned short)f2bf(f); }
__device__ __forceinline__ void st4(LAS bf16_t* p, f32x4 v) { u32x2 w; w.x = cvt_pk_bf16(v[0], v[1]); w.y = cvt_pk_bf16(v[2], v[3]); *(LAS u32x2*)p = w; }
}

template <bool DUMMY>
__device__ __forceinline__ void rwkv_stage_x(Frame& F, int li, unsigned long long& xacc) {
    using namespace rw;
    unsigned long long xt0 = 0;
#define TSX(k) do { if (MK_XA == (k)) xt0 = __builtin_amdgcn_s_memrealtime(); if (MK_XB == (k)) xacc += __builtin_amdgcn_s_memrealtime() - xt0; } while (0)
    const int o = li >> 1;
    LAS unsigned char* L = F.lds;
    LAS bf16_t* At = (LAS bf16_t*)(L + O_AT); LAS bf16_t* Rt = (LAS bf16_t*)(L + O_RT); LAS bf16_t* E = (LAS bf16_t*)(L + O_E); LAS bf16_t* ET = (LAS bf16_t*)(L + O_ET); LAS bf16_t* AM = (LAS bf16_t*)(L + O_AM);
    LAS bf16_t* X0T = (LAS bf16_t*)(L + O_X0); LAS float* Lf = (LAS float*)(L + O_LF); LAS bf16_t* Mm = (LAS bf16_t*)(L + O_MM); LAS bf16_t* NN = (LAS bf16_t*)(L + O_NN); LAS float* CS = (LAS float*)(L + O_NN);
    LAS bf16_t* Pc = (LAS bf16_t*)(L + O_PC); LAS bf16_t* Gc = (LAS bf16_t*)(L + O_GC); LAS float* gamC = (LAS float*)(L + O_SM); LAS float* SEGT = gamC + 64; LAS float* PRM = gamC + 64 + 512;
    LAS bf16_t* Tm = At; LAS bf16_t* Qh = AM; LAS bf16_t* PT = AM + 64 * S64; LAS bf16_t* WT = Mm;
    GAS bf16_t* Z = (GAS bf16_t*)(F.ws + WS_Z); const GAS bf16_t* L1g = (const GAS bf16_t*)(F.ws + WS_L1); GAS bf16_t* VF = (GAS bf16_t*)(F.ws + WS_VF);
    const GAS bf16_t* W2T = (const GAS bf16_t*)(F.ws + WS_LORA2); const GAS bf16_t* A2T = W2T + 1024 * 64; const GAS bf16_t* V2T = A2T + 1024 * 64;
    GAS bf16_t* PG = (GAS bf16_t*)(F.H); GAS float* BON = (GAS float*)(F.ws + WS_BON);
    const float* w0p = F.in[12] + o * D; const float* a0p = F.in[15] + o * D; const float* v0p = F.in[18]; const float* kkp = F.in[21] + o * D; const float* kap = F.in[22] + o * D; const float* rkp = F.in[23] + o * D;
    f32x4 nlw[2], nla[2], nlv[2]; bf16x8 nr8, nk8, nv8, nvf8;
    bf16x8 fwa[4], fwb[2], faa[4], fab[2], fva[2], fvb;
    auto fetch_issue = [&](int u2, int c2, int tid2) {
        const int bh2 = u2 & 31, blk2 = u2 >> 5, b2 = bh2 >> 4, h2 = bh2 & 15; const size_t rows2 = (size_t)b2 * SEQ + (size_t)blk2 * 128 + 64 * c2;
        const int lane2 = tid2 & 63, fr2 = lane2 & 15, g2 = lane2 >> 4; int wave2 = F.wave; asm volatile("" : "+s"(wave2));
        const int nt2 = wave2 & 3;
#pragma unroll
        for (int ti = 0; ti < 2; ++ti) { const int mt2 = ((wave2 + 8 * ti) >> 2); const GAS bf16_t* ap = L1g + (rows2 + mt2 * 16 + fr2) * 256 + 8 * g2;
            fwa[ti * 2] = ld8(ap); fwa[ti * 2 + 1] = ld8(ap + 32); faa[ti * 2] = ld8(ap + 64); faa[ti * 2 + 1] = ld8(ap + 96); if (o) fva[ti] = ld8(ap + 128); }
        { const GAS bf16_t* bp = W2T + ((size_t)h2 * 64 + nt2 * 16 + fr2) * 64 + 8 * g2; fwb[0] = ld8(bp); fwb[1] = ld8(bp + 32); }
        { const GAS bf16_t* bp = A2T + ((size_t)h2 * 64 + nt2 * 16 + fr2) * 64 + 8 * g2; fab[0] = ld8(bp); fab[1] = ld8(bp + 32); }
        if (o) fvb = ld8(V2T + ((size_t)h2 * 64 + nt2 * 16 + fr2) * 32 + 8 * g2);
        const size_t prow2 = rows2 + (tid2 >> 3); const GAS bf16_t* zp2 = Z + prow2 * ZW + h2 * 64 + (tid2 & 7) * 8;
        nr8 = ld8(zp2); nk8 = ld8(zp2 + 1024); nv8 = ld8(zp2 + 2048); nvf8 = nv8; if (o) nvf8 = ld8(VF + prow2 * D + h2 * 64 + (tid2 & 7) * 8);
    };
    auto fetch_compute = [&]() {
#pragma unroll
        for (int ti = 0; ti < 2; ++ti) { const f32x4 z4 = {0.f, 0.f, 0.f, 0.f};
            nlw[ti] = __builtin_amdgcn_mfma_f32_16x16x32_bf16(fwa[ti * 2 + 1], fwb[1], __builtin_amdgcn_mfma_f32_16x16x32_bf16(fwa[ti * 2], fwb[0], z4, 0, 0, 0), 0, 0, 0);
            nla[ti] = __builtin_amdgcn_mfma_f32_16x16x32_bf16(faa[ti * 2 + 1], fab[1], __builtin_amdgcn_mfma_f32_16x16x32_bf16(faa[ti * 2], fab[0], z4, 0, 0, 0), 0, 0, 0);
            if (o) nlv[ti] = __builtin_amdgcn_mfma_f32_16x16x32_bf16(fva[ti], fvb, z4, 0, 0, 0); }
    };
    { int t0 = F.tid; asm volatile("" : "+v"(t0)); fetch_issue(F.vcu, 0, t0); fetch_compute(); }
#pragma unroll 1
    for (int u = F.vcu; u < 2048; u += F.G) {
        const int bh = u & 31, blk = u >> 5, b = bh >> 4, h = bh & 15; const size_t row0 = (size_t)b * SEQ + (size_t)blk * 128;
        int tid = F.tid; asm volatile("" : "+v"(tid));
        __syncthreads();
        if (tid < 384) { const int a_ = tid >> 6, ch = tid & 63; const float* src = a_ == 0 ? w0p : a_ == 1 ? a0p : a_ == 2 ? v0p : a_ == 3 ? kkp : a_ == 4 ? kap : rkp; PRM[tid] = src[h * 64 + ch]; }
        for (int e = tid; e < 64 * 64; e += 512) { const int i = e >> 6, j = e & 63; Pc[i * S64 + j] = (i == j) ? (bf16_t)0x3f80 : (bf16_t)0; Gc[i * S64 + j] = 0; }
#pragma unroll 1
        for (int c = 0; c < 2; ++c) {
            const size_t rows = row0 + 64 * c;
            asm volatile("" : "+v"(tid));
            const int lane = tid & 63; int wave = F.wave; asm volatile("" : "+s"(wave));
            const int pt = tid >> 3, pc0 = (tid & 7) * 8;
            __syncthreads();
            TSX(0);
            const size_t prow = rows + pt; GAS bf16_t* zp = Z + prow * ZW + h * 64 + pc0;
            const bf16x8 r8 = nr8, k8 = nk8, v8 = nv8, vf8 = nvf8;
            { const int fr_ = lane & 15, g_ = lane >> 4;
#pragma unroll
              for (int ti = 0; ti < 2; ++ti) { const int tile = wave + 8 * ti, r0 = (tile >> 2) * 16 + 4 * g_, col = (tile & 3) * 16 + fr_;
#pragma unroll
                  for (int j = 0; j < 4; ++j) { Lf[(r0 + j) * 65 + col] = nlw[ti][j]; Mm[(r0 + j) * S64 + col] = bfs(nla[ti][j]); if (o) AM[(64 + r0 + j) * S64 + col] = bfs(nlv[ti][j]); } } }
            const int nu = c == 0 ? u : u + F.G, nc = c == 0 ? 1 : 0; const bool has_n = nu < 2048;
            if (has_n) fetch_issue(nu, nc, tid);
            __syncthreads();
            TSX(1);
            float pr[8], pkk[8], pkm[8], pb[8], pv[8];
            {
                const size_t row = prow; const int cc = h * 64 + pc0;
                float ss = 0.f, bon = 0.f, dec[8];
#pragma unroll
                for (int j = 0; j < 8; ++j) {
                    const float r = bf2f((bf16_t)r8[j]), k = bf2f((bf16_t)k8[j]); float v = bf2f((bf16_t)v8[j]);
                    const float lw = Lf[pt * 65 + pc0 + j], la = bf2f(Mm[pt * S64 + pc0 + j]);
                    dec[j] = -0.6065306597126334f * sigmoidf_(PRM[pc0 + j] + lw);
                    const float a = sigmoidf_(PRM[64 + pc0 + j] + la);
                    if (o) { const float lv = bf2f(AM[(64 + pt) * S64 + pc0 + j]); const float vf = bf2f((bf16_t)vf8[j]); v = v + (vf - v) * sigmoidf_(PRM[128 + pc0 + j] + lv); v = bf2f((bf16_t)f2bf(v)); }
                    const float kr = k * PRM[192 + pc0 + j]; ss += kr * kr; pkk[j] = kr;
                    const float km = k * (1.f + (a - 1.f) * PRM[256 + pc0 + j]); pkm[j] = km; pb[j] = a; pr[j] = r; pv[j] = v; bon += r * km * PRM[320 + pc0 + j];
                }
                if (!DUMMY) { if (o) { u32x4 w; w.x = pk2(pv[0], pv[1]); w.y = pk2(pv[2], pv[3]); w.z = pk2(pv[4], pv[5]); w.w = pk2(pv[6], pv[7]); *(GAS u32x4*)(zp + 2048) = w; }
                else *(GAS bf16x8*)(VF + row * D + cc) = v8; }
                ss += __shfl_xor(ss, 1); ss += __shfl_xor(ss, 2); ss += __shfl_xor(ss, 4);
                bon += __shfl_xor(bon, 1); bon += __shfl_xor(bon, 2); bon += __shfl_xor(bon, 4);
                const float inv = 1.f / fmaxf(sqrtf(ss), 1e-12f);
#pragma unroll
                for (int j = 0; j < 8; ++j) { pkk[j] *= inv; pb[j] *= pkk[j]; }
                if (!DUMMY && (tid & 7) == 0) BON[row * 16 + h] = bon;
                __syncthreads();
#pragma unroll
                for (int j = 0; j < 8; ++j) CS[pt * 65 + pc0 + j] = dec[j];
            }
            __syncthreads();
            TSX(2);
            { const int ch = tid & 63, sg = tid >> 6; float run = 0.f;
#pragma unroll
              for (int q = 0; q < 8; ++q) { run += CS[(sg * 8 + q) * 65 + ch]; CS[(sg * 8 + q) * 65 + ch] = run; }
              SEGT[sg * 64 + ch] = run;
              __syncthreads();
              float pre = 0.f;
              for (int q = 0; q < sg; ++q) pre += SEGT[q * 64 + ch];
#pragma unroll
              for (int q = 0; q < 8; ++q) CS[(sg * 8 + q) * 65 + ch] += pre; }
            __syncthreads();
            TSX(3);
            {
                unsigned short at[8], bt[8], kt[8], rt[8], vt[8];
#pragma unroll
                for (int j = 0; j < 8; ++j) { const float g = CS[pt * 65 + pc0 + j], gp = pt ? CS[(pt - 1) * 65 + pc0 + j] : 0.f; const float eg = __expf(g), egp = __expf(gp), ieg = __builtin_amdgcn_rcpf(eg);
                    at[j] = bfs(egp * pkk[j]); bt[j] = bfs(pb[j] * ieg); kt[j] = bfs(pkm[j] * ieg); rt[j] = bfs(pr[j] * eg); vt[j] = bfs(pv[j]);
                    if (pt == 63) gamC[pc0 + j] = eg; }
#define RW_PK4(x) (u32x4){(unsigned)x[0] | ((unsigned)x[1] << 16), (unsigned)x[2] | ((unsigned)x[3] << 16), (unsigned)x[4] | ((unsigned)x[5] << 16), (unsigned)x[6] | ((unsigned)x[7] << 16)}
                *(LAS u32x4*)(At + pt * S64 + pc0) = RW_PK4(at); *(LAS u32x4*)(Rt + pt * S64 + pc0) = RW_PK4(rt); *(LAS u32x4*)(E + pt * S64 + pc0) = RW_PK4(bt); *(LAS u32x4*)(E + (64 + pt) * S64 + pc0) = RW_PK4(kt);
#undef RW_PK4
#pragma unroll
                for (int j = 0; j < 8; ++j) { AM[(pc0 + j) * S64 + pt] = at[j]; ET[(pc0 + j) * S128 + pt] = bt[j]; ET[(pc0 + j) * S128 + 64 + pt] = kt[j]; X0T[(pc0 + j) * S128 + 64 + pt] = vt[j]; }
            }
            __syncthreads();
            TSX(4);
            mm<4, 8, 2>(At, S64, E, S64, wave, lane, [&](int, int r0, int col, f32x4 a) {
                const int i = col & 63;
#pragma unroll
                for (int j = 0; j < 4; ++j) { const float v = (i < r0 + j) ? a[j] : 0.f; if (col < 64) Lf[(r0 + j) * 65 + i] = v; else Mm[(r0 + j) * S64 + i] = bfs(v); } });
            mm<4, 8, 2>(Rt, S64, E, S64, wave, lane, [&](int, int r0, int col, f32x4 a) {
                const int i = col & 63;
#pragma unroll
                for (int j = 0; j < 4; ++j) NN[(r0 + j) * S128 + col] = bfs((i <= r0 + j) ? a[j] : 0.f); });
            __syncthreads();
            TSX(5);
            mm<4, 4, 2>(Mm, S64, X0T + 64, S128, wave, lane, [&](int, int r0, int col, f32x4 a) { st4(AM + (64 + col) * S64 + r0, (f32x4){-a[0], -a[1], -a[2], -a[3]}); });
            for (int e = tid; e < 64 * 64; e += 512) { const int t = e >> 6, i = e & 63; const float lv = Lf[t * 65 + i]; const int tb = t >> 4, ib = i >> 4;
                E[t * S64 + i] = ((tb == 1 && ib == 0) || (tb == 3 && ib == 2)) ? bfs(lv) : (bf16_t)0;
                E[(64 + t) * S64 + i] = (t >= 32 && i < 32) ? bfs(lv) : (bf16_t)0;
                Tm[t * S64 + i] = 0; X0T[t * S128 + i] = 0; }
            __syncthreads();
            TSX(6);
            if (wave < 4 && lane < 16) { const int bb = wave * 16; float x[16];
#pragma unroll
                for (int r = 0; r < 16; ++r) { float s = (r == lane) ? 1.f : 0.f;
#pragma unroll
                    for (int i = 0; i < r; ++i) s -= Lf[(bb + r) * 65 + bb + i] * x[i];
                    x[r] = s; }
#pragma unroll
                for (int r = 0; r < 16; ++r) { const unsigned short xv = bfs(x[r]); Tm[(bb + r) * S64 + bb + lane] = xv; X0T[(bb + lane) * S128 + bb + r] = xv; } }
            __syncthreads();
            mm<4, 4, 2>(E, S64, X0T, S128, wave, lane, [&](int, int r0, int col, f32x4 a) { st4(Mm + col * S64 + r0, a); });
            __syncthreads();
            mm<4, 4, 2>(Tm, S64, Mm, S64, wave, lane, [&](int, int r0, int col, f32x4 a) {
                const int tb = r0 >> 4, jb = col >> 4; if ((tb == 1 && jb == 0) || (tb == 3 && jb == 2)) st4(X0T + col * S128 + r0, (f32x4){-a[0], -a[1], -a[2], -a[3]}); });
            __syncthreads();
            { const int p = tid >> 8, tt = (tid >> 4) & 15, jj = tid & 15, t = 16 * (2 * p + 1) + tt, j = 32 * p + jj; Tm[t * S64 + j] = X0T[j * S128 + t]; }
            __syncthreads();
            mm<4, 4, 2>(E + 64 * S64, S64, X0T, S128, wave, lane, [&](int, int r0, int col, f32x4 a) { st4(Mm + col * S64 + r0, a); });
            __syncthreads();
            mm<4, 4, 2>(Tm, S64, Mm, S64, wave, lane, [&](int, int r0, int col, f32x4 a) {
                if (r0 >= 32 && col < 32) {
#pragma unroll
                    for (int j = 0; j < 4; ++j) E[(r0 + j) * S64 + col] = bfs(-a[j]); } });
            __syncthreads();
            for (int e = tid; e < 32 * 32; e += 512) { const int t = 32 + (e >> 5), j = e & 31; Tm[t * S64 + j] = E[t * S64 + j]; }
            __syncthreads();
            TSX(7);
            mm<4, 8, 2>(Tm, S64, AM, S64, wave, lane, [&](int, int r0, int col, f32x4 a) { if (col < 64) st4(WT + col * S64 + r0, a); else st4(X0T + (col - 64) * S128 + r0, a); });
            __syncthreads();
            TSX(8);
            f32x4 gt[2], y0t[2];
            mm<4, 4, 2>(WT, S64, ET, S128, wave, lane, [&](int, int r0, int col, f32x4 a) { const float gc = gamC[col];
                f32x4 p;
#pragma unroll
                for (int j = 0; j < 4; ++j) p[j] = (((r0 + j) == col ? 1.f : 0.f) - a[j]) * gc;
                st4(PT + col * S64 + r0, p); });
            mm<4, 4, 4>(X0T, S128, ET, S128, wave, lane, [&](int ti, int, int col, f32x4 a) { const float gc = gamC[col]; gt[ti] = a * gc; });
            mm<4, 4, 4>(NN, S128, X0T, S128, wave, lane, [&](int ti, int, int, f32x4 a) { y0t[ti] = a; });
            mm<4, 4, 2>(NN, S128, WT, S64, wave, lane, [&](int, int r0, int col, f32x4 a) {
#pragma unroll
                for (int j = 0; j < 4; ++j) Qh[(r0 + j) * S64 + col] = bfs(bf2f(Rt[(r0 + j) * S64 + col]) - a[j]); });
            __syncthreads();
            TSX(9);
            GAS bf16_t* rslot = Z + row0 * ZW + h * 64; GAS bf16_t* kslot = rslot + 1024;
            mm<4, 4, 2>(Qh, S64, Pc, S64, wave, lane, [&](int, int r0, int col, f32x4 a) {
                const int kt_ = col >> 5, rho = col & 31, s = rho >> 4, jj = ((rho >> 3) & 1) * 4 + (rho & 3), hh = (rho >> 2) & 1;
#pragma unroll
                for (int j = 0; j < 4; ++j) { const int t = 64 * c + r0 + j, tt_ = t >> 5, ln = 32 * hh + (t & 31); const int e = ((((tt_ * 2 + kt_) * 2 + s) * 64 + ln) << 3) + jj;
                    if (!DUMMY) rslot[(size_t)(e >> 6) * ZW + (e & 63)] = bfs(a[j]); else asm volatile("" :: "v"(a[j])); } });
            mm<4, 4, 2>(Qh, S64, Gc, S64, wave, lane, [&](int ti, int r0, int col, f32x4 a) {
                const int vt_ = col >> 5, v31 = col & 31;
#pragma unroll
                for (int j = 0; j < 4; ++j) { const int t = 64 * c + r0 + j, tt_ = t >> 5, x = t & 31, hh = (x >> 2) & 1, r = (x & 3) + 4 * (x >> 3); const int e = (((tt_ * 2 + vt_) * 64 + 32 * hh + v31) << 4) + r;
                    if (!DUMMY) kslot[(size_t)(e >> 6) * ZW + (e & 63)] = bfs(a[j] + y0t[ti][j]); else asm volatile("" :: "v"(a[j] + y0t[ti][j])); } });
            f32x4 pn[2], gn[2];
            mm<4, 4, 2>(Pc, S64, PT, S64, wave, lane, [&](int ti, int, int, f32x4 a) { pn[ti] = a; });
            mm<4, 4, 2>(Gc, S64, PT, S64, wave, lane, [&](int ti, int, int, f32x4 a) { gn[ti] = a + gt[ti]; });
            if (has_n) fetch_compute();
            __syncthreads();
            { const int fr = lane & 15, g = lane >> 4;
#pragma unroll
              for (int ti = 0; ti < 2; ++ti) { const int tile = wave + 8 * ti, mt = tile >> 2, nt = tile & 3;
#pragma unroll
                  for (int j = 0; j < 4; ++j) { Pc[(mt * 16 + 4 * g + j) * S64 + nt * 16 + fr] = bfs(pn[ti][j]); Gc[(mt * 16 + 4 * g + j) * S64 + nt * 16 + fr] = bfs(gn[ti][j]); } } }
            TSX(10);
        }
        __syncthreads();
        if (!DUMMY) { GAS bf16_t* pg = PG + (size_t)u * 8192;
          { const int f = tid >> 6, ln = tid & 63, s = f & 1, kit = (f >> 1) & 1, kot = f >> 2, hh = ln >> 5, r31 = ln & 31; unsigned short w[8];
#pragma unroll
            for (int j = 0; j < 8; ++j) { const int rho = 16 * s + 8 * (j >> 2) + 4 * hh + (j & 3); w[j] = Pc[(32 * kit + rho) * S64 + 32 * kot + r31]; }
            *(GAS u32x4*)(pg + (size_t)tid * 8) = (u32x4){(unsigned)w[0] | ((unsigned)w[1] << 16), (unsigned)w[2] | ((unsigned)w[3] << 16), (unsigned)w[4] | ((unsigned)w[5] << 16), (unsigned)w[6] | ((unsigned)w[7] << 16)}; }
          { const int tile = tid >> 7, ln = (tid >> 1) & 63, half = tid & 1, kot = tile >> 1, vt_ = tile & 1, hh = ln >> 5, v31 = ln & 31; unsigned short w[8];
#pragma unroll
            for (int q = 0; q < 8; ++q) { const int r = 8 * half + q; const int ko = 32 * kot + (r & 3) + 8 * (r >> 2) + 4 * hh; w[q] = Gc[(32 * vt_ + v31) * S64 + ko]; }
            *(GAS u32x4*)(pg + 4096 + ((size_t)(tile * 64 + ln) << 4) + 8 * half) = (u32x4){(unsigned)w[0] | ((unsigned)w[1] << 16), (unsigned)w[2] | ((unsigned)w[3] << 16), (unsigned)w[4] | ((unsigned)w[5] << 16), (unsigned)w[6] | ((unsigned)w[7] << 16)}; } }
    }
    __syncthreads();
}

__device__ __forceinline__ void rwkv_stage_y(Frame& F) {
    if (F.vcu >= 32) return;
    const int lane = F.lane, wave = F.wave, bh = F.vcu, vt = wave >> 2; const bool st = ((wave & 3) == 0);
    const bf16_t* PG = (const bf16_t*)(F.H); u32x4* SB = (u32x4*)(F.ws + WS_SB);
    LAS bf16x8* pgbuf = (LAS bf16x8*)F.lds;
    f32x16 X0, X1;
#pragma unroll
    for (int r = 0; r < 16; ++r) { X0[r] = 0.f; X1[r] = 0.f; }
    bf16x8 Ra0, Ra1, Rb0, Rb1, Rc0, Rc1;
    auto issue = [&](bf16x8& r0, bf16x8& r1, int blk) { const bf16_t* pg = PG + (size_t)(blk * 32 + bh) * 8192;
        r0 = ld8p(pg + (((size_t)(wave * 2 + 0) * 64 + lane) << 3)); r1 = ld8p(pg + (((size_t)(wave * 2 + 1) * 64 + lane) << 3)); };
    auto step = [&](bf16x8& c0, bf16x8& c1, bf16x8& n0r, bf16x8& n1r, int blk) {
        const bf16x8 nga = n0r, ngb = n1r;
        issue(c0, c1, blk + 3 < 64 ? blk + 3 : 63);
        asm volatile("s_waitcnt lgkmcnt(0)" ::: "memory"); __builtin_amdgcn_s_barrier(); asm volatile("" ::: "memory");
        pgbuf[((blk + 1) & 1) * 1024 + (wave * 2 + 0) * 64 + lane] = nga; pgbuf[((blk + 1) & 1) * 1024 + (wave * 2 + 1) * 64 + lane] = ngb;
        if (st) {
            u32x4 xb[4];
#pragma unroll
            for (int s = 0; s < 2; ++s) {
                xb[s] = (u32x4){cvt_pk_bf16(X0[8 * s], X0[8 * s + 1]), cvt_pk_bf16(X0[8 * s + 2], X0[8 * s + 3]), cvt_pk_bf16(X0[8 * s + 4], X0[8 * s + 5]), cvt_pk_bf16(X0[8 * s + 6], X0[8 * s + 7])};
                xb[2 + s] = (u32x4){cvt_pk_bf16(X1[8 * s], X1[8 * s + 1]), cvt_pk_bf16(X1[8 * s + 2], X1[8 * s + 3]), cvt_pk_bf16(X1[8 * s + 4], X1[8 * s + 5]), cvt_pk_bf16(X1[8 * s + 6], X1[8 * s + 7])}; }
            u32x4* sb = SB + ((size_t)(blk * 32 + bh) * 8 + vt * 4) * 64 + lane;
#pragma unroll
            for (int q = 0; q < 4; ++q) sb[q * 64] = xb[q];
            const LAS bf16x8* pb = pgbuf + (blk & 1) * 1024;
            f32x16 n0, n1;
            { const bf16x8 c0a = pb[512 + ((0 * 2 + vt) * 64 + lane) * 2], c0b = pb[512 + ((0 * 2 + vt) * 64 + lane) * 2 + 1], c1a = pb[512 + ((1 * 2 + vt) * 64 + lane) * 2], c1b = pb[512 + ((1 * 2 + vt) * 64 + lane) * 2 + 1];
#pragma unroll
              for (int r = 0; r < 8; ++r) { n0[r] = bf2f((bf16_t)c0a[r]); n0[8 + r] = bf2f((bf16_t)c0b[r]); n1[r] = bf2f((bf16_t)c1a[r]); n1[8 + r] = bf2f((bf16_t)c1b[r]); } }
#pragma unroll
            for (int q = 0; q < 4; ++q) {
                n0 = __builtin_amdgcn_mfma_f32_32x32x16_bf16(pb[q * 64 + lane], __builtin_bit_cast(bf16x8, xb[q]), n0, 0, 0, 0);
                n1 = __builtin_amdgcn_mfma_f32_32x32x16_bf16(pb[(4 + q) * 64 + lane], __builtin_bit_cast(bf16x8, xb[q]), n1, 0, 0, 0); }
            X0 = n0; X1 = n1;
        }
    };
    issue(Ra0, Ra1, 0); issue(Rb0, Rb1, 1); issue(Rc0, Rc1, 2);
    pgbuf[(wave * 2 + 0) * 64 + lane] = Ra0; pgbuf[(wave * 2 + 1) * 64 + lane] = Ra1;
#pragma unroll 1
    for (int blk = 0; blk < 63; blk += 3) { step(Ra0, Ra1, Rb0, Rb1, blk); step(Rb0, Rb1, Rc0, Rc1, blk + 1); step(Rc0, Rc1, Ra0, Ra1, blk + 2); }
    step(Ra0, Ra1, Rb0, Rb1, 63);
    __syncthreads();
}

template <bool DUMMY>
__device__ __forceinline__ void rwkv_stage_z(Frame& F, int li) {
    const int o = li >> 1;
    bf16_t* Z = (bf16_t*)(F.ws + WS_Z); const float* BON = (const float*)(F.ws + WS_BON); const u32x4* SB = (const u32x4*)(F.ws + WS_SB);
    const float* lgp = F.in[24] + o * D; const float* lbp = F.in[25] + o * D;
    LAS float* tile = (LAS float*)(F.lds + F.wave * 9216);
    int lane_ = F.lane;
#pragma unroll 1
    for (int w = F.vcu * 8 + F.wave; w < 8192; w += F.G * 8) {
        asm volatile("" : "+v"(lane_)); const int lane = lane_, v31 = lane & 31, hh = lane >> 5, tl = lane >> 1, hf = lane & 1;
        const int u = w >> 2, tt = w & 3, bh = u & 31, blk = u >> 5, b = bh >> 4, h = bh & 15; const size_t row0 = (size_t)b * SEQ + (size_t)blk * 128;
        const bf16_t* rslot = Z + row0 * ZW + h * 64; const bf16_t* kslot = rslot + 1024;
        const size_t row = row0 + 32 * tt + tl; bf16_t* zp = Z + row * ZW + h * 64 + 32 * hf;
        bf16x8 vv[4], gg[4];
#pragma unroll
        for (int q = 0; q < 4; ++q) { vv[q] = ld8p(zp + 2048 + 8 * q); gg[q] = ld8p(zp + 3072 + 8 * q); }
        const float bon = BON[row * 16 + h];
        bf16x8 qf[4]; u32x4 xb[2][4];
#pragma unroll
        for (int q = 0; q < 4; ++q) { const int e = (((tt * 4 + q) * 64 + lane) << 3); qf[q] = ld8p(rslot + (size_t)(e >> 6) * ZW + (e & 63)); }
#pragma unroll
        for (int vt = 0; vt < 2; ++vt)
#pragma unroll
            for (int q = 0; q < 4; ++q) xb[vt][q] = SB[((size_t)u * 8 + vt * 4 + q) * 64 + lane];
#pragma unroll
        for (int vt = 0; vt < 2; ++vt) { const int e0 = ((tt * 2 + vt) * 64 + lane) << 4; const bf16_t* yp = kslot + (size_t)(e0 >> 6) * ZW + (e0 & 63); const bf16x8 ya = ld8p(yp), yb = ld8p(yp + 8);
            f32x16 acc;
#pragma unroll
            for (int r = 0; r < 8; ++r) { acc[r] = bf2f((bf16_t)ya[r]); acc[8 + r] = bf2f((bf16_t)yb[r]); }
#pragma unroll
            for (int q = 0; q < 4; ++q) acc = __builtin_amdgcn_mfma_f32_32x32x16_bf16(qf[q], __builtin_bit_cast(bf16x8, xb[vt][q]), acc, 0, 0, 0);
#pragma unroll
            for (int r = 0; r < 16; ++r) tile[((r & 3) + 8 * (r >> 2) + 4 * hh) * 72 + 36 * vt + v31] = acc[r]; }
        LDS_WAIT(); asm volatile("" ::: "memory");
        float y[32]; float sm = 0.f;
#pragma unroll
        for (int q = 0; q < 8; ++q) { const f32x4 t4 = *(const LAS f32x4*)(tile + tl * 72 + 36 * hf + 4 * q); y[4 * q] = t4[0]; y[4 * q + 1] = t4[1]; y[4 * q + 2] = t4[2]; y[4 * q + 3] = t4[3]; sm += (t4[0] + t4[1]) + (t4[2] + t4[3]); }
        sm += __shfl_xor(sm, 1);
        const float mu = sm * (1.f / 64.f); float qq = 0.f;
#pragma unroll
        for (int j = 0; j < 32; ++j) { y[j] -= mu; qq += y[j] * y[j]; }
        qq += __shfl_xor(qq, 1);
        const float rsd = rsqrtf(qq * (1.f / 64.f) + 64e-5f);
        const float* lg = lgp + h * 64 + 32 * hf; const float* lb = lbp + h * 64 + 32 * hf;
#pragma unroll
        for (int q = 0; q < 4; ++q) { float ov[8];
#pragma unroll
            for (int j = 0; j < 8; ++j) { const int c = 8 * q + j; const float va = bf2f((bf16_t)vv[q][j]), ga = bf2f((bf16_t)gg[q][j]); ov[j] = (y[c] * rsd * lg[c] + lb[c] + bon * va) * siluf_(ga); }
            const u32x4 wv = {cvt_pk_bf16(ov[0], ov[1]), cvt_pk_bf16(ov[2], ov[3]), cvt_pk_bf16(ov[4], ov[5]), cvt_pk_bf16(ov[6], ov[7])};
            if (!DUMMY) *(u32x4*)(zp + 3072 + 8 * q) = wv; else asm volatile("" :: "v"(wv)); }
        LDS_WAIT(); asm volatile("" ::: "memory");
    }
}

enum { PH_P0 = 0, PH_FINAL = 27, N_PHASES = 28 };
#define IN(k) (lo <= (k) && (k) < hi)
#define TSG(k) do { if (LI == 0) { if (MK_GA == (k)) tA = __builtin_amdgcn_s_memrealtime(); if (MK_GB == (k)) tB = __builtin_amdgcn_s_memrealtime(); } } while (0)
#define TS(k) do { if (MK_TPA == (k)) tA = __builtin_amdgcn_s_memrealtime(); if (MK_TPB == (k)) tB = __builtin_amdgcn_s_memrealtime(); } while (0)
#if MK_MULTI
#define SEAM(k) do { } while (0)
#else
#define SEAM(k) do { if (IN(k) && IN((k) + 1)) xcd_barrier(bar); } while (0)
#endif
template <int LI>
__device__ __forceinline__ void run_layer(Frame& F, const XcdBarrier& bar, const int lo, const int hi, const int bx, unsigned long long& tA, unsigned long long& tB) {
    constexpr bool even = (LI & 1) == 0;
    constexpr int base = 1 + (LI / 2) * 13 + (even ? 0 : 6);
    bf16_t* Zp = (bf16_t*)(F.ws + WS_Z);
    if constexpr (even) {
        TS(base); if (IN(base)) { F.retid(); pg8::StaticOrder S; S.init(64, 16, F.G, bx);
            pg8::Gemm g{(const bf16_t*)(F.ws + WS_HB), (const bf16_t*)(F.ws + WS_WIN)};
            EpiEvenIn E{Zp, F.ssq(LI), (bf16_t*)(F.ws + WS_VTA), (bf16_t*)(F.ws + WS_VTB), (bf16_t*)(F.ws + WS_KT)};
            if (MK_PROBE == 1) pg8::gemm_phase<EpiEvenIn, true, D, D, 1 << 20, 0, 0>(F.lds, F.tid, g, S, E);
            pg8::gemm_phase<EpiEvenIn, true, D, D, 1 << 20, 0, 0>(F.lds, F.tid, g, S, E); }
        SEAM(base);
        TS(base + 1); if (IN(base + 1)) { F.retid();
            TSG(0); conv_wrest(F, LI); TSG(1);
            if constexpr (LI < 3) conv_win_odd(F, LI + 1);
            TSG(2);
            if (MK_PROBE == 5) { for (int u = F.vcu * 8 + F.wave; u < 4096; u += F.G * 8) ret_stage_a(F, u);
                for (int u = F.vcu * 8 + F.wave; u < 2048; u += F.G * 8) sb_unit<true>(F, u >> 8, u & 255); }
            for (int u = F.vcu * 8 + F.wave; u < 4096; u += F.G * 8) ret_stage_a(F, u);
            __syncthreads(); TSG(3);
            for (int u = F.vcu * 8 + F.wave; u < 2048; u += F.G * 8) sb_unit<false>(F, u >> 8, u & 255);
            __syncthreads(); TSG(4); }
        SEAM(base + 1);
        TS(base + 2); if (IN(base + 2)) { F.retid(); ret_stage_b(F); }
        SEAM(base + 2);
        TS(base + 3); if (IN(base + 3)) { F.retid(); const float* gng = F.in[8] + (LI >> 1) * 512;
            if (MK_PROBE == 6) for (int u = F.vcu * 8 + F.wave; u < 2048; u += F.G * 8) ret_stage_c<true>(F, u, gng);
            for (int u = F.vcu * 8 + F.wave; u < 2048; u += F.G * 8) ret_stage_c<false>(F, u, gng); }
        SEAM(base + 3);
        TS(base + 4); if (IN(base + 4)) { F.retid(); pg8::StaticOrder S; S.init(64, 4, F.G, bx);
            { pg8::Gemm g{(const bf16_t*)(F.ws + WS_PB), (const bf16_t*)(F.ws + WS_WPROJ)};
              EpiStore E{Zp, ZE}; pg8::gemm_phase<EpiStore, false, PLE, PLE, 1 << 20, 0, 0>(F.lds, F.tid, g, S, E); }
            { pg8::Gemm g{Zp + 1024, (const bf16_t*)(F.ws + WS_WOUT)};
              EpiResid E{(const bf16_t*)(F.ws + WS_HB), Zp + 1536, ZE}; pg8::gemm_phase<EpiResid, false, ZE, D, 8, (long)((2560 - 1024) * 2), 0>(F.lds, F.tid, g, S, E); } }
        SEAM(base + 4);
        TS(base + 5); if (IN(base + 5)) { F.retid(); pg8::StaticOrder S; S.init(64, 4, F.G, bx);
            pg8::Gemm g{Zp + 1536, (const bf16_t*)(F.ws + WS_WGATE)};
            EpiGate E{Zp + 1536, ZE, Zp, ZE, (bf16_t*)(F.ws + WS_HB), F.ssq(LI + 1)};
            pg8::gemm_phase<EpiGate, false, ZE, D, 1 << 20, 0, 0>(F.lds, F.tid, g, S, E); }
        SEAM(base + 5);
    } else {
        TS(base); if (IN(base)) { F.retid(); conv_lora2(F, LI); rows_norm(F, LI); }
        SEAM(base);
        TS(base + 1); if (IN(base + 1)) { F.retid(); pg8::StaticOrder S; S.init(64, 17, F.G, bx);
            pg8::Gemm g{(const bf16_t*)(F.H) + D, (const bf16_t*)(F.ws + WS_WIN)};
            EpiOddIn E{Zp, (bf16_t*)(F.ws + WS_L1)};
            if (MK_PROBE == 2) pg8::gemm_phase<EpiOddIn, true, D, 2048, 16, -(long)(D * 2), (long)(D * 2)>(F.lds, F.tid, g, S, E);
            pg8::gemm_phase<EpiOddIn, true, D, 2048, 16, -(long)(D * 2), (long)(D * 2)>(F.lds, F.tid, g, S, E); }
        SEAM(base + 1);
        TS(base + 2); if (IN(base + 2)) { F.retid();
            conv_wrest(F, LI);
            __syncthreads();
            { unsigned long long xa = 0; rwkv_stage_x<false>(F, LI, xa); if (LI == 1 && MK_XA >= 0) { tA = 0; tB = xa; } } }
        SEAM(base + 2);
        TS(base + 3); if (IN(base + 3)) { F.retid();
            rwkv_stage_y(F); }
        SEAM(base + 3);
        TS(base + 4); if (IN(base + 4)) { F.retid(); rwkv_stage_z<false>(F, LI); }
        SEAM(base + 4);
        TS(base + 5); if (IN(base + 5)) { F.retid(); pg8::StaticOrder S; S.init(64, 4, F.G, bx);
            if constexpr (LI < 3) { conv_win_even(F, LI + 1); __syncthreads(); }
            { pg8::Gemm g{(const bf16_t*)(F.ws + WS_PB), (const bf16_t*)(F.ws + WS_WPROJ)};
              EpiStore E{Zp, ZW}; pg8::gemm_phase<EpiStore, false, PLE, PLE, 1 << 20, 0, 0>(F.lds, F.tid, g, S, E); }
            { pg8::Gemm g{Zp + 3072, (const bf16_t*)(F.ws + WS_WOUT)};
              EpiResid E{(const bf16_t*)(F.ws + WS_HB), Zp + 2048, ZW}; pg8::gemm_phase<EpiResid, false, ZW, D, 1 << 20, 0, 0>(F.lds, F.tid, g, S, E); } }
        SEAM(base + 5);
        TS(base + 6); if (IN(base + 6)) { F.retid(); pg8::StaticOrder S; S.init(64, 4, F.G, bx);
            pg8::Gemm g{Zp + 2048, (const bf16_t*)(F.ws + WS_WGATE)};
            EpiGate E{Zp + 2048, ZW, Zp, ZW, (bf16_t*)(F.ws + WS_HB), F.ssq(LI + 1)};
            pg8::gemm_phase<EpiGate, false, ZW, D, 1 << 20, 0, 0>(F.lds, F.tid, g, S, E); }
        SEAM(base + 6);
    }
}
__global__ void __launch_bounds__(512, 2) mk_fwd(Args args) {
    extern __shared__ __attribute__((aligned(16))) unsigned char lds_raw[];
    Frame F;
    F.lds = (LAS unsigned char*)lds_raw; F.ldsg = lds_raw;
    F.tid = threadIdx.x; F.lane = F.tid & 63; F.wave = __builtin_amdgcn_readfirstlane(F.tid >> 6);
    F.G = gridDim.x; const int bx = blockIdx.x; F.vcu = (F.G % 8 == 0) ? (bx % 8) * (F.G / 8) + bx / 8 : bx;
    F.H = args.out; F.ws = args.ws;
    volatile LAS unsigned* MISC = (volatile LAS unsigned*)(F.lds + MISC_OFF);
    for (int u = F.tid; u < 128; u += 512) ((LAS unsigned*)(F.lds + MISC_OFF))[u] = 0u;
    __syncthreads();
    XcdBarrier bar; bar.bar = (unsigned*)(F.ws + WS_CTL) + 4096; bar.x = 0; bar.st = nullptr;
#if !MK_MULTI
    bar = xcd_barrier_post((unsigned*)(F.ws + WS_CTL) + 4096, MISC + 8);
#endif
    const int lo = args.ph_lo, hi = args.ph_hi;
    if (IN(PH_P0)) { F.retid(); rows_p0(F); conv_win_even(F, 0); }
#if !MK_MULTI
    if (IN(0) && IN(1)) { VM_WAIT(); cg::this_grid().sync(); }
#endif
    unsigned long long tA = 0, tB = 0;
    TS(0);
    run_layer<0>(F, bar, lo, hi, bx, tA, tB);
    run_layer<1>(F, bar, lo, hi, bx, tA, tB);
    run_layer<2>(F, bar, lo, hi, bx, tA, tB);
    run_layer<3>(F, bar, lo, hi, bx, tA, tB);
    TS(PH_FINAL);
    if (IN(PH_FINAL)) { F.retid(); rows_final(F); }
    TS(PH_FINAL + 1);
    if ((MK_TPA >= 0 || MK_XA >= 0 || MK_GA >= 0) && blockIdx.x == 0 && threadIdx.x == 0) { const unsigned long long t0 = __builtin_amdgcn_s_memrealtime(), span = 4ull * (tB - tA); while (__builtin_amdgcn_s_memrealtime() - t0 < span) __builtin_amdgcn_s_sleep(8); }
}

extern "C" void kernel_launch(void* const* d_in, const int* in_sizes, int n_in, void* d_out, int out_size, void* d_ws, size_t ws_size, hipStream_t stream) {
    static int grid = 0;
    if (grid == 0) {
        int dev = 0, cus = 0, per_cu = 0;
        (void)hipGetDevice(&dev); (void)hipDeviceGetAttribute(&cus, hipDeviceAttributeMultiprocessorCount, dev);
        (void)hipFuncSetAttribute((const void*)mk_fwd, hipFuncAttributeMaxDynamicSharedMemorySize, LDS_BYTES);
        (void)hipOccupancyMaxActiveBlocksPerMultiprocessor(&per_cu, (const void*)mk_fwd, 512, LDS_BYTES);
        if (per_cu < 1) per_cu = 1;
        grid = cus * 1;
        if (n_in != 26 || ws_size < WS_END) fprintf(stderr, "kernel_launch: unexpected n_in %d / ws %zu\n", n_in, ws_size);
        (void)hipGetLastError();
    }
    (void)hipMemsetAsync((char*)d_ws + WS_CTL, 0, CTL_BYTES, stream);
    Args a{};
    for (int i = 0; i < 26; ++i) a.in[i] = (const float*)d_in[i];
    a.out = (float*)d_out; a.ws = (unsigned char*)d_ws;
#if MK_MULTI
    for (int ph = 0; ph < N_PHASES; ++ph) { a.ph_lo = ph; a.ph_hi = ph + 1; hipLaunchKernelGGL(mk_fwd, dim3(grid), dim3(512), LDS_BYTES, stream, a); }
#else
    a.ph_lo = 0; a.ph_hi = N_PHASES;
    void* kargs[] = {&a};
    hipError_t e = hipLaunchCooperativeKernel((const void*)mk_fwd, dim3(grid), dim3(512), kargs, LDS_BYTES, stream);
    if (e != hipSuccess) fprintf(stderr, "cooperative launch failed: %s (grid %d)\n", hipGetErrorString(e), grid);
#endif
}
```

```cpp
#include <hip/hip_runtime.h>
#include <hip/hip_cooperative_groups.h>
#include <cstdint>
#include <cstdio>
namespace cg = cooperative_groups;

#ifndef MK_PROBE
#define MK_PROBE 0
#endif
#ifndef MK_TPA
#define MK_TPA -1
#define MK_TPB -1
#endif
#ifndef MK_XA
#define MK_XA -1
#define MK_XB -1
#endif
#ifndef MK_GA
#define MK_GA -1
#define MK_GB -1
#endif
#ifndef MK_MULTI
#define MK_MULTI 0
#endif

#define LAS __attribute__((address_space(3)))
#define GAS __attribute__((address_space(1)))
typedef unsigned short bf16_t;
typedef short bf16x8 __attribute__((ext_vector_type(8)));
typedef float f32x4 __attribute__((ext_vector_type(4)));
typedef float f32x2 __attribute__((ext_vector_type(2)));
typedef unsigned u32x4 __attribute__((ext_vector_type(4)));
typedef unsigned u32x2 __attribute__((ext_vector_type(2)));

constexpr int D = 1024, BATCH = 2, SEQ = 8192, T = BATCH * SEQ, PLE = 256, ZW = 4096, ZE = 3072;
constexpr float QK_SCALE = 0.08838834764831845f;

__device__ __forceinline__ float bf2f(bf16_t v) { return __uint_as_float(((unsigned)v) << 16); }
__device__ __forceinline__ unsigned f2bf(float f) { unsigned u = __float_as_uint(f); return (u + 0x7fffu + ((u >> 16) & 1u)) >> 16; }
__device__ __forceinline__ unsigned pk2(float lo, float hi) { return f2bf(lo) | (f2bf(hi) << 16); }
typedef __bf16 bf16x2_t __attribute__((ext_vector_type(2)));
__device__ __forceinline__ unsigned cvt_pk_bf16(float lo, float hi) { f32x2 v = {lo, hi}; bf16x2_t b = __builtin_convertvector(v, bf16x2_t); return __builtin_bit_cast(unsigned, b); }
__device__ __forceinline__ float wave_sum(float v) {
#pragma unroll
    for (int o = 1; o < 64; o <<= 1) v += __shfl_xor(v, o);
    return v;
}
__device__ __forceinline__ float sigmoidf_(float x) { return __builtin_amdgcn_rcpf(1.f + __expf(-x)); }
__device__ __forceinline__ float siluf_(float x) { return x * __builtin_amdgcn_rcpf(1.f + __expf(-x)); }
__device__ __forceinline__ float softplusf_(float x) { return x > 20.f ? x : log1pf(expf(x)); }
__device__ __forceinline__ float logsigf_(float x) { return -(x < -20.f ? -x : log1pf(expf(-x))); }
__device__ __forceinline__ float ssq_sum(const float* sq, int row) { const f32x4* p = (const f32x4*)(sq + (size_t)row * 16); const f32x4 a = p[0], b = p[1], c = p[2], d = p[3];
    return (((a[0] + a[1]) + (a[2] + a[3])) + ((b[0] + b[1]) + (b[2] + b[3]))) + (((c[0] + c[1]) + (c[2] + c[3])) + ((d[0] + d[1]) + (d[2] + d[3]))); }
#define LDS_WAIT() asm volatile("s_waitcnt lgkmcnt(0)" ::: "memory")
#define VM_WAIT() asm volatile("s_waitcnt vmcnt(0)" ::: "memory")

namespace pg8 {
constexpr int BM = 256, BK = 64, HALF = 128, HTB = HALF * BK * 2, STAGE_BYTES = 8 * HTB, NXCD = 8, WGM = 8;
__host__ __device__ __forceinline__ int lds_byte(int r, int c) { const int st = (r >> 4) * 2 + (c >> 5), rr = r & 15, cc = c & 31, ob = rr * 64 + cc * 2; return st * 1024 + (ob ^ (((ob >> 9) & 1) << 5)); }
__host__ __device__ __forceinline__ void stage_rc(int b, int& R, int& C) { const int st = b / 1024, sb = b % 1024, swz = sb ^ (((sb >> 9) & 1) << 5); R = (st >> 1) * 16 + swz / 64; C = (st & 1) * 32 + (swz % 64) / 2; }
__host__ __device__ __forceinline__ int perm32(int rho) { const int n = rho >> 4, i = rho & 15; return 8 * (i >> 2) + 4 * n + (i & 3); }
struct Unit { int pm, pn; };
struct Gemm { const bf16_t* A; const bf16_t* Bt; };
struct StaticOrder {
    int nM, nN, nwg, G, c;
    __device__ void init(int nM_, int nN_, int G_, int c_) { nM = nM_; nN = nN_; nwg = nM * nN; G = G_; c = c_; }
    __device__ bool next(int i, Unit& u) const {
        const long L = (long)i * G + c; if (L >= nwg) return false;
        int wgid = (int)L; { const int q = nwg / NXCD, r = nwg % NXCD, xcd = wgid % NXCD, off = wgid / NXCD; wgid = (xcd < r ? xcd * (q + 1) : r * (q + 1) + (xcd - r) * q) + off; }
        const int nig = WGM * nN, gid = wgid / nig, fm = gid * WGM, gsz = (nM - fm) < WGM ? (nM - fm) : WGM;
        u.pm = fm + ((wgid % nig) % gsz); u.pn = (wgid % nig) / gsz; return true;
    }
};
template <class Epi, bool ALIGN_EPI, int LDA, int KK, int TSPLIT, long ASHIFT, long BROW>
__device__ __forceinline__ void gemm_phase(LAS unsigned char* lds, const int tid_in, const Gemm g, const StaticOrder& S, const Epi& E) {
    int tid = tid_in; asm volatile("" : "+v"(tid));
    const int wid = __builtin_amdgcn_readfirstlane(tid >> 6), lane = tid & 63, wr = wid >> 2, wc = wid & 3, fr = lane & 15, fq = lane >> 4;
    constexpr int K = KK, nt = K / BK, lda = LDA, tsplit = TSPLIT; constexpr long ashift = ASHIFT;
    unsigned voffA[2], voffB[2];
#pragma unroll
    for (int i = 0; i < 2; ++i) { int R, C; stage_rc(tid * 16 + i * 8192, R, C); const int Rb = (R & ~31) + perm32(R & 31);
        voffA[i] = (unsigned)(R * lda + C) * 2u; voffB[i] = (unsigned)(Rb * K + C) * 2u; }
    constexpr size_t kstep = (size_t)(BK * 2);
    constexpr size_t hstepA = (size_t)HALF * lda * 2, hstepB = (size_t)HALF * K * 2, tstepA = 2 * hstepA, tstepB = 2 * hstepB;
    const unsigned ldsw = (unsigned)wid * 1024u;
    const int aoff = lds_byte(wr * 64 + fr, fq * 8), boff = lds_byte(wc * 32 + fr, fq * 8);
#define PG8_AP(base, tt) ((base) + (((tt) < tsplit) ? (long)(tt) * 128 : ashift + (long)((tt) - tsplit) * 128))
#define PG8_ABASE(u) ((const char*)g.A + (size_t)(u).pm * tstepA + ((BROW != 0 && (u).pm >= 32) ? BROW : 0))
#define PG8_SA(b, h) (((b) * 2 + (h)) * HTB)
#define PG8_SB(b, h) ((4 + (b) * 2 + (h)) * HTB)
#define PG8_STAGE(bufoff, gbase, voff) do { const char* _gb = (const char*)(gbase); asm volatile("" : "+s"(_gb)); _Pragma("unroll") for (int _i = 0; _i < 2; ++_i) \
        __builtin_amdgcn_global_load_lds((const unsigned*)(_gb + (voff)[_i]), (LAS unsigned*)(lds + (bufoff) + ldsw + _i * 8192), 16, 0, 0); } while (0)
#define PG8_LDA(dst, b, h) do { _Pragma("unroll") for (int m = 0; m < 4; ++m) _Pragma("unroll") for (int k = 0; k < 2; ++k) dst[m][k] = *(const LAS bf16x8*)(lds + PG8_SA(b, h) + aoff + m * 2048 + k * 1024); } while (0)
#define PG8_LDB(dst, b, h) do { _Pragma("unroll") for (int n = 0; n < 2; ++n) _Pragma("unroll") for (int k = 0; k < 2; ++k) dst[n][k] = *(const LAS bf16x8*)(lds + PG8_SB(b, h) + boff + n * 2048 + k * 1024); } while (0)
#define PG8_MMA(ai, bj, At, Bt) do { __builtin_amdgcn_s_setprio(1); _Pragma("unroll") for (int m = 0; m < 4; ++m) _Pragma("unroll") for (int n = 0; n < 2; ++n) _Pragma("unroll") for (int k = 0; k < 2; ++k) \
        acc[ai][bj][m][n] = __builtin_amdgcn_mfma_f32_16x16x32_bf16(Bt[n][k], At[m][k], acc[ai][bj][m][n], 0, 0, 0); __builtin_amdgcn_s_setprio(0); } while (0)
#define PG8_WAIT_V(n) asm volatile("s_waitcnt vmcnt(" #n ")" ::: "memory")
#define PG8_WAIT_L(n) asm volatile("s_waitcnt lgkmcnt(" #n ")" ::: "memory")
#define PG8_BAR __builtin_amdgcn_s_barrier()
#define PG8_SCHED __builtin_amdgcn_sched_barrier(0)
    Unit cur, nxt; int ui = 0;
    if (!S.next(0, cur)) return;
    f32x4 acc[2][2][4][2];
#pragma unroll
    for (int a = 0; a < 2; ++a)
#pragma unroll
        for (int b = 0; b < 2; ++b)
#pragma unroll
            for (int m = 0; m < 4; ++m)
#pragma unroll
                for (int n = 0; n < 2; ++n) acc[a][b][m][n] = (f32x4){0.f, 0.f, 0.f, 0.f};
    bf16x8 At[4][2], B0[2][2], B1[2][2];
    const char* cA = PG8_ABASE(cur); const char* cB = (const char*)g.Bt + (size_t)cur.pn * tstepB;
    {
        const char* a0 = PG8_AP(cA, 0); const char* a1 = PG8_AP(cA, 1);
        PG8_STAGE(PG8_SB(0, 0), cB, voffB); PG8_STAGE(PG8_SB(0, 1), cB + hstepB, voffB); PG8_STAGE(PG8_SA(0, 0), a0, voffA); PG8_STAGE(PG8_SA(0, 1), a0 + hstepA, voffA);
        if (wr == 1) PG8_BAR;
        PG8_WAIT_V(2); PG8_BAR;
        PG8_STAGE(PG8_SB(1, 0), cB + kstep, voffB); PG8_STAGE(PG8_SA(1, 0), a1, voffA); PG8_STAGE(PG8_SB(1, 1), cB + hstepB + kstep, voffB);
        PG8_WAIT_V(6); PG8_BAR;
    }
    for (;;) {
        const bool has_next = S.next(ui + 1, nxt);
        const char* nA = has_next ? PG8_ABASE(nxt) : cA; const char* nB = has_next ? (const char*)g.Bt + (size_t)nxt.pn * tstepB : cB;
        for (int t = 0; t < nt; t += 2) {
            const bool last = (t == nt - 2);
            const char* a1 = PG8_AP(cA, t + 1);
            const char* a2 = last ? PG8_AP(nA, 0) : PG8_AP(cA, t + 2); const char* b2 = last ? nB : cB + (size_t)(t + 2) * kstep;
            const char* a3 = last ? PG8_AP(nA, 1) : PG8_AP(cA, t + 3); const char* b3 = b2 + kstep;
            PG8_LDB(B0, 0, 0); PG8_LDB(B1, 0, 1); PG8_SCHED; PG8_LDA(At, 0, 0); PG8_STAGE(PG8_SA(1, 1), a1 + hstepA, voffA);
            PG8_WAIT_V(8); PG8_WAIT_L(0); PG8_BAR; PG8_MMA(0, 0, At, B0); PG8_MMA(0, 1, At, B1); PG8_BAR; PG8_SCHED;
            PG8_LDA(At, 0, 1); PG8_STAGE(PG8_SB(0, 0), b2, voffB); PG8_STAGE(PG8_SB(0, 1), b2 + hstepB, voffB); PG8_STAGE(PG8_SA(0, 0), a2, voffA);
            PG8_WAIT_V(8); PG8_WAIT_L(0); PG8_BAR; PG8_MMA(1, 0, At, B0); PG8_MMA(1, 1, At, B1); PG8_BAR; PG8_SCHED;
            PG8_LDB(B0, 1, 0); PG8_LDB(B1, 1, 1); PG8_SCHED; PG8_LDA(At, 1, 0); PG8_STAGE(PG8_SA(0, 1), a2 + hstepA, voffA);
            PG8_WAIT_V(8); PG8_WAIT_L(0); PG8_BAR; PG8_MMA(0, 0, At, B0); PG8_MMA(0, 1, At, B1); PG8_BAR; PG8_SCHED;
            PG8_LDA(At, 1, 1); PG8_STAGE(PG8_SB(1, 0), b3, voffB); PG8_STAGE(PG8_SB(1, 1), b3 + hstepB, voffB); PG8_STAGE(PG8_SA(1, 0), a3, voffA);
            PG8_WAIT_V(8); PG8_WAIT_L(0); PG8_BAR; PG8_MMA(1, 0, At, B0); PG8_MMA(1, 1, At, B1); PG8_BAR; PG8_SCHED;
        }
        if constexpr (ALIGN_EPI) { if (wr == 0) PG8_BAR; }
        E(acc, cur, wr, wc, fr, fq);
        if (!has_next) break;
#pragma unroll
        for (int a = 0; a < 2; ++a)
#pragma unroll
            for (int b = 0; b < 2; ++b)
#pragma unroll
                for (int m = 0; m < 4; ++m)
#pragma unroll
                    for (int n = 0; n < 2; ++n) acc[a][b][m][n] = (f32x4){0.f, 0.f, 0.f, 0.f};
        cur = nxt; cA = nA; cB = nB; ++ui;
        if constexpr (ALIGN_EPI) { if (wr == 1) PG8_BAR; }
    }
    PG8_WAIT_V(0);
    if constexpr (!ALIGN_EPI) { if (wr == 0) PG8_BAR; }
    PG8_BAR;
#undef PG8_AP
#undef PG8_ABASE
#undef PG8_SA
#undef PG8_SB
#undef PG8_STAGE
#undef PG8_LDA
#undef PG8_LDB
#undef PG8_MMA
#undef PG8_WAIT_V
#undef PG8_WAIT_L
#undef PG8_BAR
#undef PG8_SCHED
}
}

template <class Fn>
__device__ __forceinline__ void epi_for(const f32x4 (&acc)[2][2][4][2], const pg8::Unit& u, int wr, int wc, int fr, int fq, Fn fn) {
#pragma unroll
    for (int ai = 0; ai < 2; ++ai)
#pragma unroll
        for (int m = 0; m < 4; ++m) { const int row = u.pm * 256 + ai * 128 + wr * 64 + m * 16 + fr;
#pragma unroll
            for (int bj = 0; bj < 2; ++bj) { const int col = u.pn * 256 + bj * 128 + wc * 32 + 8 * fq; fn(row, col, acc[ai][bj][m][0], acc[ai][bj][m][1]); }
            if (m & 1) asm volatile("" ::: "memory"); }
}
__device__ __forceinline__ u32x4 pack8(f32x4 v0, f32x4 v1) { u32x4 w; w.x = cvt_pk_bf16(v0[0], v0[1]); w.y = cvt_pk_bf16(v0[2], v0[3]); w.z = cvt_pk_bf16(v1[0], v1[1]); w.w = cvt_pk_bf16(v1[2], v1[3]); return w; }

struct EpiEvenIn {
    bf16_t* Z; const float* ssq; bf16_t* VTa; bf16_t* VTb; bf16_t* KT;
    __device__ __forceinline__ void operator()(const f32x4 (&acc)[2][2][4][2], const pg8::Unit& u, int wr, int wc, int fr, int fq) const {
        const int g = u.pn >> 1;
        epi_for(acc, u, wr, wc, fr, fq, [&](int row, int col, f32x4 v0, f32x4 v1) {
            const float rs = rsqrtf(ssq_sum(ssq, row) * (1.f / D) + 1e-6f);
            v0 = v0 * rs; v1 = v1 * rs;
            const int cg = col & 511, t = row & (SEQ - 1), b = row >> 13;
            if (g == 2 || g == 6) {
                bf16_t* p = (g == 2 ? VTa : VTb) + ((size_t)(b * 512 + cg)) * SEQ + t;
                _Pragma("unroll") for (int j = 0; j < 4; ++j) { p[(size_t)j * SEQ] = (bf16_t)f2bf(v0[j]); p[(size_t)(4 + j) * SEQ] = (bf16_t)f2bf(v1[j]); }
            } else if (g < 2) {
                const float pos = (float)t; const int i0 = (cg & 127) >> 1;
                float o[8] = {v0[0], v0[1], v0[2], v0[3], v1[0], v1[1], v1[2], v1[3]};
                _Pragma("unroll") for (int j = 0; j < 4; ++j) { const float inv = exp2f(-(float)(i0 + j) * (13.287712379549449f / 64.f));
                    float rev = pos * inv * 0.15915494309189535f; rev = rev - floorf(rev); const float sn = __builtin_amdgcn_sinf(rev), cs = __builtin_amdgcn_cosf(rev);
                    const float x1 = o[2 * j], x2 = o[2 * j + 1]; o[2 * j] = x1 * cs - x2 * sn; o[2 * j + 1] = x1 * sn + x2 * cs; }
                const float lg2 = log2f(1.f - exp2f(-5.f - (float)(cg >> 7))); const float ip1 = (float)((t & 127) + 1);
                if (g == 0) { const float f = exp2f(ip1 * lg2);
                    *(u32x4*)(Z + (size_t)row * ZE + cg) = pack8((f32x4){o[0] * f, o[1] * f, o[2] * f, o[3] * f}, (f32x4){o[4] * f, o[5] * f, o[6] * f, o[7] * f}); }
                else { const float f = exp2f(-ip1 * lg2), f2 = exp2f((128.f - ip1) * lg2);
                    *(u32x4*)(Z + (size_t)row * ZE + 512 + cg) = pack8((f32x4){o[0] * f, o[1] * f, o[2] * f, o[3] * f}, (f32x4){o[4] * f, o[5] * f, o[6] * f, o[7] * f});
                    bf16_t* p = KT + ((size_t)(b * 512 + cg)) * SEQ + t;
                    _Pragma("unroll") for (int j = 0; j < 8; ++j) p[(size_t)j * SEQ] = (bf16_t)f2bf(o[j] * f2); }
            } else {
                const int zc = (g - 1 - (g > 6 ? 1 : 0)) * 512;
                *(u32x4*)(Z + (size_t)row * ZE + zc + cg) = pack8(v0, v1);
            }
        });
    }
};
struct EpiOddIn {
    bf16_t* Z; bf16_t* L1;
    __device__ __forceinline__ void operator()(const f32x4 (&acc)[2][2][4][2], const pg8::Unit& u, int wr, int wc, int fr, int fq) const {
        if (u.pn < 16) { epi_for(acc, u, wr, wc, fr, fq, [&](int row, int col, f32x4 v0, f32x4 v1) { *(u32x4*)(Z + (size_t)row * ZW + col) = pack8(v0, v1); }); }
        else { epi_for(acc, u, wr, wc, fr, fq, [&](int row, int col, f32x4 v0, f32x4 v1) { const int c = col - 4096; if (c < 64) {
                    _Pragma("unroll") for (int j = 0; j < 4; ++j) { v0[j] = tanhf(v0[j]); v1[j] = tanhf(v1[j]); } }
                *(u32x4*)(L1 + (size_t)row * 256 + c) = pack8(v0, v1); }); }
    }
};
__device__ __forceinline__ void unpack8(const u32x4 w, f32x4& a, f32x4& b) {
    a = (f32x4){__uint_as_float(w.x << 16), __uint_as_float(w.x & 0xffff0000u), __uint_as_float(w.y << 16), __uint_as_float(w.y & 0xffff0000u)};
    b = (f32x4){__uint_as_float(w.z << 16), __uint_as_float(w.z & 0xffff0000u), __uint_as_float(w.w << 16), __uint_as_float(w.w & 0xffff0000u)}; }
struct EpiResid {
    const bf16_t* Ha; bf16_t* HB; int ldb;
    __device__ __forceinline__ void operator()(const f32x4 (&acc)[2][2][4][2], const pg8::Unit& u, int wr, int wc, int fr, int fq) const {
        epi_for(acc, u, wr, wc, fr, fq, [&](int row, int col, f32x4 v0, f32x4 v1) { f32x4 h0, h1; unpack8(*(const u32x4*)(Ha + (size_t)row * D + col), h0, h1); h0 = h0 + v0; h1 = h1 + v1;
            *(u32x4*)(HB + (size_t)row * ldb + col) = pack8(h0, h1); });
    }
};
struct EpiStore {
    bf16_t* O; int ldc;
    __device__ __forceinline__ void operator()(const f32x4 (&acc)[2][2][4][2], const pg8::Unit& u, int wr, int wc, int fr, int fq) const {
        epi_for(acc, u, wr, wc, fr, fq, [&](int row, int col, f32x4 v0, f32x4 v1) { *(u32x4*)(O + (size_t)row * ldc + col) = pack8(v0, v1); });
    }
};
struct EpiGate {
    const bf16_t* Hb; int ldh; const bf16_t* PP; int ldp; bf16_t* Ha; float* ssq;
    __device__ __forceinline__ void operator()(const f32x4 (&acc)[2][2][4][2], const pg8::Unit& u, int wr, int wc, int fr, int fq) const {
#pragma unroll
        for (int ai = 0; ai < 2; ++ai)
#pragma unroll
            for (int m = 0; m < 4; ++m) { const int row = u.pm * 256 + ai * 128 + wr * 64 + m * 16 + fr; float sq = 0.f;
#pragma unroll
                for (int bj = 0; bj < 2; ++bj) { const int col = u.pn * 256 + bj * 128 + wc * 32 + 8 * fq; const f32x4 v0 = acc[ai][bj][m][0], v1 = acc[ai][bj][m][1];
                    f32x4 h0, h1, p0, p1; unpack8(*(const u32x4*)(Hb + (size_t)row * ldh + col), h0, h1); unpack8(*(const u32x4*)(PP + (size_t)row * ldp + col), p0, p1);
#pragma unroll
                    for (int j = 0; j < 4; ++j) { h0[j] += sigmoidf_(v0[j]) * p0[j]; h1[j] += sigmoidf_(v1[j]) * p1[j]; sq += h0[j] * h0[j] + h1[j] * h1[j]; }
                    *(u32x4*)(Ha + (size_t)row * D + col) = pack8(h0, h1); }
                sq += __shfl_xor(sq, 16); sq += __shfl_xor(sq, 32);
                if (fq == 0) ssq[(size_t)row * 16 + u.pn * 4 + wc] = sq;
                if (m & 1) asm volatile("" ::: "memory"); }
    }
};

#define XB_TMO      128
#define XB_XCNT(j)  (256  + 64 * (j))
#define XB_XSUB(j)  (1280 + 64 * (j))
#define XB_XGEN(j)  (2304 + 64 * (j))
#define XB_TOP      3328
#define XB_TOPGEN   3392
#define XCD_BAR_WORDS 3456
#define XB_SPIN_CAP (1u << 22)
__device__ __forceinline__ unsigned xb_ld(unsigned* p)              { return __hip_atomic_load(p, __ATOMIC_RELAXED, __HIP_MEMORY_SCOPE_AGENT); }
__device__ __forceinline__ unsigned xb_add(unsigned* p, unsigned v) { return __hip_atomic_fetch_add(p, v, __ATOMIC_RELAXED, __HIP_MEMORY_SCOPE_AGENT); }
__device__ __forceinline__ unsigned xb_xcc_id() { return (unsigned)__builtin_amdgcn_s_getreg((3 << 11) | 20) & 0xFu; }
#define XB_SPIN(cond, bar) do { unsigned _sp = 0; while (cond) { __builtin_amdgcn_s_sleep(1); \
    if ((++_sp & 255u) == 0u) { if (xb_ld(&(bar)[XB_TMO])) break; if (_sp > XB_SPIN_CAP) { atomicAdd(&(bar)[XB_TMO], 1u); break; } } } } while (0)
struct XcdBarrier { unsigned* bar; unsigned x; volatile LAS unsigned* st; };
__device__ __forceinline__ XcdBarrier xcd_barrier_post(unsigned* bar, volatile LAS unsigned* st) {
    XcdBarrier b; b.bar = bar; b.x = xb_xcc_id(); b.st = st;
    if (threadIdx.x == 0) (void)xb_add(&bar[XB_XCNT(b.x)], 1u);
    return b;
}
__device__ __forceinline__ void xcd_barrier_complete(unsigned* bar, unsigned x, unsigned& nloc, unsigned& nx) {
    const unsigned G = gridDim.x * gridDim.y * gridDim.z;
    unsigned sum, cnt, mine, sp = 0u;
    for (;;) {
        sum = 0u; cnt = 0u; mine = 0u;
#pragma unroll
        for (unsigned j = 0; j < 16; ++j) { const unsigned c = xb_ld(&bar[XB_XCNT(j)]); sum += c; cnt += (c > 0u) ? 1u : 0u; mine = (j == x) ? c : mine; }
        if (sum == G) break;
        __builtin_amdgcn_s_sleep(1);
        if ((++sp & 255u) == 0u) { if (xb_ld(&bar[XB_TMO])) break; if (sp > XB_SPIN_CAP) { atomicAdd(&bar[XB_TMO], 1u); break; } }
    }
    nloc = mine > 0u ? mine : 1u; nx = cnt > 0u ? cnt : 1u;
}
__device__ __forceinline__ void xcd_barrier(const XcdBarrier& b_in) {
    asm volatile("s_waitcnt vmcnt(0)" ::: "memory");
    __syncthreads();
    if (threadIdx.x == 0) {
        const XcdBarrier& b = b_in;
        unsigned* bar = b.bar;
        __builtin_amdgcn_s_waitcnt(0);
        unsigned nloc = b.st[0], nx = b.st[1];
        if (nloc == 0u) { xcd_barrier_complete(bar, b.x, nloc, nx); b.st[0] = nloc; b.st[1] = nx; }
        const unsigned old = xb_add(&bar[XB_XSUB(b.x)], 1u);
        const unsigned gen = old / nloc;
        if (old + 1u == (gen + 1u) * nloc) {
            __builtin_amdgcn_fence(__ATOMIC_RELEASE, "agent");
            asm volatile("s_waitcnt vmcnt(0)" ::: "memory");
            const unsigned og = xb_add(&bar[XB_TOP], 1u);
            const unsigned tg = og / nx;
            if (og + 1u == (tg + 1u) * nx) xb_add(&bar[XB_TOPGEN], 1u);
            else XB_SPIN(xb_ld(&bar[XB_TOPGEN]) == tg, bar);
            __builtin_amdgcn_fence(__ATOMIC_ACQUIRE, "agent");
            xb_add(&bar[XB_XGEN(b.x)], 1u);
            asm volatile("s_waitcnt vmcnt(0)" ::: "memory");
        } else {
            XB_SPIN(xb_ld(&bar[XB_XGEN(b.x)]) == gen, bar);
            __builtin_amdgcn_fence(__ATOMIC_ACQUIRE, "agent");
            asm volatile("s_waitcnt vmcnt(0)" ::: "memory");
        }
    }
    __syncthreads();
}

constexpr size_t MiB = 1u << 20;
constexpr size_t WS_CTL = 0, CTL_BYTES = 1 * MiB;
constexpr size_t WS_SSQ = 241 * (size_t)(1u << 20);
constexpr size_t WS_WIN = 2 * MiB;
constexpr size_t WS_WOUT = 19 * MiB, WS_WGATE = 21 * MiB, WS_WPROJ = 23 * MiB;
constexpr size_t WS_PB = 24 * MiB;
constexpr size_t WS_Z = 32 * MiB;
constexpr size_t WS_HB = 160 * MiB;
constexpr size_t WS_VF = 193 * MiB;
constexpr size_t WS_L1 = 225 * MiB;
constexpr size_t WS_VTA = 128 * MiB;
constexpr size_t WS_VTB = 144 * MiB;
constexpr size_t WS_KT = 225 * MiB;
constexpr size_t WS_LORA2 = 23 * MiB + 512 * 1024;
constexpr size_t WS_PG = 160 * MiB;
constexpr size_t WS_SB = 2 * MiB;
constexpr size_t WS_BON = 233 * MiB;
constexpr size_t WS_ST = 176 * MiB;
constexpr size_t WS_KV = 160 * MiB;
constexpr size_t WS_END = 256 * MiB;

constexpr int RING_BYTES = 131072, LDS_BYTES = 163840, MISC_OFF = LDS_BYTES - 512;

struct Args { const float* in[26]; float* out; unsigned char* ws; int ph_lo, ph_hi; };

__device__ __forceinline__ const float* inptr(int i) { asm volatile("" : "+s"(i)); const char* ka = (const char*)__builtin_amdgcn_kernarg_segment_ptr(); return *(const float* const*)(ka + 8 * i); }
struct InTab { __device__ __forceinline__ const float* operator[](int i) const { return inptr(i); } };
struct Frame {
    LAS unsigned char* lds; unsigned char* ldsg;
    int tid, lane, wave, G, vcu;
    InTab in; float* H; unsigned char* ws;
    __device__ __forceinline__ void retid() { int l; asm volatile("v_mbcnt_lo_u32_b32 %0, -1, 0\n\tv_mbcnt_hi_u32_b32 %0, -1, %0" : "=v"(l)); lane = l; tid = wave * 64 + l; }
    __device__ __forceinline__ float* ssq(int l) const { return (float*)(ws + WS_SSQ) + (size_t)l * T * 16; }
};

__device__ __forceinline__ void conv_item(const float* W, int ldw, int Kmax, int k0, int n0, bf16_t* dst, int ldd, int dr0, int drs, int dk0,
                                          const float* svec, float sa, float sb, float sc, LAS float* scr, int lane) {
    float wv[32];
#pragma unroll
    for (int i = 0; i < 32; ++i) { const int k = k0 + 2 * i + (lane >> 5); wv[i] = (k < Kmax) ? W[(size_t)k * ldw + n0 + (lane & 31)] : 0.f; }
#pragma unroll
    for (int i = 0; i < 32; ++i) { const int kk = 2 * i + (lane >> 5), k = k0 + kk; const float f = (k < Kmax) ? (sa + sb * (svec ? svec[k] : 0.f)) * sc : 0.f;
        scr[kk * 33 + (lane & 31)] = wv[i] * f; }
    LDS_WAIT(); asm volatile("" ::: "memory");
    const int c = lane & 7;
    if (k0 + 8 * c < Kmax) {
#pragma unroll
        for (int j = 0; j < 4; ++j) { const int n = (lane >> 3) + 8 * j; const LAS float* s = scr + (8 * c) * 33 + n;
            u32x4 o; o.x = pk2(s[0 * 33], s[1 * 33]); o.y = pk2(s[2 * 33], s[3 * 33]); o.z = pk2(s[4 * 33], s[5 * 33]); o.w = pk2(s[6 * 33], s[7 * 33]);
            *(GAS u32x4*)(dst + (size_t)(dr0 + n * drs) * ldd + dk0 + k0 + 8 * c) = o; }
    }
    LDS_WAIT(); asm volatile("" ::: "memory");
}
__device__ __forceinline__ void conv_item2(const float* W, int ldw, int k0, int n0, bf16_t* dst, int dr0, const float* mu, float sc, LAS float* scr, int lane) {
    float wv[32];
#pragma unroll
    for (int i = 0; i < 32; ++i) wv[i] = W[(size_t)(k0 + 2 * i + (lane >> 5)) * ldw + n0 + (lane & 31)];
#pragma unroll
    for (int half = 0; half < 2; ++half) {
#pragma unroll
        for (int i = 0; i < 32; ++i) { const int kk = 2 * i + (lane >> 5); const float m = mu[k0 + kk]; scr[kk * 33 + (lane & 31)] = wv[i] * ((half ? m : 1.f - m) * sc); }
        LDS_WAIT(); asm volatile("" ::: "memory");
        const int c = lane & 7;
#pragma unroll
        for (int j = 0; j < 4; ++j) { const int n = (lane >> 3) + 8 * j; const LAS float* s_ = scr + (8 * c) * 33 + n;
            u32x4 o; o.x = pk2(s_[0 * 33], s_[1 * 33]); o.y = pk2(s_[2 * 33], s_[3 * 33]); o.z = pk2(s_[4 * 33], s_[5 * 33]); o.w = pk2(s_[6 * 33], s_[7 * 33]);
            *(GAS u32x4*)(dst + (size_t)(dr0 + n) * 2048 + half * 1024 + k0 + 8 * c) = o; }
        LDS_WAIT(); asm volatile("" ::: "memory");
    }
}
__device__ __forceinline__ void conv_win_even(Frame& F, int li) {
    const int e = li >> 1; const float* W = F.in[6] + (size_t)e * D * ZW; const float* gain = F.in[2] + li * D; bf16_t* dst = (bf16_t*)(F.ws + WS_WIN);
    LAS float* scr = (LAS float*)(F.lds + F.wave * 16384);
    const int gw = F.vcu * 8 + F.wave, NGW = F.G * 8;
    for (int it = gw; it < 16 * 128; it += NGW) { const int kb = it >> 7, nb = it & 127, n0 = nb * 32, g = n0 >> 9, hh = (n0 & 511) >> 7, d0 = n0 & 127;
        int dr0 = n0, drs = 1; if (g < 2) { dr0 = g * 512 + hh * 128 + (d0 < 64 ? 2 * d0 : 2 * (d0 - 64) + 1); drs = 2; }
        const float sc = (g == 1 || g == 5) ? QK_SCALE : 1.f;
        conv_item(W, ZW, D, kb * 64, n0, dst, D, dr0, drs, 0, gain, 0.f, 1.f, sc, scr, F.lane); }
}
__device__ __forceinline__ void conv_win_odd(Frame& F, int li) {
    const int o = li >> 1; const float* mu = F.in[9] + (size_t)o * 6 * D; bf16_t* dst = (bf16_t*)(F.ws + WS_WIN);
    LAS float* scr = (LAS float*)(F.lds + F.wave * 16384);
    const int gw = F.vcu * 8 + F.wave, NGW = F.G * 8;
    for (int it = gw; it < 4 * 512; it += NGW) { const int p = it >> 9, r = it & 511, kb = r >> 5, nb = r & 31;
        conv_item2(F.in[10] + ((size_t)o * 4 + p) * D * D, D, kb * 64, nb * 32, dst, p * 1024 + nb * 32, mu + p * D, 1.f, scr, F.lane); }
    for (int it = gw; it < 32 + 32 + 16; it += NGW) { const float* W; int ldw, n0, dr0, mi, kb; const int r = it;
        if (r < 32) { W = F.in[13] + (size_t)o * D * 64; ldw = 64; kb = r >> 1; n0 = (r & 1) * 32; dr0 = 4096 + n0; mi = 4; }
        else if (r < 64) { const int q = r - 32; W = F.in[16] + (size_t)o * D * 64; ldw = 64; kb = q >> 1; n0 = (q & 1) * 32; dr0 = 4160 + n0; mi = 5; }
        else { const int q = r - 64; W = F.in[19]; ldw = 32; kb = q; n0 = 0; dr0 = 4224; mi = 2; }
        conv_item2(W, ldw, kb * 64, n0, dst, dr0, mu + mi * D, (r >= 64 && o == 0) ? 0.f : 1.f, scr, F.lane); }
    { u32x4 z = {0u, 0u, 0u, 0u}; GAS u32x4* zp = (GAS u32x4*)(dst + (size_t)4256 * 2048); const int n16 = 96 * 2048 * 2 / 16;
      for (int i = (F.vcu * 512 + F.tid); i < n16; i += F.G * 512) zp[i] = z; }
}
__device__ __forceinline__ void conv_wrest(Frame& F, int li) {
    const bool even = (li & 1) == 0; const int e = li >> 1;
    const float* Wo = even ? F.in[7] + (size_t)e * D * D : F.in[11] + (size_t)e * D * D;
    const float* Wg = F.in[5] + (size_t)li * D * D; const float* Wp = F.in[4] + (size_t)li * PLE * D;
    LAS float* scr = (LAS float*)(F.lds + F.wave * 16384);
    const int gw = F.vcu * 8 + F.wave, NGW = F.G * 8;
    for (int it = gw; it < 512 + 512 + 128; it += NGW) {
        if (it < 512) conv_item(Wo, D, D, (it >> 5) * 64, (it & 31) * 32, (bf16_t*)(F.ws + WS_WOUT), D, (it & 31) * 32, 1, 0, nullptr, 1.f, 0.f, 1.f, scr, F.lane);
        else if (it < 1024) { const int r = it - 512; conv_item(Wg, D, D, (r >> 5) * 64, (r & 31) * 32, (bf16_t*)(F.ws + WS_WGATE), D, (r & 31) * 32, 1, 0, nullptr, 1.f, 0.f, 1.f, scr, F.lane); }
        else { const int r = it - 1024; conv_item(Wp, D, PLE, (r >> 5) * 64, (r & 31) * 32, (bf16_t*)(F.ws + WS_WPROJ), PLE, (r & 31) * 32, 1, 0, nullptr, 1.f, 0.f, 1.f, scr, F.lane); }
    }
    const float* P = F.in[1] + (size_t)li * T * PLE; GAS u32x4* pb = (GAS u32x4*)(F.ws + WS_PB); const int n8 = T * PLE / 8;
    for (int i = F.vcu * 512 + F.tid; i < n8; i += F.G * 512) { const f32x4 a = *(const f32x4*)(P + (size_t)i * 8), b = *(const f32x4*)(P + (size_t)i * 8 + 4);
        u32x4 o; o.x = pk2(a[0], a[1]); o.y = pk2(a[2], a[3]); o.z = pk2(b[0], b[1]); o.w = pk2(b[2], b[3]); pb[i] = o; }
}

__device__ __forceinline__ void conv_lora2(Frame& F, int li) {
    const int o = li >> 1; LAS float* scr = (LAS float*)(F.lds + F.wave * 16384);
    bf16_t* W2T = (bf16_t*)(F.ws + WS_LORA2); bf16_t* A2T = W2T + 1024 * 64; bf16_t* V2T = A2T + 1024 * 64;
    const int gw = F.vcu * 8 + F.wave, NGW = F.G * 8;
    for (int it = gw; it < 96; it += NGW) {
        if (it < 32) conv_item(F.in[14] + (size_t)o * 64 * D, D, 64, 0, it * 32, W2T, 64, it * 32, 1, 0, nullptr, 1.f, 0.f, 1.f, scr, F.lane);
        else if (it < 64) conv_item(F.in[17] + (size_t)o * 64 * D, D, 64, 0, (it - 32) * 32, A2T, 64, (it - 32) * 32, 1, 0, nullptr, 1.f, 0.f, 1.f, scr, F.lane);
        else conv_item(F.in[20], D, 32, 0, (it - 64) * 32, V2T, 32, (it - 64) * 32, 1, 0, nullptr, 1.f, 0.f, 1.f, scr, F.lane);
    }
}
__device__ __forceinline__ void rows_p0(Frame& F) {
    const float* x = F.in[0]; bf16_t* HB = (bf16_t*)(F.ws + WS_HB); float* s0 = F.ssq(0);
    for (int row = F.vcu * 8 + F.wave; row < T; row += F.G * 8) {
        const f32x4* xr = (const f32x4*)(x + (size_t)row * D) + F.lane; u32x2* br = (u32x2*)(HB + (size_t)row * D) + F.lane; float s = 0.f;
#pragma unroll
        for (int j = 0; j < 4; ++j) { const f32x4 v = xr[64 * j]; s += (v[0] * v[0] + v[1] * v[1]) + (v[2] * v[2] + v[3] * v[3]); u32x2 w; w.x = pk2(v[0], v[1]); w.y = pk2(v[2], v[3]); br[64 * j] = w; }
        s = wave_sum(s); if (F.lane < 16) s0[(size_t)row * 16 + F.lane] = F.lane == 0 ? s : 0.f;
    }
}
__device__ __forceinline__ void rows_norm(Frame& F, int li) {
    const float* gain = F.in[2] + li * D; bf16_t* HN = (bf16_t*)(F.H); const bf16_t* Ha = (const bf16_t*)(F.ws + WS_HB); const float* sq = F.ssq(li);
    f32x4 g[4];
#pragma unroll
    for (int j = 0; j < 4; ++j) g[j] = *((const f32x4*)gain + F.lane + 64 * j);
    for (int row = F.vcu * 8 + F.wave; row < T; row += F.G * 8) {
        const u32x2* hr = (const u32x2*)(Ha + (size_t)row * D) + F.lane; u32x2* br = (u32x2*)(HN + (size_t)(row + 1 + (row >= SEQ ? 1 : 0)) * D) + F.lane;
        const float rs = rsqrtf(ssq_sum(sq, row) * (1.f / D) + 1e-6f);
#pragma unroll
        for (int j = 0; j < 4; ++j) { const u32x2 hw = hr[64 * j]; const f32x4 h4 = {__uint_as_float(hw.x << 16), __uint_as_float(hw.x & 0xffff0000u), __uint_as_float(hw.y << 16), __uint_as_float(hw.y & 0xffff0000u)};
            const f32x4 v = h4 * rs * g[j]; u32x2 w; w.x = pk2(v[0], v[1]); w.y = pk2(v[2], v[3]); br[64 * j] = w; }
    }
    if (F.vcu == 0 && F.wave < 2) { u32x2* br = (u32x2*)(HN + (size_t)(F.wave ? SEQ + 1 : 0) * D) + F.lane; u32x2 z = {0u, 0u};
#pragma unroll
        for (int j = 0; j < 4; ++j) br[64 * j] = z; }
}
__device__ __forceinline__ void rows_final(Frame& F) {
    const float* gain = F.in[3]; const float* sq = F.ssq(4); const bf16_t* Ha = (const bf16_t*)(F.ws + WS_HB);
    f32x4 g[4];
#pragma unroll
    for (int j = 0; j < 4; ++j) g[j] = *((const f32x4*)gain + F.lane + 64 * j);
    for (int row = F.vcu * 8 + F.wave; row < T; row += F.G * 8) {
        const u32x2* hr = (const u32x2*)(Ha + (size_t)row * D) + F.lane; f32x4* orow = (f32x4*)(F.H + (size_t)row * D) + F.lane; const float rs = rsqrtf(ssq_sum(sq, row) * (1.f / D) + 1e-6f);
#pragma unroll
        for (int j = 0; j < 4; ++j) { const u32x2 hw = hr[64 * j]; const f32x4 h4 = {__uint_as_float(hw.x << 16), __uint_as_float(hw.x & 0xffff0000u), __uint_as_float(hw.y << 16), __uint_as_float(hw.y & 0xffff0000u)};
            orow[64 * j] = h4 * rs * g[j]; }
    }
}

typedef float f32x16 __attribute__((ext_vector_type(16)));
template <bool DUMMY>
__device__ __forceinline__ void sb_unit(Frame& F, int bh, int qb) {
    const int lane = F.lane, l31 = lane & 31, hi = lane >> 5, b = bh >> 2, h = bh & 3;
    bf16_t* Z = (bf16_t*)(F.ws + WS_Z); const bf16_t* VT = (const bf16_t*)(F.ws + WS_VTB) + (size_t)bh * 128 * SEQ;
    const size_t rowb = (size_t)b * SEQ; const int q0 = qb * 32, tq = q0 + l31;
    bf16x8 qr[8];
    { const bf16_t* qp = Z + (rowb + tq) * ZE + 1536 + h * 128 + hi * 8;
#pragma unroll
      for (int ks = 0; ks < 8; ++ks) qr[ks] = *(const bf16x8*)(qp + 16 * ks); }
    f32x16 o[4];
#pragma unroll
    for (int d = 0; d < 4; ++d)
#pragma unroll
        for (int r = 0; r < 16; ++r) o[d][r] = 0.f;
    float carry = 1.f;
    const int pi = 16 * ((l31 >> 2) & 1) + (l31 & 3) + 4 * (l31 >> 3);
    const bf16_t* Kb = Z + rowb * ZE + 2048 + h * 128 + hi * 8;
    for (int kt = (q0 + 31) >> 6; kt >= 0; --kt) {
        const int kbase = kt * 64;
        const bf16_t* kp0 = Kb + (size_t)(kbase + pi) * ZE; const bf16_t* kp1 = kp0 + (size_t)32 * ZE;
        f32x16 p0, p1;
#pragma unroll
        for (int r = 0; r < 16; ++r) { p0[r] = 0.f; p1[r] = 0.f; }
#pragma unroll
        for (int ks = 0; ks < 8; ++ks) { const bf16x8 a0 = *(const bf16x8*)(kp0 + 16 * ks), a1 = *(const bf16x8*)(kp1 + 16 * ks);
            p0 = __builtin_amdgcn_mfma_f32_32x32x16_bf16(a0, qr[ks], p0, 0, 0, 0); p1 = __builtin_amdgcn_mfma_f32_32x32x16_bf16(a1, qr[ks], p1, 0, 0, 0); }
        float f1 = 1.f, f0 = 1.f;
        const int k1 = kbase + 32 + 16 * hi, k0 = kbase + 16 * hi;
#pragma unroll
        for (int r = 15; r >= 0; --r) { const float z = fminf(p1[r], 80.f); const float e = exp2f(z * 1.4426950408889634f); float rd = __builtin_amdgcn_rcpf(1.f + e); float be = e * rd;
            const bool valid = (k1 + r) < tq; be = valid ? be : 0.f; rd = valid ? rd : 1.f; p1[r] = be * f1; f1 *= rd; }
#pragma unroll
        for (int r = 15; r >= 0; --r) { const float z = fminf(p0[r], 80.f); const float e = exp2f(z * 1.4426950408889634f); float rd = __builtin_amdgcn_rcpf(1.f + e); float be = e * rd;
            const bool valid = (k0 + r) < tq; be = valid ? be : 0.f; rd = valid ? rd : 1.f; p0[r] = be * f0; f0 *= rd; }
        const float pf0 = __shfl_xor(f0, 32), pf1 = __shfl_xor(f1, 32);
        const float tail1 = hi ? 1.f : pf1;
        const float tail0 = hi ? (pf1 * f1) : (pf0 * f1 * pf1);
        const float s1 = tail1 * carry, s0 = tail0 * carry;
        carry *= (f0 * f1) * (pf0 * pf1);
        u32x4 pa[2][2];
#pragma unroll
        for (int s = 0; s < 2; ++s) {
            pa[0][s].x = cvt_pk_bf16(p0[8 * s + 0] * s0, p0[8 * s + 1] * s0); pa[0][s].y = cvt_pk_bf16(p0[8 * s + 2] * s0, p0[8 * s + 3] * s0);
            pa[0][s].z = cvt_pk_bf16(p0[8 * s + 4] * s0, p0[8 * s + 5] * s0); pa[0][s].w = cvt_pk_bf16(p0[8 * s + 6] * s0, p0[8 * s + 7] * s0);
            pa[1][s].x = cvt_pk_bf16(p1[8 * s + 0] * s1, p1[8 * s + 1] * s1); pa[1][s].y = cvt_pk_bf16(p1[8 * s + 2] * s1, p1[8 * s + 3] * s1);
            pa[1][s].z = cvt_pk_bf16(p1[8 * s + 4] * s1, p1[8 * s + 5] * s1); pa[1][s].w = cvt_pk_bf16(p1[8 * s + 6] * s1, p1[8 * s + 7] * s1);
        }
        const bf16_t* vp = VT + (size_t)l31 * SEQ + kbase + 16 * hi;
#pragma unroll
        for (int d = 0; d < 4; ++d)
#pragma unroll
            for (int blk = 0; blk < 2; ++blk)
#pragma unroll
                for (int s = 0; s < 2; ++s) { const bf16x8 vb = *(const bf16x8*)(vp + (size_t)(32 * d) * SEQ + 32 * blk + 8 * s);
                    o[d] = __builtin_amdgcn_mfma_f32_32x32x16_bf16(__builtin_bit_cast(bf16x8, pa[blk][s]), vb, o[d], 0, 0, 0); }
        if (__all(carry < 7.9e-31f)) break;
    }
#pragma unroll
    for (int r = 0; r < 16; ++r) { const int qrow = q0 + (r & 3) + 8 * (r >> 2) + 4 * hi; bf16_t* gp = Z + (rowb + qrow) * ZE + 2560 + h * 128 + l31;
#pragma unroll
        for (int d = 0; d < 4; ++d) { const float g = bf2f(gp[32 * d]); const float ov = o[d][r] * siluf_(g); if (!DUMMY) gp[32 * d] = (bf16_t)f2bf(ov); else asm volatile("" :: "v"(ov)); } }
}
__device__ __forceinline__ void ret_stage_a(Frame& F, int u) {
    const int l31 = F.lane & 31, hi = F.lane >> 5, cu = u >> 3, w8 = u & 7, bh = cu & 7, n = cu >> 3, dvb = w8 >> 1, dkp = w8 & 1;
    const bf16_t* vt = (const bf16_t*)(F.ws + WS_VTA) + ((size_t)(bh * 128 + 32 * dvb + l31)) * SEQ + n * 128 + 8 * hi;
    const bf16_t* kt = (const bf16_t*)(F.ws + WS_KT) + ((size_t)(bh * 128 + 64 * dkp + l31)) * SEQ + n * 128 + 8 * hi;
    f32x16 a0, a1;
#pragma unroll
    for (int r = 0; r < 16; ++r) { a0[r] = 0.f; a1[r] = 0.f; }
#pragma unroll
    for (int ks = 0; ks < 8; ++ks) { const bf16x8 va = *(const bf16x8*)(vt + 16 * ks), k0 = *(const bf16x8*)(kt + 16 * ks), k1 = *(const bf16x8*)(kt + (size_t)32 * SEQ + 16 * ks);
        a0 = __builtin_amdgcn_mfma_f32_32x32x16_bf16(va, k0, a0, 0, 0, 0); a1 = __builtin_amdgcn_mfma_f32_32x32x16_bf16(va, k1, a1, 0, 0, 0); }
    bf16_t* kv = (bf16_t*)(F.H) + ((size_t)cu * 128 + 32 * dvb) * 128 + 64 * dkp + l31;
#pragma unroll
    for (int r = 0; r < 16; ++r) { const int dv = (r & 3) + 8 * (r >> 2) + 4 * hi; kv[dv * 128] = (bf16_t)f2bf(a0[r]); kv[dv * 128 + 32] = (bf16_t)f2bf(a1[r]); }
}
__device__ __forceinline__ void ret_stage_b(Frame& F) {
    const int e = F.vcu * 512 + F.tid; if (e >= 8 * 128 * 128) return;
    const int h = (e >> 14) & 3; const float g128 = exp2f(128.f * log2f(1.f - exp2f(-5.f - (float)h)));
    const bf16_t* p = (const bf16_t*)(F.H) + e; bf16_t* q = (bf16_t*)(F.H) + (size_t)8 * 1024 * 1024 + e; float S = 0.f;
#pragma unroll 4
    for (int n = 0; n < 64; ++n) { const float kv = bf2f(p[(size_t)n * 131072]); q[(size_t)n * 131072] = (bf16_t)f2bf(S); S = S * g128 + kv; }
}
template <bool DUMMY>
__device__ __forceinline__ void ret_stage_c(Frame& F, int u, const float* gng) {
    const int lane = F.lane, l31 = lane & 31, hi = lane >> 5, cu = u >> 2, qblk = u & 3, bh = cu & 7, n = cu >> 3, b = bh >> 2, h = bh & 3;
    bf16_t* Z = (bf16_t*)(F.ws + WS_Z); const size_t rowb = (size_t)b * SEQ; const int t0 = n * 128, tq = t0 + 32 * qblk + l31;
    bf16x8 qr[8];
    { const bf16_t* qp = Z + (rowb + tq) * ZE + h * 128 + hi * 8;
#pragma unroll
      for (int ks = 0; ks < 8; ++ks) qr[ks] = *(const bf16x8*)(qp + 16 * ks); }
    f32x16 o[4];
#pragma unroll
    for (int d = 0; d < 4; ++d)
#pragma unroll
        for (int r = 0; r < 16; ++r) o[d][r] = 0.f;
    { const bf16_t* sp = (const bf16_t*)(F.H) + (size_t)8 * 1024 * 1024 + ((size_t)cu * 128 + l31) * 128 + 8 * hi;
#pragma unroll
      for (int ks = 0; ks < 8; ++ks)
#pragma unroll
          for (int d = 0; d < 4; ++d) { const bf16x8 sb = *(const bf16x8*)(sp + (size_t)(32 * d) * 128 + 16 * ks); o[d] = __builtin_amdgcn_mfma_f32_32x32x16_bf16(qr[ks], sb, o[d], 0, 0, 0); } }
    const int pi = 16 * ((l31 >> 2) & 1) + (l31 & 3) + 4 * (l31 >> 3);
    const bf16_t* Kb = Z + rowb * ZE + 512 + h * 128 + hi * 8;
    const bf16_t* VT = (const bf16_t*)(F.ws + WS_VTA) + ((size_t)(bh * 128 + l31)) * SEQ + 16 * hi;
    for (int kb = 0; kb <= qblk; ++kb) {
        const int kbase = t0 + 32 * kb; const bf16_t* kp = Kb + (size_t)(kbase + pi) * ZE;
        f32x16 p;
#pragma unroll
        for (int r = 0; r < 16; ++r) p[r] = 0.f;
#pragma unroll
        for (int ks = 0; ks < 8; ++ks) { const bf16x8 a = *(const bf16x8*)(kp + 16 * ks); p = __builtin_amdgcn_mfma_f32_32x32x16_bf16(a, qr[ks], p, 0, 0, 0); }
        if (kb == qblk) {
#pragma unroll
            for (int r = 0; r < 16; ++r) p[r] = (kbase + 16 * hi + r <= tq) ? p[r] : 0.f; }
        u32x4 pa[2];
#pragma unroll
        for (int s = 0; s < 2; ++s) { pa[s].x = cvt_pk_bf16(p[8 * s], p[8 * s + 1]); pa[s].y = cvt_pk_bf16(p[8 * s + 2], p[8 * s + 3]); pa[s].z = cvt_pk_bf16(p[8 * s + 4], p[8 * s + 5]); pa[s].w = cvt_pk_bf16(p[8 * s + 6], p[8 * s + 7]); }
#pragma unroll
        for (int d = 0; d < 4; ++d)
#pragma unroll
            for (int s = 0; s < 2; ++s) { const bf16x8 vb = *(const bf16x8*)(VT + (size_t)(32 * d) * SEQ + kbase + 8 * s);
                o[d] = __builtin_amdgcn_mfma_f32_32x32x16_bf16(__builtin_bit_cast(bf16x8, pa[s]), vb, o[d], 0, 0, 0); }
    }
    float gg[4];
#pragma unroll
    for (int d = 0; d < 4; ++d) gg[d] = gng[h * 128 + 32 * d + l31];
#pragma unroll
    for (int r = 0; r < 16; ++r) {
        float sm = (o[0][r] + o[1][r]) + (o[2][r] + o[3][r]);
        sm += __shfl_xor(sm, 1); sm += __shfl_xor(sm, 2); sm += __shfl_xor(sm, 4); sm += __shfl_xor(sm, 8); sm += __shfl_xor(sm, 16);
        const float mu = sm * (1.f / 128.f); float q = 0.f;
#pragma unroll
        for (int d = 0; d < 4; ++d) { const float dd = o[d][r] - mu; q += dd * dd; }
        q += __shfl_xor(q, 1); q += __shfl_xor(q, 2); q += __shfl_xor(q, 4); q += __shfl_xor(q, 8); q += __shfl_xor(q, 16);
        const float rsd = rsqrtf(q * (1.f / 128.f) + 1e-5f);
        const int qrow = t0 + 32 * qblk + (r & 3) + 8 * (r >> 2) + 4 * hi; bf16_t* gp = Z + (rowb + qrow) * ZE + 1024 + h * 128 + l31;
#pragma unroll
        for (int d = 0; d < 4; ++d) { const float ga = bf2f(gp[32 * d]); const float ov = (o[d][r] - mu) * rsd * gg[d] * siluf_(ga); if (!DUMMY) gp[32 * d] = (bf16_t)f2bf(ov); else asm volatile("" :: "v"(ov)); }
    }
}
__device__ __forceinline__ bf16x8 ld8p(const bf16_t* p) { return *(const bf16x8*)p; }
namespace rw {
constexpr int S64 = 72, S128 = 136, LFS = 68;
constexpr int O_AT = 0, O_RT = O_AT + 9216, O_E = O_RT + 9216, O_ET = O_E + 18432, O_AM = O_ET + 17408, O_X0 = O_AM + 18432, O_LF = O_X0 + 17408, O_MM = O_LF + 17408,
              O_NN = O_MM + 9216, O_PC = O_NN + 17408, O_GC = O_PC + 9216, O_SM = O_GC + 9216, O_END = O_SM + 8192;
static_assert(O_END <= 160 * 1024 - 1024, "rwkv stage X LDS map");
typedef __attribute__((address_space(3))) bf16_t lbf;
typedef __attribute__((address_space(3))) float lf32;
__device__ __forceinline__ bf16x8 ld8(const bf16_t* p) { return *(const bf16x8*)p; }
__device__ __forceinline__ bf16x8 ld8(const LAS bf16_t* p) { return *(const LAS bf16x8*)p; }
__device__ __forceinline__ bf16x8 ld8(const GAS bf16_t* p) { return *(const GAS bf16x8*)p; }
template <int MT, int NT, int KS, class PA, class PB, class Epi>
__device__ __forceinline__ void mm(PA A, int lda, PB B, int ldb, int wave, int lane, Epi epi) {
    const int fr = lane & 15, g = lane >> 4;
    static_assert((MT * NT) % 8 == 0, "mm: tile count must be a multiple of the 8 waves");
#pragma unroll
    for (int ti = 0; ti < MT * NT / 8; ++ti) { const int tile = wave + 8 * ti; const int mt = tile / NT, nt = tile % NT;
        f32x4 acc = {0.f, 0.f, 0.f, 0.f};
        PA ap = A + (mt * 16 + fr) * lda + 8 * g; PB bp = B + (nt * 16 + fr) * ldb + 8 * g;
#pragma unroll
        for (int ks = 0; ks < KS; ++ks) acc = __builtin_amdgcn_mfma_f32_16x16x32_bf16(ld8(ap + 32 * ks), ld8(bp + 32 * ks), acc, 0, 0, 0);
        epi(ti, mt * 16 + 4 * g, nt * 16 + fr, acc);
    }
}
template <int MT, int NT, int KS, class PA, class PB, class Epi>
__device__ __forceinline__ void mm_rt(PA A, int lda, PB B, int ldb, int w, int nw, int lane, Epi epi) {
    const int fr = lane & 15, g = lane >> 4;
#pragma unroll 1
    for (int tile = w; tile < MT * NT; tile += nw) { const int mt = tile / NT, nt = tile % NT;
        f32x4 acc = {0.f, 0.f, 0.f, 0.f};
        PA ap = A + (mt * 16 + fr) * lda + 8 * g; PB bp = B + (nt * 16 + fr) * ldb + 8 * g;
#pragma unroll
        for (int ks = 0; ks < KS; ++ks) acc = __builtin_amdgcn_mfma_f32_16x16x32_bf16(ld8(ap + 32 * ks), ld8(bp + 32 * ks), acc, 0, 0, 0);
        epi(mt * 16 + 4 * g, nt * 16 + fr, acc);
    }
}
__device__ __forceinline__ unsigned short bfs(float f) { return (unsigned short)f2bf(f); }
__device__ __forceinline__ void st4(LAS bf16_t* p, f32x4 v) { u32x2 w; w.x = cvt_pk_bf16(v[0], v[1]); w.y = cvt_pk_bf16(v[2], v[3]); *(LAS u32x2*)p = w; }
}

template <bool DUMMY>
__device__ __forceinline__ void rwkv_stage_x(Frame& F, int li, unsigned long long& xacc) {
    using namespace rw;
    unsigned long long xt0 = 0;
#define TSX(k) do { if (MK_XA == (k)) xt0 = __builtin_amdgcn_s_memrealtime(); if (MK_XB == (k)) xacc += __builtin_amdgcn_s_memrealtime() - xt0; } while (0)
    const int o = li >> 1;
    LAS unsigned char* L = F.lds;
    LAS bf16_t* At = (LAS bf16_t*)(L + O_AT); LAS bf16_t* Rt = (LAS bf16_t*)(L + O_RT); LAS bf16_t* E = (LAS bf16_t*)(L + O_E); LAS bf16_t* ET = (LAS bf16_t*)(L + O_ET); LAS bf16_t* AM = (LAS bf16_t*)(L + O_AM);
    LAS bf16_t* X0T = (LAS bf16_t*)(L + O_X0); LAS float* Lf = (LAS float*)(L + O_LF); LAS bf16_t* Mm = (LAS bf16_t*)(L + O_MM); LAS bf16_t* NN = (LAS bf16_t*)(L + O_NN); LAS float* CS = (LAS float*)(L + O_NN);
    LAS bf16_t* Pc = (LAS bf16_t*)(L + O_PC); LAS bf16_t* Gc = (LAS bf16_t*)(L + O_GC); LAS float* gamC = (LAS float*)(L + O_SM); LAS float* SEGT = gamC + 64; LAS float* PRM = gamC + 64 + 1024;
    LAS bf16_t* Tm = At; LAS bf16_t* Qh = AM; LAS bf16_t* PT = AM + 64 * S64; LAS bf16_t* WT = Mm;
    GAS bf16_t* Z = (GAS bf16_t*)(F.ws + WS_Z); const GAS bf16_t* L1g = (const GAS bf16_t*)(F.ws + WS_L1); GAS bf16_t* VF = (GAS bf16_t*)(F.ws + WS_VF);
    const GAS bf16_t* W2T = (const GAS bf16_t*)(F.ws + WS_LORA2); const GAS bf16_t* A2T = W2T + 1024 * 64; const GAS bf16_t* V2T = A2T + 1024 * 64;
    GAS bf16_t* PG = (GAS bf16_t*)(F.H); GAS float* BON = (GAS float*)(F.ws + WS_BON);
    const float* w0p = F.in[12] + o * D; const float* a0p = F.in[15] + o * D; const float* v0p = F.in[18]; const float* kkp = F.in[21] + o * D; const float* kap = F.in[22] + o * D; const float* rkp = F.in[23] + o * D;
    f32x4 nlw[2], nla[2], nlv[2]; unsigned nr[4], nk[4], nv[4], nvf[4];
    bf16x8 fwa[4], fwb[2], faa[4], fab[2], fva[2], fvb;
    auto fetch_issue = [&](int u2, int c2, int tid2) {
        const int bh2 = u2 & 31, blk2 = u2 >> 5, b2 = bh2 >> 4, h2 = bh2 & 15; const size_t rows2 = (size_t)b2 * SEQ + (size_t)blk2 * 128 + 64 * c2;
        const int lane2 = tid2 & 63, fr2 = lane2 & 15, g2 = lane2 >> 4; int wave2 = F.wave; asm volatile("" : "+s"(wave2));
        const int nt2 = wave2 & 3;
#pragma unroll
        for (int ti = 0; ti < 2; ++ti) { const int mt2 = ((wave2 + 8 * ti) >> 2); const GAS bf16_t* ap = L1g + (rows2 + mt2 * 16 + fr2) * 256 + 8 * g2;
            fwa[ti * 2] = ld8(ap); fwa[ti * 2 + 1] = ld8(ap + 32); faa[ti * 2] = ld8(ap + 64); faa[ti * 2 + 1] = ld8(ap + 96); if (o) fva[ti] = ld8(ap + 128); }
        { const GAS bf16_t* bp = W2T + ((size_t)h2 * 64 + nt2 * 16 + fr2) * 64 + 8 * g2; fwb[0] = ld8(bp); fwb[1] = ld8(bp + 32); }
        { const GAS bf16_t* bp = A2T + ((size_t)h2 * 64 + nt2 * 16 + fr2) * 64 + 8 * g2; fab[0] = ld8(bp); fab[1] = ld8(bp + 32); }
        if (o) fvb = ld8(V2T + ((size_t)h2 * 64 + nt2 * 16 + fr2) * 32 + 8 * g2);
        const int q2 = wave2 * 2 + (lane2 >> 5), cp2 = lane2 & 31;
#pragma unroll
        for (int j = 0; j < 4; ++j) { const size_t prow2 = rows2 + 4 * q2 + j; const GAS unsigned* zp2 = (const GAS unsigned*)(Z + prow2 * ZW + h2 * 64 + 2 * cp2);
            nr[j] = zp2[0]; nk[j] = zp2[512]; nv[j] = zp2[1024]; nvf[j] = o ? *(const GAS unsigned*)(VF + prow2 * D + h2 * 64 + 2 * cp2) : 0u; }
    };
    auto fetch_compute = [&]() {
#pragma unroll
        for (int ti = 0; ti < 2; ++ti) { const f32x4 z4 = {0.f, 0.f, 0.f, 0.f};
            nlw[ti] = __builtin_amdgcn_mfma_f32_16x16x32_bf16(fwa[ti * 2 + 1], fwb[1], __builtin_amdgcn_mfma_f32_16x16x32_bf16(fwa[ti * 2], fwb[0], z4, 0, 0, 0), 0, 0, 0);
            nla[ti] = __builtin_amdgcn_mfma_f32_16x16x32_bf16(faa[ti * 2 + 1], fab[1], __builtin_amdgcn_mfma_f32_16x16x32_bf16(faa[ti * 2], fab[0], z4, 0, 0, 0), 0, 0, 0);
            if (o) nlv[ti] = __builtin_amdgcn_mfma_f32_16x16x32_bf16(fva[ti], fvb, z4, 0, 0, 0); }
    };
    { F.retid(); int t0 = F.tid; asm volatile("" : "+v"(t0)); fetch_issue(F.vcu, 0, t0); fetch_compute(); }
#pragma unroll 1
    for (int u = F.vcu; u < 2048; u += F.G) {
        const int bh = u & 31, blk = u >> 5, b = bh >> 4, h = bh & 15; const size_t row0 = (size_t)b * SEQ + (size_t)blk * 128;
        F.retid(); int tid = F.tid; asm volatile("" : "+v"(tid));
        __syncthreads();
        if (tid < 384) { const int a_ = tid >> 6, ch = tid & 63; const float* src = a_ == 0 ? w0p : a_ == 1 ? a0p : a_ == 2 ? v0p : a_ == 3 ? kkp : a_ == 4 ? kap : rkp; PRM[tid] = src[h * 64 + ch]; }
        for (int e = tid; e < 64 * 64; e += 512) { const int i = e >> 6, j = e & 63; Pc[i * S64 + j] = (i == j) ? (bf16_t)0x3f80 : (bf16_t)0; Gc[i * S64 + j] = 0; }
#pragma unroll 1
        for (int c = 0; c < 2; ++c) {
            const size_t rows = row0 + 64 * c;
            asm volatile("" : "+v"(tid));
            const int lane = tid & 63; int wave = F.wave; asm volatile("" : "+s"(wave));
            const int cp = lane & 31, q = wave * 2 + (lane >> 5), ch0 = 2 * cp;
            __syncthreads();
            TSX(0);
            unsigned cr[4], ck[4], cv[4], cvf[4];
#pragma unroll
            for (int j = 0; j < 4; ++j) { cr[j] = nr[j]; ck[j] = nk[j]; cv[j] = nv[j]; cvf[j] = nvf[j]; }
            { const int fr_ = lane & 15, g_ = lane >> 4;
#pragma unroll
              for (int ti = 0; ti < 2; ++ti) { const int tile = wave + 8 * ti, r0 = (tile >> 2) * 16 + 4 * g_, col = (tile & 3) * 16 + fr_;
#pragma unroll
                  for (int j = 0; j < 4; ++j) { Lf[(r0 + j) * LFS + col] = nlw[ti][j]; Mm[(r0 + j) * S64 + col] = bfs(nla[ti][j]); if (o) AM[(64 + r0 + j) * S64 + col] = bfs(nlv[ti][j]); } } }
            const int nu = c == 0 ? u : u + F.G, nc = c == 0 ? 1 : 0; const bool has_n = nu < 2048;
            if (has_n) fetch_issue(nu, nc, tid);
            __syncthreads();
            TSX(1);
            float pr[4][2], pkk[4][2], pkm[4][2], pb[4][2], pv[4][2], cd[4][2];
            {
                float ss[4], bon[4];
#pragma unroll
                for (int j = 0; j < 4; ++j) { const int t = 4 * q + j; ss[j] = 0.f; bon[j] = 0.f;
#pragma unroll
                    for (int e = 0; e < 2; ++e) { const int ch = ch0 + e;
                        const float r = e ? __uint_as_float(cr[j] & 0xffff0000u) : __uint_as_float(cr[j] << 16), k = e ? __uint_as_float(ck[j] & 0xffff0000u) : __uint_as_float(ck[j] << 16);
                        float v = e ? __uint_as_float(cv[j] & 0xffff0000u) : __uint_as_float(cv[j] << 16);
                        const float lw = Lf[t * LFS + ch], la = bf2f(Mm[t * S64 + ch]);
                        cd[j][e] = -0.6065306597126334f * sigmoidf_(PRM[ch] + lw);
                        const float a = sigmoidf_(PRM[64 + ch] + la);
                        if (o) { const float lv = bf2f(AM[(64 + t) * S64 + ch]); const float vf = e ? __uint_as_float(cvf[j] & 0xffff0000u) : __uint_as_float(cvf[j] << 16);
                            v = v + (vf - v) * sigmoidf_(PRM[128 + ch] + lv); v = bf2f((bf16_t)f2bf(v)); }
                        const float kr = k * PRM[192 + ch]; ss[j] += kr * kr; pkk[j][e] = kr;
                        const float km = k * (1.f + (a - 1.f) * PRM[256 + ch]); pkm[j][e] = km; pb[j][e] = a; pr[j][e] = r; pv[j][e] = v; bon[j] += r * km * PRM[320 + ch]; }
                    const size_t row = rows + t;
                    if (!DUMMY) { if (o) *(GAS unsigned*)(Z + row * ZW + 2048 + h * 64 + ch0) = pk2(pv[j][0], pv[j][1]); else *(GAS unsigned*)(VF + row * D + h * 64 + ch0) = cv[j]; } }
#pragma unroll
                for (int j = 0; j < 4; ++j) {
                    float s1 = ss[j], b1 = bon[j];
                    s1 += __shfl_xor(s1, 1); s1 += __shfl_xor(s1, 2); s1 += __shfl_xor(s1, 4); s1 += __shfl_xor(s1, 8); s1 += __shfl_xor(s1, 16);
                    b1 += __shfl_xor(b1, 1); b1 += __shfl_xor(b1, 2); b1 += __shfl_xor(b1, 4); b1 += __shfl_xor(b1, 8); b1 += __shfl_xor(b1, 16);
                    const float inv = __builtin_amdgcn_rcpf(fmaxf(sqrtf(s1), 1e-12f));
#pragma unroll
                    for (int e = 0; e < 2; ++e) { pkk[j][e] *= inv; pb[j][e] *= pkk[j][e]; }
                    if (!DUMMY && cp == 0) BON[(rows + 4 * q + j) * 16 + h] = b1; }
#pragma unroll
                for (int e = 0; e < 2; ++e) { cd[1][e] += cd[0][e]; cd[2][e] += cd[1][e]; cd[3][e] += cd[2][e]; SEGT[q * 64 + ch0 + e] = cd[3][e]; }
            }
            __syncthreads();
            TSX(3);
            {
                float pre[2] = {0.f, 0.f};
                for (int qq = 0; qq < q; ++qq) { pre[0] += SEGT[qq * 64 + ch0]; pre[1] += SEGT[qq * 64 + ch0 + 1]; }
                unsigned short at[4][2], bt[4][2], kt[4][2], rt[4][2], vt[4][2];
#pragma unroll
                for (int j = 0; j < 4; ++j)
#pragma unroll
                    for (int e = 0; e < 2; ++e) { const float g = pre[e] + cd[j][e], gp = j ? pre[e] + cd[j - 1][e] : pre[e]; const float eg = __expf(g), egp = __expf(gp), ieg = __builtin_amdgcn_rcpf(eg);
                        at[j][e] = bfs(egp * pkk[j][e]); bt[j][e] = bfs(pb[j][e] * ieg); kt[j][e] = bfs(pkm[j][e] * ieg); rt[j][e] = bfs(pr[j][e] * eg); vt[j][e] = bfs(pv[j][e]);
                        if (q == 15 && j == 3) gamC[ch0 + e] = eg; }
#pragma unroll
                for (int j = 0; j < 4; ++j) { const int t = 4 * q + j;
                    *(LAS unsigned*)(At + t * S64 + ch0) = (unsigned)at[j][0] | ((unsigned)at[j][1] << 16); *(LAS unsigned*)(Rt + t * S64 + ch0) = (unsigned)rt[j][0] | ((unsigned)rt[j][1] << 16);
                    *(LAS unsigned*)(E + t * S64 + ch0) = (unsigned)bt[j][0] | ((unsigned)bt[j][1] << 16); *(LAS unsigned*)(E + (64 + t) * S64 + ch0) = (unsigned)kt[j][0] | ((unsigned)kt[j][1] << 16); }
#pragma unroll
                for (int e = 0; e < 2; ++e) { const int ch = ch0 + e;
#define RW_Q4(x) (u32x2){(unsigned)x[0][e] | ((unsigned)x[1][e] << 16), (unsigned)x[2][e] | ((unsigned)x[3][e] << 16)}
                    *(LAS u32x2*)(AM + ch * S64 + 4 * q) = RW_Q4(at); *(LAS u32x2*)(ET + ch * S128 + 4 * q) = RW_Q4(bt); *(LAS u32x2*)(ET + ch * S128 + 64 + 4 * q) = RW_Q4(kt); *(LAS u32x2*)(X0T + ch * S128 + 64 + 4 * q) = RW_Q4(vt);
#undef RW_Q4
                }
            }
            __syncthreads();
            TSX(4);
            mm<4, 8, 2>(At, S64, E, S64, wave, lane, [&](int, int r0, int col, f32x4 a) {
                const int i = col & 63;
#pragma unroll
                for (int j = 0; j < 4; ++j) { const float v = (i < r0 + j) ? a[j] : 0.f; if (col < 64) Lf[(r0 + j) * LFS + i] = v; else Mm[(r0 + j) * S64 + i] = bfs(v); } });
            mm<4, 8, 2>(Rt, S64, E, S64, wave, lane, [&](int, int r0, int col, f32x4 a) {
                const int i = col & 63;
#pragma unroll
                for (int j = 0; j < 4; ++j) NN[(r0 + j) * S128 + col] = bfs((i <= r0 + j) ? a[j] : 0.f); });
            __syncthreads();
            TSX(5);
            mm<4, 4, 2>(Mm, S64, X0T + 64, S128, wave, lane, [&](int, int r0, int col, f32x4 a) { st4(AM + (64 + col) * S64 + r0, (f32x4){-a[0], -a[1], -a[2], -a[3]}); });
            for (int e = tid; e < 64 * 64; e += 512) { const int t = e >> 6, i = e & 63; const float lv = Lf[t * LFS + i]; const int tb = t >> 4, ib = i >> 4;
                E[t * S64 + i] = ((tb == 1 && ib == 0) || (tb == 3 && ib == 2)) ? bfs(lv) : (bf16_t)0;
                E[(64 + t) * S64 + i] = (t >= 32 && i < 32) ? bfs(lv) : (bf16_t)0;
                Tm[t * S64 + i] = 0; X0T[t * S128 + i] = 0; }
            __syncthreads();
            TSX(6);
            if (wave < 4 && lane < 16) { const int bb = wave * 16; float x[16];
#pragma unroll
                for (int r = 0; r < 16; ++r) { float s = (r == lane) ? 1.f : 0.f;
#pragma unroll
                    for (int i = 0; i < r; ++i) s -= Lf[(bb + r) * LFS + bb + i] * x[i];
                    x[r] = s; }
#pragma unroll
                for (int r = 0; r < 16; ++r) { const unsigned short xv = bfs(x[r]); Tm[(bb + r) * S64 + bb + lane] = xv; X0T[(bb + lane) * S128 + bb + r] = xv; } }
            __syncthreads();
            mm<4, 4, 2>(E, S64, X0T, S128, wave, lane, [&](int, int r0, int col, f32x4 a) { st4(Mm + col * S64 + r0, a); });
            __syncthreads();
            mm<4, 4, 2>(Tm, S64, Mm, S64, wave, lane, [&](int, int r0, int col, f32x4 a) {
                const int tb = r0 >> 4, jb = col >> 4; if ((tb == 1 && jb == 0) || (tb == 3 && jb == 2)) st4(X0T + col * S128 + r0, (f32x4){-a[0], -a[1], -a[2], -a[3]}); });
            __syncthreads();
            { const int p = tid >> 8, tt = (tid >> 4) & 15, jj = tid & 15, t = 16 * (2 * p + 1) + tt, j = 32 * p + jj; Tm[t * S64 + j] = X0T[j * S128 + t]; }
            __syncthreads();
            mm<4, 4, 2>(E + 64 * S64, S64, X0T, S128, wave, lane, [&](int, int r0, int col, f32x4 a) { st4(Mm + col * S64 + r0, a); });
            __syncthreads();
            mm<4, 4, 2>(Tm, S64, Mm, S64, wave, lane, [&](int, int r0, int col, f32x4 a) {
                if (r0 >= 32 && col < 32) {
#pragma unroll
                    for (int j = 0; j < 4; ++j) E[(r0 + j) * S64 + col] = bfs(-a[j]); } });
            __syncthreads();
            for (int e = tid; e < 32 * 32; e += 512) { const int t = 32 + (e >> 5), j = e & 31; Tm[t * S64 + j] = E[t * S64 + j]; }
            __syncthreads();
            TSX(7);
            mm<4, 8, 2>(Tm, S64, AM, S64, wave, lane, [&](int, int r0, int col, f32x4 a) { if (col < 64) st4(WT + col * S64 + r0, a); else st4(X0T + (col - 64) * S128 + r0, a); });
            __syncthreads();
            TSX(8);
            f32x4 gt[2], y0t[2];
            mm<4, 4, 2>(WT, S64, ET, S128, wave, lane, [&](int, int r0, int col, f32x4 a) { const float gc = gamC[col];
                f32x4 p;
#pragma unroll
                for (int j = 0; j < 4; ++j) p[j] = (((r0 + j) == col ? 1.f : 0.f) - a[j]) * gc;
                st4(PT + col * S64 + r0, p); });
            mm<4, 4, 4>(X0T, S128, ET, S128, wave, lane, [&](int ti, int, int col, f32x4 a) { const float gc = gamC[col]; gt[ti] = a * gc; });
            mm<4, 4, 4>(NN, S128, X0T, S128, wave, lane, [&](int ti, int, int, f32x4 a) { y0t[ti] = a; });
            mm<4, 4, 2>(NN, S128, WT, S64, wave, lane, [&](int, int r0, int col, f32x4 a) {
#pragma unroll
                for (int j = 0; j < 4; ++j) Qh[(r0 + j) * S64 + col] = bfs(bf2f(Rt[(r0 + j) * S64 + col]) - a[j]); });
            __syncthreads();
            TSX(9);
            GAS bf16_t* rslot = Z + row0 * ZW + h * 64; GAS bf16_t* kslot = rslot + 1024;
            mm<4, 4, 2>(Qh, S64, Pc, S64, wave, lane, [&](int, int r0, int col, f32x4 a) {
                const int kt_ = col >> 5, rho = col & 31, s = rho >> 4, jj = ((rho >> 3) & 1) * 4 + (rho & 3), hh = (rho >> 2) & 1;
#pragma unroll
                for (int j = 0; j < 4; ++j) { const int t = 64 * c + r0 + j, tt_ = t >> 5, ln = 32 * hh + (t & 31); const int e = ((((tt_ * 2 + kt_) * 2 + s) * 64 + ln) << 3) + jj;
                    if (!DUMMY) rslot[(size_t)(e >> 6) * ZW + (e & 63)] = bfs(a[j]); else asm volatile("" :: "v"(a[j])); } });
            mm<4, 4, 2>(Qh, S64, Gc, S64, wave, lane, [&](int ti, int r0, int col, f32x4 a) {
                const int vt_ = col >> 5, v31 = col & 31;
#pragma unroll
                for (int j = 0; j < 4; ++j) { const int t = 64 * c + r0 + j, tt_ = t >> 5, x = t & 31, hh = (x >> 2) & 1, r = (x & 3) + 4 * (x >> 3); const int e = (((tt_ * 2 + vt_) * 64 + 32 * hh + v31) << 4) + r;
                    if (!DUMMY) kslot[(size_t)(e >> 6) * ZW + (e & 63)] = bfs(a[j] + y0t[ti][j]); else asm volatile("" :: "v"(a[j] + y0t[ti][j])); } });
            f32x4 pn[2], gn[2];
            mm<4, 4, 2>(Pc, S64, PT, S64, wave, lane, [&](int ti, int, int, f32x4 a) { pn[ti] = a; });
            mm<4, 4, 2>(Gc, S64, PT, S64, wave, lane, [&](int ti, int, int, f32x4 a) { gn[ti] = a + gt[ti]; });
            if (has_n) fetch_compute();
            __syncthreads();
            { const int fr = lane & 15, g = lane >> 4;
#pragma unroll
              for (int ti = 0; ti < 2; ++ti) { const int tile = wave + 8 * ti, mt = tile >> 2, nt = tile & 3;
#pragma unroll
                  for (int j = 0; j < 4; ++j) { Pc[(mt * 16 + 4 * g + j) * S64 + nt * 16 + fr] = bfs(pn[ti][j]); Gc[(mt * 16 + 4 * g + j) * S64 + nt * 16 + fr] = bfs(gn[ti][j]); } } }
            TSX(10);
        }
        __syncthreads();
        if (!DUMMY) { GAS bf16_t* pg = PG + (size_t)u * 8192;
          { const int f = tid >> 6, ln = tid & 63, s = f & 1, kit = (f >> 1) & 1, kot = f >> 2, hh = ln >> 5, r31 = ln & 31; unsigned short w[8];
#pragma unroll
            for (int j = 0; j < 8; ++j) { const int rho = 16 * s + 8 * (j >> 2) + 4 * hh + (j & 3); w[j] = Pc[(32 * kit + rho) * S64 + 32 * kot + r31]; }
            *(GAS u32x4*)(pg + (size_t)tid * 8) = (u32x4){(unsigned)w[0] | ((unsigned)w[1] << 16), (unsigned)w[2] | ((unsigned)w[3] << 16), (unsigned)w[4] | ((unsigned)w[5] << 16), (unsigned)w[6] | ((unsigned)w[7] << 16)}; }
          { const int tile = tid >> 7, ln = (tid >> 1) & 63, half = tid & 1, kot = tile >> 1, vt_ = tile & 1, hh = ln >> 5, v31 = ln & 31; unsigned short w[8];
#pragma unroll
            for (int q = 0; q < 8; ++q) { const int r = 8 * half + q; const int ko = 32 * kot + (r & 3) + 8 * (r >> 2) + 4 * hh; w[q] = Gc[(32 * vt_ + v31) * S64 + ko]; }
            *(GAS u32x4*)(pg + 4096 + ((size_t)(tile * 64 + ln) << 4) + 8 * half) = (u32x4){(unsigned)w[0] | ((unsigned)w[1] << 16), (unsigned)w[2] | ((unsigned)w[3] << 16), (unsigned)w[4] | ((unsigned)w[5] << 16), (unsigned)w[6] | ((unsigned)w[7] << 16)}; } }
    }
    __syncthreads();
}

__device__ __forceinline__ void rwkv_stage_y(Frame& F, const int bx) {
    const int lane = F.lane, wave = F.wave, bh = bx, vt = wave >> 2; const bool st = ((wave & 3) == 0);
    const bf16_t* PG = (const bf16_t*)(F.H); u32x4* SB = (u32x4*)(F.ws + WS_SB);
    LAS bf16x8* pgbuf = (LAS bf16x8*)F.lds;
    f32x16 X0, X1;
#pragma unroll
    for (int r = 0; r < 16; ++r) { X0[r] = 0.f; X1[r] = 0.f; }
    bf16x8 Ra0, Ra1, Rb0, Rb1, Rc0, Rc1;
    auto issue = [&](bf16x8& r0, bf16x8& r1, int blk) { const bf16_t* pg = PG + (size_t)(blk * 32 + bh) * 8192;
        r0 = ld8p(pg + (((size_t)(wave * 2 + 0) * 64 + lane) << 3)); r1 = ld8p(pg + (((size_t)(wave * 2 + 1) * 64 + lane) << 3)); };
    auto step = [&](bf16x8& c0, bf16x8& c1, bf16x8& n0r, bf16x8& n1r, int blk) {
        const bf16x8 nga = n0r, ngb = n1r;
        issue(c0, c1, blk + 3 < 64 ? blk + 3 : 63);
        asm volatile("s_waitcnt lgkmcnt(0)" ::: "memory"); __builtin_amdgcn_s_barrier(); asm volatile("" ::: "memory");
        pgbuf[((blk + 1) & 1) * 1024 + (wave * 2 + 0) * 64 + lane] = nga; pgbuf[((blk + 1) & 1) * 1024 + (wave * 2 + 1) * 64 + lane] = ngb;
        if (st) {
            u32x4 xb[4];
#pragma unroll
            for (int s = 0; s < 2; ++s) {
                xb[s] = (u32x4){cvt_pk_bf16(X0[8 * s], X0[8 * s + 1]), cvt_pk_bf16(X0[8 * s + 2], X0[8 * s + 3]), cvt_pk_bf16(X0[8 * s + 4], X0[8 * s + 5]), cvt_pk_bf16(X0[8 * s + 6], X0[8 * s + 7])};
                xb[2 + s] = (u32x4){cvt_pk_bf16(X1[8 * s], X1[8 * s + 1]), cvt_pk_bf16(X1[8 * s + 2], X1[8 * s + 3]), cvt_pk_bf16(X1[8 * s + 4], X1[8 * s + 5]), cvt_pk_bf16(X1[8 * s + 6], X1[8 * s + 7])}; }
            u32x4* sb = SB + ((size_t)(blk * 32 + bh) * 8 + vt * 4) * 64 + lane;
#pragma unroll
            for (int q = 0; q < 4; ++q) sb[q * 64] = xb[q];
            const LAS bf16x8* pb = pgbuf + (blk & 1) * 1024;
            f32x16 n0, n1;
            { const bf16x8 c0a = pb[512 + ((0 * 2 + vt) * 64 + lane) * 2], c0b = pb[512 + ((0 * 2 + vt) * 64 + lane) * 2 + 1], c1a = pb[512 + ((1 * 2 + vt) * 64 + lane) * 2], c1b = pb[512 + ((1 * 2 + vt) * 64 + lane) * 2 + 1];
#pragma unroll
              for (int r = 0; r < 8; ++r) { n0[r] = bf2f((bf16_t)c0a[r]); n0[8 + r] = bf2f((bf16_t)c0b[r]); n1[r] = bf2f((bf16_t)c1a[r]); n1[8 + r] = bf2f((bf16_t)c1b[r]); } }
#pragma unroll
            for (int q = 0; q < 4; ++q) {
                n0 = __builtin_amdgcn_mfma_f32_32x32x16_bf16(pb[q * 64 + lane], __builtin_bit_cast(bf16x8, xb[q]), n0, 0, 0, 0);
                n1 = __builtin_amdgcn_mfma_f32_32x32x16_bf16(pb[(4 + q) * 64 + lane], __builtin_bit_cast(bf16x8, xb[q]), n1, 0, 0, 0); }
            X0 = n0; X1 = n1;
        }
    };
    issue(Ra0, Ra1, 0); issue(Rb0, Rb1, 1); issue(Rc0, Rc1, 2);
    pgbuf[(wave * 2 + 0) * 64 + lane] = Ra0; pgbuf[(wave * 2 + 1) * 64 + lane] = Ra1;
#pragma unroll 1
    for (int blk = 0; blk < 63; blk += 3) { step(Ra0, Ra1, Rb0, Rb1, blk); step(Rb0, Rb1, Rc0, Rc1, blk + 1); step(Rc0, Rc1, Ra0, Ra1, blk + 2); }
    step(Ra0, Ra1, Rb0, Rb1, 63);
    __syncthreads();
}

template <bool DUMMY>
__device__ __forceinline__ void rwkv_stage_z(Frame& F, int li) {
    const int o = li >> 1;
    bf16_t* Z = (bf16_t*)(F.ws + WS_Z); const float* BON = (const float*)(F.ws + WS_BON); const u32x4* SB = (const u32x4*)(F.ws + WS_SB);
    const float* lgp = F.in[24] + o * D; const float* lbp = F.in[25] + o * D;
    LAS float* tile = (LAS float*)(F.lds + F.wave * 9216);
    int lane_ = F.lane;
#pragma unroll 1
    for (int w = F.vcu * 8 + F.wave; w < 8192; w += F.G * 8) {
        asm volatile("" : "+v"(lane_)); const int lane = lane_, v31 = lane & 31, hh = lane >> 5, tl = lane >> 1, hf = lane & 1;
        const int u = w >> 2, tt = w & 3, bh = u & 31, blk = u >> 5, b = bh >> 4, h = bh & 15; const size_t row0 = (size_t)b * SEQ + (size_t)blk * 128;
        const bf16_t* rslot = Z + row0 * ZW + h * 64; const bf16_t* kslot = rslot + 1024;
        const size_t row = row0 + 32 * tt + tl; bf16_t* zp = Z + row * ZW + h * 64 + 32 * hf;
        bf16x8 vv[4], gg[4];
#pragma unroll
        for (int q = 0; q < 4; ++q) { vv[q] = ld8p(zp + 2048 + 8 * q); gg[q] = ld8p(zp + 3072 + 8 * q); }
        const float bon = BON[row * 16 + h];
        bf16x8 qf[4]; u32x4 xb[2][4];
#pragma unroll
        for (int q = 0; q < 4; ++q) { const int e = (((tt * 4 + q) * 64 + lane) << 3); qf[q] = ld8p(rslot + (size_t)(e >> 6) * ZW + (e & 63)); }
#pragma unroll
        for (int vt = 0; vt < 2; ++vt)
#pragma unroll
            for (int q = 0; q < 4; ++q) xb[vt][q] = SB[((size_t)u * 8 + vt * 4 + q) * 64 + lane];
#pragma unroll
        for (int vt = 0; vt < 2; ++vt) { const int e0 = ((tt * 2 + vt) * 64 + lane) << 4; const bf16_t* yp = kslot + (size_t)(e0 >> 6) * ZW + (e0 & 63); const bf16x8 ya = ld8p(yp), yb = ld8p(yp + 8);
            f32x16 acc;
#pragma unroll
            for (int r = 0; r < 8; ++r) { acc[r] = bf2f((bf16_t)ya[r]); acc[8 + r] = bf2f((bf16_t)yb[r]); }
#pragma unroll
            for (int q = 0; q < 4; ++q) acc = __builtin_amdgcn_mfma_f32_32x32x16_bf16(qf[q], __builtin_bit_cast(bf16x8, xb[vt][q]), acc, 0, 0, 0);
#pragma unroll
            for (int r = 0; r < 16; ++r) tile[((r & 3) + 8 * (r >> 2) + 4 * hh) * 72 + 36 * vt + v31] = acc[r]; }
        LDS_WAIT(); asm volatile("" ::: "memory");
        float y[32]; float sm = 0.f;
#pragma unroll
        for (int q = 0; q < 8; ++q) { const f32x4 t4 = *(const LAS f32x4*)(tile + tl * 72 + 36 * hf + 4 * q); y[4 * q] = t4[0]; y[4 * q + 1] = t4[1]; y[4 * q + 2] = t4[2]; y[4 * q + 3] = t4[3]; sm += (t4[0] + t4[1]) + (t4[2] + t4[3]); }
        sm += __shfl_xor(sm, 1);
        const float mu = sm * (1.f / 64.f); float qq = 0.f;
#pragma unroll
        for (int j = 0; j < 32; ++j) { y[j] -= mu; qq += y[j] * y[j]; }
        qq += __shfl_xor(qq, 1);
        const float rsd = rsqrtf(qq * (1.f / 64.f) + 64e-5f);
        const float* lg = lgp + h * 64 + 32 * hf; const float* lb = lbp + h * 64 + 32 * hf;
#pragma unroll
        for (int q = 0; q < 4; ++q) { float ov[8];
#pragma unroll
            for (int j = 0; j < 8; ++j) { const int c = 8 * q + j; const float va = bf2f((bf16_t)vv[q][j]), ga = bf2f((bf16_t)gg[q][j]); ov[j] = (y[c] * rsd * lg[c] + lb[c] + bon * va) * siluf_(ga); }
            const u32x4 wv = {cvt_pk_bf16(ov[0], ov[1]), cvt_pk_bf16(ov[2], ov[3]), cvt_pk_bf16(ov[4], ov[5]), cvt_pk_bf16(ov[6], ov[7])};
            if (!DUMMY) *(u32x4*)(zp + 3072 + 8 * q) = wv; else asm volatile("" :: "v"(wv)); }
        LDS_WAIT(); asm volatile("" ::: "memory");
    }
}

enum { PH_P0 = 0, PH_FINAL = 27, N_PHASES = 28 };
#define IN(k) (lo <= (k) && (k) < hi)
#define TSG(k) do { if (LI == 0) { if (MK_GA == (k)) tA = __builtin_amdgcn_s_memrealtime(); if (MK_GB == (k)) tB = __builtin_amdgcn_s_memrealtime(); } } while (0)
#define TS(k) do { if (MK_TPA == (k)) tA = __builtin_amdgcn_s_memrealtime(); if (MK_TPB == (k)) tB = __builtin_amdgcn_s_memrealtime(); } while (0)
#if MK_MULTI
#define SEAM(k) do { } while (0)
#else
#define SEAM(k) do { if (IN(k) && IN((k) + 1)) xcd_barrier(bar); } while (0)
#endif
template <int LI>
__device__ __forceinline__ void run_layer(Frame& F, const XcdBarrier& bar, const int lo, const int hi, const int bx, unsigned long long& tA, unsigned long long& tB) {
    constexpr bool even = (LI & 1) == 0;
    constexpr int base = 1 + (LI / 2) * 13 + (even ? 0 : 6);
    bf16_t* Zp = (bf16_t*)(F.ws + WS_Z);
    if constexpr (even) {
        TS(base); if (IN(base)) { F.retid(); pg8::StaticOrder S; S.init(64, 16, F.G, bx);
            pg8::Gemm g{(const bf16_t*)(F.ws + WS_HB), (const bf16_t*)(F.ws + WS_WIN)};
            EpiEvenIn E{Zp, F.ssq(LI), (bf16_t*)(F.ws + WS_VTA), (bf16_t*)(F.ws + WS_VTB), (bf16_t*)(F.ws + WS_KT)};
            if (MK_PROBE == 1) pg8::gemm_phase<EpiEvenIn, true, D, D, 1 << 20, 0, 0>(F.lds, F.tid, g, S, E);
            pg8::gemm_phase<EpiEvenIn, true, D, D, 1 << 20, 0, 0>(F.lds, F.tid, g, S, E); }
        SEAM(base);
        TS(base + 1); if (IN(base + 1)) { F.retid();
            TSG(0); conv_wrest(F, LI); TSG(1);
            if constexpr (LI < 3) conv_win_odd(F, LI + 1);
            TSG(2);
            if (MK_PROBE == 5) { for (int u = F.vcu * 8 + F.wave; u < 4096; u += F.G * 8) ret_stage_a(F, u);
                for (int u = F.vcu * 8 + F.wave; u < 2048; u += F.G * 8) sb_unit<true>(F, u >> 8, u & 255); }
            for (int u = F.vcu * 8 + F.wave; u < 4096; u += F.G * 8) ret_stage_a(F, u);
            __syncthreads(); TSG(3);
            for (int u = F.vcu * 8 + F.wave; u < 2048; u += F.G * 8) sb_unit<false>(F, u >> 8, u & 255);
            __syncthreads(); TSG(4); }
        SEAM(base + 1);
        TS(base + 2); if (IN(base + 2)) { F.retid(); ret_stage_b(F); }
        SEAM(base + 2);
        TS(base + 3); if (IN(base + 3)) { F.retid(); const float* gng = F.in[8] + (LI >> 1) * 512;
            if (MK_PROBE == 6) for (int u = F.vcu * 8 + F.wave; u < 2048; u += F.G * 8) ret_stage_c<true>(F, u, gng);
            for (int u = F.vcu * 8 + F.wave; u < 2048; u += F.G * 8) ret_stage_c<false>(F, u, gng); }
        SEAM(base + 3);
        TS(base + 4); if (IN(base + 4)) { F.retid(); pg8::StaticOrder S; S.init(64, 4, F.G, bx);
            { pg8::Gemm g{(const bf16_t*)(F.ws + WS_PB), (const bf16_t*)(F.ws + WS_WPROJ)};
              EpiStore E{Zp, ZE}; pg8::gemm_phase<EpiStore, false, PLE, PLE, 1 << 20, 0, 0>(F.lds, F.tid, g, S, E); }
            { pg8::Gemm g{Zp + 1024, (const bf16_t*)(F.ws + WS_WOUT)};
              EpiResid E{(const bf16_t*)(F.ws + WS_HB), Zp + 1536, ZE}; pg8::gemm_phase<EpiResid, false, ZE, D, 8, (long)((2560 - 1024) * 2), 0>(F.lds, F.tid, g, S, E); } }
        SEAM(base + 4);
        TS(base + 5); if (IN(base + 5)) { F.retid(); pg8::StaticOrder S; S.init(64, 4, F.G, bx);
            pg8::Gemm g{Zp + 1536, (const bf16_t*)(F.ws + WS_WGATE)};
            EpiGate E{Zp + 1536, ZE, Zp, ZE, (bf16_t*)(F.ws + WS_HB), F.ssq(LI + 1)};
            pg8::gemm_phase<EpiGate, false, ZE, D, 1 << 20, 0, 0>(F.lds, F.tid, g, S, E); }
        SEAM(base + 5);
    } else {
        TS(base); if (IN(base)) { F.retid(); conv_lora2(F, LI); rows_norm(F, LI); }
        SEAM(base);
        TS(base + 1); if (IN(base + 1)) { F.retid(); pg8::StaticOrder S; S.init(64, 17, F.G, bx);
            pg8::Gemm g{(const bf16_t*)(F.H) + D, (const bf16_t*)(F.ws + WS_WIN)};
            EpiOddIn E{Zp, (bf16_t*)(F.ws + WS_L1)};
            if (MK_PROBE == 2) pg8::gemm_phase<EpiOddIn, true, D, 2048, 16, -(long)(D * 2), (long)(D * 2)>(F.lds, F.tid, g, S, E);
            pg8::gemm_phase<EpiOddIn, true, D, 2048, 16, -(long)(D * 2), (long)(D * 2)>(F.lds, F.tid, g, S, E); }
        SEAM(base + 1);
        TS(base + 2); if (IN(base + 2)) { F.retid();
            conv_wrest(F, LI);
            __syncthreads();
            { unsigned long long xa = 0; rwkv_stage_x<false>(F, LI, xa); if (LI == 1 && MK_XA >= 0) { tA = 0; tB = xa; } } }
        SEAM(base + 2);
        TS(base + 3); if (IN(base + 3)) { F.retid();
            if (bx < 32) rwkv_stage_y(F, bx);
            else { pg8::StaticOrder S; S.init(64, 4, F.G - 32, bx - 32);
                pg8::Gemm g{(const bf16_t*)(F.ws + WS_PB), (const bf16_t*)(F.ws + WS_WPROJ)};
                EpiStore E{(bf16_t*)(F.H) + (size_t)16 * 1024 * 1024, D}; pg8::gemm_phase<EpiStore, false, PLE, PLE, 1 << 20, 0, 0>(F.lds, F.tid, g, S, E); } }
        SEAM(base + 3);
        TS(base + 4); if (IN(base + 4)) { F.retid(); rwkv_stage_z<false>(F, LI); }
        SEAM(base + 4);
        TS(base + 5); if (IN(base + 5)) { F.retid(); pg8::StaticOrder S; S.init(64, 4, F.G, bx);
            if constexpr (LI < 3) { conv_win_even(F, LI + 1); __syncthreads(); }
            { pg8::Gemm g{Zp + 3072, (const bf16_t*)(F.ws + WS_WOUT)};
              EpiResid E{(const bf16_t*)(F.ws + WS_HB), Zp + 2048, ZW}; pg8::gemm_phase<EpiResid, false, ZW, D, 1 << 20, 0, 0>(F.lds, F.tid, g, S, E); } }
        SEAM(base + 5);
        TS(base + 6); if (IN(base + 6)) { F.retid(); pg8::StaticOrder S; S.init(64, 4, F.G, bx);
            pg8::Gemm g{Zp + 2048, (const bf16_t*)(F.ws + WS_WGATE)};
            EpiGate E{Zp + 2048, ZW, (const bf16_t*)(F.H) + (size_t)16 * 1024 * 1024, D, (bf16_t*)(F.ws + WS_HB), F.ssq(LI + 1)};
            pg8::gemm_phase<EpiGate, false, ZW, D, 1 << 20, 0, 0>(F.lds, F.tid, g, S, E); }
        SEAM(base + 6);
    }
}
__global__ void __launch_bounds__(512, 2) mk_fwd(Args args) {
    extern __shared__ __attribute__((aligned(16))) unsigned char lds_raw[];
    Frame F;
    F.lds = (LAS unsigned char*)lds_raw; F.ldsg = lds_raw;
    F.tid = threadIdx.x; F.lane = F.tid & 63; F.wave = __builtin_amdgcn_readfirstlane(F.tid >> 6);
    F.G = gridDim.x; const int bx = blockIdx.x; F.vcu = (F.G % 8 == 0) ? (bx % 8) * (F.G / 8) + bx / 8 : bx;
    F.H = args.out; F.ws = args.ws;
    volatile LAS unsigned* MISC = (volatile LAS unsigned*)(F.lds + MISC_OFF);
    for (int u = F.tid; u < 128; u += 512) ((LAS unsigned*)(F.lds + MISC_OFF))[u] = 0u;
    __syncthreads();
    XcdBarrier bar; bar.bar = (unsigned*)(F.ws + WS_CTL) + 4096; bar.x = 0; bar.st = nullptr;
#if !MK_MULTI
    bar = xcd_barrier_post((unsigned*)(F.ws + WS_CTL) + 4096, MISC + 8);
#endif
    const int lo = args.ph_lo, hi = args.ph_hi;
    if (IN(PH_P0)) { F.retid(); rows_p0(F); conv_win_even(F, 0); }
#if !MK_MULTI
    if (IN(0) && IN(1)) { VM_WAIT(); cg::this_grid().sync(); }
#endif
    unsigned long long tA = 0, tB = 0;
    TS(0);
    run_layer<0>(F, bar, lo, hi, bx, tA, tB);
    run_layer<1>(F, bar, lo, hi, bx, tA, tB);
    run_layer<2>(F, bar, lo, hi, bx, tA, tB);
    run_layer<3>(F, bar, lo, hi, bx, tA, tB);
    TS(PH_FINAL);
    if (IN(PH_FINAL)) { F.retid(); rows_final(F); }
    TS(PH_FINAL + 1);
    if ((MK_TPA >= 0 || MK_XA >= 0 || MK_GA >= 0) && blockIdx.x == 0 && threadIdx.x == 0) { const unsigned long long t0 = __builtin_amdgcn_s_memrealtime(), span = 4ull * (tB - tA); while (__builtin_amdgcn_s_memrealtime() - t0 < span) __builtin_amdgcn_s_sleep(8); }
}

extern "C" void kernel_launch(void* const* d_in, const int* in_sizes, int n_in, void* d_out, int out_size, void* d_ws, size_t ws_size, hipStream_t stream) {
    static int grid = 0;
    if (grid == 0) {
        int dev = 0, cus = 0, per_cu = 0;
        (void)hipGetDevice(&dev); (void)hipDeviceGetAttribute(&cus, hipDeviceAttributeMultiprocessorCount, dev);
        (void)hipFuncSetAttribute((const void*)mk_fwd, hipFuncAttributeMaxDynamicSharedMemorySize, LDS_BYTES);
        (void)hipOccupancyMaxActiveBlocksPerMultiprocessor(&per_cu, (const void*)mk_fwd, 512, LDS_BYTES);
        if (per_cu < 1) per_cu = 1;
        grid = cus * 1;
        if (n_in != 26 || ws_size < WS_END) fprintf(stderr, "kernel_launch: unexpected n_in %d / ws %zu\n", n_in, ws_size);
        (void)hipGetLastError();
    }
    (void)hipMemsetAsync((char*)d_ws + WS_CTL, 0, CTL_BYTES, stream);
    Args a{};
    for (int i = 0; i < 26; ++i) a.in[i] = (const float*)d_in[i];
    a.out = (float*)d_out; a.ws = (unsigned char*)d_ws;
#if MK_MULTI
    for (int ph = 0; ph < N_PHASES; ++ph) { a.ph_lo = ph; a.ph_hi = ph + 1; hipLaunchKernelGGL(mk_fwd, dim3(grid), dim3(512), LDS_BYTES, stream, a); }
#else
    a.ph_lo = 0; a.ph_hi = N_PHASES;
    void* kargs[] = {&a};
    hipError_t e = hipLaunchCooperativeKernel((const void*)mk_fwd, dim3(grid), dim3(512), kargs, LDS_BYTES, stream);
    if (e != hipSuccess) fprintf(stderr, "cooperative launch failed: %s (grid %d)\n", hipGetErrorString(e), grid);
#endif
}
```

```cpp
#include <hip/hip_runtime.h>
#include <hip/hip_cooperative_groups.h>
#include <cstdint>
#include <cstdio>
namespace cg = cooperative_groups;

#ifndef MK_PROBE
#define MK_PROBE 0
#endif
#ifndef MK_TPA
#define MK_TPA -1
#define MK_TPB -1
#endif
#ifndef MK_XA
#define MK_XA -1
#define MK_XB -1
#endif
#ifndef MK_GA
#define MK_GA -1
#define MK_GB -1
#endif
#ifndef MK_MULTI
#define MK_MULTI 0
#endif

#define LAS __attribute__((address_space(3)))
#define GAS __attribute__((address_space(1)))
typedef unsigned short bf16_t;
typedef short bf16x8 __attribute__((ext_vector_type(8)));
typedef float f32x4 __attribute__((ext_vector_type(4)));
typedef float f32x2 __attribute__((ext_vector_type(2)));
typedef unsigned u32x4 __attribute__((ext_vector_type(4)));
typedef unsigned u32x2 __attribute__((ext_vector_type(2)));

constexpr int D = 1024, BATCH = 2, SEQ = 8192, T = BATCH * SEQ, PLE = 256, ZW = 4096, ZE = 3072;
constexpr float QK_SCALE = 0.08838834764831845f;

__device__ __forceinline__ float bf2f(bf16_t v) { return __uint_as_float(((unsigned)v) << 16); }
__device__ __forceinline__ unsigned f2bf(float f) { unsigned u = __float_as_uint(f); return (u + 0x7fffu + ((u >> 16) & 1u)) >> 16; }
__device__ __forceinline__ unsigned pk2(float lo, float hi) { return f2bf(lo) | (f2bf(hi) << 16); }
typedef __bf16 bf16x2_t __attribute__((ext_vector_type(2)));
__device__ __forceinline__ unsigned cvt_pk_bf16(float lo, float hi) { f32x2 v = {lo, hi}; bf16x2_t b = __builtin_convertvector(v, bf16x2_t); return __builtin_bit_cast(unsigned, b); }
__device__ __forceinline__ float wave_sum(float v) {
#pragma unroll
    for (int o = 1; o < 64; o <<= 1) v += __shfl_xor(v, o);
    return v;
}
__device__ __forceinline__ float sigmoidf_(float x) { return __builtin_amdgcn_rcpf(1.f + __expf(-x)); }
__device__ __forceinline__ float siluf_(float x) { return x * __builtin_amdgcn_rcpf(1.f + __expf(-x)); }
__device__ __forceinline__ float softplusf_(float x) { return x > 20.f ? x : log1pf(expf(x)); }
__device__ __forceinline__ float logsigf_(float x) { return -(x < -20.f ? -x : log1pf(expf(-x))); }
__device__ __forceinline__ float ssq_sum(const float* sq, int row) { const f32x4* p = (const f32x4*)(sq + (size_t)row * 16); const f32x4 a = p[0], b = p[1], c = p[2], d = p[3];
    return (((a[0] + a[1]) + (a[2] + a[3])) + ((b[0] + b[1]) + (b[2] + b[3]))) + (((c[0] + c[1]) + (c[2] + c[3])) + ((d[0] + d[1]) + (d[2] + d[3]))); }
#define LDS_WAIT() asm volatile("s_waitcnt lgkmcnt(0)" ::: "memory")
#define VM_WAIT() asm volatile("s_waitcnt vmcnt(0)" ::: "memory")

namespace pg8 {
constexpr int BM = 256, BK = 64, HALF = 128, HTB = HALF * BK * 2, STAGE_BYTES = 8 * HTB, NXCD = 8, WGM = 8;
__host__ __device__ __forceinline__ int lds_byte(int r, int c) { const int st = (r >> 4) * 2 + (c >> 5), rr = r & 15, cc = c & 31, ob = rr * 64 + cc * 2; return st * 1024 + (ob ^ (((ob >> 9) & 1) << 5)); }
__host__ __device__ __forceinline__ void stage_rc(int b, int& R, int& C) { const int st = b / 1024, sb = b % 1024, swz = sb ^ (((sb >> 9) & 1) << 5); R = (st >> 1) * 16 + swz / 64; C = (st & 1) * 32 + (swz % 64) / 2; }
__host__ __device__ __forceinline__ int perm32(int rho) { const int n = rho >> 4, i = rho & 15; return 8 * (i >> 2) + 4 * n + (i & 3); }
struct Unit { int pm, pn; };
struct Gemm { const bf16_t* A; const bf16_t* Bt; };
struct StaticOrder {
    int nM, nN, nwg, G, c;
    __device__ void init(int nM_, int nN_, int G_, int c_) { nM = nM_; nN = nN_; nwg = nM * nN; G = G_; c = c_; }
    __device__ bool next(int i, Unit& u) const {
        const long L = (long)i * G + c; if (L >= nwg) return false;
        int wgid = (int)L; { const int q = nwg / NXCD, r = nwg % NXCD, xcd = wgid % NXCD, off = wgid / NXCD; wgid = (xcd < r ? xcd * (q + 1) : r * (q + 1) + (xcd - r) * q) + off; }
        const int nig = WGM * nN, gid = wgid / nig, fm = gid * WGM, gsz = (nM - fm) < WGM ? (nM - fm) : WGM;
        u.pm = fm + ((wgid % nig) % gsz); u.pn = (wgid % nig) / gsz; return true;
    }
};
template <class Epi, bool ALIGN_EPI, int LDA, int KK, int TSPLIT, long ASHIFT, long BROW>
__device__ __forceinline__ void gemm_phase(LAS unsigned char* lds, const int tid_in, const Gemm g, const StaticOrder& S, const Epi& E) {
    int tid = tid_in; asm volatile("" : "+v"(tid));
    const int wid = __builtin_amdgcn_readfirstlane(tid >> 6), lane = tid & 63, wr = wid >> 2, wc = wid & 3, fr = lane & 15, fq = lane >> 4;
    constexpr int K = KK, nt = K / BK, lda = LDA, tsplit = TSPLIT; constexpr long ashift = ASHIFT;
    unsigned voffA[2], voffB[2];
#pragma unroll
    for (int i = 0; i < 2; ++i) { int R, C; stage_rc(tid * 16 + i * 8192, R, C); const int Rb = (R & ~31) + perm32(R & 31);
        voffA[i] = (unsigned)(R * lda + C) * 2u; voffB[i] = (unsigned)(Rb * K + C) * 2u; }
    constexpr size_t kstep = (size_t)(BK * 2);
    constexpr size_t hstepA = (size_t)HALF * lda * 2, hstepB = (size_t)HALF * K * 2, tstepA = 2 * hstepA, tstepB = 2 * hstepB;
    const unsigned ldsw = (unsigned)wid * 1024u;
    const int aoff = lds_byte(wr * 64 + fr, fq * 8), boff = lds_byte(wc * 32 + fr, fq * 8);
#define PG8_AP(base, tt) ((base) + (((tt) < tsplit) ? (long)(tt) * 128 : ashift + (long)((tt) - tsplit) * 128))
#define PG8_ABASE(u) ((const char*)g.A + (size_t)(u).pm * tstepA + ((BROW != 0 && (u).pm >= 32) ? BROW : 0))
#define PG8_SA(b, h) (((b) * 2 + (h)) * HTB)
#define PG8_SB(b, h) ((4 + (b) * 2 + (h)) * HTB)
#define PG8_STAGE(bufoff, gbase, voff) do { const char* _gb = (const char*)(gbase); asm volatile("" : "+s"(_gb)); _Pragma("unroll") for (int _i = 0; _i < 2; ++_i) \
        __builtin_amdgcn_global_load_lds((const unsigned*)(_gb + (voff)[_i]), (LAS unsigned*)(lds + (bufoff) + ldsw + _i * 8192), 16, 0, 0); } while (0)
#define PG8_LDA(dst, b, h) do { _Pragma("unroll") for (int m = 0; m < 4; ++m) _Pragma("unroll") for (int k = 0; k < 2; ++k) dst[m][k] = *(const LAS bf16x8*)(lds + PG8_SA(b, h) + aoff + m * 2048 + k * 1024); } while (0)
#define PG8_LDB(dst, b, h) do { _Pragma("unroll") for (int n = 0; n < 2; ++n) _Pragma("unroll") for (int k = 0; k < 2; ++k) dst[n][k] = *(const LAS bf16x8*)(lds + PG8_SB(b, h) + boff + n * 2048 + k * 1024); } while (0)
#define PG8_MMA(ai, bj, At, Bt) do { __builtin_amdgcn_s_setprio(1); _Pragma("unroll") for (int m = 0; m < 4; ++m) _Pragma("unroll") for (int n = 0; n < 2; ++n) _Pragma("unroll") for (int k = 0; k < 2; ++k) \
        acc[ai][bj][m][n] = __builtin_amdgcn_mfma_f32_16x16x32_bf16(Bt[n][k], At[m][k], acc[ai][bj][m][n], 0, 0, 0); __builtin_amdgcn_s_setprio(0); } while (0)
#define PG8_WAIT_V(n) asm volatile("s_waitcnt vmcnt(" #n ")" ::: "memory")
#define PG8_WAIT_L(n) asm volatile("s_waitcnt lgkmcnt(" #n ")" ::: "memory")
#define PG8_BAR __builtin_amdgcn_s_barrier()
#define PG8_SCHED __builtin_amdgcn_sched_barrier(0)
    Unit cur, nxt; int ui = 0;
    if (!S.next(0, cur)) return;
    f32x4 acc[2][2][4][2];
#pragma unroll
    for (int a = 0; a < 2; ++a)
#pragma unroll
        for (int b = 0; b < 2; ++b)
#pragma unroll
            for (int m = 0; m < 4; ++m)
#pragma unroll
                for (int n = 0; n < 2; ++n) acc[a][b][m][n] = (f32x4){0.f, 0.f, 0.f, 0.f};
    bf16x8 At[4][2], B0[2][2], B1[2][2];
    const char* cA = PG8_ABASE(cur); const char* cB = (const char*)g.Bt + (size_t)cur.pn * tstepB;
    {
        const char* a0 = PG8_AP(cA, 0); const char* a1 = PG8_AP(cA, 1);
        PG8_STAGE(PG8_SB(0, 0), cB, voffB); PG8_STAGE(PG8_SB(0, 1), cB + hstepB, voffB); PG8_STAGE(PG8_SA(0, 0), a0, voffA); PG8_STAGE(PG8_SA(0, 1), a0 + hstepA, voffA);
        if (wr == 1) PG8_BAR;
        PG8_WAIT_V(2); PG8_BAR;
        PG8_STAGE(PG8_SB(1, 0), cB + kstep, voffB); PG8_STAGE(PG8_SA(1, 0), a1, voffA); PG8_STAGE(PG8_SB(1, 1), cB + hstepB + kstep, voffB);
        PG8_WAIT_V(6); PG8_BAR;
    }
    for (;;) {
        const bool has_next = S.next(ui + 1, nxt);
        const char* nA = has_next ? PG8_ABASE(nxt) : cA; const char* nB = has_next ? (const char*)g.Bt + (size_t)nxt.pn * tstepB : cB;
        for (int t = 0; t < nt; t += 2) {
            const bool last = (t == nt - 2);
            const char* a1 = PG8_AP(cA, t + 1);
            const char* a2 = last ? PG8_AP(nA, 0) : PG8_AP(cA, t + 2); const char* b2 = last ? nB : cB + (size_t)(t + 2) * kstep;
            const char* a3 = last ? PG8_AP(nA, 1) : PG8_AP(cA, t + 3); const char* b3 = b2 + kstep;
            PG8_LDB(B0, 0, 0); PG8_LDB(B1, 0, 1); PG8_SCHED; PG8_LDA(At, 0, 0); PG8_STAGE(PG8_SA(1, 1), a1 + hstepA, voffA);
            PG8_WAIT_V(8); PG8_WAIT_L(0); PG8_BAR; PG8_MMA(0, 0, At, B0); PG8_MMA(0, 1, At, B1); PG8_BAR; PG8_SCHED;
            PG8_LDA(At, 0, 1); PG8_STAGE(PG8_SB(0, 0), b2, voffB); PG8_STAGE(PG8_SB(0, 1), b2 + hstepB, voffB); PG8_STAGE(PG8_SA(0, 0), a2, voffA);
            PG8_WAIT_V(8); PG8_WAIT_L(0); PG8_BAR; PG8_MMA(1, 0, At, B0); PG8_MMA(1, 1, At, B1); PG8_BAR; PG8_SCHED;
            PG8_LDB(B0, 1, 0); PG8_LDB(B1, 1, 1); PG8_SCHED; PG8_LDA(At, 1, 0); PG8_STAGE(PG8_SA(0, 1), a2 + hstepA, voffA);
            PG8_WAIT_V(8); PG8_WAIT_L(0); PG8_BAR; PG8_MMA(0, 0, At, B0); PG8_MMA(0, 1, At, B1); PG8_BAR; PG8_SCHED;
            PG8_LDA(At, 1, 1); PG8_STAGE(PG8_SB(1, 0), b3, voffB); PG8_STAGE(PG8_SB(1, 1), b3 + hstepB, voffB); PG8_STAGE(PG8_SA(1, 0), a3, voffA);
            PG8_WAIT_V(8); PG8_WAIT_L(0); PG8_BAR; PG8_MMA(1, 0, At, B0); PG8_MMA(1, 1, At, B1); PG8_BAR; PG8_SCHED;
        }
        if constexpr (ALIGN_EPI) { if (wr == 0) PG8_BAR; }
        E(acc, cur, wr, wc, fr, fq);
        if (!has_next) break;
#pragma unroll
        for (int a = 0; a < 2; ++a)
#pragma unroll
            for (int b = 0; b < 2; ++b)
#pragma unroll
                for (int m = 0; m < 4; ++m)
#pragma unroll
                    for (int n = 0; n < 2; ++n) acc[a][b][m][n] = (f32x4){0.f, 0.f, 0.f, 0.f};
        cur = nxt; cA = nA; cB = nB; ++ui;
        if constexpr (ALIGN_EPI) { if (wr == 1) PG8_BAR; }
    }
    PG8_WAIT_V(0);
    if constexpr (!ALIGN_EPI) { if (wr == 0) PG8_BAR; }
    PG8_BAR;
#undef PG8_AP
#undef PG8_ABASE
#undef PG8_SA
#undef PG8_SB
#undef PG8_STAGE
#undef PG8_LDA
#undef PG8_LDB
#undef PG8_MMA
#undef PG8_WAIT_V
#undef PG8_WAIT_L
#undef PG8_BAR
#undef PG8_SCHED
}
}

template <class Fn>
__device__ __forceinline__ void epi_for(const f32x4 (&acc)[2][2][4][2], const pg8::Unit& u, int wr, int wc, int fr, int fq, Fn fn) {
#pragma unroll
    for (int ai = 0; ai < 2; ++ai)
#pragma unroll
        for (int m = 0; m < 4; ++m) { const int row = u.pm * 256 + ai * 128 + wr * 64 + m * 16 + fr;
#pragma unroll
            for (int bj = 0; bj < 2; ++bj) { const int col = u.pn * 256 + bj * 128 + wc * 32 + 8 * fq; fn(row, col, acc[ai][bj][m][0], acc[ai][bj][m][1]); }
            if (m & 1) asm volatile("" ::: "memory"); }
}
__device__ __forceinline__ u32x4 pack8(f32x4 v0, f32x4 v1) { u32x4 w; w.x = cvt_pk_bf16(v0[0], v0[1]); w.y = cvt_pk_bf16(v0[2], v0[3]); w.z = cvt_pk_bf16(v1[0], v1[1]); w.w = cvt_pk_bf16(v1[2], v1[3]); return w; }

struct EpiEvenIn {
    bf16_t* Z; const float* ssq; bf16_t* VTa; bf16_t* VTb; bf16_t* KT;
    __device__ __forceinline__ void operator()(const f32x4 (&acc)[2][2][4][2], const pg8::Unit& u, int wr, int wc, int fr, int fq) const {
        const int g = u.pn >> 1;
        epi_for(acc, u, wr, wc, fr, fq, [&](int row, int col, f32x4 v0, f32x4 v1) {
            const float rs = rsqrtf(ssq_sum(ssq, row) * (1.f / D) + 1e-6f);
            v0 = v0 * rs; v1 = v1 * rs;
            const int cg = col & 511, t = row & (SEQ - 1), b = row >> 13;
            if (g == 2 || g == 6) {
                bf16_t* p = (g == 2 ? VTa : VTb) + ((size_t)(b * 512 + cg)) * SEQ + t;
                _Pragma("unroll") for (int j = 0; j < 4; ++j) { p[(size_t)j * SEQ] = (bf16_t)f2bf(v0[j]); p[(size_t)(4 + j) * SEQ] = (bf16_t)f2bf(v1[j]); }
            } else if (g < 2) {
                const float pos = (float)t; const int i0 = (cg & 127) >> 1;
                float o[8] = {v0[0], v0[1], v0[2], v0[3], v1[0], v1[1], v1[2], v1[3]};
                _Pragma("unroll") for (int j = 0; j < 4; ++j) { const float inv = exp2f(-(float)(i0 + j) * (13.287712379549449f / 64.f));
                    float rev = pos * inv * 0.15915494309189535f; rev = rev - floorf(rev); const float sn = __builtin_amdgcn_sinf(rev), cs = __builtin_amdgcn_cosf(rev);
                    const float x1 = o[2 * j], x2 = o[2 * j + 1]; o[2 * j] = x1 * cs - x2 * sn; o[2 * j + 1] = x1 * sn + x2 * cs; }
                const float lg2 = log2f(1.f - exp2f(-5.f - (float)(cg >> 7))); const float ip1 = (float)((t & 127) + 1);
                if (g == 0) { const float f = exp2f(ip1 * lg2);
                    *(u32x4*)(Z + (size_t)row * ZE + cg) = pack8((f32x4){o[0] * f, o[1] * f, o[2] * f, o[3] * f}, (f32x4){o[4] * f, o[5] * f, o[6] * f, o[7] * f}); }
                else { const float f = exp2f(-ip1 * lg2), f2 = exp2f((128.f - ip1) * lg2);
                    *(u32x4*)(Z + (size_t)row * ZE + 512 + cg) = pack8((f32x4){o[0] * f, o[1] * f, o[2] * f, o[3] * f}, (f32x4){o[4] * f, o[5] * f, o[6] * f, o[7] * f});
                    bf16_t* p = KT + ((size_t)(b * 512 + cg)) * SEQ + t;
                    _Pragma("unroll") for (int j = 0; j < 8; ++j) p[(size_t)j * SEQ] = (bf16_t)f2bf(o[j] * f2); }
            } else {
                const int zc = (g - 1 - (g > 6 ? 1 : 0)) * 512;
                *(u32x4*)(Z + (size_t)row * ZE + zc + cg) = pack8(v0, v1);
            }
        });
    }
};
struct EpiOddIn {
    bf16_t* Z; bf16_t* L1;
    __device__ __forceinline__ void operator()(const f32x4 (&acc)[2][2][4][2], const pg8::Unit& u, int wr, int wc, int fr, int fq) const {
        if (u.pn < 16) { epi_for(acc, u, wr, wc, fr, fq, [&](int row, int col, f32x4 v0, f32x4 v1) { *(u32x4*)(Z + (size_t)row * ZW + col) = pack8(v0, v1); }); }
        else { epi_for(acc, u, wr, wc, fr, fq, [&](int row, int col, f32x4 v0, f32x4 v1) { const int c = col - 4096; if (c < 64) {
                    _Pragma("unroll") for (int j = 0; j < 4; ++j) { v0[j] = tanhf(v0[j]); v1[j] = tanhf(v1[j]); } }
                *(u32x4*)(L1 + (size_t)row * 256 + c) = pack8(v0, v1); }); }
    }
};
__device__ __forceinline__ void unpack8(const u32x4 w, f32x4& a, f32x4& b) {
    a = (f32x4){__uint_as_float(w.x << 16), __uint_as_float(w.x & 0xffff0000u), __uint_as_float(w.y << 16), __uint_as_float(w.y & 0xffff0000u)};
    b = (f32x4){__uint_as_float(w.z << 16), __uint_as_float(w.z & 0xffff0000u), __uint_as_float(w.w << 16), __uint_as_float(w.w & 0xffff0000u)}; }
struct EpiResid {
    const bf16_t* Ha; bf16_t* HB; int ldb;
    __device__ __forceinline__ void operator()(const f32x4 (&acc)[2][2][4][2], const pg8::Unit& u, int wr, int wc, int fr, int fq) const {
        epi_for(acc, u, wr, wc, fr, fq, [&](int row, int col, f32x4 v0, f32x4 v1) { f32x4 h0, h1; unpack8(*(const u32x4*)(Ha + (size_t)row * D + col), h0, h1); h0 = h0 + v0; h1 = h1 + v1;
            *(u32x4*)(HB + (size_t)row * ldb + col) = pack8(h0, h1); });
    }
};
struct EpiStore {
    bf16_t* O; int ldc;
    __device__ __forceinline__ void operator()(const f32x4 (&acc)[2][2][4][2], const pg8::Unit& u, int wr, int wc, int fr, int fq) const {
        epi_for(acc, u, wr, wc, fr, fq, [&](int row, int col, f32x4 v0, f32x4 v1) { *(u32x4*)(O + (size_t)row * ldc + col) = pack8(v0, v1); });
    }
};
struct EpiGate {
    const bf16_t* Hb; int ldh; const bf16_t* PP; int ldp; bf16_t* Ha; float* ssq;
    __device__ __forceinline__ void operator()(const f32x4 (&acc)[2][2][4][2], const pg8::Unit& u, int wr, int wc, int fr, int fq) const {
#pragma unroll
        for (int ai = 0; ai < 2; ++ai)
#pragma unroll
            for (int m = 0; m < 4; ++m) { const int row = u.pm * 256 + ai * 128 + wr * 64 + m * 16 + fr; float sq = 0.f;
#pragma unroll
                for (int bj = 0; bj < 2; ++bj) { const int col = u.pn * 256 + bj * 128 + wc * 32 + 8 * fq; const f32x4 v0 = acc[ai][bj][m][0], v1 = acc[ai][bj][m][1];
                    f32x4 h0, h1, p0, p1; unpack8(*(const u32x4*)(Hb + (size_t)row * ldh + col), h0, h1); unpack8(*(const u32x4*)(PP + (size_t)row * ldp + col), p0, p1);
#pragma unroll
                    for (int j = 0; j < 4; ++j) { h0[j] += sigmoidf_(v0[j]) * p0[j]; h1[j] += sigmoidf_(v1[j]) * p1[j]; sq += h0[j] * h0[j] + h1[j] * h1[j]; }
                    *(u32x4*)(Ha + (size_t)row * D + col) = pack8(h0, h1); }
                sq += __shfl_xor(sq, 16); sq += __shfl_xor(sq, 32);
                if (fq == 0) ssq[(size_t)row * 16 + u.pn * 4 + wc] = sq;
                if (m & 1) asm volatile("" ::: "memory"); }
    }
};

#define XB_TMO      128
#define XB_XCNT(j)  (256  + 64 * (j))
#define XB_XSUB(j)  (1280 + 64 * (j))
#define XB_XGEN(j)  (2304 + 64 * (j))
#define XB_TOP      3328
#define XB_TOPGEN   3392
#define XCD_BAR_WORDS 3456
#define XB_SPIN_CAP (1u << 22)
__device__ __forceinline__ unsigned xb_ld(unsigned* p)              { return __hip_atomic_load(p, __ATOMIC_RELAXED, __HIP_MEMORY_SCOPE_AGENT); }
__device__ __forceinline__ unsigned xb_add(unsigned* p, unsigned v) { return __hip_atomic_fetch_add(p, v, __ATOMIC_RELAXED, __HIP_MEMORY_SCOPE_AGENT); }
__device__ __forceinline__ unsigned xb_xcc_id() { return (unsigned)__builtin_amdgcn_s_getreg((3 << 11) | 20) & 0xFu; }
#define XB_SPIN(cond, bar) do { unsigned _sp = 0; while (cond) { __builtin_amdgcn_s_sleep(1); \
    if ((++_sp & 255u) == 0u) { if (xb_ld(&(bar)[XB_TMO])) break; if (_sp > XB_SPIN_CAP) { atomicAdd(&(bar)[XB_TMO], 1u); break; } } } } while (0)
struct XcdBarrier { unsigned* bar; unsigned x; volatile LAS unsigned* st; };
__device__ __forceinline__ XcdBarrier xcd_barrier_post(unsigned* bar, volatile LAS unsigned* st) {
    XcdBarrier b; b.bar = bar; b.x = xb_xcc_id(); b.st = st;
    if (threadIdx.x == 0) (void)xb_add(&bar[XB_XCNT(b.x)], 1u);
    return b;
}
__device__ __forceinline__ void xcd_barrier_complete(unsigned* bar, unsigned x, unsigned& nloc, unsigned& nx) {
    const unsigned G = gridDim.x * gridDim.y * gridDim.z;
    unsigned sum, cnt, mine, sp = 0u;
    for (;;) {
        sum = 0u; cnt = 0u; mine = 0u;
#pragma unroll
        for (unsigned j = 0; j < 16; ++j) { const unsigned c = xb_ld(&bar[XB_XCNT(j)]); sum += c; cnt += (c > 0u) ? 1u : 0u; mine = (j == x) ? c : mine; }
        if (sum == G) break;
        __builtin_amdgcn_s_sleep(1);
        if ((++sp & 255u) == 0u) { if (xb_ld(&bar[XB_TMO])) break; if (sp > XB_SPIN_CAP) { atomicAdd(&bar[XB_TMO], 1u); break; } }
    }
    nloc = mine > 0u ? mine : 1u; nx = cnt > 0u ? cnt : 1u;
}
__device__ __forceinline__ void xcd_barrier(const XcdBarrier& b_in) {
    asm volatile("s_waitcnt vmcnt(0)" ::: "memory");
    __syncthreads();
    if (threadIdx.x == 0) {
        const XcdBarrier& b = b_in;
        unsigned* bar = b.bar;
        __builtin_amdgcn_s_waitcnt(0);
        unsigned nloc = b.st[0], nx = b.st[1];
        if (nloc == 0u) { xcd_barrier_complete(bar, b.x, nloc, nx); b.st[0] = nloc; b.st[1] = nx; }
        const unsigned old = xb_add(&bar[XB_XSUB(b.x)], 1u);
        const unsigned gen = old / nloc;
        if (old + 1u == (gen + 1u) * nloc) {
            __builtin_amdgcn_fence(__ATOMIC_RELEASE, "agent");
            asm volatile("s_waitcnt vmcnt(0)" ::: "memory");
            const unsigned og = xb_add(&bar[XB_TOP], 1u);
            const unsigned tg = og / nx;
            if (og + 1u == (tg + 1u) * nx) xb_add(&bar[XB_TOPGEN], 1u);
            else XB_SPIN(xb_ld(&bar[XB_TOPGEN]) == tg, bar);
            __builtin_amdgcn_fence(__ATOMIC_ACQUIRE, "agent");
            xb_add(&bar[XB_XGEN(b.x)], 1u);
            asm volatile("s_waitcnt vmcnt(0)" ::: "memory");
        } else {
            XB_SPIN(xb_ld(&bar[XB_XGEN(b.x)]) == gen, bar);
            __builtin_amdgcn_fence(__ATOMIC_ACQUIRE, "agent");
            asm volatile("s_waitcnt vmcnt(0)" ::: "memory");
        }
    }
    __syncthreads();
}

constexpr size_t MiB = 1u << 20;
constexpr size_t WS_CTL = 0, CTL_BYTES = 1 * MiB;
constexpr size_t WS_SSQ = 241 * (size_t)(1u << 20);
constexpr size_t WS_WIN = 2 * MiB;
constexpr size_t WS_WOUT = 19 * MiB, WS_WGATE = 21 * MiB, WS_WPROJ = 23 * MiB;
constexpr size_t WS_PB = 24 * MiB;
constexpr size_t WS_Z = 32 * MiB;
constexpr size_t WS_HB = 160 * MiB;
constexpr size_t WS_VF = 193 * MiB;
constexpr size_t WS_L1 = 225 * MiB;
constexpr size_t WS_VTA = 128 * MiB;
constexpr size_t WS_VTB = 144 * MiB;
constexpr size_t WS_KT = 225 * MiB;
constexpr size_t WS_LORA2 = 23 * MiB + 512 * 1024;
constexpr size_t WS_PG = 160 * MiB;
constexpr size_t WS_SB = 2 * MiB;
constexpr size_t WS_BON = 233 * MiB;
constexpr size_t WS_ST = 176 * MiB;
constexpr size_t WS_KV = 160 * MiB;
constexpr size_t WS_END = 256 * MiB;

constexpr int RING_BYTES = 131072, LDS_BYTES = 163840, MISC_OFF = LDS_BYTES - 512;

struct Args { const float* in[26]; float* out; unsigned char* ws; int ph_lo, ph_hi; };

__device__ __forceinline__ const float* inptr(int i) { asm volatile("" : "+s"(i)); const char* ka = (const char*)__builtin_amdgcn_kernarg_segment_ptr(); return *(const float* const*)(ka + 8 * i); }
struct InTab { __device__ __forceinline__ const float* operator[](int i) const { return inptr(i); } };
struct Frame {
    LAS unsigned char* lds; unsigned char* ldsg;
    int tid, lane, wave, G, vcu;
    InTab in; float* H; unsigned char* ws;
    __device__ __forceinline__ void retid() { int l; asm volatile("v_mbcnt_lo_u32_b32 %0, -1, 0\n\tv_mbcnt_hi_u32_b32 %0, -1, %0" : "=v"(l)); lane = l; tid = wave * 64 + l; }
    __device__ __forceinline__ float* ssq(int l) const { return (float*)(ws + WS_SSQ) + (size_t)l * T * 16; }
};

__device__ __forceinline__ void conv_item(const float* W, int ldw, int Kmax, int k0, int n0, bf16_t* dst, int ldd, int dr0, int drs, int dk0,
                                          const float* svec, float sa, float sb, float sc, LAS float* scr, int lane) {
    float wv[32];
#pragma unroll
    for (int i = 0; i < 32; ++i) { const int k = k0 + 2 * i + (lane >> 5); wv[i] = (k < Kmax) ? W[(size_t)k * ldw + n0 + (lane & 31)] : 0.f; }
#pragma unroll
    for (int i = 0; i < 32; ++i) { const int kk = 2 * i + (lane >> 5), k = k0 + kk; const float f = (k < Kmax) ? (sa + sb * (svec ? svec[k] : 0.f)) * sc : 0.f;
        scr[kk * 33 + (lane & 31)] = wv[i] * f; }
    LDS_WAIT(); asm volatile("" ::: "memory");
    const int c = lane & 7;
    if (k0 + 8 * c < Kmax) {
#pragma unroll
        for (int j = 0; j < 4; ++j) { const int n = (lane >> 3) + 8 * j; const LAS float* s = scr + (8 * c) * 33 + n;
            u32x4 o; o.x = pk2(s[0 * 33], s[1 * 33]); o.y = pk2(s[2 * 33], s[3 * 33]); o.z = pk2(s[4 * 33], s[5 * 33]); o.w = pk2(s[6 * 33], s[7 * 33]);
            *(GAS u32x4*)(dst + (size_t)(dr0 + n * drs) * ldd + dk0 + k0 + 8 * c) = o; }
    }
    LDS_WAIT(); asm volatile("" ::: "memory");
}
__device__ __forceinline__ void conv_item2(const float* W, int ldw, int k0, int n0, bf16_t* dst, int dr0, const float* mu, float sc, LAS float* scr, int lane) {
    float wv[32];
#pragma unroll
    for (int i = 0; i < 32; ++i) wv[i] = W[(size_t)(k0 + 2 * i + (lane >> 5)) * ldw + n0 + (lane & 31)];
#pragma unroll
    for (int half = 0; half < 2; ++half) {
#pragma unroll
        for (int i = 0; i < 32; ++i) { const int kk = 2 * i + (lane >> 5); const float m = mu[k0 + kk]; scr[kk * 33 + (lane & 31)] = wv[i] * ((half ? m : 1.f - m) * sc); }
        LDS_WAIT(); asm volatile("" ::: "memory");
        const int c = lane & 7;
#pragma unroll
        for (int j = 0; j < 4; ++j) { const int n = (lane >> 3) + 8 * j; const LAS float* s_ = scr + (8 * c) * 33 + n;
            u32x4 o; o.x = pk2(s_[0 * 33], s_[1 * 33]); o.y = pk2(s_[2 * 33], s_[3 * 33]); o.z = pk2(s_[4 * 33], s_[5 * 33]); o.w = pk2(s_[6 * 33], s_[7 * 33]);
            *(GAS u32x4*)(dst + (size_t)(dr0 + n) * 2048 + half * 1024 + k0 + 8 * c) = o; }
        LDS_WAIT(); asm volatile("" ::: "memory");
    }
}
__device__ __forceinline__ void conv_win_even(Frame& F, int li) {
    const int e = li >> 1; const float* W = F.in[6] + (size_t)e * D * ZW; const float* gain = F.in[2] + li * D; bf16_t* dst = (bf16_t*)(F.ws + WS_WIN);
    LAS float* scr = (LAS float*)(F.lds + F.wave * 16384);
    const int gw = F.vcu * 8 + F.wave, NGW = F.G * 8;
    for (int it = gw; it < 16 * 128; it += NGW) { const int kb = it >> 7, nb = it & 127, n0 = nb * 32, g = n0 >> 9, hh = (n0 & 511) >> 7, d0 = n0 & 127;
        int dr0 = n0, drs = 1; if (g < 2) { dr0 = g * 512 + hh * 128 + (d0 < 64 ? 2 * d0 : 2 * (d0 - 64) + 1); drs = 2; }
        const float sc = (g == 1 || g == 5) ? QK_SCALE : 1.f;
        conv_item(W, ZW, D, kb * 64, n0, dst, D, dr0, drs, 0, gain, 0.f, 1.f, sc, scr, F.lane); }
}
__device__ __forceinline__ void conv_win_odd(Frame& F, int li) {
    const int o = li >> 1; const float* mu = F.in[9] + (size_t)o * 6 * D; bf16_t* dst = (bf16_t*)(F.ws + WS_WIN);
    LAS float* scr = (LAS float*)(F.lds + F.wave * 16384);
    const int gw = F.vcu * 8 + F.wave, NGW = F.G * 8;
    for (int it = gw; it < 4 * 512; it += NGW) { const int p = it >> 9, r = it & 511, kb = r >> 5, nb = r & 31;
        conv_item2(F.in[10] + ((size_t)o * 4 + p) * D * D, D, kb * 64, nb * 32, dst, p * 1024 + nb * 32, mu + p * D, 1.f, scr, F.lane); }
    for (int it = gw; it < 32 + 32 + 16; it += NGW) { const float* W; int ldw, n0, dr0, mi, kb; const int r = it;
        if (r < 32) { W = F.in[13] + (size_t)o * D * 64; ldw = 64; kb = r >> 1; n0 = (r & 1) * 32; dr0 = 4096 + n0; mi = 4; }
        else if (r < 64) { const int q = r - 32; W = F.in[16] + (size_t)o * D * 64; ldw = 64; kb = q >> 1; n0 = (q & 1) * 32; dr0 = 4160 + n0; mi = 5; }
        else { const int q = r - 64; W = F.in[19]; ldw = 32; kb = q; n0 = 0; dr0 = 4224; mi = 2; }
        conv_item2(W, ldw, kb * 64, n0, dst, dr0, mu + mi * D, (r >= 64 && o == 0) ? 0.f : 1.f, scr, F.lane); }
    { u32x4 z = {0u, 0u, 0u, 0u}; GAS u32x4* zp = (GAS u32x4*)(dst + (size_t)4256 * 2048); const int n16 = 96 * 2048 * 2 / 16;
      for (int i = (F.vcu * 512 + F.tid); i < n16; i += F.G * 512) zp[i] = z; }
}
__device__ __forceinline__ void conv_wrest(Frame& F, int li) {
    const bool even = (li & 1) == 0; const int e = li >> 1;
    const float* Wo = even ? F.in[7] + (size_t)e * D * D : F.in[11] + (size_t)e * D * D;
    const float* Wg = F.in[5] + (size_t)li * D * D; const float* Wp = F.in[4] + (size_t)li * PLE * D;
    LAS float* scr = (LAS float*)(F.lds + F.wave * 16384);
    const int gw = F.vcu * 8 + F.wave, NGW = F.G * 8;
    for (int it = gw; it < 512 + 512 + 128; it += NGW) {
        if (it < 512) conv_item(Wo, D, D, (it >> 5) * 64, (it & 31) * 32, (bf16_t*)(F.ws + WS_WOUT), D, (it & 31) * 32, 1, 0, nullptr, 1.f, 0.f, 1.f, scr, F.lane);
        else if (it < 1024) { const int r = it - 512; conv_item(Wg, D, D, (r >> 5) * 64, (r & 31) * 32, (bf16_t*)(F.ws + WS_WGATE), D, (r & 31) * 32, 1, 0, nullptr, 1.f, 0.f, 1.f, scr, F.lane); }
        else { const int r = it - 1024; conv_item(Wp, D, PLE, (r >> 5) * 64, (r & 31) * 32, (bf16_t*)(F.ws + WS_WPROJ), PLE, (r & 31) * 32, 1, 0, nullptr, 1.f, 0.f, 1.f, scr, F.lane); }
    }
    const float* P = F.in[1] + (size_t)li * T * PLE; GAS u32x4* pb = (GAS u32x4*)(F.ws + WS_PB); const int n8 = T * PLE / 8;
    for (int i = F.vcu * 512 + F.tid; i < n8; i += F.G * 512) { const f32x4 a = *(const f32x4*)(P + (size_t)i * 8), b = *(const f32x4*)(P + (size_t)i * 8 + 4);
        u32x4 o; o.x = pk2(a[0], a[1]); o.y = pk2(a[2], a[3]); o.z = pk2(b[0], b[1]); o.w = pk2(b[2], b[3]); pb[i] = o; }
}

__device__ __forceinline__ void conv_lora2(Frame& F, int li) {
    const int o = li >> 1; LAS float* scr = (LAS float*)(F.lds + F.wave * 16384);
    bf16_t* W2T = (bf16_t*)(F.ws + WS_LORA2); bf16_t* A2T = W2T + 1024 * 64; bf16_t* V2T = A2T + 1024 * 64;
    const int gw = F.vcu * 8 + F.wave, NGW = F.G * 8;
    for (int it = gw; it < 96; it += NGW) {
        if (it < 32) conv_item(F.in[14] + (size_t)o * 64 * D, D, 64, 0, it * 32, W2T, 64, it * 32, 1, 0, nullptr, 1.f, 0.f, 1.f, scr, F.lane);
        else if (it < 64) conv_item(F.in[17] + (size_t)o * 64 * D, D, 64, 0, (it - 32) * 32, A2T, 64, (it - 32) * 32, 1, 0, nullptr, 1.f, 0.f, 1.f, scr, F.lane);
        else conv_item(F.in[20], D, 32, 0, (it - 64) * 32, V2T, 32, (it - 64) * 32, 1, 0, nullptr, 1.f, 0.f, 1.f, scr, F.lane);
    }
}
__device__ __forceinline__ void rows_p0(Frame& F) {
    const float* x = F.in[0]; bf16_t* HB = (bf16_t*)(F.ws + WS_HB); float* s0 = F.ssq(0);
    for (int row = F.vcu * 8 + F.wave; row < T; row += F.G * 8) {
        const f32x4* xr = (const f32x4*)(x + (size_t)row * D) + F.lane; u32x2* br = (u32x2*)(HB + (size_t)row * D) + F.lane; float s = 0.f;
#pragma unroll
        for (int j = 0; j < 4; ++j) { const f32x4 v = xr[64 * j]; s += (v[0] * v[0] + v[1] * v[1]) + (v[2] * v[2] + v[3] * v[3]); u32x2 w; w.x = pk2(v[0], v[1]); w.y = pk2(v[2], v[3]); br[64 * j] = w; }
        s = wave_sum(s); if (F.lane < 16) s0[(size_t)row * 16 + F.lane] = F.lane == 0 ? s : 0.f;
    }
}
__device__ __forceinline__ void rows_norm(Frame& F, int li) {
    const float* gain = F.in[2] + li * D; bf16_t* HN = (bf16_t*)(F.H); const bf16_t* Ha = (const bf16_t*)(F.ws + WS_HB); const float* sq = F.ssq(li);
    f32x4 g[4];
#pragma unroll
    for (int j = 0; j < 4; ++j) g[j] = *((const f32x4*)gain + F.lane + 64 * j);
    for (int row = F.vcu * 8 + F.wave; row < T; row += F.G * 8) {
        const u32x2* hr = (const u32x2*)(Ha + (size_t)row * D) + F.lane; u32x2* br = (u32x2*)(HN + (size_t)(row + 1 + (row >= SEQ ? 1 : 0)) * D) + F.lane;
        const float rs = rsqrtf(ssq_sum(sq, row) * (1.f / D) + 1e-6f);
#pragma unroll
        for (int j = 0; j < 4; ++j) { const u32x2 hw = hr[64 * j]; const f32x4 h4 = {__uint_as_float(hw.x << 16), __uint_as_float(hw.x & 0xffff0000u), __uint_as_float(hw.y << 16), __uint_as_float(hw.y & 0xffff0000u)};
            const f32x4 v = h4 * rs * g[j]; u32x2 w; w.x = pk2(v[0], v[1]); w.y = pk2(v[2], v[3]); br[64 * j] = w; }
    }
    if (F.vcu == 0 && F.wave < 2) { u32x2* br = (u32x2*)(HN + (size_t)(F.wave ? SEQ + 1 : 0) * D) + F.lane; u32x2 z = {0u, 0u};
#pragma unroll
        for (int j = 0; j < 4; ++j) br[64 * j] = z; }
}
__device__ __forceinline__ void norm_lora_phase(Frame& F, int li) {
    const float* gain = F.in[2] + li * D; bf16_t* HN = (bf16_t*)(F.H); const bf16_t* Ha = (const bf16_t*)(F.ws + WS_HB); const float* sq = F.ssq(li);
    LAS bf16_t* HL = (LAS bf16_t*)F.lds; constexpr int HS = 1032;
    const GAS bf16_t* W1c = (const GAS bf16_t*)(F.ws + WS_WIN) + (size_t)4096 * 2048; GAS bf16_t* L1g = (GAS bf16_t*)(F.ws + WS_L1);
    const int lane = F.lane, wave = F.wave;
    f32x4 g[4];
#pragma unroll
    for (int j = 0; j < 4; ++j) g[j] = *((const f32x4*)gain + lane + 64 * j);
#pragma unroll 1
    for (int p = F.vcu; p < T / 64; p += F.G) {
        __syncthreads();
#pragma unroll 1
        for (int i = wave; i < 65; i += 8) {
            const int row = 64 * p - 1 + i; const bool valid = !(i == 0 && (row + 1) % SEQ == 0);
            LAS u32x2* lr = (LAS u32x2*)(HL + i * HS) + lane;
            if (valid) {
                const u32x2* hr = (const u32x2*)(Ha + (size_t)row * D) + lane; const float rs = rsqrtf(ssq_sum(sq, row) * (1.f / D) + 1e-6f);
                u32x2* br = (u32x2*)(HN + (size_t)(row + 1 + (row >= SEQ ? 1 : 0)) * D) + lane;
#pragma unroll
                for (int j = 0; j < 4; ++j) { const u32x2 hw = hr[64 * j]; const f32x4 h4 = {__uint_as_float(hw.x << 16), __uint_as_float(hw.x & 0xffff0000u), __uint_as_float(hw.y << 16), __uint_as_float(hw.y & 0xffff0000u)};
                    const f32x4 v = h4 * rs * g[j]; u32x2 w; w.x = pk2(v[0], v[1]); w.y = pk2(v[2], v[3]); lr[64 * j] = w; if (i > 0) br[64 * j] = w; }
            } else {
#pragma unroll
                for (int j = 0; j < 4; ++j) lr[64 * j] = (u32x2){0u, 0u};
            }
        }
        __syncthreads();
        const int fr = lane & 15, gq = lane >> 4;
        f32x4 acc[5];
#pragma unroll
        for (int i = 0; i < 5; ++i) acc[i] = (f32x4){0.f, 0.f, 0.f, 0.f};
        const LAS bf16_t* ap = HL + fr * HS + 8 * gq;
        const int mt4 = wave & 3, nt4 = 8 + (wave >> 2);
        const GAS bf16_t* bp0 = W1c + (size_t)(wave * 16 + fr) * 2048 + 8 * gq; const GAS bf16_t* bp1 = W1c + (size_t)(nt4 * 16 + fr) * 2048 + 8 * gq;
#pragma unroll 1
        for (int k8 = 0; k8 < 64; k8 += 8) {
            bf16x8 b0[8], b1[8];
#pragma unroll
            for (int q = 0; q < 8; ++q) { b0[q] = *(const GAS bf16x8*)(bp0 + 32 * (k8 + q)); b1[q] = *(const GAS bf16x8*)(bp1 + 32 * (k8 + q)); }
#pragma unroll
            for (int q = 0; q < 8; ++q) { const int ks = k8 + q; const int aoff = ((ks >> 5) ? 0 : HS) + (ks & 31) * 32;
#pragma unroll
                for (int i = 0; i < 4; ++i) acc[i] = __builtin_amdgcn_mfma_f32_16x16x32_bf16(*(const LAS bf16x8*)(ap + i * 16 * HS + aoff), b0[q], acc[i], 0, 0, 0);
                acc[4] = __builtin_amdgcn_mfma_f32_16x16x32_bf16(*(const LAS bf16x8*)(ap + mt4 * 16 * HS + aoff), b1[q], acc[4], 0, 0, 0); }
        }
#pragma unroll
        for (int i = 0; i < 5; ++i) { const int mt = i < 4 ? i : mt4, nt = i < 4 ? wave : nt4, col = nt * 16 + fr;
#pragma unroll
            for (int j = 0; j < 4; ++j) { float v = acc[i][j]; if (col < 64) v = 1.f - 2.f * __builtin_amdgcn_rcpf(1.f + __expf(2.f * v));
                L1g[(size_t)(64 * p + mt * 16 + 4 * gq + j) * 256 + col] = (bf16_t)f2bf(v); } }
    }
    if (F.vcu == 0 && wave < 2) { u32x2* br = (u32x2*)(HN + (size_t)(wave ? SEQ + 1 : 0) * D) + lane; u32x2 z = {0u, 0u};
#pragma unroll
        for (int j = 0; j < 4; ++j) br[64 * j] = z; }
    __syncthreads();
}

__device__ __forceinline__ void rows_final(Frame& F) {
    const float* gain = F.in[3]; const float* sq = F.ssq(4); const bf16_t* Ha = (const bf16_t*)(F.ws + WS_HB);
    f32x4 g[4];
#pragma unroll
    for (int j = 0; j < 4; ++j) g[j] = *((const f32x4*)gain + F.lane + 64 * j);
    for (int row = F.vcu * 8 + F.wave; row < T; row += F.G * 8) {
        const u32x2* hr = (const u32x2*)(Ha + (size_t)row * D) + F.lane; f32x4* orow = (f32x4*)(F.H + (size_t)row * D) + F.lane; const float rs = rsqrtf(ssq_sum(sq, row) * (1.f / D) + 1e-6f);
#pragma unroll
        for (int j = 0; j < 4; ++j) { const u32x2 hw = hr[64 * j]; const f32x4 h4 = {__uint_as_float(hw.x << 16), __uint_as_float(hw.x & 0xffff0000u), __uint_as_float(hw.y << 16), __uint_as_float(hw.y & 0xffff0000u)};
            orow[64 * j] = h4 * rs * g[j]; }
    }
}

typedef float f32x16 __attribute__((ext_vector_type(16)));
template <bool DUMMY>
__device__ __forceinline__ void sb_unit(Frame& F, int bh, int qb) {
    const int lane = F.lane, l31 = lane & 31, hi = lane >> 5, b = bh >> 2, h = bh & 3;
    bf16_t* Z = (bf16_t*)(F.ws + WS_Z); const bf16_t* VT = (const bf16_t*)(F.ws + WS_VTB) + (size_t)bh * 128 * SEQ;
    const size_t rowb = (size_t)b * SEQ; const int q0 = qb * 32, tq = q0 + l31;
    bf16x8 qr[8];
    { const bf16_t* qp = Z + (rowb + tq) * ZE + 1536 + h * 128 + hi * 8;
#pragma unroll
      for (int ks = 0; ks < 8; ++ks) qr[ks] = *(const bf16x8*)(qp + 16 * ks); }
    f32x16 o[4];
#pragma unroll
    for (int d = 0; d < 4; ++d)
#pragma unroll
        for (int r = 0; r < 16; ++r) o[d][r] = 0.f;
    float carry = 1.f;
    const int pi = 16 * ((l31 >> 2) & 1) + (l31 & 3) + 4 * (l31 >> 3);
    const bf16_t* Kb = Z + rowb * ZE + 2048 + h * 128 + hi * 8;
    for (int kt = (q0 + 31) >> 6; kt >= 0; --kt) {
        const int kbase = kt * 64;
        const bf16_t* kp0 = Kb + (size_t)(kbase + pi) * ZE; const bf16_t* kp1 = kp0 + (size_t)32 * ZE;
        f32x16 p0, p1;
#pragma unroll
        for (int r = 0; r < 16; ++r) { p0[r] = 0.f; p1[r] = 0.f; }
#pragma unroll
        for (int ks = 0; ks < 8; ++ks) { const bf16x8 a0 = *(const bf16x8*)(kp0 + 16 * ks), a1 = *(const bf16x8*)(kp1 + 16 * ks);
            p0 = __builtin_amdgcn_mfma_f32_32x32x16_bf16(a0, qr[ks], p0, 0, 0, 0); p1 = __builtin_amdgcn_mfma_f32_32x32x16_bf16(a1, qr[ks], p1, 0, 0, 0); }
        float f1 = 1.f, f0 = 1.f;
        const int k1 = kbase + 32 + 16 * hi, k0 = kbase + 16 * hi;
#pragma unroll
        for (int r = 15; r >= 0; --r) { const float z = fminf(p1[r], 80.f); const float e = exp2f(z * 1.4426950408889634f); float rd = __builtin_amdgcn_rcpf(1.f + e); float be = e * rd;
            const bool valid = (k1 + r) < tq; be = valid ? be : 0.f; rd = valid ? rd : 1.f; p1[r] = be * f1; f1 *= rd; }
#pragma unroll
        for (int r = 15; r >= 0; --r) { const float z = fminf(p0[r], 80.f); const float e = exp2f(z * 1.4426950408889634f); float rd = __builtin_amdgcn_rcpf(1.f + e); float be = e * rd;
            const bool valid = (k0 + r) < tq; be = valid ? be : 0.f; rd = valid ? rd : 1.f; p0[r] = be * f0; f0 *= rd; }
        const float pf0 = __shfl_xor(f0, 32), pf1 = __shfl_xor(f1, 32);
        const float tail1 = hi ? 1.f : pf1;
        const float tail0 = hi ? (pf1 * f1) : (pf0 * f1 * pf1);
        const float s1 = tail1 * carry, s0 = tail0 * carry;
        carry *= (f0 * f1) * (pf0 * pf1);
        u32x4 pa[2][2];
#pragma unroll
        for (int s = 0; s < 2; ++s) {
            pa[0][s].x = cvt_pk_bf16(p0[8 * s + 0] * s0, p0[8 * s + 1] * s0); pa[0][s].y = cvt_pk_bf16(p0[8 * s + 2] * s0, p0[8 * s + 3] * s0);
            pa[0][s].z = cvt_pk_bf16(p0[8 * s + 4] * s0, p0[8 * s + 5] * s0); pa[0][s].w = cvt_pk_bf16(p0[8 * s + 6] * s0, p0[8 * s + 7] * s0);
            pa[1][s].x = cvt_pk_bf16(p1[8 * s + 0] * s1, p1[8 * s + 1] * s1); pa[1][s].y = cvt_pk_bf16(p1[8 * s + 2] * s1, p1[8 * s + 3] * s1);
            pa[1][s].z = cvt_pk_bf16(p1[8 * s + 4] * s1, p1[8 * s + 5] * s1); pa[1][s].w = cvt_pk_bf16(p1[8 * s + 6] * s1, p1[8 * s + 7] * s1);
        }
        const bf16_t* vp = VT + (size_t)l31 * SEQ + kbase + 16 * hi;
#pragma unroll
        for (int d = 0; d < 4; ++d)
#pragma unroll
            for (int blk = 0; blk < 2; ++blk)
#pragma unroll
                for (int s = 0; s < 2; ++s) { const bf16x8 vb = *(const bf16x8*)(vp + (size_t)(32 * d) * SEQ + 32 * blk + 8 * s);
                    o[d] = __builtin_amdgcn_mfma_f32_32x32x16_bf16(__builtin_bit_cast(bf16x8, pa[blk][s]), vb, o[d], 0, 0, 0); }
        if (__all(carry < 7.9e-31f)) break;
    }
#pragma unroll
    for (int r = 0; r < 16; ++r) { const int qrow = q0 + (r & 3) + 8 * (r >> 2) + 4 * hi; bf16_t* gp = Z + (rowb + qrow) * ZE + 2560 + h * 128 + l31;
#pragma unroll
        for (int d = 0; d < 4; ++d) { const float g = bf2f(gp[32 * d]); const float ov = o[d][r] * siluf_(g); if (!DUMMY) gp[32 * d] = (bf16_t)f2bf(ov); else asm volatile("" :: "v"(ov)); } }
}
__device__ __forceinline__ void ret_stage_a(Frame& F, int u) {
    const int l31 = F.lane & 31, hi = F.lane >> 5, cu = u >> 3, w8 = u & 7, bh = cu & 7, n = cu >> 3, dvb = w8 >> 1, dkp = w8 & 1;
    const bf16_t* vt = (const bf16_t*)(F.ws + WS_VTA) + ((size_t)(bh * 128 + 32 * dvb + l31)) * SEQ + n * 128 + 8 * hi;
    const bf16_t* kt = (const bf16_t*)(F.ws + WS_KT) + ((size_t)(bh * 128 + 64 * dkp + l31)) * SEQ + n * 128 + 8 * hi;
    f32x16 a0, a1;
#pragma unroll
    for (int r = 0; r < 16; ++r) { a0[r] = 0.f; a1[r] = 0.f; }
#pragma unroll
    for (int ks = 0; ks < 8; ++ks) { const bf16x8 va = *(const bf16x8*)(vt + 16 * ks), k0 = *(const bf16x8*)(kt + 16 * ks), k1 = *(const bf16x8*)(kt + (size_t)32 * SEQ + 16 * ks);
        a0 = __builtin_amdgcn_mfma_f32_32x32x16_bf16(va, k0, a0, 0, 0, 0); a1 = __builtin_amdgcn_mfma_f32_32x32x16_bf16(va, k1, a1, 0, 0, 0); }
    bf16_t* kv = (bf16_t*)(F.H) + ((size_t)cu * 128 + 32 * dvb) * 128 + 64 * dkp + l31;
#pragma unroll
    for (int r = 0; r < 16; ++r) { const int dv = (r & 3) + 8 * (r >> 2) + 4 * hi; kv[dv * 128] = (bf16_t)f2bf(a0[r]); kv[dv * 128 + 32] = (bf16_t)f2bf(a1[r]); }
}
__device__ __forceinline__ void ret_stage_b(Frame& F) {
    const int e = F.vcu * 512 + F.tid; if (e >= 8 * 128 * 128) return;
    const int h = (e >> 14) & 3; const float g128 = exp2f(128.f * log2f(1.f - exp2f(-5.f - (float)h)));
    const bf16_t* p = (const bf16_t*)(F.H) + e; bf16_t* q = (bf16_t*)(F.H) + (size_t)8 * 1024 * 1024 + e; float S = 0.f;
#pragma unroll 4
    for (int n = 0; n < 64; ++n) { const float kv = bf2f(p[(size_t)n * 131072]); q[(size_t)n * 131072] = (bf16_t)f2bf(S); S = S * g128 + kv; }
}
template <bool DUMMY>
__device__ __forceinline__ void ret_stage_c(Frame& F, int u, const float* gng) {
    const int lane = F.lane, l31 = lane & 31, hi = lane >> 5, cu = u >> 2, qblk = u & 3, bh = cu & 7, n = cu >> 3, b = bh >> 2, h = bh & 3;
    bf16_t* Z = (bf16_t*)(F.ws + WS_Z); const size_t rowb = (size_t)b * SEQ; const int t0 = n * 128, tq = t0 + 32 * qblk + l31;
    bf16x8 qr[8];
    { const bf16_t* qp = Z + (rowb + tq) * ZE + h * 128 + hi * 8;
#pragma unroll
      for (int ks = 0; ks < 8; ++ks) qr[ks] = *(const bf16x8*)(qp + 16 * ks); }
    f32x16 o[4];
#pragma unroll
    for (int d = 0; d < 4; ++d)
#pragma unroll
        for (int r = 0; r < 16; ++r) o[d][r] = 0.f;
    { const bf16_t* sp = (const bf16_t*)(F.H) + (size_t)8 * 1024 * 1024 + ((size_t)cu * 128 + l31) * 128 + 8 * hi;
#pragma unroll
      for (int ks = 0; ks < 8; ++ks)
#pragma unroll
          for (int d = 0; d < 4; ++d) { const bf16x8 sb = *(const bf16x8*)(sp + (size_t)(32 * d) * 128 + 16 * ks); o[d] = __builtin_amdgcn_mfma_f32_32x32x16_bf16(qr[ks], sb, o[d], 0, 0, 0); } }
    const int pi = 16 * ((l31 >> 2) & 1) + (l31 & 3) + 4 * (l31 >> 3);
    const bf16_t* Kb = Z + rowb * ZE + 512 + h * 128 + hi * 8;
    const bf16_t* VT = (const bf16_t*)(F.ws + WS_VTA) + ((size_t)(bh * 128 + l31)) * SEQ + 16 * hi;
    for (int kb = 0; kb <= qblk; ++kb) {
        const int kbase = t0 + 32 * kb; const bf16_t* kp = Kb + (size_t)(kbase + pi) * ZE;
        f32x16 p;
#pragma unroll
        for (int r = 0; r < 16; ++r) p[r] = 0.f;
#pragma unroll
        for (int ks = 0; ks < 8; ++ks) { const bf16x8 a = *(const bf16x8*)(kp + 16 * ks); p = __builtin_amdgcn_mfma_f32_32x32x16_bf16(a, qr[ks], p, 0, 0, 0); }
        if (kb == qblk) {
#pragma unroll
            for (int r = 0; r < 16; ++r) p[r] = (kbase + 16 * hi + r <= tq) ? p[r] : 0.f; }
        u32x4 pa[2];
#pragma unroll
        for (int s = 0; s < 2; ++s) { pa[s].x = cvt_pk_bf16(p[8 * s], p[8 * s + 1]); pa[s].y = cvt_pk_bf16(p[8 * s + 2], p[8 * s + 3]); pa[s].z = cvt_pk_bf16(p[8 * s + 4], p[8 * s + 5]); pa[s].w = cvt_pk_bf16(p[8 * s + 6], p[8 * s + 7]); }
#pragma unroll
        for (int d = 0; d < 4; ++d)
#pragma unroll
            for (int s = 0; s < 2; ++s) { const bf16x8 vb = *(const bf16x8*)(VT + (size_t)(32 * d) * SEQ + kbase + 8 * s);
                o[d] = __builtin_amdgcn_mfma_f32_32x32x16_bf16(__builtin_bit_cast(bf16x8, pa[s]), vb, o[d], 0, 0, 0); }
    }
    float gg[4];
#pragma unroll
    for (int d = 0; d < 4; ++d) gg[d] = gng[h * 128 + 32 * d + l31];
#pragma unroll
    for (int r = 0; r < 16; ++r) {
        float sm = (o[0][r] + o[1][r]) + (o[2][r] + o[3][r]);
        sm += __shfl_xor(sm, 1); sm += __shfl_xor(sm, 2); sm += __shfl_xor(sm, 4); sm += __shfl_xor(sm, 8); sm += __shfl_xor(sm, 16);
        const float mu = sm * (1.f / 128.f); float q = 0.f;
#pragma unroll
        for (int d = 0; d < 4; ++d) { const float dd = o[d][r] - mu; q += dd * dd; }
        q += __shfl_xor(q, 1); q += __shfl_xor(q, 2); q += __shfl_xor(q, 4); q += __shfl_xor(q, 8); q += __shfl_xor(q, 16);
        const float rsd = rsqrtf(q * (1.f / 128.f) + 1e-5f);
        const int qrow = t0 + 32 * qblk + (r & 3) + 8 * (r >> 2) + 4 * hi; bf16_t* gp = Z + (rowb + qrow) * ZE + 1024 + h * 128 + l31;
#pragma unroll
        for (int d = 0; d < 4; ++d) { const float ga = bf2f(gp[32 * d]); const float ov = (o[d][r] - mu) * rsd * gg[d] * siluf_(ga); if (!DUMMY) gp[32 * d] = (bf16_t)f2bf(ov); else asm volatile("" :: "v"(ov)); }
    }
}
__device__ __forceinline__ bf16x8 ld8p(const bf16_t* p) { return *(const bf16x8*)p; }
namespace rw {
constexpr int S64 = 72, S128 = 136, LFS = 68;
constexpr int O_AT = 0, O_RT = O_AT + 9216, O_E = O_RT + 9216, O_ET = O_E + 18432, O_AM = O_ET + 17408, O_X0 = O_AM + 18432, O_LF = O_X0 + 17408, O_MM = O_LF + 17408,
              O_NN = O_MM + 9216, O_PC = O_NN + 17408, O_GC = O_PC + 9216, O_SM = O_GC + 9216, O_END = O_SM + 8192;
static_assert(O_END <= 160 * 1024 - 1024, "rwkv stage X LDS map");
typedef __attribute__((address_space(3))) bf16_t lbf;
typedef __attribute__((address_space(3))) float lf32;
__device__ __forceinline__ bf16x8 ld8(const bf16_t* p) { return *(const bf16x8*)p; }
__device__ __forceinline__ bf16x8 ld8(const LAS bf16_t* p) { return *(const LAS bf16x8*)p; }
__device__ __forceinline__ bf16x8 ld8(const GAS bf16_t* p) { return *(const GAS bf16x8*)p; }
template <int MT, int NT, int KS, class PA, class PB, class Epi>
__device__ __forceinline__ void mm(PA A, int lda, PB B, int ldb, int wave, int lane, Epi epi) {
    const int fr = lane & 15, g = lane >> 4;
    static_assert((MT * NT) % 8 == 0, "mm: tile count must be a multiple of the 8 waves");
#pragma unroll
    for (int ti = 0; ti < MT * NT / 8; ++ti) { const int tile = wave + 8 * ti; const int mt = tile / NT, nt = tile % NT;
        f32x4 acc = {0.f, 0.f, 0.f, 0.f};
        PA ap = A + (mt * 16 + fr) * lda + 8 * g; PB bp = B + (nt * 16 + fr) * ldb + 8 * g;
#pragma unroll
        for (int ks = 0; ks < KS; ++ks) acc = __builtin_amdgcn_mfma_f32_16x16x32_bf16(ld8(ap + 32 * ks), ld8(bp + 32 * ks), acc, 0, 0, 0);
        epi(ti, mt * 16 + 4 * g, nt * 16 + fr, acc);
    }
}
template <int MT, int NT, int KS, class PA, class PB, class Epi>
__device__ __forceinline__ void mm_rt(PA A, int lda, PB B, int ldb, int w, int nw, int lane, Epi epi) {
    const int fr = lane & 15, g = lane >> 4;
#pragma unroll 1
    for (int tile = w; tile < MT * NT; tile += nw) { const int mt = tile / NT, nt = tile % NT;
        f32x4 acc = {0.f, 0.f, 0.f, 0.f};
        PA ap = A + (mt * 16 + fr) * lda + 8 * g; PB bp = B + (nt * 16 + fr) * ldb + 8 * g;
#pragma unroll
        for (int ks = 0; ks < KS; ++ks) acc = __builtin_amdgcn_mfma_f32_16x16x32_bf16(ld8(ap + 32 * ks), ld8(bp + 32 * ks), acc, 0, 0, 0);
        epi(mt * 16 + 4 * g, nt * 16 + fr, acc);
    }
}
__device__ __forceinline__ unsigned short bfs(float f) { return (unsigned short)f2bf(f); }
__device__ __forceinline__ void st4(LAS bf16_t* p, f32x4 v) { u32x2 w; w.x = cvt_pk_bf16(v[0], v[1]); w.y = cvt_pk_bf16(v[2], v[3]); *(LAS u32x2*)p = w; }
}

template <bool DUMMY>
__device__ __forceinline__ void rwkv_stage_x(Frame& F, int li, unsigned long long& xacc) {
    using namespace rw;
    unsigned long long xt0 = 0;
#define TSX(k) do { if (MK_XA == (k)) xt0 = __builtin_amdgcn_s_memrealtime(); if (MK_XB == (k)) xacc += __builtin_amdgcn_s_memrealtime() - xt0; } while (0)
    const int o = li >> 1;
    LAS unsigned char* L = F.lds;
    LAS bf16_t* At = (LAS bf16_t*)(L + O_AT); LAS bf16_t* Rt = (LAS bf16_t*)(L + O_RT); LAS bf16_t* E = (LAS bf16_t*)(L + O_E); LAS bf16_t* ET = (LAS bf16_t*)(L + O_ET); LAS bf16_t* AM = (LAS bf16_t*)(L + O_AM);
    LAS bf16_t* X0T = (LAS bf16_t*)(L + O_X0); LAS float* Lf = (LAS float*)(L + O_LF); LAS bf16_t* Mm = (LAS bf16_t*)(L + O_MM); LAS bf16_t* NN = (LAS bf16_t*)(L + O_NN); LAS float* CS = (LAS float*)(L + O_NN);
    LAS bf16_t* Pc = (LAS bf16_t*)(L + O_PC); LAS bf16_t* Gc = (LAS bf16_t*)(L + O_GC); LAS float* gamC = (LAS float*)(L + O_SM); LAS float* SEGT = gamC + 64; LAS float* PRM = gamC + 64 + 1024;
    LAS bf16_t* Tm = At; LAS bf16_t* Qh = AM; LAS bf16_t* PT = AM + 64 * S64; LAS bf16_t* WT = Mm;
    GAS bf16_t* Z = (GAS bf16_t*)(F.ws + WS_Z); const GAS bf16_t* L1g = (const GAS bf16_t*)(F.ws + WS_L1); GAS bf16_t* VF = (GAS bf16_t*)(F.ws + WS_VF);
    const GAS bf16_t* W2T = (const GAS bf16_t*)(F.ws + WS_LORA2); const GAS bf16_t* A2T = W2T + 1024 * 64; const GAS bf16_t* V2T = A2T + 1024 * 64;
    GAS bf16_t* PG = (GAS bf16_t*)(F.H); GAS float* BON = (GAS float*)(F.ws + WS_BON);
    const float* w0p = F.in[12] + o * D; const float* a0p = F.in[15] + o * D; const float* v0p = F.in[18]; const float* kkp = F.in[21] + o * D; const float* kap = F.in[22] + o * D; const float* rkp = F.in[23] + o * D;
    f32x4 nlw[2], nla[2], nlv[2]; unsigned nr[4], nk[4], nv[4], nvf[4];
    bf16x8 fwa[4], fwb[2], faa[4], fab[2], fva[2], fvb;
    auto fetch_issue = [&](int u2, int c2, int tid2) {
        const int bh2 = u2 & 31, blk2 = u2 >> 5, b2 = bh2 >> 4, h2 = bh2 & 15; const size_t rows2 = (size_t)b2 * SEQ + (size_t)blk2 * 128 + 64 * c2;
        const int lane2 = tid2 & 63, fr2 = lane2 & 15, g2 = lane2 >> 4; int wave2 = F.wave; asm volatile("" : "+s"(wave2));
        const int nt2 = wave2 & 3;
#pragma unroll
        for (int ti = 0; ti < 2; ++ti) { const int mt2 = ((wave2 + 8 * ti) >> 2); const GAS bf16_t* ap = L1g + (rows2 + mt2 * 16 + fr2) * 256 + 8 * g2;
            fwa[ti * 2] = ld8(ap); fwa[ti * 2 + 1] = ld8(ap + 32); faa[ti * 2] = ld8(ap + 64); faa[ti * 2 + 1] = ld8(ap + 96); if (o) fva[ti] = ld8(ap + 128); }
        { const GAS bf16_t* bp = W2T + ((size_t)h2 * 64 + nt2 * 16 + fr2) * 64 + 8 * g2; fwb[0] = ld8(bp); fwb[1] = ld8(bp + 32); }
        { const GAS bf16_t* bp = A2T + ((size_t)h2 * 64 + nt2 * 16 + fr2) * 64 + 8 * g2; fab[0] = ld8(bp); fab[1] = ld8(bp + 32); }
        if (o) fvb = ld8(V2T + ((size_t)h2 * 64 + nt2 * 16 + fr2) * 32 + 8 * g2);
        const int q2 = wave2 * 2 + (lane2 >> 5), cp2 = lane2 & 31;
#pragma unroll
        for (int j = 0; j < 4; ++j) { const size_t prow2 = rows2 + 4 * q2 + j; const GAS unsigned* zp2 = (const GAS unsigned*)(Z + prow2 * ZW + h2 * 64 + 2 * cp2);
            nr[j] = zp2[0]; nk[j] = zp2[512]; nv[j] = zp2[1024]; nvf[j] = o ? *(const GAS unsigned*)(VF + prow2 * D + h2 * 64 + 2 * cp2) : 0u; }
    };
    auto fetch_compute = [&]() {
#pragma unroll
        for (int ti = 0; ti < 2; ++ti) { const f32x4 z4 = {0.f, 0.f, 0.f, 0.f};
            nlw[ti] = __builtin_amdgcn_mfma_f32_16x16x32_bf16(fwa[ti * 2 + 1], fwb[1], __builtin_amdgcn_mfma_f32_16x16x32_bf16(fwa[ti * 2], fwb[0], z4, 0, 0, 0), 0, 0, 0);
            nla[ti] = __builtin_amdgcn_mfma_f32_16x16x32_bf16(faa[ti * 2 + 1], fab[1], __builtin_amdgcn_mfma_f32_16x16x32_bf16(faa[ti * 2], fab[0], z4, 0, 0, 0), 0, 0, 0);
            if (o) nlv[ti] = __builtin_amdgcn_mfma_f32_16x16x32_bf16(fva[ti], fvb, z4, 0, 0, 0); }
    };
    { F.retid(); int t0 = F.tid; asm volatile("" : "+v"(t0)); fetch_issue(F.vcu, 0, t0); fetch_compute(); }
#pragma unroll 1
    for (int u = F.vcu; u < 2048; u += F.G) {
        const int bh = u & 31, blk = u >> 5, b = bh >> 4, h = bh & 15; const size_t row0 = (size_t)b * SEQ + (size_t)blk * 128;
        F.retid(); int tid = F.tid; asm volatile("" : "+v"(tid));
        __syncthreads();
        if (tid < 384) { const int a_ = tid >> 6, ch = tid & 63; const float* src = a_ == 0 ? w0p : a_ == 1 ? a0p : a_ == 2 ? v0p : a_ == 3 ? kkp : a_ == 4 ? kap : rkp; PRM[tid] = src[h * 64 + ch]; }
        for (int e = tid; e < 64 * 64; e += 512) { const int i = e >> 6, j = e & 63; Pc[i * S64 + j] = (i == j) ? (bf16_t)0x3f80 : (bf16_t)0; Gc[i * S64 + j] = 0; }
#pragma unroll 1
        for (int c = 0; c < 2; ++c) {
            const size_t rows = row0 + 64 * c;
            asm volatile("" : "+v"(tid));
            const int lane = tid & 63; int wave = F.wave; asm volatile("" : "+s"(wave));
            const int cp = lane & 31, q = wave * 2 + (lane >> 5), ch0 = 2 * cp;
            __syncthreads();
            TSX(0);
            unsigned cr[4], ck[4], cv[4], cvf[4];
#pragma unroll
            for (int j = 0; j < 4; ++j) { cr[j] = nr[j]; ck[j] = nk[j]; cv[j] = nv[j]; cvf[j] = nvf[j]; }
            { const int fr_ = lane & 15, g_ = lane >> 4;
#pragma unroll
              for (int ti = 0; ti < 2; ++ti) { const int tile = wave + 8 * ti, r0 = (tile >> 2) * 16 + 4 * g_, col = (tile & 3) * 16 + fr_;
#pragma unroll
                  for (int j = 0; j < 4; ++j) { Lf[(r0 + j) * LFS + col] = nlw[ti][j]; Mm[(r0 + j) * S64 + col] = bfs(nla[ti][j]); if (o) AM[(64 + r0 + j) * S64 + col] = bfs(nlv[ti][j]); } } }
            const int nu = c == 0 ? u : u + F.G, nc = c == 0 ? 1 : 0; const bool has_n = nu < 2048;
            if (has_n) fetch_issue(nu, nc, tid);
            __syncthreads();
            TSX(1);
            float pr[4][2], pkk[4][2], pkm[4][2], pb[4][2], pv[4][2], cd[4][2];
            {
                float ss[4], bon[4];
#pragma unroll
                for (int j = 0; j < 4; ++j) { const int t = 4 * q + j; ss[j] = 0.f; bon[j] = 0.f;
#pragma unroll
                    for (int e = 0; e < 2; ++e) { const int ch = ch0 + e;
                        const float r = e ? __uint_as_float(cr[j] & 0xffff0000u) : __uint_as_float(cr[j] << 16), k = e ? __uint_as_float(ck[j] & 0xffff0000u) : __uint_as_float(ck[j] << 16);
                        float v = e ? __uint_as_float(cv[j] & 0xffff0000u) : __uint_as_float(cv[j] << 16);
                        const float lw = Lf[t * LFS + ch], la = bf2f(Mm[t * S64 + ch]);
                        cd[j][e] = -0.6065306597126334f * sigmoidf_(PRM[ch] + lw);
                        const float a = sigmoidf_(PRM[64 + ch] + la);
                        if (o) { const float lv = bf2f(AM[(64 + t) * S64 + ch]); const float vf = e ? __uint_as_float(cvf[j] & 0xffff0000u) : __uint_as_float(cvf[j] << 16);
                            v = v + (vf - v) * sigmoidf_(PRM[128 + ch] + lv); v = bf2f((bf16_t)f2bf(v)); }
                        const float kr = k * PRM[192 + ch]; ss[j] += kr * kr; pkk[j][e] = kr;
                        const float km = k * (1.f + (a - 1.f) * PRM[256 + ch]); pkm[j][e] = km; pb[j][e] = a; pr[j][e] = r; pv[j][e] = v; bon[j] += r * km * PRM[320 + ch]; }
                    const size_t row = rows + t;
                    if (!DUMMY) { if (o) *(GAS unsigned*)(Z + row * ZW + 2048 + h * 64 + ch0) = pk2(pv[j][0], pv[j][1]); else *(GAS unsigned*)(VF + row * D + h * 64 + ch0) = cv[j]; } }
#pragma unroll
                for (int j = 0; j < 4; ++j) {
                    float s1 = ss[j], b1 = bon[j];
                    s1 += __shfl_xor(s1, 1); s1 += __shfl_xor(s1, 2); s1 += __shfl_xor(s1, 4); s1 += __shfl_xor(s1, 8); s1 += __shfl_xor(s1, 16);
                    b1 += __shfl_xor(b1, 1); b1 += __shfl_xor(b1, 2); b1 += __shfl_xor(b1, 4); b1 += __shfl_xor(b1, 8); b1 += __shfl_xor(b1, 16);
                    const float inv = __builtin_amdgcn_rcpf(fmaxf(sqrtf(s1), 1e-12f));
#pragma unroll
                    for (int e = 0; e < 2; ++e) { pkk[j][e] *= inv; pb[j][e] *= pkk[j][e]; }
                    if (!DUMMY && cp == 0) BON[(rows + 4 * q + j) * 16 + h] = b1; }
#pragma unroll
                for (int e = 0; e < 2; ++e) { cd[1][e] += cd[0][e]; cd[2][e] += cd[1][e]; cd[3][e] += cd[2][e]; SEGT[q * 64 + ch0 + e] = cd[3][e]; }
            }
            __syncthreads();
            TSX(3);
            {
                float pre[2] = {0.f, 0.f};
                for (int qq = 0; qq < q; ++qq) { pre[0] += SEGT[qq * 64 + ch0]; pre[1] += SEGT[qq * 64 + ch0 + 1]; }
                unsigned short at[4][2], bt[4][2], kt[4][2], rt[4][2], vt[4][2];
#pragma unroll
                for (int j = 0; j < 4; ++j)
#pragma unroll
                    for (int e = 0; e < 2; ++e) { const float g = pre[e] + cd[j][e], gp = j ? pre[e] + cd[j - 1][e] : pre[e]; const float eg = __expf(g), egp = __expf(gp), ieg = __builtin_amdgcn_rcpf(eg);
                        at[j][e] = bfs(egp * pkk[j][e]); bt[j][e] = bfs(pb[j][e] * ieg); kt[j][e] = bfs(pkm[j][e] * ieg); rt[j][e] = bfs(pr[j][e] * eg); vt[j][e] = bfs(pv[j][e]);
                        if (q == 15 && j == 3) gamC[ch0 + e] = eg; }
#pragma unroll
                for (int j = 0; j < 4; ++j) { const int t = 4 * q + j;
                    *(LAS unsigned*)(At + t * S64 + ch0) = (unsigned)at[j][0] | ((unsigned)at[j][1] << 16); *(LAS unsigned*)(Rt + t * S64 + ch0) = (unsigned)rt[j][0] | ((unsigned)rt[j][1] << 16);
                    *(LAS unsigned*)(E + t * S64 + ch0) = (unsigned)bt[j][0] | ((unsigned)bt[j][1] << 16); *(LAS unsigned*)(E + (64 + t) * S64 + ch0) = (unsigned)kt[j][0] | ((unsigned)kt[j][1] << 16); }
#pragma unroll
                for (int e = 0; e < 2; ++e) { const int ch = ch0 + e;
#define RW_Q4(x) (u32x2){(unsigned)x[0][e] | ((unsigned)x[1][e] << 16), (unsigned)x[2][e] | ((unsigned)x[3][e] << 16)}
                    *(LAS u32x2*)(AM + ch * S64 + 4 * q) = RW_Q4(at); *(LAS u32x2*)(ET + ch * S128 + 4 * q) = RW_Q4(bt); *(LAS u32x2*)(ET + ch * S128 + 64 + 4 * q) = RW_Q4(kt); *(LAS u32x2*)(X0T + ch * S128 + 64 + 4 * q) = RW_Q4(vt);
#undef RW_Q4
                }
            }
            __syncthreads();
            TSX(4);
            mm<4, 8, 2>(At, S64, E, S64, wave, lane, [&](int, int r0, int col, f32x4 a) {
                const int i = col & 63;
#pragma unroll
                for (int j = 0; j < 4; ++j) { const float v = (i < r0 + j) ? a[j] : 0.f; if (col < 64) Lf[(r0 + j) * LFS + i] = v; else Mm[(r0 + j) * S64 + i] = bfs(v); } });
            mm<4, 8, 2>(Rt, S64, E, S64, wave, lane, [&](int, int r0, int col, f32x4 a) {
                const int i = col & 63;
#pragma unroll
                for (int j = 0; j < 4; ++j) NN[(r0 + j) * S128 + col] = bfs((i <= r0 + j) ? a[j] : 0.f); });
            __syncthreads();
            TSX(5);
            mm<4, 4, 2>(Mm, S64, X0T + 64, S128, wave, lane, [&](int, int r0, int col, f32x4 a) { st4(AM + (64 + col) * S64 + r0, (f32x4){-a[0], -a[1], -a[2], -a[3]}); });
            for (int e = tid; e < 64 * 64; e += 512) { const int t = e >> 6, i = e & 63; const float lv = Lf[t * LFS + i]; const int tb = t >> 4, ib = i >> 4;
                E[t * S64 + i] = ((tb == 1 && ib == 0) || (tb == 3 && ib == 2)) ? bfs(lv) : (bf16_t)0;
                E[(64 + t) * S64 + i] = (t >= 32 && i < 32) ? bfs(lv) : (bf16_t)0;
                Tm[t * S64 + i] = 0; X0T[t * S128 + i] = 0; }
            __syncthreads();
            TSX(6);
            if (wave < 4 && lane < 16) { const int bb = wave * 16; float x[16];
#pragma unroll
                for (int r = 0; r < 16; ++r) { float s = (r == lane) ? 1.f : 0.f;
#pragma unroll
                    for (int i = 0; i < r; ++i) s -= Lf[(bb + r) * LFS + bb + i] * x[i];
                    x[r] = s; }
#pragma unroll
                for (int r = 0; r < 16; ++r) { const unsigned short xv = bfs(x[r]); Tm[(bb + r) * S64 + bb + lane] = xv; X0T[(bb + lane) * S128 + bb + r] = xv; } }
            __syncthreads();
            mm<4, 4, 2>(E, S64, X0T, S128, wave, lane, [&](int, int r0, int col, f32x4 a) { st4(Mm + col * S64 + r0, a); });
            __syncthreads();
            mm<4, 4, 2>(Tm, S64, Mm, S64, wave, lane, [&](int, int r0, int col, f32x4 a) {
                const int tb = r0 >> 4, jb = col >> 4; if ((tb == 1 && jb == 0) || (tb == 3 && jb == 2)) st4(X0T + col * S128 + r0, (f32x4){-a[0], -a[1], -a[2], -a[3]}); });
            __syncthreads();
            { const int p = tid >> 8, tt = (tid >> 4) & 15, jj = tid & 15, t = 16 * (2 * p + 1) + tt, j = 32 * p + jj; Tm[t * S64 + j] = X0T[j * S128 + t]; }
            __syncthreads();
            mm<4, 4, 2>(E + 64 * S64, S64, X0T, S128, wave, lane, [&](int, int r0, int col, f32x4 a) { st4(Mm + col * S64 + r0, a); });
            __syncthreads();
            mm<4, 4, 2>(Tm, S64, Mm, S64, wave, lane, [&](int, int r0, int col, f32x4 a) {
                if (r0 >= 32 && col < 32) {
#pragma unroll
                    for (int j = 0; j < 4; ++j) E[(r0 + j) * S64 + col] = bfs(-a[j]); } });
            __syncthreads();
            for (int e = tid; e < 32 * 32; e += 512) { const int t = 32 + (e >> 5), j = e & 31; Tm[t * S64 + j] = E[t * S64 + j]; }
            __syncthreads();
            TSX(7);
            mm<4, 8, 2>(Tm, S64, AM, S64, wave, lane, [&](int, int r0, int col, f32x4 a) { if (col < 64) st4(WT + col * S64 + r0, a); else st4(X0T + (col - 64) * S128 + r0, a); });
            __syncthreads();
            TSX(8);
            f32x4 gt[2], y0t[2];
            mm<4, 4, 2>(WT, S64, ET, S128, wave, lane, [&](int, int r0, int col, f32x4 a) { const float gc = gamC[col];
                f32x4 p;
#pragma unroll
                for (int j = 0; j < 4; ++j) p[j] = (((r0 + j) == col ? 1.f : 0.f) - a[j]) * gc;
                st4(PT + col * S64 + r0, p); });
            mm<4, 4, 4>(X0T, S128, ET, S128, wave, lane, [&](int ti, int, int col, f32x4 a) { const float gc = gamC[col]; gt[ti] = a * gc; });
            mm<4, 4, 4>(NN, S128, X0T, S128, wave, lane, [&](int ti, int, int, f32x4 a) { y0t[ti] = a; });
            mm<4, 4, 2>(NN, S128, WT, S64, wave, lane, [&](int, int r0, int col, f32x4 a) {
#pragma unroll
                for (int j = 0; j < 4; ++j) Qh[(r0 + j) * S64 + col] = bfs(bf2f(Rt[(r0 + j) * S64 + col]) - a[j]); });
            __syncthreads();
            TSX(9);
            GAS bf16_t* rslot = Z + row0 * ZW + h * 64; GAS bf16_t* kslot = rslot + 1024;
            mm<4, 4, 2>(Qh, S64, Pc, S64, wave, lane, [&](int, int r0, int col, f32x4 a) {
                const int kt_ = col >> 5, rho = col & 31, s = rho >> 4, jj = ((rho >> 3) & 1) * 4 + (rho & 3), hh = (rho >> 2) & 1;
#pragma unroll
                for (int j = 0; j < 4; ++j) { const int t = 64 * c + r0 + j, tt_ = t >> 5, ln = 32 * hh + (t & 31); const int e = ((((tt_ * 2 + kt_) * 2 + s) * 64 + ln) << 3) + jj;
                    if (!DUMMY) rslot[(size_t)(e >> 6) * ZW + (e & 63)] = bfs(a[j]); else asm volatile("" :: "v"(a[j])); } });
            mm<4, 4, 2>(Qh, S64, Gc, S64, wave, lane, [&](int ti, int r0, int col, f32x4 a) {
                const int vt_ = col >> 5, v31 = col & 31;
#pragma unroll
                for (int j = 0; j < 4; ++j) { const int t = 64 * c + r0 + j, tt_ = t >> 5, x = t & 31, hh = (x >> 2) & 1, r = (x & 3) + 4 * (x >> 3); const int e = (((tt_ * 2 + vt_) * 64 + 32 * hh + v31) << 4) + r;
                    if (!DUMMY) kslot[(size_t)(e >> 6) * ZW + (e & 63)] = bfs(a[j] + y0t[ti][j]); else asm volatile("" :: "v"(a[j] + y0t[ti][j])); } });
            f32x4 pn[2], gn[2];
            mm<4, 4, 2>(Pc, S64, PT, S64, wave, lane, [&](int ti, int, int, f32x4 a) { pn[ti] = a; });
            mm<4, 4, 2>(Gc, S64, PT, S64, wave, lane, [&](int ti, int, int, f32x4 a) { gn[ti] = a + gt[ti]; });
            if (has_n) fetch_compute();
            __syncthreads();
            { const int fr = lane & 15, g = lane >> 4;
#pragma unroll
              for (int ti = 0; ti < 2; ++ti) { const int tile = wave + 8 * ti, mt = tile >> 2, nt = tile & 3;
#pragma unroll
                  for (int j = 0; j < 4; ++j) { Pc[(mt * 16 + 4 * g + j) * S64 + nt * 16 + fr] = bfs(pn[ti][j]); Gc[(mt * 16 + 4 * g + j) * S64 + nt * 16 + fr] = bfs(gn[ti][j]); } } }
            TSX(10);
        }
        __syncthreads();
        if (!DUMMY) { GAS bf16_t* pg = PG + (size_t)u * 8192;
          { const int f = tid >> 6, ln = tid & 63, s = f & 1, kit = (f >> 1) & 1, kot = f >> 2, hh = ln >> 5, r31 = ln & 31; unsigned short w[8];
#pragma unroll
            for (int j = 0; j < 8; ++j) { const int rho = 16 * s + 8 * (j >> 2) + 4 * hh + (j & 3); w[j] = Pc[(32 * kit + rho) * S64 + 32 * kot + r31]; }
            *(GAS u32x4*)(pg + (size_t)tid * 8) = (u32x4){(unsigned)w[0] | ((unsigned)w[1] << 16), (unsigned)w[2] | ((unsigned)w[3] << 16), (unsigned)w[4] | ((unsigned)w[5] << 16), (unsigned)w[6] | ((unsigned)w[7] << 16)}; }
          { const int tile = tid >> 7, ln = (tid >> 1) & 63, half = tid & 1, kot = tile >> 1, vt_ = tile & 1, hh = ln >> 5, v31 = ln & 31; unsigned short w[8];
#pragma unroll
            for (int q = 0; q < 8; ++q) { const int r = 8 * half + q; const int ko = 32 * kot + (r & 3) + 8 * (r >> 2) + 4 * hh; w[q] = Gc[(32 * vt_ + v31) * S64 + ko]; }
            *(GAS u32x4*)(pg + 4096 + ((size_t)(tile * 64 + ln) << 4) + 8 * half) = (u32x4){(unsigned)w[0] | ((unsigned)w[1] << 16), (unsigned)w[2] | ((unsigned)w[3] << 16), (unsigned)w[4] | ((unsigned)w[5] << 16), (unsigned)w[6] | ((unsigned)w[7] << 16)}; } }
    }
    __syncthreads();
}

__device__ __forceinline__ void rwkv_stage_y(Frame& F, const int bx) {
    const int lane = F.lane, wave = F.wave, bh = bx, vt = wave >> 2; const bool st = ((wave & 3) == 0);
    const bf16_t* PG = (const bf16_t*)(F.H); u32x4* SB = (u32x4*)(F.ws + WS_SB);
    LAS bf16x8* pgbuf = (LAS bf16x8*)F.lds;
    f32x16 X0, X1;
#pragma unroll
    for (int r = 0; r < 16; ++r) { X0[r] = 0.f; X1[r] = 0.f; }
    bf16x8 Ra0, Ra1, Rb0, Rb1, Rc0, Rc1;
    auto issue = [&](bf16x8& r0, bf16x8& r1, int blk) { const bf16_t* pg = PG + (size_t)(blk * 32 + bh) * 8192;
        r0 = ld8p(pg + (((size_t)(wave * 2 + 0) * 64 + lane) << 3)); r1 = ld8p(pg + (((size_t)(wave * 2 + 1) * 64 + lane) << 3)); };
    auto step = [&](bf16x8& c0, bf16x8& c1, bf16x8& n0r, bf16x8& n1r, int blk) {
        const bf16x8 nga = n0r, ngb = n1r;
        issue(c0, c1, blk + 3 < 64 ? blk + 3 : 63);
        asm volatile("s_waitcnt lgkmcnt(0)" ::: "memory"); __builtin_amdgcn_s_barrier(); asm volatile("" ::: "memory");
        pgbuf[((blk + 1) & 1) * 1024 + (wave * 2 + 0) * 64 + lane] = nga; pgbuf[((blk + 1) & 1) * 1024 + (wave * 2 + 1) * 64 + lane] = ngb;
        if (st) {
            u32x4 xb[4];
#pragma unroll
            for (int s = 0; s < 2; ++s) {
                xb[s] = (u32x4){cvt_pk_bf16(X0[8 * s], X0[8 * s + 1]), cvt_pk_bf16(X0[8 * s + 2], X0[8 * s + 3]), cvt_pk_bf16(X0[8 * s + 4], X0[8 * s + 5]), cvt_pk_bf16(X0[8 * s + 6], X0[8 * s + 7])};
                xb[2 + s] = (u32x4){cvt_pk_bf16(X1[8 * s], X1[8 * s + 1]), cvt_pk_bf16(X1[8 * s + 2], X1[8 * s + 3]), cvt_pk_bf16(X1[8 * s + 4], X1[8 * s + 5]), cvt_pk_bf16(X1[8 * s + 6], X1[8 * s + 7])}; }
            u32x4* sb = SB + ((size_t)(blk * 32 + bh) * 8 + vt * 4) * 64 + lane;
#pragma unroll
            for (int q = 0; q < 4; ++q) sb[q * 64] = xb[q];
            const LAS bf16x8* pb = pgbuf + (blk & 1) * 1024;
            f32x16 n0, n1;
            { const bf16x8 c0a = pb[512 + ((0 * 2 + vt) * 64 + lane) * 2], c0b = pb[512 + ((0 * 2 + vt) * 64 + lane) * 2 + 1], c1a = pb[512 + ((1 * 2 + vt) * 64 + lane) * 2], c1b = pb[512 + ((1 * 2 + vt) * 64 + lane) * 2 + 1];
#pragma unroll
              for (int r = 0; r < 8; ++r) { n0[r] = bf2f((bf16_t)c0a[r]); n0[8 + r] = bf2f((bf16_t)c0b[r]); n1[r] = bf2f((bf16_t)c1a[r]); n1[8 + r] = bf2f((bf16_t)c1b[r]); } }
#pragma unroll
            for (int q = 0; q < 4; ++q) {
                n0 = __builtin_amdgcn_mfma_f32_32x32x16_bf16(pb[q * 64 + lane], __builtin_bit_cast(bf16x8, xb[q]), n0, 0, 0, 0);
                n1 = __builtin_amdgcn_mfma_f32_32x32x16_bf16(pb[(4 + q) * 64 + lane], __builtin_bit_cast(bf16x8, xb[q]), n1, 0, 0, 0); }
            X0 = n0; X1 = n1;
        }
    };
    issue(Ra0, Ra1, 0); issue(Rb0, Rb1, 1); issue(Rc0, Rc1, 2);
    pgbuf[(wave * 2 + 0) * 64 + lane] = Ra0; pgbuf[(wave * 2 + 1) * 64 + lane] = Ra1;
#pragma unroll 1
    for (int blk = 0; blk < 63; blk += 3) { step(Ra0, Ra1, Rb0, Rb1, blk); step(Rb0, Rb1, Rc0, Rc1, blk + 1); step(Rc0, Rc1, Ra0, Ra1, blk + 2); }
    step(Ra0, Ra1, Rb0, Rb1, 63);
    __syncthreads();
}

template <bool DUMMY>
__device__ __forceinline__ void rwkv_stage_z(Frame& F, int li) {
    const int o = li >> 1;
    bf16_t* Z = (bf16_t*)(F.ws + WS_Z); const float* BON = (const float*)(F.ws + WS_BON); const u32x4* SB = (const u32x4*)(F.ws + WS_SB);
    const float* lgp = F.in[24] + o * D; const float* lbp = F.in[25] + o * D;
    LAS float* tile = (LAS float*)(F.lds + F.wave * 9216);
    int lane_ = F.lane;
#pragma unroll 1
    for (int w = F.vcu * 8 + F.wave; w < 8192; w += F.G * 8) {
        asm volatile("" : "+v"(lane_)); const int lane = lane_, v31 = lane & 31, hh = lane >> 5, tl = lane >> 1, hf = lane & 1;
        const int u = w >> 2, tt = w & 3, bh = u & 31, blk = u >> 5, b = bh >> 4, h = bh & 15; const size_t row0 = (size_t)b * SEQ + (size_t)blk * 128;
        const bf16_t* rslot = Z + row0 * ZW + h * 64; const bf16_t* kslot = rslot + 1024;
        const size_t row = row0 + 32 * tt + tl; bf16_t* zp = Z + row * ZW + h * 64 + 32 * hf;
        bf16x8 vv[4], gg[4];
#pragma unroll
        for (int q = 0; q < 4; ++q) { vv[q] = ld8p(zp + 2048 + 8 * q); gg[q] = ld8p(zp + 3072 + 8 * q); }
        const float bon = BON[row * 16 + h];
        bf16x8 qf[4]; u32x4 xb[2][4];
#pragma unroll
        for (int q = 0; q < 4; ++q) { const int e = (((tt * 4 + q) * 64 + lane) << 3); qf[q] = ld8p(rslot + (size_t)(e >> 6) * ZW + (e & 63)); }
#pragma unroll
        for (int vt = 0; vt < 2; ++vt)
#pragma unroll
            for (int q = 0; q < 4; ++q) xb[vt][q] = SB[((size_t)u * 8 + vt * 4 + q) * 64 + lane];
#pragma unroll
        for (int vt = 0; vt < 2; ++vt) { const int e0 = ((tt * 2 + vt) * 64 + lane) << 4; const bf16_t* yp = kslot + (size_t)(e0 >> 6) * ZW + (e0 & 63); const bf16x8 ya = ld8p(yp), yb = ld8p(yp + 8);
            f32x16 acc;
#pragma unroll
            for (int r = 0; r < 8; ++r) { acc[r] = bf2f((bf16_t)ya[r]); acc[8 + r] = bf2f((bf16_t)yb[r]); }
#pragma unroll
            for (int q = 0; q < 4; ++q) acc = __builtin_amdgcn_mfma_f32_32x32x16_bf16(qf[q], __builtin_bit_cast(bf16x8, xb[vt][q]), acc, 0, 0, 0);
#pragma unroll
            for (int r = 0; r < 16; ++r) tile[((r & 3) + 8 * (r >> 2) + 4 * hh) * 72 + 36 * vt + v31] = acc[r]; }
        LDS_WAIT(); asm volatile("" ::: "memory");
        float y[32]; float sm = 0.f;
#pragma unroll
        for (int q = 0; q < 8; ++q) { const f32x4 t4 = *(const LAS f32x4*)(tile + tl * 72 + 36 * hf + 4 * q); y[4 * q] = t4[0]; y[4 * q + 1] = t4[1]; y[4 * q + 2] = t4[2]; y[4 * q + 3] = t4[3]; sm += (t4[0] + t4[1]) + (t4[2] + t4[3]); }
        sm += __shfl_xor(sm, 1);
        const float mu = sm * (1.f / 64.f); float qq = 0.f;
#pragma unroll
        for (int j = 0; j < 32; ++j) { y[j] -= mu; qq += y[j] * y[j]; }
        qq += __shfl_xor(qq, 1);
        const float rsd = rsqrtf(qq * (1.f / 64.f) + 64e-5f);
        const float* lg = lgp + h * 64 + 32 * hf; const float* lb = lbp + h * 64 + 32 * hf;
#pragma unroll
        for (int q = 0; q < 4; ++q) { float ov[8];
#pragma unroll
            for (int j = 0; j < 8; ++j) { const int c = 8 * q + j; const float va = bf2f((bf16_t)vv[q][j]), ga = bf2f((bf16_t)gg[q][j]); ov[j] = (y[c] * rsd * lg[c] + lb[c] + bon * va) * siluf_(ga); }
            const u32x4 wv = {cvt_pk_bf16(ov[0], ov[1]), cvt_pk_bf16(ov[2], ov[3]), cvt_pk_bf16(ov[4], ov[5]), cvt_pk_bf16(ov[6], ov[7])};
            if (!DUMMY) *(u32x4*)(zp + 3072 + 8 * q) = wv; else asm volatile("" :: "v"(wv)); }
        LDS_WAIT(); asm volatile("" ::: "memory");
    }
}

enum { PH_P0 = 0, PH_FINAL = 27, N_PHASES = 28 };
#define IN(k) (lo <= (k) && (k) < hi)
#define TSG(k) do { if (LI == 0) { if (MK_GA == (k)) tA = __builtin_amdgcn_s_memrealtime(); if (MK_GB == (k)) tB = __builtin_amdgcn_s_memrealtime(); } } while (0)
#define TS(k) do { if (MK_TPA == (k)) tA = __builtin_amdgcn_s_memrealtime(); if (MK_TPB == (k)) tB = __builtin_amdgcn_s_memrealtime(); } while (0)
#if MK_MULTI
#define SEAM(k) do { } while (0)
#else
#define SEAM(k) do { if (IN(k) && IN((k) + 1)) xcd_barrier(bar); } while (0)
#endif
template <int LI>
__device__ __forceinline__ void run_layer(Frame& F, const XcdBarrier& bar, const int lo, const int hi, const int bx, unsigned long long& tA, unsigned long long& tB) {
    constexpr bool even = (LI & 1) == 0;
    constexpr int base = 1 + (LI / 2) * 13 + (even ? 0 : 6);
    bf16_t* Zp = (bf16_t*)(F.ws + WS_Z);
    if constexpr (even) {
        TS(base); if (IN(base)) { F.retid(); pg8::StaticOrder S; S.init(64, 16, F.G, bx);
            pg8::Gemm g{(const bf16_t*)(F.ws + WS_HB), (const bf16_t*)(F.ws + WS_WIN)};
            EpiEvenIn E{Zp, F.ssq(LI), (bf16_t*)(F.ws + WS_VTA), (bf16_t*)(F.ws + WS_VTB), (bf16_t*)(F.ws + WS_KT)};
            if (MK_PROBE == 1) pg8::gemm_phase<EpiEvenIn, true, D, D, 1 << 20, 0, 0>(F.lds, F.tid, g, S, E);
            pg8::gemm_phase<EpiEvenIn, true, D, D, 1 << 20, 0, 0>(F.lds, F.tid, g, S, E); }
        SEAM(base);
        TS(base + 1); if (IN(base + 1)) { F.retid();
            TSG(0); conv_wrest(F, LI); TSG(1);
            if constexpr (LI < 3) conv_win_odd(F, LI + 1);
            TSG(2);
            if (MK_PROBE == 5) { for (int u = F.vcu * 8 + F.wave; u < 4096; u += F.G * 8) ret_stage_a(F, u);
                for (int u = F.vcu * 8 + F.wave; u < 2048; u += F.G * 8) sb_unit<true>(F, u >> 8, u & 255); }
            for (int u = F.vcu * 8 + F.wave; u < 4096; u += F.G * 8) ret_stage_a(F, u);
            __syncthreads(); TSG(3);
            for (int u = F.vcu * 8 + F.wave; u < 2048; u += F.G * 8) sb_unit<false>(F, u >> 8, u & 255);
            __syncthreads(); TSG(4); }
        SEAM(base + 1);
        TS(base + 2); if (IN(base + 2)) { F.retid(); ret_stage_b(F); }
        SEAM(base + 2);
        TS(base + 3); if (IN(base + 3)) { F.retid(); const float* gng = F.in[8] + (LI >> 1) * 512;
            if (MK_PROBE == 6) for (int u = F.vcu * 8 + F.wave; u < 2048; u += F.G * 8) ret_stage_c<true>(F, u, gng);
            for (int u = F.vcu * 8 + F.wave; u < 2048; u += F.G * 8) ret_stage_c<false>(F, u, gng); }
        SEAM(base + 3);
        TS(base + 4); if (IN(base + 4)) { F.retid(); pg8::StaticOrder S; S.init(64, 4, F.G, bx);
            { pg8::Gemm g{(const bf16_t*)(F.ws + WS_PB), (const bf16_t*)(F.ws + WS_WPROJ)};
              EpiStore E{Zp, ZE}; pg8::gemm_phase<EpiStore, false, PLE, PLE, 1 << 20, 0, 0>(F.lds, F.tid, g, S, E); }
            { pg8::Gemm g{Zp + 1024, (const bf16_t*)(F.ws + WS_WOUT)};
              EpiResid E{(const bf16_t*)(F.ws + WS_HB), Zp + 1536, ZE}; pg8::gemm_phase<EpiResid, false, ZE, D, 8, (long)((2560 - 1024) * 2), 0>(F.lds, F.tid, g, S, E); } }
        SEAM(base + 4);
        TS(base + 5); if (IN(base + 5)) { F.retid(); pg8::StaticOrder S; S.init(64, 4, F.G, bx);
            pg8::Gemm g{Zp + 1536, (const bf16_t*)(F.ws + WS_WGATE)};
            EpiGate E{Zp + 1536, ZE, Zp, ZE, (bf16_t*)(F.ws + WS_HB), F.ssq(LI + 1)};
            pg8::gemm_phase<EpiGate, false, ZE, D, 1 << 20, 0, 0>(F.lds, F.tid, g, S, E); }
        SEAM(base + 5);
    } else {
        TS(base); if (IN(base)) { F.retid(); conv_lora2(F, LI); norm_lora_phase(F, LI); }
        SEAM(base);
        TS(base + 1); if (IN(base + 1)) { F.retid(); pg8::StaticOrder S; S.init(64, 16, F.G, bx);
            pg8::Gemm g{(const bf16_t*)(F.H) + D, (const bf16_t*)(F.ws + WS_WIN)};
            EpiOddIn E{Zp, (bf16_t*)(F.ws + WS_L1)};
            if (MK_PROBE == 2) pg8::gemm_phase<EpiOddIn, true, D, 2048, 16, -(long)(D * 2), (long)(D * 2)>(F.lds, F.tid, g, S, E);
            pg8::gemm_phase<EpiOddIn, true, D, 2048, 16, -(long)(D * 2), (long)(D * 2)>(F.lds, F.tid, g, S, E); }
        SEAM(base + 1);
        TS(base + 2); if (IN(base + 2)) { F.retid();
            conv_wrest(F, LI);
            __syncthreads();
            { unsigned long long xa = 0; rwkv_stage_x<false>(F, LI, xa); if (LI == 1 && MK_XA >= 0) { tA = 0; tB = xa; } } }
        SEAM(base + 2);
        TS(base + 3); if (IN(base + 3)) { F.retid();
            if (bx < 32) rwkv_stage_y(F, bx);
            else { pg8::StaticOrder S; S.init(64, 4, F.G - 32, bx - 32);
                pg8::Gemm g{(const bf16_t*)(F.ws + WS_PB), (const bf16_t*)(F.ws + WS_WPROJ)};
                EpiStore E{(bf16_t*)(F.H) + (size_t)16 * 1024 * 1024, D}; pg8::gemm_phase<EpiStore, false, PLE, PLE, 1 << 20, 0, 0>(F.lds, F.tid, g, S, E); } }
        SEAM(base + 3);
        TS(base + 4); if (IN(base + 4)) { F.retid(); rwkv_stage_z<false>(F, LI); }
        SEAM(base + 4);
        TS(base + 5); if (IN(base + 5)) { F.retid(); pg8::StaticOrder S; S.init(64, 4, F.G, bx);
            if constexpr (LI < 3) { conv_win_even(F, LI + 1); __syncthreads(); }
            { pg8::Gemm g{Zp + 3072, (const bf16_t*)(F.ws + WS_WOUT)};
              EpiResid E{(const bf16_t*)(F.ws + WS_HB), Zp + 2048, ZW}; pg8::gemm_phase<EpiResid, false, ZW, D, 1 << 20, 0, 0>(F.lds, F.tid, g, S, E); } }
        SEAM(base + 5);
        TS(base + 6); if (IN(base + 6)) { F.retid(); pg8::StaticOrder S; S.init(64, 4, F.G, bx);
            pg8::Gemm g{Zp + 2048, (const bf16_t*)(F.ws + WS_WGATE)};
            EpiGate E{Zp + 2048, ZW, (const bf16_t*)(F.H) + (size_t)16 * 1024 * 1024, D, (bf16_t*)(F.ws + WS_HB), F.ssq(LI + 1)};
            pg8::gemm_phase<EpiGate, false, ZW, D, 1 << 20, 0, 0>(F.lds, F.tid, g, S, E); }
        SEAM(base + 6);
    }
}
__global__ void __launch_bounds__(512, 2) mk_fwd(Args args) {
    extern __shared__ __attribute__((aligned(16))) unsigned char lds_raw[];
    Frame F;
    F.lds = (LAS unsigned char*)lds_raw; F.ldsg = lds_raw;
    F.tid = threadIdx.x; F.lane = F.tid & 63; F.wave = __builtin_amdgcn_readfirstlane(F.tid >> 6);
    F.G = gridDim.x; const int bx = blockIdx.x; F.vcu = (F.G % 8 == 0) ? (bx % 8) * (F.G / 8) + bx / 8 : bx;
    F.H = args.out; F.ws = args.ws;
    volatile LAS unsigned* MISC = (volatile LAS unsigned*)(F.lds + MISC_OFF);
    for (int u = F.tid; u < 128; u += 512) ((LAS unsigned*)(F.lds + MISC_OFF))[u] = 0u;
    __syncthreads();
    XcdBarrier bar; bar.bar = (unsigned*)(F.ws + WS_CTL) + 4096; bar.x = 0; bar.st = nullptr;
#if !MK_MULTI
    bar = xcd_barrier_post((unsigned*)(F.ws + WS_CTL) + 4096, MISC + 8);
#endif
    const int lo = args.ph_lo, hi = args.ph_hi;
    if (IN(PH_P0)) { F.retid(); rows_p0(F); conv_win_even(F, 0); }
#if !MK_MULTI
    if (IN(0) && IN(1)) { VM_WAIT(); cg::this_grid().sync(); }
#endif
    unsigned long long tA = 0, tB = 0;
    TS(0);
    run_layer<0>(F, bar, lo, hi, bx, tA, tB);
    run_layer<1>(F, bar, lo, hi, bx, tA, tB);
    run_layer<2>(F, bar, lo, hi, bx, tA, tB);
    run_layer<3>(F, bar, lo, hi, bx, tA, tB);
    TS(PH_FINAL);
    if (IN(PH_FINAL)) { F.retid(); rows_final(F); }
    TS(PH_FINAL + 1);
    if ((MK_TPA >= 0 || MK_XA >= 0 || MK_GA >= 0) && blockIdx.x == 0 && threadIdx.x == 0) { const unsigned long long t0 = __builtin_amdgcn_s_memrealtime(), span = 4ull * (tB - tA); while (__builtin_amdgcn_s_memrealtime() - t0 < span) __builtin_amdgcn_s_sleep(8); }
}

extern "C" void kernel_launch(void* const* d_in, const int* in_sizes, int n_in, void* d_out, int out_size, void* d_ws, size_t ws_size, hipStream_t stream) {
    static int grid = 0;
    if (grid == 0) {
        int dev = 0, cus = 0, per_cu = 0;
        (void)hipGetDevice(&dev); (void)hipDeviceGetAttribute(&cus, hipDeviceAttributeMultiprocessorCount, dev);
        (void)hipFuncSetAttribute((const void*)mk_fwd, hipFuncAttributeMaxDynamicSharedMemorySize, LDS_BYTES);
        (void)hipOccupancyMaxActiveBlocksPerMultiprocessor(&per_cu, (const void*)mk_fwd, 512, LDS_BYTES);
        if (per_cu < 1) per_cu = 1;
        grid = cus * 1;
        if (n_in != 26 || ws_size < WS_END) fprintf(stderr, "kernel_launch: unexpected n_in %d / ws %zu\n", n_in, ws_size);
        (void)hipGetLastError();
    }
    (void)hipMemsetAsync((char*)d_ws + WS_CTL, 0, CTL_BYTES, stream);
    Args a{};
    for (int i = 0; i < 26; ++i) a.in[i] = (const float*)d_in[i];
    a.out = (float*)d_out; a.ws = (unsigned char*)d_ws;
#if MK_MULTI
    for (int ph = 0; ph < N_PHASES; ++ph) { a.ph_lo = ph; a.ph_hi = ph + 1; hipLaunchKernelGGL(mk_fwd, dim3(grid), dim3(512), LDS_BYTES, stream, a); }
#else
    a.ph_lo = 0; a.ph_hi = N_PHASES;
    void* kargs[] = {&a};
    hipError_t e = hipLaunchCooperativeKernel((const void*)mk_fwd, dim3(grid), dim3(512), kargs, LDS_BYTES, stream);
    if (e != hipSuccess) fprintf(stderr, "cooperative launch failed: %s (grid %d)\n", hipGetErrorString(e), grid);
#endif
}
```

```cpp
#include <hip/hip_runtime.h>
#include <hip/hip_cooperative_groups.h>
#include <cstdint>
#include <cstdio>
namespace cg = cooperative_groups;

#ifndef MK_PROBE
#define MK_PROBE 0
#endif
#ifndef MK_TPA
#define MK_TPA -1
#define MK_TPB -1
#endif
#ifndef MK_XA
#define MK_XA -1
#define MK_XB -1
#endif
#ifndef MK_GA
#define MK_GA -1
#define MK_GB -1
#endif
#ifndef MK_MULTI
#define MK_MULTI 0
#endif

#define LAS __attribute__((address_space(3)))
#define GAS __attribute__((address_space(1)))
typedef unsigned short bf16_t;
typedef short bf16x8 __attribute__((ext_vector_type(8)));
typedef float f32x4 __attribute__((ext_vector_type(4)));
typedef float f32x2 __attribute__((ext_vector_type(2)));
typedef unsigned u32x4 __attribute__((ext_vector_type(4)));
typedef unsigned u32x2 __attribute__((ext_vector_type(2)));

constexpr int D = 1024, BATCH = 2, SEQ = 8192, T = BATCH * SEQ, PLE = 256, ZW = 4096, ZE = 3072;
constexpr float QK_SCALE = 0.08838834764831845f;

__device__ __forceinline__ float bf2f(bf16_t v) { return __uint_as_float(((unsigned)v) << 16); }
__device__ __forceinline__ unsigned f2bf(float f) { unsigned u = __float_as_uint(f); return (u + 0x7fffu + ((u >> 16) & 1u)) >> 16; }
__device__ __forceinline__ unsigned pk2(float lo, float hi) { return f2bf(lo) | (f2bf(hi) << 16); }
typedef __bf16 bf16x2_t __attribute__((ext_vector_type(2)));
__device__ __forceinline__ unsigned cvt_pk_bf16(float lo, float hi) { f32x2 v = {lo, hi}; bf16x2_t b = __builtin_convertvector(v, bf16x2_t); return __builtin_bit_cast(unsigned, b); }
__device__ __forceinline__ float wave_sum(float v) {
#pragma unroll
    for (int o = 1; o < 64; o <<= 1) v += __shfl_xor(v, o);
    return v;
}
__device__ __forceinline__ float sigmoidf_(float x) { return __builtin_amdgcn_rcpf(1.f + __expf(-x)); }
__device__ __forceinline__ float siluf_(float x) { return x * __builtin_amdgcn_rcpf(1.f + __expf(-x)); }
__device__ __forceinline__ float softplusf_(float x) { return x > 20.f ? x : log1pf(expf(x)); }
__device__ __forceinline__ float logsigf_(float x) { return -(x < -20.f ? -x : log1pf(expf(-x))); }
__device__ __forceinline__ float ssq_sum(const float* sq, int row) { const f32x4* p = (const f32x4*)(sq + (size_t)row * 16); const f32x4 a = p[0], b = p[1], c = p[2], d = p[3];
    return (((a[0] + a[1]) + (a[2] + a[3])) + ((b[0] + b[1]) + (b[2] + b[3]))) + (((c[0] + c[1]) + (c[2] + c[3])) + ((d[0] + d[1]) + (d[2] + d[3]))); }
#define LDS_WAIT() asm volatile("s_waitcnt lgkmcnt(0)" ::: "memory")
#define VM_WAIT() asm volatile("s_waitcnt vmcnt(0)" ::: "memory")

namespace pg8 {
constexpr int BM = 256, BK = 64, HALF = 128, HTB = HALF * BK * 2, STAGE_BYTES = 8 * HTB, NXCD = 8, WGM = 8;
__host__ __device__ __forceinline__ int lds_byte(int r, int c) { const int st = (r >> 4) * 2 + (c >> 5), rr = r & 15, cc = c & 31, ob = rr * 64 + cc * 2; return st * 1024 + (ob ^ (((ob >> 9) & 1) << 5)); }
__host__ __device__ __forceinline__ void stage_rc(int b, int& R, int& C) { const int st = b / 1024, sb = b % 1024, swz = sb ^ (((sb >> 9) & 1) << 5); R = (st >> 1) * 16 + swz / 64; C = (st & 1) * 32 + (swz % 64) / 2; }
__host__ __device__ __forceinline__ int perm32(int rho) { const int n = rho >> 4, i = rho & 15; return 8 * (i >> 2) + 4 * n + (i & 3); }
struct Unit { int pm, pn; };
struct Gemm { const bf16_t* A; const bf16_t* Bt; };
struct StaticOrder {
    int nM, nN, nwg, G, c;
    __device__ void init(int nM_, int nN_, int G_, int c_) { nM = nM_; nN = nN_; nwg = nM * nN; G = G_; c = c_; }
    __device__ bool next(int i, Unit& u) const {
        const long L = (long)i * G + c; if (L >= nwg) return false;
        int wgid = (int)L; { const int q = nwg / NXCD, r = nwg % NXCD, xcd = wgid % NXCD, off = wgid / NXCD; wgid = (xcd < r ? xcd * (q + 1) : r * (q + 1) + (xcd - r) * q) + off; }
        const int nig = WGM * nN, gid = wgid / nig, fm = gid * WGM, gsz = (nM - fm) < WGM ? (nM - fm) : WGM;
        u.pm = fm + ((wgid % nig) % gsz); u.pn = (wgid % nig) / gsz; return true;
    }
};
template <class Epi, bool ALIGN_EPI, int LDA, int KK, int TSPLIT, long ASHIFT, long BROW>
__device__ __forceinline__ void gemm_phase(LAS unsigned char* lds, const int tid_in, const Gemm g, const StaticOrder& S, const Epi& E) {
    int tid = tid_in; asm volatile("" : "+v"(tid));
    const int wid = __builtin_amdgcn_readfirstlane(tid >> 6), lane = tid & 63, wr = wid >> 2, wc = wid & 3, fr = lane & 15, fq = lane >> 4;
    constexpr int K = KK, nt = K / BK, lda = LDA, tsplit = TSPLIT; constexpr long ashift = ASHIFT;
    unsigned voffA[2], voffB[2];
#pragma unroll
    for (int i = 0; i < 2; ++i) { int R, C; stage_rc(tid * 16 + i * 8192, R, C); const int Rb = (R & ~31) + perm32(R & 31);
        voffA[i] = (unsigned)(R * lda + C) * 2u; voffB[i] = (unsigned)(Rb * K + C) * 2u; }
    constexpr size_t kstep = (size_t)(BK * 2);
    constexpr size_t hstepA = (size_t)HALF * lda * 2, hstepB = (size_t)HALF * K * 2, tstepA = 2 * hstepA, tstepB = 2 * hstepB;
    const unsigned ldsw = (unsigned)wid * 1024u;
    const int aoff = lds_byte(wr * 64 + fr, fq * 8), boff = lds_byte(wc * 32 + fr, fq * 8);
#define PG8_AP(base, tt) ((base) + (((tt) < tsplit) ? (long)(tt) * 128 : ashift + (long)((tt) - tsplit) * 128))
#define PG8_ABASE(u) ((const char*)g.A + (size_t)(u).pm * tstepA + ((BROW != 0 && (u).pm >= 32) ? BROW : 0))
#define PG8_SA(b, h) (((b) * 2 + (h)) * HTB)
#define PG8_SB(b, h) ((4 + (b) * 2 + (h)) * HTB)
#define PG8_STAGE(bufoff, gbase, voff) do { const char* _gb = (const char*)(gbase); asm volatile("" : "+s"(_gb)); _Pragma("unroll") for (int _i = 0; _i < 2; ++_i) \
        __builtin_amdgcn_global_load_lds((const unsigned*)(_gb + (voff)[_i]), (LAS unsigned*)(lds + (bufoff) + ldsw + _i * 8192), 16, 0, 0); } while (0)
#define PG8_LDA(dst, b, h) do { _Pragma("unroll") for (int m = 0; m < 4; ++m) _Pragma("unroll") for (int k = 0; k < 2; ++k) dst[m][k] = *(const LAS bf16x8*)(lds + PG8_SA(b, h) + aoff + m * 2048 + k * 1024); } while (0)
#define PG8_LDB(dst, b, h) do { _Pragma("unroll") for (int n = 0; n < 2; ++n) _Pragma("unroll") for (int k = 0; k < 2; ++k) dst[n][k] = *(const LAS bf16x8*)(lds + PG8_SB(b, h) + boff + n * 2048 + k * 1024); } while (0)
#define PG8_MMA(ai, bj, At, Bt) do { __builtin_amdgcn_s_setprio(1); _Pragma("unroll") for (int m = 0; m < 4; ++m) _Pragma("unroll") for (int n = 0; n < 2; ++n) _Pragma("unroll") for (int k = 0; k < 2; ++k) \
        acc[ai][bj][m][n] = __builtin_amdgcn_mfma_f32_16x16x32_bf16(Bt[n][k], At[m][k], acc[ai][bj][m][n], 0, 0, 0); __builtin_amdgcn_s_setprio(0); } while (0)
#define PG8_WAIT_V(n) asm volatile("s_waitcnt vmcnt(" #n ")" ::: "memory")
#define PG8_WAIT_L(n) asm volatile("s_waitcnt lgkmcnt(" #n ")" ::: "memory")
#define PG8_BAR __builtin_amdgcn_s_barrier()
#define PG8_SCHED __builtin_amdgcn_sched_barrier(0)
    Unit cur, nxt; int ui = 0;
    if (!S.next(0, cur)) return;
    f32x4 acc[2][2][4][2];
#pragma unroll
    for (int a = 0; a < 2; ++a)
#pragma unroll
        for (int b = 0; b < 2; ++b)
#pragma unroll
            for (int m = 0; m < 4; ++m)
#pragma unroll
                for (int n = 0; n < 2; ++n) acc[a][b][m][n] = (f32x4){0.f, 0.f, 0.f, 0.f};
    bf16x8 At[4][2], B0[2][2], B1[2][2];
    const char* cA = PG8_ABASE(cur); const char* cB = (const char*)g.Bt + (size_t)cur.pn * tstepB;
    {
        const char* a0 = PG8_AP(cA, 0); const char* a1 = PG8_AP(cA, 1);
        PG8_STAGE(PG8_SB(0, 0), cB, voffB); PG8_STAGE(PG8_SB(0, 1), cB + hstepB, voffB); PG8_STAGE(PG8_SA(0, 0), a0, voffA); PG8_STAGE(PG8_SA(0, 1), a0 + hstepA, voffA);
        if (wr == 1) PG8_BAR;
        PG8_WAIT_V(2); PG8_BAR;
        PG8_STAGE(PG8_SB(1, 0), cB + kstep, voffB); PG8_STAGE(PG8_SA(1, 0), a1, voffA); PG8_STAGE(PG8_SB(1, 1), cB + hstepB + kstep, voffB);
        PG8_WAIT_V(6); PG8_BAR;
    }
    for (;;) {
        const bool has_next = S.next(ui + 1, nxt);
        const char* nA = has_next ? PG8_ABASE(nxt) : cA; const char* nB = has_next ? (const char*)g.Bt + (size_t)nxt.pn * tstepB : cB;
        for (int t = 0; t < nt; t += 2) {
            const bool last = (t == nt - 2);
            const char* a1 = PG8_AP(cA, t + 1);
            const char* a2 = last ? PG8_AP(nA, 0) : PG8_AP(cA, t + 2); const char* b2 = last ? nB : cB + (size_t)(t + 2) * kstep;
            const char* a3 = last ? PG8_AP(nA, 1) : PG8_AP(cA, t + 3); const char* b3 = b2 + kstep;
            PG8_LDB(B0, 0, 0); PG8_LDB(B1, 0, 1); PG8_SCHED; PG8_LDA(At, 0, 0); PG8_STAGE(PG8_SA(1, 1), a1 + hstepA, voffA);
            PG8_WAIT_V(8); PG8_WAIT_L(0); PG8_BAR; PG8_MMA(0, 0, At, B0); PG8_MMA(0, 1, At, B1); PG8_BAR; PG8_SCHED;
            PG8_LDA(At, 0, 1); PG8_STAGE(PG8_SB(0, 0), b2, voffB); PG8_STAGE(PG8_SB(0, 1), b2 + hstepB, voffB); PG8_STAGE(PG8_SA(0, 0), a2, voffA);
            PG8_WAIT_V(8); PG8_WAIT_L(0); PG8_BAR; PG8_MMA(1, 0, At, B0); PG8_MMA(1, 1, At, B1); PG8_BAR; PG8_SCHED;
            PG8_LDB(B0, 1, 0); PG8_LDB(B1, 1, 1); PG8_SCHED; PG8_LDA(At, 1, 0); PG8_STAGE(PG8_SA(0, 1), a2 + hstepA, voffA);
            PG8_WAIT_V(8); PG8_WAIT_L(0); PG8_BAR; PG8_MMA(0, 0, At, B0); PG8_MMA(0, 1, At, B1); PG8_BAR; PG8_SCHED;
            PG8_LDA(At, 1, 1); PG8_STAGE(PG8_SB(1, 0), b3, voffB); PG8_STAGE(PG8_SB(1, 1), b3 + hstepB, voffB); PG8_STAGE(PG8_SA(1, 0), a3, voffA);
            PG8_WAIT_V(8); PG8_WAIT_L(0); PG8_BAR; PG8_MMA(1, 0, At, B0); PG8_MMA(1, 1, At, B1); PG8_BAR; PG8_SCHED;
        }
        if constexpr (ALIGN_EPI) { if (wr == 0) PG8_BAR; }
        E(acc, cur, wr, wc, fr, fq);
        if (!has_next) break;
#pragma unroll
        for (int a = 0; a < 2; ++a)
#pragma unroll
            for (int b = 0; b < 2; ++b)
#pragma unroll
                for (int m = 0; m < 4; ++m)
#pragma unroll
                    for (int n = 0; n < 2; ++n) acc[a][b][m][n] = (f32x4){0.f, 0.f, 0.f, 0.f};
        cur = nxt; cA = nA; cB = nB; ++ui;
        if constexpr (ALIGN_EPI) { if (wr == 1) PG8_BAR; }
    }
    PG8_WAIT_V(0);
    if constexpr (!ALIGN_EPI) { if (wr == 0) PG8_BAR; }
    PG8_BAR;
#undef PG8_AP
#undef PG8_ABASE
#undef PG8_SA
#undef PG8_SB
#undef PG8_STAGE
#undef PG8_LDA
#undef PG8_LDB
#undef PG8_MMA
#undef PG8_WAIT_V
#undef PG8_WAIT_L
#undef PG8_BAR
#undef PG8_SCHED
}
}

template <class Fn>
__device__ __forceinline__ void epi_for(const f32x4 (&acc)[2][2][4][2], const pg8::Unit& u, int wr, int wc, int fr, int fq, Fn fn) {
#pragma unroll
    for (int ai = 0; ai < 2; ++ai)
#pragma unroll
        for (int m = 0; m < 4; ++m) { const int row = u.pm * 256 + ai * 128 + wr * 64 + m * 16 + fr;
#pragma unroll
            for (int bj = 0; bj < 2; ++bj) { const int col = u.pn * 256 + bj * 128 + wc * 32 + 8 * fq; fn(row, col, acc[ai][bj][m][0], acc[ai][bj][m][1]); }
            if (m & 1) asm volatile("" ::: "memory"); }
}
__device__ __forceinline__ u32x4 pack8(f32x4 v0, f32x4 v1) { u32x4 w; w.x = cvt_pk_bf16(v0[0], v0[1]); w.y = cvt_pk_bf16(v0[2], v0[3]); w.z = cvt_pk_bf16(v1[0], v1[1]); w.w = cvt_pk_bf16(v1[2], v1[3]); return w; }

struct EpiEvenIn {
    bf16_t* Z; const float* ssq; bf16_t* VTa; bf16_t* VTb; bf16_t* KT;
    __device__ __forceinline__ void operator()(const f32x4 (&acc)[2][2][4][2], const pg8::Unit& u, int wr, int wc, int fr, int fq) const {
        const int g = u.pn >> 1;
        epi_for(acc, u, wr, wc, fr, fq, [&](int row, int col, f32x4 v0, f32x4 v1) {
            const float rs = rsqrtf(ssq_sum(ssq, row) * (1.f / D) + 1e-6f);
            v0 = v0 * rs; v1 = v1 * rs;
            const int cg = col & 511, t = row & (SEQ - 1), b = row >> 13;
            if (g == 2 || g == 6) {
                bf16_t* p = (g == 2 ? VTa : VTb) + ((size_t)(b * 512 + cg)) * SEQ + t;
                _Pragma("unroll") for (int j = 0; j < 4; ++j) { p[(size_t)j * SEQ] = (bf16_t)f2bf(v0[j]); p[(size_t)(4 + j) * SEQ] = (bf16_t)f2bf(v1[j]); }
            } else if (g < 2) {
                const float pos = (float)t; const int i0 = (cg & 127) >> 1;
                float o[8] = {v0[0], v0[1], v0[2], v0[3], v1[0], v1[1], v1[2], v1[3]};
                _Pragma("unroll") for (int j = 0; j < 4; ++j) { const float inv = exp2f(-(float)(i0 + j) * (13.287712379549449f / 64.f));
                    float rev = pos * inv * 0.15915494309189535f; rev = rev - floorf(rev); const float sn = __builtin_amdgcn_sinf(rev), cs = __builtin_amdgcn_cosf(rev);
                    const float x1 = o[2 * j], x2 = o[2 * j + 1]; o[2 * j] = x1 * cs - x2 * sn; o[2 * j + 1] = x1 * sn + x2 * cs; }
                const float lg2 = log2f(1.f - exp2f(-5.f - (float)(cg >> 7))); const float ip1 = (float)((t & 127) + 1);
                if (g == 0) { const float f = exp2f(ip1 * lg2);
                    *(u32x4*)(Z + (size_t)row * ZE + cg) = pack8((f32x4){o[0] * f, o[1] * f, o[2] * f, o[3] * f}, (f32x4){o[4] * f, o[5] * f, o[6] * f, o[7] * f}); }
                else { const float f = exp2f(-ip1 * lg2), f2 = exp2f((128.f - ip1) * lg2);
                    *(u32x4*)(Z + (size_t)row * ZE + 512 + cg) = pack8((f32x4){o[0] * f, o[1] * f, o[2] * f, o[3] * f}, (f32x4){o[4] * f, o[5] * f, o[6] * f, o[7] * f});
                    bf16_t* p = KT + ((size_t)(b * 512 + cg)) * SEQ + t;
                    _Pragma("unroll") for (int j = 0; j < 8; ++j) p[(size_t)j * SEQ] = (bf16_t)f2bf(o[j] * f2); }
            } else {
                const int zc = (g - 1 - (g > 6 ? 1 : 0)) * 512;
                *(u32x4*)(Z + (size_t)row * ZE + zc + cg) = pack8(v0, v1);
            }
        });
    }
};
struct EpiOddIn {
    bf16_t* Z; bf16_t* L1;
    __device__ __forceinline__ void operator()(const f32x4 (&acc)[2][2][4][2], const pg8::Unit& u, int wr, int wc, int fr, int fq) const {
        if (u.pn < 16) { epi_for(acc, u, wr, wc, fr, fq, [&](int row, int col, f32x4 v0, f32x4 v1) { *(u32x4*)(Z + (size_t)row * ZW + col) = pack8(v0, v1); }); }
        else { epi_for(acc, u, wr, wc, fr, fq, [&](int row, int col, f32x4 v0, f32x4 v1) { const int c = col - 4096; if (c < 64) {
                    _Pragma("unroll") for (int j = 0; j < 4; ++j) { v0[j] = tanhf(v0[j]); v1[j] = tanhf(v1[j]); } }
                *(u32x4*)(L1 + (size_t)row * 256 + c) = pack8(v0, v1); }); }
    }
};
__device__ __forceinline__ void unpack8(const u32x4 w, f32x4& a, f32x4& b) {
    a = (f32x4){__uint_as_float(w.x << 16), __uint_as_float(w.x & 0xffff0000u), __uint_as_float(w.y << 16), __uint_as_float(w.y & 0xffff0000u)};
    b = (f32x4){__uint_as_float(w.z << 16), __uint_as_float(w.z & 0xffff0000u), __uint_as_float(w.w << 16), __uint_as_float(w.w & 0xffff0000u)}; }
struct EpiResid {
    const bf16_t* Ha; bf16_t* HB; int ldb;
    __device__ __forceinline__ void operator()(const f32x4 (&acc)[2][2][4][2], const pg8::Unit& u, int wr, int wc, int fr, int fq) const {
        epi_for(acc, u, wr, wc, fr, fq, [&](int row, int col, f32x4 v0, f32x4 v1) { f32x4 h0, h1; unpack8(*(const u32x4*)(Ha + (size_t)row * D + col), h0, h1); h0 = h0 + v0; h1 = h1 + v1;
            *(u32x4*)(HB + (size_t)row * ldb + col) = pack8(h0, h1); });
    }
};
struct EpiStore {
    bf16_t* O; int ldc;
    __device__ __forceinline__ void operator()(const f32x4 (&acc)[2][2][4][2], const pg8::Unit& u, int wr, int wc, int fr, int fq) const {
        epi_for(acc, u, wr, wc, fr, fq, [&](int row, int col, f32x4 v0, f32x4 v1) { *(u32x4*)(O + (size_t)row * ldc + col) = pack8(v0, v1); });
    }
};
struct EpiGate {
    const bf16_t* Hb; int ldh; const bf16_t* PP; int ldp; bf16_t* Ha; float* ssq;
    __device__ __forceinline__ void operator()(const f32x4 (&acc)[2][2][4][2], const pg8::Unit& u, int wr, int wc, int fr, int fq) const {
#pragma unroll
        for (int ai = 0; ai < 2; ++ai)
#pragma unroll
            for (int m = 0; m < 4; ++m) { const int row = u.pm * 256 + ai * 128 + wr * 64 + m * 16 + fr; float sq = 0.f;
#pragma unroll
                for (int bj = 0; bj < 2; ++bj) { const int col = u.pn * 256 + bj * 128 + wc * 32 + 8 * fq; const f32x4 v0 = acc[ai][bj][m][0], v1 = acc[ai][bj][m][1];
                    f32x4 h0, h1, p0, p1; unpack8(*(const u32x4*)(Hb + (size_t)row * ldh + col), h0, h1); unpack8(*(const u32x4*)(PP + (size_t)row * ldp + col), p0, p1);
#pragma unroll
                    for (int j = 0; j < 4; ++j) { h0[j] += sigmoidf_(v0[j]) * p0[j]; h1[j] += sigmoidf_(v1[j]) * p1[j]; sq += h0[j] * h0[j] + h1[j] * h1[j]; }
                    *(u32x4*)(Ha + (size_t)row * D + col) = pack8(h0, h1); }
                sq += __shfl_xor(sq, 16); sq += __shfl_xor(sq, 32);
                if (fq == 0) ssq[(size_t)row * 16 + u.pn * 4 + wc] = sq;
                if (m & 1) asm volatile("" ::: "memory"); }
    }
};

#define XB_TMO      128
#define XB_XCNT(j)  (256  + 64 * (j))
#define XB_XSUB(j)  (1280 + 64 * (j))
#define XB_XGEN(j)  (2304 + 64 * (j))
#define XB_TOP      3328
#define XB_TOPGEN   3392
#define XCD_BAR_WORDS 3456
#define XB_SPIN_CAP (1u << 22)
__device__ __forceinline__ unsigned xb_ld(unsigned* p)              { return __hip_atomic_load(p, __ATOMIC_RELAXED, __HIP_MEMORY_SCOPE_AGENT); }
__device__ __forceinline__ unsigned xb_add(unsigned* p, unsigned v) { return __hip_atomic_fetch_add(p, v, __ATOMIC_RELAXED, __HIP_MEMORY_SCOPE_AGENT); }
__device__ __forceinline__ unsigned xb_xcc_id() { return (unsigned)__builtin_amdgcn_s_getreg((3 << 11) | 20) & 0xFu; }
#define XB_SPIN(cond, bar) do { unsigned _sp = 0; while (cond) { __builtin_amdgcn_s_sleep(1); \
    if ((++_sp & 255u) == 0u) { if (xb_ld(&(bar)[XB_TMO])) break; if (_sp > XB_SPIN_CAP) { atomicAdd(&(bar)[XB_TMO], 1u); break; } } } } while (0)
struct XcdBarrier { unsigned* bar; unsigned x; volatile LAS unsigned* st; };
__device__ __forceinline__ XcdBarrier xcd_barrier_post(unsigned* bar, volatile LAS unsigned* st) {
    XcdBarrier b; b.bar = bar; b.x = xb_xcc_id(); b.st = st;
    if (threadIdx.x == 0) (void)xb_add(&bar[XB_XCNT(b.x)], 1u);
    return b;
}
__device__ __forceinline__ void xcd_barrier_complete(unsigned* bar, unsigned x, unsigned& nloc, unsigned& nx) {
    const unsigned G = gridDim.x * gridDim.y * gridDim.z;
    unsigned sum, cnt, mine, sp = 0u;
    for (;;) {
        sum = 0u; cnt = 0u; mine = 0u;
#pragma unroll
        for (unsigned j = 0; j < 16; ++j) { const unsigned c = xb_ld(&bar[XB_XCNT(j)]); sum += c; cnt += (c > 0u) ? 1u : 0u; mine = (j == x) ? c : mine; }
        if (sum == G) break;
        __builtin_amdgcn_s_sleep(1);
        if ((++sp & 255u) == 0u) { if (xb_ld(&bar[XB_TMO])) break; if (sp > XB_SPIN_CAP) { atomicAdd(&bar[XB_TMO], 1u); break; } }
    }
    nloc = mine > 0u ? mine : 1u; nx = cnt > 0u ? cnt : 1u;
}
__device__ __forceinline__ void xcd_barrier(const XcdBarrier& b_in) {
    asm volatile("s_waitcnt vmcnt(0)" ::: "memory");
    __syncthreads();
    if (threadIdx.x == 0) {
        const XcdBarrier& b = b_in;
        unsigned* bar = b.bar;
        __builtin_amdgcn_s_waitcnt(0);
        unsigned nloc = b.st[0], nx = b.st[1];
        if (nloc == 0u) { xcd_barrier_complete(bar, b.x, nloc, nx); b.st[0] = nloc; b.st[1] = nx; }
        const unsigned old = xb_add(&bar[XB_XSUB(b.x)], 1u);
        const unsigned gen = old / nloc;
        if (old + 1u == (gen + 1u) * nloc) {
            __builtin_amdgcn_fence(__ATOMIC_RELEASE, "agent");
            asm volatile("s_waitcnt vmcnt(0)" ::: "memory");
            const unsigned og = xb_add(&bar[XB_TOP], 1u);
            const unsigned tg = og / nx;
            if (og + 1u == (tg + 1u) * nx) xb_add(&bar[XB_TOPGEN], 1u);
            else XB_SPIN(xb_ld(&bar[XB_TOPGEN]) == tg, bar);
            __builtin_amdgcn_fence(__ATOMIC_ACQUIRE, "agent");
            xb_add(&bar[XB_XGEN(b.x)], 1u);
            asm volatile("s_waitcnt vmcnt(0)" ::: "memory");
        } else {
            XB_SPIN(xb_ld(&bar[XB_XGEN(b.x)]) == gen, bar);
            __builtin_amdgcn_fence(__ATOMIC_ACQUIRE, "agent");
            asm volatile("s_waitcnt vmcnt(0)" ::: "memory");
        }
    }
    __syncthreads();
}

constexpr size_t MiB = 1u << 20;
constexpr size_t WS_CTL = 0, CTL_BYTES = 1 * MiB;
constexpr size_t WS_SSQ = 241 * (size_t)(1u << 20);
constexpr size_t WS_WIN = 2 * MiB;
constexpr size_t WS_WOUT = 19 * MiB, WS_WGATE = 21 * MiB, WS_WPROJ = 23 * MiB;
constexpr size_t WS_PB = 24 * MiB;
constexpr size_t WS_Z = 32 * MiB;
constexpr size_t WS_HB = 160 * MiB;
constexpr size_t WS_VF = 193 * MiB;
constexpr size_t WS_L1 = 225 * MiB;
constexpr size_t WS_VTA = 128 * MiB;
constexpr size_t WS_VTB = 144 * MiB;
constexpr size_t WS_KT = 225 * MiB;
constexpr size_t WS_LORA2 = 23 * MiB + 512 * 1024;
constexpr size_t WS_PG = 160 * MiB;
constexpr size_t WS_SB = 2 * MiB;
constexpr size_t WS_BON = 233 * MiB;
constexpr size_t WS_ST = 176 * MiB;
constexpr size_t WS_KV = 160 * MiB;
constexpr size_t WS_END = 256 * MiB;

constexpr int RING_BYTES = 131072, LDS_BYTES = 163840, MISC_OFF = LDS_BYTES - 512;

struct Args { const float* in[26]; float* out; unsigned char* ws; int ph_lo, ph_hi; };

__device__ __forceinline__ const float* inptr(int i) { asm volatile("" : "+s"(i)); const char* ka = (const char*)__builtin_amdgcn_kernarg_segment_ptr(); return *(const float* const*)(ka + 8 * i); }
struct InTab { __device__ __forceinline__ const float* operator[](int i) const { return inptr(i); } };
struct Frame {
    LAS unsigned char* lds; unsigned char* ldsg;
    int tid, lane, wave, G, vcu;
    InTab in; float* H; unsigned char* ws;
    __device__ __forceinline__ void retid() { int l; asm volatile("v_mbcnt_lo_u32_b32 %0, -1, 0\n\tv_mbcnt_hi_u32_b32 %0, -1, %0" : "=v"(l)); lane = l; tid = wave * 64 + l; }
    __device__ __forceinline__ float* ssq(int l) const { return (float*)(ws + WS_SSQ) + (size_t)l * T * 16; }
};

__device__ __forceinline__ void conv_item(const float* W, int ldw, int Kmax, int k0, int n0, bf16_t* dst, int ldd, int dr0, int drs, int dk0,
                                          const float* svec, float sa, float sb, float sc, LAS float* scr, int lane) {
    float wv[32];
#pragma unroll
    for (int i = 0; i < 32; ++i) { const int k = k0 + 2 * i + (lane >> 5); wv[i] = (k < Kmax) ? W[(size_t)k * ldw + n0 + (lane & 31)] : 0.f; }
#pragma unroll
    for (int i = 0; i < 32; ++i) { const int kk = 2 * i + (lane >> 5), k = k0 + kk; const float f = (k < Kmax) ? (sa + sb * (svec ? svec[k] : 0.f)) * sc : 0.f;
        scr[kk * 33 + (lane & 31)] = wv[i] * f; }
    LDS_WAIT(); asm volatile("" ::: "memory");
    const int c = lane & 7;
    if (k0 + 8 * c < Kmax) {
#pragma unroll
        for (int j = 0; j < 4; ++j) { const int n = (lane >> 3) + 8 * j; const LAS float* s = scr + (8 * c) * 33 + n;
            u32x4 o; o.x = pk2(s[0 * 33], s[1 * 33]); o.y = pk2(s[2 * 33], s[3 * 33]); o.z = pk2(s[4 * 33], s[5 * 33]); o.w = pk2(s[6 * 33], s[7 * 33]);
            *(GAS u32x4*)(dst + (size_t)(dr0 + n * drs) * ldd + dk0 + k0 + 8 * c) = o; }
    }
    LDS_WAIT(); asm volatile("" ::: "memory");
}
__device__ __forceinline__ void conv_item2(const float* W, int ldw, int k0, int n0, bf16_t* dst, int dr0, const float* mu, float sc, LAS float* scr, int lane) {
    float wv[32];
#pragma unroll
    for (int i = 0; i < 32; ++i) wv[i] = W[(size_t)(k0 + 2 * i + (lane >> 5)) * ldw + n0 + (lane & 31)];
#pragma unroll
    for (int half = 0; half < 2; ++half) {
#pragma unroll
        for (int i = 0; i < 32; ++i) { const int kk = 2 * i + (lane >> 5); const float m = mu[k0 + kk]; scr[kk * 33 + (lane & 31)] = wv[i] * ((half ? m : 1.f - m) * sc); }
        LDS_WAIT(); asm volatile("" ::: "memory");
        const int c = lane & 7;
#pragma unroll
        for (int j = 0; j < 4; ++j) { const int n = (lane >> 3) + 8 * j; const LAS float* s_ = scr + (8 * c) * 33 + n;
            u32x4 o; o.x = pk2(s_[0 * 33], s_[1 * 33]); o.y = pk2(s_[2 * 33], s_[3 * 33]); o.z = pk2(s_[4 * 33], s_[5 * 33]); o.w = pk2(s_[6 * 33], s_[7 * 33]);
            *(GAS u32x4*)(dst + (size_t)(dr0 + n) * 2048 + half * 1024 + k0 + 8 * c) = o; }
        LDS_WAIT(); asm volatile("" ::: "memory");
    }
}
__device__ __forceinline__ void conv_win_even(Frame& F, int li) {
    const int e = li >> 1; const float* W = F.in[6] + (size_t)e * D * ZW; const float* gain = F.in[2] + li * D; bf16_t* dst = (bf16_t*)(F.ws + WS_WIN);
    LAS float* scr = (LAS float*)(F.lds + F.wave * 16384);
    const int gw = F.vcu * 8 + F.wave, NGW = F.G * 8;
    for (int it = gw; it < 16 * 128; it += NGW) { const int kb = it >> 7, nb = it & 127, n0 = nb * 32, g = n0 >> 9, hh = (n0 & 511) >> 7, d0 = n0 & 127;
        int dr0 = n0, drs = 1; if (g < 2) { dr0 = g * 512 + hh * 128 + (d0 < 64 ? 2 * d0 : 2 * (d0 - 64) + 1); drs = 2; }
        const float sc = (g == 1 || g == 5) ? QK_SCALE : 1.f;
        conv_item(W, ZW, D, kb * 64, n0, dst, D, dr0, drs, 0, gain, 0.f, 1.f, sc, scr, F.lane); }
}
__device__ __forceinline__ void conv_win_odd(Frame& F, int li) {
    const int o = li >> 1; const float* mu = F.in[9] + (size_t)o * 6 * D; bf16_t* dst = (bf16_t*)(F.ws + WS_WIN);
    LAS float* scr = (LAS float*)(F.lds + F.wave * 16384);
    const int gw = F.vcu * 8 + F.wave, NGW = F.G * 8;
    for (int it = gw; it < 4 * 512; it += NGW) { const int p = it >> 9, r = it & 511, kb = r >> 5, nb = r & 31;
        conv_item2(F.in[10] + ((size_t)o * 4 + p) * D * D, D, kb * 64, nb * 32, dst, p * 1024 + nb * 32, mu + p * D, 1.f, scr, F.lane); }
    for (int it = gw; it < 32 + 32 + 16; it += NGW) { const float* W; int ldw, n0, dr0, mi, kb; const int r = it;
        if (r < 32) { W = F.in[13] + (size_t)o * D * 64; ldw = 64; kb = r >> 1; n0 = (r & 1) * 32; dr0 = 4096 + n0; mi = 4; }
        else if (r < 64) { const int q = r - 32; W = F.in[16] + (size_t)o * D * 64; ldw = 64; kb = q >> 1; n0 = (q & 1) * 32; dr0 = 4160 + n0; mi = 5; }
        else { const int q = r - 64; W = F.in[19]; ldw = 32; kb = q; n0 = 0; dr0 = 4224; mi = 2; }
        conv_item2(W, ldw, kb * 64, n0, dst, dr0, mu + mi * D, (r >= 64 && o == 0) ? 0.f : 1.f, scr, F.lane); }
    { u32x4 z = {0u, 0u, 0u, 0u}; GAS u32x4* zp = (GAS u32x4*)(dst + (size_t)4256 * 2048); const int n16 = 96 * 2048 * 2 / 16;
      for (int i = (F.vcu * 512 + F.tid); i < n16; i += F.G * 512) zp[i] = z; }
}
__device__ __forceinline__ void conv_wrest_a(Frame& F, int li) {
    const float* Wp = F.in[4] + (size_t)li * PLE * D;
    LAS float* scr = (LAS float*)(F.lds + F.wave * 16384);
    const int gw = F.vcu * 8 + F.wave, NGW = F.G * 8;
    for (int r = gw; r < 128; r += NGW) conv_item(Wp, D, PLE, (r >> 5) * 64, (r & 31) * 32, (bf16_t*)(F.ws + WS_WPROJ), PLE, (r & 31) * 32, 1, 0, nullptr, 1.f, 0.f, 1.f, scr, F.lane);
    const float* P = F.in[1] + (size_t)li * T * PLE; GAS u32x4* pb = (GAS u32x4*)(F.ws + WS_PB); const int n8 = T * PLE / 8;
    for (int i = F.vcu * 512 + F.tid; i < n8; i += F.G * 512) { const f32x4 a = *(const f32x4*)(P + (size_t)i * 8), b = *(const f32x4*)(P + (size_t)i * 8 + 4);
        u32x4 o; o.x = pk2(a[0], a[1]); o.y = pk2(a[2], a[3]); o.z = pk2(b[0], b[1]); o.w = pk2(b[2], b[3]); pb[i] = o; }
}
__device__ __forceinline__ void conv_wrest_b(Frame& F, int li, int widx, int nw) {
    const bool even = (li & 1) == 0; const int e = li >> 1;
    const float* Wo = even ? F.in[7] + (size_t)e * D * D : F.in[11] + (size_t)e * D * D; const float* Wg = F.in[5] + (size_t)li * D * D;
    LAS float* scr = (LAS float*)(F.lds + F.wave * 16384);
    for (int it = widx * 8 + F.wave; it < 1024; it += nw * 8) {
        if (it < 512) conv_item(Wo, D, D, (it >> 5) * 64, (it & 31) * 32, (bf16_t*)(F.ws + WS_WOUT), D, (it & 31) * 32, 1, 0, nullptr, 1.f, 0.f, 1.f, scr, F.lane);
        else { const int r = it - 512; conv_item(Wg, D, D, (r >> 5) * 64, (r & 31) * 32, (bf16_t*)(F.ws + WS_WGATE), D, (r & 31) * 32, 1, 0, nullptr, 1.f, 0.f, 1.f, scr, F.lane); }
    }
}
__device__ __forceinline__ void conv_lora2(Frame& F, int li) {
    const int o = li >> 1; LAS float* scr = (LAS float*)(F.lds + F.wave * 16384);
    bf16_t* W2T = (bf16_t*)(F.ws + WS_LORA2); bf16_t* A2T = W2T + 1024 * 64; bf16_t* V2T = A2T + 1024 * 64;
    const int gw = F.vcu * 8 + F.wave, NGW = F.G * 8;
    for (int it = gw; it < 96; it += NGW) {
        if (it < 32) conv_item(F.in[14] + (size_t)o * 64 * D, D, 64, 0, it * 32, W2T, 64, it * 32, 1, 0, nullptr, 1.f, 0.f, 1.f, scr, F.lane);
        else if (it < 64) conv_item(F.in[17] + (size_t)o * 64 * D, D, 64, 0, (it - 32) * 32, A2T, 64, (it - 32) * 32, 1, 0, nullptr, 1.f, 0.f, 1.f, scr, F.lane);
        else conv_item(F.in[20], D, 32, 0, (it - 64) * 32, V2T, 32, (it - 64) * 32, 1, 0, nullptr, 1.f, 0.f, 1.f, scr, F.lane);
    }
}
__device__ __forceinline__ void rows_p0(Frame& F) {
    const float* x = F.in[0]; bf16_t* HB = (bf16_t*)(F.ws + WS_HB); float* s0 = F.ssq(0);
    for (int row = F.vcu * 8 + F.wave; row < T; row += F.G * 8) {
        const f32x4* xr = (const f32x4*)(x + (size_t)row * D) + F.lane; u32x2* br = (u32x2*)(HB + (size_t)row * D) + F.lane; float s = 0.f;
#pragma unroll
        for (int j = 0; j < 4; ++j) { const f32x4 v = xr[64 * j]; s += (v[0] * v[0] + v[1] * v[1]) + (v[2] * v[2] + v[3] * v[3]); u32x2 w; w.x = pk2(v[0], v[1]); w.y = pk2(v[2], v[3]); br[64 * j] = w; }
        s = wave_sum(s); if (F.lane < 16) s0[(size_t)row * 16 + F.lane] = F.lane == 0 ? s : 0.f;
    }
}
__device__ __forceinline__ void rows_norm(Frame& F, int li) {
    const float* gain = F.in[2] + li * D; bf16_t* HN = (bf16_t*)(F.H); const bf16_t* Ha = (const bf16_t*)(F.ws + WS_HB); const float* sq = F.ssq(li);
    f32x4 g[4];
#pragma unroll
    for (int j = 0; j < 4; ++j) g[j] = *((const f32x4*)gain + F.lane + 64 * j);
    for (int row = F.vcu * 8 + F.wave; row < T; row += F.G * 8) {
        const u32x2* hr = (const u32x2*)(Ha + (size_t)row * D) + F.lane; u32x2* br = (u32x2*)(HN + (size_t)(row + 1 + (row >= SEQ ? 1 : 0)) * D) + F.lane;
        const float rs = rsqrtf(ssq_sum(sq, row) * (1.f / D) + 1e-6f);
#pragma unroll
        for (int j = 0; j < 4; ++j) { const u32x2 hw = hr[64 * j]; const f32x4 h4 = {__uint_as_float(hw.x << 16), __uint_as_float(hw.x & 0xffff0000u), __uint_as_float(hw.y << 16), __uint_as_float(hw.y & 0xffff0000u)};
            const f32x4 v = h4 * rs * g[j]; u32x2 w; w.x = pk2(v[0], v[1]); w.y = pk2(v[2], v[3]); br[64 * j] = w; }
    }
    if (F.vcu == 0 && F.wave < 2) { u32x2* br = (u32x2*)(HN + (size_t)(F.wave ? SEQ + 1 : 0) * D) + F.lane; u32x2 z = {0u, 0u};
#pragma unroll
        for (int j = 0; j < 4; ++j) br[64 * j] = z; }
}
__device__ __forceinline__ void norm_lora_phase(Frame& F, int li) {
    const float* gain = F.in[2] + li * D; bf16_t* HN = (bf16_t*)(F.H); const bf16_t* Ha = (const bf16_t*)(F.ws + WS_HB); const float* sq = F.ssq(li);
    LAS bf16_t* HL = (LAS bf16_t*)F.lds; constexpr int HS = 1032;
    const GAS bf16_t* W1c = (const GAS bf16_t*)(F.ws + WS_WIN) + (size_t)4096 * 2048; GAS bf16_t* L1g = (GAS bf16_t*)(F.ws + WS_L1);
    const int lane = F.lane, wave = F.wave;
    f32x4 g[4];
#pragma unroll
    for (int j = 0; j < 4; ++j) g[j] = *((const f32x4*)gain + lane + 64 * j);
#pragma unroll 1
    for (int p = F.vcu; p < T / 64; p += F.G) {
        __syncthreads();
        u32x2 hw[9][4]; float rsv[9];
#pragma unroll
        for (int sidx = 0; sidx < 9; ++sidx) { const int i = wave + 8 * sidx, row = 64 * p - 1 + i; const bool valid = i < 65 && !(i == 0 && (row + 1) % SEQ == 0);
            if (valid) { const u32x2* hr = (const u32x2*)(Ha + (size_t)row * D) + lane;
#pragma unroll
                for (int j = 0; j < 4; ++j) hw[sidx][j] = hr[64 * j];
                rsv[sidx] = ssq_sum(sq, row); }
            else {
#pragma unroll
                for (int j = 0; j < 4; ++j) hw[sidx][j] = (u32x2){0u, 0u};
                rsv[sidx] = 1.f; } }
#pragma unroll
        for (int sidx = 0; sidx < 9; ++sidx) { const int i = wave + 8 * sidx, row = 64 * p - 1 + i;
            if (i < 65) { const bool valid = !(i == 0 && (row + 1) % SEQ == 0);
                LAS u32x2* lr = (LAS u32x2*)(HL + i * HS) + lane; const float rs = rsqrtf(rsv[sidx] * (1.f / D) + 1e-6f);
                u32x2* br = (u32x2*)(HN + (size_t)(row + 1 + (row >= SEQ ? 1 : 0)) * D) + lane;
#pragma unroll
                for (int j = 0; j < 4; ++j) { const u32x2 h2 = hw[sidx][j]; const f32x4 h4 = {__uint_as_float(h2.x << 16), __uint_as_float(h2.x & 0xffff0000u), __uint_as_float(h2.y << 16), __uint_as_float(h2.y & 0xffff0000u)};
                    const f32x4 v = h4 * rs * g[j]; u32x2 w; w.x = pk2(v[0], v[1]); w.y = pk2(v[2], v[3]); if (!valid) w = (u32x2){0u, 0u}; lr[64 * j] = w; if (i > 0) br[64 * j] = w; } } }
        __syncthreads();
        const int fr = lane & 15, gq = lane >> 4;
        f32x4 acc[5];
#pragma unroll
        for (int i = 0; i < 5; ++i) acc[i] = (f32x4){0.f, 0.f, 0.f, 0.f};
        const LAS bf16_t* ap = HL + fr * HS + 8 * gq;
        const int mt4 = wave & 3, nt4 = 8 + (wave >> 2);
        const GAS bf16_t* bp0 = W1c + (size_t)(wave * 16 + fr) * 2048 + 8 * gq; const GAS bf16_t* bp1 = W1c + (size_t)(nt4 * 16 + fr) * 2048 + 8 * gq;
        bf16x8 bA0[8], bA1[8], bB0[8], bB1[8];
#define NL_LOAD(B0, B1, K8) do { _Pragma("unroll") for (int q = 0; q < 8; ++q) { B0[q] = *(const GAS bf16x8*)(bp0 + 32 * ((K8) + q)); B1[q] = *(const GAS bf16x8*)(bp1 + 32 * ((K8) + q)); } } while (0)
#define NL_COMP(B0, B1, K8) do { _Pragma("unroll") for (int q = 0; q < 8; ++q) { const int ks = (K8) + q; const int aoff = ((ks >> 5) ? 0 : HS) + (ks & 31) * 32; \
            _Pragma("unroll") for (int i = 0; i < 4; ++i) acc[i] = __builtin_amdgcn_mfma_f32_16x16x32_bf16(*(const LAS bf16x8*)(ap + i * 16 * HS + aoff), B0[q], acc[i], 0, 0, 0); \
            acc[4] = __builtin_amdgcn_mfma_f32_16x16x32_bf16(*(const LAS bf16x8*)(ap + mt4 * 16 * HS + aoff), B1[q], acc[4], 0, 0, 0); } } while (0)
        NL_LOAD(bA0, bA1, 0);
#pragma unroll 1
        for (int k16 = 0; k16 < 64; k16 += 16) {
            NL_LOAD(bB0, bB1, k16 + 8);
            NL_COMP(bA0, bA1, k16);
            NL_LOAD(bA0, bA1, (k16 + 16 < 64 ? k16 + 16 : 0));
            NL_COMP(bB0, bB1, k16 + 8);
        }
#undef NL_LOAD
#undef NL_COMP
#pragma unroll
        for (int i = 0; i < 5; ++i) { const int mt = i < 4 ? i : mt4, nt = i < 4 ? wave : nt4, col = nt * 16 + fr;
#pragma unroll
            for (int j = 0; j < 4; ++j) { float v = acc[i][j]; if (col < 64) v = 1.f - 2.f * __builtin_amdgcn_rcpf(1.f + __expf(2.f * v));
                L1g[(size_t)(64 * p + mt * 16 + 4 * gq + j) * 256 + col] = (bf16_t)f2bf(v); } }
    }
    if (F.vcu == 0 && wave < 2) { u32x2* br = (u32x2*)(HN + (size_t)(wave ? SEQ + 1 : 0) * D) + lane; u32x2 z = {0u, 0u};
#pragma unroll
        for (int j = 0; j < 4; ++j) br[64 * j] = z; }
    __syncthreads();
}

__device__ __forceinline__ void rows_final(Frame& F) {
    const float* gain = F.in[3]; const float* sq = F.ssq(4); const bf16_t* Ha = (const bf16_t*)(F.ws + WS_HB);
    f32x4 g[4];
#pragma unroll
    for (int j = 0; j < 4; ++j) g[j] = *((const f32x4*)gain + F.lane + 64 * j);
    for (int row = F.vcu * 8 + F.wave; row < T; row += F.G * 8) {
        const u32x2* hr = (const u32x2*)(Ha + (size_t)row * D) + F.lane; f32x4* orow = (f32x4*)(F.H + (size_t)row * D) + F.lane; const float rs = rsqrtf(ssq_sum(sq, row) * (1.f / D) + 1e-6f);
#pragma unroll
        for (int j = 0; j < 4; ++j) { const u32x2 hw = hr[64 * j]; const f32x4 h4 = {__uint_as_float(hw.x << 16), __uint_as_float(hw.x & 0xffff0000u), __uint_as_float(hw.y << 16), __uint_as_float(hw.y & 0xffff0000u)};
            orow[64 * j] = h4 * rs * g[j]; }
    }
}

typedef float f32x16 __attribute__((ext_vector_type(16)));
template <bool DUMMY>
__device__ __forceinline__ void sb_unit(Frame& F, int bh, int qb) {
    const int lane = F.lane, l31 = lane & 31, hi = lane >> 5, b = bh >> 2, h = bh & 3;
    bf16_t* Z = (bf16_t*)(F.ws + WS_Z); const bf16_t* VT = (const bf16_t*)(F.ws + WS_VTB) + (size_t)bh * 128 * SEQ;
    const size_t rowb = (size_t)b * SEQ; const int q0 = qb * 32, tq = q0 + l31;
    bf16x8 qr[8];
    { const bf16_t* qp = Z + (rowb + tq) * ZE + 1536 + h * 128 + hi * 8;
#pragma unroll
      for (int ks = 0; ks < 8; ++ks) qr[ks] = *(const bf16x8*)(qp + 16 * ks); }
    f32x16 o[4];
#pragma unroll
    for (int d = 0; d < 4; ++d)
#pragma unroll
        for (int r = 0; r < 16; ++r) o[d][r] = 0.f;
    float carry = 1.f;
    const int pi = 16 * ((l31 >> 2) & 1) + (l31 & 3) + 4 * (l31 >> 3);
    const bf16_t* Kb = Z + rowb * ZE + 2048 + h * 128 + hi * 8;
    for (int kt = (q0 + 31) >> 6; kt >= 0; --kt) {
        const int kbase = kt * 64;
        const bf16_t* kp0 = Kb + (size_t)(kbase + pi) * ZE; const bf16_t* kp1 = kp0 + (size_t)32 * ZE;
        f32x16 p0, p1;
#pragma unroll
        for (int r = 0; r < 16; ++r) { p0[r] = 0.f; p1[r] = 0.f; }
#pragma unroll
        for (int ks = 0; ks < 8; ++ks) { const bf16x8 a0 = *(const bf16x8*)(kp0 + 16 * ks), a1 = *(const bf16x8*)(kp1 + 16 * ks);
            p0 = __builtin_amdgcn_mfma_f32_32x32x16_bf16(a0, qr[ks], p0, 0, 0, 0); p1 = __builtin_amdgcn_mfma_f32_32x32x16_bf16(a1, qr[ks], p1, 0, 0, 0); }
        float f1 = 1.f, f0 = 1.f;
        const int k1 = kbase + 32 + 16 * hi, k0 = kbase + 16 * hi;
#pragma unroll
        for (int r = 15; r >= 0; --r) { const float z = fminf(p1[r], 80.f); const float e = exp2f(z * 1.4426950408889634f); float rd = __builtin_amdgcn_rcpf(1.f + e); float be = e * rd;
            const bool valid = (k1 + r) < tq; be = valid ? be : 0.f; rd = valid ? rd : 1.f; p1[r] = be * f1; f1 *= rd; }
#pragma unroll
        for (int r = 15; r >= 0; --r) { const float z = fminf(p0[r], 80.f); const float e = exp2f(z * 1.4426950408889634f); float rd = __builtin_amdgcn_rcpf(1.f + e); float be = e * rd;
            const bool valid = (k0 + r) < tq; be = valid ? be : 0.f; rd = valid ? rd : 1.f; p0[r] = be * f0; f0 *= rd; }
        const float pf0 = __shfl_xor(f0, 32), pf1 = __shfl_xor(f1, 32);
        const float tail1 = hi ? 1.f : pf1;
        const float tail0 = hi ? (pf1 * f1) : (pf0 * f1 * pf1);
        const float s1 = tail1 * carry, s0 = tail0 * carry;
        carry *= (f0 * f1) * (pf0 * pf1);
        u32x4 pa[2][2];
#pragma unroll
        for (int s = 0; s < 2; ++s) {
            pa[0][s].x = cvt_pk_bf16(p0[8 * s + 0] * s0, p0[8 * s + 1] * s0); pa[0][s].y = cvt_pk_bf16(p0[8 * s + 2] * s0, p0[8 * s + 3] * s0);
            pa[0][s].z = cvt_pk_bf16(p0[8 * s + 4] * s0, p0[8 * s + 5] * s0); pa[0][s].w = cvt_pk_bf16(p0[8 * s + 6] * s0, p0[8 * s + 7] * s0);
            pa[1][s].x = cvt_pk_bf16(p1[8 * s + 0] * s1, p1[8 * s + 1] * s1); pa[1][s].y = cvt_pk_bf16(p1[8 * s + 2] * s1, p1[8 * s + 3] * s1);
            pa[1][s].z = cvt_pk_bf16(p1[8 * s + 4] * s1, p1[8 * s + 5] * s1); pa[1][s].w = cvt_pk_bf16(p1[8 * s + 6] * s1, p1[8 * s + 7] * s1);
        }
        const bf16_t* vp = VT + (size_t)l31 * SEQ + kbase + 16 * hi;
#pragma unroll
        for (int d = 0; d < 4; ++d)
#pragma unroll
            for (int blk = 0; blk < 2; ++blk)
#pragma unroll
                for (int s = 0; s < 2; ++s) { const bf16x8 vb = *(const bf16x8*)(vp + (size_t)(32 * d) * SEQ + 32 * blk + 8 * s);
                    o[d] = __builtin_amdgcn_mfma_f32_32x32x16_bf16(__builtin_bit_cast(bf16x8, pa[blk][s]), vb, o[d], 0, 0, 0); }
        if (__all(carry < 7.9e-31f)) break;
    }
#pragma unroll
    for (int r = 0; r < 16; ++r) { const int qrow = q0 + (r & 3) + 8 * (r >> 2) + 4 * hi; bf16_t* gp = Z + (rowb + qrow) * ZE + 2560 + h * 128 + l31;
#pragma unroll
        for (int d = 0; d < 4; ++d) { const float g = bf2f(gp[32 * d]); const float ov = o[d][r] * siluf_(g); if (!DUMMY) gp[32 * d] = (bf16_t)f2bf(ov); else asm volatile("" :: "v"(ov)); } }
}
__device__ __forceinline__ void ret_stage_a(Frame& F, int u) {
    const int l31 = F.lane & 31, hi = F.lane >> 5, cu = u >> 3, w8 = u & 7, bh = cu & 7, n = cu >> 3, dvb = w8 >> 1, dkp = w8 & 1;
    const bf16_t* vt = (const bf16_t*)(F.ws + WS_VTA) + ((size_t)(bh * 128 + 32 * dvb + l31)) * SEQ + n * 128 + 8 * hi;
    const bf16_t* kt = (const bf16_t*)(F.ws + WS_KT) + ((size_t)(bh * 128 + 64 * dkp + l31)) * SEQ + n * 128 + 8 * hi;
    f32x16 a0, a1;
#pragma unroll
    for (int r = 0; r < 16; ++r) { a0[r] = 0.f; a1[r] = 0.f; }
#pragma unroll
    for (int ks = 0; ks < 8; ++ks) { const bf16x8 va = *(const bf16x8*)(vt + 16 * ks), k0 = *(const bf16x8*)(kt + 16 * ks), k1 = *(const bf16x8*)(kt + (size_t)32 * SEQ + 16 * ks);
        a0 = __builtin_amdgcn_mfma_f32_32x32x16_bf16(va, k0, a0, 0, 0, 0); a1 = __builtin_amdgcn_mfma_f32_32x32x16_bf16(va, k1, a1, 0, 0, 0); }
    bf16_t* kv = (bf16_t*)(F.H) + ((size_t)cu * 128 + 32 * dvb) * 128 + 64 * dkp + l31;
#pragma unroll
    for (int r = 0; r < 16; ++r) { const int dv = (r & 3) + 8 * (r >> 2) + 4 * hi; kv[dv * 128] = (bf16_t)f2bf(a0[r]); kv[dv * 128 + 32] = (bf16_t)f2bf(a1[r]); }
}
__device__ __forceinline__ void ret_stage_b(Frame& F) {
    const int e = F.vcu * 512 + F.tid; if (e >= 8 * 128 * 128) return;
    const int h = (e >> 14) & 3; const float g128 = exp2f(128.f * log2f(1.f - exp2f(-5.f - (float)h)));
    const bf16_t* p = (const bf16_t*)(F.H) + e; bf16_t* q = (bf16_t*)(F.H) + (size_t)8 * 1024 * 1024 + e; float S = 0.f;
#pragma unroll 4
    for (int n = 0; n < 64; ++n) { const float kv = bf2f(p[(size_t)n * 131072]); q[(size_t)n * 131072] = (bf16_t)f2bf(S); S = S * g128 + kv; }
}
template <bool DUMMY>
__device__ __forceinline__ void ret_stage_c(Frame& F, int u, const float* gng) {
    const int lane = F.lane, l31 = lane & 31, hi = lane >> 5, cu = u >> 2, qblk = u & 3, bh = cu & 7, n = cu >> 3, b = bh >> 2, h = bh & 3;
    bf16_t* Z = (bf16_t*)(F.ws + WS_Z); const size_t rowb = (size_t)b * SEQ; const int t0 = n * 128, tq = t0 + 32 * qblk + l31;
    bf16x8 qr[8];
    { const bf16_t* qp = Z + (rowb + tq) * ZE + h * 128 + hi * 8;
#pragma unroll
      for (int ks = 0; ks < 8; ++ks) qr[ks] = *(const bf16x8*)(qp + 16 * ks); }
    f32x16 o[4];
#pragma unroll
    for (int d = 0; d < 4; ++d)
#pragma unroll
        for (int r = 0; r < 16; ++r) o[d][r] = 0.f;
    { const bf16_t* sp = (const bf16_t*)(F.H) + (size_t)8 * 1024 * 1024 + ((size_t)cu * 128 + l31) * 128 + 8 * hi;
#pragma unroll
      for (int ks = 0; ks < 8; ++ks)
#pragma unroll
          for (int d = 0; d < 4; ++d) { const bf16x8 sb = *(const bf16x8*)(sp + (size_t)(32 * d) * 128 + 16 * ks); o[d] = __builtin_amdgcn_mfma_f32_32x32x16_bf16(qr[ks], sb, o[d], 0, 0, 0); } }
    const int pi = 16 * ((l31 >> 2) & 1) + (l31 & 3) + 4 * (l31 >> 3);
    const bf16_t* Kb = Z + rowb * ZE + 512 + h * 128 + hi * 8;
    const bf16_t* VT = (const bf16_t*)(F.ws + WS_VTA) + ((size_t)(bh * 128 + l31)) * SEQ + 16 * hi;
    for (int kb = 0; kb <= qblk; ++kb) {
        const int kbase = t0 + 32 * kb; const bf16_t* kp = Kb + (size_t)(kbase + pi) * ZE;
        f32x16 p;
#pragma unroll
        for (int r = 0; r < 16; ++r) p[r] = 0.f;
#pragma unroll
        for (int ks = 0; ks < 8; ++ks) { const bf16x8 a = *(const bf16x8*)(kp + 16 * ks); p = __builtin_amdgcn_mfma_f32_32x32x16_bf16(a, qr[ks], p, 0, 0, 0); }
        if (kb == qblk) {
#pragma unroll
            for (int r = 0; r < 16; ++r) p[r] = (kbase + 16 * hi + r <= tq) ? p[r] : 0.f; }
        u32x4 pa[2];
#pragma unroll
        for (int s = 0; s < 2; ++s) { pa[s].x = cvt_pk_bf16(p[8 * s], p[8 * s + 1]); pa[s].y = cvt_pk_bf16(p[8 * s + 2], p[8 * s + 3]); pa[s].z = cvt_pk_bf16(p[8 * s + 4], p[8 * s + 5]); pa[s].w = cvt_pk_bf16(p[8 * s + 6], p[8 * s + 7]); }
#pragma unroll
        for (int d = 0; d < 4; ++d)
#pragma unroll
            for (int s = 0; s < 2; ++s) { const bf16x8 vb = *(const bf16x8*)(VT + (size_t)(32 * d) * SEQ + kbase + 8 * s);
                o[d] = __builtin_amdgcn_mfma_f32_32x32x16_bf16(__builtin_bit_cast(bf16x8, pa[s]), vb, o[d], 0, 0, 0); }
    }
    float gg[4];
#pragma unroll
    for (int d = 0; d < 4; ++d) gg[d] = gng[h * 128 + 32 * d + l31];
#pragma unroll
    for (int r = 0; r < 16; ++r) {
        float sm = (o[0][r] + o[1][r]) + (o[2][r] + o[3][r]);
        sm += __shfl_xor(sm, 1); sm += __shfl_xor(sm, 2); sm += __shfl_xor(sm, 4); sm += __shfl_xor(sm, 8); sm += __shfl_xor(sm, 16);
        const float mu = sm * (1.f / 128.f); float q = 0.f;
#pragma unroll
        for (int d = 0; d < 4; ++d) { const float dd = o[d][r] - mu; q += dd * dd; }
        q += __shfl_xor(q, 1); q += __shfl_xor(q, 2); q += __shfl_xor(q, 4); q += __shfl_xor(q, 8); q += __shfl_xor(q, 16);
        const float rsd = rsqrtf(q * (1.f / 128.f) + 1e-5f);
        const int qrow = t0 + 32 * qblk + (r & 3) + 8 * (r >> 2) + 4 * hi; bf16_t* gp = Z + (rowb + qrow) * ZE + 1024 + h * 128 + l31;
#pragma unroll
        for (int d = 0; d < 4; ++d) { const float ga = bf2f(gp[32 * d]); const float ov = (o[d][r] - mu) * rsd * gg[d] * siluf_(ga); if (!DUMMY) gp[32 * d] = (bf16_t)f2bf(ov); else asm volatile("" :: "v"(ov)); }
    }
}
__device__ __forceinline__ bf16x8 ld8p(const bf16_t* p) { return *(const bf16x8*)p; }
namespace rw {
constexpr int S64 = 72, S128 = 136, LFS = 68;
constexpr int O_AT = 0, O_RT = O_AT + 9216, O_E = O_RT + 9216, O_ET = O_E + 18432, O_AM = O_ET + 17408, O_X0 = O_AM + 18432, O_LF = O_X0 + 17408, O_MM = O_LF + 17408,
              O_NN = O_MM + 9216, O_PC = O_NN + 17408, O_GC = O_PC + 9216, O_SM = O_GC + 9216, O_END = O_SM + 8192;
static_assert(O_END <= 160 * 1024 - 1024, "rwkv stage X LDS map");
typedef __attribute__((address_space(3))) bf16_t lbf;
typedef __attribute__((address_space(3))) float lf32;
__device__ __forceinline__ bf16x8 ld8(const bf16_t* p) { return *(const bf16x8*)p; }
__device__ __forceinline__ bf16x8 ld8(const LAS bf16_t* p) { return *(const LAS bf16x8*)p; }
__device__ __forceinline__ bf16x8 ld8(const GAS bf16_t* p) { return *(const GAS bf16x8*)p; }
template <int MT, int NT, int KS, class PA, class PB, class Epi>
__device__ __forceinline__ void mm(PA A, int lda, PB B, int ldb, int wave, int lane, Epi epi) {
    const int fr = lane & 15, g = lane >> 4;
    static_assert((MT * NT) % 8 == 0, "mm: tile count must be a multiple of the 8 waves");
#pragma unroll
    for (int ti = 0; ti < MT * NT / 8; ++ti) { const int tile = wave + 8 * ti; const int mt = tile / NT, nt = tile % NT;
        f32x4 acc = {0.f, 0.f, 0.f, 0.f};
        PA ap = A + (mt * 16 + fr) * lda + 8 * g; PB bp = B + (nt * 16 + fr) * ldb + 8 * g;
#pragma unroll
        for (int ks = 0; ks < KS; ++ks) acc = __builtin_amdgcn_mfma_f32_16x16x32_bf16(ld8(ap + 32 * ks), ld8(bp + 32 * ks), acc, 0, 0, 0);
        epi(ti, mt * 16 + 4 * g, nt * 16 + fr, acc);
    }
}
template <int MT, int NT, int KS, class PA, class PB, class Epi>
__device__ __forceinline__ void mm_rt(PA A, int lda, PB B, int ldb, int w, int nw, int lane, Epi epi) {
    const int fr = lane & 15, g = lane >> 4;
#pragma unroll 1
    for (int tile = w; tile < MT * NT; tile += nw) { const int mt = tile / NT, nt = tile % NT;
        f32x4 acc = {0.f, 0.f, 0.f, 0.f};
        PA ap = A + (mt * 16 + fr) * lda + 8 * g; PB bp = B + (nt * 16 + fr) * ldb + 8 * g;
#pragma unroll
        for (int ks = 0; ks < KS; ++ks) acc = __builtin_amdgcn_mfma_f32_16x16x32_bf16(ld8(ap + 32 * ks), ld8(bp + 32 * ks), acc, 0, 0, 0);
        epi(mt * 16 + 4 * g, nt * 16 + fr, acc);
    }
}
__device__ __forceinline__ unsigned short bfs(float f) { return (unsigned short)f2bf(f); }
__device__ __forceinline__ void st4(LAS bf16_t* p, f32x4 v) { u32x2 w; w.x = cvt_pk_bf16(v[0], v[1]); w.y = cvt_pk_bf16(v[2], v[3]); *(LAS u32x2*)p = w; }
}

template <bool DUMMY>
__device__ __forceinline__ void rwkv_stage_x(Frame& F, int li, unsigned long long& xacc) {
    using namespace rw;
    unsigned long long xt0 = 0;
#define TSX(k) do { if (MK_XA == (k)) xt0 = __builtin_amdgcn_s_memrealtime(); if (MK_XB == (k)) xacc += __builtin_amdgcn_s_memrealtime() - xt0; } while (0)
    const int o = li >> 1;
    LAS unsigned char* L = F.lds;
    LAS bf16_t* At = (LAS bf16_t*)(L + O_AT); LAS bf16_t* Rt = (LAS bf16_t*)(L + O_RT); LAS bf16_t* E = (LAS bf16_t*)(L + O_E); LAS bf16_t* ET = (LAS bf16_t*)(L + O_ET); LAS bf16_t* AM = (LAS bf16_t*)(L + O_AM);
    LAS bf16_t* X0T = (LAS bf16_t*)(L + O_X0); LAS float* Lf = (LAS float*)(L + O_LF); LAS bf16_t* Mm = (LAS bf16_t*)(L + O_MM); LAS bf16_t* NN = (LAS bf16_t*)(L + O_NN); LAS float* CS = (LAS float*)(L + O_NN);
    LAS bf16_t* Pc = (LAS bf16_t*)(L + O_PC); LAS bf16_t* Gc = (LAS bf16_t*)(L + O_GC); LAS float* gamC = (LAS float*)(L + O_SM); LAS float* SEGT = gamC + 64; LAS float* PRM = gamC + 64 + 1024;
    LAS bf16_t* Tm = At; LAS bf16_t* Qh = AM; LAS bf16_t* PT = AM + 64 * S64; LAS bf16_t* WT = Mm;
    GAS bf16_t* Z = (GAS bf16_t*)(F.ws + WS_Z); const GAS bf16_t* L1g = (const GAS bf16_t*)(F.ws + WS_L1); GAS bf16_t* VF = (GAS bf16_t*)(F.ws + WS_VF);
    const GAS bf16_t* W2T = (const GAS bf16_t*)(F.ws + WS_LORA2); const GAS bf16_t* A2T = W2T + 1024 * 64; const GAS bf16_t* V2T = A2T + 1024 * 64;
    GAS bf16_t* PG = (GAS bf16_t*)(F.H); GAS float* BON = (GAS float*)(F.ws + WS_BON);
    const float* w0p = F.in[12] + o * D; const float* a0p = F.in[15] + o * D; const float* v0p = F.in[18]; const float* kkp = F.in[21] + o * D; const float* kap = F.in[22] + o * D; const float* rkp = F.in[23] + o * D;
    f32x4 nlw[2], nla[2], nlv[2]; unsigned nr[4], nk[4], nv[4], nvf[4];
    bf16x8 fwa[4], fwb[2], faa[4], fab[2], fva[2], fvb;
    auto fetch_issue = [&](int u2, int c2, int tid2) {
        const int bh2 = u2 & 31, blk2 = u2 >> 5, b2 = bh2 >> 4, h2 = bh2 & 15; const size_t rows2 = (size_t)b2 * SEQ + (size_t)blk2 * 128 + 64 * c2;
        const int lane2 = tid2 & 63, fr2 = lane2 & 15, g2 = lane2 >> 4; int wave2 = F.wave; asm volatile("" : "+s"(wave2));
        const int nt2 = wave2 & 3;
#pragma unroll
        for (int ti = 0; ti < 2; ++ti) { const int mt2 = ((wave2 + 8 * ti) >> 2); const GAS bf16_t* ap = L1g + (rows2 + mt2 * 16 + fr2) * 256 + 8 * g2;
            fwa[ti * 2] = ld8(ap); fwa[ti * 2 + 1] = ld8(ap + 32); faa[ti * 2] = ld8(ap + 64); faa[ti * 2 + 1] = ld8(ap + 96); if (o) fva[ti] = ld8(ap + 128); }
        { const GAS bf16_t* bp = W2T + ((size_t)h2 * 64 + nt2 * 16 + fr2) * 64 + 8 * g2; fwb[0] = ld8(bp); fwb[1] = ld8(bp + 32); }
        { const GAS bf16_t* bp = A2T + ((size_t)h2 * 64 + nt2 * 16 + fr2) * 64 + 8 * g2; fab[0] = ld8(bp); fab[1] = ld8(bp + 32); }
        if (o) fvb = ld8(V2T + ((size_t)h2 * 64 + nt2 * 16 + fr2) * 32 + 8 * g2);
        const int q2 = wave2 * 2 + (lane2 >> 5), cp2 = lane2 & 31;
#pragma unroll
        for (int j = 0; j < 4; ++j) { const size_t prow2 = rows2 + 4 * q2 + j; const GAS unsigned* zp2 = (const GAS unsigned*)(Z + prow2 * ZW + h2 * 64 + 2 * cp2);
            nr[j] = zp2[0]; nk[j] = zp2[512]; nv[j] = zp2[1024]; nvf[j] = o ? *(const GAS unsigned*)(VF + prow2 * D + h2 * 64 + 2 * cp2) : 0u; }
    };
    auto fetch_compute = [&]() {
#pragma unroll
        for (int ti = 0; ti < 2; ++ti) { const f32x4 z4 = {0.f, 0.f, 0.f, 0.f};
            nlw[ti] = __builtin_amdgcn_mfma_f32_16x16x32_bf16(fwa[ti * 2 + 1], fwb[1], __builtin_amdgcn_mfma_f32_16x16x32_bf16(fwa[ti * 2], fwb[0], z4, 0, 0, 0), 0, 0, 0);
            nla[ti] = __builtin_amdgcn_mfma_f32_16x16x32_bf16(faa[ti * 2 + 1], fab[1], __builtin_amdgcn_mfma_f32_16x16x32_bf16(faa[ti * 2], fab[0], z4, 0, 0, 0), 0, 0, 0);
            if (o) nlv[ti] = __builtin_amdgcn_mfma_f32_16x16x32_bf16(fva[ti], fvb, z4, 0, 0, 0); }
    };
    { F.retid(); int t0 = F.tid; asm volatile("" : "+v"(t0)); fetch_issue(F.vcu, 0, t0); fetch_compute(); }
#pragma unroll 1
    for (int u = F.vcu; u < 2048; u += F.G) {
        const int bh = u & 31, blk = u >> 5, b = bh >> 4, h = bh & 15; const size_t row0 = (size_t)b * SEQ + (size_t)blk * 128;
        F.retid(); int tid = F.tid; asm volatile("" : "+v"(tid));
        __syncthreads();
        if ((F.G & 31) != 0 || u == F.vcu) {
            if (tid < 384) { const int a_ = tid >> 6, ch = tid & 63; const float* src = a_ == 0 ? w0p : a_ == 1 ? a0p : a_ == 2 ? v0p : a_ == 3 ? kkp : a_ == 4 ? kap : rkp; PRM[tid] = src[h * 64 + ch]; } }
        for (int e = tid; e < 64 * 64; e += 512) { const int i = e >> 6, j = e & 63; Pc[i * S64 + j] = (i == j) ? (bf16_t)0x3f80 : (bf16_t)0; Gc[i * S64 + j] = 0; }
#pragma unroll 1
        for (int c = 0; c < 2; ++c) {
            const size_t rows = row0 + 64 * c;
            asm volatile("" : "+v"(tid));
            const int lane = tid & 63; int wave = F.wave; asm volatile("" : "+s"(wave));
            const int cp = lane & 31, q = wave * 2 + (lane >> 5), ch0 = 2 * cp;
            __syncthreads();
            TSX(0);
            unsigned cr[4], ck[4], cv[4], cvf[4];
#pragma unroll
            for (int j = 0; j < 4; ++j) { cr[j] = nr[j]; ck[j] = nk[j]; cv[j] = nv[j]; cvf[j] = nvf[j]; }
            { const int fr_ = lane & 15, g_ = lane >> 4;
#pragma unroll
              for (int ti = 0; ti < 2; ++ti) { const int tile = wave + 8 * ti, r0 = (tile >> 2) * 16 + 4 * g_, col = (tile & 3) * 16 + fr_;
#pragma unroll
                  for (int j = 0; j < 4; ++j) { Lf[(r0 + j) * LFS + col] = nlw[ti][j]; Mm[(r0 + j) * S64 + col] = bfs(nla[ti][j]); if (o) AM[(64 + r0 + j) * S64 + col] = bfs(nlv[ti][j]); } } }
            const int nu = c == 0 ? u : u + F.G, nc = c == 0 ? 1 : 0; const bool has_n = nu < 2048;
            if (has_n) fetch_issue(nu, nc, tid);
            __syncthreads();
            TSX(1);
            float pr[4][2], pkk[4][2], pkm[4][2], pb[4][2], pv[4][2], cd[4][2];
            {
                float ss[4], bon[4];
#pragma unroll
                for (int j = 0; j < 4; ++j) { const int t = 4 * q + j; ss[j] = 0.f; bon[j] = 0.f;
#pragma unroll
                    for (int e = 0; e < 2; ++e) { const int ch = ch0 + e;
                        const float r = e ? __uint_as_float(cr[j] & 0xffff0000u) : __uint_as_float(cr[j] << 16), k = e ? __uint_as_float(ck[j] & 0xffff0000u) : __uint_as_float(ck[j] << 16);
                        float v = e ? __uint_as_float(cv[j] & 0xffff0000u) : __uint_as_float(cv[j] << 16);
                        const float lw = Lf[t * LFS + ch], la = bf2f(Mm[t * S64 + ch]);
                        cd[j][e] = -0.6065306597126334f * sigmoidf_(PRM[ch] + lw);
                        const float a = sigmoidf_(PRM[64 + ch] + la);
                        if (o) { const float lv = bf2f(AM[(64 + t) * S64 + ch]); const float vf = e ? __uint_as_float(cvf[j] & 0xffff0000u) : __uint_as_float(cvf[j] << 16);
                            v = v + (vf - v) * sigmoidf_(PRM[128 + ch] + lv); v = bf2f((bf16_t)f2bf(v)); }
                        const float kr = k * PRM[192 + ch]; ss[j] += kr * kr; pkk[j][e] = kr;
                        const float km = k * (1.f + (a - 1.f) * PRM[256 + ch]); pkm[j][e] = km; pb[j][e] = a; pr[j][e] = r; pv[j][e] = v; bon[j] += r * km * PRM[320 + ch]; }
                    const size_t row = rows + t;
                    if (!DUMMY) { if (o) *(GAS unsigned*)(Z + row * ZW + 2048 + h * 64 + ch0) = pk2(pv[j][0], pv[j][1]); else *(GAS unsigned*)(VF + row * D + h * 64 + ch0) = cv[j]; } }
#pragma unroll
                for (int j = 0; j < 4; ++j) {
                    float s1 = ss[j], b1 = bon[j];
                    s1 += __shfl_xor(s1, 1); s1 += __shfl_xor(s1, 2); s1 += __shfl_xor(s1, 4); s1 += __shfl_xor(s1, 8); s1 += __shfl_xor(s1, 16);
                    b1 += __shfl_xor(b1, 1); b1 += __shfl_xor(b1, 2); b1 += __shfl_xor(b1, 4); b1 += __shfl_xor(b1, 8); b1 += __shfl_xor(b1, 16);
                    const float inv = __builtin_amdgcn_rcpf(fmaxf(sqrtf(s1), 1e-12f));
#pragma unroll
                    for (int e = 0; e < 2; ++e) { pkk[j][e] *= inv; pb[j][e] *= pkk[j][e]; }
                    if (!DUMMY && cp == 0) BON[(rows + 4 * q + j) * 16 + h] = b1; }
#pragma unroll
                for (int e = 0; e < 2; ++e) { cd[1][e] += cd[0][e]; cd[2][e] += cd[1][e]; cd[3][e] += cd[2][e]; SEGT[q * 64 + ch0 + e] = cd[3][e]; }
            }
            __syncthreads();
            TSX(3);
            {
                float pre[2] = {0.f, 0.f};
                for (int qq = 0; qq < q; ++qq) { pre[0] += SEGT[qq * 64 + ch0]; pre[1] += SEGT[qq * 64 + ch0 + 1]; }
                unsigned short at[4][2], bt[4][2], kt[4][2], rt[4][2], vt[4][2];
#pragma unroll
                for (int j = 0; j < 4; ++j)
#pragma unroll
                    for (int e = 0; e < 2; ++e) { const float g = pre[e] + cd[j][e], gp = j ? pre[e] + cd[j - 1][e] : pre[e]; const float eg = __expf(g), egp = __expf(gp), ieg = __builtin_amdgcn_rcpf(eg);
                        at[j][e] = bfs(egp * pkk[j][e]); bt[j][e] = bfs(pb[j][e] * ieg); kt[j][e] = bfs(pkm[j][e] * ieg); rt[j][e] = bfs(pr[j][e] * eg); vt[j][e] = bfs(pv[j][e]);
                        if (q == 15 && j == 3) gamC[ch0 + e] = eg; }
#pragma unroll
                for (int j = 0; j < 4; ++j) { const int t = 4 * q + j;
                    *(LAS unsigned*)(At + t * S64 + ch0) = (unsigned)at[j][0] | ((unsigned)at[j][1] << 16); *(LAS unsigned*)(Rt + t * S64 + ch0) = (unsigned)rt[j][0] | ((unsigned)rt[j][1] << 16);
                    *(LAS unsigned*)(E + t * S64 + ch0) = (unsigned)bt[j][0] | ((unsigned)bt[j][1] << 16); *(LAS unsigned*)(E + (64 + t) * S64 + ch0) = (unsigned)kt[j][0] | ((unsigned)kt[j][1] << 16); }
#pragma unroll
                for (int e = 0; e < 2; ++e) { const int ch = ch0 + e;
#define RW_Q4(x) (u32x2){(unsigned)x[0][e] | ((unsigned)x[1][e] << 16), (unsigned)x[2][e] | ((unsigned)x[3][e] << 16)}
                    *(LAS u32x2*)(AM + ch * S64 + 4 * q) = RW_Q4(at); *(LAS u32x2*)(ET + ch * S128 + 4 * q) = RW_Q4(bt); *(LAS u32x2*)(ET + ch * S128 + 64 + 4 * q) = RW_Q4(kt); *(LAS u32x2*)(X0T + ch * S128 + 64 + 4 * q) = RW_Q4(vt);
#undef RW_Q4
                }
            }
            __syncthreads();
            TSX(4);
            mm<4, 8, 2>(At, S64, E, S64, wave, lane, [&](int, int r0, int col, f32x4 a) {
                const int i = col & 63;
#pragma unroll
                for (int j = 0; j < 4; ++j) { const float v = (i < r0 + j) ? a[j] : 0.f; if (col < 64) Lf[(r0 + j) * LFS + i] = v; else Mm[(r0 + j) * S64 + i] = bfs(v); } });
            __syncthreads();
            TSX(5);
            if (wave < 2) {
                const int bb = 32 * wave; float x[32]; int vz = 0; asm volatile("" : "+v"(vz));
                const LAS float* Lz = Lf + vz; const int cl = lane & 31;
#pragma unroll
                for (int t = 0; t < 32; ++t) x[t] = 0.f;
#pragma unroll
                for (int t = 0; t < 32; ++t) { float s0 = (t == cl) ? 1.f : 0.f, s1 = 0.f, s2 = 0.f, s3 = 0.f;
#pragma unroll
                    for (int i4 = 0; i4 < (t + 3) / 4; ++i4) { const f32x4 l4 = *(const LAS f32x4*)(Lz + (bb + t) * LFS + bb + 4 * i4);
                        s0 -= l4[0] * x[4 * i4]; s1 -= l4[1] * x[4 * i4 + 1]; s2 -= l4[2] * x[4 * i4 + 2]; s3 -= l4[3] * x[4 * i4 + 3]; }
                    x[t] = (s0 + s1) + (s2 + s3); }
                if (lane < 32) {
#pragma unroll
                    for (int t = 0; t < 32; ++t) Tm[(bb + t) * S64 + bb + cl] = bfs(x[t]);
                    if (wave == 0) {
#pragma unroll
                        for (int i4 = 0; i4 < 8; ++i4) st4(X0T + cl * S128 + 4 * i4, (f32x4){x[4 * i4], x[4 * i4 + 1], x[4 * i4 + 2], x[4 * i4 + 3]}); }
                }
            } else {
                mm_rt<4, 8, 2>(Rt, S64, E, S64, wave - 2, 6, lane, [&](int r0, int col, f32x4 a) {
                    const int i = col & 63;
#pragma unroll
                    for (int j = 0; j < 4; ++j) NN[(r0 + j) * S128 + col] = bfs((i <= r0 + j) ? a[j] : 0.f); });
                mm_rt<4, 4, 2>(Mm, S64, X0T + 64, S128, wave - 2, 6, lane, [&](int r0, int col, f32x4 a) { st4(AM + (64 + col) * S64 + r0, (f32x4){-a[0], -a[1], -a[2], -a[3]}); });
                asm volatile("s_waitcnt lgkmcnt(0)" ::: "memory");
                for (int e = tid - 128; e < 32 * 32; e += 384) { const int t = e >> 5, i = e & 31; X0T[t * S128 + 32 + i] = bfs(Lf[(32 + t) * LFS + i]); Tm[t * S64 + 32 + i] = 0; }
            }
            __syncthreads();
            TSX(6);
            if (wave < 4) { const int fr_ = lane & 15, g_ = lane >> 4, mt = wave >> 1, nt = wave & 1;
                const f32x4 z4 = {0.f, 0.f, 0.f, 0.f};
                const f32x4 a = __builtin_amdgcn_mfma_f32_16x16x32_bf16(ld8(X0T + (mt * 16 + fr_) * S128 + 32 + 8 * g_), ld8(X0T + (nt * 16 + fr_) * S128 + 8 * g_), z4, 0, 0, 0);
                st4(Mm + (nt * 16 + fr_) * S64 + mt * 16 + 4 * g_, a); }
            __syncthreads();
            if (wave < 4) { const int fr_ = lane & 15, g_ = lane >> 4, mt = wave >> 1, nt = wave & 1;
                const f32x4 z4 = {0.f, 0.f, 0.f, 0.f};
                const f32x4 a = __builtin_amdgcn_mfma_f32_16x16x32_bf16(ld8(Tm + (32 + mt * 16 + fr_) * S64 + 32 + 8 * g_), ld8(Mm + (nt * 16 + fr_) * S64 + 8 * g_), z4, 0, 0, 0);
#pragma unroll
                for (int j = 0; j < 4; ++j) Tm[(32 + mt * 16 + 4 * g_ + j) * S64 + nt * 16 + fr_] = bfs(-a[j]); }
            __syncthreads();
            TSX(7);
            mm<4, 8, 2>(Tm, S64, AM, S64, wave, lane, [&](int, int r0, int col, f32x4 a) { if (col < 64) st4(WT + col * S64 + r0, a); else st4(X0T + (col - 64) * S128 + r0, a); });
            __syncthreads();
            TSX(8);
            f32x4 gt[2], y0t[2];
            mm<4, 4, 2>(WT, S64, ET, S128, wave, lane, [&](int, int r0, int col, f32x4 a) { const float gc = gamC[col];
                f32x4 p;
#pragma unroll
                for (int j = 0; j < 4; ++j) p[j] = (((r0 + j) == col ? 1.f : 0.f) - a[j]) * gc;
                st4(PT + col * S64 + r0, p); });
            mm<4, 4, 4>(X0T, S128, ET, S128, wave, lane, [&](int ti, int, int col, f32x4 a) { const float gc = gamC[col]; gt[ti] = a * gc; });
            mm<4, 4, 4>(NN, S128, X0T, S128, wave, lane, [&](int ti, int, int, f32x4 a) { y0t[ti] = a; });
            mm<4, 4, 2>(NN, S128, WT, S64, wave, lane, [&](int, int r0, int col, f32x4 a) {
#pragma unroll
                for (int j = 0; j < 4; ++j) Qh[(r0 + j) * S64 + col] = bfs(bf2f(Rt[(r0 + j) * S64 + col]) - a[j]); });
            __syncthreads();
            TSX(9);
            GAS bf16_t* rslot = Z + row0 * ZW + h * 64; GAS bf16_t* kslot = rslot + 1024;
            mm<4, 4, 2>(Qh, S64, Pc, S64, wave, lane, [&](int, int r0, int col, f32x4 a) {
                const int kt_ = col >> 5, rho = col & 31, s = rho >> 4, jj = ((rho >> 3) & 1) * 4 + (rho & 3), hh = (rho >> 2) & 1;
#pragma unroll
                for (int j = 0; j < 4; ++j) { const int t = 64 * c + r0 + j, tt_ = t >> 5, ln = 32 * hh + (t & 31); const int e = ((((tt_ * 2 + kt_) * 2 + s) * 64 + ln) << 3) + jj;
                    if (!DUMMY) rslot[(size_t)(e >> 6) * ZW + (e & 63)] = bfs(a[j]); else asm volatile("" :: "v"(a[j])); } });
            mm<4, 4, 2>(Qh, S64, Gc, S64, wave, lane, [&](int ti, int r0, int col, f32x4 a) {
                const int vt_ = col >> 5, v31 = col & 31;
#pragma unroll
                for (int j = 0; j < 4; ++j) { const int t = 64 * c + r0 + j, tt_ = t >> 5, x = t & 31, hh = (x >> 2) & 1, r = (x & 3) + 4 * (x >> 3); const int e = (((tt_ * 2 + vt_) * 64 + 32 * hh + v31) << 4) + r;
                    if (!DUMMY) kslot[(size_t)(e >> 6) * ZW + (e & 63)] = bfs(a[j] + y0t[ti][j]); else asm volatile("" :: "v"(a[j] + y0t[ti][j])); } });
            f32x4 pn[2], gn[2];
            mm<4, 4, 2>(Pc, S64, PT, S64, wave, lane, [&](int ti, int, int, f32x4 a) { pn[ti] = a; });
            mm<4, 4, 2>(Gc, S64, PT, S64, wave, lane, [&](int ti, int, int, f32x4 a) { gn[ti] = a + gt[ti]; });
            if (has_n) fetch_compute();
            __syncthreads();
            { const int fr = lane & 15, g = lane >> 4;
#pragma unroll
              for (int ti = 0; ti < 2; ++ti) { const int tile = wave + 8 * ti, mt = tile >> 2, nt = tile & 3;
#pragma unroll
                  for (int j = 0; j < 4; ++j) { Pc[(mt * 16 + 4 * g + j) * S64 + nt * 16 + fr] = bfs(pn[ti][j]); Gc[(mt * 16 + 4 * g + j) * S64 + nt * 16 + fr] = bfs(gn[ti][j]); } } }
            TSX(10);
        }
        __syncthreads();
        if (!DUMMY) { GAS bf16_t* pg = PG + (size_t)u * 8192;
          { const int f = tid >> 6, ln = tid & 63, s = f & 1, kit = (f >> 1) & 1, kot = f >> 2, hh = ln >> 5, r31 = ln & 31; unsigned short w[8];
#pragma unroll
            for (int j = 0; j < 8; ++j) { const int rho = 16 * s + 8 * (j >> 2) + 4 * hh + (j & 3); w[j] = Pc[(32 * kit + rho) * S64 + 32 * kot + r31]; }
            *(GAS u32x4*)(pg + (size_t)tid * 8) = (u32x4){(unsigned)w[0] | ((unsigned)w[1] << 16), (unsigned)w[2] | ((unsigned)w[3] << 16), (unsigned)w[4] | ((unsigned)w[5] << 16), (unsigned)w[6] | ((unsigned)w[7] << 16)}; }
          { const int tile = tid >> 7, ln = (tid >> 1) & 63, half = tid & 1, kot = tile >> 1, vt_ = tile & 1, hh = ln >> 5, v31 = ln & 31; unsigned short w[8];
#pragma unroll
            for (int q = 0; q < 8; ++q) { const int r = 8 * half + q; const int ko = 32 * kot + (r & 3) + 8 * (r >> 2) + 4 * hh; w[q] = Gc[(32 * vt_ + v31) * S64 + ko]; }
            *(GAS u32x4*)(pg + 4096 + ((size_t)(tile * 64 + ln) << 4) + 8 * half) = (u32x4){(unsigned)w[0] | ((unsigned)w[1] << 16), (unsigned)w[2] | ((unsigned)w[3] << 16), (unsigned)w[4] | ((unsigned)w[5] << 16), (unsigned)w[6] | ((unsigned)w[7] << 16)}; } }
    }
    __syncthreads();
}

__device__ __forceinline__ void rwkv_stage_y(Frame& F, const int bx) {
    const int lane = F.lane, wave = F.wave, bh = bx, vt = wave >> 2; const bool st = ((wave & 3) == 0);
    const bf16_t* PG = (const bf16_t*)(F.H); u32x4* SB = (u32x4*)(F.ws + WS_SB);
    LAS bf16x8* pgbuf = (LAS bf16x8*)F.lds;
    f32x16 X0, X1;
#pragma unroll
    for (int r = 0; r < 16; ++r) { X0[r] = 0.f; X1[r] = 0.f; }
    bf16x8 Ra0, Ra1, Rb0, Rb1, Rc0, Rc1;
    auto issue = [&](bf16x8& r0, bf16x8& r1, int blk) { const bf16_t* pg = PG + (size_t)(blk * 32 + bh) * 8192;
        r0 = ld8p(pg + (((size_t)(wave * 2 + 0) * 64 + lane) << 3)); r1 = ld8p(pg + (((size_t)(wave * 2 + 1) * 64 + lane) << 3)); };
    auto step = [&](bf16x8& c0, bf16x8& c1, bf16x8& n0r, bf16x8& n1r, int blk) {
        const bf16x8 nga = n0r, ngb = n1r;
        issue(c0, c1, blk + 3 < 64 ? blk + 3 : 63);
        asm volatile("s_waitcnt lgkmcnt(0)" ::: "memory"); __builtin_amdgcn_s_barrier(); asm volatile("" ::: "memory");
        pgbuf[((blk + 1) & 1) * 1024 + (wave * 2 + 0) * 64 + lane] = nga; pgbuf[((blk + 1) & 1) * 1024 + (wave * 2 + 1) * 64 + lane] = ngb;
        if (st) {
            u32x4 xb[4];
#pragma unroll
            for (int s = 0; s < 2; ++s) {
                xb[s] = (u32x4){cvt_pk_bf16(X0[8 * s], X0[8 * s + 1]), cvt_pk_bf16(X0[8 * s + 2], X0[8 * s + 3]), cvt_pk_bf16(X0[8 * s + 4], X0[8 * s + 5]), cvt_pk_bf16(X0[8 * s + 6], X0[8 * s + 7])};
                xb[2 + s] = (u32x4){cvt_pk_bf16(X1[8 * s], X1[8 * s + 1]), cvt_pk_bf16(X1[8 * s + 2], X1[8 * s + 3]), cvt_pk_bf16(X1[8 * s + 4], X1[8 * s + 5]), cvt_pk_bf16(X1[8 * s + 6], X1[8 * s + 7])}; }
            u32x4* sb = SB + ((size_t)(blk * 32 + bh) * 8 + vt * 4) * 64 + lane;
#pragma unroll
            for (int q = 0; q < 4; ++q) sb[q * 64] = xb[q];
            const LAS bf16x8* pb = pgbuf + (blk & 1) * 1024;
            f32x16 n0, n1;
            { const bf16x8 c0a = pb[512 + ((0 * 2 + vt) * 64 + lane) * 2], c0b = pb[512 + ((0 * 2 + vt) * 64 + lane) * 2 + 1], c1a = pb[512 + ((1 * 2 + vt) * 64 + lane) * 2], c1b = pb[512 + ((1 * 2 + vt) * 64 + lane) * 2 + 1];
#pragma unroll
              for (int r = 0; r < 8; ++r) { n0[r] = bf2f((bf16_t)c0a[r]); n0[8 + r] = bf2f((bf16_t)c0b[r]); n1[r] = bf2f((bf16_t)c1a[r]); n1[8 + r] = bf2f((bf16_t)c1b[r]); } }
#pragma unroll
            for (int q = 0; q < 4; ++q) {
                n0 = __builtin_amdgcn_mfma_f32_32x32x16_bf16(pb[q * 64 + lane], __builtin_bit_cast(bf16x8, xb[q]), n0, 0, 0, 0);
                n1 = __builtin_amdgcn_mfma_f32_32x32x16_bf16(pb[(4 + q) * 64 + lane], __builtin_bit_cast(bf16x8, xb[q]), n1, 0, 0, 0); }
            X0 = n0; X1 = n1;
        }
    };
    issue(Ra0, Ra1, 0); issue(Rb0, Rb1, 1); issue(Rc0, Rc1, 2);
    pgbuf[(wave * 2 + 0) * 64 + lane] = Ra0; pgbuf[(wave * 2 + 1) * 64 + lane] = Ra1;
#pragma unroll 1
    for (int blk = 0; blk < 63; blk += 3) { step(Ra0, Ra1, Rb0, Rb1, blk); step(Rb0, Rb1, Rc0, Rc1, blk + 1); step(Rc0, Rc1, Ra0, Ra1, blk + 2); }
    step(Ra0, Ra1, Rb0, Rb1, 63);
    __syncthreads();
}

template <bool DUMMY>
__device__ __forceinline__ void rwkv_stage_z(Frame& F, int li) {
    const int o = li >> 1;
    bf16_t* Z = (bf16_t*)(F.ws + WS_Z); const float* BON = (const float*)(F.ws + WS_BON); const u32x4* SB = (const u32x4*)(F.ws + WS_SB);
    const float* lgp = F.in[24] + o * D; const float* lbp = F.in[25] + o * D;
    LAS float* tile = (LAS float*)(F.lds + F.wave * 9216);
    int lane_ = F.lane;
#pragma unroll 1
    for (int w = F.vcu * 8 + F.wave; w < 8192; w += F.G * 8) {
        asm volatile("" : "+v"(lane_)); const int lane = lane_, v31 = lane & 31, hh = lane >> 5, tl = lane >> 1, hf = lane & 1;
        const int u = w >> 2, tt = w & 3, bh = u & 31, blk = u >> 5, b = bh >> 4, h = bh & 15; const size_t row0 = (size_t)b * SEQ + (size_t)blk * 128;
        const bf16_t* rslot = Z + row0 * ZW + h * 64; const bf16_t* kslot = rslot + 1024;
        const size_t row = row0 + 32 * tt + tl; bf16_t* zp = Z + row * ZW + h * 64 + 32 * hf;
        bf16x8 vv[4], gg[4];
#pragma unroll
        for (int q = 0; q < 4; ++q) { vv[q] = ld8p(zp + 2048 + 8 * q); gg[q] = ld8p(zp + 3072 + 8 * q); }
        const float bon = BON[row * 16 + h];
        bf16x8 qf[4]; u32x4 xb[2][4];
#pragma unroll
        for (int q = 0; q < 4; ++q) { const int e = (((tt * 4 + q) * 64 + lane) << 3); qf[q] = ld8p(rslot + (size_t)(e >> 6) * ZW + (e & 63)); }
#pragma unroll
        for (int vt = 0; vt < 2; ++vt)
#pragma unroll
            for (int q = 0; q < 4; ++q) xb[vt][q] = SB[((size_t)u * 8 + vt * 4 + q) * 64 + lane];
#pragma unroll
        for (int vt = 0; vt < 2; ++vt) { const int e0 = ((tt * 2 + vt) * 64 + lane) << 4; const bf16_t* yp = kslot + (size_t)(e0 >> 6) * ZW + (e0 & 63); const bf16x8 ya = ld8p(yp), yb = ld8p(yp + 8);
            f32x16 acc;
#pragma unroll
            for (int r = 0; r < 8; ++r) { acc[r] = bf2f((bf16_t)ya[r]); acc[8 + r] = bf2f((bf16_t)yb[r]); }
#pragma unroll
            for (int q = 0; q < 4; ++q) acc = __builtin_amdgcn_mfma_f32_32x32x16_bf16(qf[q], __builtin_bit_cast(bf16x8, xb[vt][q]), acc, 0, 0, 0);
#pragma unroll
            for (int r = 0; r < 16; ++r) tile[((r & 3) + 8 * (r >> 2) + 4 * hh) * 72 + 36 * vt + v31] = acc[r]; }
        LDS_WAIT(); asm volatile("" ::: "memory");
        float y[32]; float sm = 0.f;
#pragma unroll
        for (int q = 0; q < 8; ++q) { const f32x4 t4 = *(const LAS f32x4*)(tile + tl * 72 + 36 * hf + 4 * q); y[4 * q] = t4[0]; y[4 * q + 1] = t4[1]; y[4 * q + 2] = t4[2]; y[4 * q + 3] = t4[3]; sm += (t4[0] + t4[1]) + (t4[2] + t4[3]); }
        sm += __shfl_xor(sm, 1);
        const float mu = sm * (1.f / 64.f); float qq = 0.f;
#pragma unroll
        for (int j = 0; j < 32; ++j) { y[j] -= mu; qq += y[j] * y[j]; }
        qq += __shfl_xor(qq, 1);
        const float rsd = rsqrtf(qq * (1.f / 64.f) + 64e-5f);
        const float* lg = lgp + h * 64 + 32 * hf; const float* lb = lbp + h * 64 + 32 * hf;
#pragma unroll
        for (int q = 0; q < 4; ++q) { float ov[8];
#pragma unroll
            for (int j = 0; j < 8; ++j) { const int c = 8 * q + j; const float va = bf2f((bf16_t)vv[q][j]), ga = bf2f((bf16_t)gg[q][j]); ov[j] = (y[c] * rsd * lg[c] + lb[c] + bon * va) * siluf_(ga); }
            const u32x4 wv = {cvt_pk_bf16(ov[0], ov[1]), cvt_pk_bf16(ov[2], ov[3]), cvt_pk_bf16(ov[4], ov[5]), cvt_pk_bf16(ov[6], ov[7])};
            if (!DUMMY) *(u32x4*)(zp + 3072 + 8 * q) = wv; else asm volatile("" :: "v"(wv)); }
        LDS_WAIT(); asm volatile("" ::: "memory");
    }
}

enum { PH_P0 = 0, PH_FINAL = 27, N_PHASES = 28 };
#define IN(k) (lo <= (k) && (k) < hi)
#define TSG(k) do { if (LI == 0) { if (MK_GA == (k)) tA = __builtin_amdgcn_s_memrealtime(); if (MK_GB == (k)) tB = __builtin_amdgcn_s_memrealtime(); } } while (0)
#define TS(k) do { if (MK_TPA == (k)) tA = __builtin_amdgcn_s_memrealtime(); if (MK_TPB == (k)) tB = __builtin_amdgcn_s_memrealtime(); } while (0)
#if MK_MULTI
#define SEAM(k) do { } while (0)
#else
#define SEAM(k) do { if (IN(k) && IN((k) + 1)) xcd_barrier(bar); } while (0)
#endif
template <int LI>
__device__ __forceinline__ void run_layer(Frame& F, const XcdBarrier& bar, const int lo, const int hi, const int bx, unsigned long long& tA, unsigned long long& tB) {
    constexpr bool even = (LI & 1) == 0;
    constexpr int base = 1 + (LI / 2) * 13 + (even ? 0 : 6);
    bf16_t* Zp = (bf16_t*)(F.ws + WS_Z);
    if constexpr (even) {
        TS(base); if (IN(base)) { F.retid(); pg8::StaticOrder S; S.init(64, 16, F.G, bx);
            pg8::Gemm g{(const bf16_t*)(F.ws + WS_HB), (const bf16_t*)(F.ws + WS_WIN)};
            EpiEvenIn E{Zp, F.ssq(LI), (bf16_t*)(F.ws + WS_VTA), (bf16_t*)(F.ws + WS_VTB), (bf16_t*)(F.ws + WS_KT)};
            if (MK_PROBE == 1) pg8::gemm_phase<EpiEvenIn, true, D, D, 1 << 20, 0, 0>(F.lds, F.tid, g, S, E);
            pg8::gemm_phase<EpiEvenIn, true, D, D, 1 << 20, 0, 0>(F.lds, F.tid, g, S, E); }
        SEAM(base);
        TS(base + 1); if (IN(base + 1)) { F.retid();
            TSG(0); conv_wrest_a(F, LI); TSG(1);
            if constexpr (LI < 3) conv_win_odd(F, LI + 1);
            TSG(2);
            if (MK_PROBE == 5) { for (int u = F.vcu * 8 + F.wave; u < 4096; u += F.G * 8) ret_stage_a(F, u);
                for (int u = F.vcu * 8 + F.wave; u < 2048; u += F.G * 8) sb_unit<true>(F, u >> 8, u & 255); }
            for (int u = F.vcu * 8 + F.wave; u < 4096; u += F.G * 8) ret_stage_a(F, u);
            __syncthreads(); TSG(3);
            for (int u = F.vcu * 8 + F.wave; u < 2048; u += F.G * 8) sb_unit<false>(F, u >> 8, u & 255);
            __syncthreads(); TSG(4); }
        SEAM(base + 1);
        TS(base + 2); if (IN(base + 2)) { F.retid(); ret_stage_b(F); conv_wrest_b(F, LI, F.vcu, F.G); }
        SEAM(base + 2);
        TS(base + 3); if (IN(base + 3)) { F.retid(); const float* gng = F.in[8] + (LI >> 1) * 512;
            if (MK_PROBE == 6) for (int u = F.vcu * 8 + F.wave; u < 2048; u += F.G * 8) ret_stage_c<true>(F, u, gng);
            for (int u = F.vcu * 8 + F.wave; u < 2048; u += F.G * 8) ret_stage_c<false>(F, u, gng); }
        SEAM(base + 3);
        TS(base + 4); if (IN(base + 4)) { F.retid(); pg8::StaticOrder S; S.init(64, 4, F.G, bx);
            { pg8::Gemm g{(const bf16_t*)(F.ws + WS_PB), (const bf16_t*)(F.ws + WS_WPROJ)};
              EpiStore E{Zp, ZE}; pg8::gemm_phase<EpiStore, false, PLE, PLE, 1 << 20, 0, 0>(F.lds, F.tid, g, S, E); }
            { pg8::Gemm g{Zp + 1024, (const bf16_t*)(F.ws + WS_WOUT)};
              EpiResid E{(const bf16_t*)(F.ws + WS_HB), Zp + 1536, ZE}; pg8::gemm_phase<EpiResid, false, ZE, D, 8, (long)((2560 - 1024) * 2), 0>(F.lds, F.tid, g, S, E); } }
        SEAM(base + 4);
        TS(base + 5); if (IN(base + 5)) { F.retid(); pg8::StaticOrder S; S.init(64, 4, F.G, bx);
            pg8::Gemm g{Zp + 1536, (const bf16_t*)(F.ws + WS_WGATE)};
            EpiGate E{Zp + 1536, ZE, Zp, ZE, (bf16_t*)(F.ws + WS_HB), F.ssq(LI + 1)};
            pg8::gemm_phase<EpiGate, false, ZE, D, 1 << 20, 0, 0>(F.lds, F.tid, g, S, E); }
        SEAM(base + 5);
    } else {
        TS(base); if (IN(base)) { F.retid(); conv_lora2(F, LI); norm_lora_phase(F, LI); }
        SEAM(base);
        TS(base + 1); if (IN(base + 1)) { F.retid(); pg8::StaticOrder S; S.init(64, 16, F.G, bx);
            pg8::Gemm g{(const bf16_t*)(F.H) + D, (const bf16_t*)(F.ws + WS_WIN)};
            EpiOddIn E{Zp, (bf16_t*)(F.ws + WS_L1)};
            if (MK_PROBE == 2) pg8::gemm_phase<EpiOddIn, true, D, 2048, 16, -(long)(D * 2), (long)(D * 2)>(F.lds, F.tid, g, S, E);
            pg8::gemm_phase<EpiOddIn, true, D, 2048, 16, -(long)(D * 2), (long)(D * 2)>(F.lds, F.tid, g, S, E); }
        SEAM(base + 1);
        TS(base + 2); if (IN(base + 2)) { F.retid();
            conv_wrest_a(F, LI);
            __syncthreads();
            { unsigned long long xa = 0; rwkv_stage_x<false>(F, LI, xa); if (LI == 1 && MK_XA >= 0) { tA = 0; tB = xa; } } }
        SEAM(base + 2);
        TS(base + 3); if (IN(base + 3)) { F.retid();
            if (bx < 32) rwkv_stage_y(F, bx);
            else { pg8::StaticOrder S; S.init(64, 4, F.G - 32, bx - 32);
                pg8::Gemm g{(const bf16_t*)(F.ws + WS_PB), (const bf16_t*)(F.ws + WS_WPROJ)};
                EpiStore E{(bf16_t*)(F.H) + (size_t)16 * 1024 * 1024, D}; pg8::gemm_phase<EpiStore, false, PLE, PLE, 1 << 20, 0, 0>(F.lds, F.tid, g, S, E);
                __syncthreads(); conv_wrest_b(F, LI, bx - 32, F.G - 32); } }
        SEAM(base + 3);
        TS(base + 4); if (IN(base + 4)) { F.retid(); rwkv_stage_z<false>(F, LI); }
        SEAM(base + 4);
        TS(base + 5); if (IN(base + 5)) { F.retid(); pg8::StaticOrder S; S.init(64, 4, F.G, bx);
            if constexpr (LI < 3) { conv_win_even(F, LI + 1); __syncthreads(); }
            { pg8::Gemm g{Zp + 3072, (const bf16_t*)(F.ws + WS_WOUT)};
              EpiResid E{(const bf16_t*)(F.ws + WS_HB), Zp + 2048, ZW}; pg8::gemm_phase<EpiResid, false, ZW, D, 1 << 20, 0, 0>(F.lds, F.tid, g, S, E); } }
        SEAM(base + 5);
        TS(base + 6); if (IN(base + 6)) { F.retid(); pg8::StaticOrder S; S.init(64, 4, F.G, bx);
            pg8::Gemm g{Zp + 2048, (const bf16_t*)(F.ws + WS_WGATE)};
            EpiGate E{Zp + 2048, ZW, (const bf16_t*)(F.H) + (size_t)16 * 1024 * 1024, D, (bf16_t*)(F.ws + WS_HB), F.ssq(LI + 1)};
            pg8::gemm_phase<EpiGate, false, ZW, D, 1 << 20, 0, 0>(F.lds, F.tid, g, S, E); }
        SEAM(base + 6);
    }
}
__global__ void __launch_bounds__(512, 2) mk_fwd(Args args) {
    extern __shared__ __attribute__((aligned(16))) unsigned char lds_raw[];
    Frame F;
    F.lds = (LAS unsigned char*)lds_raw; F.ldsg = lds_raw;
    F.tid = threadIdx.x; F.lane = F.tid & 63; F.wave = __builtin_amdgcn_readfirstlane(F.tid >> 6);
    F.G = gridDim.x; const int bx = blockIdx.x; F.vcu = (F.G % 8 == 0) ? (bx % 8) * (F.G / 8) + bx / 8 : bx;
    F.H = args.out; F.ws = args.ws;
    volatile LAS unsigned* MISC = (volatile LAS unsigned*)(F.lds + MISC_OFF);
    for (int u = F.tid; u < 128; u += 512) ((LAS unsigned*)(F.lds + MISC_OFF))[u] = 0u;
    __syncthreads();
    XcdBarrier bar; bar.bar = (unsigned*)(F.ws + WS_CTL) + 4096; bar.x = 0; bar.st = nullptr;
#if !MK_MULTI
    bar = xcd_barrier_post((unsigned*)(F.ws + WS_CTL) + 4096, MISC + 8);
#endif
    const int lo = args.ph_lo, hi = args.ph_hi;
    if (IN(PH_P0)) { F.retid(); rows_p0(F); conv_win_even(F, 0); }
#if !MK_MULTI
    if (IN(0) && IN(1)) { VM_WAIT(); cg::this_grid().sync(); }
#endif
    unsigned long long tA = 0, tB = 0;
    TS(0);
    run_layer<0>(F, bar, lo, hi, bx, tA, tB);
    run_layer<1>(F, bar, lo, hi, bx, tA, tB);
    run_layer<2>(F, bar, lo, hi, bx, tA, tB);
    run_layer<3>(F, bar, lo, hi, bx, tA, tB);
    TS(PH_FINAL);
    if (IN(PH_FINAL)) { F.retid(); rows_final(F); }
    TS(PH_FINAL + 1);
    if ((MK_TPA >= 0 || MK_XA >= 0 || MK_GA >= 0) && blockIdx.x == 0 && threadIdx.x == 0) { const unsigned long long t0 = __builtin_amdgcn_s_memrealtime(), span = 4ull * (tB - tA); while (__builtin_amdgcn_s_memrealtime() - t0 < span) __builtin_amdgcn_s_sleep(8); }
}

extern "C" void kernel_launch(void* const* d_in, const int* in_sizes, int n_in, void* d_out, int out_size, void* d_ws, size_t ws_size, hipStream_t stream) {
    static int grid = 0;
    if (grid == 0) {
        int dev = 0, cus = 0, per_cu = 0;
        (void)hipGetDevice(&dev); (void)hipDeviceGetAttribute(&cus, hipDeviceAttributeMultiprocessorCount, dev);
        (void)hipFuncSetAttribute((const void*)mk_fwd, hipFuncAttributeMaxDynamicSharedMemorySize, LDS_BYTES);
        (void)hipOccupancyMaxActiveBlocksPerMultiprocessor(&per_cu, (const void*)mk_fwd, 512, LDS_BYTES);
        if (per_cu < 1) per_cu = 1;
        grid = cus * 1;
        if (n_in != 26 || ws_size < WS_END) fprintf(stderr, "kernel_launch: unexpected n_in %d / ws %zu\n", n_in, ws_size);
        (void)hipGetLastError();
    }
    (void)hipMemsetAsync((char*)d_ws + WS_CTL, 0, CTL_BYTES, stream);
    Args a{};
    for (int i = 0; i < 26; ++i) a.in[i] = (const float*)d_in[i];
    a.out = (float*)d_out; a.ws = (unsigned char*)d_ws;
#if MK_MULTI
    for (int ph = 0; ph < N_PHASES; ++ph) { a.ph_lo = ph; a.ph_hi = ph + 1; hipLaunchKernelGGL(mk_fwd, dim3(grid), dim3(512), LDS_BYTES, stream, a); }
#else
    a.ph_lo = 0; a.ph_hi = N_PHASES;
    void* kargs[] = {&a};
    hipError_t e = hipLaunchCooperativeKernel((const void*)mk_fwd, dim3(grid), dim3(512), kargs, LDS_BYTES, stream);
    if (e != hipSuccess) fprintf(stderr, "cooperative launch failed: %s (grid %d)\n", hipGetErrorString(e), grid);
#endif
}
```

```cpp
#include <hip/hip_runtime.h>
#include <hip/hip_cooperative_groups.h>
#include <cstdint>
#include <cstdio>
namespace cg = cooperative_groups;

#ifndef MK_PROBE
#define MK_PROBE 0
#endif
#ifndef MK_TPA
#define MK_TPA -1
#define MK_TPB -1
#endif
#ifndef MK_XA
#define MK_XA -1
#define MK_XB -1
#endif
#ifndef MK_GA
#define MK_GA -1
#define MK_GB -1
#endif
#ifndef MK_MULTI
#define MK_MULTI 0
#endif

#define LAS __attribute__((address_space(3)))
#define GAS __attribute__((address_space(1)))
typedef unsigned short bf16_t;
typedef short bf16x8 __attribute__((ext_vector_type(8)));
typedef float f32x4 __attribute__((ext_vector_type(4)));
typedef float f32x2 __attribute__((ext_vector_type(2)));
typedef unsigned u32x4 __attribute__((ext_vector_type(4)));
typedef unsigned u32x2 __attribute__((ext_vector_type(2)));

constexpr int D = 1024, BATCH = 2, SEQ = 8192, T = BATCH * SEQ, PLE = 256, ZW = 4096, ZE = 3072;
constexpr float QK_SCALE = 0.08838834764831845f;

__device__ __forceinline__ float bf2f(bf16_t v) { return __uint_as_float(((unsigned)v) << 16); }
__device__ __forceinline__ unsigned f2bf(float f) { unsigned u = __float_as_uint(f); return (u + 0x7fffu + ((u >> 16) & 1u)) >> 16; }
__device__ __forceinline__ unsigned pk2(float lo, float hi) { return f2bf(lo) | (f2bf(hi) << 16); }
typedef __bf16 bf16x2_t __attribute__((ext_vector_type(2)));
__device__ __forceinline__ unsigned cvt_pk_bf16(float lo, float hi) { f32x2 v = {lo, hi}; bf16x2_t b = __builtin_convertvector(v, bf16x2_t); return __builtin_bit_cast(unsigned, b); }
__device__ __forceinline__ float wave_sum(float v) {
#pragma unroll
    for (int o = 1; o < 64; o <<= 1) v += __shfl_xor(v, o);
    return v;
}
__device__ __forceinline__ float sigmoidf_(float x) { return __builtin_amdgcn_rcpf(1.f + __expf(-x)); }
__device__ __forceinline__ float siluf_(float x) { return x * __builtin_amdgcn_rcpf(1.f + __expf(-x)); }
__device__ __forceinline__ float softplusf_(float x) { return x > 20.f ? x : log1pf(expf(x)); }
__device__ __forceinline__ float logsigf_(float x) { return -(x < -20.f ? -x : log1pf(expf(-x))); }
__device__ __forceinline__ float ssq_sum(const float* sq, int row) { const f32x4* p = (const f32x4*)(sq + (size_t)row * 16); const f32x4 a = p[0], b = p[1], c = p[2], d = p[3];
    return (((a[0] + a[1]) + (a[2] + a[3])) + ((b[0] + b[1]) + (b[2] + b[3]))) + (((c[0] + c[1]) + (c[2] + c[3])) + ((d[0] + d[1]) + (d[2] + d[3]))); }
#define LDS_WAIT() asm volatile("s_waitcnt lgkmcnt(0)" ::: "memory")
#define VM_WAIT() asm volatile("s_waitcnt vmcnt(0)" ::: "memory")

namespace pg8 {
constexpr int BM = 256, BK = 64, HALF = 128, HTB = HALF * BK * 2, STAGE_BYTES = 8 * HTB, NXCD = 8, WGM = 8;
__host__ __device__ __forceinline__ int lds_byte(int r, int c) { const int st = (r >> 4) * 2 + (c >> 5), rr = r & 15, cc = c & 31, ob = rr * 64 + cc * 2; return st * 1024 + (ob ^ (((ob >> 9) & 1) << 5)); }
__host__ __device__ __forceinline__ void stage_rc(int b, int& R, int& C) { const int st = b / 1024, sb = b % 1024, swz = sb ^ (((sb >> 9) & 1) << 5); R = (st >> 1) * 16 + swz / 64; C = (st & 1) * 32 + (swz % 64) / 2; }
__host__ __device__ __forceinline__ int perm32(int rho) { const int n = rho >> 4, i = rho & 15; return 8 * (i >> 2) + 4 * n + (i & 3); }
struct Unit { int pm, pn; };
struct Gemm { const bf16_t* A; const bf16_t* Bt; };
struct StaticOrder {
    int nM, nN, nwg, G, c;
    __device__ void init(int nM_, int nN_, int G_, int c_) { nM = nM_; nN = nN_; nwg = nM * nN; G = G_; c = c_; }
    __device__ bool next(int i, Unit& u) const {
        const long L = (long)i * G + c; if (L >= nwg) return false;
        int wgid = (int)L; { const int q = nwg / NXCD, r = nwg % NXCD, xcd = wgid % NXCD, off = wgid / NXCD; wgid = (xcd < r ? xcd * (q + 1) : r * (q + 1) + (xcd - r) * q) + off; }
        const int nig = WGM * nN, gid = wgid / nig, fm = gid * WGM, gsz = (nM - fm) < WGM ? (nM - fm) : WGM;
        u.pm = fm + ((wgid % nig) % gsz); u.pn = (wgid % nig) / gsz; return true;
    }
};
template <class Epi, bool ALIGN_EPI, int LDA, int KK, int TSPLIT, long ASHIFT, long BROW>
__device__ __forceinline__ void gemm_phase(LAS unsigned char* lds, const int tid_in, const Gemm g, const StaticOrder& S, const Epi& E) {
    int tid = tid_in; asm volatile("" : "+v"(tid));
    const int wid = __builtin_amdgcn_readfirstlane(tid >> 6), lane = tid & 63, wr = wid >> 2, wc = wid & 3, fr = lane & 15, fq = lane >> 4;
    constexpr int K = KK, nt = K / BK, lda = LDA, tsplit = TSPLIT; constexpr long ashift = ASHIFT;
    unsigned voffA[2], voffB[2];
#pragma unroll
    for (int i = 0; i < 2; ++i) { int R, C; stage_rc(tid * 16 + i * 8192, R, C); const int Rb = (R & ~31) + perm32(R & 31);
        voffA[i] = (unsigned)(R * lda + C) * 2u; voffB[i] = (unsigned)(Rb * K + C) * 2u; }
    constexpr size_t kstep = (size_t)(BK * 2);
    constexpr size_t hstepA = (size_t)HALF * lda * 2, hstepB = (size_t)HALF * K * 2, tstepA = 2 * hstepA, tstepB = 2 * hstepB;
    const unsigned ldsw = (unsigned)wid * 1024u;
    const int aoff = lds_byte(wr * 64 + fr, fq * 8), boff = lds_byte(wc * 32 + fr, fq * 8);
#define PG8_AP(base, tt) ((base) + (((tt) < tsplit) ? (long)(tt) * 128 : ashift + (long)((tt) - tsplit) * 128))
#define PG8_ABASE(u) ((const char*)g.A + (size_t)(u).pm * tstepA + ((BROW != 0 && (u).pm >= 32) ? BROW : 0))
#define PG8_SA(b, h) (((b) * 2 + (h)) * HTB)
#define PG8_SB(b, h) ((4 + (b) * 2 + (h)) * HTB)
#define PG8_STAGE(bufoff, gbase, voff) do { const char* _gb = (const char*)(gbase); asm volatile("" : "+s"(_gb)); _Pragma("unroll") for (int _i = 0; _i < 2; ++_i) \
        __builtin_amdgcn_global_load_lds((const unsigned*)(_gb + (voff)[_i]), (LAS unsigned*)(lds + (bufoff) + ldsw + _i * 8192), 16, 0, 0); } while (0)
#define PG8_LDA(dst, b, h) do { _Pragma("unroll") for (int m = 0; m < 4; ++m) _Pragma("unroll") for (int k = 0; k < 2; ++k) dst[m][k] = *(const LAS bf16x8*)(lds + PG8_SA(b, h) + aoff + m * 2048 + k * 1024); } while (0)
#define PG8_LDB(dst, b, h) do { _Pragma("unroll") for (int n = 0; n < 2; ++n) _Pragma("unroll") for (int k = 0; k < 2; ++k) dst[n][k] = *(const LAS bf16x8*)(lds + PG8_SB(b, h) + boff + n * 2048 + k * 1024); } while (0)
#define PG8_MMA(ai, bj, At, Bt) do { __builtin_amdgcn_s_setprio(1); _Pragma("unroll") for (int m = 0; m < 4; ++m) _Pragma("unroll") for (int n = 0; n < 2; ++n) _Pragma("unroll") for (int k = 0; k < 2; ++k) \
        acc[ai][bj][m][n] = __builtin_amdgcn_mfma_f32_16x16x32_bf16(Bt[n][k], At[m][k], acc[ai][bj][m][n], 0, 0, 0); __builtin_amdgcn_s_setprio(0); } while (0)
#define PG8_WAIT_V(n) asm volatile("s_waitcnt vmcnt(" #n ")" ::: "memory")
#define PG8_WAIT_L(n) asm volatile("s_waitcnt lgkmcnt(" #n ")" ::: "memory")
#define PG8_BAR __builtin_amdgcn_s_barrier()
#define LBAR() do { asm volatile("s_waitcnt lgkmcnt(0)" ::: "memory"); __builtin_amdgcn_s_barrier(); asm volatile("" ::: "memory"); } while (0)
#define PG8_SCHED __builtin_amdgcn_sched_barrier(0)
    Unit cur, nxt; int ui = 0;
    if (!S.next(0, cur)) return;
    f32x4 acc[2][2][4][2];
#pragma unroll
    for (int a = 0; a < 2; ++a)
#pragma unroll
        for (int b = 0; b < 2; ++b)
#pragma unroll
            for (int m = 0; m < 4; ++m)
#pragma unroll
                for (int n = 0; n < 2; ++n) acc[a][b][m][n] = (f32x4){0.f, 0.f, 0.f, 0.f};
    bf16x8 At[4][2], B0[2][2], B1[2][2];
    const char* cA = PG8_ABASE(cur); const char* cB = (const char*)g.Bt + (size_t)cur.pn * tstepB;
    {
        const char* a0 = PG8_AP(cA, 0); const char* a1 = PG8_AP(cA, 1);
        PG8_STAGE(PG8_SB(0, 0), cB, voffB); PG8_STAGE(PG8_SB(0, 1), cB + hstepB, voffB); PG8_STAGE(PG8_SA(0, 0), a0, voffA); PG8_STAGE(PG8_SA(0, 1), a0 + hstepA, voffA);
        if (wr == 1) PG8_BAR;
        PG8_WAIT_V(2); PG8_BAR;
        PG8_STAGE(PG8_SB(1, 0), cB + kstep, voffB); PG8_STAGE(PG8_SA(1, 0), a1, voffA); PG8_STAGE(PG8_SB(1, 1), cB + hstepB + kstep, voffB);
        PG8_WAIT_V(6); PG8_BAR;
    }
    for (;;) {
        const bool has_next = S.next(ui + 1, nxt);
        const char* nA = has_next ? PG8_ABASE(nxt) : cA; const char* nB = has_next ? (const char*)g.Bt + (size_t)nxt.pn * tstepB : cB;
        for (int t = 0; t < nt; t += 2) {
            const bool last = (t == nt - 2);
            const char* a1 = PG8_AP(cA, t + 1);
            const char* a2 = last ? PG8_AP(nA, 0) : PG8_AP(cA, t + 2); const char* b2 = last ? nB : cB + (size_t)(t + 2) * kstep;
            const char* a3 = last ? PG8_AP(nA, 1) : PG8_AP(cA, t + 3); const char* b3 = b2 + kstep;
            PG8_LDB(B0, 0, 0); PG8_LDB(B1, 0, 1); PG8_SCHED; PG8_LDA(At, 0, 0); PG8_STAGE(PG8_SA(1, 1), a1 + hstepA, voffA);
            PG8_WAIT_V(8); PG8_WAIT_L(0); PG8_BAR; PG8_MMA(0, 0, At, B0); PG8_MMA(0, 1, At, B1); PG8_BAR; PG8_SCHED;
            PG8_LDA(At, 0, 1); PG8_STAGE(PG8_SB(0, 0), b2, voffB); PG8_STAGE(PG8_SB(0, 1), b2 + hstepB, voffB); PG8_STAGE(PG8_SA(0, 0), a2, voffA);
            PG8_WAIT_V(8); PG8_WAIT_L(0); PG8_BAR; PG8_MMA(1, 0, At, B0); PG8_MMA(1, 1, At, B1); PG8_BAR; PG8_SCHED;
            PG8_LDB(B0, 1, 0); PG8_LDB(B1, 1, 1); PG8_SCHED; PG8_LDA(At, 1, 0); PG8_STAGE(PG8_SA(0, 1), a2 + hstepA, voffA);
            PG8_WAIT_V(8); PG8_WAIT_L(0); PG8_BAR; PG8_MMA(0, 0, At, B0); PG8_MMA(0, 1, At, B1); PG8_BAR; PG8_SCHED;
            PG8_LDA(At, 1, 1); PG8_STAGE(PG8_SB(1, 0), b3, voffB); PG8_STAGE(PG8_SB(1, 1), b3 + hstepB, voffB); PG8_STAGE(PG8_SA(1, 0), a3, voffA);
            PG8_WAIT_V(8); PG8_WAIT_L(0); PG8_BAR; PG8_MMA(1, 0, At, B0); PG8_MMA(1, 1, At, B1); PG8_BAR; PG8_SCHED;
        }
        if constexpr (ALIGN_EPI) { if (wr == 0) PG8_BAR; }
        E(acc, cur, wr, wc, fr, fq);
        if (!has_next) break;
#pragma unroll
        for (int a = 0; a < 2; ++a)
#pragma unroll
            for (int b = 0; b < 2; ++b)
#pragma unroll
                for (int m = 0; m < 4; ++m)
#pragma unroll
                    for (int n = 0; n < 2; ++n) acc[a][b][m][n] = (f32x4){0.f, 0.f, 0.f, 0.f};
        cur = nxt; cA = nA; cB = nB; ++ui;
        if constexpr (ALIGN_EPI) { if (wr == 1) PG8_BAR; }
    }
    PG8_WAIT_V(0);
    if constexpr (!ALIGN_EPI) { if (wr == 0) PG8_BAR; }
    PG8_BAR;
#undef PG8_AP
#undef PG8_ABASE
#undef PG8_SA
#undef PG8_SB
#undef PG8_STAGE
#undef PG8_LDA
#undef PG8_LDB
#undef PG8_MMA
#undef PG8_WAIT_V
#undef PG8_WAIT_L
#undef PG8_BAR
#undef PG8_SCHED
}
}

template <class Fn>
__device__ __forceinline__ void epi_for(const f32x4 (&acc)[2][2][4][2], const pg8::Unit& u, int wr, int wc, int fr, int fq, Fn fn) {
#pragma unroll
    for (int ai = 0; ai < 2; ++ai)
#pragma unroll
        for (int m = 0; m < 4; ++m) { const int row = u.pm * 256 + ai * 128 + wr * 64 + m * 16 + fr;
#pragma unroll
            for (int bj = 0; bj < 2; ++bj) { const int col = u.pn * 256 + bj * 128 + wc * 32 + 8 * fq; fn(row, col, acc[ai][bj][m][0], acc[ai][bj][m][1]); }
            if (m & 1) asm volatile("" ::: "memory"); }
}
__device__ __forceinline__ u32x4 pack8(f32x4 v0, f32x4 v1) { u32x4 w; w.x = cvt_pk_bf16(v0[0], v0[1]); w.y = cvt_pk_bf16(v0[2], v0[3]); w.z = cvt_pk_bf16(v1[0], v1[1]); w.w = cvt_pk_bf16(v1[2], v1[3]); return w; }

struct EpiEvenIn {
    bf16_t* Z; const float* ssq; bf16_t* VTa; bf16_t* VTb; bf16_t* KT; LAS unsigned char* spare;
    template <class ValFn>
    __device__ __forceinline__ void tstore(bf16_t* dst, const pg8::Unit& u, int wr, int wc, int fr, int fq, ValFn val) const {
        asm volatile("" : "+v"(fr), "+v"(fq));
        LAS bf16_t* tl = (LAS bf16_t*)(spare + (wr * 4 + wc) * 4032); const int lane = fq * 16 + fr;
#pragma unroll
        for (int ai = 0; ai < 2; ++ai)
#pragma unroll
            for (int bj = 0; bj < 2; ++bj) {
                const int row0 = u.pm * 256 + ai * 128 + wr * 64, cg0 = (u.pn * 256 + bj * 128 + wc * 32) & 511, b = row0 >> 13, t0 = row0 & (SEQ - 1);
#pragma unroll
                for (int half = 0; half < 2; ++half) {
#pragma unroll
                    for (int mm = 0; mm < 2; ++mm) { float o[8]; val(ai, 2 * half + mm, bj, o);
#pragma unroll
                        for (int j = 0; j < 8; ++j) tl[(8 * fq + j) * 32 + 16 * mm + fr] = (bf16_t)f2bf(o[j]); }
                    asm volatile("s_waitcnt lgkmcnt(0)" ::: "memory");
#pragma unroll
                    for (int r = 0; r < 2; ++r) { const int c = lane + 64 * r, d = c >> 2, part = c & 3; const u32x4 w = *(const LAS u32x4*)(tl + d * 32 + part * 8);
                        *(u32x4*)(dst + ((size_t)(b * 512 + cg0 + d)) * SEQ + t0 + 32 * half + 8 * part) = w; }
                    asm volatile("s_waitcnt lgkmcnt(0)" ::: "memory");
                }
            }
    }
    __device__ __forceinline__ void operator()(const f32x4 (&acc)[2][2][4][2], const pg8::Unit& u, int wr, int wc, int fr, int fq) const {
        const int g = u.pn >> 1;
        if (g == 2 || g == 6) {
            tstore(g == 2 ? VTa : VTb, u, wr, wc, fr, fq, [&](int ai, int m, int bj, float (&o)[8]) {
                const int row = u.pm * 256 + ai * 128 + wr * 64 + m * 16 + fr; const float rs = rsqrtf(ssq_sum(ssq, row) * (1.f / D) + 1e-6f);
                const f32x4 v0 = acc[ai][bj][m][0] * rs, v1 = acc[ai][bj][m][1] * rs;
                o[0] = v0[0]; o[1] = v0[1]; o[2] = v0[2]; o[3] = v0[3]; o[4] = v1[0]; o[5] = v1[1]; o[6] = v1[2]; o[7] = v1[3]; });
            return;
        }
        if (g == 1) {
            tstore(KT, u, wr, wc, fr, fq, [&](int ai, int m, int bj, float (&o)[8]) {
                const int row = u.pm * 256 + ai * 128 + wr * 64 + m * 16 + fr, col = u.pn * 256 + bj * 128 + wc * 32 + 8 * fq; const float rs = rsqrtf(ssq_sum(ssq, row) * (1.f / D) + 1e-6f);
                const f32x4 v0 = acc[ai][bj][m][0] * rs, v1 = acc[ai][bj][m][1] * rs; const int cg = col & 511, t = row & (SEQ - 1);
                const float pos = (float)t; const int i0 = (cg & 127) >> 1;
                float q[8] = {v0[0], v0[1], v0[2], v0[3], v1[0], v1[1], v1[2], v1[3]};
                _Pragma("unroll") for (int j = 0; j < 4; ++j) { const float inv = exp2f(-(float)(i0 + j) * (13.287712379549449f / 64.f));
                    float rev = pos * inv * 0.15915494309189535f; rev = rev - floorf(rev); const float sn = __builtin_amdgcn_sinf(rev), cs = __builtin_amdgcn_cosf(rev);
                    const float x1 = q[2 * j], x2 = q[2 * j + 1]; q[2 * j] = x1 * cs - x2 * sn; q[2 * j + 1] = x1 * sn + x2 * cs; }
                const float lg2 = log2f(1.f - exp2f(-5.f - (float)(cg >> 7))); const float ip1 = (float)((t & 127) + 1);
                const float f = exp2f(-ip1 * lg2), f2 = exp2f((128.f - ip1) * lg2);
                *(u32x4*)(Z + (size_t)row * ZE + 512 + cg) = pack8((f32x4){q[0] * f, q[1] * f, q[2] * f, q[3] * f}, (f32x4){q[4] * f, q[5] * f, q[6] * f, q[7] * f});
                _Pragma("unroll") for (int j = 0; j < 8; ++j) o[j] = q[j] * f2; });
            return;
        }
        epi_for(acc, u, wr, wc, fr, fq, [&](int row, int col, f32x4 v0, f32x4 v1) {
            const float rs = rsqrtf(ssq_sum(ssq, row) * (1.f / D) + 1e-6f);
            v0 = v0 * rs; v1 = v1 * rs;
            const int cg = col & 511, t = row & (SEQ - 1);
            if (g == 0) {
                const float pos = (float)t; const int i0 = (cg & 127) >> 1;
                float o[8] = {v0[0], v0[1], v0[2], v0[3], v1[0], v1[1], v1[2], v1[3]};
                _Pragma("unroll") for (int j = 0; j < 4; ++j) { const float inv = exp2f(-(float)(i0 + j) * (13.287712379549449f / 64.f));
                    float rev = pos * inv * 0.15915494309189535f; rev = rev - floorf(rev); const float sn = __builtin_amdgcn_sinf(rev), cs = __builtin_amdgcn_cosf(rev);
                    const float x1 = o[2 * j], x2 = o[2 * j + 1]; o[2 * j] = x1 * cs - x2 * sn; o[2 * j + 1] = x1 * sn + x2 * cs; }
                const float lg2 = log2f(1.f - exp2f(-5.f - (float)(cg >> 7))); const float ip1 = (float)((t & 127) + 1); const float f = exp2f(ip1 * lg2);
                *(u32x4*)(Z + (size_t)row * ZE + cg) = pack8((f32x4){o[0] * f, o[1] * f, o[2] * f, o[3] * f}, (f32x4){o[4] * f, o[5] * f, o[6] * f, o[7] * f});
            } else {
                const int zc = (g - 1 - (g > 6 ? 1 : 0)) * 512;
                *(u32x4*)(Z + (size_t)row * ZE + zc + cg) = pack8(v0, v1);
            }
        });
    }
};
struct EpiOddIn {
    bf16_t* Z; bf16_t* L1;
    __device__ __forceinline__ void operator()(const f32x4 (&acc)[2][2][4][2], const pg8::Unit& u, int wr, int wc, int fr, int fq) const {
        if (u.pn < 16) { epi_for(acc, u, wr, wc, fr, fq, [&](int row, int col, f32x4 v0, f32x4 v1) { *(u32x4*)(Z + (size_t)row * ZW + col) = pack8(v0, v1); }); }
        else { epi_for(acc, u, wr, wc, fr, fq, [&](int row, int col, f32x4 v0, f32x4 v1) { const int c = col - 4096; if (c < 64) {
                    _Pragma("unroll") for (int j = 0; j < 4; ++j) { v0[j] = tanhf(v0[j]); v1[j] = tanhf(v1[j]); } }
                *(u32x4*)(L1 + (size_t)row * 256 + c) = pack8(v0, v1); }); }
    }
};
__device__ __forceinline__ void unpack8(const u32x4 w, f32x4& a, f32x4& b) {
    a = (f32x4){__uint_as_float(w.x << 16), __uint_as_float(w.x & 0xffff0000u), __uint_as_float(w.y << 16), __uint_as_float(w.y & 0xffff0000u)};
    b = (f32x4){__uint_as_float(w.z << 16), __uint_as_float(w.z & 0xffff0000u), __uint_as_float(w.w << 16), __uint_as_float(w.w & 0xffff0000u)}; }
struct EpiResid {
    const bf16_t* Ha; bf16_t* HB; int ldb;
    __device__ __forceinline__ void operator()(const f32x4 (&acc)[2][2][4][2], const pg8::Unit& u, int wr, int wc, int fr, int fq) const {
        epi_for(acc, u, wr, wc, fr, fq, [&](int row, int col, f32x4 v0, f32x4 v1) { f32x4 h0, h1; unpack8(*(const u32x4*)(Ha + (size_t)row * D + col), h0, h1); h0 = h0 + v0; h1 = h1 + v1;
            *(u32x4*)(HB + (size_t)row * ldb + col) = pack8(h0, h1); });
    }
};
struct EpiStore {
    bf16_t* O; int ldc;
    __device__ __forceinline__ void operator()(const f32x4 (&acc)[2][2][4][2], const pg8::Unit& u, int wr, int wc, int fr, int fq) const {
        epi_for(acc, u, wr, wc, fr, fq, [&](int row, int col, f32x4 v0, f32x4 v1) { *(u32x4*)(O + (size_t)row * ldc + col) = pack8(v0, v1); });
    }
};
struct EpiGate {
    const bf16_t* Hb; int ldh; const bf16_t* PP; int ldp; bf16_t* Ha; float* ssq;
    __device__ __forceinline__ void operator()(const f32x4 (&acc)[2][2][4][2], const pg8::Unit& u, int wr, int wc, int fr, int fq) const {
#pragma unroll
        for (int ai = 0; ai < 2; ++ai)
#pragma unroll
            for (int m = 0; m < 4; ++m) { const int row = u.pm * 256 + ai * 128 + wr * 64 + m * 16 + fr; float sq = 0.f;
#pragma unroll
                for (int bj = 0; bj < 2; ++bj) { const int col = u.pn * 256 + bj * 128 + wc * 32 + 8 * fq; const f32x4 v0 = acc[ai][bj][m][0], v1 = acc[ai][bj][m][1];
                    f32x4 h0, h1, p0, p1; unpack8(*(const u32x4*)(Hb + (size_t)row * ldh + col), h0, h1); unpack8(*(const u32x4*)(PP + (size_t)row * ldp + col), p0, p1);
#pragma unroll
                    for (int j = 0; j < 4; ++j) { h0[j] += sigmoidf_(v0[j]) * p0[j]; h1[j] += sigmoidf_(v1[j]) * p1[j]; sq += h0[j] * h0[j] + h1[j] * h1[j]; }
                    *(u32x4*)(Ha + (size_t)row * D + col) = pack8(h0, h1); }
                sq += __shfl_xor(sq, 16); sq += __shfl_xor(sq, 32);
                if (fq == 0) ssq[(size_t)row * 16 + u.pn * 4 + wc] = sq;
                if (m & 1) asm volatile("" ::: "memory"); }
    }
};

#define XB_TMO      128
#define XB_XCNT(j)  (256  + 64 * (j))
#define XB_XSUB(j)  (1280 + 64 * (j))
#define XB_XGEN(j)  (2304 + 64 * (j))
#define XB_TOP      3328
#define XB_TOPGEN   3392
#define XCD_BAR_WORDS 3456
#define XB_SPIN_CAP (1u << 22)
__device__ __forceinline__ unsigned xb_ld(unsigned* p)              { return __hip_atomic_load(p, __ATOMIC_RELAXED, __HIP_MEMORY_SCOPE_AGENT); }
__device__ __forceinline__ unsigned xb_add(unsigned* p, unsigned v) { return __hip_atomic_fetch_add(p, v, __ATOMIC_RELAXED, __HIP_MEMORY_SCOPE_AGENT); }
__device__ __forceinline__ unsigned xb_xcc_id() { return (unsigned)__builtin_amdgcn_s_getreg((3 << 11) | 20) & 0xFu; }
#define XB_SPIN(cond, bar) do { unsigned _sp = 0; while (cond) { __builtin_amdgcn_s_sleep(1); \
    if ((++_sp & 255u) == 0u) { if (xb_ld(&(bar)[XB_TMO])) break; if (_sp > XB_SPIN_CAP) { atomicAdd(&(bar)[XB_TMO], 1u); break; } } } } while (0)
struct XcdBarrier { unsigned* bar; unsigned x; volatile LAS unsigned* st; };
__device__ __forceinline__ XcdBarrier xcd_barrier_post(unsigned* bar, volatile LAS unsigned* st) {
    XcdBarrier b; b.bar = bar; b.x = xb_xcc_id(); b.st = st;
    if (threadIdx.x == 0) (void)xb_add(&bar[XB_XCNT(b.x)], 1u);
    return b;
}
__device__ __forceinline__ void xcd_barrier_complete(unsigned* bar, unsigned x, unsigned& nloc, unsigned& nx) {
    const unsigned G = gridDim.x * gridDim.y * gridDim.z;
    unsigned sum, cnt, mine, sp = 0u;
    for (;;) {
        sum = 0u; cnt = 0u; mine = 0u;
#pragma unroll
        for (unsigned j = 0; j < 16; ++j) { const unsigned c = xb_ld(&bar[XB_XCNT(j)]); sum += c; cnt += (c > 0u) ? 1u : 0u; mine = (j == x) ? c : mine; }
        if (sum == G) break;
        __builtin_amdgcn_s_sleep(1);
        if ((++sp & 255u) == 0u) { if (xb_ld(&bar[XB_TMO])) break; if (sp > XB_SPIN_CAP) { atomicAdd(&bar[XB_TMO], 1u); break; } }
    }
    nloc = mine > 0u ? mine : 1u; nx = cnt > 0u ? cnt : 1u;
}
__device__ __forceinline__ void xcd_barrier(const XcdBarrier& b_in) {
    asm volatile("s_waitcnt vmcnt(0)" ::: "memory");
    __syncthreads();
    if (threadIdx.x == 0) {
        const XcdBarrier& b = b_in;
        unsigned* bar = b.bar;
        __builtin_amdgcn_s_waitcnt(0);
        unsigned nloc = b.st[0], nx = b.st[1];
        if (nloc == 0u) { xcd_barrier_complete(bar, b.x, nloc, nx); b.st[0] = nloc; b.st[1] = nx; }
        const unsigned old = xb_add(&bar[XB_XSUB(b.x)], 1u);
        const unsigned gen = old / nloc;
        if (old + 1u == (gen + 1u) * nloc) {
            __builtin_amdgcn_fence(__ATOMIC_RELEASE, "agent");
            asm volatile("s_waitcnt vmcnt(0)" ::: "memory");
            const unsigned og = xb_add(&bar[XB_TOP], 1u);
            const unsigned tg = og / nx;
            if (og + 1u == (tg + 1u) * nx) xb_add(&bar[XB_TOPGEN], 1u);
            else XB_SPIN(xb_ld(&bar[XB_TOPGEN]) == tg, bar);
            __builtin_amdgcn_fence(__ATOMIC_ACQUIRE, "agent");
            xb_add(&bar[XB_XGEN(b.x)], 1u);
            asm volatile("s_waitcnt vmcnt(0)" ::: "memory");
        } else {
            XB_SPIN(xb_ld(&bar[XB_XGEN(b.x)]) == gen, bar);
            __builtin_amdgcn_fence(__ATOMIC_ACQUIRE, "agent");
            asm volatile("s_waitcnt vmcnt(0)" ::: "memory");
        }
    }
    __syncthreads();
}

constexpr size_t MiB = 1u << 20;
constexpr size_t WS_CTL = 0, CTL_BYTES = 1 * MiB;
constexpr size_t WS_SSQ = 241 * (size_t)(1u << 20);
constexpr size_t WS_WIN = 2 * MiB;
constexpr size_t WS_WOUT = 19 * MiB, WS_WGATE = 21 * MiB, WS_WPROJ = 23 * MiB;
constexpr size_t WS_PB = 24 * MiB;
constexpr size_t WS_Z = 32 * MiB;
constexpr size_t WS_HB = 160 * MiB;
constexpr size_t WS_VF = 193 * MiB;
constexpr size_t WS_L1 = 225 * MiB;
constexpr size_t WS_VTA = 128 * MiB;
constexpr size_t WS_VTB = 144 * MiB;
constexpr size_t WS_KT = 225 * MiB;
constexpr size_t WS_LORA2 = 23 * MiB + 512 * 1024;
constexpr size_t WS_PG = 160 * MiB;
constexpr size_t WS_SB = 2 * MiB;
constexpr size_t WS_BON = 233 * MiB;
constexpr size_t WS_ST = 176 * MiB;
constexpr size_t WS_KV = 160 * MiB;
constexpr size_t WS_END = 256 * MiB;

constexpr int RING_BYTES = 131072, LDS_BYTES = 163840, MISC_OFF = LDS_BYTES - 512;

struct Args { const float* in[26]; float* out; unsigned char* ws; int ph_lo, ph_hi; };

__device__ __forceinline__ const float* inptr(int i) { asm volatile("" : "+s"(i)); const char* ka = (const char*)__builtin_amdgcn_kernarg_segment_ptr(); return *(const float* const*)(ka + 8 * i); }
struct InTab { __device__ __forceinline__ const float* operator[](int i) const { return inptr(i); } };
struct Frame {
    LAS unsigned char* lds; unsigned char* ldsg;
    int tid, lane, wave, G, vcu;
    InTab in; float* H; unsigned char* ws;
    __device__ __forceinline__ void retid() { int l; asm volatile("v_mbcnt_lo_u32_b32 %0, -1, 0\n\tv_mbcnt_hi_u32_b32 %0, -1, %0" : "=v"(l)); lane = l; tid = wave * 64 + l; }
    __device__ __forceinline__ float* ssq(int l) const { return (float*)(ws + WS_SSQ) + (size_t)l * T * 16; }
};

__device__ __forceinline__ void conv_item(const float* W, int ldw, int Kmax, int k0, int n0, bf16_t* dst, int ldd, int dr0, int drs, int dk0,
                                          const float* svec, float sa, float sb, float sc, LAS float* scr, int lane) {
    float wv[32];
#pragma unroll
    for (int i = 0; i < 32; ++i) { const int k = k0 + 2 * i + (lane >> 5); wv[i] = (k < Kmax) ? W[(size_t)k * ldw + n0 + (lane & 31)] : 0.f; }
#pragma unroll
    for (int i = 0; i < 32; ++i) { const int kk = 2 * i + (lane >> 5), k = k0 + kk; const float f = (k < Kmax) ? (sa + sb * (svec ? svec[k] : 0.f)) * sc : 0.f;
        scr[kk * 33 + (lane & 31)] = wv[i] * f; }
    LDS_WAIT(); asm volatile("" ::: "memory");
    const int c = lane & 7;
    if (k0 + 8 * c < Kmax) {
#pragma unroll
        for (int j = 0; j < 4; ++j) { const int n = (lane >> 3) + 8 * j; const LAS float* s = scr + (8 * c) * 33 + n;
            u32x4 o; o.x = pk2(s[0 * 33], s[1 * 33]); o.y = pk2(s[2 * 33], s[3 * 33]); o.z = pk2(s[4 * 33], s[5 * 33]); o.w = pk2(s[6 * 33], s[7 * 33]);
            *(GAS u32x4*)(dst + (size_t)(dr0 + n * drs) * ldd + dk0 + k0 + 8 * c) = o; }
    }
    LDS_WAIT(); asm volatile("" ::: "memory");
}
__device__ __forceinline__ void conv_item2(const float* W, int ldw, int k0, int n0, bf16_t* dst, int dr0, const float* mu, float sc, LAS float* scr, int lane) {
    float wv[32];
#pragma unroll
    for (int i = 0; i < 32; ++i) wv[i] = W[(size_t)(k0 + 2 * i + (lane >> 5)) * ldw + n0 + (lane & 31)];
#pragma unroll
    for (int half = 0; half < 2; ++half) {
#pragma unroll
        for (int i = 0; i < 32; ++i) { const int kk = 2 * i + (lane >> 5); const float m = mu[k0 + kk]; scr[kk * 33 + (lane & 31)] = wv[i] * ((half ? m : 1.f - m) * sc); }
        LDS_WAIT(); asm volatile("" ::: "memory");
        const int c = lane & 7;
#pragma unroll
        for (int j = 0; j < 4; ++j) { const int n = (lane >> 3) + 8 * j; const LAS float* s_ = scr + (8 * c) * 33 + n;
            u32x4 o; o.x = pk2(s_[0 * 33], s_[1 * 33]); o.y = pk2(s_[2 * 33], s_[3 * 33]); o.z = pk2(s_[4 * 33], s_[5 * 33]); o.w = pk2(s_[6 * 33], s_[7 * 33]);
            *(GAS u32x4*)(dst + (size_t)(dr0 + n) * 2048 + half * 1024 + k0 + 8 * c) = o; }
        LDS_WAIT(); asm volatile("" ::: "memory");
    }
}
__device__ __forceinline__ void conv_win_even(Frame& F, int li) {
    const int e = li >> 1; const float* W = F.in[6] + (size_t)e * D * ZW; const float* gain = F.in[2] + li * D; bf16_t* dst = (bf16_t*)(F.ws + WS_WIN);
    LAS float* scr = (LAS float*)(F.lds + F.wave * 16384);
    const int gw = F.vcu * 8 + F.wave, NGW = F.G * 8;
    for (int it = gw; it < 16 * 128; it += NGW) { const int kb = it >> 7, nb = it & 127, n0 = nb * 32, g = n0 >> 9, hh = (n0 & 511) >> 7, d0 = n0 & 127;
        int dr0 = n0, drs = 1; if (g < 2) { dr0 = g * 512 + hh * 128 + (d0 < 64 ? 2 * d0 : 2 * (d0 - 64) + 1); drs = 2; }
        const float sc = (g == 1 || g == 5) ? QK_SCALE : 1.f;
        conv_item(W, ZW, D, kb * 64, n0, dst, D, dr0, drs, 0, gain, 0.f, 1.f, sc, scr, F.lane); }
}
__device__ __forceinline__ void conv_win_odd(Frame& F, int li) {
    const int o = li >> 1; const float* mu = F.in[9] + (size_t)o * 6 * D; bf16_t* dst = (bf16_t*)(F.ws + WS_WIN);
    LAS float* scr = (LAS float*)(F.lds + F.wave * 16384);
    const int gw = F.vcu * 8 + F.wave, NGW = F.G * 8;
    for (int it = gw; it < 4 * 512; it += NGW) { const int p = it >> 9, r = it & 511, kb = r >> 5, nb = r & 31;
        conv_item2(F.in[10] + ((size_t)o * 4 + p) * D * D, D, kb * 64, nb * 32, dst, p * 1024 + nb * 32, mu + p * D, 1.f, scr, F.lane); }
    for (int it = gw; it < 32 + 32 + 16; it += NGW) { const float* W; int ldw, n0, dr0, mi, kb; const int r = it;
        if (r < 32) { W = F.in[13] + (size_t)o * D * 64; ldw = 64; kb = r >> 1; n0 = (r & 1) * 32; dr0 = 4096 + n0; mi = 4; }
        else if (r < 64) { const int q = r - 32; W = F.in[16] + (size_t)o * D * 64; ldw = 64; kb = q >> 1; n0 = (q & 1) * 32; dr0 = 4160 + n0; mi = 5; }
        else { const int q = r - 64; W = F.in[19]; ldw = 32; kb = q; n0 = 0; dr0 = 4224; mi = 2; }
        conv_item2(W, ldw, kb * 64, n0, dst, dr0, mu + mi * D, (r >= 64 && o == 0) ? 0.f : 1.f, scr, F.lane); }
    { u32x4 z = {0u, 0u, 0u, 0u}; GAS u32x4* zp = (GAS u32x4*)(dst + (size_t)4256 * 2048); const int n16 = 96 * 2048 * 2 / 16;
      for (int i = (F.vcu * 512 + F.tid); i < n16; i += F.G * 512) zp[i] = z; }
}
__device__ __forceinline__ void conv_wrest_a(Frame& F, int li) {
    const float* Wp = F.in[4] + (size_t)li * PLE * D;
    LAS float* scr = (LAS float*)(F.lds + F.wave * 16384);
    const int gw = F.vcu * 8 + F.wave, NGW = F.G * 8;
    for (int r = gw; r < 128; r += NGW) conv_item(Wp, D, PLE, (r >> 5) * 64, (r & 31) * 32, (bf16_t*)(F.ws + WS_WPROJ), PLE, (r & 31) * 32, 1, 0, nullptr, 1.f, 0.f, 1.f, scr, F.lane);
    const float* P = F.in[1] + (size_t)li * T * PLE; GAS u32x4* pb = (GAS u32x4*)(F.ws + WS_PB); const int n8 = T * PLE / 8;
    for (int i = F.vcu * 512 + F.tid; i < n8; i += F.G * 512) { const f32x4 a = *(const f32x4*)(P + (size_t)i * 8), b = *(const f32x4*)(P + (size_t)i * 8 + 4);
        u32x4 o; o.x = pk2(a[0], a[1]); o.y = pk2(a[2], a[3]); o.z = pk2(b[0], b[1]); o.w = pk2(b[2], b[3]); pb[i] = o; }
}
__device__ __forceinline__ void conv_wrest_b(Frame& F, int li, int widx, int nw) {
    const bool even = (li & 1) == 0; const int e = li >> 1;
    const float* Wo = even ? F.in[7] + (size_t)e * D * D : F.in[11] + (size_t)e * D * D; const float* Wg = F.in[5] + (size_t)li * D * D;
    LAS float* scr = (LAS float*)(F.lds + F.wave * 16384);
    for (int it = widx * 8 + F.wave; it < 1024; it += nw * 8) {
        if (it < 512) conv_item(Wo, D, D, (it >> 5) * 64, (it & 31) * 32, (bf16_t*)(F.ws + WS_WOUT), D, (it & 31) * 32, 1, 0, nullptr, 1.f, 0.f, 1.f, scr, F.lane);
        else { const int r = it - 512; conv_item(Wg, D, D, (r >> 5) * 64, (r & 31) * 32, (bf16_t*)(F.ws + WS_WGATE), D, (r & 31) * 32, 1, 0, nullptr, 1.f, 0.f, 1.f, scr, F.lane); }
    }
}
__device__ __forceinline__ void conv_lora2(Frame& F, int li) {
    const int o = li >> 1; LAS float* scr = (LAS float*)(F.lds + F.wave * 16384);
    bf16_t* W2T = (bf16_t*)(F.ws + WS_LORA2); bf16_t* A2T = W2T + 1024 * 64; bf16_t* V2T = A2T + 1024 * 64;
    const int gw = F.vcu * 8 + F.wave, NGW = F.G * 8;
    for (int it = gw; it < 96; it += NGW) {
        if (it < 32) conv_item(F.in[14] + (size_t)o * 64 * D, D, 64, 0, it * 32, W2T, 64, it * 32, 1, 0, nullptr, 1.f, 0.f, 1.f, scr, F.lane);
        else if (it < 64) conv_item(F.in[17] + (size_t)o * 64 * D, D, 64, 0, (it - 32) * 32, A2T, 64, (it - 32) * 32, 1, 0, nullptr, 1.f, 0.f, 1.f, scr, F.lane);
        else conv_item(F.in[20], D, 32, 0, (it - 64) * 32, V2T, 32, (it - 64) * 32, 1, 0, nullptr, 1.f, 0.f, 1.f, scr, F.lane);
    }
}
__device__ __forceinline__ void rows_p0(Frame& F) {
    const float* x = F.in[0]; bf16_t* HB = (bf16_t*)(F.ws + WS_HB); float* s0 = F.ssq(0);
    for (int row = F.vcu * 8 + F.wave; row < T; row += F.G * 8) {
        const f32x4* xr = (const f32x4*)(x + (size_t)row * D) + F.lane; u32x2* br = (u32x2*)(HB + (size_t)row * D) + F.lane; float s = 0.f;
#pragma unroll
        for (int j = 0; j < 4; ++j) { const f32x4 v = xr[64 * j]; s += (v[0] * v[0] + v[1] * v[1]) + (v[2] * v[2] + v[3] * v[3]); u32x2 w; w.x = pk2(v[0], v[1]); w.y = pk2(v[2], v[3]); br[64 * j] = w; }
        s = wave_sum(s); if (F.lane < 16) s0[(size_t)row * 16 + F.lane] = F.lane == 0 ? s : 0.f;
    }
}
__device__ __forceinline__ void rows_norm(Frame& F, int li) {
    const float* gain = F.in[2] + li * D; bf16_t* HN = (bf16_t*)(F.H); const bf16_t* Ha = (const bf16_t*)(F.ws + WS_HB); const float* sq = F.ssq(li);
    f32x4 g[4];
#pragma unroll
    for (int j = 0; j < 4; ++j) g[j] = *((const f32x4*)gain + F.lane + 64 * j);
    for (int row = F.vcu * 8 + F.wave; row < T; row += F.G * 8) {
        const u32x2* hr = (const u32x2*)(Ha + (size_t)row * D) + F.lane; u32x2* br = (u32x2*)(HN + (size_t)(row + 1 + (row >= SEQ ? 1 : 0)) * D) + F.lane;
        const float rs = rsqrtf(ssq_sum(sq, row) * (1.f / D) + 1e-6f);
#pragma unroll
        for (int j = 0; j < 4; ++j) { const u32x2 hw = hr[64 * j]; const f32x4 h4 = {__uint_as_float(hw.x << 16), __uint_as_float(hw.x & 0xffff0000u), __uint_as_float(hw.y << 16), __uint_as_float(hw.y & 0xffff0000u)};
            const f32x4 v = h4 * rs * g[j]; u32x2 w; w.x = pk2(v[0], v[1]); w.y = pk2(v[2], v[3]); br[64 * j] = w; }
    }
    if (F.vcu == 0 && F.wave < 2) { u32x2* br = (u32x2*)(HN + (size_t)(F.wave ? SEQ + 1 : 0) * D) + F.lane; u32x2 z = {0u, 0u};
#pragma unroll
        for (int j = 0; j < 4; ++j) br[64 * j] = z; }
}
__device__ __forceinline__ void rows_final(Frame& F) {
    const float* gain = F.in[3]; const float* sq = F.ssq(4); const bf16_t* Ha = (const bf16_t*)(F.ws + WS_HB);
    f32x4 g[4];
#pragma unroll
    for (int j = 0; j < 4; ++j) g[j] = *((const f32x4*)gain + F.lane + 64 * j);
    for (int row = F.vcu * 8 + F.wave; row < T; row += F.G * 8) {
        const u32x2* hr = (const u32x2*)(Ha + (size_t)row * D) + F.lane; f32x4* orow = (f32x4*)(F.H + (size_t)row * D) + F.lane; const float rs = rsqrtf(ssq_sum(sq, row) * (1.f / D) + 1e-6f);
#pragma unroll
        for (int j = 0; j < 4; ++j) { const u32x2 hw = hr[64 * j]; const f32x4 h4 = {__uint_as_float(hw.x << 16), __uint_as_float(hw.x & 0xffff0000u), __uint_as_float(hw.y << 16), __uint_as_float(hw.y & 0xffff0000u)};
            orow[64 * j] = h4 * rs * g[j]; }
    }
}

typedef float f32x16 __attribute__((ext_vector_type(16)));
template <bool DUMMY>
__device__ __forceinline__ void sb_unit(Frame& F, int bh, int qb) {
    const int lane = F.lane, l31 = lane & 31, hi = lane >> 5, b = bh >> 2, h = bh & 3;
    bf16_t* Z = (bf16_t*)(F.ws + WS_Z); const bf16_t* VT = (const bf16_t*)(F.ws + WS_VTB) + (size_t)bh * 128 * SEQ;
    const size_t rowb = (size_t)b * SEQ; const int q0 = qb * 32, tq = q0 + l31;
    bf16x8 qr[8];
    { const bf16_t* qp = Z + (rowb + tq) * ZE + 1536 + h * 128 + hi * 8;
#pragma unroll
      for (int ks = 0; ks < 8; ++ks) qr[ks] = *(const bf16x8*)(qp + 16 * ks); }
    f32x16 o[4];
#pragma unroll
    for (int d = 0; d < 4; ++d)
#pragma unroll
        for (int r = 0; r < 16; ++r) o[d][r] = 0.f;
    float carry = 1.f;
    const int pi = 16 * ((l31 >> 2) & 1) + (l31 & 3) + 4 * (l31 >> 3);
    const bf16_t* Kb = Z + rowb * ZE + 2048 + h * 128 + hi * 8;
    for (int kt = (q0 + 31) >> 6; kt >= 0; --kt) {
        const int kbase = kt * 64;
        const bf16_t* kp0 = Kb + (size_t)(kbase + pi) * ZE; const bf16_t* kp1 = kp0 + (size_t)32 * ZE;
        f32x16 p0, p1;
#pragma unroll
        for (int r = 0; r < 16; ++r) { p0[r] = 0.f; p1[r] = 0.f; }
#pragma unroll
        for (int ks = 0; ks < 8; ++ks) { const bf16x8 a0 = *(const bf16x8*)(kp0 + 16 * ks), a1 = *(const bf16x8*)(kp1 + 16 * ks);
            p0 = __builtin_amdgcn_mfma_f32_32x32x16_bf16(a0, qr[ks], p0, 0, 0, 0); p1 = __builtin_amdgcn_mfma_f32_32x32x16_bf16(a1, qr[ks], p1, 0, 0, 0); }
        float f1 = 1.f, f0 = 1.f;
        const int k1 = kbase + 32 + 16 * hi, k0 = kbase + 16 * hi;
#pragma unroll
        for (int r = 15; r >= 0; --r) { const float z = fminf(p1[r], 80.f); const float e = exp2f(z * 1.4426950408889634f); float rd = __builtin_amdgcn_rcpf(1.f + e); float be = e * rd;
            const bool valid = (k1 + r) < tq; be = valid ? be : 0.f; rd = valid ? rd : 1.f; p1[r] = be * f1; f1 *= rd; }
#pragma unroll
        for (int r = 15; r >= 0; --r) { const float z = fminf(p0[r], 80.f); const float e = exp2f(z * 1.4426950408889634f); float rd = __builtin_amdgcn_rcpf(1.f + e); float be = e * rd;
            const bool valid = (k0 + r) < tq; be = valid ? be : 0.f; rd = valid ? rd : 1.f; p0[r] = be * f0; f0 *= rd; }
        const float pf0 = __shfl_xor(f0, 32), pf1 = __shfl_xor(f1, 32);
        const float tail1 = hi ? 1.f : pf1;
        const float tail0 = hi ? (pf1 * f1) : (pf0 * f1 * pf1);
        const float s1 = tail1 * carry, s0 = tail0 * carry;
        carry *= (f0 * f1) * (pf0 * pf1);
        u32x4 pa[2][2];
#pragma unroll
        for (int s = 0; s < 2; ++s) {
            pa[0][s].x = cvt_pk_bf16(p0[8 * s + 0] * s0, p0[8 * s + 1] * s0); pa[0][s].y = cvt_pk_bf16(p0[8 * s + 2] * s0, p0[8 * s + 3] * s0);
            pa[0][s].z = cvt_pk_bf16(p0[8 * s + 4] * s0, p0[8 * s + 5] * s0); pa[0][s].w = cvt_pk_bf16(p0[8 * s + 6] * s0, p0[8 * s + 7] * s0);
            pa[1][s].x = cvt_pk_bf16(p1[8 * s + 0] * s1, p1[8 * s + 1] * s1); pa[1][s].y = cvt_pk_bf16(p1[8 * s + 2] * s1, p1[8 * s + 3] * s1);
            pa[1][s].z = cvt_pk_bf16(p1[8 * s + 4] * s1, p1[8 * s + 5] * s1); pa[1][s].w = cvt_pk_bf16(p1[8 * s + 6] * s1, p1[8 * s + 7] * s1);
        }
        const bf16_t* vp = VT + (size_t)l31 * SEQ + kbase + 16 * hi;
#pragma unroll
        for (int d = 0; d < 4; ++d)
#pragma unroll
            for (int blk = 0; blk < 2; ++blk)
#pragma unroll
                for (int s = 0; s < 2; ++s) { const bf16x8 vb = *(const bf16x8*)(vp + (size_t)(32 * d) * SEQ + 32 * blk + 8 * s);
                    o[d] = __builtin_amdgcn_mfma_f32_32x32x16_bf16(__builtin_bit_cast(bf16x8, pa[blk][s]), vb, o[d], 0, 0, 0); }
        if (__all(carry < 7.9e-31f)) break;
    }
#pragma unroll
    for (int r = 0; r < 16; ++r) { const int qrow = q0 + (r & 3) + 8 * (r >> 2) + 4 * hi; bf16_t* gp = Z + (rowb + qrow) * ZE + 2560 + h * 128 + l31;
#pragma unroll
        for (int d = 0; d < 4; ++d) { const float g = bf2f(gp[32 * d]); const float ov = o[d][r] * siluf_(g); if (!DUMMY) gp[32 * d] = (bf16_t)f2bf(ov); else asm volatile("" :: "v"(ov)); } }
}
__device__ __forceinline__ void ret_stage_a(Frame& F, int u) {
    const int l31 = F.lane & 31, hi = F.lane >> 5, cu = u >> 3, w8 = u & 7, bh = cu & 7, n = cu >> 3, dvb = w8 >> 1, dkp = w8 & 1;
    const bf16_t* vt = (const bf16_t*)(F.ws + WS_VTA) + ((size_t)(bh * 128 + 32 * dvb + l31)) * SEQ + n * 128 + 8 * hi;
    const bf16_t* kt = (const bf16_t*)(F.ws + WS_KT) + ((size_t)(bh * 128 + 64 * dkp + l31)) * SEQ + n * 128 + 8 * hi;
    f32x16 a0, a1;
#pragma unroll
    for (int r = 0; r < 16; ++r) { a0[r] = 0.f; a1[r] = 0.f; }
#pragma unroll
    for (int ks = 0; ks < 8; ++ks) { const bf16x8 va = *(const bf16x8*)(vt + 16 * ks), k0 = *(const bf16x8*)(kt + 16 * ks), k1 = *(const bf16x8*)(kt + (size_t)32 * SEQ + 16 * ks);
        a0 = __builtin_amdgcn_mfma_f32_32x32x16_bf16(va, k0, a0, 0, 0, 0); a1 = __builtin_amdgcn_mfma_f32_32x32x16_bf16(va, k1, a1, 0, 0, 0); }
    bf16_t* kv = (bf16_t*)(F.H) + ((size_t)cu * 128 + 32 * dvb) * 128 + 64 * dkp + l31;
#pragma unroll
    for (int r = 0; r < 16; ++r) { const int dv = (r & 3) + 8 * (r >> 2) + 4 * hi; kv[dv * 128] = (bf16_t)f2bf(a0[r]); kv[dv * 128 + 32] = (bf16_t)f2bf(a1[r]); }
}
__device__ __forceinline__ void ret_stage_b(Frame& F) {
    const int e = F.vcu * 512 + F.tid; if (e >= 8 * 128 * 128) return;
    const int h = (e >> 14) & 3; const float g128 = exp2f(128.f * log2f(1.f - exp2f(-5.f - (float)h)));
    const bf16_t* p = (const bf16_t*)(F.H) + e; bf16_t* q = (bf16_t*)(F.H) + (size_t)8 * 1024 * 1024 + e; float S = 0.f;
#pragma unroll 4
    for (int n = 0; n < 64; ++n) { const float kv = bf2f(p[(size_t)n * 131072]); q[(size_t)n * 131072] = (bf16_t)f2bf(S); S = S * g128 + kv; }
}
template <bool DUMMY>
__device__ __forceinline__ void ret_stage_c(Frame& F, int u, const float* gng) {
    const int lane = F.lane, l31 = lane & 31, hi = lane >> 5, cu = u >> 2, qblk = u & 3, bh = cu & 7, n = cu >> 3, b = bh >> 2, h = bh & 3;
    bf16_t* Z = (bf16_t*)(F.ws + WS_Z); const size_t rowb = (size_t)b * SEQ; const int t0 = n * 128, tq = t0 + 32 * qblk + l31;
    bf16x8 qr[8];
    { const bf16_t* qp = Z + (rowb + tq) * ZE + h * 128 + hi * 8;
#pragma unroll
      for (int ks = 0; ks < 8; ++ks) qr[ks] = *(const bf16x8*)(qp + 16 * ks); }
    f32x16 o[4];
#pragma unroll
    for (int d = 0; d < 4; ++d)
#pragma unroll
        for (int r = 0; r < 16; ++r) o[d][r] = 0.f;
    { const bf16_t* sp = (const bf16_t*)(F.H) + (size_t)8 * 1024 * 1024 + ((size_t)cu * 128 + l31) * 128 + 8 * hi;
#pragma unroll
      for (int ks = 0; ks < 8; ++ks)
#pragma unroll
          for (int d = 0; d < 4; ++d) { const bf16x8 sb = *(const bf16x8*)(sp + (size_t)(32 * d) * 128 + 16 * ks); o[d] = __builtin_amdgcn_mfma_f32_32x32x16_bf16(qr[ks], sb, o[d], 0, 0, 0); } }
    const int pi = 16 * ((l31 >> 2) & 1) + (l31 & 3) + 4 * (l31 >> 3);
    const bf16_t* Kb = Z + rowb * ZE + 512 + h * 128 + hi * 8;
    const bf16_t* VT = (const bf16_t*)(F.ws + WS_VTA) + ((size_t)(bh * 128 + l31)) * SEQ + 16 * hi;
    for (int kb = 0; kb <= qblk; ++kb) {
        const int kbase = t0 + 32 * kb; const bf16_t* kp = Kb + (size_t)(kbase + pi) * ZE;
        f32x16 p;
#pragma unroll
        for (int r = 0; r < 16; ++r) p[r] = 0.f;
#pragma unroll
        for (int ks = 0; ks < 8; ++ks) { const bf16x8 a = *(const bf16x8*)(kp + 16 * ks); p = __builtin_amdgcn_mfma_f32_32x32x16_bf16(a, qr[ks], p, 0, 0, 0); }
        if (kb == qblk) {
#pragma unroll
            for (int r = 0; r < 16; ++r) p[r] = (kbase + 16 * hi + r <= tq) ? p[r] : 0.f; }
        u32x4 pa[2];
#pragma unroll
        for (int s = 0; s < 2; ++s) { pa[s].x = cvt_pk_bf16(p[8 * s], p[8 * s + 1]); pa[s].y = cvt_pk_bf16(p[8 * s + 2], p[8 * s + 3]); pa[s].z = cvt_pk_bf16(p[8 * s + 4], p[8 * s + 5]); pa[s].w = cvt_pk_bf16(p[8 * s + 6], p[8 * s + 7]); }
#pragma unroll
        for (int d = 0; d < 4; ++d)
#pragma unroll
            for (int s = 0; s < 2; ++s) { const bf16x8 vb = *(const bf16x8*)(VT + (size_t)(32 * d) * SEQ + kbase + 8 * s);
                o[d] = __builtin_amdgcn_mfma_f32_32x32x16_bf16(__builtin_bit_cast(bf16x8, pa[s]), vb, o[d], 0, 0, 0); }
    }
    float gg[4];
#pragma unroll
    for (int d = 0; d < 4; ++d) gg[d] = gng[h * 128 + 32 * d + l31];
#pragma unroll
    for (int r = 0; r < 16; ++r) {
        float sm = (o[0][r] + o[1][r]) + (o[2][r] + o[3][r]);
        sm += __shfl_xor(sm, 1); sm += __shfl_xor(sm, 2); sm += __shfl_xor(sm, 4); sm += __shfl_xor(sm, 8); sm += __shfl_xor(sm, 16);
        const float mu = sm * (1.f / 128.f); float q = 0.f;
#pragma unroll
        for (int d = 0; d < 4; ++d) { const float dd = o[d][r] - mu; q += dd * dd; }
        q += __shfl_xor(q, 1); q += __shfl_xor(q, 2); q += __shfl_xor(q, 4); q += __shfl_xor(q, 8); q += __shfl_xor(q, 16);
        const float rsd = rsqrtf(q * (1.f / 128.f) + 1e-5f);
        const int qrow = t0 + 32 * qblk + (r & 3) + 8 * (r >> 2) + 4 * hi; bf16_t* gp = Z + (rowb + qrow) * ZE + 1024 + h * 128 + l31;
#pragma unroll
        for (int d = 0; d < 4; ++d) { const float ga = bf2f(gp[32 * d]); const float ov = (o[d][r] - mu) * rsd * gg[d] * siluf_(ga); if (!DUMMY) gp[32 * d] = (bf16_t)f2bf(ov); else asm volatile("" :: "v"(ov)); }
    }
}
__device__ __forceinline__ bf16x8 ld8p(const bf16_t* p) { return *(const bf16x8*)p; }
namespace rw {
constexpr int S64 = 72, S128 = 136, LFS = 68;
constexpr int O_AT = 0, O_RT = O_AT + 9216, O_E = O_RT + 9216, O_ET = O_E + 18432, O_AM = O_ET + 17408, O_X0 = O_AM + 18432, O_LF = O_X0 + 17408, O_MM = O_LF + 17408,
              O_NN = O_MM + 9216, O_PC = O_NN + 17408, O_GC = O_PC + 9216, O_SM = O_GC + 9216, O_END = O_SM + 8192;
static_assert(O_END <= 160 * 1024 - 1024, "rwkv stage X LDS map");
typedef __attribute__((address_space(3))) bf16_t lbf;
typedef __attribute__((address_space(3))) float lf32;
__device__ __forceinline__ bf16x8 ld8(const bf16_t* p) { return *(const bf16x8*)p; }
__device__ __forceinline__ bf16x8 ld8(const LAS bf16_t* p) { return *(const LAS bf16x8*)p; }
__device__ __forceinline__ bf16x8 ld8(const GAS bf16_t* p) { return *(const GAS bf16x8*)p; }
template <int MT, int NT, int KS, class PA, class PB, class Epi>
__device__ __forceinline__ void mm(PA A, int lda, PB B, int ldb, int wave, int lane, Epi epi) {
    const int fr = lane & 15, g = lane >> 4;
    static_assert((MT * NT) % 8 == 0, "mm: tile count must be a multiple of the 8 waves");
#pragma unroll
    for (int ti = 0; ti < MT * NT / 8; ++ti) { const int tile = wave + 8 * ti; const int mt = tile / NT, nt = tile % NT;
        f32x4 acc = {0.f, 0.f, 0.f, 0.f};
        PA ap = A + (mt * 16 + fr) * lda + 8 * g; PB bp = B + (nt * 16 + fr) * ldb + 8 * g;
#pragma unroll
        for (int ks = 0; ks < KS; ++ks) acc = __builtin_amdgcn_mfma_f32_16x16x32_bf16(ld8(ap + 32 * ks), ld8(bp + 32 * ks), acc, 0, 0, 0);
        epi(ti, mt * 16 + 4 * g, nt * 16 + fr, acc);
    }
}
template <int MT, int NT, int KS, class PA, class PB, class Epi>
__device__ __forceinline__ void mm_rt(PA A, int lda, PB B, int ldb, int w, int nw, int lane, Epi epi) {
    const int fr = lane & 15, g = lane >> 4;
#pragma unroll 1
    for (int tile = w; tile < MT * NT; tile += nw) { const int mt = tile / NT, nt = tile % NT;
        f32x4 acc = {0.f, 0.f, 0.f, 0.f};
        PA ap = A + (mt * 16 + fr) * lda + 8 * g; PB bp = B + (nt * 16 + fr) * ldb + 8 * g;
#pragma unroll
        for (int ks = 0; ks < KS; ++ks) acc = __builtin_amdgcn_mfma_f32_16x16x32_bf16(ld8(ap + 32 * ks), ld8(bp + 32 * ks), acc, 0, 0, 0);
        epi(mt * 16 + 4 * g, nt * 16 + fr, acc);
    }
}
__device__ __forceinline__ unsigned short bfs(float f) { return (unsigned short)f2bf(f); }
__device__ __forceinline__ void st4(LAS bf16_t* p, f32x4 v) { u32x2 w; w.x = cvt_pk_bf16(v[0], v[1]); w.y = cvt_pk_bf16(v[2], v[3]); *(LAS u32x2*)p = w; }
}

template <bool DUMMY>
__device__ __forceinline__ void rwkv_stage_x(Frame& F, int li, unsigned long long& xacc) {
    using namespace rw;
#define TSX(k) do { if (MK_XA == (k) && li == 1 && F.wave == 0) { const unsigned long long t_ = __builtin_amdgcn_s_memrealtime(); *(volatile LAS unsigned long long*)(F.lds + MISC_OFF + 256) = t_; } if (MK_XB == (k) && li == 1 && F.wave == 0) { volatile LAS unsigned long long* p_ = (volatile LAS unsigned long long*)(F.lds + MISC_OFF + 256); const unsigned long long t0_ = p_[0]; if (t0_) p_[1] += __builtin_amdgcn_s_memrealtime() - t0_; } } while (0)
    const int o = li >> 1;
    LAS unsigned char* L = F.lds;
    LAS bf16_t* At = (LAS bf16_t*)(L + O_AT); LAS bf16_t* Rt = (LAS bf16_t*)(L + O_RT); LAS bf16_t* E = (LAS bf16_t*)(L + O_E); LAS bf16_t* ET = (LAS bf16_t*)(L + O_ET); LAS bf16_t* AM = (LAS bf16_t*)(L + O_AM);
    LAS bf16_t* X0T = (LAS bf16_t*)(L + O_X0); LAS float* Lf = (LAS float*)(L + O_LF); LAS bf16_t* Mm = (LAS bf16_t*)(L + O_MM); LAS bf16_t* NN = (LAS bf16_t*)(L + O_NN); LAS float* CS = (LAS float*)(L + O_NN);
    LAS bf16_t* Pc = (LAS bf16_t*)(L + O_PC); LAS bf16_t* Gc = (LAS bf16_t*)(L + O_GC); LAS float* gamC = (LAS float*)(L + O_SM); LAS float* SEGT = gamC + 64; LAS float* PRM = gamC + 64 + 1024;
    LAS bf16_t* Tm = At; LAS bf16_t* Qh = AM; LAS bf16_t* PT = AM + 64 * S64; LAS bf16_t* WT = Mm;
    GAS bf16_t* Z = (GAS bf16_t*)(F.ws + WS_Z); const GAS bf16_t* L1g = (const GAS bf16_t*)(F.ws + WS_L1); GAS bf16_t* VF = (GAS bf16_t*)(F.ws + WS_VF);
    const GAS bf16_t* W2T = (const GAS bf16_t*)(F.ws + WS_LORA2); const GAS bf16_t* A2T = W2T + 1024 * 64; const GAS bf16_t* V2T = A2T + 1024 * 64;
    GAS bf16_t* PG = (GAS bf16_t*)(F.H); GAS float* BON = (GAS float*)(F.ws + WS_BON);
    const float* w0p = F.in[12] + o * D; const float* a0p = F.in[15] + o * D; const float* v0p = F.in[18]; const float* kkp = F.in[21] + o * D; const float* kap = F.in[22] + o * D; const float* rkp = F.in[23] + o * D;
    f32x4 nlw[2], nla[2], nlv[2]; unsigned nr[4], nk[4], nv[4], nvf[4];
    bf16x8 fwa[4], fwb[2], faa[4], fab[2], fva[2], fvb;
    auto fetch_issue = [&](int u2, int c2, int tid2) {
        const int bh2 = u2 & 31, blk2 = u2 >> 5, b2 = bh2 >> 4, h2 = bh2 & 15; const size_t rows2 = (size_t)b2 * SEQ + (size_t)blk2 * 128 + 64 * c2;
        const int lane2 = tid2 & 63, fr2 = lane2 & 15, g2 = lane2 >> 4; int wave2 = F.wave; asm volatile("" : "+s"(wave2));
        const int nt2 = wave2 & 3;
#pragma unroll
        for (int ti = 0; ti < 2; ++ti) { const int mt2 = ((wave2 + 8 * ti) >> 2); const GAS bf16_t* ap = L1g + (rows2 + mt2 * 16 + fr2) * 256 + 8 * g2;
            fwa[ti * 2] = ld8(ap); fwa[ti * 2 + 1] = ld8(ap + 32); faa[ti * 2] = ld8(ap + 64); faa[ti * 2 + 1] = ld8(ap + 96); if (o) fva[ti] = ld8(ap + 128); }
        { const GAS bf16_t* bp = W2T + ((size_t)h2 * 64 + nt2 * 16 + fr2) * 64 + 8 * g2; fwb[0] = ld8(bp); fwb[1] = ld8(bp + 32); }
        { const GAS bf16_t* bp = A2T + ((size_t)h2 * 64 + nt2 * 16 + fr2) * 64 + 8 * g2; fab[0] = ld8(bp); fab[1] = ld8(bp + 32); }
        if (o) fvb = ld8(V2T + ((size_t)h2 * 64 + nt2 * 16 + fr2) * 32 + 8 * g2);
        const int q2 = wave2 * 2 + (lane2 >> 5), cp2 = lane2 & 31;
#pragma unroll
        for (int j = 0; j < 4; ++j) { const size_t prow2 = rows2 + 4 * q2 + j; const GAS unsigned* zp2 = (const GAS unsigned*)(Z + prow2 * ZW + h2 * 64 + 2 * cp2);
            nr[j] = zp2[0]; nk[j] = zp2[512]; nv[j] = zp2[1024]; nvf[j] = o ? *(const GAS unsigned*)(VF + prow2 * D + h2 * 64 + 2 * cp2) : 0u; }
    };
    auto fetch_compute = [&]() {
#pragma unroll
        for (int ti = 0; ti < 2; ++ti) { const f32x4 z4 = {0.f, 0.f, 0.f, 0.f};
            nlw[ti] = __builtin_amdgcn_mfma_f32_16x16x32_bf16(fwb[1], fwa[ti * 2 + 1], __builtin_amdgcn_mfma_f32_16x16x32_bf16(fwb[0], fwa[ti * 2], z4, 0, 0, 0), 0, 0, 0);
            nla[ti] = __builtin_amdgcn_mfma_f32_16x16x32_bf16(fab[1], faa[ti * 2 + 1], __builtin_amdgcn_mfma_f32_16x16x32_bf16(fab[0], faa[ti * 2], z4, 0, 0, 0), 0, 0, 0);
            if (o) nlv[ti] = __builtin_amdgcn_mfma_f32_16x16x32_bf16(fvb, fva[ti], z4, 0, 0, 0); }
    };
    { F.retid(); int t0 = F.tid; asm volatile("" : "+v"(t0)); fetch_issue(F.vcu, 0, t0); fetch_compute(); }
#pragma unroll 1
    for (int u = F.vcu; u < 2048; u += F.G) {
        const int bh = u & 31, blk = u >> 5, b = bh >> 4, h = bh & 15; const size_t row0 = (size_t)b * SEQ + (size_t)blk * 128;
        F.retid(); int tid = F.tid; asm volatile("" : "+v"(tid));
        LBAR();
        if ((F.G & 31) != 0 || u == F.vcu) {
            if (tid < 384) { const int a_ = tid >> 6, ch = tid & 63; const float* src = a_ == 0 ? w0p : a_ == 1 ? a0p : a_ == 2 ? v0p : a_ == 3 ? kkp : a_ == 4 ? kap : rkp; PRM[tid] = src[h * 64 + ch]; } }
        for (int e = tid; e < 64 * 64; e += 512) { const int i = e >> 6, j = e & 63; Pc[i * S64 + j] = (i == j) ? (bf16_t)0x3f80 : (bf16_t)0; Gc[i * S64 + j] = 0; }
#pragma unroll 1
        for (int c = 0; c < 2; ++c) {
            const size_t rows = row0 + 64 * c;
            asm volatile("" : "+v"(tid));
            const int lane = tid & 63; int wave = F.wave; asm volatile("" : "+s"(wave));
            const int cp = lane & 31, q = wave * 2 + (lane >> 5), ch0 = 2 * cp;
            LBAR();
            TSX(0);
            unsigned cr[4], ck[4], cv[4], cvf[4];
#pragma unroll
            for (int j = 0; j < 4; ++j) { cr[j] = nr[j]; ck[j] = nk[j]; cv[j] = nv[j]; cvf[j] = nvf[j]; }
            { const int fr_ = lane & 15, g_ = lane >> 4;
#pragma unroll
              for (int ti = 0; ti < 2; ++ti) { const int tile = wave + 8 * ti, t = (tile >> 2) * 16 + fr_, c0 = (tile & 3) * 16 + 4 * g_;
                  *(LAS f32x4*)(Lf + t * LFS + c0) = nlw[ti]; st4(Mm + t * S64 + c0, nla[ti]); if (o) st4(AM + (64 + t) * S64 + c0, nlv[ti]); } }
            const int nu = c == 0 ? u : u + F.G, nc = c == 0 ? 1 : 0; const bool has_n = nu < 2048;
            if (has_n) fetch_issue(nu, nc, tid);
            LBAR();
            TSX(1);
            float pr[4][2], pkk[4][2], pkm[4][2], pb[4][2], pv[4][2], cd[4][2];
            {
                float ss[4], bon[4];
#pragma unroll
                for (int j = 0; j < 4; ++j) { const int t = 4 * q + j; ss[j] = 0.f; bon[j] = 0.f;
                    const f32x2 lw2 = *(const LAS f32x2*)(Lf + t * LFS + ch0); const unsigned la2 = *(const LAS unsigned*)(Mm + t * S64 + ch0); const unsigned lv2 = o ? *(const LAS unsigned*)(AM + (64 + t) * S64 + ch0) : 0u;
#pragma unroll
                    for (int e = 0; e < 2; ++e) { const int ch = ch0 + e;
                        const float r = e ? __uint_as_float(cr[j] & 0xffff0000u) : __uint_as_float(cr[j] << 16), k = e ? __uint_as_float(ck[j] & 0xffff0000u) : __uint_as_float(ck[j] << 16);
                        float v = e ? __uint_as_float(cv[j] & 0xffff0000u) : __uint_as_float(cv[j] << 16);
                        const float lw = lw2[e], la = e ? __uint_as_float(la2 & 0xffff0000u) : __uint_as_float(la2 << 16);
                        cd[j][e] = -0.6065306597126334f * sigmoidf_(PRM[ch] + lw);
                        const float a = sigmoidf_(PRM[64 + ch] + la);
                        if (o) { const float lv = e ? __uint_as_float(lv2 & 0xffff0000u) : __uint_as_float(lv2 << 16); const float vf = e ? __uint_as_float(cvf[j] & 0xffff0000u) : __uint_as_float(cvf[j] << 16);
                            v = v + (vf - v) * sigmoidf_(PRM[128 + ch] + lv); v = bf2f((bf16_t)f2bf(v)); }
                        const float kr = k * PRM[192 + ch]; ss[j] += kr * kr; pkk[j][e] = kr;
                        const float km = k * (1.f + (a - 1.f) * PRM[256 + ch]); pkm[j][e] = km; pb[j][e] = a; pr[j][e] = r; pv[j][e] = v; bon[j] += r * km * PRM[320 + ch]; }
                    const size_t row = rows + t;
                    if (!DUMMY) { if (o) *(GAS unsigned*)(Z + row * ZW + 2048 + h * 64 + ch0) = pk2(pv[j][0], pv[j][1]); else *(GAS unsigned*)(VF + row * D + h * 64 + ch0) = cv[j]; } }
#pragma unroll
                for (int j = 0; j < 4; ++j) {
                    float s1 = ss[j], b1 = bon[j];
                    s1 += __shfl_xor(s1, 1); s1 += __shfl_xor(s1, 2); s1 += __shfl_xor(s1, 4); s1 += __shfl_xor(s1, 8); s1 += __shfl_xor(s1, 16);
                    b1 += __shfl_xor(b1, 1); b1 += __shfl_xor(b1, 2); b1 += __shfl_xor(b1, 4); b1 += __shfl_xor(b1, 8); b1 += __shfl_xor(b1, 16);
                    const float inv = __builtin_amdgcn_rcpf(fmaxf(sqrtf(s1), 1e-12f));
#pragma unroll
                    for (int e = 0; e < 2; ++e) { pkk[j][e] *= inv; pb[j][e] *= pkk[j][e]; }
                    if (!DUMMY && cp == 0) BON[(rows + 4 * q + j) * 16 + h] = b1; }
#pragma unroll
                for (int e = 0; e < 2; ++e) { cd[1][e] += cd[0][e]; cd[2][e] += cd[1][e]; cd[3][e] += cd[2][e]; SEGT[q * 64 + ch0 + e] = cd[3][e]; }
            }
            LBAR();
            TSX(3);
            {
                float pre[2] = {0.f, 0.f};
                for (int qq = 0; qq < q; ++qq) { pre[0] += SEGT[qq * 64 + ch0]; pre[1] += SEGT[qq * 64 + ch0 + 1]; }
                unsigned short at[4][2], bt[4][2], kt[4][2], rt[4][2], vt[4][2];
#pragma unroll
                for (int j = 0; j < 4; ++j)
#pragma unroll
                    for (int e = 0; e < 2; ++e) { const float g = pre[e] + cd[j][e], gp = j ? pre[e] + cd[j - 1][e] : pre[e]; const float eg = __expf(g), egp = __expf(gp), ieg = __builtin_amdgcn_rcpf(eg);
                        at[j][e] = bfs(egp * pkk[j][e]); bt[j][e] = bfs(pb[j][e] * ieg); kt[j][e] = bfs(pkm[j][e] * ieg); rt[j][e] = bfs(pr[j][e] * eg); vt[j][e] = bfs(pv[j][e]);
                        if (q == 15 && j == 3) gamC[ch0 + e] = eg; }
#pragma unroll
                for (int j = 0; j < 4; ++j) { const int t = 4 * q + j;
                    *(LAS unsigned*)(At + t * S64 + ch0) = (unsigned)at[j][0] | ((unsigned)at[j][1] << 16); *(LAS unsigned*)(Rt + t * S64 + ch0) = (unsigned)rt[j][0] | ((unsigned)rt[j][1] << 16);
                    *(LAS unsigned*)(E + t * S64 + ch0) = (unsigned)bt[j][0] | ((unsigned)bt[j][1] << 16); *(LAS unsigned*)(E + (64 + t) * S64 + ch0) = (unsigned)kt[j][0] | ((unsigned)kt[j][1] << 16); }
#pragma unroll
                for (int e = 0; e < 2; ++e) { const int ch = ch0 + e;
#define RW_Q4(x) (u32x2){(unsigned)x[0][e] | ((unsigned)x[1][e] << 16), (unsigned)x[2][e] | ((unsigned)x[3][e] << 16)}
                    *(LAS u32x2*)(AM + ch * S64 + 4 * q) = RW_Q4(at); *(LAS u32x2*)(ET + ch * S128 + 4 * q) = RW_Q4(bt); *(LAS u32x2*)(ET + ch * S128 + 64 + 4 * q) = RW_Q4(kt); *(LAS u32x2*)(X0T + ch * S128 + 64 + 4 * q) = RW_Q4(vt);
#undef RW_Q4
                }
            }
            LBAR();
            TSX(4);
            mm<8, 4, 2>(E, S64, At, S64, wave, lane, [&](int, int r0, int col, f32x4 a) {
                const int i0 = r0 & 63; f32x4 v;
#pragma unroll
                for (int j = 0; j < 4; ++j) v[j] = (i0 + j < col) ? a[j] : 0.f;
                if (r0 < 64) *(LAS f32x4*)(Lf + col * LFS + i0) = v; else st4(Mm + col * S64 + i0, v); });
            LBAR();
            TSX(5);
            if (wave < 2) {
                const int bb = 32 * wave; float x[32]; int vz = 0; asm volatile("" : "+v"(vz));
                const LAS float* Lz = Lf + vz; const int cl = lane & 31;
#pragma unroll
                for (int t = 0; t < 32; ++t) x[t] = 0.f;
#pragma unroll
                for (int t = 0; t < 32; ++t) { float s0 = (t == cl) ? 1.f : 0.f, s1 = 0.f, s2 = 0.f, s3 = 0.f;
#pragma unroll
                    for (int i4 = 0; i4 < (t + 3) / 4; ++i4) { const f32x4 l4 = *(const LAS f32x4*)(Lz + (bb + t) * LFS + bb + 4 * i4);
                        s0 -= l4[0] * x[4 * i4]; s1 -= l4[1] * x[4 * i4 + 1]; s2 -= l4[2] * x[4 * i4 + 2]; s3 -= l4[3] * x[4 * i4 + 3]; }
                    x[t] = (s0 + s1) + (s2 + s3); }
                if (lane < 32) {
#pragma unroll
                    for (int t = 0; t < 32; ++t) Tm[(bb + t) * S64 + bb + cl] = bfs(x[t]);
                    if (wave == 0) {
#pragma unroll
                        for (int i4 = 0; i4 < 8; ++i4) st4(X0T + cl * S128 + 4 * i4, (f32x4){x[4 * i4], x[4 * i4 + 1], x[4 * i4 + 2], x[4 * i4 + 3]}); }
                }
            } else {
                mm_rt<8, 4, 2>(E, S64, Rt, S64, wave - 2, 6, lane, [&](int r0, int col, f32x4 a) {
                    const int i0 = r0 & 63; f32x4 v;
#pragma unroll
                    for (int j = 0; j < 4; ++j) v[j] = (i0 + j <= col) ? a[j] : 0.f;
                    st4(NN + col * S128 + r0, v); });
                mm_rt<4, 4, 2>(Mm, S64, X0T + 64, S128, wave - 2, 6, lane, [&](int r0, int col, f32x4 a) { st4(AM + (64 + col) * S64 + r0, (f32x4){-a[0], -a[1], -a[2], -a[3]}); });
                asm volatile("s_waitcnt lgkmcnt(0)" ::: "memory");
                { const int e = tid - 128; if (e < 256) { const int t = e >> 3, i4 = (e & 7) * 4; st4(X0T + t * S128 + 32 + i4, *(const LAS f32x4*)(Lf + (32 + t) * LFS + i4)); *(LAS u32x2*)(Tm + t * S64 + 32 + i4) = (u32x2){0u, 0u}; } }
            }
            LBAR();
            TSX(6);
            if (wave < 4) { const int fr_ = lane & 15, g_ = lane >> 4, mt = wave >> 1, nt = wave & 1;
                const f32x4 z4 = {0.f, 0.f, 0.f, 0.f};
                const f32x4 a = __builtin_amdgcn_mfma_f32_16x16x32_bf16(ld8(X0T + (mt * 16 + fr_) * S128 + 32 + 8 * g_), ld8(X0T + (nt * 16 + fr_) * S128 + 8 * g_), z4, 0, 0, 0);
                st4(Mm + (nt * 16 + fr_) * S64 + mt * 16 + 4 * g_, a); }
            LBAR();
            if (wave < 4) { const int fr_ = lane & 15, g_ = lane >> 4, mt = wave >> 1, nt = wave & 1;
                const f32x4 z4 = {0.f, 0.f, 0.f, 0.f};
                const f32x4 a = __builtin_amdgcn_mfma_f32_16x16x32_bf16(ld8(Tm + (32 + mt * 16 + fr_) * S64 + 32 + 8 * g_), ld8(Mm + (nt * 16 + fr_) * S64 + 8 * g_), z4, 0, 0, 0);
#pragma unroll
                for (int j = 0; j < 4; ++j) Tm[(32 + mt * 16 + 4 * g_ + j) * S64 + nt * 16 + fr_] = bfs(-a[j]); }
            LBAR();
            TSX(7);
            mm<4, 8, 2>(Tm, S64, AM, S64, wave, lane, [&](int, int r0, int col, f32x4 a) { if (col < 64) st4(WT + col * S64 + r0, a); else st4(X0T + (col - 64) * S128 + r0, a); });
            LBAR();
            TSX(8);
            f32x4 gt[2], y0t[2];
            mm<4, 4, 2>(WT, S64, ET, S128, wave, lane, [&](int, int r0, int col, f32x4 a) { const float gc = gamC[col];
                f32x4 p;
#pragma unroll
                for (int j = 0; j < 4; ++j) p[j] = (((r0 + j) == col ? 1.f : 0.f) - a[j]) * gc;
                st4(PT + col * S64 + r0, p); });
            mm<4, 4, 4>(ET, S128, X0T, S128, wave, lane, [&](int ti, int r0, int, f32x4 a) { gt[ti] = a * *(const LAS f32x4*)(gamC + r0); });
            mm<4, 4, 4>(NN, S128, X0T, S128, wave, lane, [&](int ti, int, int, f32x4 a) { y0t[ti] = a; });
            mm<4, 4, 2>(WT, S64, NN, S128, wave, lane, [&](int, int r0, int col, f32x4 a) {
                const u32x2 rr = *(const LAS u32x2*)(Rt + col * S64 + r0);
                st4(Qh + col * S64 + r0, (f32x4){__uint_as_float(rr.x << 16) - a[0], __uint_as_float(rr.x & 0xffff0000u) - a[1], __uint_as_float(rr.y << 16) - a[2], __uint_as_float(rr.y & 0xffff0000u) - a[3]}); });
            LBAR();
            TSX(9);
            GAS bf16_t* rslot = Z + row0 * ZW + h * 64; GAS bf16_t* kslot = rslot + 1024;
            mm<4, 4, 2>(Pc, S64, Qh, S64, wave, lane, [&](int, int r0, int col, f32x4 a) {
                const int kt_ = r0 >> 5, rho = r0 & 31, s = rho >> 4, jj = ((rho >> 3) & 1) * 4, hh = (rho >> 2) & 1;
                const int t = 64 * c + col, tt_ = t >> 5, ln = 32 * hh + (t & 31); const int e = ((((tt_ * 2 + kt_) * 2 + s) * 64 + ln) << 3) + jj;
                if (!DUMMY) *(GAS u32x2*)(rslot + (size_t)(e >> 6) * ZW + (e & 63)) = (u32x2){cvt_pk_bf16(a[0], a[1]), cvt_pk_bf16(a[2], a[3])}; else asm volatile("" :: "v"(a[0])); });
            mm<4, 4, 2>(Qh, S64, Gc, S64, wave, lane, [&](int ti, int r0, int col, f32x4 a) {
                const int vt_ = col >> 5, v31 = col & 31;
                const int t = 64 * c + r0, tt_ = t >> 5, x = t & 31, hh = (x >> 2) & 1, r = 4 * (x >> 3); const int e = (((tt_ * 2 + vt_) * 64 + 32 * hh + v31) << 4) + r;
                const f32x4 y = a + y0t[ti];
                if (!DUMMY) *(GAS u32x2*)(kslot + (size_t)(e >> 6) * ZW + (e & 63)) = (u32x2){cvt_pk_bf16(y[0], y[1]), cvt_pk_bf16(y[2], y[3])}; else asm volatile("" :: "v"(y[0])); });
            f32x4 pn[2], gn[2];
            mm<4, 4, 2>(PT, S64, Pc, S64, wave, lane, [&](int ti, int, int, f32x4 a) { pn[ti] = a; });
            mm<4, 4, 2>(PT, S64, Gc, S64, wave, lane, [&](int ti, int, int, f32x4 a) { gn[ti] = a + gt[ti]; });
            if (has_n) fetch_compute();
            LBAR();
            { const int fr = lane & 15, g = lane >> 4;
#pragma unroll
              for (int ti = 0; ti < 2; ++ti) { const int tile = wave + 8 * ti, mt = tile >> 2, nt = tile & 3;
                  st4(Pc + (nt * 16 + fr) * S64 + mt * 16 + 4 * g, pn[ti]); st4(Gc + (nt * 16 + fr) * S64 + mt * 16 + 4 * g, gn[ti]); } }
            TSX(10);
        }
        LBAR();
        if (!DUMMY) { GAS bf16_t* pg = PG + (size_t)u * 8192;
          { const int f = tid >> 6, ln = tid & 63, s = f & 1, kit = (f >> 1) & 1, kot = f >> 2, hh = ln >> 5, r31 = ln & 31; unsigned short w[8];
#pragma unroll
            for (int j = 0; j < 8; ++j) { const int rho = 16 * s + 8 * (j >> 2) + 4 * hh + (j & 3); w[j] = Pc[(32 * kit + rho) * S64 + 32 * kot + r31]; }
            *(GAS u32x4*)(pg + (size_t)tid * 8) = (u32x4){(unsigned)w[0] | ((unsigned)w[1] << 16), (unsigned)w[2] | ((unsigned)w[3] << 16), (unsigned)w[4] | ((unsigned)w[5] << 16), (unsigned)w[6] | ((unsigned)w[7] << 16)}; }
          { const int tile = tid >> 7, ln = (tid >> 1) & 63, half = tid & 1, kot = tile >> 1, vt_ = tile & 1, hh = ln >> 5, v31 = ln & 31; unsigned short w[8];
#pragma unroll
            for (int q = 0; q < 8; ++q) { const int r = 8 * half + q; const int ko = 32 * kot + (r & 3) + 8 * (r >> 2) + 4 * hh; w[q] = Gc[(32 * vt_ + v31) * S64 + ko]; }
            *(GAS u32x4*)(pg + 4096 + ((size_t)(tile * 64 + ln) << 4) + 8 * half) = (u32x4){(unsigned)w[0] | ((unsigned)w[1] << 16), (unsigned)w[2] | ((unsigned)w[3] << 16), (unsigned)w[4] | ((unsigned)w[5] << 16), (unsigned)w[6] | ((unsigned)w[7] << 16)}; } }
    }
    LBAR();
}

__device__ __forceinline__ void rwkv_stage_y(Frame& F, const int bx) {
    const int lane = F.lane, wave = F.wave, bh = bx, vt = wave >> 2; const bool st = ((wave & 3) == 0);
    const bf16_t* PG = (const bf16_t*)(F.H); u32x4* SB = (u32x4*)(F.ws + WS_SB);
    LAS bf16x8* pgbuf = (LAS bf16x8*)F.lds;
    f32x16 X0, X1;
#pragma unroll
    for (int r = 0; r < 16; ++r) { X0[r] = 0.f; X1[r] = 0.f; }
    bf16x8 Ra0, Ra1, Rb0, Rb1, Rc0, Rc1;
    auto issue = [&](bf16x8& r0, bf16x8& r1, int blk) { const bf16_t* pg = PG + (size_t)(blk * 32 + bh) * 8192;
        r0 = ld8p(pg + (((size_t)(wave * 2 + 0) * 64 + lane) << 3)); r1 = ld8p(pg + (((size_t)(wave * 2 + 1) * 64 + lane) << 3)); };
    auto step = [&](bf16x8& c0, bf16x8& c1, bf16x8& n0r, bf16x8& n1r, int blk) {
        const bf16x8 nga = n0r, ngb = n1r;
        issue(c0, c1, blk + 3 < 64 ? blk + 3 : 63);
        asm volatile("s_waitcnt lgkmcnt(0)" ::: "memory"); __builtin_amdgcn_s_barrier(); asm volatile("" ::: "memory");
        pgbuf[((blk + 1) & 1) * 1024 + (wave * 2 + 0) * 64 + lane] = nga; pgbuf[((blk + 1) & 1) * 1024 + (wave * 2 + 1) * 64 + lane] = ngb;
        if (st) {
            u32x4 xb[4];
#pragma unroll
            for (int s = 0; s < 2; ++s) {
                xb[s] = (u32x4){cvt_pk_bf16(X0[8 * s], X0[8 * s + 1]), cvt_pk_bf16(X0[8 * s + 2], X0[8 * s + 3]), cvt_pk_bf16(X0[8 * s + 4], X0[8 * s + 5]), cvt_pk_bf16(X0[8 * s + 6], X0[8 * s + 7])};
                xb[2 + s] = (u32x4){cvt_pk_bf16(X1[8 * s], X1[8 * s + 1]), cvt_pk_bf16(X1[8 * s + 2], X1[8 * s + 3]), cvt_pk_bf16(X1[8 * s + 4], X1[8 * s + 5]), cvt_pk_bf16(X1[8 * s + 6], X1[8 * s + 7])}; }
            u32x4* sb = SB + ((size_t)(blk * 32 + bh) * 8 + vt * 4) * 64 + lane;
#pragma unroll
            for (int q = 0; q < 4; ++q) sb[q * 64] = xb[q];
            const LAS bf16x8* pb = pgbuf + (blk & 1) * 1024;
            f32x16 n0, n1;
            { const bf16x8 c0a = pb[512 + ((0 * 2 + vt) * 64 + lane) * 2], c0b = pb[512 + ((0 * 2 + vt) * 64 + lane) * 2 + 1], c1a = pb[512 + ((1 * 2 + vt) * 64 + lane) * 2], c1b = pb[512 + ((1 * 2 + vt) * 64 + lane) * 2 + 1];
#pragma unroll
              for (int r = 0; r < 8; ++r) { n0[r] = bf2f((bf16_t)c0a[r]); n0[8 + r] = bf2f((bf16_t)c0b[r]); n1[r] = bf2f((bf16_t)c1a[r]); n1[8 + r] = bf2f((bf16_t)c1b[r]); } }
#pragma unroll
            for (int q = 0; q < 4; ++q) {
                n0 = __builtin_amdgcn_mfma_f32_32x32x16_bf16(pb[q * 64 + lane], __builtin_bit_cast(bf16x8, xb[q]), n0, 0, 0, 0);
                n1 = __builtin_amdgcn_mfma_f32_32x32x16_bf16(pb[(4 + q) * 64 + lane], __builtin_bit_cast(bf16x8, xb[q]), n1, 0, 0, 0); }
            X0 = n0; X1 = n1;
        }
    };
    issue(Ra0, Ra1, 0); issue(Rb0, Rb1, 1); issue(Rc0, Rc1, 2);
    pgbuf[(wave * 2 + 0) * 64 + lane] = Ra0; pgbuf[(wave * 2 + 1) * 64 + lane] = Ra1;
#pragma unroll 1
    for (int blk = 0; blk < 63; blk += 3) { step(Ra0, Ra1, Rb0, Rb1, blk); step(Rb0, Rb1, Rc0, Rc1, blk + 1); step(Rc0, Rc1, Ra0, Ra1, blk + 2); }
    step(Ra0, Ra1, Rb0, Rb1, 63);
    __syncthreads();
}

template <bool DUMMY>
__device__ __forceinline__ void rwkv_stage_z(Frame& F, int li) {
    const int o = li >> 1;
    bf16_t* Z = (bf16_t*)(F.ws + WS_Z); const float* BON = (const float*)(F.ws + WS_BON); const u32x4* SB = (const u32x4*)(F.ws + WS_SB);
    const float* lgp = F.in[24] + o * D; const float* lbp = F.in[25] + o * D;
    LAS float* tile = (LAS float*)(F.lds + F.wave * 9216);
    int lane_ = F.lane;
#pragma unroll 1
    for (int w = F.vcu * 8 + F.wave; w < 8192; w += F.G * 8) {
        asm volatile("" : "+v"(lane_)); const int lane = lane_, v31 = lane & 31, hh = lane >> 5, tl = lane >> 1, hf = lane & 1;
        const int u = w >> 2, tt = w & 3, bh = u & 31, blk = u >> 5, b = bh >> 4, h = bh & 15; const size_t row0 = (size_t)b * SEQ + (size_t)blk * 128;
        const bf16_t* rslot = Z + row0 * ZW + h * 64; const bf16_t* kslot = rslot + 1024;
        const size_t row = row0 + 32 * tt + tl; bf16_t* zp = Z + row * ZW + h * 64 + 32 * hf;
        bf16x8 vv[4], gg[4];
#pragma unroll
        for (int q = 0; q < 4; ++q) { vv[q] = ld8p(zp + 2048 + 8 * q); gg[q] = ld8p(zp + 3072 + 8 * q); }
        const float bon = BON[row * 16 + h];
        bf16x8 qf[4]; u32x4 xb[2][4];
#pragma unroll
        for (int q = 0; q < 4; ++q) { const int e = (((tt * 4 + q) * 64 + lane) << 3); qf[q] = ld8p(rslot + (size_t)(e >> 6) * ZW + (e & 63)); }
#pragma unroll
        for (int vt = 0; vt < 2; ++vt)
#pragma unroll
            for (int q = 0; q < 4; ++q) xb[vt][q] = SB[((size_t)u * 8 + vt * 4 + q) * 64 + lane];
#pragma unroll
        for (int vt = 0; vt < 2; ++vt) { const int e0 = ((tt * 2 + vt) * 64 + lane) << 4; const bf16_t* yp = kslot + (size_t)(e0 >> 6) * ZW + (e0 & 63); const bf16x8 ya = ld8p(yp), yb = ld8p(yp + 8);
            f32x16 acc;
#pragma unroll
            for (int r = 0; r < 8; ++r) { acc[r] = bf2f((bf16_t)ya[r]); acc[8 + r] = bf2f((bf16_t)yb[r]); }
#pragma unroll
            for (int q = 0; q < 4; ++q) acc = __builtin_amdgcn_mfma_f32_32x32x16_bf16(qf[q], __builtin_bit_cast(bf16x8, xb[vt][q]), acc, 0, 0, 0);
#pragma unroll
            for (int r = 0; r < 16; ++r) tile[((r & 3) + 8 * (r >> 2) + 4 * hh) * 72 + 36 * vt + v31] = acc[r]; }
        LDS_WAIT(); asm volatile("" ::: "memory");
        float y[32]; float sm = 0.f;
#pragma unroll
        for (int q = 0; q < 8; ++q) { const f32x4 t4 = *(const LAS f32x4*)(tile + tl * 72 + 36 * hf + 4 * q); y[4 * q] = t4[0]; y[4 * q + 1] = t4[1]; y[4 * q + 2] = t4[2]; y[4 * q + 3] = t4[3]; sm += (t4[0] + t4[1]) + (t4[2] + t4[3]); }
        sm += __shfl_xor(sm, 1);
        const float mu = sm * (1.f / 64.f); float qq = 0.f;
#pragma unroll
        for (int j = 0; j < 32; ++j) { y[j] -= mu; qq += y[j] * y[j]; }
        qq += __shfl_xor(qq, 1);
        const float rsd = rsqrtf(qq * (1.f / 64.f) + 64e-5f);
        const float* lg = lgp + h * 64 + 32 * hf; const float* lb = lbp + h * 64 + 32 * hf;
#pragma unroll
        for (int q = 0; q < 4; ++q) { float ov[8];
#pragma unroll
            for (int j = 0; j < 8; ++j) { const int c = 8 * q + j; const float va = bf2f((bf16_t)vv[q][j]), ga = bf2f((bf16_t)gg[q][j]); ov[j] = (y[c] * rsd * lg[c] + lb[c] + bon * va) * siluf_(ga); }
            const u32x4 wv = {cvt_pk_bf16(ov[0], ov[1]), cvt_pk_bf16(ov[2], ov[3]), cvt_pk_bf16(ov[4], ov[5]), cvt_pk_bf16(ov[6], ov[7])};
            if (!DUMMY) *(u32x4*)(zp + 3072 + 8 * q) = wv; else asm volatile("" :: "v"(wv)); }
        LDS_WAIT(); asm volatile("" ::: "memory");
    }
}

enum { PH_P0 = 0, PH_FINAL = 27, N_PHASES = 28 };
#define IN(k) (lo <= (k) && (k) < hi)
#define TSG(k) do { if (LI == 0) { if (MK_GA == (k)) tA = __builtin_amdgcn_s_memrealtime(); if (MK_GB == (k)) tB = __builtin_amdgcn_s_memrealtime(); } } while (0)
#define TS(k) do { if (MK_TPA == (k)) tA = __builtin_amdgcn_s_memrealtime(); if (MK_TPB == (k)) tB = __builtin_amdgcn_s_memrealtime(); } while (0)
#if MK_MULTI
#define SEAM(k) do { } while (0)
#else
#define SEAM(k) do { if (IN(k) && IN((k) + 1)) xcd_barrier(bar); } while (0)
#endif
template <int LI>
__device__ __forceinline__ void run_layer(Frame& F, const XcdBarrier& bar, const int lo, const int hi, const int bx, unsigned long long& tA, unsigned long long& tB) {
    constexpr bool even = (LI & 1) == 0;
    constexpr int base = 1 + (LI / 2) * 13 + (even ? 0 : 6);
    bf16_t* Zp = (bf16_t*)(F.ws + WS_Z);
    if constexpr (even) {
        TS(base); if (IN(base)) { F.retid(); pg8::StaticOrder S; S.init(64, 16, F.G, bx);
            pg8::Gemm g{(const bf16_t*)(F.ws + WS_HB), (const bf16_t*)(F.ws + WS_WIN)};
            EpiEvenIn E{Zp, F.ssq(LI), (bf16_t*)(F.ws + WS_VTA), (bf16_t*)(F.ws + WS_VTB), (bf16_t*)(F.ws + WS_KT), F.lds + RING_BYTES};
            if (MK_PROBE == 1) pg8::gemm_phase<EpiEvenIn, true, D, D, 1 << 20, 0, 0>(F.lds, F.tid, g, S, E);
            pg8::gemm_phase<EpiEvenIn, true, D, D, 1 << 20, 0, 0>(F.lds, F.tid, g, S, E); }
        SEAM(base);
        TS(base + 1); if (IN(base + 1)) { F.retid();
            TSG(0); conv_wrest_a(F, LI); TSG(1);
            if constexpr (LI < 3) conv_win_odd(F, LI + 1);
            TSG(2);
            if (MK_PROBE == 5) { for (int u = F.vcu * 8 + F.wave; u < 4096; u += F.G * 8) ret_stage_a(F, u);
                for (int u = F.vcu * 8 + F.wave; u < 2048; u += F.G * 8) sb_unit<true>(F, u >> 8, u & 255); }
            for (int u = F.vcu * 8 + F.wave; u < 4096; u += F.G * 8) ret_stage_a(F, u);
            __syncthreads(); TSG(3);
            for (int u = F.vcu * 8 + F.wave; u < 2048; u += F.G * 8) sb_unit<false>(F, u >> 8, u & 255);
            __syncthreads(); TSG(4); }
        SEAM(base + 1);
        TS(base + 2); if (IN(base + 2)) { F.retid(); ret_stage_b(F); conv_wrest_b(F, LI, F.vcu, F.G); }
        SEAM(base + 2);
        TS(base + 3); if (IN(base + 3)) { F.retid(); const float* gng = F.in[8] + (LI >> 1) * 512;
            if (MK_PROBE == 6) for (int u = F.vcu * 8 + F.wave; u < 2048; u += F.G * 8) ret_stage_c<true>(F, u, gng);
            for (int u = F.vcu * 8 + F.wave; u < 2048; u += F.G * 8) ret_stage_c<false>(F, u, gng); }
        SEAM(base + 3);
        TS(base + 4); if (IN(base + 4)) { F.retid(); pg8::StaticOrder S; S.init(64, 4, F.G, bx);
            { pg8::Gemm g{(const bf16_t*)(F.ws + WS_PB), (const bf16_t*)(F.ws + WS_WPROJ)};
              EpiStore E{Zp, ZE}; pg8::gemm_phase<EpiStore, false, PLE, PLE, 1 << 20, 0, 0>(F.lds, F.tid, g, S, E); }
            { pg8::Gemm g{Zp + 1024, (const bf16_t*)(F.ws + WS_WOUT)};
              EpiResid E{(const bf16_t*)(F.ws + WS_HB), Zp + 1536, ZE}; pg8::gemm_phase<EpiResid, false, ZE, D, 8, (long)((2560 - 1024) * 2), 0>(F.lds, F.tid, g, S, E); } }
        SEAM(base + 4);
        TS(base + 5); if (IN(base + 5)) { F.retid(); pg8::StaticOrder S; S.init(64, 4, F.G, bx);
            pg8::Gemm g{Zp + 1536, (const bf16_t*)(F.ws + WS_WGATE)};
            EpiGate E{Zp + 1536, ZE, Zp, ZE, (bf16_t*)(F.ws + WS_HB), F.ssq(LI + 1)};
            pg8::gemm_phase<EpiGate, false, ZE, D, 1 << 20, 0, 0>(F.lds, F.tid, g, S, E); }
        SEAM(base + 5);
    } else {
        TS(base); if (IN(base)) { F.retid(); conv_lora2(F, LI); rows_norm(F, LI); }
        SEAM(base);
        TS(base + 1); if (IN(base + 1)) { F.retid(); pg8::StaticOrder S; S.init(64, 17, F.G, bx);
            pg8::Gemm g{(const bf16_t*)(F.H) + D, (const bf16_t*)(F.ws + WS_WIN)};
            EpiOddIn E{Zp, (bf16_t*)(F.ws + WS_L1)};
            if (MK_PROBE == 2) pg8::gemm_phase<EpiOddIn, true, D, 2048, 16, -(long)(D * 2), (long)(D * 2)>(F.lds, F.tid, g, S, E);
            pg8::gemm_phase<EpiOddIn, true, D, 2048, 16, -(long)(D * 2), (long)(D * 2)>(F.lds, F.tid, g, S, E); }
        SEAM(base + 1);
        TS(base + 2); if (IN(base + 2)) { F.retid();
            conv_wrest_a(F, LI);
            __syncthreads();
            { unsigned long long xa = 0; rwkv_stage_x<false>(F, LI, xa); } }
        SEAM(base + 2);
        TS(base + 3); if (IN(base + 3)) { F.retid();
            if (bx < 32) rwkv_stage_y(F, bx);
            else { pg8::StaticOrder S; S.init(64, 4, F.G - 32, bx - 32);
                pg8::Gemm g{(const bf16_t*)(F.ws + WS_PB), (const bf16_t*)(F.ws + WS_WPROJ)};
                EpiStore E{(bf16_t*)(F.H) + (size_t)16 * 1024 * 1024, D}; pg8::gemm_phase<EpiStore, false, PLE, PLE, 1 << 20, 0, 0>(F.lds, F.tid, g, S, E);
                __syncthreads(); conv_wrest_b(F, LI, bx - 32, F.G - 32); } }
        SEAM(base + 3);
        TS(base + 4); if (IN(base + 4)) { F.retid(); rwkv_stage_z<false>(F, LI); }
        SEAM(base + 4);
        TS(base + 5); if (IN(base + 5)) { F.retid(); pg8::StaticOrder S; S.init(64, 4, F.G, bx);
            if constexpr (LI < 3) { conv_win_even(F, LI + 1); __syncthreads(); }
            { pg8::Gemm g{Zp + 3072, (const bf16_t*)(F.ws + WS_WOUT)};
              EpiResid E{(const bf16_t*)(F.ws + WS_HB), Zp + 2048, ZW}; pg8::gemm_phase<EpiResid, false, ZW, D, 1 << 20, 0, 0>(F.lds, F.tid, g, S, E); } }
        SEAM(base + 5);
        TS(base + 6); if (IN(base + 6)) { F.retid(); pg8::StaticOrder S; S.init(64, 4, F.G, bx);
            pg8::Gemm g{Zp + 2048, (const bf16_t*)(F.ws + WS_WGATE)};
            EpiGate E{Zp + 2048, ZW, (const bf16_t*)(F.H) + (size_t)16 * 1024 * 1024, D, (bf16_t*)(F.ws + WS_HB), F.ssq(LI + 1)};
            pg8::gemm_phase<EpiGate, false, ZW, D, 1 << 20, 0, 0>(F.lds, F.tid, g, S, E); }
        SEAM(base + 6);
    }
}
__global__ void __launch_bounds__(512, 2) mk_fwd(Args args) {
    extern __shared__ __attribute__((aligned(16))) unsigned char lds_raw[];
    Frame F;
    F.lds = (LAS unsigned char*)lds_raw; F.ldsg = lds_raw;
    F.tid = threadIdx.x; F.lane = F.tid & 63; F.wave = __builtin_amdgcn_readfirstlane(F.tid >> 6);
    F.G = gridDim.x; const int bx = blockIdx.x; F.vcu = (F.G % 8 == 0) ? (bx % 8) * (F.G / 8) + bx / 8 : bx;
    F.H = args.out; F.ws = args.ws;
    volatile LAS unsigned* MISC = (volatile LAS unsigned*)(F.lds + MISC_OFF);
    for (int u = F.tid; u < 128; u += 512) ((LAS unsigned*)(F.lds + MISC_OFF))[u] = 0u;
    __syncthreads();
    XcdBarrier bar; bar.bar = (unsigned*)(F.ws + WS_CTL) + 4096; bar.x = 0; bar.st = nullptr;
#if !MK_MULTI
    bar = xcd_barrier_post((unsigned*)(F.ws + WS_CTL) + 4096, MISC + 8);
#endif
    const int lo = args.ph_lo, hi = args.ph_hi;
    if (IN(PH_P0)) { F.retid(); rows_p0(F); conv_win_even(F, 0); }
#if !MK_MULTI
    if (IN(0) && IN(1)) { VM_WAIT(); cg::this_grid().sync(); }
#endif
    unsigned long long tA = 0, tB = 0;
    TS(0);
    run_layer<0>(F, bar, lo, hi, bx, tA, tB);
    run_layer<1>(F, bar, lo, hi, bx, tA, tB);
    run_layer<2>(F, bar, lo, hi, bx, tA, tB);
    run_layer<3>(F, bar, lo, hi, bx, tA, tB);
    TS(PH_FINAL);
    if (IN(PH_FINAL)) { F.retid(); rows_final(F); }
    TS(PH_FINAL + 1);
    if ((MK_TPA >= 0 || MK_XA >= 0 || MK_GA >= 0) && blockIdx.x == 0 && F.wave == 0) { const unsigned long long t0 = __builtin_amdgcn_s_memrealtime(), span = 4ull * (MK_XA >= 0 ? ((volatile LAS unsigned long long*)(F.lds + MISC_OFF + 256))[1] : (tB - tA)); while (__builtin_amdgcn_s_memrealtime() - t0 < span) __builtin_amdgcn_s_sleep(8); }
}

extern "C" void kernel_launch(void* const* d_in, const int* in_sizes, int n_in, void* d_out, int out_size, void* d_ws, size_t ws_size, hipStream_t stream) {
    static int grid = 0;
    if (grid == 0) {
        int dev = 0, cus = 0, per_cu = 0;
        (void)hipGetDevice(&dev); (void)hipDeviceGetAttribute(&cus, hipDeviceAttributeMultiprocessorCount, dev);
        (void)hipFuncSetAttribute((const void*)mk_fwd, hipFuncAttributeMaxDynamicSharedMemorySize, LDS_BYTES);
        (void)hipOccupancyMaxActiveBlocksPerMultiprocessor(&per_cu, (const void*)mk_fwd, 512, LDS_BYTES);
        if (per_cu < 1) per_cu = 1;
        grid = cus * 1;
        if (n_in != 26 || ws_size < WS_END) fprintf(stderr, "kernel_launch: unexpected n_in %d / ws %zu\n", n_in, ws_size);
        (void)hipGetLastError();
    }
    (void)hipMemsetAsync((char*)d_ws + WS_CTL, 0, CTL_BYTES, stream);
    Args a{};
    for (int i = 0; i < 26; ++i) a.in[i] = (const float*)d_in[i];
    a.out = (float*)d_out; a.ws = (unsigned char*)d_ws;
#if MK_MULTI
    for (int ph = 0; ph < N_PHASES; ++ph) { a.ph_lo = ph; a.ph_hi = ph + 1; hipLaunchKernelGGL(mk_fwd, dim3(grid), dim3(512), LDS_BYTES, stream, a); }
#else
    a.ph_lo = 0; a.ph_hi = N_PHASES;
    void* kargs[] = {&a};
    hipError_t e = hipLaunchCooperativeKernel((const void*)mk_fwd, dim3(grid), dim3(512), kargs, LDS_BYTES, stream);
    if (e != hipSuccess) fprintf(stderr, "cooperative launch failed: %s (grid %d)\n", hipGetErrorString(e), grid);
#endif
}
```

```cpp
#include <hip/hip_runtime.h>
#include <hip/hip_cooperative_groups.h>
#include <cstdint>
#include <cstdio>
namespace cg = cooperative_groups;

#ifndef MK_PROBE
#define MK_PROBE 0
#endif
#ifndef MK_TPA
#define MK_TPA -1
#define MK_TPB -1
#endif
#ifndef MK_XA
#define MK_XA -1
#define MK_XB -1
#endif
#ifndef MK_GA
#define MK_GA -1
#define MK_GB -1
#endif
#ifndef MK_MULTI
#define MK_MULTI 0
#endif

#define LAS __attribute__((address_space(3)))
#define GAS __attribute__((address_space(1)))
typedef unsigned short bf16_t;
typedef short bf16x8 __attribute__((ext_vector_type(8)));
typedef float f32x4 __attribute__((ext_vector_type(4)));
typedef float f32x2 __attribute__((ext_vector_type(2)));
typedef unsigned u32x4 __attribute__((ext_vector_type(4)));
typedef unsigned u32x2 __attribute__((ext_vector_type(2)));

constexpr int D = 1024, BATCH = 2, SEQ = 8192, T = BATCH * SEQ, PLE = 256, ZW = 4096, ZE = 3072;
constexpr float QK_SCALE = 0.08838834764831845f;

__device__ __forceinline__ float bf2f(bf16_t v) { return __uint_as_float(((unsigned)v) << 16); }
__device__ __forceinline__ unsigned f2bf(float f) { unsigned u = __float_as_uint(f); return (u + 0x7fffu + ((u >> 16) & 1u)) >> 16; }
__device__ __forceinline__ unsigned pk2(float lo, float hi) { return f2bf(lo) | (f2bf(hi) << 16); }
typedef __bf16 bf16x2_t __attribute__((ext_vector_type(2)));
__device__ __forceinline__ unsigned cvt_pk_bf16(float lo, float hi) { f32x2 v = {lo, hi}; bf16x2_t b = __builtin_convertvector(v, bf16x2_t); return __builtin_bit_cast(unsigned, b); }
template <int CTRL> __device__ __forceinline__ float dpp_mov(float x) { return __builtin_bit_cast(float, __builtin_amdgcn_update_dpp(0, __builtin_bit_cast(int, x), CTRL, 0xf, 0xf, true)); }
__device__ __forceinline__ float red32(float x) { x += dpp_mov<0xB1>(x); x += dpp_mov<0x4E>(x); x += dpp_mov<0x141>(x); x += dpp_mov<0x140>(x);
    x += __builtin_bit_cast(float, __builtin_amdgcn_ds_swizzle(__builtin_bit_cast(int, x), 0x401F)); return x; }
__device__ __forceinline__ float wave_sum(float v) {
#pragma unroll
    for (int o = 1; o < 64; o <<= 1) v += __shfl_xor(v, o);
    return v;
}
__device__ __forceinline__ float sigmoidf_(float x) { return __builtin_amdgcn_rcpf(1.f + __expf(-x)); }
__device__ __forceinline__ float siluf_(float x) { return x * __builtin_amdgcn_rcpf(1.f + __expf(-x)); }
__device__ __forceinline__ float softplusf_(float x) { return x > 20.f ? x : log1pf(expf(x)); }
__device__ __forceinline__ float logsigf_(float x) { return -(x < -20.f ? -x : log1pf(expf(-x))); }
__device__ __forceinline__ float ssq_sum(const float* sq, int row) { const f32x4* p = (const f32x4*)(sq + (size_t)row * 16); const f32x4 a = p[0], b = p[1], c = p[2], d = p[3];
    return (((a[0] + a[1]) + (a[2] + a[3])) + ((b[0] + b[1]) + (b[2] + b[3]))) + (((c[0] + c[1]) + (c[2] + c[3])) + ((d[0] + d[1]) + (d[2] + d[3]))); }
#define LDS_WAIT() asm volatile("s_waitcnt lgkmcnt(0)" ::: "memory")
#define VM_WAIT() asm volatile("s_waitcnt vmcnt(0)" ::: "memory")

namespace pg8 {
constexpr int BM = 256, BK = 64, HALF = 128, HTB = HALF * BK * 2, STAGE_BYTES = 8 * HTB, NXCD = 8, WGM = 8;
__host__ __device__ __forceinline__ int lds_byte(int r, int c) { const int st = (r >> 4) * 2 + (c >> 5), rr = r & 15, cc = c & 31, ob = rr * 64 + cc * 2; return st * 1024 + (ob ^ (((ob >> 9) & 1) << 5)); }
__host__ __device__ __forceinline__ void stage_rc(int b, int& R, int& C) { const int st = b / 1024, sb = b % 1024, swz = sb ^ (((sb >> 9) & 1) << 5); R = (st >> 1) * 16 + swz / 64; C = (st & 1) * 32 + (swz % 64) / 2; }
__host__ __device__ __forceinline__ int perm32(int rho) { const int n = rho >> 4, i = rho & 15; return 8 * (i >> 2) + 4 * n + (i & 3); }
struct Unit { int pm, pn; };
struct Gemm { const bf16_t* A; const bf16_t* Bt; };
struct StaticOrder {
    int nM, nN, nwg, G, c;
    __device__ void init(int nM_, int nN_, int G_, int c_) { nM = nM_; nN = nN_; nwg = nM * nN; G = G_; c = c_; }
    __device__ bool next(int i, Unit& u) const {
        const long L = (long)i * G + c; if (L >= nwg) return false;
        int wgid = (int)L; { const int q = nwg / NXCD, r = nwg % NXCD, xcd = wgid % NXCD, off = wgid / NXCD; wgid = (xcd < r ? xcd * (q + 1) : r * (q + 1) + (xcd - r) * q) + off; }
        const int nig = WGM * nN, gid = wgid / nig, fm = gid * WGM, gsz = (nM - fm) < WGM ? (nM - fm) : WGM;
        u.pm = fm + ((wgid % nig) % gsz); u.pn = (wgid % nig) / gsz; return true;
    }
};
template <class Epi, bool ALIGN_EPI, int LDA, int KK, int TSPLIT, long ASHIFT, long BROW>
__device__ __forceinline__ void gemm_phase(LAS unsigned char* lds, const int tid_in, const Gemm g, const StaticOrder& S, const Epi& E) {
    int tid = tid_in; asm volatile("" : "+v"(tid));
    const int wid = __builtin_amdgcn_readfirstlane(tid >> 6), lane = tid & 63, wr = wid >> 2, wc = wid & 3, fr = lane & 15, fq = lane >> 4;
    constexpr int K = KK, nt = K / BK, lda = LDA, tsplit = TSPLIT; constexpr long ashift = ASHIFT;
    unsigned voffA[2], voffB[2];
#pragma unroll
    for (int i = 0; i < 2; ++i) { int R, C; stage_rc(tid * 16 + i * 8192, R, C); const int Rb = (R & ~31) + perm32(R & 31);
        voffA[i] = (unsigned)(R * lda + C) * 2u; voffB[i] = (unsigned)(Rb * K + C) * 2u; }
    constexpr size_t kstep = (size_t)(BK * 2);
    constexpr size_t hstepA = (size_t)HALF * lda * 2, hstepB = (size_t)HALF * K * 2, tstepA = 2 * hstepA, tstepB = 2 * hstepB;
    const unsigned ldsw = (unsigned)wid * 1024u;
    const int aoff = lds_byte(wr * 64 + fr, fq * 8), boff = lds_byte(wc * 32 + fr, fq * 8);
#define PG8_AP(base, tt) ((base) + (((tt) < tsplit) ? (long)(tt) * 128 : ashift + (long)((tt) - tsplit) * 128))
#define PG8_ABASE(u) ((const char*)g.A + (size_t)(u).pm * tstepA + ((BROW != 0 && (u).pm >= 32) ? BROW : 0))
#define PG8_SA(b, h) (((b) * 2 + (h)) * HTB)
#define PG8_SB(b, h) ((4 + (b) * 2 + (h)) * HTB)
#define PG8_STAGE(bufoff, gbase, voff) do { const char* _gb = (const char*)(gbase); asm volatile("" : "+s"(_gb)); _Pragma("unroll") for (int _i = 0; _i < 2; ++_i) \
        __builtin_amdgcn_global_load_lds((const unsigned*)(_gb + (voff)[_i]), (LAS unsigned*)(lds + (bufoff) + ldsw + _i * 8192), 16, 0, 0); } while (0)
#define PG8_LDA(dst, b, h) do { _Pragma("unroll") for (int m = 0; m < 4; ++m) _Pragma("unroll") for (int k = 0; k < 2; ++k) dst[m][k] = *(const LAS bf16x8*)(lds + PG8_SA(b, h) + aoff + m * 2048 + k * 1024); } while (0)
#define PG8_LDB(dst, b, h) do { _Pragma("unroll") for (int n = 0; n < 2; ++n) _Pragma("unroll") for (int k = 0; k < 2; ++k) dst[n][k] = *(const LAS bf16x8*)(lds + PG8_SB(b, h) + boff + n * 2048 + k * 1024); } while (0)
#define PG8_MMA(ai, bj, At, Bt) do { __builtin_amdgcn_s_setprio(1); _Pragma("unroll") for (int m = 0; m < 4; ++m) _Pragma("unroll") for (int n = 0; n < 2; ++n) _Pragma("unroll") for (int k = 0; k < 2; ++k) \
        acc[ai][bj][m][n] = __builtin_amdgcn_mfma_f32_16x16x32_bf16(Bt[n][k], At[m][k], acc[ai][bj][m][n], 0, 0, 0); __builtin_amdgcn_s_setprio(0); } while (0)
#define PG8_WAIT_V(n) asm volatile("s_waitcnt vmcnt(" #n ")" ::: "memory")
#define PG8_WAIT_L(n) asm volatile("s_waitcnt lgkmcnt(" #n ")" ::: "memory")
#define PG8_BAR __builtin_amdgcn_s_barrier()
#define LBAR() do { asm volatile("s_waitcnt lgkmcnt(0)" ::: "memory"); __builtin_amdgcn_s_barrier(); asm volatile("" ::: "memory"); } while (0)
#define PG8_SCHED __builtin_amdgcn_sched_barrier(0)
    Unit cur, nxt; int ui = 0;
    if (!S.next(0, cur)) return;
    f32x4 acc[2][2][4][2];
#pragma unroll
    for (int a = 0; a < 2; ++a)
#pragma unroll
        for (int b = 0; b < 2; ++b)
#pragma unroll
            for (int m = 0; m < 4; ++m)
#pragma unroll
                for (int n = 0; n < 2; ++n) acc[a][b][m][n] = (f32x4){0.f, 0.f, 0.f, 0.f};
    bf16x8 At[4][2], B0[2][2], B1[2][2];
    const char* cA = PG8_ABASE(cur); const char* cB = (const char*)g.Bt + (size_t)cur.pn * tstepB;
    {
        const char* a0 = PG8_AP(cA, 0); const char* a1 = PG8_AP(cA, 1);
        PG8_STAGE(PG8_SB(0, 0), cB, voffB); PG8_STAGE(PG8_SB(0, 1), cB + hstepB, voffB); PG8_STAGE(PG8_SA(0, 0), a0, voffA); PG8_STAGE(PG8_SA(0, 1), a0 + hstepA, voffA);
        if (wr == 1) PG8_BAR;
        PG8_WAIT_V(2); PG8_BAR;
        PG8_STAGE(PG8_SB(1, 0), cB + kstep, voffB); PG8_STAGE(PG8_SA(1, 0), a1, voffA); PG8_STAGE(PG8_SB(1, 1), cB + hstepB + kstep, voffB);
        PG8_WAIT_V(6); PG8_BAR;
    }
    for (;;) {
        const bool has_next = S.next(ui + 1, nxt);
        const char* nA = has_next ? PG8_ABASE(nxt) : cA; const char* nB = has_next ? (const char*)g.Bt + (size_t)nxt.pn * tstepB : cB;
        for (int t = 0; t < nt; t += 2) {
            const bool last = (t == nt - 2);
            const char* a1 = PG8_AP(cA, t + 1);
            const char* a2 = last ? PG8_AP(nA, 0) : PG8_AP(cA, t + 2); const char* b2 = last ? nB : cB + (size_t)(t + 2) * kstep;
            const char* a3 = last ? PG8_AP(nA, 1) : PG8_AP(cA, t + 3); const char* b3 = b2 + kstep;
            PG8_LDB(B0, 0, 0); PG8_LDB(B1, 0, 1); PG8_SCHED; PG8_LDA(At, 0, 0); PG8_STAGE(PG8_SA(1, 1), a1 + hstepA, voffA);
            PG8_WAIT_V(8); PG8_WAIT_L(0); PG8_BAR; PG8_MMA(0, 0, At, B0); PG8_MMA(0, 1, At, B1); PG8_BAR; PG8_SCHED;
            PG8_LDA(At, 0, 1); PG8_STAGE(PG8_SB(0, 0), b2, voffB); PG8_STAGE(PG8_SB(0, 1), b2 + hstepB, voffB); PG8_STAGE(PG8_SA(0, 0), a2, voffA);
            PG8_WAIT_V(8); PG8_WAIT_L(0); PG8_BAR; PG8_MMA(1, 0, At, B0); PG8_MMA(1, 1, At, B1); PG8_BAR; PG8_SCHED;
            PG8_LDB(B0, 1, 0); PG8_LDB(B1, 1, 1); PG8_SCHED; PG8_LDA(At, 1, 0); PG8_STAGE(PG8_SA(0, 1), a2 + hstepA, voffA);
            PG8_WAIT_V(8); PG8_WAIT_L(0); PG8_BAR; PG8_MMA(0, 0, At, B0); PG8_MMA(0, 1, At, B1); PG8_BAR; PG8_SCHED;
            PG8_LDA(At, 1, 1); PG8_STAGE(PG8_SB(1, 0), b3, voffB); PG8_STAGE(PG8_SB(1, 1), b3 + hstepB, voffB); PG8_STAGE(PG8_SA(1, 0), a3, voffA);
            PG8_WAIT_V(8); PG8_WAIT_L(0); PG8_BAR; PG8_MMA(1, 0, At, B0); PG8_MMA(1, 1, At, B1); PG8_BAR; PG8_SCHED;
        }
        if constexpr (ALIGN_EPI) { if (wr == 0) PG8_BAR; }
        E(acc, cur, wr, wc, fr, fq);
        if (!has_next) break;
#pragma unroll
        for (int a = 0; a < 2; ++a)
#pragma unroll
            for (int b = 0; b < 2; ++b)
#pragma unroll
                for (int m = 0; m < 4; ++m)
#pragma unroll
                    for (int n = 0; n < 2; ++n) acc[a][b][m][n] = (f32x4){0.f, 0.f, 0.f, 0.f};
        cur = nxt; cA = nA; cB = nB; ++ui;
        if constexpr (ALIGN_EPI) { if (wr == 1) PG8_BAR; }
    }
    PG8_WAIT_V(0);
    if constexpr (!ALIGN_EPI) { if (wr == 0) PG8_BAR; }
    PG8_BAR;
#undef PG8_AP
#undef PG8_ABASE
#undef PG8_SA
#undef PG8_SB
#undef PG8_STAGE
#undef PG8_LDA
#undef PG8_LDB
#undef PG8_MMA
#undef PG8_WAIT_V
#undef PG8_WAIT_L
#undef PG8_BAR
#undef PG8_SCHED
}
}

template <class Fn>
__device__ __forceinline__ void epi_for(const f32x4 (&acc)[2][2][4][2], const pg8::Unit& u, int wr, int wc, int fr, int fq, Fn fn) {
#pragma unroll
    for (int ai = 0; ai < 2; ++ai)
#pragma unroll
        for (int m = 0; m < 4; ++m) { const int row = u.pm * 256 + ai * 128 + wr * 64 + m * 16 + fr;
#pragma unroll
            for (int bj = 0; bj < 2; ++bj) { const int col = u.pn * 256 + bj * 128 + wc * 32 + 8 * fq; fn(row, col, acc[ai][bj][m][0], acc[ai][bj][m][1]); }
            if (m & 1) asm volatile("" ::: "memory"); }
}
__device__ __forceinline__ u32x4 pack8(f32x4 v0, f32x4 v1) { u32x4 w; w.x = cvt_pk_bf16(v0[0], v0[1]); w.y = cvt_pk_bf16(v0[2], v0[3]); w.z = cvt_pk_bf16(v1[0], v1[1]); w.w = cvt_pk_bf16(v1[2], v1[3]); return w; }

struct EpiEvenIn {
    bf16_t* Z; const float* ssq; bf16_t* VTa; bf16_t* VTb; bf16_t* KT; LAS unsigned char* spare;
    template <class ValFn>
    __device__ __forceinline__ void tstore(bf16_t* dst, const pg8::Unit& u, int wr, int wc, int fr, int fq, ValFn val) const {
        asm volatile("" : "+v"(fr), "+v"(fq));
        LAS bf16_t* tl = (LAS bf16_t*)(spare + (wr * 4 + wc) * 4032); const int lane = fq * 16 + fr;
#pragma unroll
        for (int ai = 0; ai < 2; ++ai)
#pragma unroll
            for (int bj = 0; bj < 2; ++bj) {
                const int row0 = u.pm * 256 + ai * 128 + wr * 64, cg0 = (u.pn * 256 + bj * 128 + wc * 32) & 511, b = row0 >> 13, t0 = row0 & (SEQ - 1);
#pragma unroll
                for (int half = 0; half < 2; ++half) {
#pragma unroll
                    for (int mm = 0; mm < 2; ++mm) { float o[8]; val(ai, 2 * half + mm, bj, o);
#pragma unroll
                        for (int j = 0; j < 8; ++j) tl[(8 * fq + j) * 32 + 16 * mm + fr] = (bf16_t)f2bf(o[j]); }
                    asm volatile("s_waitcnt lgkmcnt(0)" ::: "memory");
#pragma unroll
                    for (int r = 0; r < 2; ++r) { const int c = lane + 64 * r, d = c >> 2, part = c & 3; const u32x4 w = *(const LAS u32x4*)(tl + d * 32 + part * 8);
                        *(u32x4*)(dst + ((size_t)(b * 512 + cg0 + d)) * SEQ + t0 + 32 * half + 8 * part) = w; }
                    asm volatile("s_waitcnt lgkmcnt(0)" ::: "memory");
                }
            }
    }
    __device__ __forceinline__ void operator()(const f32x4 (&acc)[2][2][4][2], const pg8::Unit& u, int wr, int wc, int fr, int fq) const {
        const int g = u.pn >> 1;
        float rs8[8];
        { f32x4 pr[8];
#pragma unroll
          for (int it = 0; it < 8; ++it) pr[it] = *(const f32x4*)(ssq + (size_t)(u.pm * 256 + (it >> 2) * 128 + wr * 64 + (it & 3) * 16 + fr) * 16 + 4 * fq);
#pragma unroll
          for (int it = 0; it < 8; ++it) { float s_ = (pr[it][0] + pr[it][1]) + (pr[it][2] + pr[it][3]); s_ += __shfl_xor(s_, 16); s_ += __shfl_xor(s_, 32); rs8[it] = rsqrtf(s_ * (1.f / D) + 1e-6f); } }
        if (g == 2 || g == 6) {
            tstore(g == 2 ? VTa : VTb, u, wr, wc, fr, fq, [&](int ai, int m, int bj, float (&o)[8]) {
                const float rs = rs8[ai * 4 + m];
                const f32x4 v0 = acc[ai][bj][m][0] * rs, v1 = acc[ai][bj][m][1] * rs;
                o[0] = v0[0]; o[1] = v0[1]; o[2] = v0[2]; o[3] = v0[3]; o[4] = v1[0]; o[5] = v1[1]; o[6] = v1[2]; o[7] = v1[3]; });
            return;
        }
        if (g == 1) {
            tstore(KT, u, wr, wc, fr, fq, [&](int ai, int m, int bj, float (&o)[8]) {
                const int row = u.pm * 256 + ai * 128 + wr * 64 + m * 16 + fr, col = u.pn * 256 + bj * 128 + wc * 32 + 8 * fq; const float rs = rs8[ai * 4 + m];
                const f32x4 v0 = acc[ai][bj][m][0] * rs, v1 = acc[ai][bj][m][1] * rs; const int cg = col & 511, t = row & (SEQ - 1);
                const float pos = (float)t; const int i0 = (cg & 127) >> 1;
                float q[8] = {v0[0], v0[1], v0[2], v0[3], v1[0], v1[1], v1[2], v1[3]};
                _Pragma("unroll") for (int j = 0; j < 4; ++j) { const float inv = exp2f(-(float)(i0 + j) * (13.287712379549449f / 64.f));
                    float rev = pos * inv * 0.15915494309189535f; rev = rev - floorf(rev); const float sn = __builtin_amdgcn_sinf(rev), cs = __builtin_amdgcn_cosf(rev);
                    const float x1 = q[2 * j], x2 = q[2 * j + 1]; q[2 * j] = x1 * cs - x2 * sn; q[2 * j + 1] = x1 * sn + x2 * cs; }
                const float lg2 = log2f(1.f - exp2f(-5.f - (float)(cg >> 7))); const float ip1 = (float)((t & 127) + 1);
                const float f = exp2f(-ip1 * lg2), f2 = exp2f((128.f - ip1) * lg2);
                *(u32x4*)(Z + (size_t)row * ZE + 512 + cg) = pack8((f32x4){q[0] * f, q[1] * f, q[2] * f, q[3] * f}, (f32x4){q[4] * f, q[5] * f, q[6] * f, q[7] * f});
                _Pragma("unroll") for (int j = 0; j < 8; ++j) o[j] = q[j] * f2; });
            return;
        }
#pragma unroll
        for (int ai = 0; ai < 2; ++ai)
#pragma unroll
          for (int m = 0; m < 4; ++m) { const int row = u.pm * 256 + ai * 128 + wr * 64 + m * 16 + fr; const float rs = rs8[ai * 4 + m];
#pragma unroll
            for (int bj = 0; bj < 2; ++bj) { const int col = u.pn * 256 + bj * 128 + wc * 32 + 8 * fq; const f32x4 v0 = acc[ai][bj][m][0] * rs, v1 = acc[ai][bj][m][1] * rs;
            const int cg = col & 511, t = row & (SEQ - 1);
            if (g == 0) {
                const float pos = (float)t; const int i0 = (cg & 127) >> 1;
                float o[8] = {v0[0], v0[1], v0[2], v0[3], v1[0], v1[1], v1[2], v1[3]};
                _Pragma("unroll") for (int j = 0; j < 4; ++j) { const float inv = exp2f(-(float)(i0 + j) * (13.287712379549449f / 64.f));
                    float rev = pos * inv * 0.15915494309189535f; rev = rev - floorf(rev); const float sn = __builtin_amdgcn_sinf(rev), cs = __builtin_amdgcn_cosf(rev);
                    const float x1 = o[2 * j], x2 = o[2 * j + 1]; o[2 * j] = x1 * cs - x2 * sn; o[2 * j + 1] = x1 * sn + x2 * cs; }
                const float lg2 = log2f(1.f - exp2f(-5.f - (float)(cg >> 7))); const float ip1 = (float)((t & 127) + 1); const float f = exp2f(ip1 * lg2);
                *(u32x4*)(Z + (size_t)row * ZE + cg) = pack8((f32x4){o[0] * f, o[1] * f, o[2] * f, o[3] * f}, (f32x4){o[4] * f, o[5] * f, o[6] * f, o[7] * f});
            } else {
                const int zc = (g - 1 - (g > 6 ? 1 : 0)) * 512;
                *(u32x4*)(Z + (size_t)row * ZE + zc + cg) = pack8(v0, v1);
            }
            }
            if (m & 1) asm volatile("" ::: "memory"); }
    }
};
struct EpiOddIn {
    bf16_t* Z; bf16_t* L1;
    __device__ __forceinline__ void operator()(const f32x4 (&acc)[2][2][4][2], const pg8::Unit& u, int wr, int wc, int fr, int fq) const {
        if (u.pn < 16) { epi_for(acc, u, wr, wc, fr, fq, [&](int row, int col, f32x4 v0, f32x4 v1) { *(u32x4*)(Z + (size_t)row * ZW + col) = pack8(v0, v1); }); }
        else { epi_for(acc, u, wr, wc, fr, fq, [&](int row, int col, f32x4 v0, f32x4 v1) { const int c = col - 4096; if (c < 64) {
                    _Pragma("unroll") for (int j = 0; j < 4; ++j) { v0[j] = tanhf(v0[j]); v1[j] = tanhf(v1[j]); } }
                *(u32x4*)(L1 + (size_t)row * 256 + c) = pack8(v0, v1); }); }
    }
};
__device__ __forceinline__ void unpack8(const u32x4 w, f32x4& a, f32x4& b) {
    a = (f32x4){__uint_as_float(w.x << 16), __uint_as_float(w.x & 0xffff0000u), __uint_as_float(w.y << 16), __uint_as_float(w.y & 0xffff0000u)};
    b = (f32x4){__uint_as_float(w.z << 16), __uint_as_float(w.z & 0xffff0000u), __uint_as_float(w.w << 16), __uint_as_float(w.w & 0xffff0000u)}; }
struct EpiResid {
    const bf16_t* Ha; bf16_t* HB; int ldb;
    __device__ __forceinline__ void operator()(const f32x4 (&acc)[2][2][4][2], const pg8::Unit& u, int wr, int wc, int fr, int fq) const {
        u32x4 hq[3][2]; const int rowb = u.pm * 256 + wr * 64 + fr, colb = u.pn * 256 + wc * 32 + 8 * fq;
        auto ld = [&](int it, int sl) { const size_t row = rowb + (it >> 2) * 128 + (it & 3) * 16;
            _Pragma("unroll") for (int bj = 0; bj < 2; ++bj) hq[sl][bj] = *(const u32x4*)(Ha + row * D + colb + bj * 128); };
        ld(0, 0); ld(1, 1);
#pragma unroll
        for (int it = 0; it < 8; ++it) { if (it + 2 < 8) ld(it + 2, (it + 2) % 3);
            const int ai = it >> 2, m = it & 3; const size_t row = rowb + ai * 128 + m * 16;
#pragma unroll
            for (int bj = 0; bj < 2; ++bj) { f32x4 h0, h1; unpack8(hq[it % 3][bj], h0, h1); h0 = h0 + acc[ai][bj][m][0]; h1 = h1 + acc[ai][bj][m][1];
                *(u32x4*)(HB + row * ldb + colb + bj * 128) = pack8(h0, h1); }
            asm volatile("" ::: "memory"); }
    }
};
struct EpiStore {
    bf16_t* O; int ldc;
    __device__ __forceinline__ void operator()(const f32x4 (&acc)[2][2][4][2], const pg8::Unit& u, int wr, int wc, int fr, int fq) const {
        epi_for(acc, u, wr, wc, fr, fq, [&](int row, int col, f32x4 v0, f32x4 v1) { *(u32x4*)(O + (size_t)row * ldc + col) = pack8(v0, v1); });
    }
};
struct EpiGate {
    const bf16_t* Hb; int ldh; const bf16_t* PP; int ldp; bf16_t* Ha; float* ssq;
    __device__ __forceinline__ void operator()(const f32x4 (&acc)[2][2][4][2], const pg8::Unit& u, int wr, int wc, int fr, int fq) const {
        u32x4 hq[3][2], pq[3][2]; const int rowb = u.pm * 256 + wr * 64 + fr, colb = u.pn * 256 + wc * 32 + 8 * fq;
        auto ld = [&](int it, int sl) { const size_t row = rowb + (it >> 2) * 128 + (it & 3) * 16;
            _Pragma("unroll") for (int bj = 0; bj < 2; ++bj) { hq[sl][bj] = *(const u32x4*)(Hb + row * ldh + colb + bj * 128); pq[sl][bj] = *(const u32x4*)(PP + row * ldp + colb + bj * 128); } };
        ld(0, 0); ld(1, 1);
#pragma unroll
        for (int it = 0; it < 8; ++it) { if (it + 2 < 8) ld(it + 2, (it + 2) % 3);
            const int ai = it >> 2, m = it & 3; const size_t row = rowb + ai * 128 + m * 16; float sq = 0.f;
#pragma unroll
            for (int bj = 0; bj < 2; ++bj) { const f32x4 v0 = acc[ai][bj][m][0], v1 = acc[ai][bj][m][1];
                f32x4 h0, h1, p0, p1; unpack8(hq[it % 3][bj], h0, h1); unpack8(pq[it % 3][bj], p0, p1);
#pragma unroll
                for (int j = 0; j < 4; ++j) { h0[j] += sigmoidf_(v0[j]) * p0[j]; h1[j] += sigmoidf_(v1[j]) * p1[j]; sq += h0[j] * h0[j] + h1[j] * h1[j]; }
                *(u32x4*)(Ha + row * D + colb + bj * 128) = pack8(h0, h1); }
            sq += __shfl_xor(sq, 16); sq += __shfl_xor(sq, 32);
            if (fq == 0) ssq[row * 16 + u.pn * 4 + wc] = sq;
            asm volatile("" ::: "memory"); }
    }
};

#define XB_TMO      128
#define XB_XCNT(j)  (256  + 64 * (j))
#define XB_XSUB(j)  (1280 + 64 * (j))
#define XB_XGEN(j)  (2304 + 64 * (j))
#define XB_TOP      3328
#define XB_TOPGEN   3392
#define XCD_BAR_WORDS 3456
#define XB_SPIN_CAP (1u << 22)
__device__ __forceinline__ unsigned xb_ld(unsigned* p)              { return __hip_atomic_load(p, __ATOMIC_RELAXED, __HIP_MEMORY_SCOPE_AGENT); }
__device__ __forceinline__ unsigned xb_add(unsigned* p, unsigned v) { return __hip_atomic_fetch_add(p, v, __ATOMIC_RELAXED, __HIP_MEMORY_SCOPE_AGENT); }
__device__ __forceinline__ unsigned xb_xcc_id() { return (unsigned)__builtin_amdgcn_s_getreg((3 << 11) | 20) & 0xFu; }
#define XB_SPIN(cond, bar) do { unsigned _sp = 0; while (cond) { __builtin_amdgcn_s_sleep(1); \
    if ((++_sp & 255u) == 0u) { if (xb_ld(&(bar)[XB_TMO])) break; if (_sp > XB_SPIN_CAP) { atomicAdd(&(bar)[XB_TMO], 1u); break; } } } } while (0)
struct XcdBarrier { unsigned* bar; unsigned x; volatile LAS unsigned* st; };
__device__ __forceinline__ XcdBarrier xcd_barrier_post(unsigned* bar, volatile LAS unsigned* st) {
    XcdBarrier b; b.bar = bar; b.x = xb_xcc_id(); b.st = st;
    if (threadIdx.x == 0) (void)xb_add(&bar[XB_XCNT(b.x)], 1u);
    return b;
}
__device__ __forceinline__ void xcd_barrier_complete(unsigned* bar, unsigned x, unsigned& nloc, unsigned& nx) {
    const unsigned G = gridDim.x * gridDim.y * gridDim.z;
    unsigned sum, cnt, mine, sp = 0u;
    for (;;) {
        sum = 0u; cnt = 0u; mine = 0u;
#pragma unroll
        for (unsigned j = 0; j < 16; ++j) { const unsigned c = xb_ld(&bar[XB_XCNT(j)]); sum += c; cnt += (c > 0u) ? 1u : 0u; mine = (j == x) ? c : mine; }
        if (sum == G) break;
        __builtin_amdgcn_s_sleep(1);
        if ((++sp & 255u) == 0u) { if (xb_ld(&bar[XB_TMO])) break; if (sp > XB_SPIN_CAP) { atomicAdd(&bar[XB_TMO], 1u); break; } }
    }
    nloc = mine > 0u ? mine : 1u; nx = cnt > 0u ? cnt : 1u;
}
__device__ __forceinline__ void xcd_barrier(const XcdBarrier& b_in) {
    asm volatile("s_waitcnt vmcnt(0)" ::: "memory");
    __syncthreads();
    if (threadIdx.x == 0) {
        const XcdBarrier& b = b_in;
        unsigned* bar = b.bar;
        __builtin_amdgcn_s_waitcnt(0);
        unsigned nloc = b.st[0], nx = b.st[1];
        if (nloc == 0u) { xcd_barrier_complete(bar, b.x, nloc, nx); b.st[0] = nloc; b.st[1] = nx; }
        const unsigned old = xb_add(&bar[XB_XSUB(b.x)], 1u);
        const unsigned gen = old / nloc;
        if (old + 1u == (gen + 1u) * nloc) {
            __builtin_amdgcn_fence(__ATOMIC_RELEASE, "agent");
            asm volatile("s_waitcnt vmcnt(0)" ::: "memory");
            const unsigned og = xb_add(&bar[XB_TOP], 1u);
            const unsigned tg = og / nx;
            if (og + 1u == (tg + 1u) * nx) xb_add(&bar[XB_TOPGEN], 1u);
            else XB_SPIN(xb_ld(&bar[XB_TOPGEN]) == tg, bar);
            __builtin_amdgcn_fence(__ATOMIC_ACQUIRE, "agent");
            xb_add(&bar[XB_XGEN(b.x)], 1u);
            asm volatile("s_waitcnt vmcnt(0)" ::: "memory");
        } else {
            XB_SPIN(xb_ld(&bar[XB_XGEN(b.x)]) == gen, bar);
            __builtin_amdgcn_fence(__ATOMIC_ACQUIRE, "agent");
            asm volatile("s_waitcnt vmcnt(0)" ::: "memory");
        }
    }
    __syncthreads();
}

constexpr size_t MiB = 1u << 20;
constexpr size_t WS_CTL = 0, CTL_BYTES = 1 * MiB;
constexpr size_t WS_SSQ = 241 * (size_t)(1u << 20);
constexpr size_t WS_WIN = 2 * MiB;
constexpr size_t WS_WOUT = 19 * MiB, WS_WGATE = 21 * MiB, WS_WPROJ = 23 * MiB;
constexpr size_t WS_PB = 24 * MiB;
constexpr size_t WS_Z = 32 * MiB;
constexpr size_t WS_HB = 160 * MiB;
constexpr size_t WS_VF = 193 * MiB;
constexpr size_t WS_L1 = 225 * MiB;
constexpr size_t WS_VTA = 128 * MiB;
constexpr size_t WS_VTB = 144 * MiB;
constexpr size_t WS_KT = 225 * MiB;
constexpr size_t WS_LORA2 = 23 * MiB + 512 * 1024;
constexpr size_t WS_PG = 160 * MiB;
constexpr size_t WS_SB = 2 * MiB;
constexpr size_t WS_BON = 233 * MiB;
constexpr size_t WS_ST = 176 * MiB;
constexpr size_t WS_KV = 160 * MiB;
constexpr size_t WS_END = 256 * MiB;

constexpr int RING_BYTES = 131072, LDS_BYTES = 163840, MISC_OFF = LDS_BYTES - 512;

struct Args { const float* in[26]; float* out; unsigned char* ws; int ph_lo, ph_hi; };

__device__ __forceinline__ const float* inptr(int i) { asm volatile("" : "+s"(i)); const char* ka = (const char*)__builtin_amdgcn_kernarg_segment_ptr(); return *(const float* const*)(ka + 8 * i); }
struct InTab { __device__ __forceinline__ const float* operator[](int i) const { return inptr(i); } };
struct Frame {
    LAS unsigned char* lds; unsigned char* ldsg;
    int tid, lane, wave, G, vcu;
    InTab in; float* H; unsigned char* ws;
    __device__ __forceinline__ void retid() { int l; asm volatile("v_mbcnt_lo_u32_b32 %0, -1, 0\n\tv_mbcnt_hi_u32_b32 %0, -1, %0" : "=v"(l)); lane = l; tid = wave * 64 + l; }
    __device__ __forceinline__ float* ssq(int l) const { return (float*)(ws + WS_SSQ) + (size_t)l * T * 16; }
};

__device__ __forceinline__ void conv_item(const float* W, int ldw, int Kmax, int k0, int n0, bf16_t* dst, int ldd, int dr0, int drs, int dk0,
                                          const float* svec, float sa, float sb, float sc, LAS float* scr, int lane) {
    float wv[32];
#pragma unroll
    for (int i = 0; i < 32; ++i) { const int k = k0 + 2 * i + (lane >> 5); wv[i] = (k < Kmax) ? W[(size_t)k * ldw + n0 + (lane & 31)] : 0.f; }
#pragma unroll
    for (int i = 0; i < 32; ++i) { const int kk = 2 * i + (lane >> 5), k = k0 + kk; const float f = (k < Kmax) ? (sa + sb * (svec ? svec[k] : 0.f)) * sc : 0.f;
        scr[kk * 33 + (lane & 31)] = wv[i] * f; }
    LDS_WAIT(); asm volatile("" ::: "memory");
    const int c = lane & 7;
    if (k0 + 8 * c < Kmax) {
#pragma unroll
        for (int j = 0; j < 4; ++j) { const int n = (lane >> 3) + 8 * j; const LAS float* s = scr + (8 * c) * 33 + n;
            u32x4 o; o.x = pk2(s[0 * 33], s[1 * 33]); o.y = pk2(s[2 * 33], s[3 * 33]); o.z = pk2(s[4 * 33], s[5 * 33]); o.w = pk2(s[6 * 33], s[7 * 33]);
            *(GAS u32x4*)(dst + (size_t)(dr0 + n * drs) * ldd + dk0 + k0 + 8 * c) = o; }
    }
    LDS_WAIT(); asm volatile("" ::: "memory");
}
__device__ __forceinline__ void conv_item2(const float* W, int ldw, int k0, int n0, bf16_t* dst, int dr0, const float* mu, float sc, LAS float* scr, int lane) {
    float wv[32];
#pragma unroll
    for (int i = 0; i < 32; ++i) wv[i] = W[(size_t)(k0 + 2 * i + (lane >> 5)) * ldw + n0 + (lane & 31)];
#pragma unroll
    for (int half = 0; half < 2; ++half) {
#pragma unroll
        for (int i = 0; i < 32; ++i) { const int kk = 2 * i + (lane >> 5); const float m = mu[k0 + kk]; scr[kk * 33 + (lane & 31)] = wv[i] * ((half ? m : 1.f - m) * sc); }
        LDS_WAIT(); asm volatile("" ::: "memory");
        const int c = lane & 7;
#pragma unroll
        for (int j = 0; j < 4; ++j) { const int n = (lane >> 3) + 8 * j; const LAS float* s_ = scr + (8 * c) * 33 + n;
            u32x4 o; o.x = pk2(s_[0 * 33], s_[1 * 33]); o.y = pk2(s_[2 * 33], s_[3 * 33]); o.z = pk2(s_[4 * 33], s_[5 * 33]); o.w = pk2(s_[6 * 33], s_[7 * 33]);
            *(GAS u32x4*)(dst + (size_t)(dr0 + n) * 2048 + half * 1024 + k0 + 8 * c) = o; }
        LDS_WAIT(); asm volatile("" ::: "memory");
    }
}
__device__ __forceinline__ void conv_win_even(Frame& F, int li) {
    const int e = li >> 1; const float* W = F.in[6] + (size_t)e * D * ZW; const float* gain = F.in[2] + li * D; bf16_t* dst = (bf16_t*)(F.ws + WS_WIN);
    LAS float* scr = (LAS float*)(F.lds + F.wave * 16384);
    const int gw = F.vcu * 8 + F.wave, NGW = F.G * 8;
    for (int it = gw; it < 16 * 128; it += NGW) { const int kb = it >> 7, nb = it & 127, n0 = nb * 32, g = n0 >> 9, hh = (n0 & 511) >> 7, d0 = n0 & 127;
        int dr0 = n0, drs = 1; if (g < 2) { dr0 = g * 512 + hh * 128 + (d0 < 64 ? 2 * d0 : 2 * (d0 - 64) + 1); drs = 2; }
        const float sc = (g == 1 || g == 5) ? QK_SCALE : 1.f;
        conv_item(W, ZW, D, kb * 64, n0, dst, D, dr0, drs, 0, gain, 0.f, 1.f, sc, scr, F.lane); }
}
__device__ __forceinline__ void conv_win_odd(Frame& F, int li) {
    const int o = li >> 1; const float* mu = F.in[9] + (size_t)o * 6 * D; bf16_t* dst = (bf16_t*)(F.ws + WS_WIN);
    LAS float* scr = (LAS float*)(F.lds + F.wave * 16384);
    const int gw = F.vcu * 8 + F.wave, NGW = F.G * 8;
    for (int it = gw; it < 4 * 512; it += NGW) { const int p = it >> 9, r = it & 511, kb = r >> 5, nb = r & 31;
        conv_item2(F.in[10] + ((size_t)o * 4 + p) * D * D, D, kb * 64, nb * 32, dst, p * 1024 + nb * 32, mu + p * D, 1.f, scr, F.lane); }
    for (int it = gw; it < 32 + 32 + 16; it += NGW) { const float* W; int ldw, n0, dr0, mi, kb; const int r = it;
        if (r < 32) { W = F.in[13] + (size_t)o * D * 64; ldw = 64; kb = r >> 1; n0 = (r & 1) * 32; dr0 = 4096 + n0; mi = 4; }
        else if (r < 64) { const int q = r - 32; W = F.in[16] + (size_t)o * D * 64; ldw = 64; kb = q >> 1; n0 = (q & 1) * 32; dr0 = 4160 + n0; mi = 5; }
        else { const int q = r - 64; W = F.in[19]; ldw = 32; kb = q; n0 = 0; dr0 = 4224; mi = 2; }
        conv_item2(W, ldw, kb * 64, n0, dst, dr0, mu + mi * D, (r >= 64 && o == 0) ? 0.f : 1.f, scr, F.lane); }
    { u32x4 z = {0u, 0u, 0u, 0u}; GAS u32x4* zp = (GAS u32x4*)(dst + (size_t)4256 * 2048); const int n16 = 96 * 2048 * 2 / 16;
      for (int i = (F.vcu * 512 + F.tid); i < n16; i += F.G * 512) zp[i] = z; }
}
__device__ __forceinline__ void conv_wrest_a(Frame& F, int li) {
    const float* Wp = F.in[4] + (size_t)li * PLE * D;
    LAS float* scr = (LAS float*)(F.lds + F.wave * 16384);
    const int gw = F.vcu * 8 + F.wave, NGW = F.G * 8;
    for (int r = gw; r < 128; r += NGW) conv_item(Wp, D, PLE, (r >> 5) * 64, (r & 31) * 32, (bf16_t*)(F.ws + WS_WPROJ), PLE, (r & 31) * 32, 1, 0, nullptr, 1.f, 0.f, 1.f, scr, F.lane);
    const float* P = F.in[1] + (size_t)li * T * PLE; GAS u32x4* pb = (GAS u32x4*)(F.ws + WS_PB); const int n8 = T * PLE / 8;
    const int stp = F.G * 512;
    for (int i0 = F.vcu * 512 + F.tid; i0 < n8; i0 += 4 * stp) { f32x4 a[4], b[4];
#pragma unroll
        for (int j = 0; j < 4; ++j) { const int i = min(i0 + j * stp, n8 - 1); a[j] = *(const f32x4*)(P + (size_t)i * 8); b[j] = *(const f32x4*)(P + (size_t)i * 8 + 4); }
#pragma unroll
        for (int j = 0; j < 4; ++j) { const int i = i0 + j * stp;
            u32x4 o; o.x = cvt_pk_bf16(a[j][0], a[j][1]); o.y = cvt_pk_bf16(a[j][2], a[j][3]); o.z = cvt_pk_bf16(b[j][0], b[j][1]); o.w = cvt_pk_bf16(b[j][2], b[j][3]); if (i < n8) pb[i] = o; } }
}
__device__ __forceinline__ void conv_wrest_b(Frame& F, int li, int widx, int nw) {
    const bool even = (li & 1) == 0; const int e = li >> 1;
    const float* Wo = even ? F.in[7] + (size_t)e * D * D : F.in[11] + (size_t)e * D * D; const float* Wg = F.in[5] + (size_t)li * D * D;
    LAS float* scr = (LAS float*)(F.lds + F.wave * 16384);
    for (int it = widx * 8 + F.wave; it < 1024; it += nw * 8) {
        if (it < 512) conv_item(Wo, D, D, (it >> 5) * 64, (it & 31) * 32, (bf16_t*)(F.ws + WS_WOUT), D, (it & 31) * 32, 1, 0, nullptr, 1.f, 0.f, 1.f, scr, F.lane);
        else { const int r = it - 512; conv_item(Wg, D, D, (r >> 5) * 64, (r & 31) * 32, (bf16_t*)(F.ws + WS_WGATE), D, (r & 31) * 32, 1, 0, nullptr, 1.f, 0.f, 1.f, scr, F.lane); }
    }
}
__device__ __forceinline__ void conv_lora2(Frame& F, int li) {
    const int o = li >> 1; LAS float* scr = (LAS float*)(F.lds + F.wave * 16384);
    bf16_t* W2T = (bf16_t*)(F.ws + WS_LORA2); bf16_t* A2T = W2T + 1024 * 64; bf16_t* V2T = A2T + 1024 * 64;
    const int gw = F.vcu * 8 + F.wave, NGW = F.G * 8;
    for (int it = gw; it < 96; it += NGW) {
        if (it < 32) conv_item(F.in[14] + (size_t)o * 64 * D, D, 64, 0, it * 32, W2T, 64, it * 32, 1, 0, nullptr, 1.f, 0.f, 1.f, scr, F.lane);
        else if (it < 64) conv_item(F.in[17] + (size_t)o * 64 * D, D, 64, 0, (it - 32) * 32, A2T, 64, (it - 32) * 32, 1, 0, nullptr, 1.f, 0.f, 1.f, scr, F.lane);
        else conv_item(F.in[20], D, 32, 0, (it - 64) * 32, V2T, 32, (it - 64) * 32, 1, 0, nullptr, 1.f, 0.f, 1.f, scr, F.lane);
    }
}
__device__ __forceinline__ void rows_p0(Frame& F) {
    const float* x = F.in[0]; bf16_t* HB = (bf16_t*)(F.ws + WS_HB); float* s0 = F.ssq(0);
    for (int row = F.vcu * 8 + F.wave; row < T; row += F.G * 8) {
        const f32x4* xr = (const f32x4*)(x + (size_t)row * D) + F.lane; u32x2* br = (u32x2*)(HB + (size_t)row * D) + F.lane; float s = 0.f;
#pragma unroll
        for (int j = 0; j < 4; ++j) { const f32x4 v = xr[64 * j]; s += (v[0] * v[0] + v[1] * v[1]) + (v[2] * v[2] + v[3] * v[3]); u32x2 w; w.x = pk2(v[0], v[1]); w.y = pk2(v[2], v[3]); br[64 * j] = w; }
        s = wave_sum(s); if (F.lane < 16) s0[(size_t)row * 16 + F.lane] = F.lane == 0 ? s : 0.f;
    }
}
__device__ __forceinline__ void rows_norm(Frame& F, int li) {
    const float* gain = F.in[2] + li * D; bf16_t* HN = (bf16_t*)(F.H); const bf16_t* Ha = (const bf16_t*)(F.ws + WS_HB); const float* sq = F.ssq(li);
    f32x4 g[4];
#pragma unroll
    for (int j = 0; j < 4; ++j) g[j] = *((const f32x4*)gain + F.lane + 64 * j);
    for (int row = F.vcu * 8 + F.wave; row < T; row += F.G * 8) {
        const u32x2* hr = (const u32x2*)(Ha + (size_t)row * D) + F.lane; u32x2* br = (u32x2*)(HN + (size_t)(row + 1 + (row >= SEQ ? 1 : 0)) * D) + F.lane;
        const float rs = rsqrtf(ssq_sum(sq, row) * (1.f / D) + 1e-6f);
#pragma unroll
        for (int j = 0; j < 4; ++j) { const u32x2 hw = hr[64 * j]; const f32x4 h4 = {__uint_as_float(hw.x << 16), __uint_as_float(hw.x & 0xffff0000u), __uint_as_float(hw.y << 16), __uint_as_float(hw.y & 0xffff0000u)};
            const f32x4 v = h4 * rs * g[j]; u32x2 w; w.x = pk2(v[0], v[1]); w.y = pk2(v[2], v[3]); br[64 * j] = w; }
    }
    if (F.vcu == 0 && F.wave < 2) { u32x2* br = (u32x2*)(HN + (size_t)(F.wave ? SEQ + 1 : 0) * D) + F.lane; u32x2 z = {0u, 0u};
#pragma unroll
        for (int j = 0; j < 4; ++j) br[64 * j] = z; }
}
__device__ __forceinline__ void rows_final(Frame& F) {
    const float* gain = F.in[3]; const float* sq = F.ssq(4); const bf16_t* Ha = (const bf16_t*)(F.ws + WS_HB);
    f32x4 g[4];
#pragma unroll
    for (int j = 0; j < 4; ++j) g[j] = *((const f32x4*)gain + F.lane + 64 * j);
    for (int row = F.vcu * 8 + F.wave; row < T; row += F.G * 8) {
        const u32x2* hr = (const u32x2*)(Ha + (size_t)row * D) + F.lane; f32x4* orow = (f32x4*)(F.H + (size_t)row * D) + F.lane; const float rs = rsqrtf(ssq_sum(sq, row) * (1.f / D) + 1e-6f);
#pragma unroll
        for (int j = 0; j < 4; ++j) { const u32x2 hw = hr[64 * j]; const f32x4 h4 = {__uint_as_float(hw.x << 16), __uint_as_float(hw.x & 0xffff0000u), __uint_as_float(hw.y << 16), __uint_as_float(hw.y & 0xffff0000u)};
            orow[64 * j] = h4 * rs * g[j]; }
    }
}

typedef float f32x16 __attribute__((ext_vector_type(16)));
template <bool DUMMY>
__device__ __forceinline__ void sb_unit(Frame& F, int bh, int qb) {
    const int lane = F.lane, l31 = lane & 31, hi = lane >> 5, b = bh >> 2, h = bh & 3;
    bf16_t* Z = (bf16_t*)(F.ws + WS_Z); const bf16_t* VT = (const bf16_t*)(F.ws + WS_VTB) + (size_t)bh * 128 * SEQ;
    const size_t rowb = (size_t)b * SEQ; const int q0 = qb * 32, tq = q0 + l31;
    bf16x8 qr[8];
    { const bf16_t* qp = Z + (rowb + tq) * ZE + 1536 + h * 128 + hi * 8;
#pragma unroll
      for (int ks = 0; ks < 8; ++ks) qr[ks] = *(const bf16x8*)(qp + 16 * ks); }
    f32x16 o[4];
#pragma unroll
    for (int d = 0; d < 4; ++d)
#pragma unroll
        for (int r = 0; r < 16; ++r) o[d][r] = 0.f;
    float carry = 1.f;
    const int pi = 16 * ((l31 >> 2) & 1) + (l31 & 3) + 4 * (l31 >> 3);
    const bf16_t* Kb = Z + rowb * ZE + 2048 + h * 128 + hi * 8;
    for (int kt = (q0 + 31) >> 6; kt >= 0; --kt) {
        const int kbase = kt * 64;
        const bf16_t* kp0 = Kb + (size_t)(kbase + pi) * ZE; const bf16_t* kp1 = kp0 + (size_t)32 * ZE;
        f32x16 p0, p1;
#pragma unroll
        for (int r = 0; r < 16; ++r) { p0[r] = 0.f; p1[r] = 0.f; }
#pragma unroll
        for (int ks = 0; ks < 8; ++ks) { const bf16x8 a0 = *(const bf16x8*)(kp0 + 16 * ks), a1 = *(const bf16x8*)(kp1 + 16 * ks);
            p0 = __builtin_amdgcn_mfma_f32_32x32x16_bf16(a0, qr[ks], p0, 0, 0, 0); p1 = __builtin_amdgcn_mfma_f32_32x32x16_bf16(a1, qr[ks], p1, 0, 0, 0); }
        float f1 = 1.f, f0 = 1.f;
        const int k1 = kbase + 32 + 16 * hi, k0 = kbase + 16 * hi;
#pragma unroll
        for (int r = 15; r >= 0; --r) { const float z = fminf(p1[r], 80.f); const float e = exp2f(z * 1.4426950408889634f); float rd = __builtin_amdgcn_rcpf(1.f + e); float be = e * rd;
            const bool valid = (k1 + r) < tq; be = valid ? be : 0.f; rd = valid ? rd : 1.f; p1[r] = be * f1; f1 *= rd; }
#pragma unroll
        for (int r = 15; r >= 0; --r) { const float z = fminf(p0[r], 80.f); const float e = exp2f(z * 1.4426950408889634f); float rd = __builtin_amdgcn_rcpf(1.f + e); float be = e * rd;
            const bool valid = (k0 + r) < tq; be = valid ? be : 0.f; rd = valid ? rd : 1.f; p0[r] = be * f0; f0 *= rd; }
        const float pf0 = __shfl_xor(f0, 32), pf1 = __shfl_xor(f1, 32);
        const float tail1 = hi ? 1.f : pf1;
        const float tail0 = hi ? (pf1 * f1) : (pf0 * f1 * pf1);
        const float s1 = tail1 * carry, s0 = tail0 * carry;
        carry *= (f0 * f1) * (pf0 * pf1);
        u32x4 pa[2][2];
#pragma unroll
        for (int s = 0; s < 2; ++s) {
            pa[0][s].x = cvt_pk_bf16(p0[8 * s + 0] * s0, p0[8 * s + 1] * s0); pa[0][s].y = cvt_pk_bf16(p0[8 * s + 2] * s0, p0[8 * s + 3] * s0);
            pa[0][s].z = cvt_pk_bf16(p0[8 * s + 4] * s0, p0[8 * s + 5] * s0); pa[0][s].w = cvt_pk_bf16(p0[8 * s + 6] * s0, p0[8 * s + 7] * s0);
            pa[1][s].x = cvt_pk_bf16(p1[8 * s + 0] * s1, p1[8 * s + 1] * s1); pa[1][s].y = cvt_pk_bf16(p1[8 * s + 2] * s1, p1[8 * s + 3] * s1);
            pa[1][s].z = cvt_pk_bf16(p1[8 * s + 4] * s1, p1[8 * s + 5] * s1); pa[1][s].w = cvt_pk_bf16(p1[8 * s + 6] * s1, p1[8 * s + 7] * s1);
        }
        const bf16_t* vp = VT + (size_t)l31 * SEQ + kbase + 16 * hi;
#pragma unroll
        for (int d = 0; d < 4; ++d)
#pragma unroll
            for (int blk = 0; blk < 2; ++blk)
#pragma unroll
                for (int s = 0; s < 2; ++s) { const bf16x8 vb = *(const bf16x8*)(vp + (size_t)(32 * d) * SEQ + 32 * blk + 8 * s);
                    o[d] = __builtin_amdgcn_mfma_f32_32x32x16_bf16(__builtin_bit_cast(bf16x8, pa[blk][s]), vb, o[d], 0, 0, 0); }
        if (__all(carry < 7.9e-31f)) break;
    }
#pragma unroll
    for (int r = 0; r < 16; ++r) { const int qrow = q0 + (r & 3) + 8 * (r >> 2) + 4 * hi; bf16_t* gp = Z + (rowb + qrow) * ZE + 2560 + h * 128 + l31;
#pragma unroll
        for (int d = 0; d < 4; ++d) { const float g = bf2f(gp[32 * d]); const float ov = o[d][r] * siluf_(g); if (!DUMMY) gp[32 * d] = (bf16_t)f2bf(ov); else asm volatile("" :: "v"(ov)); } }
}
__device__ __forceinline__ void ret_stage_a(Frame& F, int u) {
    const int l31 = F.lane & 31, hi = F.lane >> 5, cu = u >> 3, w8 = u & 7, bh = cu & 7, n = cu >> 3, dvb = w8 >> 1, dkp = w8 & 1;
    const bf16_t* vt = (const bf16_t*)(F.ws + WS_VTA) + ((size_t)(bh * 128 + 32 * dvb + l31)) * SEQ + n * 128 + 8 * hi;
    const bf16_t* kt = (const bf16_t*)(F.ws + WS_KT) + ((size_t)(bh * 128 + 64 * dkp + l31)) * SEQ + n * 128 + 8 * hi;
    f32x16 a0, a1;
#pragma unroll
    for (int r = 0; r < 16; ++r) { a0[r] = 0.f; a1[r] = 0.f; }
#pragma unroll
    for (int ks = 0; ks < 8; ++ks) { const bf16x8 va = *(const bf16x8*)(vt + 16 * ks), k0 = *(const bf16x8*)(kt + 16 * ks), k1 = *(const bf16x8*)(kt + (size_t)32 * SEQ + 16 * ks);
        a0 = __builtin_amdgcn_mfma_f32_32x32x16_bf16(va, k0, a0, 0, 0, 0); a1 = __builtin_amdgcn_mfma_f32_32x32x16_bf16(va, k1, a1, 0, 0, 0); }
    bf16_t* kv = (bf16_t*)(F.H) + ((size_t)cu * 128 + 32 * dvb) * 128 + 64 * dkp + l31;
#pragma unroll
    for (int r = 0; r < 16; ++r) { const int dv = (r & 3) + 8 * (r >> 2) + 4 * hi; kv[dv * 128] = (bf16_t)f2bf(a0[r]); kv[dv * 128 + 32] = (bf16_t)f2bf(a1[r]); }
}
__device__ __forceinline__ void ret_stage_b(Frame& F) {
    const int e = F.vcu * 512 + F.tid; if (e >= 8 * 128 * 128) return;
    const int h = (e >> 14) & 3; const float g128 = exp2f(128.f * log2f(1.f - exp2f(-5.f - (float)h)));
    const bf16_t* p = (const bf16_t*)(F.H) + e; bf16_t* q = (bf16_t*)(F.H) + (size_t)8 * 1024 * 1024 + e; float S = 0.f;
#pragma unroll 4
    for (int n = 0; n < 64; ++n) { const float kv = bf2f(p[(size_t)n * 131072]); q[(size_t)n * 131072] = (bf16_t)f2bf(S); S = S * g128 + kv; }
}
template <bool DUMMY>
__device__ __forceinline__ void ret_stage_c(Frame& F, int u, const float* gng) {
    const int lane = F.lane, l31 = lane & 31, hi = lane >> 5, cu = u >> 2, qblk = u & 3, bh = cu & 7, n = cu >> 3, b = bh >> 2, h = bh & 3;
    bf16_t* Z = (bf16_t*)(F.ws + WS_Z); const size_t rowb = (size_t)b * SEQ; const int t0 = n * 128, tq = t0 + 32 * qblk + l31;
    bf16x8 qr[8];
    { const bf16_t* qp = Z + (rowb + tq) * ZE + h * 128 + hi * 8;
#pragma unroll
      for (int ks = 0; ks < 8; ++ks) qr[ks] = *(const bf16x8*)(qp + 16 * ks); }
    f32x16 o[4];
#pragma unroll
    for (int d = 0; d < 4; ++d)
#pragma unroll
        for (int r = 0; r < 16; ++r) o[d][r] = 0.f;
    { const bf16_t* sp = (const bf16_t*)(F.H) + (size_t)8 * 1024 * 1024 + ((size_t)cu * 128 + l31) * 128 + 8 * hi;
#pragma unroll
      for (int ks = 0; ks < 8; ++ks)
#pragma unroll
          for (int d = 0; d < 4; ++d) { const bf16x8 sb = *(const bf16x8*)(sp + (size_t)(32 * d) * 128 + 16 * ks); o[d] = __builtin_amdgcn_mfma_f32_32x32x16_bf16(qr[ks], sb, o[d], 0, 0, 0); } }
    const int pi = 16 * ((l31 >> 2) & 1) + (l31 & 3) + 4 * (l31 >> 3);
    const bf16_t* Kb = Z + rowb * ZE + 512 + h * 128 + hi * 8;
    const bf16_t* VT = (const bf16_t*)(F.ws + WS_VTA) + ((size_t)(bh * 128 + l31)) * SEQ + 16 * hi;
    for (int kb = 0; kb <= qblk; ++kb) {
        const int kbase = t0 + 32 * kb; const bf16_t* kp = Kb + (size_t)(kbase + pi) * ZE;
        f32x16 p;
#pragma unroll
        for (int r = 0; r < 16; ++r) p[r] = 0.f;
#pragma unroll
        for (int ks = 0; ks < 8; ++ks) { const bf16x8 a = *(const bf16x8*)(kp + 16 * ks); p = __builtin_amdgcn_mfma_f32_32x32x16_bf16(a, qr[ks], p, 0, 0, 0); }
        if (kb == qblk) {
#pragma unroll
            for (int r = 0; r < 16; ++r) p[r] = (kbase + 16 * hi + r <= tq) ? p[r] : 0.f; }
        u32x4 pa[2];
#pragma unroll
        for (int s = 0; s < 2; ++s) { pa[s].x = cvt_pk_bf16(p[8 * s], p[8 * s + 1]); pa[s].y = cvt_pk_bf16(p[8 * s + 2], p[8 * s + 3]); pa[s].z = cvt_pk_bf16(p[8 * s + 4], p[8 * s + 5]); pa[s].w = cvt_pk_bf16(p[8 * s + 6], p[8 * s + 7]); }
#pragma unroll
        for (int d = 0; d < 4; ++d)
#pragma unroll
            for (int s = 0; s < 2; ++s) { const bf16x8 vb = *(const bf16x8*)(VT + (size_t)(32 * d) * SEQ + kbase + 8 * s);
                o[d] = __builtin_amdgcn_mfma_f32_32x32x16_bf16(__builtin_bit_cast(bf16x8, pa[s]), vb, o[d], 0, 0, 0); }
    }
    float gg[4];
#pragma unroll
    for (int d = 0; d < 4; ++d) gg[d] = gng[h * 128 + 32 * d + l31];
#pragma unroll
    for (int r = 0; r < 16; ++r) {
        float sm = (o[0][r] + o[1][r]) + (o[2][r] + o[3][r]);
        sm = red32(sm);
        const float mu = sm * (1.f / 128.f); float q = 0.f;
#pragma unroll
        for (int d = 0; d < 4; ++d) { const float dd = o[d][r] - mu; q += dd * dd; }
        q = red32(q);
        const float rsd = rsqrtf(q * (1.f / 128.f) + 1e-5f);
        const int qrow = t0 + 32 * qblk + (r & 3) + 8 * (r >> 2) + 4 * hi; bf16_t* gp = Z + (rowb + qrow) * ZE + 1024 + h * 128 + l31;
#pragma unroll
        for (int d = 0; d < 4; ++d) { const float ga = bf2f(gp[32 * d]); const float ov = (o[d][r] - mu) * rsd * gg[d] * siluf_(ga); if (!DUMMY) gp[32 * d] = (bf16_t)f2bf(ov); else asm volatile("" :: "v"(ov)); }
    }
}
__device__ __forceinline__ bf16x8 ld8p(const bf16_t* p) { return *(const bf16x8*)p; }
namespace rw {
constexpr int S64 = 72, S128 = 136, LFS = 68;
constexpr int O_AT = 0, O_RT = O_AT + 9216, O_E = O_RT + 9216, O_ET = O_E + 18432, O_AM = O_ET + 17408, O_X0 = O_AM + 18432, O_LF = O_X0 + 17408, O_MM = O_LF + 17408,
              O_NN = O_MM + 9216, O_PC = O_NN + 17408, O_GC = O_PC + 9216, O_SM = O_GC + 9216, O_END = O_SM + 8192;
static_assert(O_END <= 160 * 1024 - 1024, "rwkv stage X LDS map");
typedef __attribute__((address_space(3))) bf16_t lbf;
typedef __attribute__((address_space(3))) float lf32;
__device__ __forceinline__ bf16x8 ld8(const bf16_t* p) { return *(const bf16x8*)p; }
__device__ __forceinline__ bf16x8 ld8(const LAS bf16_t* p) { return *(const LAS bf16x8*)p; }
__device__ __forceinline__ bf16x8 ld8(const GAS bf16_t* p) { return *(const GAS bf16x8*)p; }
template <int MT, int NT, int KS, class PA, class PB, class Epi>
__device__ __forceinline__ void mm(PA A, int lda, PB B, int ldb, int wave, int lane, Epi epi) {
    const int fr = lane & 15, g = lane >> 4;
    static_assert((MT * NT) % 8 == 0, "mm: tile count must be a multiple of the 8 waves");
#pragma unroll
    for (int ti = 0; ti < MT * NT / 8; ++ti) { const int tile = wave + 8 * ti; const int mt = tile / NT, nt = tile % NT;
        f32x4 acc = {0.f, 0.f, 0.f, 0.f};
        PA ap = A + (mt * 16 + fr) * lda + 8 * g; PB bp = B + (nt * 16 + fr) * ldb + 8 * g;
#pragma unroll
        for (int ks = 0; ks < KS; ++ks) acc = __builtin_amdgcn_mfma_f32_16x16x32_bf16(ld8(ap + 32 * ks), ld8(bp + 32 * ks), acc, 0, 0, 0);
        epi(ti, mt * 16 + 4 * g, nt * 16 + fr, acc);
    }
}
template <int MT, int NT, int KS, class PA, class PB, class Epi>
__device__ __forceinline__ void mm_rt(PA A, int lda, PB B, int ldb, int w, int nw, int lane, Epi epi) {
    const int fr = lane & 15, g = lane >> 4;
#pragma unroll 1
    for (int tile = w; tile < MT * NT; tile += nw) { const int mt = tile / NT, nt = tile % NT;
        f32x4 acc = {0.f, 0.f, 0.f, 0.f};
        PA ap = A + (mt * 16 + fr) * lda + 8 * g; PB bp = B + (nt * 16 + fr) * ldb + 8 * g;
#pragma unroll
        for (int ks = 0; ks < KS; ++ks) acc = __builtin_amdgcn_mfma_f32_16x16x32_bf16(ld8(ap + 32 * ks), ld8(bp + 32 * ks), acc, 0, 0, 0);
        epi(mt * 16 + 4 * g, nt * 16 + fr, acc);
    }
}
__device__ __forceinline__ unsigned short bfs(float f) { return (unsigned short)f2bf(f); }
__device__ __forceinline__ void st4(LAS bf16_t* p, f32x4 v) { u32x2 w; w.x = cvt_pk_bf16(v[0], v[1]); w.y = cvt_pk_bf16(v[2], v[3]); *(LAS u32x2*)p = w; }
}

template <bool DUMMY>
__device__ __forceinline__ void rwkv_stage_x(Frame& F, int li, unsigned long long& xacc) {
    using namespace rw;
#define TSX(k) do { if (MK_XA == (k) && li == 1 && F.wave == 0) { const unsigned long long t_ = __builtin_amdgcn_s_memrealtime(); *(volatile LAS unsigned long long*)(F.lds + MISC_OFF + 256) = t_; } if (MK_XB == (k) && li == 1 && F.wave == 0) { volatile LAS unsigned long long* p_ = (volatile LAS unsigned long long*)(F.lds + MISC_OFF + 256); const unsigned long long t0_ = p_[0]; if (t0_) p_[1] += __builtin_amdgcn_s_memrealtime() - t0_; } } while (0)
    const int o = li >> 1;
    LAS unsigned char* L = F.lds;
    LAS bf16_t* At = (LAS bf16_t*)(L + O_AT); LAS bf16_t* Rt = (LAS bf16_t*)(L + O_RT); LAS bf16_t* E = (LAS bf16_t*)(L + O_E); LAS bf16_t* ET = (LAS bf16_t*)(L + O_ET); LAS bf16_t* AM = (LAS bf16_t*)(L + O_AM);
    LAS bf16_t* X0T = (LAS bf16_t*)(L + O_X0); LAS float* Lf = (LAS float*)(L + O_LF); LAS bf16_t* Mm = (LAS bf16_t*)(L + O_MM); LAS bf16_t* NN = (LAS bf16_t*)(L + O_NN); LAS float* CS = (LAS float*)(L + O_NN);
    LAS bf16_t* Pc = (LAS bf16_t*)(L + O_PC); LAS bf16_t* Gc = (LAS bf16_t*)(L + O_GC); LAS float* gamC = (LAS float*)(L + O_SM); LAS float* SEGT = gamC + 64; LAS float* PRM = gamC + 64 + 1024;
    LAS bf16_t* Tm = At; LAS bf16_t* Qh = AM; LAS bf16_t* PT = AM + 64 * S64; LAS bf16_t* WT = Mm;
    GAS bf16_t* Z = (GAS bf16_t*)(F.ws + WS_Z); const GAS bf16_t* L1g = (const GAS bf16_t*)(F.ws + WS_L1); GAS bf16_t* VF = (GAS bf16_t*)(F.ws + WS_VF);
    const GAS bf16_t* W2T = (const GAS bf16_t*)(F.ws + WS_LORA2); const GAS bf16_t* A2T = W2T + 1024 * 64; const GAS bf16_t* V2T = A2T + 1024 * 64;
    GAS bf16_t* PG = (GAS bf16_t*)(F.H); GAS float* BON = (GAS float*)(F.ws + WS_BON);
    const float* w0p = F.in[12] + o * D; const float* a0p = F.in[15] + o * D; const float* v0p = F.in[18]; const float* kkp = F.in[21] + o * D; const float* kap = F.in[22] + o * D; const float* rkp = F.in[23] + o * D;
    f32x4 nlw[2], nla[2], nlv[2]; unsigned nr[4], nk[4], nv[4], nvf[4];
    bf16x8 fwa[4], fwb[2], faa[4], fab[2], fva[2], fvb;
    auto fetch_issue = [&](int u2, int c2, int tid2, const int part) {
        const int bh2 = u2 & 31, blk2 = u2 >> 5, b2 = bh2 >> 4, h2 = bh2 & 15; const size_t rows2 = (size_t)b2 * SEQ + (size_t)blk2 * 128 + 64 * c2;
        const int lane2 = tid2 & 63, fr2 = lane2 & 15, g2 = lane2 >> 4; int wave2 = F.wave; asm volatile("" : "+s"(wave2));
        const int nt2 = wave2 & 3;
#pragma unroll
        for (int ti = 0; ti < 2; ++ti) if (part & (1 << ti)) { const int mt2 = ((wave2 + 8 * ti) >> 2); const GAS bf16_t* ap = L1g + (rows2 + mt2 * 16 + fr2) * 256 + 8 * g2;
            fwa[ti * 2] = ld8(ap); fwa[ti * 2 + 1] = ld8(ap + 32); faa[ti * 2] = ld8(ap + 64); faa[ti * 2 + 1] = ld8(ap + 96); if (o) fva[ti] = ld8(ap + 128); }
        if (part & 4) {
        { const GAS bf16_t* bp = W2T + ((size_t)h2 * 64 + nt2 * 16 + fr2) * 64 + 8 * g2; fwb[0] = ld8(bp); fwb[1] = ld8(bp + 32); }
        { const GAS bf16_t* bp = A2T + ((size_t)h2 * 64 + nt2 * 16 + fr2) * 64 + 8 * g2; fab[0] = ld8(bp); fab[1] = ld8(bp + 32); }
        if (o) fvb = ld8(V2T + ((size_t)h2 * 64 + nt2 * 16 + fr2) * 32 + 8 * g2); }
        const int q2 = wave2 * 2 + (lane2 >> 5), cp2 = lane2 & 31;
        if (part & 8)
#pragma unroll
        for (int j = 0; j < 4; ++j) { const size_t prow2 = rows2 + 4 * q2 + j; const GAS unsigned* zp2 = (const GAS unsigned*)(Z + prow2 * ZW + h2 * 64 + 2 * cp2);
            nr[j] = zp2[0]; nk[j] = zp2[512]; nv[j] = zp2[1024]; nvf[j] = o ? *(const GAS unsigned*)(VF + prow2 * D + h2 * 64 + 2 * cp2) : 0u; }
    };
    auto fetch_compute = [&]() {
#pragma unroll
        for (int ti = 0; ti < 2; ++ti) { const f32x4 z4 = {0.f, 0.f, 0.f, 0.f};
            nlw[ti] = __builtin_amdgcn_mfma_f32_16x16x32_bf16(fwb[1], fwa[ti * 2 + 1], __builtin_amdgcn_mfma_f32_16x16x32_bf16(fwb[0], fwa[ti * 2], z4, 0, 0, 0), 0, 0, 0);
            nla[ti] = __builtin_amdgcn_mfma_f32_16x16x32_bf16(fab[1], faa[ti * 2 + 1], __builtin_amdgcn_mfma_f32_16x16x32_bf16(fab[0], faa[ti * 2], z4, 0, 0, 0), 0, 0, 0);
            if (o) nlv[ti] = __builtin_amdgcn_mfma_f32_16x16x32_bf16(fvb, fva[ti], z4, 0, 0, 0); }
    };
    { F.retid(); int t0 = F.tid; asm volatile("" : "+v"(t0)); fetch_issue(F.vcu, 0, t0, 15); fetch_compute(); }
#pragma unroll 1
    for (int u = F.vcu; u < 2048; u += F.G) {
        const int bh = u & 31, blk = u >> 5, b = bh >> 4, h = bh & 15; const size_t row0 = (size_t)b * SEQ + (size_t)blk * 128;
        F.retid(); int tid = F.tid; asm volatile("" : "+v"(tid));
        LBAR();
        if ((F.G & 31) != 0 || u == F.vcu) {
            if (tid < 384) { const int a_ = tid >> 6, ch = tid & 63; const float* src = a_ == 0 ? w0p : a_ == 1 ? a0p : a_ == 2 ? v0p : a_ == 3 ? kkp : a_ == 4 ? kap : rkp; PRM[tid] = src[h * 64 + ch]; } }
        for (int e = tid; e < 64 * 64; e += 512) { const int i = e >> 6, j = e & 63; Pc[i * S64 + j] = (i == j) ? (bf16_t)0x3f80 : (bf16_t)0; Gc[i * S64 + j] = 0; }
#pragma unroll 1
        for (int c = 0; c < 2; ++c) {
            const size_t rows = row0 + 64 * c;
            asm volatile("" : "+v"(tid));
            const int lane = tid & 63; int wave = F.wave; asm volatile("" : "+s"(wave));
            const int cp = lane & 31, q = wave * 2 + (lane >> 5), ch0 = 2 * cp;
            LBAR();
            TSX(0);
            unsigned cr[4], ck[4], cv[4], cvf[4];
#pragma unroll
            for (int j = 0; j < 4; ++j) { cr[j] = nr[j]; ck[j] = nk[j]; cv[j] = nv[j]; cvf[j] = nvf[j]; }
            { const int fr_ = lane & 15, g_ = lane >> 4;
#pragma unroll
              for (int ti = 0; ti < 2; ++ti) { const int tile = wave + 8 * ti, t = (tile >> 2) * 16 + fr_, c0 = (tile & 3) * 16 + 4 * g_;
                  *(LAS f32x4*)(Lf + t * LFS + c0) = nlw[ti]; st4(Mm + t * S64 + c0, nla[ti]); if (o) st4(AM + (64 + t) * S64 + c0, nlv[ti]); } }
            const int nu = c == 0 ? u : u + F.G, nc = c == 0 ? 1 : 0; const bool has_n = nu < 2048;
            if (has_n) fetch_issue(nu, nc, tid, 1);
            LBAR();
            TSX(1);
            if (has_n) fetch_issue(nu, nc, tid, 2);
            float pr[4][2], pkk[4][2], pkm[4][2], pb[4][2], pv[4][2], cd[4][2];
            {
                float ss[4], bon[4];
#pragma unroll
                for (int j = 0; j < 4; ++j) { const int t = 4 * q + j; ss[j] = 0.f; bon[j] = 0.f;
                    const f32x2 lw2 = *(const LAS f32x2*)(Lf + t * LFS + ch0); const unsigned la2 = *(const LAS unsigned*)(Mm + t * S64 + ch0); const unsigned lv2 = o ? *(const LAS unsigned*)(AM + (64 + t) * S64 + ch0) : 0u;
#pragma unroll
                    for (int e = 0; e < 2; ++e) { const int ch = ch0 + e;
                        const float r = e ? __uint_as_float(cr[j] & 0xffff0000u) : __uint_as_float(cr[j] << 16), k = e ? __uint_as_float(ck[j] & 0xffff0000u) : __uint_as_float(ck[j] << 16);
                        float v = e ? __uint_as_float(cv[j] & 0xffff0000u) : __uint_as_float(cv[j] << 16);
                        const float lw = lw2[e], la = e ? __uint_as_float(la2 & 0xffff0000u) : __uint_as_float(la2 << 16);
                        cd[j][e] = -0.6065306597126334f * sigmoidf_(PRM[ch] + lw);
                        const float a = sigmoidf_(PRM[64 + ch] + la);
                        if (o) { const float lv = e ? __uint_as_float(lv2 & 0xffff0000u) : __uint_as_float(lv2 << 16); const float vf = e ? __uint_as_float(cvf[j] & 0xffff0000u) : __uint_as_float(cvf[j] << 16);
                            v = v + (vf - v) * sigmoidf_(PRM[128 + ch] + lv); v = bf2f((bf16_t)f2bf(v)); }
                        const float kr = k * PRM[192 + ch]; ss[j] += kr * kr; pkk[j][e] = kr;
                        const float km = k * (1.f + (a - 1.f) * PRM[256 + ch]); pkm[j][e] = km; pb[j][e] = a; pr[j][e] = r; pv[j][e] = v; bon[j] += r * km * PRM[320 + ch]; }
                    const size_t row = rows + t;
                    if (!DUMMY) { if (o) *(GAS unsigned*)(Z + row * ZW + 2048 + h * 64 + ch0) = pk2(pv[j][0], pv[j][1]); else *(GAS unsigned*)(VF + row * D + h * 64 + ch0) = cv[j]; } }
#pragma unroll
                for (int j = 0; j < 4; ++j) {
                    float s1 = ss[j], b1 = bon[j];
                    s1 = red32(s1);
                    b1 = red32(b1);
                    const float inv = __builtin_amdgcn_rcpf(fmaxf(sqrtf(s1), 1e-12f));
#pragma unroll
                    for (int e = 0; e < 2; ++e) { pkk[j][e] *= inv; pb[j][e] *= pkk[j][e]; }
                    if (!DUMMY && cp == 0) BON[(rows + 4 * q + j) * 16 + h] = b1; }
#pragma unroll
                for (int e = 0; e < 2; ++e) { cd[1][e] += cd[0][e]; cd[2][e] += cd[1][e]; cd[3][e] += cd[2][e]; SEGT[q * 64 + ch0 + e] = cd[3][e]; }
            }
            LBAR();
            TSX(3);
            if (has_n) fetch_issue(nu, nc, tid, 4);
            {
                float pre[2] = {0.f, 0.f};
                for (int qq = 0; qq < q; ++qq) { pre[0] += SEGT[qq * 64 + ch0]; pre[1] += SEGT[qq * 64 + ch0 + 1]; }
                float at[4][2], bt[4][2], kt[4][2], rt[4][2];
#pragma unroll
                for (int j = 0; j < 4; ++j)
#pragma unroll
                    for (int e = 0; e < 2; ++e) { const float g = pre[e] + cd[j][e], gp = j ? pre[e] + cd[j - 1][e] : pre[e]; const float eg = __expf(g), egp = __expf(gp), ieg = __builtin_amdgcn_rcpf(eg);
                        at[j][e] = egp * pkk[j][e]; bt[j][e] = pb[j][e] * ieg; kt[j][e] = pkm[j][e] * ieg; rt[j][e] = pr[j][e] * eg;
                        if (q == 15 && j == 3) gamC[ch0 + e] = eg; }
#pragma unroll
                for (int j = 0; j < 4; ++j) { const int t = 4 * q + j;
                    *(LAS unsigned*)(At + t * S64 + ch0) = cvt_pk_bf16(at[j][0], at[j][1]); *(LAS unsigned*)(Rt + t * S64 + ch0) = cvt_pk_bf16(rt[j][0], rt[j][1]);
                    *(LAS unsigned*)(E + t * S64 + ch0) = cvt_pk_bf16(bt[j][0], bt[j][1]); *(LAS unsigned*)(E + (64 + t) * S64 + ch0) = cvt_pk_bf16(kt[j][0], kt[j][1]); }
#pragma unroll
                for (int e = 0; e < 2; ++e) { const int ch = ch0 + e;
#define RW_Q4(x) (u32x2){cvt_pk_bf16(x[0][e], x[1][e]), cvt_pk_bf16(x[2][e], x[3][e])}
                    *(LAS u32x2*)(AM + ch * S64 + 4 * q) = RW_Q4(at); *(LAS u32x2*)(ET + ch * S128 + 4 * q) = RW_Q4(bt); *(LAS u32x2*)(ET + ch * S128 + 64 + 4 * q) = RW_Q4(kt); *(LAS u32x2*)(X0T + ch * S128 + 64 + 4 * q) = RW_Q4(pv);
#undef RW_Q4
                }
            }
            LBAR();
            TSX(4);
            if (has_n) fetch_issue(nu, nc, tid, 8);
            mm<8, 4, 2>(E, S64, At, S64, wave, lane, [&](int, int r0, int col, f32x4 a) {
                const int i0 = r0 & 63; f32x4 v;
#pragma unroll
                for (int j = 0; j < 4; ++j) v[j] = (i0 + j < col) ? a[j] : 0.f;
                if (r0 < 64) *(LAS f32x4*)(Lf + col * LFS + i0) = v; else st4(Mm + col * S64 + i0, v); });
            LBAR();
            TSX(5);
            if (wave < 2) {
                const int bb = 32 * wave; float x[32]; int vz = 0; asm volatile("" : "+v"(vz));
                const LAS float* Lz = Lf + vz; const int cl = lane & 31;
#pragma unroll
                for (int t = 0; t < 32; ++t) x[t] = 0.f;
#pragma unroll
                for (int t = 0; t < 32; ++t) { float s0 = (t == cl) ? 1.f : 0.f, s1 = 0.f, s2 = 0.f, s3 = 0.f;
#pragma unroll
                    for (int i4 = 0; i4 < (t + 3) / 4; ++i4) { const f32x4 l4 = *(const LAS f32x4*)(Lz + (bb + t) * LFS + bb + 4 * i4);
                        s0 -= l4[0] * x[4 * i4]; s1 -= l4[1] * x[4 * i4 + 1]; s2 -= l4[2] * x[4 * i4 + 2]; s3 -= l4[3] * x[4 * i4 + 3]; }
                    x[t] = (s0 + s1) + (s2 + s3); }
                if (lane < 32) {
#pragma unroll
                    for (int t = 0; t < 32; ++t) Tm[(bb + t) * S64 + bb + cl] = bfs(x[t]);
                    if (wave == 0) {
#pragma unroll
                        for (int i4 = 0; i4 < 8; ++i4) st4(X0T + cl * S128 + 4 * i4, (f32x4){x[4 * i4], x[4 * i4 + 1], x[4 * i4 + 2], x[4 * i4 + 3]}); }
                }
            } else {
                mm_rt<8, 4, 2>(E, S64, Rt, S64, wave - 2, 6, lane, [&](int r0, int col, f32x4 a) {
                    const int i0 = r0 & 63; f32x4 v;
#pragma unroll
                    for (int j = 0; j < 4; ++j) v[j] = (i0 + j <= col) ? a[j] : 0.f;
                    st4(NN + col * S128 + r0, v); });
                mm_rt<4, 4, 2>(Mm, S64, X0T + 64, S128, wave - 2, 6, lane, [&](int r0, int col, f32x4 a) { st4(AM + (64 + col) * S64 + r0, (f32x4){-a[0], -a[1], -a[2], -a[3]}); });
                asm volatile("s_waitcnt lgkmcnt(0)" ::: "memory");
                { const int e = tid - 128; if (e < 256) { const int t = e >> 3, i4 = (e & 7) * 4; st4(X0T + t * S128 + 32 + i4, *(const LAS f32x4*)(Lf + (32 + t) * LFS + i4)); *(LAS u32x2*)(Tm + t * S64 + 32 + i4) = (u32x2){0u, 0u}; } }
            }
            LBAR();
            TSX(6);
            if (wave < 4) { const int fr_ = lane & 15, g_ = lane >> 4, mt = wave >> 1, nt = wave & 1;
                const f32x4 z4 = {0.f, 0.f, 0.f, 0.f};
                const f32x4 a = __builtin_amdgcn_mfma_f32_16x16x32_bf16(ld8(X0T + (mt * 16 + fr_) * S128 + 32 + 8 * g_), ld8(X0T + (nt * 16 + fr_) * S128 + 8 * g_), z4, 0, 0, 0);
                st4(Mm + (nt * 16 + fr_) * S64 + mt * 16 + 4 * g_, a); }
            LBAR();
            if (wave < 4) { const int fr_ = lane & 15, g_ = lane >> 4, mt = wave >> 1, nt = wave & 1;
                const f32x4 z4 = {0.f, 0.f, 0.f, 0.f};
                const f32x4 a = __builtin_amdgcn_mfma_f32_16x16x32_bf16(ld8(Tm + (32 + mt * 16 + fr_) * S64 + 32 + 8 * g_), ld8(Mm + (nt * 16 + fr_) * S64 + 8 * g_), z4, 0, 0, 0);
#pragma unroll
                for (int j = 0; j < 4; ++j) Tm[(32 + mt * 16 + 4 * g_ + j) * S64 + nt * 16 + fr_] = bfs(-a[j]); }
            LBAR();
            TSX(7);
            mm<4, 8, 2>(Tm, S64, AM, S64, wave, lane, [&](int, int r0, int col, f32x4 a) { if (col < 64) st4(WT + col * S64 + r0, a); else st4(X0T + (col - 64) * S128 + r0, a); });
            LBAR();
            TSX(8);
            f32x4 gt[2], y0t[2];
            mm<4, 4, 2>(WT, S64, ET, S128, wave, lane, [&](int, int r0, int col, f32x4 a) { const float gc = gamC[col];
                f32x4 p;
#pragma unroll
                for (int j = 0; j < 4; ++j) p[j] = (((r0 + j) == col ? 1.f : 0.f) - a[j]) * gc;
                st4(PT + col * S64 + r0, p); });
            mm<4, 4, 4>(ET, S128, X0T, S128, wave, lane, [&](int ti, int r0, int, f32x4 a) { gt[ti] = a * *(const LAS f32x4*)(gamC + r0); });
            mm<4, 4, 4>(NN, S128, X0T, S128, wave, lane, [&](int ti, int, int, f32x4 a) { y0t[ti] = a; });
            mm<4, 4, 2>(WT, S64, NN, S128, wave, lane, [&](int, int r0, int col, f32x4 a) {
                const u32x2 rr = *(const LAS u32x2*)(Rt + col * S64 + r0);
                st4(Qh + col * S64 + r0, (f32x4){__uint_as_float(rr.x << 16) - a[0], __uint_as_float(rr.x & 0xffff0000u) - a[1], __uint_as_float(rr.y << 16) - a[2], __uint_as_float(rr.y & 0xffff0000u) - a[3]}); });
            LBAR();
            TSX(9);
            GAS bf16_t* rslot = Z + row0 * ZW + h * 64; GAS bf16_t* kslot = rslot + 1024;
            mm<4, 4, 2>(Pc, S64, Qh, S64, wave, lane, [&](int, int r0, int col, f32x4 a) {
                const int kt_ = r0 >> 5, rho = r0 & 31, s = rho >> 4, jj = ((rho >> 3) & 1) * 4, hh = (rho >> 2) & 1;
                const int t = 64 * c + col, tt_ = t >> 5, ln = 32 * hh + (t & 31); const int e = ((((tt_ * 2 + kt_) * 2 + s) * 64 + ln) << 3) + jj;
                if (!DUMMY) *(GAS u32x2*)(rslot + (size_t)(e >> 6) * ZW + (e & 63)) = (u32x2){cvt_pk_bf16(a[0], a[1]), cvt_pk_bf16(a[2], a[3])}; else asm volatile("" :: "v"(a[0])); });
            mm<4, 4, 2>(Qh, S64, Gc, S64, wave, lane, [&](int ti, int r0, int col, f32x4 a) {
                const int vt_ = col >> 5, v31 = col & 31;
                const int t = 64 * c + r0, tt_ = t >> 5, x = t & 31, hh = (x >> 2) & 1, r = 4 * (x >> 3); const int e = (((tt_ * 2 + vt_) * 64 + 32 * hh + v31) << 4) + r;
                const f32x4 y = a + y0t[ti];
                if (!DUMMY) *(GAS u32x2*)(kslot + (size_t)(e >> 6) * ZW + (e & 63)) = (u32x2){cvt_pk_bf16(y[0], y[1]), cvt_pk_bf16(y[2], y[3])}; else asm volatile("" :: "v"(y[0])); });
            f32x4 pn[2], gn[2];
            mm<4, 4, 2>(PT, S64, Pc, S64, wave, lane, [&](int ti, int, int, f32x4 a) { pn[ti] = a; });
            mm<4, 4, 2>(PT, S64, Gc, S64, wave, lane, [&](int ti, int, int, f32x4 a) { gn[ti] = a + gt[ti]; });
            if (has_n) fetch_compute();
            LBAR();
            { const int fr = lane & 15, g = lane >> 4;
#pragma unroll
              for (int ti = 0; ti < 2; ++ti) { const int tile = wave + 8 * ti, mt = tile >> 2, nt = tile & 3;
                  st4(Pc + (nt * 16 + fr) * S64 + mt * 16 + 4 * g, pn[ti]); st4(Gc + (nt * 16 + fr) * S64 + mt * 16 + 4 * g, gn[ti]); } }
            TSX(10);
        }
        LBAR();
        if (!DUMMY) { GAS bf16_t* pg = PG + (size_t)u * 8192;
          { const int f = tid >> 6, ln = tid & 63, s = f & 1, kit = (f >> 1) & 1, kot = f >> 2, hh = ln >> 5, r31 = ln & 31; unsigned short w[8];
#pragma unroll
            for (int j = 0; j < 8; ++j) { const int rho = 16 * s + 8 * (j >> 2) + 4 * hh + (j & 3); w[j] = Pc[(32 * kit + rho) * S64 + 32 * kot + r31]; }
            *(GAS u32x4*)(pg + (size_t)tid * 8) = (u32x4){(unsigned)w[0] | ((unsigned)w[1] << 16), (unsigned)w[2] | ((unsigned)w[3] << 16), (unsigned)w[4] | ((unsigned)w[5] << 16), (unsigned)w[6] | ((unsigned)w[7] << 16)}; }
          { const int tile = tid >> 7, ln = (tid >> 1) & 63, half = tid & 1, kot = tile >> 1, vt_ = tile & 1, hh = ln >> 5, v31 = ln & 31; unsigned short w[8];
#pragma unroll
            for (int q = 0; q < 8; ++q) { const int r = 8 * half + q; const int ko = 32 * kot + (r & 3) + 8 * (r >> 2) + 4 * hh; w[q] = Gc[(32 * vt_ + v31) * S64 + ko]; }
            *(GAS u32x4*)(pg + 4096 + ((size_t)(tile * 64 + ln) << 4) + 8 * half) = (u32x4){(unsigned)w[0] | ((unsigned)w[1] << 16), (unsigned)w[2] | ((unsigned)w[3] << 16), (unsigned)w[4] | ((unsigned)w[5] << 16), (unsigned)w[6] | ((unsigned)w[7] << 16)}; } }
    }
    LBAR();
}

__device__ __forceinline__ void rwkv_stage_y(Frame& F, const int bx) {
    const int lane = F.lane, wave = F.wave, bh = bx, vt = wave >> 2; const bool st = ((wave & 3) == 0);
    const bf16_t* PG = (const bf16_t*)(F.H); u32x4* SB = (u32x4*)(F.ws + WS_SB);
    LAS bf16x8* pgbuf = (LAS bf16x8*)F.lds;
    f32x16 X0, X1;
#pragma unroll
    for (int r = 0; r < 16; ++r) { X0[r] = 0.f; X1[r] = 0.f; }
    bf16x8 Ra0, Ra1, Rb0, Rb1, Rc0, Rc1;
    auto issue = [&](bf16x8& r0, bf16x8& r1, int blk) { const bf16_t* pg = PG + (size_t)(blk * 32 + bh) * 8192;
        r0 = ld8p(pg + (((size_t)(wave * 2 + 0) * 64 + lane) << 3)); r1 = ld8p(pg + (((size_t)(wave * 2 + 1) * 64 + lane) << 3)); };
    auto step = [&](bf16x8& c0, bf16x8& c1, bf16x8& n0r, bf16x8& n1r, int blk) {
        const bf16x8 nga = n0r, ngb = n1r;
        issue(c0, c1, blk + 3 < 64 ? blk + 3 : 63);
        asm volatile("s_waitcnt lgkmcnt(0)" ::: "memory"); __builtin_amdgcn_s_barrier(); asm volatile("" ::: "memory");
        pgbuf[((blk + 1) & 1) * 1024 + (wave * 2 + 0) * 64 + lane] = nga; pgbuf[((blk + 1) & 1) * 1024 + (wave * 2 + 1) * 64 + lane] = ngb;
        if (st) {
            u32x4 xb[4];
#pragma unroll
            for (int s = 0; s < 2; ++s) {
                xb[s] = (u32x4){cvt_pk_bf16(X0[8 * s], X0[8 * s + 1]), cvt_pk_bf16(X0[8 * s + 2], X0[8 * s + 3]), cvt_pk_bf16(X0[8 * s + 4], X0[8 * s + 5]), cvt_pk_bf16(X0[8 * s + 6], X0[8 * s + 7])};
                xb[2 + s] = (u32x4){cvt_pk_bf16(X1[8 * s], X1[8 * s + 1]), cvt_pk_bf16(X1[8 * s + 2], X1[8 * s + 3]), cvt_pk_bf16(X1[8 * s + 4], X1[8 * s + 5]), cvt_pk_bf16(X1[8 * s + 6], X1[8 * s + 7])}; }
            u32x4* sb = SB + ((size_t)(blk * 32 + bh) * 8 + vt * 4) * 64 + lane;
#pragma unroll
            for (int q = 0; q < 4; ++q) sb[q * 64] = xb[q];
            const LAS bf16x8* pb = pgbuf + (blk & 1) * 1024;
            f32x16 n0, n1;
            { const bf16x8 c0a = pb[512 + ((0 * 2 + vt) * 64 + lane) * 2], c0b = pb[512 + ((0 * 2 + vt) * 64 + lane) * 2 + 1], c1a = pb[512 + ((1 * 2 + vt) * 64 + lane) * 2], c1b = pb[512 + ((1 * 2 + vt) * 64 + lane) * 2 + 1];
#pragma unroll
              for (int r = 0; r < 8; ++r) { n0[r] = bf2f((bf16_t)c0a[r]); n0[8 + r] = bf2f((bf16_t)c0b[r]); n1[r] = bf2f((bf16_t)c1a[r]); n1[8 + r] = bf2f((bf16_t)c1b[r]); } }
#pragma unroll
            for (int q = 0; q < 4; ++q) {
                n0 = __builtin_amdgcn_mfma_f32_32x32x16_bf16(pb[q * 64 + lane], __builtin_bit_cast(bf16x8, xb[q]), n0, 0, 0, 0);
                n1 = __builtin_amdgcn_mfma_f32_32x32x16_bf16(pb[(4 + q) * 64 + lane], __builtin_bit_cast(bf16x8, xb[q]), n1, 0, 0, 0); }
            X0 = n0; X1 = n1;
        }
    };
    issue(Ra0, Ra1, 0); issue(Rb0, Rb1, 1); issue(Rc0, Rc1, 2);
    pgbuf[(wave * 2 + 0) * 64 + lane] = Ra0; pgbuf[(wave * 2 + 1) * 64 + lane] = Ra1;
#pragma unroll 1
    for (int blk = 0; blk < 63; blk += 3) { step(Ra0, Ra1, Rb0, Rb1, blk); step(Rb0, Rb1, Rc0, Rc1, blk + 1); step(Rc0, Rc1, Ra0, Ra1, blk + 2); }
    step(Ra0, Ra1, Rb0, Rb1, 63);
    __syncthreads();
}

template <bool DUMMY>
__device__ __forceinline__ void rwkv_stage_z(Frame& F, int li) {
    const int o = li >> 1;
    bf16_t* Z = (bf16_t*)(F.ws + WS_Z); const float* BON = (const float*)(F.ws + WS_BON); const u32x4* SB = (const u32x4*)(F.ws + WS_SB);
    const float* lgp = F.in[24] + o * D; const float* lbp = F.in[25] + o * D;
    LAS float* tile = (LAS float*)(F.lds + F.wave * 9216);
    int lane_ = F.lane;
#pragma unroll 1
    for (int w = F.vcu * 8 + F.wave; w < 8192; w += F.G * 8) {
        asm volatile("" : "+v"(lane_)); const int lane = lane_, v31 = lane & 31, hh = lane >> 5, tl = lane >> 1, hf = lane & 1;
        const int u = w >> 2, tt = w & 3, bh = u & 31, blk = u >> 5, b = bh >> 4, h = bh & 15; const size_t row0 = (size_t)b * SEQ + (size_t)blk * 128;
        const bf16_t* rslot = Z + row0 * ZW + h * 64; const bf16_t* kslot = rslot + 1024;
        const size_t row = row0 + 32 * tt + tl; bf16_t* zp = Z + row * ZW + h * 64 + 32 * hf;
        bf16x8 vv[4], gg[4];
#pragma unroll
        for (int q = 0; q < 4; ++q) { vv[q] = ld8p(zp + 2048 + 8 * q); gg[q] = ld8p(zp + 3072 + 8 * q); }
        const float bon = BON[row * 16 + h];
        bf16x8 qf[4]; u32x4 xb[2][4];
#pragma unroll
        for (int q = 0; q < 4; ++q) { const int e = (((tt * 4 + q) * 64 + lane) << 3); qf[q] = ld8p(rslot + (size_t)(e >> 6) * ZW + (e & 63)); }
#pragma unroll
        for (int vt = 0; vt < 2; ++vt)
#pragma unroll
            for (int q = 0; q < 4; ++q) xb[vt][q] = SB[((size_t)u * 8 + vt * 4 + q) * 64 + lane];
#pragma unroll
        for (int vt = 0; vt < 2; ++vt) { const int e0 = ((tt * 2 + vt) * 64 + lane) << 4; const bf16_t* yp = kslot + (size_t)(e0 >> 6) * ZW + (e0 & 63); const bf16x8 ya = ld8p(yp), yb = ld8p(yp + 8);
            f32x16 acc;
#pragma unroll
            for (int r = 0; r < 8; ++r) { acc[r] = bf2f((bf16_t)ya[r]); acc[8 + r] = bf2f((bf16_t)yb[r]); }
#pragma unroll
            for (int q = 0; q < 4; ++q) acc = __builtin_amdgcn_mfma_f32_32x32x16_bf16(qf[q], __builtin_bit_cast(bf16x8, xb[vt][q]), acc, 0, 0, 0);
#pragma unroll
            for (int r = 0; r < 16; ++r) tile[((r & 3) + 8 * (r >> 2) + 4 * hh) * 72 + 36 * vt + v31] = acc[r]; }
        LDS_WAIT(); asm volatile("" ::: "memory");
        float y[32]; float sm = 0.f;
#pragma unroll
        for (int q = 0; q < 8; ++q) { const f32x4 t4 = *(const LAS f32x4*)(tile + tl * 72 + 36 * hf + 4 * q); y[4 * q] = t4[0]; y[4 * q + 1] = t4[1]; y[4 * q + 2] = t4[2]; y[4 * q + 3] = t4[3]; sm += (t4[0] + t4[1]) + (t4[2] + t4[3]); }
        sm += __shfl_xor(sm, 1);
        const float mu = sm * (1.f / 64.f); float qq = 0.f;
#pragma unroll
        for (int j = 0; j < 32; ++j) { y[j] -= mu; qq += y[j] * y[j]; }
        qq += __shfl_xor(qq, 1);
        const float rsd = rsqrtf(qq * (1.f / 64.f) + 64e-5f);
        const float* lg = lgp + h * 64 + 32 * hf; const float* lb = lbp + h * 64 + 32 * hf;
#pragma unroll
        for (int q = 0; q < 4; ++q) { float ov[8];
#pragma unroll
            for (int j = 0; j < 8; ++j) { const int c = 8 * q + j; const float va = bf2f((bf16_t)vv[q][j]), ga = bf2f((bf16_t)gg[q][j]); ov[j] = (y[c] * rsd * lg[c] + lb[c] + bon * va) * siluf_(ga); }
            const u32x4 wv = {cvt_pk_bf16(ov[0], ov[1]), cvt_pk_bf16(ov[2], ov[3]), cvt_pk_bf16(ov[4], ov[5]), cvt_pk_bf16(ov[6], ov[7])};
            if (!DUMMY) *(u32x4*)(zp + 3072 + 8 * q) = wv; else asm volatile("" :: "v"(wv)); }
        LDS_WAIT(); asm volatile("" ::: "memory");
    }
}

enum { PH_P0 = 0, PH_FINAL = 27, N_PHASES = 28 };
#define IN(k) (lo <= (k) && (k) < hi)
#define TSG(k) do { if (LI == 0) { if (MK_GA == (k)) tA = __builtin_amdgcn_s_memrealtime(); if (MK_GB == (k)) tB = __builtin_amdgcn_s_memrealtime(); } } while (0)
#define TS(k) do { if (MK_TPA == (k)) tA = __builtin_amdgcn_s_memrealtime(); if (MK_TPB == (k)) tB = __builtin_amdgcn_s_memrealtime(); } while (0)
#if MK_MULTI
#define SEAM(k) do { } while (0)
#else
#define SEAM(k) do { if (IN(k) && IN((k) + 1)) xcd_barrier(bar); } while (0)
#endif
template <int LI>
__device__ __forceinline__ void run_layer(Frame& F, const XcdBarrier& bar, const int lo, const int hi, const int bx, unsigned long long& tA, unsigned long long& tB) {
    constexpr bool even = (LI & 1) == 0;
    constexpr int base = 1 + (LI / 2) * 13 + (even ? 0 : 6);
    bf16_t* Zp = (bf16_t*)(F.ws + WS_Z);
    if constexpr (even) {
        TS(base); if (IN(base)) { F.retid(); pg8::StaticOrder S; S.init(64, 16, F.G, bx);
            pg8::Gemm g{(const bf16_t*)(F.ws + WS_HB), (const bf16_t*)(F.ws + WS_WIN)};
            EpiEvenIn E{Zp, F.ssq(LI), (bf16_t*)(F.ws + WS_VTA), (bf16_t*)(F.ws + WS_VTB), (bf16_t*)(F.ws + WS_KT), F.lds + RING_BYTES};
            if (MK_PROBE == 1) pg8::gemm_phase<EpiEvenIn, true, D, D, 1 << 20, 0, 0>(F.lds, F.tid, g, S, E);
            pg8::gemm_phase<EpiEvenIn, true, D, D, 1 << 20, 0, 0>(F.lds, F.tid, g, S, E); }
        SEAM(base);
        TS(base + 1); if (IN(base + 1)) { F.retid();
            TSG(0); conv_wrest_a(F, LI); TSG(1);
            if constexpr (LI < 3) conv_win_odd(F, LI + 1);
            TSG(2);
            if (MK_PROBE == 5) { for (int u = F.vcu * 8 + F.wave; u < 4096; u += F.G * 8) ret_stage_a(F, u);
                for (int u = F.vcu * 8 + F.wave; u < 2048; u += F.G * 8) sb_unit<true>(F, u >> 8, u & 255); }
            for (int u = F.vcu * 8 + F.wave; u < 4096; u += F.G * 8) ret_stage_a(F, u);
            __syncthreads(); TSG(3);
            for (int u = F.vcu * 8 + F.wave; u < 2048; u += F.G * 8) sb_unit<false>(F, u >> 8, u & 255);
            __syncthreads(); TSG(4); }
        SEAM(base + 1);
        TS(base + 2); if (IN(base + 2)) { F.retid(); ret_stage_b(F); conv_wrest_b(F, LI, F.vcu, F.G); }
        SEAM(base + 2);
        TS(base + 3); if (IN(base + 3)) { F.retid(); const float* gng = F.in[8] + (LI >> 1) * 512;
            if (MK_PROBE == 6) for (int u = F.vcu * 8 + F.wave; u < 2048; u += F.G * 8) ret_stage_c<true>(F, u, gng);
            for (int u = F.vcu * 8 + F.wave; u < 2048; u += F.G * 8) ret_stage_c<false>(F, u, gng); }
        SEAM(base + 3);
        TS(base + 4); if (IN(base + 4)) { F.retid(); pg8::StaticOrder S; S.init(64, 4, F.G, bx);
            { pg8::Gemm g{(const bf16_t*)(F.ws + WS_PB), (const bf16_t*)(F.ws + WS_WPROJ)};
              EpiStore E{Zp, ZE}; pg8::gemm_phase<EpiStore, false, PLE, PLE, 1 << 20, 0, 0>(F.lds, F.tid, g, S, E); }
            { pg8::Gemm g{Zp + 1024, (const bf16_t*)(F.ws + WS_WOUT)};
              EpiResid E{(const bf16_t*)(F.ws + WS_HB), Zp + 1536, ZE}; pg8::gemm_phase<EpiResid, false, ZE, D, 8, (long)((2560 - 1024) * 2), 0>(F.lds, F.tid, g, S, E); } }
        SEAM(base + 4);
        TS(base + 5); if (IN(base + 5)) { F.retid(); pg8::StaticOrder S; S.init(64, 4, F.G, bx);
            pg8::Gemm g{Zp + 1536, (const bf16_t*)(F.ws + WS_WGATE)};
            EpiGate E{Zp + 1536, ZE, Zp, ZE, (bf16_t*)(F.ws + WS_HB), F.ssq(LI + 1)};
            pg8::gemm_phase<EpiGate, false, ZE, D, 1 << 20, 0, 0>(F.lds, F.tid, g, S, E); }
        SEAM(base + 5);
    } else {
        TS(base); if (IN(base)) { F.retid(); conv_lora2(F, LI); rows_norm(F, LI); }
        SEAM(base);
        TS(base + 1); if (IN(base + 1)) { F.retid(); pg8::StaticOrder S; S.init(64, 17, F.G, bx);
            pg8::Gemm g{(const bf16_t*)(F.H) + D, (const bf16_t*)(F.ws + WS_WIN)};
            EpiOddIn E{Zp, (bf16_t*)(F.ws + WS_L1)};
            if (MK_PROBE == 2) pg8::gemm_phase<EpiOddIn, true, D, 2048, 16, -(long)(D * 2), (long)(D * 2)>(F.lds, F.tid, g, S, E);
            pg8::gemm_phase<EpiOddIn, true, D, 2048, 16, -(long)(D * 2), (long)(D * 2)>(F.lds, F.tid, g, S, E); }
        SEAM(base + 1);
        TS(base + 2); if (IN(base + 2)) { F.retid();
            conv_wrest_a(F, LI);
            __syncthreads();
            { unsigned long long xa = 0; rwkv_stage_x<false>(F, LI, xa); } }
        SEAM(base + 2);
        TS(base + 3); if (IN(base + 3)) { F.retid();
            if (bx < 32) rwkv_stage_y(F, bx);
            else { pg8::StaticOrder S; S.init(64, 4, F.G - 32, bx - 32);
                pg8::Gemm g{(const bf16_t*)(F.ws + WS_PB), (const bf16_t*)(F.ws + WS_WPROJ)};
                EpiStore E{(bf16_t*)(F.H) + (size_t)16 * 1024 * 1024, D}; pg8::gemm_phase<EpiStore, false, PLE, PLE, 1 << 20, 0, 0>(F.lds, F.tid, g, S, E);
                __syncthreads(); conv_wrest_b(F, LI, bx - 32, F.G - 32); } }
        SEAM(base + 3);
        TS(base + 4); if (IN(base + 4)) { F.retid(); rwkv_stage_z<false>(F, LI); }
        SEAM(base + 4);
        TS(base + 5); if (IN(base + 5)) { F.retid(); pg8::StaticOrder S; S.init(64, 4, F.G, bx);
            if constexpr (LI < 3) { conv_win_even(F, LI + 1); __syncthreads(); }
            { pg8::Gemm g{Zp + 3072, (const bf16_t*)(F.ws + WS_WOUT)};
              EpiResid E{(const bf16_t*)(F.ws + WS_HB), Zp + 2048, ZW}; pg8::gemm_phase<EpiResid, false, ZW, D, 1 << 20, 0, 0>(F.lds, F.tid, g, S, E); } }
        SEAM(base + 5);
        TS(base + 6); if (IN(base + 6)) { F.retid(); pg8::StaticOrder S; S.init(64, 4, F.G, bx);
            pg8::Gemm g{Zp + 2048, (const bf16_t*)(F.ws + WS_WGATE)};
            EpiGate E{Zp + 2048, ZW, (const bf16_t*)(F.H) + (size_t)16 * 1024 * 1024, D, (bf16_t*)(F.ws + WS_HB), F.ssq(LI + 1)};
            pg8::gemm_phase<EpiGate, false, ZW, D, 1 << 20, 0, 0>(F.lds, F.tid, g, S, E); }
        SEAM(base + 6);
    }
}
__global__ void __launch_bounds__(512, 2) mk_fwd(Args args) {
    extern __shared__ __attribute__((aligned(16))) unsigned char lds_raw[];
    Frame F;
    F.lds = (LAS unsigned char*)lds_raw; F.ldsg = lds_raw;
    F.tid = threadIdx.x; F.lane = F.tid & 63; F.wave = __builtin_amdgcn_readfirstlane(F.tid >> 6);
    F.G = gridDim.x; const int bx = blockIdx.x; F.vcu = (F.G % 8 == 0) ? (bx % 8) * (F.G / 8) + bx / 8 : bx;
    F.H = args.out; F.ws = args.ws;
    volatile LAS unsigned* MISC = (volatile LAS unsigned*)(F.lds + MISC_OFF);
    for (int u = F.tid; u < 128; u += 512) ((LAS unsigned*)(F.lds + MISC_OFF))[u] = 0u;
    __syncthreads();
    XcdBarrier bar; bar.bar = (unsigned*)(F.ws + WS_CTL) + 4096; bar.x = 0; bar.st = nullptr;
#if !MK_MULTI
    bar = xcd_barrier_post((unsigned*)(F.ws + WS_CTL) + 4096, MISC + 8);
#endif
    const int lo = args.ph_lo, hi = args.ph_hi;
    if (IN(PH_P0)) { F.retid(); rows_p0(F); conv_win_even(F, 0); }
#if !MK_MULTI
    if (IN(0) && IN(1)) { VM_WAIT(); cg::this_grid().sync(); }
#endif
    unsigned long long tA = 0, tB = 0;
    TS(0);
    run_layer<0>(F, bar, lo, hi, bx, tA, tB);
    run_layer<1>(F, bar, lo, hi, bx, tA, tB);
    run_layer<2>(F, bar, lo, hi, bx, tA, tB);
    run_layer<3>(F, bar, lo, hi, bx, tA, tB);
    TS(PH_FINAL);
    if (IN(PH_FINAL)) { F.retid(); rows_final(F); }
    TS(PH_FINAL + 1);
    if ((MK_TPA >= 0 || MK_XA >= 0 || MK_GA >= 0) && blockIdx.x == 0 && F.wave == 0) { const unsigned long long t0 = __builtin_amdgcn_s_memrealtime(), span = 4ull * (MK_XA >= 0 ? ((volatile LAS unsigned long long*)(F.lds + MISC_OFF + 256))[1] : (tB - tA)); while (__builtin_amdgcn_s_memrealtime() - t0 < span) __builtin_amdgcn_s_sleep(8); }
}

extern "C" void kernel_launch(void* const* d_in, const int* in_sizes, int n_in, void* d_out, int out_size, void* d_ws, size_t ws_size, hipStream_t stream) {
    static int grid = 0;
    if (grid == 0) {
        int dev = 0, cus = 0, per_cu = 0;
        (void)hipGetDevice(&dev); (void)hipDeviceGetAttribute(&cus, hipDeviceAttributeMultiprocessorCount, dev);
        (void)hipFuncSetAttribute((const void*)mk_fwd, hipFuncAttributeMaxDynamicSharedMemorySize, LDS_BYTES);
        (void)hipOccupancyMaxActiveBlocksPerMultiprocessor(&per_cu, (const void*)mk_fwd, 512, LDS_BYTES);
        if (per_cu < 1) per_cu = 1;
        grid = cus * 1;
        if (n_in != 26 || ws_size < WS_END) fprintf(stderr, "kernel_launch: unexpected n_in %d / ws %zu\n", n_in, ws_size);
        (void)hipGetLastError();
    }
    (void)hipMemsetAsync((char*)d_ws + WS_CTL, 0, CTL_BYTES, stream);
    Args a{};
    for (int i = 0; i < 26; ++i) a.in[i] = (const float*)d_in[i];
    a.out = (float*)d_out; a.ws = (unsigned char*)d_ws;
#if MK_MULTI
    for (int ph = 0; ph < N_PHASES; ++ph) { a.ph_lo = ph; a.ph_hi = ph + 1; hipLaunchKernelGGL(mk_fwd, dim3(grid), dim3(512), LDS_BYTES, stream, a); }
#else
    a.ph_lo = 0; a.ph_hi = N_PHASES;
    void* kargs[] = {&a};
    hipError_t e = hipLaunchCooperativeKernel((const void*)mk_fwd, dim3(grid), dim3(512), kargs, LDS_BYTES, stream);
    if (e != hipSuccess) fprintf(stderr, "cooperative launch failed: %s (grid %d)\n", hipGetErrorString(e), grid);
#endif
}
```

```cpp
#include <hip/hip_runtime.h>
#include <hip/hip_cooperative_groups.h>
#include <cstdint>
#include <cstdio>
namespace cg = cooperative_groups;

#ifndef MK_PROBE
#define MK_PROBE 0
#endif
#ifndef MK_TPA
#define MK_TPA -1
#define MK_TPB -1
#endif
#ifndef MK_XA
#define MK_XA -1
#define MK_XB -1
#endif
#ifndef MK_GA
#define MK_GA -1
#define MK_GB -1
#endif
#ifndef MK_MULTI
#define MK_MULTI 0
#endif

#define LAS __attribute__((address_space(3)))
#define GAS __attribute__((address_space(1)))
typedef unsigned short bf16_t;
typedef short bf16x8 __attribute__((ext_vector_type(8)));
typedef float f32x4 __attribute__((ext_vector_type(4)));
typedef float f32x2 __attribute__((ext_vector_type(2)));
typedef unsigned u32x4 __attribute__((ext_vector_type(4)));
typedef unsigned u32x2 __attribute__((ext_vector_type(2)));

constexpr int D = 1024, BATCH = 2, SEQ = 8192, T = BATCH * SEQ, PLE = 256, ZW = 4096, ZE = 3072;
constexpr float QK_SCALE = 0.08838834764831845f;

__device__ __forceinline__ float bf2f(bf16_t v) { return __uint_as_float(((unsigned)v) << 16); }
__device__ __forceinline__ unsigned f2bf(float f) { unsigned u = __float_as_uint(f); return (u + 0x7fffu + ((u >> 16) & 1u)) >> 16; }
__device__ __forceinline__ unsigned pk2(float lo, float hi) { return f2bf(lo) | (f2bf(hi) << 16); }
typedef __bf16 bf16x2_t __attribute__((ext_vector_type(2)));
__device__ __forceinline__ unsigned cvt_pk_bf16(float lo, float hi) { f32x2 v = {lo, hi}; bf16x2_t b = __builtin_convertvector(v, bf16x2_t); return __builtin_bit_cast(unsigned, b); }
template <int CTRL> __device__ __forceinline__ float dpp_mov(float x) { return __builtin_bit_cast(float, __builtin_amdgcn_update_dpp(0, __builtin_bit_cast(int, x), CTRL, 0xf, 0xf, true)); }
__device__ __forceinline__ float red32(float x) { x += dpp_mov<0xB1>(x); x += dpp_mov<0x4E>(x); x += dpp_mov<0x141>(x); x += dpp_mov<0x140>(x);
    x += __builtin_bit_cast(float, __builtin_amdgcn_ds_swizzle(__builtin_bit_cast(int, x), 0x401F)); return x; }
__device__ __forceinline__ float wave_sum(float v) {
#pragma unroll
    for (int o = 1; o < 64; o <<= 1) v += __shfl_xor(v, o);
    return v;
}
__device__ __forceinline__ float sigmoidf_(float x) { return __builtin_amdgcn_rcpf(1.f + __expf(-x)); }
__device__ __forceinline__ float siluf_(float x) { return x * __builtin_amdgcn_rcpf(1.f + __expf(-x)); }
__device__ __forceinline__ float softplusf_(float x) { return x > 20.f ? x : log1pf(expf(x)); }
__device__ __forceinline__ float logsigf_(float x) { return -(x < -20.f ? -x : log1pf(expf(-x))); }
__device__ __forceinline__ float ssq_sum(const float* sq, int row) { const f32x4* p = (const f32x4*)(sq + (size_t)row * 16); const f32x4 a = p[0], b = p[1], c = p[2], d = p[3];
    return (((a[0] + a[1]) + (a[2] + a[3])) + ((b[0] + b[1]) + (b[2] + b[3]))) + (((c[0] + c[1]) + (c[2] + c[3])) + ((d[0] + d[1]) + (d[2] + d[3]))); }
#define LDS_WAIT() asm volatile("s_waitcnt lgkmcnt(0)" ::: "memory")
#define VM_WAIT() asm volatile("s_waitcnt vmcnt(0)" ::: "memory")

namespace pg8 {
constexpr int BM = 256, BK = 64, HALF = 128, HTB = HALF * BK * 2, STAGE_BYTES = 8 * HTB, NXCD = 8, WGM = 8;
__host__ __device__ __forceinline__ int lds_byte(int r, int c) { const int st = (r >> 4) * 2 + (c >> 5), rr = r & 15, cc = c & 31, ob = rr * 64 + cc * 2; return st * 1024 + (ob ^ (((ob >> 9) & 1) << 5)); }
__host__ __device__ __forceinline__ void stage_rc(int b, int& R, int& C) { const int st = b / 1024, sb = b % 1024, swz = sb ^ (((sb >> 9) & 1) << 5); R = (st >> 1) * 16 + swz / 64; C = (st & 1) * 32 + (swz % 64) / 2; }
__host__ __device__ __forceinline__ int perm32(int rho) { const int n = rho >> 4, i = rho & 15; return 8 * (i >> 2) + 4 * n + (i & 3); }
struct Unit { int pm, pn; };
struct Gemm { const bf16_t* A; const bf16_t* Bt; long brow = 0; };
struct StaticOrder {
    int nM, nN, nwg, G, c;
    __device__ void init(int nM_, int nN_, int G_, int c_) { nM = nM_; nN = nN_; nwg = nM * nN; G = G_; c = c_; }
    __device__ bool next(int i, Unit& u) const {
        const long L = (long)i * G + c; if (L >= nwg) return false;
        int wgid = (int)L; { const int q = nwg / NXCD, r = nwg % NXCD, xcd = wgid % NXCD, off = wgid / NXCD; wgid = (xcd < r ? xcd * (q + 1) : r * (q + 1) + (xcd - r) * q) + off; }
        const int nig = WGM * nN, gid = wgid / nig, fm = gid * WGM, gsz = (nM - fm) < WGM ? (nM - fm) : WGM;
        u.pm = fm + ((wgid % nig) % gsz); u.pn = (wgid % nig) / gsz; return true;
    }
};
template <class Epi, bool ALIGN_EPI, int LDA, int KK, int TSPLIT, long ASHIFT, long BROW>
__device__ __forceinline__ void gemm_phase(LAS unsigned char* lds, const int tid_in, const Gemm g, const StaticOrder& S, const Epi& E) {
    int tid = tid_in; asm volatile("" : "+v"(tid));
    const int wid = __builtin_amdgcn_readfirstlane(tid >> 6), lane = tid & 63, wr = wid >> 2, wc = wid & 3, fr = lane & 15, fq = lane >> 4;
    constexpr int K = KK, nt = K / BK, lda = LDA, tsplit = TSPLIT; constexpr long ashift = ASHIFT;
    unsigned voffA[2], voffB[2];
#pragma unroll
    for (int i = 0; i < 2; ++i) { int R, C; stage_rc(tid * 16 + i * 8192, R, C); const int Rb = (R & ~31) + perm32(R & 31);
        voffA[i] = (unsigned)(R * lda + C) * 2u; voffB[i] = (unsigned)(Rb * K + C) * 2u; }
    constexpr size_t kstep = (size_t)(BK * 2);
    constexpr size_t hstepA = (size_t)HALF * lda * 2, hstepB = (size_t)HALF * K * 2, tstepA = 2 * hstepA, tstepB = 2 * hstepB;
    const unsigned ldsw = (unsigned)wid * 1024u;
    const int aoff = lds_byte(wr * 64 + fr, fq * 8), boff = lds_byte(wc * 32 + fr, fq * 8);
#define PG8_AP(base, tt) ((base) + (((tt) < tsplit) ? (long)(tt) * 128 : ashift + (long)((tt) - tsplit) * 128))
#define PG8_ABASE(u) ((const char*)g.A + (size_t)(u).pm * tstepA + ((BROW != 0 && (u).pm >= 32) ? BROW : 0) + ((u).pm >= 32 ? g.brow : 0))
#define PG8_SA(b, h) (((b) * 2 + (h)) * HTB)
#define PG8_SB(b, h) ((4 + (b) * 2 + (h)) * HTB)
#define PG8_STAGE(bufoff, gbase, voff) do { const char* _gb = (const char*)(gbase); asm volatile("" : "+s"(_gb)); _Pragma("unroll") for (int _i = 0; _i < 2; ++_i) \
        __builtin_amdgcn_global_load_lds((const unsigned*)(_gb + (voff)[_i]), (LAS unsigned*)(lds + (bufoff) + ldsw + _i * 8192), 16, 0, 0); } while (0)
#define PG8_LDA(dst, b, h) do { _Pragma("unroll") for (int m = 0; m < 4; ++m) _Pragma("unroll") for (int k = 0; k < 2; ++k) dst[m][k] = *(const LAS bf16x8*)(lds + PG8_SA(b, h) + aoff + m * 2048 + k * 1024); } while (0)
#define PG8_LDB(dst, b, h) do { _Pragma("unroll") for (int n = 0; n < 2; ++n) _Pragma("unroll") for (int k = 0; k < 2; ++k) dst[n][k] = *(const LAS bf16x8*)(lds + PG8_SB(b, h) + boff + n * 2048 + k * 1024); } while (0)
#define PG8_MMA(ai, bj, At, Bt) do { __builtin_amdgcn_s_setprio(1); _Pragma("unroll") for (int m = 0; m < 4; ++m) _Pragma("unroll") for (int n = 0; n < 2; ++n) _Pragma("unroll") for (int k = 0; k < 2; ++k) \
        acc[ai][bj][m][n] = __builtin_amdgcn_mfma_f32_16x16x32_bf16(Bt[n][k], At[m][k], acc[ai][bj][m][n], 0, 0, 0); __builtin_amdgcn_s_setprio(0); } while (0)
#define PG8_WAIT_V(n) asm volatile("s_waitcnt vmcnt(" #n ")" ::: "memory")
#define PG8_WAIT_L(n) asm volatile("s_waitcnt lgkmcnt(" #n ")" ::: "memory")
#define PG8_BAR __builtin_amdgcn_s_barrier()
#define LBAR() do { asm volatile("s_waitcnt lgkmcnt(0)" ::: "memory"); __builtin_amdgcn_s_barrier(); asm volatile("" ::: "memory"); } while (0)
#define PG8_SCHED __builtin_amdgcn_sched_barrier(0)
    Unit cur, nxt; int ui = 0;
    if (!S.next(0, cur)) return;
    f32x4 acc[2][2][4][2];
#pragma unroll
    for (int a = 0; a < 2; ++a)
#pragma unroll
        for (int b = 0; b < 2; ++b)
#pragma unroll
            for (int m = 0; m < 4; ++m)
#pragma unroll
                for (int n = 0; n < 2; ++n) acc[a][b][m][n] = (f32x4){0.f, 0.f, 0.f, 0.f};
    bf16x8 At[4][2], B0[2][2], B1[2][2];
    const char* cA = PG8_ABASE(cur); const char* cB = (const char*)g.Bt + (size_t)cur.pn * tstepB;
    {
        const char* a0 = PG8_AP(cA, 0); const char* a1 = PG8_AP(cA, 1);
        PG8_STAGE(PG8_SB(0, 0), cB, voffB); PG8_STAGE(PG8_SB(0, 1), cB + hstepB, voffB); PG8_STAGE(PG8_SA(0, 0), a0, voffA); PG8_STAGE(PG8_SA(0, 1), a0 + hstepA, voffA);
        if (wr == 1) PG8_BAR;
        PG8_WAIT_V(2); PG8_BAR;
        PG8_STAGE(PG8_SB(1, 0), cB + kstep, voffB); PG8_STAGE(PG8_SA(1, 0), a1, voffA); PG8_STAGE(PG8_SB(1, 1), cB + hstepB + kstep, voffB);
        PG8_WAIT_V(6); PG8_BAR;
    }
    for (;;) {
        const bool has_next = S.next(ui + 1, nxt);
        const char* nA = has_next ? PG8_ABASE(nxt) : cA; const char* nB = has_next ? (const char*)g.Bt + (size_t)nxt.pn * tstepB : cB;
        for (int t = 0; t < nt; t += 2) {
            const bool last = (t == nt - 2);
            const char* a1 = PG8_AP(cA, t + 1);
            const char* a2 = last ? PG8_AP(nA, 0) : PG8_AP(cA, t + 2); const char* b2 = last ? nB : cB + (size_t)(t + 2) * kstep;
            const char* a3 = last ? PG8_AP(nA, 1) : PG8_AP(cA, t + 3); const char* b3 = b2 + kstep;
            PG8_LDB(B0, 0, 0); PG8_LDB(B1, 0, 1); PG8_SCHED; PG8_LDA(At, 0, 0); PG8_STAGE(PG8_SA(1, 1), a1 + hstepA, voffA);
            PG8_WAIT_V(8); PG8_WAIT_L(0); PG8_BAR; PG8_MMA(0, 0, At, B0); PG8_MMA(0, 1, At, B1); PG8_BAR; PG8_SCHED;
            PG8_LDA(At, 0, 1); PG8_STAGE(PG8_SB(0, 0), b2, voffB); PG8_STAGE(PG8_SB(0, 1), b2 + hstepB, voffB); PG8_STAGE(PG8_SA(0, 0), a2, voffA);
            PG8_WAIT_V(8); PG8_WAIT_L(0); PG8_BAR; PG8_MMA(1, 0, At, B0); PG8_MMA(1, 1, At, B1); PG8_BAR; PG8_SCHED;
            PG8_LDB(B0, 1, 0); PG8_LDB(B1, 1, 1); PG8_SCHED; PG8_LDA(At, 1, 0); PG8_STAGE(PG8_SA(0, 1), a2 + hstepA, voffA);
            PG8_WAIT_V(8); PG8_WAIT_L(0); PG8_BAR; PG8_MMA(0, 0, At, B0); PG8_MMA(0, 1, At, B1); PG8_BAR; PG8_SCHED;
            PG8_LDA(At, 1, 1); PG8_STAGE(PG8_SB(1, 0), b3, voffB); PG8_STAGE(PG8_SB(1, 1), b3 + hstepB, voffB); PG8_STAGE(PG8_SA(1, 0), a3, voffA);
            PG8_WAIT_V(8); PG8_WAIT_L(0); PG8_BAR; PG8_MMA(1, 0, At, B0); PG8_MMA(1, 1, At, B1); PG8_BAR; PG8_SCHED;
        }
        if constexpr (ALIGN_EPI) { if (wr == 0) PG8_BAR; }
        E(acc, cur, wr, wc, fr, fq);
        if (!has_next) break;
#pragma unroll
        for (int a = 0; a < 2; ++a)
#pragma unroll
            for (int b = 0; b < 2; ++b)
#pragma unroll
                for (int m = 0; m < 4; ++m)
#pragma unroll
                    for (int n = 0; n < 2; ++n) acc[a][b][m][n] = (f32x4){0.f, 0.f, 0.f, 0.f};
        cur = nxt; cA = nA; cB = nB; ++ui;
        if constexpr (ALIGN_EPI) { if (wr == 1) PG8_BAR; }
    }
    PG8_WAIT_V(0);
    if constexpr (!ALIGN_EPI) { if (wr == 0) PG8_BAR; }
    PG8_BAR;
#undef PG8_AP
#undef PG8_ABASE
#undef PG8_SA
#undef PG8_SB
#undef PG8_STAGE
#undef PG8_LDA
#undef PG8_LDB
#undef PG8_MMA
#undef PG8_WAIT_V
#undef PG8_WAIT_L
#undef PG8_BAR
#undef PG8_SCHED
}
}

template <class Fn>
__device__ __forceinline__ void epi_for(const f32x4 (&acc)[2][2][4][2], const pg8::Unit& u, int wr, int wc, int fr, int fq, Fn fn) {
#pragma unroll
    for (int ai = 0; ai < 2; ++ai)
#pragma unroll
        for (int m = 0; m < 4; ++m) { const int row = u.pm * 256 + ai * 128 + wr * 64 + m * 16 + fr;
#pragma unroll
            for (int bj = 0; bj < 2; ++bj) { const int col = u.pn * 256 + bj * 128 + wc * 32 + 8 * fq; fn(row, col, acc[ai][bj][m][0], acc[ai][bj][m][1]); }
            if (m & 1) asm volatile("" ::: "memory"); }
}
__device__ __forceinline__ u32x4 pack8(f32x4 v0, f32x4 v1) { u32x4 w; w.x = cvt_pk_bf16(v0[0], v0[1]); w.y = cvt_pk_bf16(v0[2], v0[3]); w.z = cvt_pk_bf16(v1[0], v1[1]); w.w = cvt_pk_bf16(v1[2], v1[3]); return w; }

struct EpiEvenIn {
    bf16_t* Z; const float* ssq; bf16_t* VTa; bf16_t* VTb; bf16_t* KT; LAS unsigned char* spare;
    template <class ValFn>
    __device__ __forceinline__ void tstore(bf16_t* dst, const pg8::Unit& u, int wr, int wc, int fr, int fq, ValFn val) const {
        asm volatile("" : "+v"(fr), "+v"(fq));
        LAS bf16_t* tl = (LAS bf16_t*)(spare + (wr * 4 + wc) * 4032); const int lane = fq * 16 + fr;
#pragma unroll
        for (int ai = 0; ai < 2; ++ai)
#pragma unroll
            for (int bj = 0; bj < 2; ++bj) {
                const int row0 = u.pm * 256 + ai * 128 + wr * 64, cg0 = (u.pn * 256 + bj * 128 + wc * 32) & 511, b = row0 >> 13, t0 = row0 & (SEQ - 1);
#pragma unroll
                for (int half = 0; half < 2; ++half) {
#pragma unroll
                    for (int mm = 0; mm < 2; ++mm) { float o[8]; val(ai, 2 * half + mm, bj, o);
#pragma unroll
                        for (int j = 0; j < 8; ++j) tl[(8 * fq + j) * 32 + 16 * mm + fr] = (bf16_t)f2bf(o[j]); }
                    asm volatile("s_waitcnt lgkmcnt(0)" ::: "memory");
#pragma unroll
                    for (int r = 0; r < 2; ++r) { const int c = lane + 64 * r, d = c >> 2, part = c & 3; const u32x4 w = *(const LAS u32x4*)(tl + d * 32 + part * 8);
                        *(u32x4*)(dst + ((size_t)(b * 512 + cg0 + d)) * SEQ + t0 + 32 * half + 8 * part) = w; }
                    asm volatile("s_waitcnt lgkmcnt(0)" ::: "memory");
                }
            }
    }
    __device__ __forceinline__ void operator()(const f32x4 (&acc)[2][2][4][2], const pg8::Unit& u, int wr, int wc, int fr, int fq) const {
        const int g = u.pn >> 1;
        float rs8[8];
        { f32x4 pr[8];
#pragma unroll
          for (int it = 0; it < 8; ++it) pr[it] = *(const f32x4*)(ssq + (size_t)(u.pm * 256 + (it >> 2) * 128 + wr * 64 + (it & 3) * 16 + fr) * 16 + 4 * fq);
#pragma unroll
          for (int it = 0; it < 8; ++it) { float s_ = (pr[it][0] + pr[it][1]) + (pr[it][2] + pr[it][3]); s_ += __shfl_xor(s_, 16); s_ += __shfl_xor(s_, 32); rs8[it] = rsqrtf(s_ * (1.f / D) + 1e-6f); } }
        if (g == 2 || g == 6) {
            tstore(g == 2 ? VTa : VTb, u, wr, wc, fr, fq, [&](int ai, int m, int bj, float (&o)[8]) {
                const float rs = rs8[ai * 4 + m];
                const f32x4 v0 = acc[ai][bj][m][0] * rs, v1 = acc[ai][bj][m][1] * rs;
                o[0] = v0[0]; o[1] = v0[1]; o[2] = v0[2]; o[3] = v0[3]; o[4] = v1[0]; o[5] = v1[1]; o[6] = v1[2]; o[7] = v1[3]; });
            return;
        }
        if (g == 1) {
            tstore(KT, u, wr, wc, fr, fq, [&](int ai, int m, int bj, float (&o)[8]) {
                const int row = u.pm * 256 + ai * 128 + wr * 64 + m * 16 + fr, col = u.pn * 256 + bj * 128 + wc * 32 + 8 * fq; const float rs = rs8[ai * 4 + m];
                const f32x4 v0 = acc[ai][bj][m][0] * rs, v1 = acc[ai][bj][m][1] * rs; const int cg = col & 511, t = row & (SEQ - 1);
                const float pos = (float)t; const int i0 = (cg & 127) >> 1;
                float q[8] = {v0[0], v0[1], v0[2], v0[3], v1[0], v1[1], v1[2], v1[3]};
                _Pragma("unroll") for (int j = 0; j < 4; ++j) { const float inv = exp2f(-(float)(i0 + j) * (13.287712379549449f / 64.f));
                    float rev = pos * inv * 0.15915494309189535f; rev = rev - floorf(rev); const float sn = __builtin_amdgcn_sinf(rev), cs = __builtin_amdgcn_cosf(rev);
                    const float x1 = q[2 * j], x2 = q[2 * j + 1]; q[2 * j] = x1 * cs - x2 * sn; q[2 * j + 1] = x1 * sn + x2 * cs; }
                const float lg2 = log2f(1.f - exp2f(-5.f - (float)(cg >> 7))); const float ip1 = (float)((t & 127) + 1);
                const float f = exp2f(-ip1 * lg2), f2 = exp2f((128.f - ip1) * lg2);
                *(u32x4*)(Z + (size_t)row * ZE + 512 + cg) = pack8((f32x4){q[0] * f, q[1] * f, q[2] * f, q[3] * f}, (f32x4){q[4] * f, q[5] * f, q[6] * f, q[7] * f});
                _Pragma("unroll") for (int j = 0; j < 8; ++j) o[j] = q[j] * f2; });
            return;
        }
#pragma unroll
        for (int ai = 0; ai < 2; ++ai)
#pragma unroll
          for (int m = 0; m < 4; ++m) { const int row = u.pm * 256 + ai * 128 + wr * 64 + m * 16 + fr; const float rs = rs8[ai * 4 + m];
#pragma unroll
            for (int bj = 0; bj < 2; ++bj) { const int col = u.pn * 256 + bj * 128 + wc * 32 + 8 * fq; const f32x4 v0 = acc[ai][bj][m][0] * rs, v1 = acc[ai][bj][m][1] * rs;
            const int cg = col & 511, t = row & (SEQ - 1);
            if (g == 0) {
                const float pos = (float)t; const int i0 = (cg & 127) >> 1;
                float o[8] = {v0[0], v0[1], v0[2], v0[3], v1[0], v1[1], v1[2], v1[3]};
                _Pragma("unroll") for (int j = 0; j < 4; ++j) { const float inv = exp2f(-(float)(i0 + j) * (13.287712379549449f / 64.f));
                    float rev = pos * inv * 0.15915494309189535f; rev = rev - floorf(rev); const float sn = __builtin_amdgcn_sinf(rev), cs = __builtin_amdgcn_cosf(rev);
                    const float x1 = o[2 * j], x2 = o[2 * j + 1]; o[2 * j] = x1 * cs - x2 * sn; o[2 * j + 1] = x1 * sn + x2 * cs; }
                const float lg2 = log2f(1.f - exp2f(-5.f - (float)(cg >> 7))); const float ip1 = (float)((t & 127) + 1); const float f = exp2f(ip1 * lg2);
                *(u32x4*)(Z + (size_t)row * ZE + cg) = pack8((f32x4){o[0] * f, o[1] * f, o[2] * f, o[3] * f}, (f32x4){o[4] * f, o[5] * f, o[6] * f, o[7] * f});
            } else {
                const int zc = (g - 1 - (g > 6 ? 1 : 0)) * 512;
                *(u32x4*)(Z + (size_t)row * ZE + zc + cg) = pack8(v0, v1);
            }
            }
            if (m & 1) asm volatile("" ::: "memory"); }
    }
};
struct EpiOddIn {
    bf16_t* Z; bf16_t* L1; int pn0;
    __device__ __forceinline__ void operator()(const f32x4 (&acc)[2][2][4][2], const pg8::Unit& u_, int wr, int wc, int fr, int fq) const {
        pg8::Unit u = u_; u.pn += pn0;
        if (u.pn < 16) { epi_for(acc, u, wr, wc, fr, fq, [&](int row, int col, f32x4 v0, f32x4 v1) { *(u32x4*)(Z + (size_t)row * ZW + col) = pack8(v0, v1); }); }
        else { epi_for(acc, u, wr, wc, fr, fq, [&](int row, int col, f32x4 v0, f32x4 v1) { const int c = col - 4096; if (c < 64) {
                    _Pragma("unroll") for (int j = 0; j < 4; ++j) { v0[j] = tanhf(v0[j]); v1[j] = tanhf(v1[j]); } }
                *(u32x4*)(L1 + (size_t)row * 256 + c) = pack8(v0, v1); }); }
    }
};
__device__ __forceinline__ void unpack8(const u32x4 w, f32x4& a, f32x4& b) {
    a = (f32x4){__uint_as_float(w.x << 16), __uint_as_float(w.x & 0xffff0000u), __uint_as_float(w.y << 16), __uint_as_float(w.y & 0xffff0000u)};
    b = (f32x4){__uint_as_float(w.z << 16), __uint_as_float(w.z & 0xffff0000u), __uint_as_float(w.w << 16), __uint_as_float(w.w & 0xffff0000u)}; }
struct EpiResid {
    const bf16_t* Ha; bf16_t* HB; int ldb;
    __device__ __forceinline__ void operator()(const f32x4 (&acc)[2][2][4][2], const pg8::Unit& u, int wr, int wc, int fr, int fq) const {
        u32x4 hq[3][2]; const int rowb = u.pm * 256 + wr * 64 + fr, colb = u.pn * 256 + wc * 32 + 8 * fq;
        auto ld = [&](int it, int sl) { const size_t row = rowb + (it >> 2) * 128 + (it & 3) * 16;
            _Pragma("unroll") for (int bj = 0; bj < 2; ++bj) hq[sl][bj] = *(const u32x4*)(Ha + row * D + colb + bj * 128); };
        ld(0, 0); ld(1, 1);
#pragma unroll
        for (int it = 0; it < 8; ++it) { if (it + 2 < 8) ld(it + 2, (it + 2) % 3);
            const int ai = it >> 2, m = it & 3; const size_t row = rowb + ai * 128 + m * 16;
#pragma unroll
            for (int bj = 0; bj < 2; ++bj) { f32x4 h0, h1; unpack8(hq[it % 3][bj], h0, h1); h0 = h0 + acc[ai][bj][m][0]; h1 = h1 + acc[ai][bj][m][1];
                *(u32x4*)(HB + row * ldb + colb + bj * 128) = pack8(h0, h1); }
            asm volatile("" ::: "memory"); }
    }
};
struct EpiStore {
    bf16_t* O; int ldc;
    __device__ __forceinline__ void operator()(const f32x4 (&acc)[2][2][4][2], const pg8::Unit& u, int wr, int wc, int fr, int fq) const {
        epi_for(acc, u, wr, wc, fr, fq, [&](int row, int col, f32x4 v0, f32x4 v1) { *(u32x4*)(O + (size_t)row * ldc + col) = pack8(v0, v1); });
    }
};
struct EpiGate {
    const bf16_t* Hb; int ldh; const bf16_t* PP; int ldp; bf16_t* Ha; float* ssq;
    __device__ __forceinline__ void operator()(const f32x4 (&acc)[2][2][4][2], const pg8::Unit& u, int wr, int wc, int fr, int fq) const {
        u32x4 hq[3][2], pq[3][2]; const int rowb = u.pm * 256 + wr * 64 + fr, colb = u.pn * 256 + wc * 32 + 8 * fq;
        auto ld = [&](int it, int sl) { const size_t row = rowb + (it >> 2) * 128 + (it & 3) * 16;
            _Pragma("unroll") for (int bj = 0; bj < 2; ++bj) { hq[sl][bj] = *(const u32x4*)(Hb + row * ldh + colb + bj * 128); pq[sl][bj] = *(const u32x4*)(PP + row * ldp + colb + bj * 128); } };
        ld(0, 0); ld(1, 1);
#pragma unroll
        for (int it = 0; it < 8; ++it) { if (it + 2 < 8) ld(it + 2, (it + 2) % 3);
            const int ai = it >> 2, m = it & 3; const size_t row = rowb + ai * 128 + m * 16; float sq = 0.f;
#pragma unroll
            for (int bj = 0; bj < 2; ++bj) { const f32x4 v0 = acc[ai][bj][m][0], v1 = acc[ai][bj][m][1];
                f32x4 h0, h1, p0, p1; unpack8(hq[it % 3][bj], h0, h1); unpack8(pq[it % 3][bj], p0, p1);
#pragma unroll
                for (int j = 0; j < 4; ++j) { h0[j] += sigmoidf_(v0[j]) * p0[j]; h1[j] += sigmoidf_(v1[j]) * p1[j]; sq += h0[j] * h0[j] + h1[j] * h1[j]; }
                *(u32x4*)(Ha + row * D + colb + bj * 128) = pack8(h0, h1); }
            sq += __shfl_xor(sq, 16); sq += __shfl_xor(sq, 32);
            if (fq == 0) ssq[row * 16 + u.pn * 4 + wc] = sq;
            asm volatile("" ::: "memory"); }
    }
};

#define XB_TMO      128
#define XB_XCNT(j)  (256  + 64 * (j))
#define XB_XSUB(j)  (1280 + 64 * (j))
#define XB_XGEN(j)  (2304 + 64 * (j))
#define XB_TOP      3328
#define XB_TOPGEN   3392
#define XCD_BAR_WORDS 3456
#define XB_SPIN_CAP (1u << 22)
__device__ __forceinline__ unsigned xb_ld(unsigned* p)              { return __hip_atomic_load(p, __ATOMIC_RELAXED, __HIP_MEMORY_SCOPE_AGENT); }
__device__ __forceinline__ unsigned xb_add(unsigned* p, unsigned v) { return __hip_atomic_fetch_add(p, v, __ATOMIC_RELAXED, __HIP_MEMORY_SCOPE_AGENT); }
__device__ __forceinline__ unsigned xb_xcc_id() { return (unsigned)__builtin_amdgcn_s_getreg((3 << 11) | 20) & 0xFu; }
#define XB_SPIN(cond, bar) do { unsigned _sp = 0; while (cond) { __builtin_amdgcn_s_sleep(1); \
    if ((++_sp & 255u) == 0u) { if (xb_ld(&(bar)[XB_TMO])) break; if (_sp > XB_SPIN_CAP) { atomicAdd(&(bar)[XB_TMO], 1u); break; } } } } while (0)
struct XcdBarrier { unsigned* bar; unsigned x; volatile LAS unsigned* st; };
__device__ __forceinline__ XcdBarrier xcd_barrier_post(unsigned* bar, volatile LAS unsigned* st) {
    XcdBarrier b; b.bar = bar; b.x = xb_xcc_id(); b.st = st;
    if (threadIdx.x == 0) (void)xb_add(&bar[XB_XCNT(b.x)], 1u);
    return b;
}
__device__ __forceinline__ void xcd_barrier_complete(unsigned* bar, unsigned x, unsigned& nloc, unsigned& nx) {
    const unsigned G = gridDim.x * gridDim.y * gridDim.z;
    unsigned sum, cnt, mine, sp = 0u;
    for (;;) {
        sum = 0u; cnt = 0u; mine = 0u;
#pragma unroll
        for (unsigned j = 0; j < 16; ++j) { const unsigned c = xb_ld(&bar[XB_XCNT(j)]); sum += c; cnt += (c > 0u) ? 1u : 0u; mine = (j == x) ? c : mine; }
        if (sum == G) break;
        __builtin_amdgcn_s_sleep(1);
        if ((++sp & 255u) == 0u) { if (xb_ld(&bar[XB_TMO])) break; if (sp > XB_SPIN_CAP) { atomicAdd(&bar[XB_TMO], 1u); break; } }
    }
    nloc = mine > 0u ? mine : 1u; nx = cnt > 0u ? cnt : 1u;
}
__device__ __forceinline__ void xcd_barrier(const XcdBarrier& b_in) {
    asm volatile("s_waitcnt vmcnt(0)" ::: "memory");
    __syncthreads();
    if (threadIdx.x == 0) {
        const XcdBarrier& b = b_in;
        unsigned* bar = b.bar;
        __builtin_amdgcn_s_waitcnt(0);
        unsigned nloc = b.st[0], nx = b.st[1];
        if (nloc == 0u) { xcd_barrier_complete(bar, b.x, nloc, nx); b.st[0] = nloc; b.st[1] = nx; }
        const unsigned old = xb_add(&bar[XB_XSUB(b.x)], 1u);
        const unsigned gen = old / nloc;
        if (old + 1u == (gen + 1u) * nloc) {
            __builtin_amdgcn_fence(__ATOMIC_RELEASE, "agent");
            asm volatile("s_waitcnt vmcnt(0)" ::: "memory");
            const unsigned og = xb_add(&bar[XB_TOP], 1u);
            const unsigned tg = og / nx;
            if (og + 1u == (tg + 1u) * nx) xb_add(&bar[XB_TOPGEN], 1u);
            else XB_SPIN(xb_ld(&bar[XB_TOPGEN]) == tg, bar);
            __builtin_amdgcn_fence(__ATOMIC_ACQUIRE, "agent");
            xb_add(&bar[XB_XGEN(b.x)], 1u);
            asm volatile("s_waitcnt vmcnt(0)" ::: "memory");
        } else {
            XB_SPIN(xb_ld(&bar[XB_XGEN(b.x)]) == gen, bar);
            __builtin_amdgcn_fence(__ATOMIC_ACQUIRE, "agent");
            asm volatile("s_waitcnt vmcnt(0)" ::: "memory");
        }
    }
    __syncthreads();
}

constexpr size_t MiB = 1u << 20;
constexpr size_t WS_CTL = 0, CTL_BYTES = 1 * MiB;
constexpr size_t WS_SSQ = 250 * (size_t)(1u << 20);
constexpr size_t WS_WIN = 2 * MiB;
constexpr size_t WS_WOUT = 19 * MiB, WS_WGATE = 21 * MiB, WS_WPROJ = 23 * MiB;
constexpr size_t WS_PB = 24 * MiB;
constexpr size_t WS_Z = 32 * MiB;
constexpr size_t WS_HB = 160 * MiB;
constexpr size_t WS_VF = 193 * MiB;
constexpr size_t WS_L1 = 225 * MiB;
constexpr size_t WS_VTA = 128 * MiB;
constexpr size_t WS_VTB = 144 * MiB;
constexpr size_t WS_KT = 225 * MiB;
constexpr size_t WS_LORA2 = 23 * MiB + 512 * 1024;
constexpr size_t WS_PG = 160 * MiB;
constexpr size_t WS_SB = 2 * MiB;
constexpr size_t WS_BON = 192 * MiB;
constexpr size_t WS_ST = 176 * MiB;
constexpr size_t WS_KV = 160 * MiB;
constexpr size_t WS_XR1 = 233 * MiB;
constexpr size_t XR0_OFF = 32 * MiB + 4096;
constexpr size_t WS_END = 256 * MiB;

constexpr int RING_BYTES = 131072, LDS_BYTES = 163840, MISC_OFF = LDS_BYTES - 512;

struct Args { const float* in[26]; float* out; unsigned char* ws; int ph_lo, ph_hi; };

__device__ __forceinline__ const float* inptr(int i) { asm volatile("" : "+s"(i)); const char* ka = (const char*)__builtin_amdgcn_kernarg_segment_ptr(); return *(const float* const*)(ka + 8 * i); }
struct InTab { __device__ __forceinline__ const float* operator[](int i) const { return inptr(i); } };
struct Frame {
    LAS unsigned char* lds; unsigned char* ldsg;
    int tid, lane, wave, G, vcu;
    InTab in; float* H; unsigned char* ws;
    __device__ __forceinline__ void retid() { int l; asm volatile("v_mbcnt_lo_u32_b32 %0, -1, 0\n\tv_mbcnt_hi_u32_b32 %0, -1, %0" : "=v"(l)); lane = l; tid = wave * 64 + l; }
    __device__ __forceinline__ float* ssq(int l) const { return (float*)(ws + WS_SSQ) + (size_t)l * T * 16; }
};

__device__ __forceinline__ void conv_item(const float* W, int ldw, int Kmax, int k0, int n0, bf16_t* dst, int ldd, int dr0, int drs, int dk0,
                                          const float* svec, float sa, float sb, float sc, LAS float* scr, int lane) {
    float wv[32];
#pragma unroll
    for (int i = 0; i < 32; ++i) { const int k = k0 + 2 * i + (lane >> 5); wv[i] = (k < Kmax) ? W[(size_t)k * ldw + n0 + (lane & 31)] : 0.f; }
#pragma unroll
    for (int i = 0; i < 32; ++i) { const int kk = 2 * i + (lane >> 5), k = k0 + kk; const float f = (k < Kmax) ? (sa + sb * (svec ? svec[k] : 0.f)) * sc : 0.f;
        scr[kk * 33 + (lane & 31)] = wv[i] * f; }
    LDS_WAIT(); asm volatile("" ::: "memory");
    const int c = lane & 7;
    if (k0 + 8 * c < Kmax) {
#pragma unroll
        for (int j = 0; j < 4; ++j) { const int n = (lane >> 3) + 8 * j; const LAS float* s = scr + (8 * c) * 33 + n;
            u32x4 o; o.x = pk2(s[0 * 33], s[1 * 33]); o.y = pk2(s[2 * 33], s[3 * 33]); o.z = pk2(s[4 * 33], s[5 * 33]); o.w = pk2(s[6 * 33], s[7 * 33]);
            *(GAS u32x4*)(dst + (size_t)(dr0 + n * drs) * ldd + dk0 + k0 + 8 * c) = o; }
    }
    LDS_WAIT(); asm volatile("" ::: "memory");
}
__device__ __forceinline__ void conv_item2(const float* W, int ldw, int k0, int n0, bf16_t* dst, int dr0, const float* mu, float sc, LAS float* scr, int lane) {
    float wv[32];
#pragma unroll
    for (int i = 0; i < 32; ++i) wv[i] = W[(size_t)(k0 + 2 * i + (lane >> 5)) * ldw + n0 + (lane & 31)];
#pragma unroll
    for (int half = 0; half < 2; ++half) {
#pragma unroll
        for (int i = 0; i < 32; ++i) { const int kk = 2 * i + (lane >> 5); const float m = mu[k0 + kk]; scr[kk * 33 + (lane & 31)] = wv[i] * ((half ? m : 1.f - m) * sc); }
        LDS_WAIT(); asm volatile("" ::: "memory");
        const int c = lane & 7;
#pragma unroll
        for (int j = 0; j < 4; ++j) { const int n = (lane >> 3) + 8 * j; const LAS float* s_ = scr + (8 * c) * 33 + n;
            u32x4 o; o.x = pk2(s_[0 * 33], s_[1 * 33]); o.y = pk2(s_[2 * 33], s_[3 * 33]); o.z = pk2(s_[4 * 33], s_[5 * 33]); o.w = pk2(s_[6 * 33], s_[7 * 33]);
            *(GAS u32x4*)(dst + (size_t)(dr0 + n) * 2048 + half * 1024 + k0 + 8 * c) = o; }
        LDS_WAIT(); asm volatile("" ::: "memory");
    }
}
__device__ __forceinline__ void conv_win_even(Frame& F, int li) {
    const int e = li >> 1; const float* W = F.in[6] + (size_t)e * D * ZW; const float* gain = F.in[2] + li * D; bf16_t* dst = (bf16_t*)(F.ws + WS_WIN);
    LAS float* scr = (LAS float*)(F.lds + F.wave * 16384);
    const int gw = F.vcu * 8 + F.wave, NGW = F.G * 8;
    for (int it = gw; it < 16 * 128; it += NGW) { const int kb = it >> 7, nb = it & 127, n0 = nb * 32, g = n0 >> 9, hh = (n0 & 511) >> 7, d0 = n0 & 127;
        int dr0 = n0, drs = 1; if (g < 2) { dr0 = g * 512 + hh * 128 + (d0 < 64 ? 2 * d0 : 2 * (d0 - 64) + 1); drs = 2; }
        const float sc = (g == 1 || g == 5) ? QK_SCALE : 1.f;
        conv_item(W, ZW, D, kb * 64, n0, dst, D, dr0, drs, 0, gain, 0.f, 1.f, sc, scr, F.lane); }
}
__device__ __forceinline__ void conv_win_odd(Frame& F, int li) {
    const int o = li >> 1; const float* mu = F.in[9] + (size_t)o * 6 * D; bf16_t* dst = (bf16_t*)(F.ws + WS_WIN);
    LAS float* scr = (LAS float*)(F.lds + F.wave * 16384);
    const int gw = F.vcu * 8 + F.wave, NGW = F.G * 8;
    bf16_t* dst2 = dst + (size_t)1024 * 1024;
    for (int it = gw; it < 4 * 512; it += NGW) { const int p = it >> 9, r = it & 511, kb = r >> 5, nb = r & 31;
        if (p == 0) conv_item(F.in[10] + (size_t)o * 4 * D * D, D, D, kb * 64, nb * 32, dst, D, nb * 32, 1, 0, nullptr, 1.f, 0.f, 1.f, scr, F.lane);
        else conv_item2(F.in[10] + ((size_t)o * 4 + p) * D * D, D, kb * 64, nb * 32, dst2, (p - 1) * 1024 + nb * 32, mu + p * D, 1.f, scr, F.lane); }
    for (int it = gw; it < 32 + 32 + 16; it += NGW) { const float* W; int ldw, n0, dr0, mi, kb; const int r = it;
        if (r < 32) { W = F.in[13] + (size_t)o * D * 64; ldw = 64; kb = r >> 1; n0 = (r & 1) * 32; dr0 = 3072 + n0; mi = 4; }
        else if (r < 64) { const int q = r - 32; W = F.in[16] + (size_t)o * D * 64; ldw = 64; kb = q >> 1; n0 = (q & 1) * 32; dr0 = 3136 + n0; mi = 5; }
        else { const int q = r - 64; W = F.in[19]; ldw = 32; kb = q; n0 = 0; dr0 = 3200; mi = 2; }
        conv_item2(W, ldw, kb * 64, n0, dst2, dr0, mu + mi * D, (r >= 64 && o == 0) ? 0.f : 1.f, scr, F.lane); }
    { u32x4 z = {0u, 0u, 0u, 0u}; GAS u32x4* zp = (GAS u32x4*)(dst2 + (size_t)3232 * 2048); const int n16 = 96 * 2048 * 2 / 16;
      for (int i = (F.vcu * 512 + F.tid); i < n16; i += F.G * 512) zp[i] = z; }
}
__device__ __forceinline__ void conv_wrest_a(Frame& F, int li) {
    const float* Wp = F.in[4] + (size_t)li * PLE * D;
    LAS float* scr = (LAS float*)(F.lds + F.wave * 16384);
    const int gw = F.vcu * 8 + F.wave, NGW = F.G * 8;
    for (int r = gw; r < 128; r += NGW) conv_item(Wp, D, PLE, (r >> 5) * 64, (r & 31) * 32, (bf16_t*)(F.ws + WS_WPROJ), PLE, (r & 31) * 32, 1, 0, nullptr, 1.f, 0.f, 1.f, scr, F.lane);
    const float* P = F.in[1] + (size_t)li * T * PLE; GAS u32x4* pb = (GAS u32x4*)(F.ws + WS_PB); const int n8 = T * PLE / 8;
    const int stp = F.G * 512;
    for (int i0 = F.vcu * 512 + F.tid; i0 < n8; i0 += 4 * stp) { f32x4 a[4], b[4];
#pragma unroll
        for (int j = 0; j < 4; ++j) { const int i = min(i0 + j * stp, n8 - 1); a[j] = *(const f32x4*)(P + (size_t)i * 8); b[j] = *(const f32x4*)(P + (size_t)i * 8 + 4); }
#pragma unroll
        for (int j = 0; j < 4; ++j) { const int i = i0 + j * stp;
            u32x4 o; o.x = cvt_pk_bf16(a[j][0], a[j][1]); o.y = cvt_pk_bf16(a[j][2], a[j][3]); o.z = cvt_pk_bf16(b[j][0], b[j][1]); o.w = cvt_pk_bf16(b[j][2], b[j][3]); if (i < n8) pb[i] = o; } }
}
__device__ __forceinline__ void conv_wrest_b(Frame& F, int li, int widx, int nw) {
    const bool even = (li & 1) == 0; const int e = li >> 1;
    const float* Wo = even ? F.in[7] + (size_t)e * D * D : F.in[11] + (size_t)e * D * D; const float* Wg = F.in[5] + (size_t)li * D * D;
    LAS float* scr = (LAS float*)(F.lds + F.wave * 16384);
    for (int it = widx * 8 + F.wave; it < 1024; it += nw * 8) {
        if (it < 512) conv_item(Wo, D, D, (it >> 5) * 64, (it & 31) * 32, (bf16_t*)(F.ws + WS_WOUT), D, (it & 31) * 32, 1, 0, nullptr, 1.f, 0.f, 1.f, scr, F.lane);
        else { const int r = it - 512; conv_item(Wg, D, D, (r >> 5) * 64, (r & 31) * 32, (bf16_t*)(F.ws + WS_WGATE), D, (r & 31) * 32, 1, 0, nullptr, 1.f, 0.f, 1.f, scr, F.lane); }
    }
}
__device__ __forceinline__ void conv_lora2(Frame& F, int li) {
    const int o = li >> 1; LAS float* scr = (LAS float*)(F.lds + F.wave * 16384);
    bf16_t* W2T = (bf16_t*)(F.ws + WS_LORA2); bf16_t* A2T = W2T + 1024 * 64; bf16_t* V2T = A2T + 1024 * 64;
    const int gw = F.vcu * 8 + F.wave, NGW = F.G * 8;
    for (int it = gw; it < 96; it += NGW) {
        if (it < 32) conv_item(F.in[14] + (size_t)o * 64 * D, D, 64, 0, it * 32, W2T, 64, it * 32, 1, 0, nullptr, 1.f, 0.f, 1.f, scr, F.lane);
        else if (it < 64) conv_item(F.in[17] + (size_t)o * 64 * D, D, 64, 0, (it - 32) * 32, A2T, 64, (it - 32) * 32, 1, 0, nullptr, 1.f, 0.f, 1.f, scr, F.lane);
        else conv_item(F.in[20], D, 32, 0, (it - 64) * 32, V2T, 32, (it - 64) * 32, 1, 0, nullptr, 1.f, 0.f, 1.f, scr, F.lane);
    }
}
__device__ __forceinline__ void rows_p0(Frame& F) {
    const float* x = F.in[0]; bf16_t* HB = (bf16_t*)(F.ws + WS_HB); float* s0 = F.ssq(0);
    for (int row = F.vcu * 8 + F.wave; row < T; row += F.G * 8) {
        const f32x4* xr = (const f32x4*)(x + (size_t)row * D) + F.lane; u32x2* br = (u32x2*)(HB + (size_t)row * D) + F.lane; float s = 0.f;
#pragma unroll
        for (int j = 0; j < 4; ++j) { const f32x4 v = xr[64 * j]; s += (v[0] * v[0] + v[1] * v[1]) + (v[2] * v[2] + v[3] * v[3]); u32x2 w; w.x = pk2(v[0], v[1]); w.y = pk2(v[2], v[3]); br[64 * j] = w; }
        s = wave_sum(s); if (F.lane < 16) s0[(size_t)row * 16 + F.lane] = F.lane == 0 ? s : 0.f;
    }
}
__device__ __forceinline__ void rows_norm(Frame& F, int li) {
    const float* gain = F.in[2] + li * D; const float* mur = F.in[9] + (size_t)(li >> 1) * 6 * D; bf16_t* HN = (bf16_t*)(F.H); const bf16_t* Ha = (const bf16_t*)(F.ws + WS_HB); const float* sq = F.ssq(li);
    bf16_t* XR0 = (bf16_t*)((char*)F.H + XR0_OFF); bf16_t* XR1 = (bf16_t*)(F.ws + WS_XR1);
    f32x4 g[4], mu[4];
#pragma unroll
    for (int j = 0; j < 4; ++j) { g[j] = *((const f32x4*)gain + F.lane + 64 * j); mu[j] = *((const f32x4*)mur + F.lane + 64 * j); }
    for (int row = F.vcu * 8 + F.wave; row < T; row += F.G * 8) {
        const bool first = (row & (SEQ - 1)) == 0; const int prow = first ? row : row - 1;
        const u32x2* hr = (const u32x2*)(Ha + (size_t)row * D) + F.lane; const u32x2* hp = (const u32x2*)(Ha + (size_t)prow * D) + F.lane;
        u32x2* br = (u32x2*)(HN + (size_t)(row + 1 + (row >= SEQ ? 1 : 0)) * D) + F.lane;
        u32x2* xr = (u32x2*)((row < SEQ ? XR0 + (size_t)row * D : XR1 + (size_t)(row - SEQ) * D)) + F.lane;
        u32x2 hw[4], pw[4];
#pragma unroll
        for (int j = 0; j < 4; ++j) { hw[j] = hr[64 * j]; pw[j] = hp[64 * j]; }
        const float rs = rsqrtf(ssq_sum(sq, row) * (1.f / D) + 1e-6f), rp = first ? 0.f : rsqrtf(ssq_sum(sq, prow) * (1.f / D) + 1e-6f);
#pragma unroll
        for (int j = 0; j < 4; ++j) { const f32x4 h4 = {__uint_as_float(hw[j].x << 16), __uint_as_float(hw[j].x & 0xffff0000u), __uint_as_float(hw[j].y << 16), __uint_as_float(hw[j].y & 0xffff0000u)};
            const f32x4 p4 = {__uint_as_float(pw[j].x << 16), __uint_as_float(pw[j].x & 0xffff0000u), __uint_as_float(pw[j].y << 16), __uint_as_float(pw[j].y & 0xffff0000u)};
            const f32x4 v = h4 * rs * g[j], pv = p4 * rp * g[j], x = v + (pv - v) * mu[j];
            u32x2 w; w.x = cvt_pk_bf16(v[0], v[1]); w.y = cvt_pk_bf16(v[2], v[3]); br[64 * j] = w;
            u32x2 wx; wx.x = cvt_pk_bf16(x[0], x[1]); wx.y = cvt_pk_bf16(x[2], x[3]); xr[64 * j] = wx; }
    }
    if (F.vcu == 0 && F.wave < 2) { u32x2* br = (u32x2*)(HN + (size_t)(F.wave ? SEQ + 1 : 0) * D) + F.lane; u32x2 z = {0u, 0u};
#pragma unroll
        for (int j = 0; j < 4; ++j) br[64 * j] = z; }
}
__device__ __forceinline__ void rows_final(Frame& F) {
    const float* gain = F.in[3]; const float* sq = F.ssq(4); const bf16_t* Ha = (const bf16_t*)(F.ws + WS_HB);
    f32x4 g[4];
#pragma unroll
    for (int j = 0; j < 4; ++j) g[j] = *((const f32x4*)gain + F.lane + 64 * j);
    for (int row = F.vcu * 8 + F.wave; row < T; row += F.G * 8) {
        const u32x2* hr = (const u32x2*)(Ha + (size_t)row * D) + F.lane; f32x4* orow = (f32x4*)(F.H + (size_t)row * D) + F.lane; const float rs = rsqrtf(ssq_sum(sq, row) * (1.f / D) + 1e-6f);
#pragma unroll
        for (int j = 0; j < 4; ++j) { const u32x2 hw = hr[64 * j]; const f32x4 h4 = {__uint_as_float(hw.x << 16), __uint_as_float(hw.x & 0xffff0000u), __uint_as_float(hw.y << 16), __uint_as_float(hw.y & 0xffff0000u)};
            orow[64 * j] = h4 * rs * g[j]; }
    }
}

typedef float f32x16 __attribute__((ext_vector_type(16)));
template <bool DUMMY>
__device__ __forceinline__ void sb_unit(Frame& F, int bh, int qb) {
    const int lane = F.lane, l31 = lane & 31, hi = lane >> 5, b = bh >> 2, h = bh & 3;
    bf16_t* Z = (bf16_t*)(F.ws + WS_Z); const bf16_t* VT = (const bf16_t*)(F.ws + WS_VTB) + (size_t)bh * 128 * SEQ;
    const size_t rowb = (size_t)b * SEQ; const int q0 = qb * 32, tq = q0 + l31;
    bf16x8 qr[8];
    { const bf16_t* qp = Z + (rowb + tq) * ZE + 1536 + h * 128 + hi * 8;
#pragma unroll
      for (int ks = 0; ks < 8; ++ks) qr[ks] = *(const bf16x8*)(qp + 16 * ks); }
    f32x16 o[4];
#pragma unroll
    for (int d = 0; d < 4; ++d)
#pragma unroll
        for (int r = 0; r < 16; ++r) o[d][r] = 0.f;
    float carry = 1.f;
    const int pi = 16 * ((l31 >> 2) & 1) + (l31 & 3) + 4 * (l31 >> 3);
    const bf16_t* Kb = Z + rowb * ZE + 2048 + h * 128 + hi * 8;
    for (int kt = (q0 + 31) >> 6; kt >= 0; --kt) {
        const int kbase = kt * 64;
        const bf16_t* kp0 = Kb + (size_t)(kbase + pi) * ZE; const bf16_t* kp1 = kp0 + (size_t)32 * ZE;
        f32x16 p0, p1;
#pragma unroll
        for (int r = 0; r < 16; ++r) { p0[r] = 0.f; p1[r] = 0.f; }
#pragma unroll
        for (int ks = 0; ks < 8; ++ks) { const bf16x8 a0 = *(const bf16x8*)(kp0 + 16 * ks), a1 = *(const bf16x8*)(kp1 + 16 * ks);
            p0 = __builtin_amdgcn_mfma_f32_32x32x16_bf16(a0, qr[ks], p0, 0, 0, 0); p1 = __builtin_amdgcn_mfma_f32_32x32x16_bf16(a1, qr[ks], p1, 0, 0, 0); }
        float f1 = 1.f, f0 = 1.f;
        const int k1 = kbase + 32 + 16 * hi, k0 = kbase + 16 * hi;
#pragma unroll
        for (int r = 15; r >= 0; --r) { const float z = fminf(p1[r], 80.f); const float e = exp2f(z * 1.4426950408889634f); float rd = __builtin_amdgcn_rcpf(1.f + e); float be = e * rd;
            const bool valid = (k1 + r) < tq; be = valid ? be : 0.f; rd = valid ? rd : 1.f; p1[r] = be * f1; f1 *= rd; }
#pragma unroll
        for (int r = 15; r >= 0; --r) { const float z = fminf(p0[r], 80.f); const float e = exp2f(z * 1.4426950408889634f); float rd = __builtin_amdgcn_rcpf(1.f + e); float be = e * rd;
            const bool valid = (k0 + r) < tq; be = valid ? be : 0.f; rd = valid ? rd : 1.f; p0[r] = be * f0; f0 *= rd; }
        const float pf0 = __shfl_xor(f0, 32), pf1 = __shfl_xor(f1, 32);
        const float tail1 = hi ? 1.f : pf1;
        const float tail0 = hi ? (pf1 * f1) : (pf0 * f1 * pf1);
        const float s1 = tail1 * carry, s0 = tail0 * carry;
        carry *= (f0 * f1) * (pf0 * pf1);
        u32x4 pa[2][2];
#pragma unroll
        for (int s = 0; s < 2; ++s) {
            pa[0][s].x = cvt_pk_bf16(p0[8 * s + 0] * s0, p0[8 * s + 1] * s0); pa[0][s].y = cvt_pk_bf16(p0[8 * s + 2] * s0, p0[8 * s + 3] * s0);
            pa[0][s].z = cvt_pk_bf16(p0[8 * s + 4] * s0, p0[8 * s + 5] * s0); pa[0][s].w = cvt_pk_bf16(p0[8 * s + 6] * s0, p0[8 * s + 7] * s0);
            pa[1][s].x = cvt_pk_bf16(p1[8 * s + 0] * s1, p1[8 * s + 1] * s1); pa[1][s].y = cvt_pk_bf16(p1[8 * s + 2] * s1, p1[8 * s + 3] * s1);
            pa[1][s].z = cvt_pk_bf16(p1[8 * s + 4] * s1, p1[8 * s + 5] * s1); pa[1][s].w = cvt_pk_bf16(p1[8 * s + 6] * s1, p1[8 * s + 7] * s1);
        }
        const bf16_t* vp = VT + (size_t)l31 * SEQ + kbase + 16 * hi;
#pragma unroll
        for (int d = 0; d < 4; ++d)
#pragma unroll
            for (int blk = 0; blk < 2; ++blk)
#pragma unroll
                for (int s = 0; s < 2; ++s) { const bf16x8 vb = *(const bf16x8*)(vp + (size_t)(32 * d) * SEQ + 32 * blk + 8 * s);
                    o[d] = __builtin_amdgcn_mfma_f32_32x32x16_bf16(__builtin_bit_cast(bf16x8, pa[blk][s]), vb, o[d], 0, 0, 0); }
        if (__all(carry < 7.9e-31f)) break;
    }
#pragma unroll
    for (int r = 0; r < 16; ++r) { const int qrow = q0 + (r & 3) + 8 * (r >> 2) + 4 * hi; bf16_t* gp = Z + (rowb + qrow) * ZE + 2560 + h * 128 + l31;
#pragma unroll
        for (int d = 0; d < 4; ++d) { const float g = bf2f(gp[32 * d]); const float ov = o[d][r] * siluf_(g); if (!DUMMY) gp[32 * d] = (bf16_t)f2bf(ov); else asm volatile("" :: "v"(ov)); } }
}
__device__ __forceinline__ void ret_stage_a(Frame& F, int u) {
    const int l31 = F.lane & 31, hi = F.lane >> 5, cu = u >> 3, w8 = u & 7, bh = cu & 7, n = cu >> 3, dvb = w8 >> 1, dkp = w8 & 1;
    const bf16_t* vt = (const bf16_t*)(F.ws + WS_VTA) + ((size_t)(bh * 128 + 32 * dvb + l31)) * SEQ + n * 128 + 8 * hi;
    const bf16_t* kt = (const bf16_t*)(F.ws + WS_KT) + ((size_t)(bh * 128 + 64 * dkp + l31)) * SEQ + n * 128 + 8 * hi;
    f32x16 a0, a1;
#pragma unroll
    for (int r = 0; r < 16; ++r) { a0[r] = 0.f; a1[r] = 0.f; }
#pragma unroll
    for (int ks = 0; ks < 8; ++ks) { const bf16x8 va = *(const bf16x8*)(vt + 16 * ks), k0 = *(const bf16x8*)(kt + 16 * ks), k1 = *(const bf16x8*)(kt + (size_t)32 * SEQ + 16 * ks);
        a0 = __builtin_amdgcn_mfma_f32_32x32x16_bf16(va, k0, a0, 0, 0, 0); a1 = __builtin_amdgcn_mfma_f32_32x32x16_bf16(va, k1, a1, 0, 0, 0); }
    bf16_t* kv = (bf16_t*)(F.H) + ((size_t)cu * 128 + 32 * dvb) * 128 + 64 * dkp + l31;
#pragma unroll
    for (int r = 0; r < 16; ++r) { const int dv = (r & 3) + 8 * (r >> 2) + 4 * hi; kv[dv * 128] = (bf16_t)f2bf(a0[r]); kv[dv * 128 + 32] = (bf16_t)f2bf(a1[r]); }
}
__device__ __forceinline__ void ret_stage_b(Frame& F) {
    const int e = F.vcu * 512 + F.tid; if (e >= 8 * 128 * 128) return;
    const int h = (e >> 14) & 3; const float g128 = exp2f(128.f * log2f(1.f - exp2f(-5.f - (float)h)));
    const bf16_t* p = (const bf16_t*)(F.H) + e; bf16_t* q = (bf16_t*)(F.H) + (size_t)8 * 1024 * 1024 + e; float S = 0.f;
#pragma unroll 4
    for (int n = 0; n < 64; ++n) { const float kv = bf2f(p[(size_t)n * 131072]); q[(size_t)n * 131072] = (bf16_t)f2bf(S); S = S * g128 + kv; }
}
template <bool DUMMY>
__device__ __forceinline__ void ret_stage_c(Frame& F, int u, const float* gng) {
    const int lane = F.lane, l31 = lane & 31, hi = lane >> 5, cu = u >> 2, qblk = u & 3, bh = cu & 7, n = cu >> 3, b = bh >> 2, h = bh & 3;
    bf16_t* Z = (bf16_t*)(F.ws + WS_Z); const size_t rowb = (size_t)b * SEQ; const int t0 = n * 128, tq = t0 + 32 * qblk + l31;
    bf16x8 qr[8];
    { const bf16_t* qp = Z + (rowb + tq) * ZE + h * 128 + hi * 8;
#pragma unroll
      for (int ks = 0; ks < 8; ++ks) qr[ks] = *(const bf16x8*)(qp + 16 * ks); }
    f32x16 o[4];
#pragma unroll
    for (int d = 0; d < 4; ++d)
#pragma unroll
        for (int r = 0; r < 16; ++r) o[d][r] = 0.f;
    { const bf16_t* sp = (const bf16_t*)(F.H) + (size_t)8 * 1024 * 1024 + ((size_t)cu * 128 + l31) * 128 + 8 * hi;
#pragma unroll
      for (int ks = 0; ks < 8; ++ks)
#pragma unroll
          for (int d = 0; d < 4; ++d) { const bf16x8 sb = *(const bf16x8*)(sp + (size_t)(32 * d) * 128 + 16 * ks); o[d] = __builtin_amdgcn_mfma_f32_32x32x16_bf16(qr[ks], sb, o[d], 0, 0, 0); } }
    const int pi = 16 * ((l31 >> 2) & 1) + (l31 & 3) + 4 * (l31 >> 3);
    const bf16_t* Kb = Z + rowb * ZE + 512 + h * 128 + hi * 8;
    const bf16_t* VT = (const bf16_t*)(F.ws + WS_VTA) + ((size_t)(bh * 128 + l31)) * SEQ + 16 * hi;
    for (int kb = 0; kb <= qblk; ++kb) {
        const int kbase = t0 + 32 * kb; const bf16_t* kp = Kb + (size_t)(kbase + pi) * ZE;
        f32x16 p;
#pragma unroll
        for (int r = 0; r < 16; ++r) p[r] = 0.f;
#pragma unroll
        for (int ks = 0; ks < 8; ++ks) { const bf16x8 a = *(const bf16x8*)(kp + 16 * ks); p = __builtin_amdgcn_mfma_f32_32x32x16_bf16(a, qr[ks], p, 0, 0, 0); }
        if (kb == qblk) {
#pragma unroll
            for (int r = 0; r < 16; ++r) p[r] = (kbase + 16 * hi + r <= tq) ? p[r] : 0.f; }
        u32x4 pa[2];
#pragma unroll
        for (int s = 0; s < 2; ++s) { pa[s].x = cvt_pk_bf16(p[8 * s], p[8 * s + 1]); pa[s].y = cvt_pk_bf16(p[8 * s + 2], p[8 * s + 3]); pa[s].z = cvt_pk_bf16(p[8 * s + 4], p[8 * s + 5]); pa[s].w = cvt_pk_bf16(p[8 * s + 6], p[8 * s + 7]); }
#pragma unroll
        for (int d = 0; d < 4; ++d)
#pragma unroll
            for (int s = 0; s < 2; ++s) { const bf16x8 vb = *(const bf16x8*)(VT + (size_t)(32 * d) * SEQ + kbase + 8 * s);
                o[d] = __builtin_amdgcn_mfma_f32_32x32x16_bf16(__builtin_bit_cast(bf16x8, pa[s]), vb, o[d], 0, 0, 0); }
    }
    float gg[4];
#pragma unroll
    for (int d = 0; d < 4; ++d) gg[d] = gng[h * 128 + 32 * d + l31];
#pragma unroll
    for (int r = 0; r < 16; ++r) {
        float sm = (o[0][r] + o[1][r]) + (o[2][r] + o[3][r]);
        sm = red32(sm);
        const float mu = sm * (1.f / 128.f); float q = 0.f;
#pragma unroll
        for (int d = 0; d < 4; ++d) { const float dd = o[d][r] - mu; q += dd * dd; }
        q = red32(q);
        const float rsd = rsqrtf(q * (1.f / 128.f) + 1e-5f);
        const int qrow = t0 + 32 * qblk + (r & 3) + 8 * (r >> 2) + 4 * hi; bf16_t* gp = Z + (rowb + qrow) * ZE + 1024 + h * 128 + l31;
#pragma unroll
        for (int d = 0; d < 4; ++d) { const float ga = bf2f(gp[32 * d]); const float ov = (o[d][r] - mu) * rsd * gg[d] * siluf_(ga); if (!DUMMY) gp[32 * d] = (bf16_t)f2bf(ov); else asm volatile("" :: "v"(ov)); }
    }
}
__device__ __forceinline__ bf16x8 ld8p(const bf16_t* p) { return *(const bf16x8*)p; }
namespace rw {
constexpr int S64 = 72, S128 = 136, LFS = 68;
constexpr int O_AT = 0, O_RT = O_AT + 9216, O_E = O_RT + 9216, O_ET = O_E + 18432, O_AM = O_ET + 17408, O_X0 = O_AM + 18432, O_LF = O_X0 + 17408, O_MM = O_LF + 17408,
              O_NN = O_MM + 9216, O_PC = O_NN + 17408, O_GC = O_PC + 9216, O_SM = O_GC + 9216, O_END = O_SM + 8192;
static_assert(O_END <= 160 * 1024 - 1024, "rwkv stage X LDS map");
typedef __attribute__((address_space(3))) bf16_t lbf;
typedef __attribute__((address_space(3))) float lf32;
__device__ __forceinline__ bf16x8 ld8(const bf16_t* p) { return *(const bf16x8*)p; }
__device__ __forceinline__ bf16x8 ld8(const LAS bf16_t* p) { return *(const LAS bf16x8*)p; }
__device__ __forceinline__ bf16x8 ld8(const GAS bf16_t* p) { return *(const GAS bf16x8*)p; }
template <int MT, int NT, int KS, class PA, class PB, class Epi>
__device__ __forceinline__ void mm(PA A, int lda, PB B, int ldb, int wave, int lane, Epi epi) {
    const int fr = lane & 15, g = lane >> 4;
    static_assert((MT * NT) % 8 == 0, "mm: tile count must be a multiple of the 8 waves");
#pragma unroll
    for (int ti = 0; ti < MT * NT / 8; ++ti) { const int tile = wave + 8 * ti; const int mt = tile / NT, nt = tile % NT;
        f32x4 acc = {0.f, 0.f, 0.f, 0.f};
        PA ap = A + (mt * 16 + fr) * lda + 8 * g; PB bp = B + (nt * 16 + fr) * ldb + 8 * g;
#pragma unroll
        for (int ks = 0; ks < KS; ++ks) acc = __builtin_amdgcn_mfma_f32_16x16x32_bf16(ld8(ap + 32 * ks), ld8(bp + 32 * ks), acc, 0, 0, 0);
        epi(ti, mt * 16 + 4 * g, nt * 16 + fr, acc);
    }
}
template <int MT, int NT, int KS, class PA, class PB, class Epi>
__device__ __forceinline__ void mm_rt(PA A, int lda, PB B, int ldb, int w, int nw, int lane, Epi epi) {
    const int fr = lane & 15, g = lane >> 4;
#pragma unroll 1
    for (int tile = w; tile < MT * NT; tile += nw) { const int mt = tile / NT, nt = tile % NT;
        f32x4 acc = {0.f, 0.f, 0.f, 0.f};
        PA ap = A + (mt * 16 + fr) * lda + 8 * g; PB bp = B + (nt * 16 + fr) * ldb + 8 * g;
#pragma unroll
        for (int ks = 0; ks < KS; ++ks) acc = __builtin_amdgcn_mfma_f32_16x16x32_bf16(ld8(ap + 32 * ks), ld8(bp + 32 * ks), acc, 0, 0, 0);
        epi(mt * 16 + 4 * g, nt * 16 + fr, acc);
    }
}
__device__ __forceinline__ unsigned short bfs(float f) { return (unsigned short)f2bf(f); }
__device__ __forceinline__ void st4(LAS bf16_t* p, f32x4 v) { u32x2 w; w.x = cvt_pk_bf16(v[0], v[1]); w.y = cvt_pk_bf16(v[2], v[3]); *(LAS u32x2*)p = w; }
}

template <bool DUMMY>
__device__ __forceinline__ void rwkv_stage_x(Frame& F, int li, unsigned long long& xacc) {
    using namespace rw;
#define TSX(k) do { if (MK_XA == (k) && li == 1 && F.wave == 0) { const unsigned long long t_ = __builtin_amdgcn_s_memrealtime(); *(volatile LAS unsigned long long*)(F.lds + MISC_OFF + 256) = t_; } if (MK_XB == (k) && li == 1 && F.wave == 0) { volatile LAS unsigned long long* p_ = (volatile LAS unsigned long long*)(F.lds + MISC_OFF + 256); const unsigned long long t0_ = p_[0]; if (t0_) p_[1] += __builtin_amdgcn_s_memrealtime() - t0_; } } while (0)
    const int o = li >> 1;
    LAS unsigned char* L = F.lds;
    LAS bf16_t* At = (LAS bf16_t*)(L + O_AT); LAS bf16_t* Rt = (LAS bf16_t*)(L + O_RT); LAS bf16_t* E = (LAS bf16_t*)(L + O_E); LAS bf16_t* ET = (LAS bf16_t*)(L + O_ET); LAS bf16_t* AM = (LAS bf16_t*)(L + O_AM);
    LAS bf16_t* X0T = (LAS bf16_t*)(L + O_X0); LAS float* Lf = (LAS float*)(L + O_LF); LAS bf16_t* Mm = (LAS bf16_t*)(L + O_MM); LAS bf16_t* NN = (LAS bf16_t*)(L + O_NN); LAS float* CS = (LAS float*)(L + O_NN);
    LAS bf16_t* Pc = (LAS bf16_t*)(L + O_PC); LAS bf16_t* Gc = (LAS bf16_t*)(L + O_GC); LAS float* gamC = (LAS float*)(L + O_SM); LAS float* SEGT = gamC + 64; LAS float* PRM = gamC + 64 + 1024;
    LAS bf16_t* Tm = At; LAS bf16_t* Qh = AM; LAS bf16_t* PT = AM + 64 * S64; LAS bf16_t* WT = Mm;
    GAS bf16_t* Z = (GAS bf16_t*)(F.ws + WS_Z); const GAS bf16_t* L1g = (const GAS bf16_t*)(F.ws + WS_L1); GAS bf16_t* VF = (GAS bf16_t*)(F.ws + WS_VF);
    const GAS bf16_t* W2T = (const GAS bf16_t*)(F.ws + WS_LORA2); const GAS bf16_t* A2T = W2T + 1024 * 64; const GAS bf16_t* V2T = A2T + 1024 * 64;
    GAS bf16_t* PG = (GAS bf16_t*)(F.H); GAS float* BON = (GAS float*)(F.ws + WS_BON);
    const float* w0p = F.in[12] + o * D; const float* a0p = F.in[15] + o * D; const float* v0p = F.in[18]; const float* kkp = F.in[21] + o * D; const float* kap = F.in[22] + o * D; const float* rkp = F.in[23] + o * D;
    f32x4 nlw[2], nla[2], nlv[2]; unsigned nr[4], nk[4], nv[4], nvf[4];
    bf16x8 fwa[4], fwb[2], faa[4], fab[2], fva[2], fvb;
    auto fetch_issue = [&](int u2, int c2, int tid2, const int part) {
        const int bh2 = u2 & 31, blk2 = u2 >> 5, b2 = bh2 >> 4, h2 = bh2 & 15; const size_t rows2 = (size_t)b2 * SEQ + (size_t)blk2 * 128 + 64 * c2;
        const int lane2 = tid2 & 63, fr2 = lane2 & 15, g2 = lane2 >> 4; int wave2 = F.wave; asm volatile("" : "+s"(wave2));
        const int nt2 = wave2 & 3;
#pragma unroll
        for (int ti = 0; ti < 2; ++ti) if (part & (1 << ti)) { const int mt2 = ((wave2 + 8 * ti) >> 2); const GAS bf16_t* ap = L1g + (rows2 + mt2 * 16 + fr2) * 256 + 8 * g2;
            fwa[ti * 2] = ld8(ap); fwa[ti * 2 + 1] = ld8(ap + 32); faa[ti * 2] = ld8(ap + 64); faa[ti * 2 + 1] = ld8(ap + 96); if (o) fva[ti] = ld8(ap + 128); }
        if (part & 4) {
        { const GAS bf16_t* bp = W2T + ((size_t)h2 * 64 + nt2 * 16 + fr2) * 64 + 8 * g2; fwb[0] = ld8(bp); fwb[1] = ld8(bp + 32); }
        { const GAS bf16_t* bp = A2T + ((size_t)h2 * 64 + nt2 * 16 + fr2) * 64 + 8 * g2; fab[0] = ld8(bp); fab[1] = ld8(bp + 32); }
        if (o) fvb = ld8(V2T + ((size_t)h2 * 64 + nt2 * 16 + fr2) * 32 + 8 * g2); }
        const int q2 = wave2 * 2 + (lane2 >> 5), cp2 = lane2 & 31;
        if (part & 8)
#pragma unroll
        for (int j = 0; j < 4; ++j) { const size_t prow2 = rows2 + 4 * q2 + j; const GAS unsigned* zp2 = (const GAS unsigned*)(Z + prow2 * ZW + h2 * 64 + 2 * cp2);
            nr[j] = zp2[0]; nk[j] = zp2[512]; nv[j] = zp2[1024]; nvf[j] = o ? *(const GAS unsigned*)(VF + prow2 * D + h2 * 64 + 2 * cp2) : 0u; }
    };
    auto fetch_compute = [&]() {
#pragma unroll
        for (int ti = 0; ti < 2; ++ti) { const f32x4 z4 = {0.f, 0.f, 0.f, 0.f};
            nlw[ti] = __builtin_amdgcn_mfma_f32_16x16x32_bf16(fwb[1], fwa[ti * 2 + 1], __builtin_amdgcn_mfma_f32_16x16x32_bf16(fwb[0], fwa[ti * 2], z4, 0, 0, 0), 0, 0, 0);
            nla[ti] = __builtin_amdgcn_mfma_f32_16x16x32_bf16(fab[1], faa[ti * 2 + 1], __builtin_amdgcn_mfma_f32_16x16x32_bf16(fab[0], faa[ti * 2], z4, 0, 0, 0), 0, 0, 0);
            if (o) nlv[ti] = __builtin_amdgcn_mfma_f32_16x16x32_bf16(fvb, fva[ti], z4, 0, 0, 0); }
    };
    { F.retid(); int t0 = F.tid; asm volatile("" : "+v"(t0)); fetch_issue(F.vcu, 0, t0, 15); fetch_compute(); }
#pragma unroll 1
    for (int u = F.vcu; u < 2048; u += F.G) {
        const int bh = u & 31, blk = u >> 5, b = bh >> 4, h = bh & 15; const size_t row0 = (size_t)b * SEQ + (size_t)blk * 128;
        F.retid(); int tid = F.tid; asm volatile("" : "+v"(tid));
        LBAR();
        if ((F.G & 31) != 0 || u == F.vcu) {
            if (tid < 384) { const int a_ = tid >> 6, ch = tid & 63; const float* src = a_ == 0 ? w0p : a_ == 1 ? a0p : a_ == 2 ? v0p : a_ == 3 ? kkp : a_ == 4 ? kap : rkp; PRM[tid] = src[h * 64 + ch]; } }
        for (int e = tid; e < 64 * 64; e += 512) { const int i = e >> 6, j = e & 63; Pc[i * S64 + j] = (i == j) ? (bf16_t)0x3f80 : (bf16_t)0; Gc[i * S64 + j] = 0; }
#pragma unroll 1
        for (int c = 0; c < 2; ++c) {
            const size_t rows = row0 + 64 * c;
            asm volatile("" : "+v"(tid));
            const int lane = tid & 63; int wave = F.wave; asm volatile("" : "+s"(wave));
            const int cp = lane & 31, q = wave * 2 + (lane >> 5), ch0 = 2 * cp;
            LBAR();
            TSX(0);
            unsigned cr[4], ck[4], cv[4], cvf[4];
#pragma unroll
            for (int j = 0; j < 4; ++j) { cr[j] = nr[j]; ck[j] = nk[j]; cv[j] = nv[j]; cvf[j] = nvf[j]; }
            { const int fr_ = lane & 15, g_ = lane >> 4;
#pragma unroll
              for (int ti = 0; ti < 2; ++ti) { const int tile = wave + 8 * ti, t = (tile >> 2) * 16 + fr_, c0 = (tile & 3) * 16 + 4 * g_;
                  *(LAS f32x4*)(Lf + t * LFS + c0) = nlw[ti]; st4(Mm + t * S64 + c0, nla[ti]); if (o) st4(AM + (64 + t) * S64 + c0, nlv[ti]); } }
            const int nu = c == 0 ? u : u + F.G, nc = c == 0 ? 1 : 0; const bool has_n = nu < 2048;
            if (has_n) fetch_issue(nu, nc, tid, 1);
            LBAR();
            TSX(1);
            if (has_n) fetch_issue(nu, nc, tid, 2);
            float pr[4][2], pkk[4][2], pkm[4][2], pb[4][2], pv[4][2], cd[4][2];
            {
                float ss[4], bon[4];
#pragma unroll
                for (int j = 0; j < 4; ++j) { const int t = 4 * q + j; ss[j] = 0.f; bon[j] = 0.f;
                    const f32x2 lw2 = *(const LAS f32x2*)(Lf + t * LFS + ch0); const unsigned la2 = *(const LAS unsigned*)(Mm + t * S64 + ch0); const unsigned lv2 = o ? *(const LAS unsigned*)(AM + (64 + t) * S64 + ch0) : 0u;
#pragma unroll
                    for (int e = 0; e < 2; ++e) { const int ch = ch0 + e;
                        const float r = e ? __uint_as_float(cr[j] & 0xffff0000u) : __uint_as_float(cr[j] << 16), k = e ? __uint_as_float(ck[j] & 0xffff0000u) : __uint_as_float(ck[j] << 16);
                        float v = e ? __uint_as_float(cv[j] & 0xffff0000u) : __uint_as_float(cv[j] << 16);
                        const float lw = lw2[e], la = e ? __uint_as_float(la2 & 0xffff0000u) : __uint_as_float(la2 << 16);
                        cd[j][e] = -0.6065306597126334f * sigmoidf_(PRM[ch] + lw);
                        const float a = sigmoidf_(PRM[64 + ch] + la);
                        if (o) { const float lv = e ? __uint_as_float(lv2 & 0xffff0000u) : __uint_as_float(lv2 << 16); const float vf = e ? __uint_as_float(cvf[j] & 0xffff0000u) : __uint_as_float(cvf[j] << 16);
                            v = v + (vf - v) * sigmoidf_(PRM[128 + ch] + lv); v = bf2f((bf16_t)f2bf(v)); }
                        const float kr = k * PRM[192 + ch]; ss[j] += kr * kr; pkk[j][e] = kr;
                        const float km = k * (1.f + (a - 1.f) * PRM[256 + ch]); pkm[j][e] = km; pb[j][e] = a; pr[j][e] = r; pv[j][e] = v; bon[j] += r * km * PRM[320 + ch]; }
                    const size_t row = rows + t;
                    if (!DUMMY) { if (o) *(GAS unsigned*)(Z + row * ZW + 2048 + h * 64 + ch0) = pk2(pv[j][0], pv[j][1]); else *(GAS unsigned*)(VF + row * D + h * 64 + ch0) = cv[j]; } }
#pragma unroll
                for (int j = 0; j < 4; ++j) {
                    float s1 = ss[j], b1 = bon[j];
                    s1 = red32(s1);
                    b1 = red32(b1);
                    const float inv = __builtin_amdgcn_rcpf(fmaxf(sqrtf(s1), 1e-12f));
#pragma unroll
                    for (int e = 0; e < 2; ++e) { pkk[j][e] *= inv; pb[j][e] *= pkk[j][e]; }
                    if (!DUMMY && cp == 0) BON[(rows + 4 * q + j) * 16 + h] = b1; }
#pragma unroll
                for (int e = 0; e < 2; ++e) { cd[1][e] += cd[0][e]; cd[2][e] += cd[1][e]; cd[3][e] += cd[2][e]; SEGT[q * 64 + ch0 + e] = cd[3][e]; }
            }
            LBAR();
            TSX(3);
            if (has_n) fetch_issue(nu, nc, tid, 4);
            {
                float pre[2] = {0.f, 0.f};
                for (int qq = 0; qq < q; ++qq) { pre[0] += SEGT[qq * 64 + ch0]; pre[1] += SEGT[qq * 64 + ch0 + 1]; }
                float at[4][2], bt[4][2], kt[4][2], rt[4][2];
#pragma unroll
                for (int j = 0; j < 4; ++j)
#pragma unroll
                    for (int e = 0; e < 2; ++e) { const float g = pre[e] + cd[j][e], gp = j ? pre[e] + cd[j - 1][e] : pre[e]; const float eg = __expf(g), egp = __expf(gp), ieg = __builtin_amdgcn_rcpf(eg);
                        at[j][e] = egp * pkk[j][e]; bt[j][e] = pb[j][e] * ieg; kt[j][e] = pkm[j][e] * ieg; rt[j][e] = pr[j][e] * eg;
                        if (q == 15 && j == 3) gamC[ch0 + e] = eg; }
#pragma unroll
                for (int j = 0; j < 4; ++j) { const int t = 4 * q + j;
                    *(LAS unsigned*)(At + t * S64 + ch0) = cvt_pk_bf16(at[j][0], at[j][1]); *(LAS unsigned*)(Rt + t * S64 + ch0) = cvt_pk_bf16(rt[j][0], rt[j][1]);
                    *(LAS unsigned*)(E + t * S64 + ch0) = cvt_pk_bf16(bt[j][0], bt[j][1]); *(LAS unsigned*)(E + (64 + t) * S64 + ch0) = cvt_pk_bf16(kt[j][0], kt[j][1]); }
#pragma unroll
                for (int e = 0; e < 2; ++e) { const int ch = ch0 + e;
#define RW_Q4(x) (u32x2){cvt_pk_bf16(x[0][e], x[1][e]), cvt_pk_bf16(x[2][e], x[3][e])}
                    *(LAS u32x2*)(AM + ch * S64 + 4 * q) = RW_Q4(at); *(LAS u32x2*)(ET + ch * S128 + 4 * q) = RW_Q4(bt); *(LAS u32x2*)(ET + ch * S128 + 64 + 4 * q) = RW_Q4(kt); *(LAS u32x2*)(X0T + ch * S128 + 64 + 4 * q) = RW_Q4(pv);
#undef RW_Q4
                }
            }
            LBAR();
            TSX(4);
            if (has_n) fetch_issue(nu, nc, tid, 8);
            mm<8, 4, 2>(E, S64, At, S64, wave, lane, [&](int, int r0, int col, f32x4 a) {
                const int i0 = r0 & 63; f32x4 v;
#pragma unroll
                for (int j = 0; j < 4; ++j) v[j] = (i0 + j < col) ? a[j] : 0.f;
                if (r0 < 64) *(LAS f32x4*)(Lf + col * LFS + i0) = v; else st4(Mm + col * S64 + i0, v); });
            LBAR();
            TSX(5);
            if (wave < 2) {
                const int bb = 32 * wave; float x[32]; int vz = 0; asm volatile("" : "+v"(vz));
                const LAS float* Lz = Lf + vz; const int cl = lane & 31;
#pragma unroll
                for (int t = 0; t < 32; ++t) x[t] = 0.f;
#pragma unroll
                for (int t = 0; t < 32; ++t) { float s0 = (t == cl) ? 1.f : 0.f, s1 = 0.f, s2 = 0.f, s3 = 0.f;
#pragma unroll
                    for (int i4 = 0; i4 < (t + 3) / 4; ++i4) { const f32x4 l4 = *(const LAS f32x4*)(Lz + (bb + t) * LFS + bb + 4 * i4);
                        s0 -= l4[0] * x[4 * i4]; s1 -= l4[1] * x[4 * i4 + 1]; s2 -= l4[2] * x[4 * i4 + 2]; s3 -= l4[3] * x[4 * i4 + 3]; }
                    x[t] = (s0 + s1) + (s2 + s3); }
                if (lane < 32) {
#pragma unroll
                    for (int t = 0; t < 32; ++t) Tm[(bb + t) * S64 + bb + cl] = bfs(x[t]);
                    if (wave == 0) {
#pragma unroll
                        for (int i4 = 0; i4 < 8; ++i4) st4(X0T + cl * S128 + 4 * i4, (f32x4){x[4 * i4], x[4 * i4 + 1], x[4 * i4 + 2], x[4 * i4 + 3]}); }
                }
            } else {
                mm_rt<8, 4, 2>(E, S64, Rt, S64, wave - 2, 6, lane, [&](int r0, int col, f32x4 a) {
                    const int i0 = r0 & 63; f32x4 v;
#pragma unroll
                    for (int j = 0; j < 4; ++j) v[j] = (i0 + j <= col) ? a[j] : 0.f;
                    st4(NN + col * S128 + r0, v); });
                mm_rt<4, 4, 2>(Mm, S64, X0T + 64, S128, wave - 2, 6, lane, [&](int r0, int col, f32x4 a) { st4(AM + (64 + col) * S64 + r0, (f32x4){-a[0], -a[1], -a[2], -a[3]}); });
                asm volatile("s_waitcnt lgkmcnt(0)" ::: "memory");
                { const int e = tid - 128; if (e < 256) { const int t = e >> 3, i4 = (e & 7) * 4; st4(X0T + t * S128 + 32 + i4, *(const LAS f32x4*)(Lf + (32 + t) * LFS + i4)); *(LAS u32x2*)(Tm + t * S64 + 32 + i4) = (u32x2){0u, 0u}; } }
            }
            LBAR();
            TSX(6);
            if (wave < 4) { const int fr_ = lane & 15, g_ = lane >> 4, mt = wave >> 1, nt = wave & 1;
                const f32x4 z4 = {0.f, 0.f, 0.f, 0.f};
                const f32x4 a = __builtin_amdgcn_mfma_f32_16x16x32_bf16(ld8(X0T + (mt * 16 + fr_) * S128 + 32 + 8 * g_), ld8(X0T + (nt * 16 + fr_) * S128 + 8 * g_), z4, 0, 0, 0);
                st4(Mm + (nt * 16 + fr_) * S64 + mt * 16 + 4 * g_, a); }
            LBAR();
            if (wave < 4) { const int fr_ = lane & 15, g_ = lane >> 4, mt = wave >> 1, nt = wave & 1;
                const f32x4 z4 = {0.f, 0.f, 0.f, 0.f};
                const f32x4 a = __builtin_amdgcn_mfma_f32_16x16x32_bf16(ld8(Tm + (32 + mt * 16 + fr_) * S64 + 32 + 8 * g_), ld8(Mm + (nt * 16 + fr_) * S64 + 8 * g_), z4, 0, 0, 0);
#pragma unroll
                for (int j = 0; j < 4; ++j) Tm[(32 + mt * 16 + 4 * g_ + j) * S64 + nt * 16 + fr_] = bfs(-a[j]); }
            LBAR();
            TSX(7);
            mm<4, 8, 2>(Tm, S64, AM, S64, wave, lane, [&](int, int r0, int col, f32x4 a) { if (col < 64) st4(WT + col * S64 + r0, a); else st4(X0T + (col - 64) * S128 + r0, a); });
            LBAR();
            TSX(8);
            f32x4 gt[2], y0t[2];
            mm<4, 4, 2>(WT, S64, ET, S128, wave, lane, [&](int, int r0, int col, f32x4 a) { const float gc = gamC[col];
                f32x4 p;
#pragma unroll
                for (int j = 0; j < 4; ++j) p[j] = (((r0 + j) == col ? 1.f : 0.f) - a[j]) * gc;
                st4(PT + col * S64 + r0, p); });
            mm<4, 4, 4>(ET, S128, X0T, S128, wave, lane, [&](int ti, int r0, int, f32x4 a) { gt[ti] = a * *(const LAS f32x4*)(gamC + r0); });
            mm<4, 4, 4>(NN, S128, X0T, S128, wave, lane, [&](int ti, int, int, f32x4 a) { y0t[ti] = a; });
            mm<4, 4, 2>(WT, S64, NN, S128, wave, lane, [&](int, int r0, int col, f32x4 a) {
                const u32x2 rr = *(const LAS u32x2*)(Rt + col * S64 + r0);
                st4(Qh + col * S64 + r0, (f32x4){__uint_as_float(rr.x << 16) - a[0], __uint_as_float(rr.x & 0xffff0000u) - a[1], __uint_as_float(rr.y << 16) - a[2], __uint_as_float(rr.y & 0xffff0000u) - a[3]}); });
            LBAR();
            TSX(9);
            GAS bf16_t* rslot = Z + row0 * ZW + h * 64; GAS bf16_t* kslot = rslot + 1024;
            mm<4, 4, 2>(Pc, S64, Qh, S64, wave, lane, [&](int, int r0, int col, f32x4 a) {
                const int kt_ = r0 >> 5, rho = r0 & 31, s = rho >> 4, jj = ((rho >> 3) & 1) * 4, hh = (rho >> 2) & 1;
                const int t = 64 * c + col, tt_ = t >> 5, ln = 32 * hh + (t & 31); const int e = ((((tt_ * 2 + kt_) * 2 + s) * 64 + ln) << 3) + jj;
                if (!DUMMY) *(GAS u32x2*)(rslot + (size_t)(e >> 6) * ZW + (e & 63)) = (u32x2){cvt_pk_bf16(a[0], a[1]), cvt_pk_bf16(a[2], a[3])}; else asm volatile("" :: "v"(a[0])); });
            mm<4, 4, 2>(Qh, S64, Gc, S64, wave, lane, [&](int ti, int r0, int col, f32x4 a) {
                const int vt_ = col >> 5, v31 = col & 31;
                const int t = 64 * c + r0, tt_ = t >> 5, x = t & 31, hh = (x >> 2) & 1, r = 4 * (x >> 3); const int e = (((tt_ * 2 + vt_) * 64 + 32 * hh + v31) << 4) + r;
                const f32x4 y = a + y0t[ti];
                if (!DUMMY) *(GAS u32x2*)(kslot + (size_t)(e >> 6) * ZW + (e & 63)) = (u32x2){cvt_pk_bf16(y[0], y[1]), cvt_pk_bf16(y[2], y[3])}; else asm volatile("" :: "v"(y[0])); });
            f32x4 pn[2], gn[2];
            mm<4, 4, 2>(PT, S64, Pc, S64, wave, lane, [&](int ti, int, int, f32x4 a) { pn[ti] = a; });
            mm<4, 4, 2>(PT, S64, Gc, S64, wave, lane, [&](int ti, int, int, f32x4 a) { gn[ti] = a + gt[ti]; });
            if (has_n) fetch_compute();
            LBAR();
            { const int fr = lane & 15, g = lane >> 4;
#pragma unroll
              for (int ti = 0; ti < 2; ++ti) { const int tile = wave + 8 * ti, mt = tile >> 2, nt = tile & 3;
                  st4(Pc + (nt * 16 + fr) * S64 + mt * 16 + 4 * g, pn[ti]); st4(Gc + (nt * 16 + fr) * S64 + mt * 16 + 4 * g, gn[ti]); } }
            TSX(10);
        }
        LBAR();
        if (!DUMMY) { GAS bf16_t* pg = PG + (size_t)u * 8192;
          { const int f = tid >> 6, ln = tid & 63, s = f & 1, kit = (f >> 1) & 1, kot = f >> 2, hh = ln >> 5, r31 = ln & 31; unsigned short w[8];
#pragma unroll
            for (int j = 0; j < 8; ++j) { const int rho = 16 * s + 8 * (j >> 2) + 4 * hh + (j & 3); w[j] = Pc[(32 * kit + rho) * S64 + 32 * kot + r31]; }
            *(GAS u32x4*)(pg + (size_t)tid * 8) = (u32x4){(unsigned)w[0] | ((unsigned)w[1] << 16), (unsigned)w[2] | ((unsigned)w[3] << 16), (unsigned)w[4] | ((unsigned)w[5] << 16), (unsigned)w[6] | ((unsigned)w[7] << 16)}; }
          { const int tile = tid >> 7, ln = (tid >> 1) & 63, half = tid & 1, kot = tile >> 1, vt_ = tile & 1, hh = ln >> 5, v31 = ln & 31; unsigned short w[8];
#pragma unroll
            for (int q = 0; q < 8; ++q) { const int r = 8 * half + q; const int ko = 32 * kot + (r & 3) + 8 * (r >> 2) + 4 * hh; w[q] = Gc[(32 * vt_ + v31) * S64 + ko]; }
            *(GAS u32x4*)(pg + 4096 + ((size_t)(tile * 64 + ln) << 4) + 8 * half) = (u32x4){(unsigned)w[0] | ((unsigned)w[1] << 16), (unsigned)w[2] | ((unsigned)w[3] << 16), (unsigned)w[4] | ((unsigned)w[5] << 16), (unsigned)w[6] | ((unsigned)w[7] << 16)}; } }
    }
    LBAR();
}

__device__ __forceinline__ void rwkv_stage_y(Frame& F, const int bx) {
    const int lane = F.lane, wave = F.wave, bh = bx, vt = wave >> 2; const bool st = ((wave & 3) == 0);
    const bf16_t* PG = (const bf16_t*)(F.H); u32x4* SB = (u32x4*)(F.ws + WS_SB);
    LAS bf16x8* pgbuf = (LAS bf16x8*)F.lds;
    f32x16 X0, X1;
#pragma unroll
    for (int r = 0; r < 16; ++r) { X0[r] = 0.f; X1[r] = 0.f; }
    bf16x8 Ra0, Ra1, Rb0, Rb1, Rc0, Rc1;
    auto issue = [&](bf16x8& r0, bf16x8& r1, int blk) { const bf16_t* pg = PG + (size_t)(blk * 32 + bh) * 8192;
        r0 = ld8p(pg + (((size_t)(wave * 2 + 0) * 64 + lane) << 3)); r1 = ld8p(pg + (((size_t)(wave * 2 + 1) * 64 + lane) << 3)); };
    auto step = [&](bf16x8& c0, bf16x8& c1, bf16x8& n0r, bf16x8& n1r, int blk) {
        const bf16x8 nga = n0r, ngb = n1r;
        issue(c0, c1, blk + 3 < 64 ? blk + 3 : 63);
        asm volatile("s_waitcnt lgkmcnt(0)" ::: "memory"); __builtin_amdgcn_s_barrier(); asm volatile("" ::: "memory");
        pgbuf[((blk + 1) & 1) * 1024 + (wave * 2 + 0) * 64 + lane] = nga; pgbuf[((blk + 1) & 1) * 1024 + (wave * 2 + 1) * 64 + lane] = ngb;
        if (st) {
            u32x4 xb[4];
#pragma unroll
            for (int s = 0; s < 2; ++s) {
                xb[s] = (u32x4){cvt_pk_bf16(X0[8 * s], X0[8 * s + 1]), cvt_pk_bf16(X0[8 * s + 2], X0[8 * s + 3]), cvt_pk_bf16(X0[8 * s + 4], X0[8 * s + 5]), cvt_pk_bf16(X0[8 * s + 6], X0[8 * s + 7])};
                xb[2 + s] = (u32x4){cvt_pk_bf16(X1[8 * s], X1[8 * s + 1]), cvt_pk_bf16(X1[8 * s + 2], X1[8 * s + 3]), cvt_pk_bf16(X1[8 * s + 4], X1[8 * s + 5]), cvt_pk_bf16(X1[8 * s + 6], X1[8 * s + 7])}; }
            u32x4* sb = SB + ((size_t)(blk * 32 + bh) * 8 + vt * 4) * 64 + lane;
#pragma unroll
            for (int q = 0; q < 4; ++q) sb[q * 64] = xb[q];
            const LAS bf16x8* pb = pgbuf + (blk & 1) * 1024;
            f32x16 n0, n1;
            { const bf16x8 c0a = pb[512 + ((0 * 2 + vt) * 64 + lane) * 2], c0b = pb[512 + ((0 * 2 + vt) * 64 + lane) * 2 + 1], c1a = pb[512 + ((1 * 2 + vt) * 64 + lane) * 2], c1b = pb[512 + ((1 * 2 + vt) * 64 + lane) * 2 + 1];
#pragma unroll
              for (int r = 0; r < 8; ++r) { n0[r] = bf2f((bf16_t)c0a[r]); n0[8 + r] = bf2f((bf16_t)c0b[r]); n1[r] = bf2f((bf16_t)c1a[r]); n1[8 + r] = bf2f((bf16_t)c1b[r]); } }
#pragma unroll
            for (int q = 0; q < 4; ++q) {
                n0 = __builtin_amdgcn_mfma_f32_32x32x16_bf16(pb[q * 64 + lane], __builtin_bit_cast(bf16x8, xb[q]), n0, 0, 0, 0);
                n1 = __builtin_amdgcn_mfma_f32_32x32x16_bf16(pb[(4 + q) * 64 + lane], __builtin_bit_cast(bf16x8, xb[q]), n1, 0, 0, 0); }
            X0 = n0; X1 = n1;
        }
    };
    issue(Ra0, Ra1, 0); issue(Rb0, Rb1, 1); issue(Rc0, Rc1, 2);
    pgbuf[(wave * 2 + 0) * 64 + lane] = Ra0; pgbuf[(wave * 2 + 1) * 64 + lane] = Ra1;
#pragma unroll 1
    for (int blk = 0; blk < 63; blk += 3) { step(Ra0, Ra1, Rb0, Rb1, blk); step(Rb0, Rb1, Rc0, Rc1, blk + 1); step(Rc0, Rc1, Ra0, Ra1, blk + 2); }
    step(Ra0, Ra1, Rb0, Rb1, 63);
    __syncthreads();
}

template <bool DUMMY>
__device__ __forceinline__ void rwkv_stage_z(Frame& F, int li) {
    const int o = li >> 1;
    bf16_t* Z = (bf16_t*)(F.ws + WS_Z); const float* BON = (const float*)(F.ws + WS_BON); const u32x4* SB = (const u32x4*)(F.ws + WS_SB);
    const float* lgp = F.in[24] + o * D; const float* lbp = F.in[25] + o * D;
    LAS float* tile = (LAS float*)(F.lds + F.wave * 9216);
    int lane_ = F.lane;
#pragma unroll 1
    for (int w = F.vcu * 8 + F.wave; w < 8192; w += F.G * 8) {
        asm volatile("" : "+v"(lane_)); const int lane = lane_, v31 = lane & 31, hh = lane >> 5, tl = lane >> 1, hf = lane & 1;
        const int u = w >> 2, tt = w & 3, bh = u & 31, blk = u >> 5, b = bh >> 4, h = bh & 15; const size_t row0 = (size_t)b * SEQ + (size_t)blk * 128;
        const bf16_t* rslot = Z + row0 * ZW + h * 64; const bf16_t* kslot = rslot + 1024;
        const size_t row = row0 + 32 * tt + tl; bf16_t* zp = Z + row * ZW + h * 64 + 32 * hf;
        bf16x8 vv[4], gg[4];
#pragma unroll
        for (int q = 0; q < 4; ++q) { vv[q] = ld8p(zp + 2048 + 8 * q); gg[q] = ld8p(zp + 3072 + 8 * q); }
        const float bon = BON[row * 16 + h];
        bf16x8 qf[4]; u32x4 xb[2][4];
#pragma unroll
        for (int q = 0; q < 4; ++q) { const int e = (((tt * 4 + q) * 64 + lane) << 3); qf[q] = ld8p(rslot + (size_t)(e >> 6) * ZW + (e & 63)); }
#pragma unroll
        for (int vt = 0; vt < 2; ++vt)
#pragma unroll
            for (int q = 0; q < 4; ++q) xb[vt][q] = SB[((size_t)u * 8 + vt * 4 + q) * 64 + lane];
#pragma unroll
        for (int vt = 0; vt < 2; ++vt) { const int e0 = ((tt * 2 + vt) * 64 + lane) << 4; const bf16_t* yp = kslot + (size_t)(e0 >> 6) * ZW + (e0 & 63); const bf16x8 ya = ld8p(yp), yb = ld8p(yp + 8);
            f32x16 acc;
#pragma unroll
            for (int r = 0; r < 8; ++r) { acc[r] = bf2f((bf16_t)ya[r]); acc[8 + r] = bf2f((bf16_t)yb[r]); }
#pragma unroll
            for (int q = 0; q < 4; ++q) acc = __builtin_amdgcn_mfma_f32_32x32x16_bf16(qf[q], __builtin_bit_cast(bf16x8, xb[vt][q]), acc, 0, 0, 0);
#pragma unroll
            for (int r = 0; r < 16; ++r) tile[((r & 3) + 8 * (r >> 2) + 4 * hh) * 72 + 36 * vt + v31] = acc[r]; }
        LDS_WAIT(); asm volatile("" ::: "memory");
        float y[32]; float sm = 0.f;
#pragma unroll
        for (int q = 0; q < 8; ++q) { const f32x4 t4 = *(const LAS f32x4*)(tile + tl * 72 + 36 * hf + 4 * q); y[4 * q] = t4[0]; y[4 * q + 1] = t4[1]; y[4 * q + 2] = t4[2]; y[4 * q + 3] = t4[3]; sm += (t4[0] + t4[1]) + (t4[2] + t4[3]); }
        sm += __shfl_xor(sm, 1);
        const float mu = sm * (1.f / 64.f); float qq = 0.f;
#pragma unroll
        for (int j = 0; j < 32; ++j) { y[j] -= mu; qq += y[j] * y[j]; }
        qq += __shfl_xor(qq, 1);
        const float rsd = rsqrtf(qq * (1.f / 64.f) + 64e-5f);
        const float* lg = lgp + h * 64 + 32 * hf; const float* lb = lbp + h * 64 + 32 * hf;
#pragma unroll
        for (int q = 0; q < 4; ++q) { float ov[8];
#pragma unroll
            for (int j = 0; j < 8; ++j) { const int c = 8 * q + j; const float va = bf2f((bf16_t)vv[q][j]), ga = bf2f((bf16_t)gg[q][j]); ov[j] = (y[c] * rsd * lg[c] + lb[c] + bon * va) * siluf_(ga); }
            const u32x4 wv = {cvt_pk_bf16(ov[0], ov[1]), cvt_pk_bf16(ov[2], ov[3]), cvt_pk_bf16(ov[4], ov[5]), cvt_pk_bf16(ov[6], ov[7])};
            if (!DUMMY) *(u32x4*)(zp + 3072 + 8 * q) = wv; else asm volatile("" :: "v"(wv)); }
        LDS_WAIT(); asm volatile("" ::: "memory");
    }
}

enum { PH_P0 = 0, PH_FINAL = 27, N_PHASES = 28 };
#define IN(k) (lo <= (k) && (k) < hi)
#define TSG(k) do { if (LI == 0) { if (MK_GA == (k)) tA = __builtin_amdgcn_s_memrealtime(); if (MK_GB == (k)) tB = __builtin_amdgcn_s_memrealtime(); } } while (0)
#define TS(k) do { if (MK_TPA == (k)) tA = __builtin_amdgcn_s_memrealtime(); if (MK_TPB == (k)) tB = __builtin_amdgcn_s_memrealtime(); } while (0)
#if MK_MULTI
#define SEAM(k) do { } while (0)
#else
#define SEAM(k) do { if (IN(k) && IN((k) + 1)) xcd_barrier(bar); } while (0)
#endif
template <int LI>
__device__ __forceinline__ void run_layer(Frame& F, const XcdBarrier& bar, const int lo, const int hi, const int bx, unsigned long long& tA, unsigned long long& tB) {
    constexpr bool even = (LI & 1) == 0;
    constexpr int base = 1 + (LI / 2) * 13 + (even ? 0 : 6);
    bf16_t* Zp = (bf16_t*)(F.ws + WS_Z);
    if constexpr (even) {
        TS(base); if (IN(base)) { F.retid(); pg8::StaticOrder S; S.init(64, 16, F.G, bx);
            pg8::Gemm g{(const bf16_t*)(F.ws + WS_HB), (const bf16_t*)(F.ws + WS_WIN)};
            EpiEvenIn E{Zp, F.ssq(LI), (bf16_t*)(F.ws + WS_VTA), (bf16_t*)(F.ws + WS_VTB), (bf16_t*)(F.ws + WS_KT), F.lds + RING_BYTES};
            if (MK_PROBE == 1) pg8::gemm_phase<EpiEvenIn, true, D, D, 1 << 20, 0, 0>(F.lds, F.tid, g, S, E);
            pg8::gemm_phase<EpiEvenIn, true, D, D, 1 << 20, 0, 0>(F.lds, F.tid, g, S, E); }
        SEAM(base);
        TS(base + 1); if (IN(base + 1)) { F.retid();
            TSG(0); conv_wrest_a(F, LI); TSG(1);
            if constexpr (LI < 3) conv_win_odd(F, LI + 1);
            TSG(2);
            if (MK_PROBE == 5) { for (int u = F.vcu * 8 + F.wave; u < 4096; u += F.G * 8) ret_stage_a(F, u);
                for (int u = F.vcu * 8 + F.wave; u < 2048; u += F.G * 8) sb_unit<true>(F, u >> 8, u & 255); }
            for (int u = F.vcu * 8 + F.wave; u < 4096; u += F.G * 8) ret_stage_a(F, u);
            __syncthreads(); TSG(3);
            for (int u = F.vcu * 8 + F.wave; u < 2048; u += F.G * 8) sb_unit<false>(F, u >> 8, u & 255);
            __syncthreads(); TSG(4); }
        SEAM(base + 1);
        TS(base + 2); if (IN(base + 2)) { F.retid(); ret_stage_b(F); conv_wrest_b(F, LI, F.vcu, F.G); }
        SEAM(base + 2);
        TS(base + 3); if (IN(base + 3)) { F.retid(); const float* gng = F.in[8] + (LI >> 1) * 512;
            if (MK_PROBE == 6) for (int u = F.vcu * 8 + F.wave; u < 2048; u += F.G * 8) ret_stage_c<true>(F, u, gng);
            for (int u = F.vcu * 8 + F.wave; u < 2048; u += F.G * 8) ret_stage_c<false>(F, u, gng); }
        SEAM(base + 3);
        TS(base + 4); if (IN(base + 4)) { F.retid(); pg8::StaticOrder S; S.init(64, 4, F.G, bx);
            { pg8::Gemm g{(const bf16_t*)(F.ws + WS_PB), (const bf16_t*)(F.ws + WS_WPROJ)};
              EpiStore E{Zp, ZE}; pg8::gemm_phase<EpiStore, false, PLE, PLE, 1 << 20, 0, 0>(F.lds, F.tid, g, S, E); }
            { pg8::Gemm g{Zp + 1024, (const bf16_t*)(F.ws + WS_WOUT)};
              EpiResid E{(const bf16_t*)(F.ws + WS_HB), Zp + 1536, ZE}; pg8::gemm_phase<EpiResid, false, ZE, D, 8, (long)((2560 - 1024) * 2), 0>(F.lds, F.tid, g, S, E); } }
        SEAM(base + 4);
        TS(base + 5); if (IN(base + 5)) { F.retid(); pg8::StaticOrder S; S.init(64, 4, F.G, bx);
            pg8::Gemm g{Zp + 1536, (const bf16_t*)(F.ws + WS_WGATE)};
            EpiGate E{Zp + 1536, ZE, Zp, ZE, (bf16_t*)(F.ws + WS_HB), F.ssq(LI + 1)};
            pg8::gemm_phase<EpiGate, false, ZE, D, 1 << 20, 0, 0>(F.lds, F.tid, g, S, E); }
        SEAM(base + 5);
    } else {
        TS(base); if (IN(base)) { F.retid(); conv_lora2(F, LI); rows_norm(F, LI); }
        SEAM(base);
        TS(base + 1); if (IN(base + 1)) { F.retid();
            { pg8::StaticOrder S; S.init(64, 13, F.G, bx);
              pg8::Gemm g{(const bf16_t*)(F.H) + D, (const bf16_t*)(F.ws + WS_WIN) + (size_t)1024 * 1024};
              EpiOddIn E{Zp, (bf16_t*)(F.ws + WS_L1), 4};
              pg8::gemm_phase<EpiOddIn, true, D, 2048, 16, -(long)(D * 2), (long)(D * 2)>(F.lds, F.tid, g, S, E); }
            { const int ex = (64 * 13) % F.G; const bool split = ex > 0; pg8::StaticOrder S; S.init(64, 4, split ? F.G - ex : F.G, split ? bx - ex : bx);
              const char* xr0 = (const char*)F.H + XR0_OFF;
              pg8::Gemm g{(const bf16_t*)xr0, (const bf16_t*)(F.ws + WS_WIN), (long)((const char*)(F.ws + WS_XR1) - (xr0 + (size_t)SEQ * D * 2))};
              EpiOddIn E{Zp, (bf16_t*)(F.ws + WS_L1), 0};
              if (!split || bx >= ex) { F.retid(); pg8::gemm_phase<EpiOddIn, true, D, D, 1 << 20, 0, 0>(F.lds, F.tid, g, S, E); } } }
        SEAM(base + 1);
        TS(base + 2); if (IN(base + 2)) { F.retid();
            conv_wrest_a(F, LI);
            __syncthreads();
            { unsigned long long xa = 0; rwkv_stage_x<false>(F, LI, xa); } }
        SEAM(base + 2);
        TS(base + 3); if (IN(base + 3)) { F.retid();
            if (bx < 32) rwkv_stage_y(F, bx);
            else { pg8::StaticOrder S; S.init(64, 4, F.G - 32, bx - 32);
                pg8::Gemm g{(const bf16_t*)(F.ws + WS_PB), (const bf16_t*)(F.ws + WS_WPROJ)};
                EpiStore E{(bf16_t*)(F.H) + (size_t)16 * 1024 * 1024, D}; pg8::gemm_phase<EpiStore, false, PLE, PLE, 1 << 20, 0, 0>(F.lds, F.tid, g, S, E);
                __syncthreads(); conv_wrest_b(F, LI, bx - 32, F.G - 32); } }
        SEAM(base + 3);
        TS(base + 4); if (IN(base + 4)) { F.retid(); rwkv_stage_z<false>(F, LI); }
        SEAM(base + 4);
        TS(base + 5); if (IN(base + 5)) { F.retid(); pg8::StaticOrder S; S.init(64, 4, F.G, bx);
            if constexpr (LI < 3) { conv_win_even(F, LI + 1); __syncthreads(); }
            { pg8::Gemm g{Zp + 3072, (const bf16_t*)(F.ws + WS_WOUT)};
              EpiResid E{(const bf16_t*)(F.ws + WS_HB), Zp + 2048, ZW}; pg8::gemm_phase<EpiResid, false, ZW, D, 1 << 20, 0, 0>(F.lds, F.tid, g, S, E); } }
        SEAM(base + 5);
        TS(base + 6); if (IN(base + 6)) { F.retid(); pg8::StaticOrder S; S.init(64, 4, F.G, bx);
            pg8::Gemm g{Zp + 2048, (const bf16_t*)(F.ws + WS_WGATE)};
            EpiGate E{Zp + 2048, ZW, (const bf16_t*)(F.H) + (size_t)16 * 1024 * 1024, D, (bf16_t*)(F.ws + WS_HB), F.ssq(LI + 1)};
            pg8::gemm_phase<EpiGate, false, ZW, D, 1 << 20, 0, 0>(F.lds, F.tid, g, S, E); }
        SEAM(base + 6);
    }
}
__global__ void __launch_bounds__(512, 2) mk_fwd(Args args) {
    extern __shared__ __attribute__((aligned(16))) unsigned char lds_raw[];
    Frame F;
    F.lds = (LAS unsigned char*)lds_raw; F.ldsg = lds_raw;
    F.tid = threadIdx.x; F.lane = F.tid & 63; F.wave = __builtin_amdgcn_readfirstlane(F.tid >> 6);
    F.G = gridDim.x; const int bx = blockIdx.x; F.vcu = (F.G % 8 == 0) ? (bx % 8) * (F.G / 8) + bx / 8 : bx;
    F.H = args.out; F.ws = args.ws;
    volatile LAS unsigned* MISC = (volatile LAS unsigned*)(F.lds + MISC_OFF);
    for (int u = F.tid; u < 128; u += 512) ((LAS unsigned*)(F.lds + MISC_OFF))[u] = 0u;
    __syncthreads();
    XcdBarrier bar; bar.bar = (unsigned*)(F.ws + WS_CTL) + 4096; bar.x = 0; bar.st = nullptr;
#if !MK_MULTI
    bar = xcd_barrier_post((unsigned*)(F.ws + WS_CTL) + 4096, MISC + 8);
#endif
    const int lo = args.ph_lo, hi = args.ph_hi;
    if (IN(PH_P0)) { F.retid(); rows_p0(F); conv_win_even(F, 0); }
#if !MK_MULTI
    if (IN(0) && IN(1)) { VM_WAIT(); cg::this_grid().sync(); }
#endif
    unsigned long long tA = 0, tB = 0;
    TS(0);
    run_layer<0>(F, bar, lo, hi, bx, tA, tB);
    run_layer<1>(F, bar, lo, hi, bx, tA, tB);
    run_layer<2>(F, bar, lo, hi, bx, tA, tB);
    run_layer<3>(F, bar, lo, hi, bx, tA, tB);
    TS(PH_FINAL);
    if (IN(PH_FINAL)) { F.retid(); rows_final(F); }
    TS(PH_FINAL + 1);
    if ((MK_TPA >= 0 || MK_XA >= 0 || MK_GA >= 0) && blockIdx.x == 0 && F.wave == 0) { const unsigned long long t0 = __builtin_amdgcn_s_memrealtime(), span = 4ull * (MK_XA >= 0 ? ((volatile LAS unsigned long long*)(F.lds + MISC_OFF + 256))[1] : (tB - tA)); while (__builtin_amdgcn_s_memrealtime() - t0 < span) __builtin_amdgcn_s_sleep(8); }
}

extern "C" void kernel_launch(void* const* d_in, const int* in_sizes, int n_in, void* d_out, int out_size, void* d_ws, size_t ws_size, hipStream_t stream) {
    static int grid = 0;
    if (grid == 0) {
        int dev = 0, cus = 0, per_cu = 0;
        (void)hipGetDevice(&dev); (void)hipDeviceGetAttribute(&cus, hipDeviceAttributeMultiprocessorCount, dev);
        (void)hipFuncSetAttribute((const void*)mk_fwd, hipFuncAttributeMaxDynamicSharedMemorySize, LDS_BYTES);
        (void)hipOccupancyMaxActiveBlocksPerMultiprocessor(&per_cu, (const void*)mk_fwd, 512, LDS_BYTES);
        if (per_cu < 1) per_cu = 1;
        grid = cus * 1;
        if (n_in != 26 || ws_size < WS_END) fprintf(stderr, "kernel_launch: unexpected n_in %d / ws %zu\n", n_in, ws_size);
        (void)hipGetLastError();
    }
    (void)hipMemsetAsync((char*)d_ws + WS_CTL, 0, CTL_BYTES, stream);
    Args a{};
    for (int i = 0; i < 26; ++i) a.in[i] = (const float*)d_in[i];
    a.out = (float*)d_out; a.ws = (unsigned char*)d_ws;
#if MK_MULTI
    for (int ph = 0; ph < N_PHASES; ++ph) { a.ph_lo = ph; a.ph_hi = ph + 1; hipLaunchKernelGGL(mk_fwd, dim3(grid), dim3(512), LDS_BYTES, stream, a); }
#else
    a.ph_lo = 0; a.ph_hi = N_PHASES;
    void* kargs[] = {&a};
    hipError_t e = hipLaunchCooperativeKernel((const void*)mk_fwd, dim3(grid), dim3(512), kargs, LDS_BYTES, stream);
    if (e != hipSuccess) fprintf(stderr, "cooperative launch failed: %s (grid %d)\n", hipGetErrorString(e), grid);
#endif
}
```

```cpp
#include <hip/hip_runtime.h>
#include <hip/hip_cooperative_groups.h>
#include <cstdint>
#include <cstdio>
namespace cg = cooperative_groups;

#ifndef MK_PROBE
#define MK_PROBE 0
#endif
#ifndef MK_TPA
#define MK_TPA -1
#define MK_TPB -1
#endif
#ifndef MK_XA
#define MK_XA -1
#define MK_XB -1
#endif
#ifndef MK_GA
#define MK_GA -1
#define MK_GB -1
#endif
#ifndef MK_MULTI
#define MK_MULTI 0
#endif

#define LAS __attribute__((address_space(3)))
#define GAS __attribute__((address_space(1)))
typedef unsigned short bf16_t;
typedef short bf16x8 __attribute__((ext_vector_type(8)));
typedef float f32x4 __attribute__((ext_vector_type(4)));
typedef float f32x2 __attribute__((ext_vector_type(2)));
typedef unsigned u32x4 __attribute__((ext_vector_type(4)));
typedef unsigned u32x2 __attribute__((ext_vector_type(2)));

constexpr int D = 1024, BATCH = 2, SEQ = 8192, T = BATCH * SEQ, PLE = 256, ZW = 4096, ZE = 3072;
constexpr float QK_SCALE = 0.08838834764831845f;

__device__ __forceinline__ float bf2f(bf16_t v) { return __uint_as_float(((unsigned)v) << 16); }
__device__ __forceinline__ unsigned f2bf(float f) { unsigned u = __float_as_uint(f); return (u + 0x7fffu + ((u >> 16) & 1u)) >> 16; }
__device__ __forceinline__ unsigned pk2(float lo, float hi) { return f2bf(lo) | (f2bf(hi) << 16); }
typedef __bf16 bf16x2_t __attribute__((ext_vector_type(2)));
__device__ __forceinline__ unsigned cvt_pk_bf16(float lo, float hi) { f32x2 v = {lo, hi}; bf16x2_t b = __builtin_convertvector(v, bf16x2_t); return __builtin_bit_cast(unsigned, b); }
template <int CTRL> __device__ __forceinline__ float dpp_mov(float x) { return __builtin_bit_cast(float, __builtin_amdgcn_update_dpp(0, __builtin_bit_cast(int, x), CTRL, 0xf, 0xf, true)); }
__device__ __forceinline__ float red32(float x) { x += dpp_mov<0xB1>(x); x += dpp_mov<0x4E>(x); x += dpp_mov<0x141>(x); x += dpp_mov<0x140>(x);
    x += __builtin_bit_cast(float, __builtin_amdgcn_ds_swizzle(__builtin_bit_cast(int, x), 0x401F)); return x; }
__device__ __forceinline__ float wave_sum(float v) {
#pragma unroll
    for (int o = 1; o < 64; o <<= 1) v += __shfl_xor(v, o);
    return v;
}
__device__ __forceinline__ float sigmoidf_(float x) { return __builtin_amdgcn_rcpf(1.f + __expf(-x)); }
__device__ __forceinline__ float siluf_(float x) { return x * __builtin_amdgcn_rcpf(1.f + __expf(-x)); }
__device__ __forceinline__ float softplusf_(float x) { return x > 20.f ? x : log1pf(expf(x)); }
__device__ __forceinline__ float logsigf_(float x) { return -(x < -20.f ? -x : log1pf(expf(-x))); }
__device__ __forceinline__ float ssq_sum(const float* sq, int row) { const f32x4* p = (const f32x4*)(sq + (size_t)row * 16); const f32x4 a = p[0], b = p[1], c = p[2], d = p[3];
    return (((a[0] + a[1]) + (a[2] + a[3])) + ((b[0] + b[1]) + (b[2] + b[3]))) + (((c[0] + c[1]) + (c[2] + c[3])) + ((d[0] + d[1]) + (d[2] + d[3]))); }
#define LDS_WAIT() asm volatile("s_waitcnt lgkmcnt(0)" ::: "memory")
#define VM_WAIT() asm volatile("s_waitcnt vmcnt(0)" ::: "memory")

namespace pg8 {
constexpr int BM = 256, BK = 64, HALF = 128, HTB = HALF * BK * 2, STAGE_BYTES = 8 * HTB, NXCD = 8, WGM = 8;
__host__ __device__ __forceinline__ int lds_byte(int r, int c) { const int st = (r >> 4) * 2 + (c >> 5), rr = r & 15, cc = c & 31, ob = rr * 64 + cc * 2; return st * 1024 + (ob ^ (((ob >> 9) & 1) << 5)); }
__host__ __device__ __forceinline__ void stage_rc(int b, int& R, int& C) { const int st = b / 1024, sb = b % 1024, swz = sb ^ (((sb >> 9) & 1) << 5); R = (st >> 1) * 16 + swz / 64; C = (st & 1) * 32 + (swz % 64) / 2; }
__host__ __device__ __forceinline__ int perm32(int rho) { const int n = rho >> 4, i = rho & 15; return 8 * (i >> 2) + 4 * n + (i & 3); }
struct Unit { int pm, pn; };
struct Gemm { const bf16_t* A; const bf16_t* Bt; long brow = 0; };
struct StaticOrder {
    int nM, nN, nwg, G, c;
    __device__ void init(int nM_, int nN_, int G_, int c_) { nM = nM_; nN = nN_; nwg = nM * nN; G = G_; c = c_; }
    __device__ bool next(int i, Unit& u) const {
        const long L = (long)i * G + c; if (L >= nwg) return false;
        int wgid = (int)L; { const int q = nwg / NXCD, r = nwg % NXCD, xcd = wgid % NXCD, off = wgid / NXCD; wgid = (xcd < r ? xcd * (q + 1) : r * (q + 1) + (xcd - r) * q) + off; }
        const int nig = WGM * nN, gid = wgid / nig, fm = gid * WGM, gsz = (nM - fm) < WGM ? (nM - fm) : WGM;
        u.pm = fm + ((wgid % nig) % gsz); u.pn = (wgid % nig) / gsz; return true;
    }
};
template <class Epi, bool ALIGN_EPI, int LDA, int KK, int TSPLIT, long ASHIFT, long BROW>
__device__ __forceinline__ void gemm_phase(LAS unsigned char* lds, const int tid_in, const Gemm g, const StaticOrder& S, const Epi& E) {
    int tid = tid_in; asm volatile("" : "+v"(tid));
    const int wid = __builtin_amdgcn_readfirstlane(tid >> 6), lane = tid & 63, wr = wid >> 2, wc = wid & 3, fr = lane & 15, fq = lane >> 4;
    constexpr int K = KK, nt = K / BK, lda = LDA, tsplit = TSPLIT; constexpr long ashift = ASHIFT;
    unsigned voffA[2], voffB[2];
#pragma unroll
    for (int i = 0; i < 2; ++i) { int R, C; stage_rc(tid * 16 + i * 8192, R, C); const int Rb = (R & ~31) + perm32(R & 31);
        voffA[i] = (unsigned)(R * lda + C) * 2u; voffB[i] = (unsigned)(Rb * K + C) * 2u; }
    constexpr size_t kstep = (size_t)(BK * 2);
    constexpr size_t hstepA = (size_t)HALF * lda * 2, hstepB = (size_t)HALF * K * 2, tstepA = 2 * hstepA, tstepB = 2 * hstepB;
    const unsigned ldsw = (unsigned)wid * 1024u;
    const int aoff = lds_byte(wr * 64 + fr, fq * 8), boff = lds_byte(wc * 32 + fr, fq * 8);
#define PG8_AP(base, tt) ((base) + (((tt) < tsplit) ? (long)(tt) * 128 : ashift + (long)((tt) - tsplit) * 128))
#define PG8_ABASE(u) ((const char*)g.A + (size_t)(u).pm * tstepA + ((BROW != 0 && (u).pm >= 32) ? BROW : 0) + ((u).pm >= 32 ? g.brow : 0))
#define PG8_SA(b, h) (((b) * 2 + (h)) * HTB)
#define PG8_SB(b, h) ((4 + (b) * 2 + (h)) * HTB)
#define PG8_STAGE(bufoff, gbase, voff) do { const char* _gb = (const char*)(gbase); asm volatile("" : "+s"(_gb)); _Pragma("unroll") for (int _i = 0; _i < 2; ++_i) \
        __builtin_amdgcn_global_load_lds((const unsigned*)(_gb + (voff)[_i]), (LAS unsigned*)(lds + (bufoff) + ldsw + _i * 8192), 16, 0, 0); } while (0)
#define PG8_LDA(dst, b, h) do { _Pragma("unroll") for (int m = 0; m < 4; ++m) _Pragma("unroll") for (int k = 0; k < 2; ++k) dst[m][k] = *(const LAS bf16x8*)(lds + PG8_SA(b, h) + aoff + m * 2048 + k * 1024); } while (0)
#define PG8_LDB(dst, b, h) do { _Pragma("unroll") for (int n = 0; n < 2; ++n) _Pragma("unroll") for (int k = 0; k < 2; ++k) dst[n][k] = *(const LAS bf16x8*)(lds + PG8_SB(b, h) + boff + n * 2048 + k * 1024); } while (0)
#define PG8_MMA(ai, bj, At, Bt) do { __builtin_amdgcn_s_setprio(1); _Pragma("unroll") for (int m = 0; m < 4; ++m) _Pragma("unroll") for (int n = 0; n < 2; ++n) _Pragma("unroll") for (int k = 0; k < 2; ++k) \
        acc[ai][bj][m][n] = __builtin_amdgcn_mfma_f32_16x16x32_bf16(Bt[n][k], At[m][k], acc[ai][bj][m][n], 0, 0, 0); __builtin_amdgcn_s_setprio(0); } while (0)
#define PG8_WAIT_V(n) asm volatile("s_waitcnt vmcnt(" #n ")" ::: "memory")
#define PG8_WAIT_L(n) asm volatile("s_waitcnt lgkmcnt(" #n ")" ::: "memory")
#define PG8_BAR __builtin_amdgcn_s_barrier()
#define LBAR() do { asm volatile("s_waitcnt lgkmcnt(0)" ::: "memory"); __builtin_amdgcn_s_barrier(); asm volatile("" ::: "memory"); } while (0)
#define PG8_SCHED __builtin_amdgcn_sched_barrier(0)
    Unit cur, nxt; int ui = 0;
    if (!S.next(0, cur)) return;
    f32x4 acc[2][2][4][2];
#pragma unroll
    for (int a = 0; a < 2; ++a)
#pragma unroll
        for (int b = 0; b < 2; ++b)
#pragma unroll
            for (int m = 0; m < 4; ++m)
#pragma unroll
                for (int n = 0; n < 2; ++n) acc[a][b][m][n] = (f32x4){0.f, 0.f, 0.f, 0.f};
    bf16x8 At[4][2], B0[2][2], B1[2][2];
    const char* cA = PG8_ABASE(cur); const char* cB = (const char*)g.Bt + (size_t)cur.pn * tstepB;
    {
        const char* a0 = PG8_AP(cA, 0); const char* a1 = PG8_AP(cA, 1);
        PG8_STAGE(PG8_SB(0, 0), cB, voffB); PG8_STAGE(PG8_SB(0, 1), cB + hstepB, voffB); PG8_STAGE(PG8_SA(0, 0), a0, voffA); PG8_STAGE(PG8_SA(0, 1), a0 + hstepA, voffA);
        if (wr == 1) PG8_BAR;
        PG8_WAIT_V(2); PG8_BAR;
        PG8_STAGE(PG8_SB(1, 0), cB + kstep, voffB); PG8_STAGE(PG8_SA(1, 0), a1, voffA); PG8_STAGE(PG8_SB(1, 1), cB + hstepB + kstep, voffB);
        PG8_WAIT_V(6); PG8_BAR;
    }
    for (;;) {
        const bool has_next = S.next(ui + 1, nxt);
        const char* nA = has_next ? PG8_ABASE(nxt) : cA; const char* nB = has_next ? (const char*)g.Bt + (size_t)nxt.pn * tstepB : cB;
        for (int t = 0; t < nt; t += 2) {
            const bool last = (t == nt - 2);
            const char* a1 = PG8_AP(cA, t + 1);
            const char* a2 = last ? PG8_AP(nA, 0) : PG8_AP(cA, t + 2); const char* b2 = last ? nB : cB + (size_t)(t + 2) * kstep;
            const char* a3 = last ? PG8_AP(nA, 1) : PG8_AP(cA, t + 3); const char* b3 = b2 + kstep;
            PG8_LDB(B0, 0, 0); PG8_LDB(B1, 0, 1); PG8_SCHED; PG8_LDA(At, 0, 0); PG8_STAGE(PG8_SA(1, 1), a1 + hstepA, voffA);
            PG8_WAIT_V(8); PG8_WAIT_L(0); PG8_BAR; PG8_MMA(0, 0, At, B0); PG8_MMA(0, 1, At, B1); PG8_BAR; PG8_SCHED;
            PG8_LDA(At, 0, 1); PG8_STAGE(PG8_SB(0, 0), b2, voffB); PG8_STAGE(PG8_SB(0, 1), b2 + hstepB, voffB); PG8_STAGE(PG8_SA(0, 0), a2, voffA);
            PG8_WAIT_V(8); PG8_WAIT_L(0); PG8_BAR; PG8_MMA(1, 0, At, B0); PG8_MMA(1, 1, At, B1); PG8_BAR; PG8_SCHED;
            PG8_LDB(B0, 1, 0); PG8_LDB(B1, 1, 1); PG8_SCHED; PG8_LDA(At, 1, 0); PG8_STAGE(PG8_SA(0, 1), a2 + hstepA, voffA);
            PG8_WAIT_V(8); PG8_WAIT_L(0); PG8_BAR; PG8_MMA(0, 0, At, B0); PG8_MMA(0, 1, At, B1); PG8_BAR; PG8_SCHED;
            PG8_LDA(At, 1, 1); PG8_STAGE(PG8_SB(1, 0), b3, voffB); PG8_STAGE(PG8_SB(1, 1), b3 + hstepB, voffB); PG8_STAGE(PG8_SA(1, 0), a3, voffA);
            PG8_WAIT_V(8); PG8_WAIT_L(0); PG8_BAR; PG8_MMA(1, 0, At, B0); PG8_MMA(1, 1, At, B1); PG8_BAR; PG8_SCHED;
        }
        if constexpr (ALIGN_EPI) { if (wr == 0) PG8_BAR; }
        E(acc, cur, wr, wc, fr, fq);
        if (!has_next) break;
#pragma unroll
        for (int a = 0; a < 2; ++a)
#pragma unroll
            for (int b = 0; b < 2; ++b)
#pragma unroll
                for (int m = 0; m < 4; ++m)
#pragma unroll
                    for (int n = 0; n < 2; ++n) acc[a][b][m][n] = (f32x4){0.f, 0.f, 0.f, 0.f};
        cur = nxt; cA = nA; cB = nB; ++ui;
        if constexpr (ALIGN_EPI) { if (wr == 1) PG8_BAR; }
    }
    PG8_WAIT_V(0);
    if constexpr (!ALIGN_EPI) { if (wr == 0) PG8_BAR; }
    PG8_BAR;
#undef PG8_AP
#undef PG8_ABASE
#undef PG8_SA
#undef PG8_SB
#undef PG8_STAGE
#undef PG8_LDA
#undef PG8_LDB
#undef PG8_MMA
#undef PG8_WAIT_V
#undef PG8_WAIT_L
#undef PG8_BAR
#undef PG8_SCHED
}
}

template <class Fn>
__device__ __forceinline__ void epi_for(const f32x4 (&acc)[2][2][4][2], const pg8::Unit& u, int wr, int wc, int fr, int fq, Fn fn) {
#pragma unroll
    for (int ai = 0; ai < 2; ++ai)
#pragma unroll
        for (int m = 0; m < 4; ++m) { const int row = u.pm * 256 + ai * 128 + wr * 64 + m * 16 + fr;
#pragma unroll
            for (int bj = 0; bj < 2; ++bj) { const int col = u.pn * 256 + bj * 128 + wc * 32 + 8 * fq; fn(row, col, acc[ai][bj][m][0], acc[ai][bj][m][1]); }
            if (m & 1) asm volatile("" ::: "memory"); }
}
__device__ __forceinline__ u32x4 pack8(f32x4 v0, f32x4 v1) { u32x4 w; w.x = cvt_pk_bf16(v0[0], v0[1]); w.y = cvt_pk_bf16(v0[2], v0[3]); w.z = cvt_pk_bf16(v1[0], v1[1]); w.w = cvt_pk_bf16(v1[2], v1[3]); return w; }

struct EpiEvenIn {
    bf16_t* Z; const float* ssq; bf16_t* VTa; bf16_t* VTb; bf16_t* KT; LAS unsigned char* spare;
    template <class ValFn>
    __device__ __forceinline__ void tstore(bf16_t* dst, const pg8::Unit& u, int wr, int wc, int fr, int fq, ValFn val) const {
        asm volatile("" : "+v"(fr), "+v"(fq));
        LAS bf16_t* tl = (LAS bf16_t*)(spare + (wr * 4 + wc) * 4032); const int lane = fq * 16 + fr;
#pragma unroll
        for (int ai = 0; ai < 2; ++ai)
#pragma unroll
            for (int bj = 0; bj < 2; ++bj) {
                const int row0 = u.pm * 256 + ai * 128 + wr * 64, cg0 = (u.pn * 256 + bj * 128 + wc * 32) & 511, b = row0 >> 13, t0 = row0 & (SEQ - 1);
#pragma unroll
                for (int half = 0; half < 2; ++half) {
#pragma unroll
                    for (int mm = 0; mm < 2; ++mm) { float o[8]; val(ai, 2 * half + mm, bj, o);
#pragma unroll
                        for (int j = 0; j < 8; ++j) tl[(8 * fq + j) * 32 + 16 * mm + fr] = (bf16_t)f2bf(o[j]); }
                    asm volatile("s_waitcnt lgkmcnt(0)" ::: "memory");
#pragma unroll
                    for (int r = 0; r < 2; ++r) { const int c = lane + 64 * r, d = c >> 2, part = c & 3; const u32x4 w = *(const LAS u32x4*)(tl + d * 32 + part * 8);
                        *(u32x4*)(dst + ((size_t)(b * 512 + cg0 + d)) * SEQ + t0 + 32 * half + 8 * part) = w; }
                    asm volatile("s_waitcnt lgkmcnt(0)" ::: "memory");
                }
            }
    }
    __device__ __forceinline__ void operator()(const f32x4 (&acc)[2][2][4][2], const pg8::Unit& u, int wr, int wc, int fr, int fq) const {
        const int g = u.pn >> 1;
        float rs8[8];
        { f32x4 pr[8];
#pragma unroll
          for (int it = 0; it < 8; ++it) pr[it] = *(const f32x4*)(ssq + (size_t)(u.pm * 256 + (it >> 2) * 128 + wr * 64 + (it & 3) * 16 + fr) * 16 + 4 * fq);
#pragma unroll
          for (int it = 0; it < 8; ++it) { float s_ = (pr[it][0] + pr[it][1]) + (pr[it][2] + pr[it][3]); s_ += __shfl_xor(s_, 16); s_ += __shfl_xor(s_, 32); rs8[it] = rsqrtf(s_ * (1.f / D) + 1e-6f); } }
        if (g == 2 || g == 6) {
            tstore(g == 2 ? VTa : VTb, u, wr, wc, fr, fq, [&](int ai, int m, int bj, float (&o)[8]) {
                const float rs = rs8[ai * 4 + m];
                const f32x4 v0 = acc[ai][bj][m][0] * rs, v1 = acc[ai][bj][m][1] * rs;
                o[0] = v0[0]; o[1] = v0[1]; o[2] = v0[2]; o[3] = v0[3]; o[4] = v1[0]; o[5] = v1[1]; o[6] = v1[2]; o[7] = v1[3]; });
            return;
        }
        if (g == 1) {
            tstore(KT, u, wr, wc, fr, fq, [&](int ai, int m, int bj, float (&o)[8]) {
                const int row = u.pm * 256 + ai * 128 + wr * 64 + m * 16 + fr, col = u.pn * 256 + bj * 128 + wc * 32 + 8 * fq; const float rs = rs8[ai * 4 + m];
                const f32x4 v0 = acc[ai][bj][m][0] * rs, v1 = acc[ai][bj][m][1] * rs; const int cg = col & 511, t = row & (SEQ - 1);
                const float pos = (float)t; const int i0 = (cg & 127) >> 1;
                float q[8] = {v0[0], v0[1], v0[2], v0[3], v1[0], v1[1], v1[2], v1[3]};
                _Pragma("unroll") for (int j = 0; j < 4; ++j) { const float inv = exp2f(-(float)(i0 + j) * (13.287712379549449f / 64.f));
                    float rev = pos * inv * 0.15915494309189535f; rev = rev - floorf(rev); const float sn = __builtin_amdgcn_sinf(rev), cs = __builtin_amdgcn_cosf(rev);
                    const float x1 = q[2 * j], x2 = q[2 * j + 1]; q[2 * j] = x1 * cs - x2 * sn; q[2 * j + 1] = x1 * sn + x2 * cs; }
                const float lg2 = log2f(1.f - exp2f(-5.f - (float)(cg >> 7))); const float ip1 = (float)((t & 127) + 1);
                const float f = exp2f(-ip1 * lg2), f2 = exp2f((128.f - ip1) * lg2);
                *(u32x4*)(Z + (size_t)row * ZE + 512 + cg) = pack8((f32x4){q[0] * f, q[1] * f, q[2] * f, q[3] * f}, (f32x4){q[4] * f, q[5] * f, q[6] * f, q[7] * f});
                _Pragma("unroll") for (int j = 0; j < 8; ++j) o[j] = q[j] * f2; });
            return;
        }
#pragma unroll
        for (int ai = 0; ai < 2; ++ai)
#pragma unroll
          for (int m = 0; m < 4; ++m) { const int row = u.pm * 256 + ai * 128 + wr * 64 + m * 16 + fr; const float rs = rs8[ai * 4 + m];
#pragma unroll
            for (int bj = 0; bj < 2; ++bj) { const int col = u.pn * 256 + bj * 128 + wc * 32 + 8 * fq; const f32x4 v0 = acc[ai][bj][m][0] * rs, v1 = acc[ai][bj][m][1] * rs;
            const int cg = col & 511, t = row & (SEQ - 1);
            if (g == 0) {
                const float pos = (float)t; const int i0 = (cg & 127) >> 1;
                float o[8] = {v0[0], v0[1], v0[2], v0[3], v1[0], v1[1], v1[2], v1[3]};
                _Pragma("unroll") for (int j = 0; j < 4; ++j) { const float inv = exp2f(-(float)(i0 + j) * (13.287712379549449f / 64.f));
                    float rev = pos * inv * 0.15915494309189535f; rev = rev - floorf(rev); const float sn = __builtin_amdgcn_sinf(rev), cs = __builtin_amdgcn_cosf(rev);
                    const float x1 = o[2 * j], x2 = o[2 * j + 1]; o[2 * j] = x1 * cs - x2 * sn; o[2 * j + 1] = x1 * sn + x2 * cs; }
                const float lg2 = log2f(1.f - exp2f(-5.f - (float)(cg >> 7))); const float ip1 = (float)((t & 127) + 1); const float f = exp2f(ip1 * lg2);
                *(u32x4*)(Z + (size_t)row * ZE + cg) = pack8((f32x4){o[0] * f, o[1] * f, o[2] * f, o[3] * f}, (f32x4){o[4] * f, o[5] * f, o[6] * f, o[7] * f});
            } else {
                const int zc = (g - 1 - (g > 6 ? 1 : 0)) * 512;
                *(u32x4*)(Z + (size_t)row * ZE + zc + cg) = pack8(v0, v1);
            }
            }
            if (m & 1) asm volatile("" ::: "memory"); }
    }
};
struct EpiOddIn {
    bf16_t* Z; bf16_t* L1; int pn0; unsigned* cnt;
    __device__ __forceinline__ void operator()(const f32x4 (&acc)[2][2][4][2], const pg8::Unit& u_, int wr, int wc, int fr, int fq) const {
        pg8::Unit u = u_; u.pn += pn0;
        { const int grp = u.pn >> 2;
          if (grp >= 1 && grp <= 3 && (wr | wc | fr | fq) == 0) __hip_atomic_fetch_add(cnt + grp * 64 + u.pm, 1u, __ATOMIC_RELAXED, __HIP_MEMORY_SCOPE_AGENT);
          const int dep = grp == 1 ? 2 : grp == 3 ? 1 : grp == 0 ? 3 : 0;
          if (dep) { while (__hip_atomic_load(cnt + dep * 64 + u.pm, __ATOMIC_RELAXED, __HIP_MEMORY_SCOPE_AGENT) < 4u) __builtin_amdgcn_s_sleep(2); asm volatile("" ::: "memory"); } }
        if (u.pn < 16) { epi_for(acc, u, wr, wc, fr, fq, [&](int row, int col, f32x4 v0, f32x4 v1) { *(u32x4*)(Z + (size_t)row * ZW + col) = pack8(v0, v1); }); }
        else { epi_for(acc, u, wr, wc, fr, fq, [&](int row, int col, f32x4 v0, f32x4 v1) { const int c = col - 4096; if (c < 64) {
                    _Pragma("unroll") for (int j = 0; j < 4; ++j) { v0[j] = tanhf(v0[j]); v1[j] = tanhf(v1[j]); } }
                *(u32x4*)(L1 + (size_t)row * 256 + c) = pack8(v0, v1); }); }
    }
};
__device__ __forceinline__ void unpack8(const u32x4 w, f32x4& a, f32x4& b) {
    a = (f32x4){__uint_as_float(w.x << 16), __uint_as_float(w.x & 0xffff0000u), __uint_as_float(w.y << 16), __uint_as_float(w.y & 0xffff0000u)};
    b = (f32x4){__uint_as_float(w.z << 16), __uint_as_float(w.z & 0xffff0000u), __uint_as_float(w.w << 16), __uint_as_float(w.w & 0xffff0000u)}; }
struct EpiResid {
    const bf16_t* Ha; bf16_t* HB; int ldb;
    __device__ __forceinline__ void operator()(const f32x4 (&acc)[2][2][4][2], const pg8::Unit& u, int wr, int wc, int fr, int fq) const {
        u32x4 hq[3][2]; const int rowb = u.pm * 256 + wr * 64 + fr, colb = u.pn * 256 + wc * 32 + 8 * fq;
        auto ld = [&](int it, int sl) { const size_t row = rowb + (it >> 2) * 128 + (it & 3) * 16;
            _Pragma("unroll") for (int bj = 0; bj < 2; ++bj) hq[sl][bj] = *(const u32x4*)(Ha + row * D + colb + bj * 128); };
        ld(0, 0); ld(1, 1);
#pragma unroll
        for (int it = 0; it < 8; ++it) { if (it + 2 < 8) ld(it + 2, (it + 2) % 3);
            const int ai = it >> 2, m = it & 3; const size_t row = rowb + ai * 128 + m * 16;
#pragma unroll
            for (int bj = 0; bj < 2; ++bj) { f32x4 h0, h1; unpack8(hq[it % 3][bj], h0, h1); h0 = h0 + acc[ai][bj][m][0]; h1 = h1 + acc[ai][bj][m][1];
                *(u32x4*)(HB + row * ldb + colb + bj * 128) = pack8(h0, h1); }
            asm volatile("" ::: "memory"); }
    }
};
struct EpiStore {
    bf16_t* O; int ldc;
    __device__ __forceinline__ void operator()(const f32x4 (&acc)[2][2][4][2], const pg8::Unit& u, int wr, int wc, int fr, int fq) const {
        epi_for(acc, u, wr, wc, fr, fq, [&](int row, int col, f32x4 v0, f32x4 v1) { *(u32x4*)(O + (size_t)row * ldc + col) = pack8(v0, v1); });
    }
};
struct EpiGate {
    const bf16_t* Hb; int ldh; const bf16_t* PP; int ldp; bf16_t* Ha; float* ssq;
    __device__ __forceinline__ void operator()(const f32x4 (&acc)[2][2][4][2], const pg8::Unit& u, int wr, int wc, int fr, int fq) const {
        u32x4 hq[3][2], pq[3][2]; const int rowb = u.pm * 256 + wr * 64 + fr, colb = u.pn * 256 + wc * 32 + 8 * fq;
        auto ld = [&](int it, int sl) { const size_t row = rowb + (it >> 2) * 128 + (it & 3) * 16;
            _Pragma("unroll") for (int bj = 0; bj < 2; ++bj) { hq[sl][bj] = *(const u32x4*)(Hb + row * ldh + colb + bj * 128); pq[sl][bj] = *(const u32x4*)(PP + row * ldp + colb + bj * 128); } };
        ld(0, 0); ld(1, 1);
#pragma unroll
        for (int it = 0; it < 8; ++it) { if (it + 2 < 8) ld(it + 2, (it + 2) % 3);
            const int ai = it >> 2, m = it & 3; const size_t row = rowb + ai * 128 + m * 16; float sq = 0.f;
#pragma unroll
            for (int bj = 0; bj < 2; ++bj) { const f32x4 v0 = acc[ai][bj][m][0], v1 = acc[ai][bj][m][1];
                f32x4 h0, h1, p0, p1; unpack8(hq[it % 3][bj], h0, h1); unpack8(pq[it % 3][bj], p0, p1);
#pragma unroll
                for (int j = 0; j < 4; ++j) { h0[j] += sigmoidf_(v0[j]) * p0[j]; h1[j] += sigmoidf_(v1[j]) * p1[j]; sq += h0[j] * h0[j] + h1[j] * h1[j]; }
                *(u32x4*)(Ha + row * D + colb + bj * 128) = pack8(h0, h1); }
            sq += __shfl_xor(sq, 16); sq += __shfl_xor(sq, 32);
            if (fq == 0) ssq[row * 16 + u.pn * 4 + wc] = sq;
            asm volatile("" ::: "memory"); }
    }
};

#define XB_TMO      128
#define XB_XCNT(j)  (256  + 64 * (j))
#define XB_XSUB(j)  (1280 + 64 * (j))
#define XB_XGEN(j)  (2304 + 64 * (j))
#define XB_TOP      3328
#define XB_TOPGEN   3392
#define XCD_BAR_WORDS 3456
#define XB_SPIN_CAP (1u << 22)
__device__ __forceinline__ unsigned xb_ld(unsigned* p)              { return __hip_atomic_load(p, __ATOMIC_RELAXED, __HIP_MEMORY_SCOPE_AGENT); }
__device__ __forceinline__ unsigned xb_add(unsigned* p, unsigned v) { return __hip_atomic_fetch_add(p, v, __ATOMIC_RELAXED, __HIP_MEMORY_SCOPE_AGENT); }
__device__ __forceinline__ unsigned xb_xcc_id() { return (unsigned)__builtin_amdgcn_s_getreg((3 << 11) | 20) & 0xFu; }
#define XB_SPIN(cond, bar) do { unsigned _sp = 0; while (cond) { __builtin_amdgcn_s_sleep(1); \
    if ((++_sp & 255u) == 0u) { if (xb_ld(&(bar)[XB_TMO])) break; if (_sp > XB_SPIN_CAP) { atomicAdd(&(bar)[XB_TMO], 1u); break; } } } } while (0)
struct XcdBarrier { unsigned* bar; unsigned x; volatile LAS unsigned* st; };
__device__ __forceinline__ XcdBarrier xcd_barrier_post(unsigned* bar, volatile LAS unsigned* st) {
    XcdBarrier b; b.bar = bar; b.x = xb_xcc_id(); b.st = st;
    if (threadIdx.x == 0) (void)xb_add(&bar[XB_XCNT(b.x)], 1u);
    return b;
}
__device__ __forceinline__ void xcd_barrier_complete(unsigned* bar, unsigned x, unsigned& nloc, unsigned& nx) {
    const unsigned G = gridDim.x * gridDim.y * gridDim.z;
    unsigned sum, cnt, mine, sp = 0u;
    for (;;) {
        sum = 0u; cnt = 0u; mine = 0u;
#pragma unroll
        for (unsigned j = 0; j < 16; ++j) { const unsigned c = xb_ld(&bar[XB_XCNT(j)]); sum += c; cnt += (c > 0u) ? 1u : 0u; mine = (j == x) ? c : mine; }
        if (sum == G) break;
        __builtin_amdgcn_s_sleep(1);
        if ((++sp & 255u) == 0u) { if (xb_ld(&bar[XB_TMO])) break; if (sp > XB_SPIN_CAP) { atomicAdd(&bar[XB_TMO], 1u); break; } }
    }
    nloc = mine > 0u ? mine : 1u; nx = cnt > 0u ? cnt : 1u;
}
__device__ __forceinline__ void xcd_barrier(const XcdBarrier& b_in) {
    asm volatile("s_waitcnt vmcnt(0)" ::: "memory");
    __syncthreads();
    if (threadIdx.x == 0) {
        const XcdBarrier& b = b_in;
        unsigned* bar = b.bar;
        __builtin_amdgcn_s_waitcnt(0);
        unsigned nloc = b.st[0], nx = b.st[1];
        if (nloc == 0u) { xcd_barrier_complete(bar, b.x, nloc, nx); b.st[0] = nloc; b.st[1] = nx; }
        const unsigned old = xb_add(&bar[XB_XSUB(b.x)], 1u);
        const unsigned gen = old / nloc;
        if (old + 1u == (gen + 1u) * nloc) {
            __builtin_amdgcn_fence(__ATOMIC_RELEASE, "agent");
            asm volatile("s_waitcnt vmcnt(0)" ::: "memory");
            const unsigned og = xb_add(&bar[XB_TOP], 1u);
            const unsigned tg = og / nx;
            if (og + 1u == (tg + 1u) * nx) xb_add(&bar[XB_TOPGEN], 1u);
            else XB_SPIN(xb_ld(&bar[XB_TOPGEN]) == tg, bar);
            __builtin_amdgcn_fence(__ATOMIC_ACQUIRE, "agent");
            xb_add(&bar[XB_XGEN(b.x)], 1u);
            asm volatile("s_waitcnt vmcnt(0)" ::: "memory");
        } else {
            XB_SPIN(xb_ld(&bar[XB_XGEN(b.x)]) == gen, bar);
            __builtin_amdgcn_fence(__ATOMIC_ACQUIRE, "agent");
            asm volatile("s_waitcnt vmcnt(0)" ::: "memory");
        }
    }
    __syncthreads();
}

constexpr size_t MiB = 1u << 20;
constexpr size_t WS_CTL = 0, CTL_BYTES = 1 * MiB;
constexpr size_t WS_SSQ = 250 * (size_t)(1u << 20);
constexpr size_t WS_WIN = 2 * MiB;
constexpr size_t WS_WOUT = 19 * MiB, WS_WGATE = 21 * MiB, WS_WPROJ = 23 * MiB;
constexpr size_t WS_PB = 24 * MiB;
constexpr size_t WS_Z = 32 * MiB;
constexpr size_t WS_HB = 160 * MiB;
constexpr size_t WS_VF = 193 * MiB;
constexpr size_t WS_L1 = 225 * MiB;
constexpr size_t WS_VTA = 128 * MiB;
constexpr size_t WS_VTB = 144 * MiB;
constexpr size_t WS_KT = 225 * MiB;
constexpr size_t WS_LORA2 = 23 * MiB + 512 * 1024;
constexpr size_t WS_PG = 160 * MiB;
constexpr size_t WS_SB = 2 * MiB;
constexpr size_t WS_BON = 192 * MiB;
constexpr size_t WS_ST = 176 * MiB;
constexpr size_t WS_KV = 160 * MiB;
constexpr size_t WS_XR1 = 233 * MiB;
constexpr size_t XR0_OFF = 32 * MiB + 4096;
constexpr size_t WS_END = 256 * MiB;

constexpr int RING_BYTES = 131072, LDS_BYTES = 163840, MISC_OFF = LDS_BYTES - 512;

struct Args { const float* in[26]; float* out; unsigned char* ws; int ph_lo, ph_hi; };

__device__ __forceinline__ const float* inptr(int i) { asm volatile("" : "+s"(i)); const char* ka = (const char*)__builtin_amdgcn_kernarg_segment_ptr(); return *(const float* const*)(ka + 8 * i); }
struct InTab { __device__ __forceinline__ const float* operator[](int i) const { return inptr(i); } };
struct Frame {
    LAS unsigned char* lds; unsigned char* ldsg;
    int tid, lane, wave, G, vcu;
    InTab in; float* H; unsigned char* ws;
    __device__ __forceinline__ void retid() { int l; asm volatile("v_mbcnt_lo_u32_b32 %0, -1, 0\n\tv_mbcnt_hi_u32_b32 %0, -1, %0" : "=v"(l)); lane = l; tid = wave * 64 + l; }
    __device__ __forceinline__ float* ssq(int l) const { return (float*)(ws + WS_SSQ) + (size_t)l * T * 16; }
};

__device__ __forceinline__ void conv_item(const float* W, int ldw, int Kmax, int k0, int n0, bf16_t* dst, int ldd, int dr0, int drs, int dk0,
                                          const float* svec, float sa, float sb, float sc, LAS float* scr, int lane) {
    float wv[32];
#pragma unroll
    for (int i = 0; i < 32; ++i) { const int k = k0 + 2 * i + (lane >> 5); wv[i] = (k < Kmax) ? W[(size_t)k * ldw + n0 + (lane & 31)] : 0.f; }
#pragma unroll
    for (int i = 0; i < 32; ++i) { const int kk = 2 * i + (lane >> 5), k = k0 + kk; const float f = (k < Kmax) ? (sa + sb * (svec ? svec[k] : 0.f)) * sc : 0.f;
        scr[kk * 33 + (lane & 31)] = wv[i] * f; }
    LDS_WAIT(); asm volatile("" ::: "memory");
    const int c = lane & 7;
    if (k0 + 8 * c < Kmax) {
#pragma unroll
        for (int j = 0; j < 4; ++j) { const int n = (lane >> 3) + 8 * j; const LAS float* s = scr + (8 * c) * 33 + n;
            u32x4 o; o.x = pk2(s[0 * 33], s[1 * 33]); o.y = pk2(s[2 * 33], s[3 * 33]); o.z = pk2(s[4 * 33], s[5 * 33]); o.w = pk2(s[6 * 33], s[7 * 33]);
            *(GAS u32x4*)(dst + (size_t)(dr0 + n * drs) * ldd + dk0 + k0 + 8 * c) = o; }
    }
    LDS_WAIT(); asm volatile("" ::: "memory");
}
__device__ __forceinline__ void conv_item2(const float* W, int ldw, int k0, int n0, bf16_t* dst, int dr0, const float* mu, float sc, LAS float* scr, int lane) {
    float wv[32];
#pragma unroll
    for (int i = 0; i < 32; ++i) wv[i] = W[(size_t)(k0 + 2 * i + (lane >> 5)) * ldw + n0 + (lane & 31)];
#pragma unroll
    for (int half = 0; half < 2; ++half) {
#pragma unroll
        for (int i = 0; i < 32; ++i) { const int kk = 2 * i + (lane >> 5); const float m = mu[k0 + kk]; scr[kk * 33 + (lane & 31)] = wv[i] * ((half ? m : 1.f - m) * sc); }
        LDS_WAIT(); asm volatile("" ::: "memory");
        const int c = lane & 7;
#pragma unroll
        for (int j = 0; j < 4; ++j) { const int n = (lane >> 3) + 8 * j; const LAS float* s_ = scr + (8 * c) * 33 + n;
            u32x4 o; o.x = pk2(s_[0 * 33], s_[1 * 33]); o.y = pk2(s_[2 * 33], s_[3 * 33]); o.z = pk2(s_[4 * 33], s_[5 * 33]); o.w = pk2(s_[6 * 33], s_[7 * 33]);
            *(GAS u32x4*)(dst + (size_t)(dr0 + n) * 2048 + half * 1024 + k0 + 8 * c) = o; }
        LDS_WAIT(); asm volatile("" ::: "memory");
    }
}
__device__ __forceinline__ void conv_win_even(Frame& F, int li) {
    const int e = li >> 1; const float* W = F.in[6] + (size_t)e * D * ZW; const float* gain = F.in[2] + li * D; bf16_t* dst = (bf16_t*)(F.ws + WS_WIN);
    LAS float* scr = (LAS float*)(F.lds + F.wave * 16384);
    const int gw = F.vcu * 8 + F.wave, NGW = F.G * 8;
    for (int it = gw; it < 16 * 128; it += NGW) { const int kb = it >> 7, nb = it & 127, n0 = nb * 32, g = n0 >> 9, hh = (n0 & 511) >> 7, d0 = n0 & 127;
        int dr0 = n0, drs = 1; if (g < 2) { dr0 = g * 512 + hh * 128 + (d0 < 64 ? 2 * d0 : 2 * (d0 - 64) + 1); drs = 2; }
        const float sc = (g == 1 || g == 5) ? QK_SCALE : 1.f;
        conv_item(W, ZW, D, kb * 64, n0, dst, D, dr0, drs, 0, gain, 0.f, 1.f, sc, scr, F.lane); }
}
__device__ __forceinline__ void conv_win_odd(Frame& F, int li) {
    const int o = li >> 1; const float* mu = F.in[9] + (size_t)o * 6 * D; bf16_t* dst = (bf16_t*)(F.ws + WS_WIN);
    LAS float* scr = (LAS float*)(F.lds + F.wave * 16384);
    const int gw = F.vcu * 8 + F.wave, NGW = F.G * 8;
    bf16_t* dst2 = dst + (size_t)4096 * 1024;
    for (int it = gw; it < 4 * 512; it += NGW) { const int p = it >> 9, r = it & 511, kb = r >> 5, nb = r & 31;
        conv_item(F.in[10] + ((size_t)o * 4 + p) * D * D, D, D, kb * 64, nb * 32, dst + (size_t)p * 1024 * 1024, D, nb * 32, 1, 0, nullptr, 1.f, 0.f, 1.f, scr, F.lane); }
    for (int it = (gw + NGW - 1280 % NGW) % NGW; it < 32 + 32 + 16; it += NGW) { const float* W; int ldw, n0, dr0, mi, kb; const int r = it;
        if (r < 32) { W = F.in[13] + (size_t)o * D * 64; ldw = 64; kb = r >> 1; n0 = (r & 1) * 32; dr0 = n0; mi = 4; }
        else if (r < 64) { const int q = r - 32; W = F.in[16] + (size_t)o * D * 64; ldw = 64; kb = q >> 1; n0 = (q & 1) * 32; dr0 = 64 + n0; mi = 5; }
        else { const int q = r - 64; W = F.in[19]; ldw = 32; kb = q; n0 = 0; dr0 = 128; mi = 2; }
        conv_item2(W, ldw, kb * 64, n0, dst2, dr0, mu + mi * D, (r >= 64 && o == 0) ? 0.f : 1.f, scr, F.lane); }
    { u32x4 z = {0u, 0u, 0u, 0u}; GAS u32x4* zp = (GAS u32x4*)(dst2 + (size_t)160 * 2048); const int n16 = 96 * 2048 * 2 / 16;
      for (int i = (F.vcu * 512 + F.tid); i < n16; i += F.G * 512) zp[i] = z; }
}
__device__ __forceinline__ void conv_wrest_a(Frame& F, int li) {
    const float* Wp = F.in[4] + (size_t)li * PLE * D;
    LAS float* scr = (LAS float*)(F.lds + F.wave * 16384);
    const int gw = F.vcu * 8 + F.wave, NGW = F.G * 8;
    for (int r = (gw + NGW - 1024 % NGW) % NGW; r < 128; r += NGW)
        conv_item(Wp, D, PLE, (r >> 5) * 64, (r & 31) * 32, (bf16_t*)(F.ws + WS_WPROJ), PLE, (r & 31) * 32, 1, 0, nullptr, 1.f, 0.f, 1.f, scr, F.lane);
    const float* P = F.in[1] + (size_t)li * T * PLE; GAS u32x4* pb = (GAS u32x4*)(F.ws + WS_PB); const int n8 = T * PLE / 8;
    const int stp = F.G * 512;
    for (int i0 = F.vcu * 512 + F.tid; i0 < n8; i0 += 4 * stp) { f32x4 a[4], b[4];
#pragma unroll
        for (int j = 0; j < 4; ++j) { const int i = min(i0 + j * stp, n8 - 1); a[j] = *(const f32x4*)(P + (size_t)i * 8); b[j] = *(const f32x4*)(P + (size_t)i * 8 + 4); }
#pragma unroll
        for (int j = 0; j < 4; ++j) { const int i = i0 + j * stp;
            u32x4 o; o.x = cvt_pk_bf16(a[j][0], a[j][1]); o.y = cvt_pk_bf16(a[j][2], a[j][3]); o.z = cvt_pk_bf16(b[j][0], b[j][1]); o.w = cvt_pk_bf16(b[j][2], b[j][3]); if (i < n8) pb[i] = o; } }
}
__device__ __forceinline__ void conv_wrest_b(Frame& F, int li, int widx, int nw) {
    const bool even = (li & 1) == 0; const int e = li >> 1;
    const float* Wo = even ? F.in[7] + (size_t)e * D * D : F.in[11] + (size_t)e * D * D; const float* Wg = F.in[5] + (size_t)li * D * D;
    LAS float* scr = (LAS float*)(F.lds + F.wave * 16384);
    for (int it = widx * 8 + F.wave; it < 1024; it += nw * 8) {
        if (it < 512) conv_item(Wo, D, D, (it >> 5) * 64, (it & 31) * 32, (bf16_t*)(F.ws + WS_WOUT), D, (it & 31) * 32, 1, 0, nullptr, 1.f, 0.f, 1.f, scr, F.lane);
        else { const int r = it - 512; conv_item(Wg, D, D, (r >> 5) * 64, (r & 31) * 32, (bf16_t*)(F.ws + WS_WGATE), D, (r & 31) * 32, 1, 0, nullptr, 1.f, 0.f, 1.f, scr, F.lane); }
    }
}
__device__ __forceinline__ void conv_lora2(Frame& F, int li) {
    const int o = li >> 1; LAS float* scr = (LAS float*)(F.lds + F.wave * 16384);
    bf16_t* W2T = (bf16_t*)(F.ws + WS_LORA2); bf16_t* A2T = W2T + 1024 * 64; bf16_t* V2T = A2T + 1024 * 64;
    const int gw = F.vcu * 8 + F.wave, NGW = F.G * 8;
    for (int it = gw; it < 96; it += NGW) {
        if (it < 32) conv_item(F.in[14] + (size_t)o * 64 * D, D, 64, 0, it * 32, W2T, 64, it * 32, 1, 0, nullptr, 1.f, 0.f, 1.f, scr, F.lane);
        else if (it < 64) conv_item(F.in[17] + (size_t)o * 64 * D, D, 64, 0, (it - 32) * 32, A2T, 64, (it - 32) * 32, 1, 0, nullptr, 1.f, 0.f, 1.f, scr, F.lane);
        else conv_item(F.in[20], D, 32, 0, (it - 64) * 32, V2T, 32, (it - 64) * 32, 1, 0, nullptr, 1.f, 0.f, 1.f, scr, F.lane);
    }
}
__device__ __forceinline__ void rows_p0(Frame& F) {
    const float* x = F.in[0]; bf16_t* HB = (bf16_t*)(F.ws + WS_HB); float* s0 = F.ssq(0);
    const int stp = F.G * 8;
    for (int row0 = F.vcu * 8 + F.wave; row0 < T; row0 += 4 * stp) {
        f32x4 v[4][4];
#pragma unroll
        for (int r = 0; r < 4; ++r) { const int row = min(row0 + r * stp, T - 1); const f32x4* xr = (const f32x4*)(x + (size_t)row * D) + F.lane;
#pragma unroll
            for (int j = 0; j < 4; ++j) v[r][j] = xr[64 * j]; }
#pragma unroll
        for (int r = 0; r < 4; ++r) { const int row = row0 + r * stp; if (row < T) { u32x2* br = (u32x2*)(HB + (size_t)row * D) + F.lane; float s = 0.f;
#pragma unroll
            for (int j = 0; j < 4; ++j) { const f32x4 w4 = v[r][j]; s += (w4[0] * w4[0] + w4[1] * w4[1]) + (w4[2] * w4[2] + w4[3] * w4[3]); u32x2 w; w.x = cvt_pk_bf16(w4[0], w4[1]); w.y = cvt_pk_bf16(w4[2], w4[3]); br[64 * j] = w; }
            s = wave_sum(s); if (F.lane < 16) s0[(size_t)row * 16 + F.lane] = F.lane == 0 ? s : 0.f; } }
    }
}
__device__ __forceinline__ void rows_norm(Frame& F, int li) {
    const float* gain = F.in[2] + li * D; const float* mur = F.in[9] + (size_t)(li >> 1) * 6 * D; bf16_t* HN = (bf16_t*)(F.H); bf16_t* Zb = (bf16_t*)(F.ws + WS_Z);     const bf16_t* Ha = (const bf16_t*)(F.ws + WS_HB); const float* sq = F.ssq(li);
    bf16_t* XR0 = (bf16_t*)((char*)F.H + XR0_OFF); bf16_t* XR1 = (bf16_t*)(F.ws + WS_XR1);
    f32x4 g[4], mu[4], muk[4], muv[4], mug[4];
#pragma unroll
    for (int j = 0; j < 4; ++j) { g[j] = *((const f32x4*)gain + F.lane + 64 * j); mu[j] = *((const f32x4*)mur + F.lane + 64 * j); muk[j] = *((const f32x4*)(mur + D) + F.lane + 64 * j);
        muv[j] = *((const f32x4*)(mur + 2 * D) + F.lane + 64 * j); mug[j] = *((const f32x4*)(mur + 3 * D) + F.lane + 64 * j); }
    const int gw = F.vcu * 8 + F.wave, NGW = F.G * 8; const int rb = (int)((long)gw * T / NGW), re = (int)((long)(gw + 1) * T / NGW);
    auto up4 = [](u32x2 w) { return (f32x4){__uint_as_float(w.x << 16), __uint_as_float(w.x & 0xffff0000u), __uint_as_float(w.y << 16), __uint_as_float(w.y & 0xffff0000u)}; };
    f32x4 pv[4];
    if (rb < re) { const bool first = (rb & (SEQ - 1)) == 0; const int prow = first ? rb : rb - 1; const u32x2* hp = (const u32x2*)(Ha + (size_t)prow * D) + F.lane;
        const float rp = first ? 0.f : rsqrtf(ssq_sum(sq, prow) * (1.f / D) + 1e-6f);
#pragma unroll
        for (int j = 0; j < 4; ++j) pv[j] = up4(hp[64 * j]) * rp * g[j]; }
    for (int row0 = rb; row0 < re; row0 += 2) {
        u32x2 hw[2][4]; float rs[2];
#pragma unroll
        for (int r = 0; r < 2; ++r) { const int row = min(row0 + r, re - 1); const u32x2* hr = (const u32x2*)(Ha + (size_t)row * D) + F.lane;
#pragma unroll
            for (int j = 0; j < 4; ++j) hw[r][j] = hr[64 * j];
            rs[r] = rsqrtf(ssq_sum(sq, row) * (1.f / D) + 1e-6f); }
#pragma unroll
        for (int r = 0; r < 2; ++r) { const int row = row0 + r; if (row < re) {
            u32x2* br = (u32x2*)(HN + (size_t)(row + 1 + (row >= SEQ ? 1 : 0)) * D) + F.lane;
            u32x2* xr = (u32x2*)((row < SEQ ? XR0 + (size_t)row * D : XR1 + (size_t)(row - SEQ) * D)) + F.lane; u32x2* zr = (u32x2*)(Zb + (size_t)row * ZW) + F.lane;
            const bool first = (row & (SEQ - 1)) == 0;
#pragma unroll
            for (int j = 0; j < 4; ++j) { const f32x4 v = up4(hw[r][j]) * rs[r] * g[j]; const f32x4 p = first ? (f32x4){0.f, 0.f, 0.f, 0.f} : pv[j]; const f32x4 dd = p - v, x = v + dd * mu[j], xk4 = v + dd * muk[j], xv4 = v + dd * muv[j], xg4 = v + dd * mug[j]; pv[j] = v;
                u32x2 w; w.x = cvt_pk_bf16(v[0], v[1]); w.y = cvt_pk_bf16(v[2], v[3]); br[64 * j] = w;
                u32x2 wx; wx.x = cvt_pk_bf16(x[0], x[1]); wx.y = cvt_pk_bf16(x[2], x[3]); xr[64 * j] = wx;
                u32x2 wk; wk.x = cvt_pk_bf16(xk4[0], xk4[1]); wk.y = cvt_pk_bf16(xk4[2], xk4[3]); zr[768 + 64 * j] = wk;
                u32x2 wv; wv.x = cvt_pk_bf16(xv4[0], xv4[1]); wv.y = cvt_pk_bf16(xv4[2], xv4[3]); zr[256 + 64 * j] = wv;
                u32x2 wg; wg.x = cvt_pk_bf16(xg4[0], xg4[1]); wg.y = cvt_pk_bf16(xg4[2], xg4[3]); zr[64 * j] = wg; } } }
    }
    if (F.vcu == 0 && F.wave < 2) { u32x2* br = (u32x2*)(HN + (size_t)(F.wave ? SEQ + 1 : 0) * D) + F.lane; u32x2 z = {0u, 0u};
#pragma unroll
        for (int j = 0; j < 4; ++j) br[64 * j] = z; }
}
__device__ __forceinline__ void rows_final(Frame& F) {
    const float* gain = F.in[3]; const float* sq = F.ssq(4); const bf16_t* Ha = (const bf16_t*)(F.ws + WS_HB);
    f32x4 g[4];
#pragma unroll
    for (int j = 0; j < 4; ++j) g[j] = *((const f32x4*)gain + F.lane + 64 * j);
    const int stp = F.G * 8;
    for (int row0 = F.vcu * 8 + F.wave; row0 < T; row0 += 4 * stp) {
        u32x2 hw[4][4]; float rs[4];
#pragma unroll
        for (int r = 0; r < 4; ++r) { const int row = min(row0 + r * stp, T - 1); const u32x2* hr = (const u32x2*)(Ha + (size_t)row * D) + F.lane;
#pragma unroll
            for (int j = 0; j < 4; ++j) hw[r][j] = hr[64 * j];
            rs[r] = rsqrtf(ssq_sum(sq, row) * (1.f / D) + 1e-6f); }
#pragma unroll
        for (int r = 0; r < 4; ++r) { const int row = row0 + r * stp; if (row < T) { f32x4* orow = (f32x4*)(F.H + (size_t)row * D) + F.lane;
#pragma unroll
            for (int j = 0; j < 4; ++j) { const u32x2 w = hw[r][j]; const f32x4 h4 = {__uint_as_float(w.x << 16), __uint_as_float(w.x & 0xffff0000u), __uint_as_float(w.y << 16), __uint_as_float(w.y & 0xffff0000u)};
                orow[64 * j] = h4 * rs[r] * g[j]; } } }
    }
}

typedef float f32x16 __attribute__((ext_vector_type(16)));
template <bool DUMMY>
__device__ __forceinline__ void sb_unit(Frame& F, int bh, int qb) {
    const int lane = F.lane, l31 = lane & 31, hi = lane >> 5, b = bh >> 2, h = bh & 3;
    bf16_t* Z = (bf16_t*)(F.ws + WS_Z); const bf16_t* VT = (const bf16_t*)(F.ws + WS_VTB) + (size_t)bh * 128 * SEQ;
    const size_t rowb = (size_t)b * SEQ; const int q0 = qb * 32, tq = q0 + l31;
    bf16x8 qr[8];
    { const bf16_t* qp = Z + (rowb + tq) * ZE + 1536 + h * 128 + hi * 8;
#pragma unroll
      for (int ks = 0; ks < 8; ++ks) qr[ks] = *(const bf16x8*)(qp + 16 * ks); }
    f32x16 o[4];
#pragma unroll
    for (int d = 0; d < 4; ++d)
#pragma unroll
        for (int r = 0; r < 16; ++r) o[d][r] = 0.f;
    float carry = 1.f;
    const int pi = 16 * ((l31 >> 2) & 1) + (l31 & 3) + 4 * (l31 >> 3);
    const bf16_t* Kb = Z + rowb * ZE + 2048 + h * 128 + hi * 8;
    bf16x8 ka0[8], ka1[8];
    { const bf16_t* kp0 = Kb + (size_t)(((q0 + 31) >> 6) * 64 + pi) * ZE; const bf16_t* kp1 = kp0 + (size_t)32 * ZE;
#pragma unroll
      for (int ks = 0; ks < 8; ++ks) { ka0[ks] = *(const bf16x8*)(kp0 + 16 * ks); ka1[ks] = *(const bf16x8*)(kp1 + 16 * ks); } }
    for (int kt = (q0 + 31) >> 6; kt >= 0; --kt) {
        const int kbase = kt * 64;
        bf16x8 nb0[8], nb1[8];
        { const int kn = kt > 0 ? kt - 1 : 0; const bf16_t* kp0 = Kb + (size_t)(kn * 64 + pi) * ZE; const bf16_t* kp1 = kp0 + (size_t)32 * ZE;
#pragma unroll
          for (int ks = 0; ks < 8; ++ks) { nb0[ks] = *(const bf16x8*)(kp0 + 16 * ks); nb1[ks] = *(const bf16x8*)(kp1 + 16 * ks); } }
        f32x16 p0, p1;
#pragma unroll
        for (int r = 0; r < 16; ++r) { p0[r] = 0.f; p1[r] = 0.f; }
#pragma unroll
        for (int ks = 0; ks < 8; ++ks) { p0 = __builtin_amdgcn_mfma_f32_32x32x16_bf16(ka0[ks], qr[ks], p0, 0, 0, 0); p1 = __builtin_amdgcn_mfma_f32_32x32x16_bf16(ka1[ks], qr[ks], p1, 0, 0, 0); }

        float f1 = 1.f, f0 = 1.f;
        const int k1 = kbase + 32 + 16 * hi, k0 = kbase + 16 * hi;
#pragma unroll
        for (int r = 15; r >= 0; --r) { const float z = fminf(p1[r], 80.f); const float e = exp2f(z * 1.4426950408889634f); float rd = __builtin_amdgcn_rcpf(1.f + e); float be = e * rd;
            const bool valid = (k1 + r) < tq; be = valid ? be : 0.f; rd = valid ? rd : 1.f; p1[r] = be * f1; f1 *= rd; }
#pragma unroll
        for (int r = 15; r >= 0; --r) { const float z = fminf(p0[r], 80.f); const float e = exp2f(z * 1.4426950408889634f); float rd = __builtin_amdgcn_rcpf(1.f + e); float be = e * rd;
            const bool valid = (k0 + r) < tq; be = valid ? be : 0.f; rd = valid ? rd : 1.f; p0[r] = be * f0; f0 *= rd; }
        const float pf0 = __shfl_xor(f0, 32), pf1 = __shfl_xor(f1, 32);
        const float tail1 = hi ? 1.f : pf1;
        const float tail0 = hi ? (pf1 * f1) : (pf0 * f1 * pf1);
        const float s1 = tail1 * carry, s0 = tail0 * carry;
        carry *= (f0 * f1) * (pf0 * pf1);
        u32x4 pa[2][2];
#pragma unroll
        for (int s = 0; s < 2; ++s) {
            pa[0][s].x = cvt_pk_bf16(p0[8 * s + 0] * s0, p0[8 * s + 1] * s0); pa[0][s].y = cvt_pk_bf16(p0[8 * s + 2] * s0, p0[8 * s + 3] * s0);
            pa[0][s].z = cvt_pk_bf16(p0[8 * s + 4] * s0, p0[8 * s + 5] * s0); pa[0][s].w = cvt_pk_bf16(p0[8 * s + 6] * s0, p0[8 * s + 7] * s0);
            pa[1][s].x = cvt_pk_bf16(p1[8 * s + 0] * s1, p1[8 * s + 1] * s1); pa[1][s].y = cvt_pk_bf16(p1[8 * s + 2] * s1, p1[8 * s + 3] * s1);
            pa[1][s].z = cvt_pk_bf16(p1[8 * s + 4] * s1, p1[8 * s + 5] * s1); pa[1][s].w = cvt_pk_bf16(p1[8 * s + 6] * s1, p1[8 * s + 7] * s1);
        }
        const bf16_t* vp = VT + (size_t)l31 * SEQ + kbase + 16 * hi;
#pragma unroll
        for (int d = 0; d < 4; ++d)
#pragma unroll
            for (int blk = 0; blk < 2; ++blk)
#pragma unroll
                for (int s = 0; s < 2; ++s) { const bf16x8 vb = *(const bf16x8*)(vp + (size_t)(32 * d) * SEQ + 32 * blk + 8 * s);
                    o[d] = __builtin_amdgcn_mfma_f32_32x32x16_bf16(__builtin_bit_cast(bf16x8, pa[blk][s]), vb, o[d], 0, 0, 0); }
#pragma unroll
        for (int ks = 0; ks < 8; ++ks) { ka0[ks] = nb0[ks]; ka1[ks] = nb1[ks]; }
        if (__all(carry < 7.9e-31f)) break;
    }
    bf16_t gav[16][4];
#pragma unroll
    for (int r = 0; r < 16; ++r) { const int qrow = q0 + (r & 3) + 8 * (r >> 2) + 4 * hi; const bf16_t* gp = Z + (rowb + qrow) * ZE + 2560 + h * 128 + l31;
#pragma unroll
        for (int d = 0; d < 4; ++d) gav[r][d] = gp[32 * d]; }
#pragma unroll
    for (int r = 0; r < 16; ++r) { const int qrow = q0 + (r & 3) + 8 * (r >> 2) + 4 * hi; bf16_t* gp = Z + (rowb + qrow) * ZE + 2560 + h * 128 + l31;
#pragma unroll
        for (int d = 0; d < 4; ++d) { const float g = bf2f(gav[r][d]); const float ov = o[d][r] * siluf_(g); if (!DUMMY) gp[32 * d] = (bf16_t)f2bf(ov); else asm volatile("" :: "v"(ov)); } }
}
__device__ __forceinline__ void ret_stage_a(Frame& F, int u, int u2) {
    const int l31 = F.lane & 31, hi = F.lane >> 5;
    bf16x8 va[8], k0[8], k1[8];
    auto ld = [&](int uu) { const int cu = uu >> 3, w8 = uu & 7, bh = cu & 7, n = cu >> 3, dvb = w8 >> 1, dkp = w8 & 1;
        const bf16_t* vt = (const bf16_t*)(F.ws + WS_VTA) + ((size_t)(bh * 128 + 32 * dvb + l31)) * SEQ + n * 128 + 8 * hi;
        const bf16_t* kt = (const bf16_t*)(F.ws + WS_KT) + ((size_t)(bh * 128 + 64 * dkp + l31)) * SEQ + n * 128 + 8 * hi;
#pragma unroll
        for (int ks = 0; ks < 8; ++ks) { va[ks] = *(const bf16x8*)(vt + 16 * ks); k0[ks] = *(const bf16x8*)(kt + 16 * ks); k1[ks] = *(const bf16x8*)(kt + (size_t)32 * SEQ + 16 * ks); } };
    auto mma = [&](f32x16& a0, f32x16& a1) {
#pragma unroll
        for (int r = 0; r < 16; ++r) { a0[r] = 0.f; a1[r] = 0.f; }
#pragma unroll
        for (int ks = 0; ks < 8; ++ks) { a0 = __builtin_amdgcn_mfma_f32_32x32x16_bf16(va[ks], k0[ks], a0, 0, 0, 0); a1 = __builtin_amdgcn_mfma_f32_32x32x16_bf16(va[ks], k1[ks], a1, 0, 0, 0); } };
    auto st = [&](int uu, const f32x16& a0, const f32x16& a1) { const int cu = uu >> 3, w8 = uu & 7, dvb = w8 >> 1, dkp = w8 & 1;
        bf16_t* kv = (bf16_t*)(F.H) + ((size_t)cu * 128 + 32 * dvb) * 128 + 64 * dkp + l31;
#pragma unroll
        for (int r = 0; r < 16; ++r) { const int dv = (r & 3) + 8 * (r >> 2) + 4 * hi; kv[dv * 128] = (bf16_t)f2bf(a0[r]); kv[dv * 128 + 32] = (bf16_t)f2bf(a1[r]); } };
    f32x16 a0, a1;
    ld(u); mma(a0, a1);
    if (u2 >= 0) { ld(u2); st(u, a0, a1); f32x16 b0, b1; mma(b0, b1); st(u2, b0, b1); }
    else st(u, a0, a1);
}
__device__ __forceinline__ void ret_stage_b(Frame& F) {
    const int e = F.vcu * 512 + F.tid; if (e >= 8 * 128 * 128) return;
    const int h = (e >> 14) & 3; const float g128 = exp2f(128.f * log2f(1.f - exp2f(-5.f - (float)h)));
    const bf16_t* p = (const bf16_t*)(F.H) + e; bf16_t* q = (bf16_t*)(F.H) + (size_t)8 * 1024 * 1024 + e; float S = 0.f;
    bf16_t kvv[64];
#pragma unroll
    for (int n = 0; n < 64; ++n) kvv[n] = p[(size_t)n * 131072];
#pragma unroll
    for (int n = 0; n < 64; ++n) { q[(size_t)n * 131072] = (bf16_t)f2bf(S); S = S * g128 + bf2f(kvv[n]); }
}
template <bool DUMMY>
__device__ __forceinline__ void ret_stage_c(Frame& F, int u, const float* gng) {
    const int lane = F.lane, l31 = lane & 31, hi = lane >> 5, cu = u >> 2, qblk = u & 3, bh = cu & 7, n = cu >> 3, b = bh >> 2, h = bh & 3;
    bf16_t* Z = (bf16_t*)(F.ws + WS_Z); const size_t rowb = (size_t)b * SEQ; const int t0 = n * 128, tq = t0 + 32 * qblk + l31;
    bf16x8 qr[8];
    { const bf16_t* qp = Z + (rowb + tq) * ZE + h * 128 + hi * 8;
#pragma unroll
      for (int ks = 0; ks < 8; ++ks) qr[ks] = *(const bf16x8*)(qp + 16 * ks); }
    f32x16 o[4];
#pragma unroll
    for (int d = 0; d < 4; ++d)
#pragma unroll
        for (int r = 0; r < 16; ++r) o[d][r] = 0.f;
    { const bf16_t* sp = (const bf16_t*)(F.H) + (size_t)8 * 1024 * 1024 + ((size_t)cu * 128 + l31) * 128 + 8 * hi;
#pragma unroll
      for (int ks = 0; ks < 8; ++ks)
#pragma unroll
          for (int d = 0; d < 4; ++d) { const bf16x8 sb = *(const bf16x8*)(sp + (size_t)(32 * d) * 128 + 16 * ks); o[d] = __builtin_amdgcn_mfma_f32_32x32x16_bf16(qr[ks], sb, o[d], 0, 0, 0); } }
    const int pi = 16 * ((l31 >> 2) & 1) + (l31 & 3) + 4 * (l31 >> 3);
    const bf16_t* Kb = Z + rowb * ZE + 512 + h * 128 + hi * 8;
    const bf16_t* VT = (const bf16_t*)(F.ws + WS_VTA) + ((size_t)(bh * 128 + l31)) * SEQ + 16 * hi;
    bf16x8 ka[8];
    { const bf16_t* kp = Kb + (size_t)(t0 + pi) * ZE;
#pragma unroll
      for (int ks = 0; ks < 8; ++ks) ka[ks] = *(const bf16x8*)(kp + 16 * ks); }
    for (int kb = 0; kb <= qblk; ++kb) {
        const int kbase = t0 + 32 * kb;
        bf16x8 nb[8];
        { const int kn = kb < qblk ? kb + 1 : kb; const bf16_t* kp = Kb + (size_t)(t0 + 32 * kn + pi) * ZE;
#pragma unroll
          for (int ks = 0; ks < 8; ++ks) nb[ks] = *(const bf16x8*)(kp + 16 * ks); }
        f32x16 p;
#pragma unroll
        for (int r = 0; r < 16; ++r) p[r] = 0.f;
#pragma unroll
        for (int ks = 0; ks < 8; ++ks) p = __builtin_amdgcn_mfma_f32_32x32x16_bf16(ka[ks], qr[ks], p, 0, 0, 0);
        if (kb == qblk) {
#pragma unroll
            for (int r = 0; r < 16; ++r) p[r] = (kbase + 16 * hi + r <= tq) ? p[r] : 0.f; }
        u32x4 pa[2];
#pragma unroll
        for (int s = 0; s < 2; ++s) { pa[s].x = cvt_pk_bf16(p[8 * s], p[8 * s + 1]); pa[s].y = cvt_pk_bf16(p[8 * s + 2], p[8 * s + 3]); pa[s].z = cvt_pk_bf16(p[8 * s + 4], p[8 * s + 5]); pa[s].w = cvt_pk_bf16(p[8 * s + 6], p[8 * s + 7]); }
#pragma unroll
        for (int d = 0; d < 4; ++d)
#pragma unroll
            for (int s = 0; s < 2; ++s) { const bf16x8 vb = *(const bf16x8*)(VT + (size_t)(32 * d) * SEQ + kbase + 8 * s);
                o[d] = __builtin_amdgcn_mfma_f32_32x32x16_bf16(__builtin_bit_cast(bf16x8, pa[s]), vb, o[d], 0, 0, 0); }
#pragma unroll
        for (int ks = 0; ks < 8; ++ks) ka[ks] = nb[ks];
    }
    float gg[4];
#pragma unroll
    for (int d = 0; d < 4; ++d) gg[d] = gng[h * 128 + 32 * d + l31];
    bf16_t gav[16][4];
#pragma unroll
    for (int r = 0; r < 16; ++r) { const int qrow = t0 + 32 * qblk + (r & 3) + 8 * (r >> 2) + 4 * hi; const bf16_t* gp = Z + (rowb + qrow) * ZE + 1024 + h * 128 + l31;
#pragma unroll
        for (int d = 0; d < 4; ++d) gav[r][d] = gp[32 * d]; }
#pragma unroll
    for (int r = 0; r < 16; ++r) {
        float sm = (o[0][r] + o[1][r]) + (o[2][r] + o[3][r]);
        sm = red32(sm);
        const float mu = sm * (1.f / 128.f); float q = 0.f;
#pragma unroll
        for (int d = 0; d < 4; ++d) { const float dd = o[d][r] - mu; q += dd * dd; }
        q = red32(q);
        const float rsd = rsqrtf(q * (1.f / 128.f) + 1e-5f);
        const int qrow = t0 + 32 * qblk + (r & 3) + 8 * (r >> 2) + 4 * hi; bf16_t* gp = Z + (rowb + qrow) * ZE + 1024 + h * 128 + l31;
#pragma unroll
        for (int d = 0; d < 4; ++d) { const float ga = bf2f(gav[r][d]); const float ov = (o[d][r] - mu) * rsd * gg[d] * siluf_(ga); if (!DUMMY) gp[32 * d] = (bf16_t)f2bf(ov); else asm volatile("" :: "v"(ov)); }
    }
}
__device__ __forceinline__ bf16x8 ld8p(const bf16_t* p) { return *(const bf16x8*)p; }
namespace rw {
constexpr int S64 = 72, S128 = 136, LFS = 68;
constexpr int O_AT = 0, O_RT = O_AT + 9216, O_E = O_RT + 9216, O_ET = O_E + 18432, O_AM = O_ET + 17408, O_X0 = O_AM + 18432, O_LF = O_X0 + 17408, O_MM = O_LF + 17408,
              O_NN = O_MM + 9216, O_PC = O_NN + 17408, O_GC = O_PC + 9216, O_SM = O_GC + 9216, O_END = O_SM + 8192;
static_assert(O_END <= 160 * 1024 - 1024, "rwkv stage X LDS map");
typedef __attribute__((address_space(3))) bf16_t lbf;
typedef __attribute__((address_space(3))) float lf32;
__device__ __forceinline__ bf16x8 ld8(const bf16_t* p) { return *(const bf16x8*)p; }
__device__ __forceinline__ bf16x8 ld8(const LAS bf16_t* p) { return *(const LAS bf16x8*)p; }
__device__ __forceinline__ bf16x8 ld8(const GAS bf16_t* p) { return *(const GAS bf16x8*)p; }
template <int MT, int NT, int KS, class PA, class PB, class Epi>
__device__ __forceinline__ void mm(PA A, int lda, PB B, int ldb, int wave, int lane, Epi epi) {
    const int fr = lane & 15, g = lane >> 4;
    static_assert((MT * NT) % 8 == 0, "mm: tile count must be a multiple of the 8 waves");
#pragma unroll
    for (int ti = 0; ti < MT * NT / 8; ++ti) { const int tile = wave + 8 * ti; const int mt = tile / NT, nt = tile % NT;
        f32x4 acc = {0.f, 0.f, 0.f, 0.f};
        PA ap = A + (mt * 16 + fr) * lda + 8 * g; PB bp = B + (nt * 16 + fr) * ldb + 8 * g;
#pragma unroll
        for (int ks = 0; ks < KS; ++ks) acc = __builtin_amdgcn_mfma_f32_16x16x32_bf16(ld8(ap + 32 * ks), ld8(bp + 32 * ks), acc, 0, 0, 0);
        epi(ti, mt * 16 + 4 * g, nt * 16 + fr, acc);
    }
}
template <int MT, int NT, int KS, class PA, class PB, class Epi>
__device__ __forceinline__ void mm_rt(PA A, int lda, PB B, int ldb, int w, int nw, int lane, Epi epi) {
    const int fr = lane & 15, g = lane >> 4;
#pragma unroll 1
    for (int tile = w; tile < MT * NT; tile += nw) { const int mt = tile / NT, nt = tile % NT;
        f32x4 acc = {0.f, 0.f, 0.f, 0.f};
        PA ap = A + (mt * 16 + fr) * lda + 8 * g; PB bp = B + (nt * 16 + fr) * ldb + 8 * g;
#pragma unroll
        for (int ks = 0; ks < KS; ++ks) acc = __builtin_amdgcn_mfma_f32_16x16x32_bf16(ld8(ap + 32 * ks), ld8(bp + 32 * ks), acc, 0, 0, 0);
        epi(mt * 16 + 4 * g, nt * 16 + fr, acc);
    }
}
__device__ __forceinline__ unsigned short bfs(float f) { return (unsigned short)f2bf(f); }
__device__ __forceinline__ void st4(LAS bf16_t* p, f32x4 v) { u32x2 w; w.x = cvt_pk_bf16(v[0], v[1]); w.y = cvt_pk_bf16(v[2], v[3]); *(LAS u32x2*)p = w; }
}

template <bool DUMMY>
__device__ __forceinline__ void rwkv_stage_x(Frame& F, int li, unsigned long long& xacc) {
    using namespace rw;
#define TSX(k) do { if (MK_XA == (k) && li == 1 && F.wave == 0) { const unsigned long long t_ = __builtin_amdgcn_s_memrealtime(); *(volatile LAS unsigned long long*)(F.lds + MISC_OFF + 256) = t_; } if (MK_XB == (k) && li == 1 && F.wave == 0) { volatile LAS unsigned long long* p_ = (volatile LAS unsigned long long*)(F.lds + MISC_OFF + 256); const unsigned long long t0_ = p_[0]; if (t0_) p_[1] += __builtin_amdgcn_s_memrealtime() - t0_; } } while (0)
    const int o = li >> 1;
    LAS unsigned char* L = F.lds;
    LAS bf16_t* At = (LAS bf16_t*)(L + O_AT); LAS bf16_t* Rt = (LAS bf16_t*)(L + O_RT); LAS bf16_t* E = (LAS bf16_t*)(L + O_E); LAS bf16_t* ET = (LAS bf16_t*)(L + O_ET); LAS bf16_t* AM = (LAS bf16_t*)(L + O_AM);
    LAS bf16_t* X0T = (LAS bf16_t*)(L + O_X0); LAS float* Lf = (LAS float*)(L + O_LF); LAS bf16_t* Mm = (LAS bf16_t*)(L + O_MM); LAS bf16_t* NN = (LAS bf16_t*)(L + O_NN); LAS float* CS = (LAS float*)(L + O_NN);
    LAS bf16_t* Pc = (LAS bf16_t*)(L + O_PC); LAS bf16_t* Gc = (LAS bf16_t*)(L + O_GC); LAS float* gamC = (LAS float*)(L + O_SM); LAS float* SEGT = gamC + 64; LAS float* PRM = gamC + 64 + 1024;
    LAS bf16_t* Tm = At; LAS bf16_t* Qh = AM; LAS bf16_t* PT = AM + 64 * S64; LAS bf16_t* WT = Mm;
    GAS bf16_t* Z = (GAS bf16_t*)(F.ws + WS_Z); const GAS bf16_t* L1g = (const GAS bf16_t*)(F.ws + WS_L1); GAS bf16_t* VF = (GAS bf16_t*)(F.ws + WS_VF);
    const GAS bf16_t* W2T = (const GAS bf16_t*)(F.ws + WS_LORA2); const GAS bf16_t* A2T = W2T + 1024 * 64; const GAS bf16_t* V2T = A2T + 1024 * 64;
    GAS bf16_t* PG = (GAS bf16_t*)(F.H); GAS float* BON = (GAS float*)(F.ws + WS_BON);
    const float* w0p = F.in[12] + o * D; const float* a0p = F.in[15] + o * D; const float* v0p = F.in[18]; const float* kkp = F.in[21] + o * D; const float* kap = F.in[22] + o * D; const float* rkp = F.in[23] + o * D;
    f32x4 nlw[2], nla[2], nlv[2]; unsigned nr[4], nk[4], nv[4], nvf[4];
    bf16x8 fwa[2], fwb[4], faa[2], fab[4], fva, fvb[2];
    int hcur = -1;
    auto fetch_issue = [&](int u2, int c2, int tid2, const int part) {
        const int bh2 = u2 & 31, blk2 = u2 >> 5, b2 = bh2 >> 4, h2 = bh2 & 15; const size_t rows2 = (size_t)b2 * SEQ + (size_t)blk2 * 128 + 64 * c2;
        const int lane2 = tid2 & 63, fr2 = lane2 & 15, g2 = lane2 >> 4; int wave2 = F.wave; asm volatile("" : "+s"(wave2));
        if (part & 1) { const int mt2 = wave2 >> 1; const GAS bf16_t* ap = L1g + (rows2 + mt2 * 16 + fr2) * 256 + 8 * g2;
            fwa[0] = ld8(ap); fwa[1] = ld8(ap + 32); faa[0] = ld8(ap + 64); faa[1] = ld8(ap + 96); if (o) fva = ld8(ap + 128); }
        if ((part & 4) && h2 != hcur) { hcur = h2;
#pragma unroll
        for (int ti = 0; ti < 2; ++ti) { const int nt2 = (wave2 & 1) * 2 + ti;
        { const GAS bf16_t* bp = W2T + ((size_t)h2 * 64 + nt2 * 16 + fr2) * 64 + 8 * g2; fwb[ti * 2] = ld8(bp); fwb[ti * 2 + 1] = ld8(bp + 32); }
        { const GAS bf16_t* bp = A2T + ((size_t)h2 * 64 + nt2 * 16 + fr2) * 64 + 8 * g2; fab[ti * 2] = ld8(bp); fab[ti * 2 + 1] = ld8(bp + 32); }
        if (o) fvb[ti] = ld8(V2T + ((size_t)h2 * 64 + nt2 * 16 + fr2) * 32 + 8 * g2); } }
        const int q2 = wave2 * 2 + (lane2 >> 5), cp2 = lane2 & 31;
        if (part & 8)
#pragma unroll
        for (int j = 0; j < 4; ++j) { const size_t prow2 = rows2 + 4 * q2 + j; const GAS unsigned* zp2 = (const GAS unsigned*)(Z + prow2 * ZW + h2 * 64 + 2 * cp2);
            nr[j] = zp2[0]; nk[j] = zp2[512]; nv[j] = zp2[1024]; nvf[j] = o ? *(const GAS unsigned*)(VF + prow2 * D + h2 * 64 + 2 * cp2) : 0u; }
    };
    auto fetch_compute = [&]() {
#pragma unroll
        for (int ti = 0; ti < 2; ++ti) { const f32x4 z4 = {0.f, 0.f, 0.f, 0.f};
            nlw[ti] = __builtin_amdgcn_mfma_f32_16x16x32_bf16(fwb[ti * 2 + 1], fwa[1], __builtin_amdgcn_mfma_f32_16x16x32_bf16(fwb[ti * 2], fwa[0], z4, 0, 0, 0), 0, 0, 0);
            nla[ti] = __builtin_amdgcn_mfma_f32_16x16x32_bf16(fab[ti * 2 + 1], faa[1], __builtin_amdgcn_mfma_f32_16x16x32_bf16(fab[ti * 2], faa[0], z4, 0, 0, 0), 0, 0, 0);
            if (o) nlv[ti] = __builtin_amdgcn_mfma_f32_16x16x32_bf16(fvb[ti], fva, z4, 0, 0, 0); }
    };
    { F.retid(); int t0 = F.tid; asm volatile("" : "+v"(t0)); fetch_issue(F.vcu, 0, t0, 15); fetch_compute(); }
#pragma unroll 1
    for (int u = F.vcu; u < 2048; u += F.G) {
        const int bh = u & 31, blk = u >> 5, b = bh >> 4, h = bh & 15; const size_t row0 = (size_t)b * SEQ + (size_t)blk * 128;
        F.retid(); int tid = F.tid; asm volatile("" : "+v"(tid));
        LBAR();
        if ((F.G & 31) != 0 || u == F.vcu) {
            if (tid < 384) { const int a_ = tid >> 6, ch = tid & 63; const float* src = a_ == 0 ? w0p : a_ == 1 ? a0p : a_ == 2 ? v0p : a_ == 3 ? kkp : a_ == 4 ? kap : rkp; PRM[tid] = src[h * 64 + ch]; } }
#pragma unroll 1
        for (int c = 0; c < 2; ++c) {
            const size_t rows = row0 + 64 * c;
            asm volatile("" : "+v"(tid));
            const int lane = tid & 63; int wave = F.wave; asm volatile("" : "+s"(wave));
            const int cp = lane & 31, q = wave * 2 + (lane >> 5), ch0 = 2 * cp;
            LBAR();
            TSX(0);
            unsigned cr[4], ck[4], cv[4], cvf[4];
#pragma unroll
            for (int j = 0; j < 4; ++j) { cr[j] = nr[j]; ck[j] = nk[j]; cv[j] = nv[j]; cvf[j] = nvf[j]; }
            { const int fr_ = lane & 15, g_ = lane >> 4;
#pragma unroll
              for (int ti = 0; ti < 2; ++ti) { const int t = (wave >> 1) * 16 + fr_, c0 = ((wave & 1) * 2 + ti) * 16 + 4 * g_;
                  *(LAS f32x4*)(Lf + t * LFS + c0) = nlw[ti]; st4(Mm + t * S64 + c0, nla[ti]); if (o) st4(AM + (64 + t) * S64 + c0, nlv[ti]); } }
            const int nu = c == 0 ? u : u + F.G, nc = c == 0 ? 1 : 0; const bool has_n = nu < 2048;
            if (has_n) fetch_issue(nu, nc, tid, 1);
            LBAR();
            TSX(1);
            if (has_n) fetch_issue(nu, nc, tid, 2);
            float pr[4][2], pkk[4][2], pkm[4][2], pb[4][2], pv[4][2], cd[4][2];
            {
                float ss[4], bon[4];
#pragma unroll
                for (int j = 0; j < 4; ++j) { const int t = 4 * q + j; ss[j] = 0.f; bon[j] = 0.f;
                    const f32x2 lw2 = *(const LAS f32x2*)(Lf + t * LFS + ch0); const unsigned la2 = *(const LAS unsigned*)(Mm + t * S64 + ch0); const unsigned lv2 = o ? *(const LAS unsigned*)(AM + (64 + t) * S64 + ch0) : 0u;
#pragma unroll
                    for (int e = 0; e < 2; ++e) { const int ch = ch0 + e;
                        const float r = e ? __uint_as_float(cr[j] & 0xffff0000u) : __uint_as_float(cr[j] << 16), k = e ? __uint_as_float(ck[j] & 0xffff0000u) : __uint_as_float(ck[j] << 16);
                        float v = e ? __uint_as_float(cv[j] & 0xffff0000u) : __uint_as_float(cv[j] << 16);
                        const float lw = lw2[e], la = e ? __uint_as_float(la2 & 0xffff0000u) : __uint_as_float(la2 << 16);
                        cd[j][e] = -0.6065306597126334f * sigmoidf_(PRM[ch] + lw);
                        const float a = sigmoidf_(PRM[64 + ch] + la);
                        if (o) { const float lv = e ? __uint_as_float(lv2 & 0xffff0000u) : __uint_as_float(lv2 << 16); const float vf = e ? __uint_as_float(cvf[j] & 0xffff0000u) : __uint_as_float(cvf[j] << 16);
                            v = v + (vf - v) * sigmoidf_(PRM[128 + ch] + lv); v = bf2f((bf16_t)f2bf(v)); }
                        const float kr = k * PRM[192 + ch]; ss[j] += kr * kr; pkk[j][e] = kr;
                        const float km = k * (1.f + (a - 1.f) * PRM[256 + ch]); pkm[j][e] = km; pb[j][e] = a; pr[j][e] = r; pv[j][e] = v; bon[j] += r * km * PRM[320 + ch]; }
                    const size_t row = rows + t;
                    if (!DUMMY) { if (o) *(GAS unsigned*)(Z + row * ZW + 2048 + h * 64 + ch0) = pk2(pv[j][0], pv[j][1]); else *(GAS unsigned*)(VF + row * D + h * 64 + ch0) = cv[j]; } }
                float bq[4];
#pragma unroll
                for (int j = 0; j < 4; ++j) {
                    float s1 = ss[j], b1 = bon[j];
                    s1 = red32(s1);
                    b1 = red32(b1); bq[j] = b1;
                    const float inv = __builtin_amdgcn_rcpf(fmaxf(sqrtf(s1), 1e-12f));
#pragma unroll
                    for (int e = 0; e < 2; ++e) { pkk[j][e] *= inv; pb[j][e] *= pkk[j][e]; }
                }
                if (!DUMMY && cp < 4) BON[(rows + 4 * q + cp) * 16 + h] = cp == 0 ? bq[0] : cp == 1 ? bq[1] : cp == 2 ? bq[2] : bq[3];
#pragma unroll
                for (int e = 0; e < 2; ++e) { cd[1][e] += cd[0][e]; cd[2][e] += cd[1][e]; cd[3][e] += cd[2][e]; SEGT[q * 64 + ch0 + e] = cd[3][e]; }
            }
            LBAR();
            TSX(3);
            if (has_n) fetch_issue(nu, nc, tid, 4);
            {
                float pre[2] = {0.f, 0.f};
                for (int qq = 0; qq < q; ++qq) { pre[0] += SEGT[qq * 64 + ch0]; pre[1] += SEGT[qq * 64 + ch0 + 1]; }
                float at[4][2], bt[4][2], kt[4][2], rt[4][2];
#pragma unroll
                for (int j = 0; j < 4; ++j)
#pragma unroll
                    for (int e = 0; e < 2; ++e) { const float g = pre[e] + cd[j][e], gp = j ? pre[e] + cd[j - 1][e] : pre[e]; const float eg = __expf(g), egp = __expf(gp), ieg = __builtin_amdgcn_rcpf(eg);
                        at[j][e] = egp * pkk[j][e]; bt[j][e] = pb[j][e] * ieg; kt[j][e] = pkm[j][e] * ieg; rt[j][e] = pr[j][e] * eg;
                        if (q == 15 && j == 3) gamC[ch0 + e] = eg; }
#pragma unroll
                for (int j = 0; j < 4; ++j) { const int t = 4 * q + j;
                    *(LAS unsigned*)(At + t * S64 + ch0) = cvt_pk_bf16(at[j][0], at[j][1]); *(LAS unsigned*)(Rt + t * S64 + ch0) = cvt_pk_bf16(rt[j][0], rt[j][1]);
                    *(LAS unsigned*)(E + t * S64 + ch0) = cvt_pk_bf16(bt[j][0], bt[j][1]); *(LAS unsigned*)(E + (64 + t) * S64 + ch0) = cvt_pk_bf16(kt[j][0], kt[j][1]); }
#pragma unroll
                for (int e = 0; e < 2; ++e) { const int ch = ch0 + e;
#define RW_Q4(x) (u32x2){cvt_pk_bf16(x[0][e], x[1][e]), cvt_pk_bf16(x[2][e], x[3][e])}
                    *(LAS u32x2*)(AM + ch * S64 + 4 * q) = RW_Q4(at); *(LAS u32x2*)(ET + ch * S128 + 4 * q) = RW_Q4(bt); *(LAS u32x2*)(ET + ch * S128 + 64 + 4 * q) = RW_Q4(kt); *(LAS u32x2*)(X0T + ch * S128 + 64 + 4 * q) = RW_Q4(pv);
#undef RW_Q4
                }
            }
            LBAR();
            TSX(4);
            if (has_n) fetch_issue(nu, nc, tid, 8);
            mm<8, 4, 2>(E, S64, At, S64, wave, lane, [&](int, int r0, int col, f32x4 a) {
                const int i0 = r0 & 63; f32x4 v;
#pragma unroll
                for (int j = 0; j < 4; ++j) v[j] = (i0 + j < col) ? a[j] : 0.f;
                if (r0 < 64) *(LAS f32x4*)(Lf + col * LFS + i0) = v; else st4(Mm + col * S64 + i0, v); });
            LBAR();
            TSX(5);
            if (wave < 2) {
                const int bb = 32 * wave; float x[32]; int vz = 0; asm volatile("" : "+v"(vz));
                const LAS float* Lz = Lf + vz; const int cl = lane & 31;
#pragma unroll
                for (int t = 0; t < 32; ++t) x[t] = 0.f;
#pragma unroll
                for (int t = 0; t < 32; ++t) { float s0 = (t == cl) ? 1.f : 0.f, s1 = 0.f, s2 = 0.f, s3 = 0.f;
#pragma unroll
                    for (int i4 = 0; i4 < (t + 3) / 4; ++i4) { const f32x4 l4 = *(const LAS f32x4*)(Lz + (bb + t) * LFS + bb + 4 * i4);
                        s0 -= l4[0] * x[4 * i4]; s1 -= l4[1] * x[4 * i4 + 1]; s2 -= l4[2] * x[4 * i4 + 2]; s3 -= l4[3] * x[4 * i4 + 3]; }
                    x[t] = (s0 + s1) + (s2 + s3); }
                if (lane < 32) {
#pragma unroll
                    for (int t = 0; t < 32; ++t) Tm[(bb + t) * S64 + bb + cl] = bfs(x[t]);
                    if (wave == 0) {
#pragma unroll
                        for (int i4 = 0; i4 < 8; ++i4) st4(X0T + cl * S128 + 4 * i4, (f32x4){x[4 * i4], x[4 * i4 + 1], x[4 * i4 + 2], x[4 * i4 + 3]}); }
                }
            } else {
                mm_rt<8, 4, 2>(E, S64, Rt, S64, wave - 2, 6, lane, [&](int r0, int col, f32x4 a) {
                    const int i0 = r0 & 63; f32x4 v;
#pragma unroll
                    for (int j = 0; j < 4; ++j) v[j] = (i0 + j <= col) ? a[j] : 0.f;
                    st4(NN + col * S128 + r0, v); });
                mm_rt<4, 4, 2>(Mm, S64, X0T + 64, S128, wave - 2, 6, lane, [&](int r0, int col, f32x4 a) { st4(AM + (64 + col) * S64 + r0, (f32x4){-a[0], -a[1], -a[2], -a[3]}); });
                asm volatile("s_waitcnt lgkmcnt(0)" ::: "memory");
                { const int e = tid - 128; if (e < 256) { const int t = e >> 3, i4 = (e & 7) * 4; st4(X0T + t * S128 + 32 + i4, *(const LAS f32x4*)(Lf + (32 + t) * LFS + i4)); *(LAS u32x2*)(Tm + t * S64 + 32 + i4) = (u32x2){0u, 0u}; } }
            }
            LBAR();
            TSX(6);
            if (wave < 4) { const int fr_ = lane & 15, g_ = lane >> 4, mt = wave >> 1, nt = wave & 1;
                const f32x4 z4 = {0.f, 0.f, 0.f, 0.f};
                const f32x4 a = __builtin_amdgcn_mfma_f32_16x16x32_bf16(ld8(X0T + (mt * 16 + fr_) * S128 + 32 + 8 * g_), ld8(X0T + (nt * 16 + fr_) * S128 + 8 * g_), z4, 0, 0, 0);
                st4(Mm + (nt * 16 + fr_) * S64 + mt * 16 + 4 * g_, a); }
            LBAR();
            if (wave < 4) { const int fr_ = lane & 15, g_ = lane >> 4, mt = wave >> 1, nt = wave & 1;
                const f32x4 z4 = {0.f, 0.f, 0.f, 0.f};
                const f32x4 a = __builtin_amdgcn_mfma_f32_16x16x32_bf16(ld8(Tm + (32 + mt * 16 + fr_) * S64 + 32 + 8 * g_), ld8(Mm + (nt * 16 + fr_) * S64 + 8 * g_), z4, 0, 0, 0);
#pragma unroll
                for (int j = 0; j < 4; ++j) Tm[(32 + mt * 16 + 4 * g_ + j) * S64 + nt * 16 + fr_] = bfs(-a[j]); }
            LBAR();
            TSX(7);
            mm<4, 8, 2>(Tm, S64, AM, S64, wave, lane, [&](int, int r0, int col, f32x4 a) { if (col < 64) st4(WT + col * S64 + r0, a); else st4(X0T + (col - 64) * S128 + r0, a); });
            LBAR();
            TSX(8);
            f32x4 gt[2], y0t[2];
            mm<4, 4, 2>(WT, S64, ET, S128, wave, lane, [&](int, int r0, int col, f32x4 a) { const float gc = gamC[col];
                f32x4 p;
#pragma unroll
                for (int j = 0; j < 4; ++j) p[j] = (((r0 + j) == col ? 1.f : 0.f) - a[j]) * gc;
                st4(PT + col * S64 + r0, p); });
            mm<4, 4, 4>(ET, S128, X0T, S128, wave, lane, [&](int ti, int r0, int, f32x4 a) { gt[ti] = a * *(const LAS f32x4*)(gamC + r0); });
            mm<4, 4, 4>(NN, S128, X0T, S128, wave, lane, [&](int ti, int, int, f32x4 a) { y0t[ti] = a; });
            mm<4, 4, 2>(WT, S64, NN, S128, wave, lane, [&](int, int r0, int col, f32x4 a) {
                const u32x2 rr = *(const LAS u32x2*)(Rt + col * S64 + r0);
                st4(Qh + col * S64 + r0, (f32x4){__uint_as_float(rr.x << 16) - a[0], __uint_as_float(rr.x & 0xffff0000u) - a[1], __uint_as_float(rr.y << 16) - a[2], __uint_as_float(rr.y & 0xffff0000u) - a[3]}); });
            LBAR();
            TSX(9);
            GAS bf16_t* rslot = Z + row0 * ZW + h * 64; GAS bf16_t* kslot = rslot + 1024;
            auto stQ = [&](int r0, int col, u32x2 w) {
                const int kt_ = r0 >> 5, rho = r0 & 31, s = rho >> 4, jj = ((rho >> 3) & 1) * 4, hh = (rho >> 2) & 1;
                const int t = 64 * c + col, tt_ = t >> 5, ln = 32 * hh + (t & 31); const int e = ((((tt_ * 2 + kt_) * 2 + s) * 64 + ln) << 3) + jj;
                if (!DUMMY) *(GAS u32x2*)(rslot + (size_t)(e >> 6) * ZW + (e & 63)) = w; else asm volatile("" :: "v"(w.x)); };
            auto stY = [&](int r0, int col, f32x4 y) {
                const int vt_ = col >> 5, v31 = col & 31;
                const int t = 64 * c + r0, tt_ = t >> 5, x = t & 31, hh = (x >> 2) & 1, r = 4 * (x >> 3); const int e = (((tt_ * 2 + vt_) * 64 + 32 * hh + v31) << 4) + r;
                if (!DUMMY) *(GAS u32x2*)(kslot + (size_t)(e >> 6) * ZW + (e & 63)) = (u32x2){cvt_pk_bf16(y[0], y[1]), cvt_pk_bf16(y[2], y[3])}; else asm volatile("" :: "v"(y[0])); };
            f32x4 pn[2], gn[2];
            if (c != 0) {
                mm<4, 4, 2>(Pc, S64, Qh, S64, wave, lane, [&](int, int r0, int col, f32x4 a) { stQ(r0, col, (u32x2){cvt_pk_bf16(a[0], a[1]), cvt_pk_bf16(a[2], a[3])}); });
                mm<4, 4, 2>(Qh, S64, Gc, S64, wave, lane, [&](int ti, int r0, int col, f32x4 a) { stY(r0, col, a + y0t[ti]); });
                mm<4, 4, 2>(PT, S64, Pc, S64, wave, lane, [&](int ti, int, int, f32x4 a) { pn[ti] = a; });
                mm<4, 4, 2>(PT, S64, Gc, S64, wave, lane, [&](int ti, int, int, f32x4 a) { gn[ti] = a + gt[ti]; });
            } else {
                const int fr_ = lane & 15, g_ = lane >> 4;
#pragma unroll
                for (int ti = 0; ti < 2; ++ti) { const int tile = wave + 8 * ti, r0 = (tile >> 2) * 16 + 4 * g_, col = (tile & 3) * 16 + fr_;
                    stQ(r0, col, *(const LAS u32x2*)(Qh + col * S64 + r0));
                    stY(r0, col, y0t[ti]);
                    pn[ti] = (f32x4){bf2f(PT[(r0 + 0) * S64 + col]), bf2f(PT[(r0 + 1) * S64 + col]), bf2f(PT[(r0 + 2) * S64 + col]), bf2f(PT[(r0 + 3) * S64 + col])}; gn[ti] = gt[ti]; }
            }
            if (has_n) fetch_compute();
            LBAR();
            { const int fr = lane & 15, g = lane >> 4;
#pragma unroll
              for (int ti = 0; ti < 2; ++ti) { const int tile = wave + 8 * ti, mt = tile >> 2, nt = tile & 3;
                  st4(Pc + (nt * 16 + fr) * S64 + mt * 16 + 4 * g, pn[ti]); st4(Gc + (nt * 16 + fr) * S64 + mt * 16 + 4 * g, gn[ti]); } }
            TSX(10);
        }
        LBAR();
        if (!DUMMY) { GAS bf16_t* pg = PG + (size_t)u * 8192;
          { const int f = tid >> 6, ln = tid & 63, s = f & 1, kit = (f >> 1) & 1, kot = f >> 2, hh = ln >> 5, r31 = ln & 31; unsigned short w[8];
#pragma unroll
            for (int j = 0; j < 8; ++j) { const int rho = 16 * s + 8 * (j >> 2) + 4 * hh + (j & 3); w[j] = Pc[(32 * kit + rho) * S64 + 32 * kot + r31]; }
            *(GAS u32x4*)(pg + (size_t)tid * 8) = (u32x4){(unsigned)w[0] | ((unsigned)w[1] << 16), (unsigned)w[2] | ((unsigned)w[3] << 16), (unsigned)w[4] | ((unsigned)w[5] << 16), (unsigned)w[6] | ((unsigned)w[7] << 16)}; }
          { const int tile = tid >> 7, ln = (tid >> 1) & 63, half = tid & 1, kot = tile >> 1, vt_ = tile & 1, hh = ln >> 5, v31 = ln & 31; unsigned short w[8];
#pragma unroll
            for (int q = 0; q < 8; ++q) { const int r = 8 * half + q; const int ko = 32 * kot + (r & 3) + 8 * (r >> 2) + 4 * hh; w[q] = Gc[(32 * vt_ + v31) * S64 + ko]; }
            *(GAS u32x4*)(pg + 4096 + ((size_t)(tile * 64 + ln) << 4) + 8 * half) = (u32x4){(unsigned)w[0] | ((unsigned)w[1] << 16), (unsigned)w[2] | ((unsigned)w[3] << 16), (unsigned)w[4] | ((unsigned)w[5] << 16), (unsigned)w[6] | ((unsigned)w[7] << 16)}; } }
    }
    LBAR();
}

__device__ __forceinline__ void rwkv_stage_y(Frame& F, const int bx) {
    const int lane = F.lane, wave = F.wave, bh = bx, vt = wave >> 2; const bool st = ((wave & 3) == 0);
    const bf16_t* PG = (const bf16_t*)(F.H); u32x4* SB = (u32x4*)(F.ws + WS_SB);
    LAS unsigned char* ring = F.lds;
    if (st) {
        f32x16 X0, X1;
#pragma unroll
        for (int r = 0; r < 16; ++r) { X0[r] = 0.f; X1[r] = 0.f; }
        bf16x8 fA[12], fB[12];
        auto ldfrag = [&](bf16x8 (&f)[12], int blk) { const LAS bf16x8* pb = (const LAS bf16x8*)(ring + (blk & 1) * 16384);
#pragma unroll
            for (int q = 0; q < 4; ++q) { f[q] = pb[q * 64 + lane]; f[4 + q] = pb[(4 + q) * 64 + lane]; }
            f[8] = pb[512 + ((0 * 2 + vt) * 64 + lane) * 2]; f[9] = pb[512 + ((0 * 2 + vt) * 64 + lane) * 2 + 1]; f[10] = pb[512 + ((1 * 2 + vt) * 64 + lane) * 2]; f[11] = pb[512 + ((1 * 2 + vt) * 64 + lane) * 2 + 1]; };
        auto step = [&](bf16x8 (&fc)[12], bf16x8 (&fn)[12], int blk) {
            LBAR();
            if (blk + 1 < 64) ldfrag(fn, blk + 1);
            f32x16 n0, n1;
#pragma unroll
            for (int r = 0; r < 8; ++r) { n0[r] = bf2f((bf16_t)fc[8][r]); n0[8 + r] = bf2f((bf16_t)fc[9][r]); n1[r] = bf2f((bf16_t)fc[10][r]); n1[8 + r] = bf2f((bf16_t)fc[11][r]); }
            u32x4 xb[4];
#pragma unroll
            for (int s = 0; s < 2; ++s) {
                xb[s] = (u32x4){cvt_pk_bf16(X0[8 * s], X0[8 * s + 1]), cvt_pk_bf16(X0[8 * s + 2], X0[8 * s + 3]), cvt_pk_bf16(X0[8 * s + 4], X0[8 * s + 5]), cvt_pk_bf16(X0[8 * s + 6], X0[8 * s + 7])};
                xb[2 + s] = (u32x4){cvt_pk_bf16(X1[8 * s], X1[8 * s + 1]), cvt_pk_bf16(X1[8 * s + 2], X1[8 * s + 3]), cvt_pk_bf16(X1[8 * s + 4], X1[8 * s + 5]), cvt_pk_bf16(X1[8 * s + 6], X1[8 * s + 7])}; }
            u32x4* sb = SB + ((size_t)(blk * 32 + bh) * 8 + vt * 4) * 64 + lane;
#pragma unroll
            for (int q = 0; q < 4; ++q) sb[q * 64] = xb[q];
#pragma unroll
            for (int q = 0; q < 4; ++q) {
                n0 = __builtin_amdgcn_mfma_f32_32x32x16_bf16(fc[q], __builtin_bit_cast(bf16x8, xb[q]), n0, 0, 0, 0);
                n1 = __builtin_amdgcn_mfma_f32_32x32x16_bf16(fc[4 + q], __builtin_bit_cast(bf16x8, xb[q]), n1, 0, 0, 0); }
            X0 = n0; X1 = n1;
        };
        LBAR();
        ldfrag(fA, 0);
#pragma unroll 1
        for (int blk = 0; blk < 64; blk += 2) { step(fA, fB, blk); step(fB, fA, blk + 1); }
    } else {
        const int lw = wave - 1 - vt;
        bf16x8 R[16][3];
        auto gl = [&](bf16x8 (&r)[3], int blk) { const int b = blk < 64 ? blk : 63; const bf16_t* pg = PG + (size_t)(b * 32 + bh) * 8192;
#pragma unroll
            for (int i = 0; i < 3; ++i) { const int sl = min(lw * 3 + i, 15); r[i] = ld8p(pg + (((size_t)sl * 64 + lane) << 3)); } };
        auto lput = [&](const bf16x8 (&r)[3], int blk) { LAS bf16x8* pb = (LAS bf16x8*)(ring + (blk & 1) * 16384);
#pragma unroll
            for (int i = 0; i < 3; ++i) { const int sl = min(lw * 3 + i, 15); pb[sl * 64 + lane] = r[i]; } };
#pragma unroll
        for (int k = 0; k < 16; ++k) gl(R[k], k);
        lput(R[0], 0); lput(R[1], 1);
        gl(R[0], 16); gl(R[1], 17);
        LBAR();
#pragma unroll 1
        for (int base = 0; base < 64; base += 16) {
#pragma unroll
            for (int k = 0; k < 16; ++k) { const int sN = base + k;
                LBAR();
                lput(R[(k + 2) & 15], sN + 2); gl(R[(k + 2) & 15], sN + 18); }
        }
    }
    __syncthreads();
}

template <bool DUMMY>
__device__ __forceinline__ void rwkv_stage_z(Frame& F, int li) {
    const int o = li >> 1;
    bf16_t* Z = (bf16_t*)(F.ws + WS_Z); const float* BON = (const float*)(F.ws + WS_BON); const u32x4* SB = (const u32x4*)(F.ws + WS_SB);
    const float* lgp = F.in[24] + o * D; const float* lbp = F.in[25] + o * D;
    LAS float* tile = (LAS float*)(F.lds + F.wave * 9216);
    int lane_ = F.lane; const bool lockstep = (8192 % (F.G * 8)) == 0;
#pragma unroll 1
    for (int w = F.vcu * 8 + F.wave; w < 8192; w += F.G * 8) {
        asm volatile("" : "+v"(lane_)); const int lane = lane_, v31 = lane & 31, hh = lane >> 5, tl = lane >> 1, hf = lane & 1;
        const int u = w >> 2, tt = w & 3, bh = u & 31, blk = u >> 5, b = bh >> 4, h = bh & 15; const size_t row0 = (size_t)b * SEQ + (size_t)blk * 128;
        const bf16_t* rslot = Z + row0 * ZW + h * 64; const bf16_t* kslot = rslot + 1024;
        const size_t row = row0 + 32 * tt + tl; bf16_t* zp = Z + row * ZW + h * 64 + 32 * hf;
        bf16x8 vv[4], gg[4];
#pragma unroll
        for (int q = 0; q < 4; ++q) { vv[q] = ld8p(zp + 2048 + 8 * q); gg[q] = ld8p(zp + 3072 + 8 * q); }
        const float bon = BON[row * 16 + h];
        bf16x8 qf[4]; u32x4 xb[2][4];
#pragma unroll
        for (int q = 0; q < 4; ++q) { const int e = (((tt * 4 + q) * 64 + lane) << 3); qf[q] = ld8p(rslot + (size_t)(e >> 6) * ZW + (e & 63)); }
#pragma unroll
        for (int vt = 0; vt < 2; ++vt)
#pragma unroll
            for (int q = 0; q < 4; ++q) xb[vt][q] = SB[((size_t)u * 8 + vt * 4 + q) * 64 + lane];
#pragma unroll
        for (int vt = 0; vt < 2; ++vt) { const int e0 = ((tt * 2 + vt) * 64 + lane) << 4; const bf16_t* yp = kslot + (size_t)(e0 >> 6) * ZW + (e0 & 63); const bf16x8 ya = ld8p(yp), yb = ld8p(yp + 8);
            f32x16 acc;
#pragma unroll
            for (int r = 0; r < 8; ++r) { acc[r] = bf2f((bf16_t)ya[r]); acc[8 + r] = bf2f((bf16_t)yb[r]); }
#pragma unroll
            for (int q = 0; q < 4; ++q) acc = __builtin_amdgcn_mfma_f32_32x32x16_bf16(qf[q], __builtin_bit_cast(bf16x8, xb[vt][q]), acc, 0, 0, 0);
#pragma unroll
            for (int r = 0; r < 16; ++r) tile[((r & 3) + 8 * (r >> 2) + 4 * hh) * 72 + 36 * vt + v31] = acc[r]; }
        LDS_WAIT(); asm volatile("" ::: "memory");
        float y[32]; float sm = 0.f;
#pragma unroll
        for (int q = 0; q < 8; ++q) { const f32x4 t4 = *(const LAS f32x4*)(tile + tl * 72 + 36 * hf + 4 * q); y[4 * q] = t4[0]; y[4 * q + 1] = t4[1]; y[4 * q + 2] = t4[2]; y[4 * q + 3] = t4[3]; sm += (t4[0] + t4[1]) + (t4[2] + t4[3]); }
        sm += __shfl_xor(sm, 1);
        const float mu = sm * (1.f / 64.f); float qq = 0.f;
#pragma unroll
        for (int j = 0; j < 32; ++j) { y[j] -= mu; qq += y[j] * y[j]; }
        qq += __shfl_xor(qq, 1);
        const float rsd = rsqrtf(qq * (1.f / 64.f) + 64e-5f);
        const float* lg = lgp + h * 64 + 32 * hf; const float* lb = lbp + h * 64 + 32 * hf;
#pragma unroll
        for (int q = 0; q < 4; ++q) { float ov[8];
#pragma unroll
            for (int j = 0; j < 8; ++j) { const int c = 8 * q + j; const float va = bf2f((bf16_t)vv[q][j]), ga = bf2f((bf16_t)gg[q][j]); ov[j] = (y[c] * rsd * lg[c] + lb[c] + bon * va) * siluf_(ga); }
            const u32x4 wv = {cvt_pk_bf16(ov[0], ov[1]), cvt_pk_bf16(ov[2], ov[3]), cvt_pk_bf16(ov[4], ov[5]), cvt_pk_bf16(ov[6], ov[7])};
            if (!DUMMY) *(u32x4*)(zp + 3072 + 8 * q) = wv; else asm volatile("" :: "v"(wv)); }
        LDS_WAIT(); asm volatile("" ::: "memory");
        if (lockstep) __builtin_amdgcn_s_barrier();
    }
}

enum { PH_P0 = 0, PH_FINAL = 27, N_PHASES = 28 };
#define IN(k) (lo <= (k) && (k) < hi)
#define TSG(k) do { if (LI == 0) { if (MK_GA == (k)) tA = __builtin_amdgcn_s_memrealtime(); if (MK_GB == (k)) tB = __builtin_amdgcn_s_memrealtime(); } } while (0)
#define TS(k) do { if (MK_TPA == (k)) tA = __builtin_amdgcn_s_memrealtime(); if (MK_TPB == (k)) tB = __builtin_amdgcn_s_memrealtime(); } while (0)
#if MK_MULTI
#define SEAM(k) do { } while (0)
#else
#define SEAM(k) do { if (IN(k) && IN((k) + 1)) xcd_barrier(bar); } while (0)
#endif
template <int LI>
__device__ __forceinline__ void run_layer(Frame& F, const XcdBarrier& bar, const int lo, const int hi, const int bx, unsigned long long& tA, unsigned long long& tB) {
    constexpr bool even = (LI & 1) == 0;
    constexpr int base = 1 + (LI / 2) * 13 + (even ? 0 : 6);
    bf16_t* Zp = (bf16_t*)(F.ws + WS_Z);
    if constexpr (even) {
        TS(base); if (IN(base)) { F.retid(); pg8::StaticOrder S; S.init(64, 16, F.G, bx);
            pg8::Gemm g{(const bf16_t*)(F.ws + WS_HB), (const bf16_t*)(F.ws + WS_WIN)};
            EpiEvenIn E{Zp, F.ssq(LI), (bf16_t*)(F.ws + WS_VTA), (bf16_t*)(F.ws + WS_VTB), (bf16_t*)(F.ws + WS_KT), F.lds + RING_BYTES};
            if (MK_PROBE == 1) pg8::gemm_phase<EpiEvenIn, true, D, D, 1 << 20, 0, 0>(F.lds, F.tid, g, S, E);
            pg8::gemm_phase<EpiEvenIn, true, D, D, 1 << 20, 0, 0>(F.lds, F.tid, g, S, E); }
        SEAM(base);
        TS(base + 1); if (IN(base + 1)) { F.retid();
            TSG(0); conv_wrest_a(F, LI); TSG(1);
            if constexpr (LI < 3) conv_win_odd(F, LI + 1);
            TSG(2);
            if (MK_PROBE == 5) { for (int u = F.vcu * 8 + F.wave; u < 4096; u += F.G * 16) ret_stage_a(F, u, u + F.G * 8 < 4096 ? u + F.G * 8 : -1);
                for (int u = F.vcu * 8 + F.wave; u < 2048; u += F.G * 8) sb_unit<true>(F, u >> 8, u & 255); }
            for (int u = F.vcu * 8 + F.wave; u < 4096; u += F.G * 16) ret_stage_a(F, u, u + F.G * 8 < 4096 ? u + F.G * 8 : -1);
            __syncthreads(); TSG(3);
            for (int u = F.vcu * 8 + F.wave; u < 2048; u += F.G * 8) sb_unit<false>(F, u >> 8, u & 255);
            __syncthreads(); TSG(4); }
        SEAM(base + 1);
        TS(base + 2); if (IN(base + 2)) { F.retid(); ret_stage_b(F); conv_wrest_b(F, LI, F.vcu, F.G); }
        SEAM(base + 2);
        TS(base + 3); if (IN(base + 3)) { F.retid(); const float* gng = F.in[8] + (LI >> 1) * 512;
            if (MK_PROBE == 6) for (int u = F.vcu * 8 + F.wave; u < 2048; u += F.G * 8) ret_stage_c<true>(F, u, gng);
            for (int u = F.vcu * 8 + F.wave; u < 2048; u += F.G * 8) ret_stage_c<false>(F, u, gng); }
        SEAM(base + 3);
        TS(base + 4); if (IN(base + 4)) { F.retid(); pg8::StaticOrder S; S.init(64, 4, F.G, bx);
            { pg8::Gemm g{(const bf16_t*)(F.ws + WS_PB), (const bf16_t*)(F.ws + WS_WPROJ)};
              EpiStore E{Zp, ZE}; pg8::gemm_phase<EpiStore, false, PLE, PLE, 1 << 20, 0, 0>(F.lds, F.tid, g, S, E); }
            { pg8::Gemm g{Zp + 1024, (const bf16_t*)(F.ws + WS_WOUT)};
              EpiResid E{(const bf16_t*)(F.ws + WS_HB), Zp + 1536, ZE}; pg8::gemm_phase<EpiResid, false, ZE, D, 8, (long)((2560 - 1024) * 2), 0>(F.lds, F.tid, g, S, E); } }
        SEAM(base + 4);
        TS(base + 5); if (IN(base + 5)) { F.retid(); pg8::StaticOrder S; S.init(64, 4, F.G, bx);
            pg8::Gemm g{Zp + 1536, (const bf16_t*)(F.ws + WS_WGATE)};
            EpiGate E{Zp + 1536, ZE, Zp, ZE, (bf16_t*)(F.ws + WS_HB), F.ssq(LI + 1)};
            pg8::gemm_phase<EpiGate, false, ZE, D, 1 << 20, 0, 0>(F.lds, F.tid, g, S, E); }
        SEAM(base + 5);
    } else {
        TS(base); if (IN(base)) { F.retid(); conv_lora2(F, LI); rows_norm(F, LI); }
        SEAM(base);
        TS(base + 1); if (IN(base + 1)) { F.retid();
            unsigned* kcnt = (unsigned*)(F.ws + WS_CTL) + 8192 + (LI >> 1) * 256;
            const bf16_t* Wb = (const bf16_t*)(F.ws + WS_WIN); bf16_t* L1p = (bf16_t*)(F.ws + WS_L1);
            const int nl = F.G > 64 ? 64 : 0;
            { F.retid(); pg8::StaticOrder S; S.init(64, 4, F.G, bx);
              pg8::Gemm g{Zp + 1024, Wb + (size_t)2048 * 1024}; EpiOddIn E{Zp, L1p, 8, kcnt};
              pg8::gemm_phase<EpiOddIn, true, ZW, D, 1 << 20, 0, 0>(F.lds, F.tid, g, S, E); }
            { F.retid(); pg8::StaticOrder S; S.init(64, 4, F.G, bx);
              pg8::Gemm g{Zp + 3072, Wb + (size_t)1024 * 1024}; EpiOddIn E{Zp, L1p, 4, kcnt};
              pg8::gemm_phase<EpiOddIn, true, ZW, D, 1 << 20, 0, 0>(F.lds, F.tid, g, S, E); }
            { F.retid(); pg8::StaticOrder S; S.init(64, 4, F.G, bx);
              pg8::Gemm g{Zp, Wb + (size_t)3072 * 1024}; EpiOddIn E{Zp, L1p, 12, kcnt};
              pg8::gemm_phase<EpiOddIn, true, ZW, D, 1 << 20, 0, 0>(F.lds, F.tid, g, S, E); }
            { F.retid(); pg8::StaticOrder S; S.init(64, 4, F.G - nl, bx - nl);
              const char* xr0 = (const char*)F.H + XR0_OFF;
              pg8::Gemm g{(const bf16_t*)xr0, Wb, (long)((const char*)(F.ws + WS_XR1) - (xr0 + (size_t)SEQ * D * 2))}; EpiOddIn E{Zp, L1p, 0, kcnt};
              if (bx >= nl) pg8::gemm_phase<EpiOddIn, true, D, D, 1 << 20, 0, 0>(F.lds, F.tid, g, S, E); }
            { F.retid(); pg8::StaticOrder S; S.init(64, 1, F.G, bx);
              pg8::Gemm g{(const bf16_t*)(F.H) + D, Wb + (size_t)4096 * 1024}; EpiOddIn E{Zp, L1p, 16, kcnt};
              pg8::gemm_phase<EpiOddIn, true, D, 2048, 16, -(long)(D * 2), (long)(D * 2)>(F.lds, F.tid, g, S, E); } }
        SEAM(base + 1);
        TS(base + 2); if (IN(base + 2)) { F.retid();
            conv_wrest_a(F, LI);
            __syncthreads();
            { unsigned long long xa = 0; rwkv_stage_x<false>(F, LI, xa); } }
        SEAM(base + 2);
        TS(base + 3); if (IN(base + 3)) { F.retid();
            if (bx < 32) { if (LI == 1 && MK_GA == 10) tA = __builtin_amdgcn_s_memrealtime(); rwkv_stage_y(F, bx); if (LI == 1 && MK_GB == 11) tB = __builtin_amdgcn_s_memrealtime(); }
            else { pg8::StaticOrder S; S.init(64, 4, F.G - 32, bx - 32);
                pg8::Gemm g{(const bf16_t*)(F.ws + WS_PB), (const bf16_t*)(F.ws + WS_WPROJ)};
                EpiStore E{(bf16_t*)(F.H) + (size_t)16 * 1024 * 1024, D}; pg8::gemm_phase<EpiStore, false, PLE, PLE, 1 << 20, 0, 0>(F.lds, F.tid, g, S, E);
                __syncthreads(); conv_wrest_b(F, LI, bx - 32, F.G - 32); } }
        SEAM(base + 3);
        TS(base + 4); if (IN(base + 4)) { F.retid(); rwkv_stage_z<false>(F, LI); }
        SEAM(base + 4);
        TS(base + 5); if (IN(base + 5)) { F.retid(); pg8::StaticOrder S; S.init(64, 4, F.G, bx);
            if constexpr (LI < 3) { conv_win_even(F, LI + 1); __syncthreads(); }
            { pg8::Gemm g{Zp + 3072, (const bf16_t*)(F.ws + WS_WOUT)};
              EpiResid E{(const bf16_t*)(F.ws + WS_HB), Zp + 2048, ZW}; pg8::gemm_phase<EpiResid, false, ZW, D, 1 << 20, 0, 0>(F.lds, F.tid, g, S, E); } }
        SEAM(base + 5);
        TS(base + 6); if (IN(base + 6)) { F.retid(); pg8::StaticOrder S; S.init(64, 4, F.G, bx);
            pg8::Gemm g{Zp + 2048, (const bf16_t*)(F.ws + WS_WGATE)};
            EpiGate E{Zp + 2048, ZW, (const bf16_t*)(F.H) + (size_t)16 * 1024 * 1024, D, (bf16_t*)(F.ws + WS_HB), F.ssq(LI + 1)};
            pg8::gemm_phase<EpiGate, false, ZW, D, 1 << 20, 0, 0>(F.lds, F.tid, g, S, E); }
        SEAM(base + 6);
    }
}
__global__ void __launch_bounds__(512, 2) mk_fwd(Args args) {
    extern __shared__ __attribute__((aligned(16))) unsigned char lds_raw[];
    Frame F;
    F.lds = (LAS unsigned char*)lds_raw; F.ldsg = lds_raw;
    F.tid = threadIdx.x; F.lane = F.tid & 63; F.wave = __builtin_amdgcn_readfirstlane(F.tid >> 6);
    F.G = gridDim.x; const int bx = blockIdx.x; F.vcu = (F.G % 8 == 0) ? (bx % 8) * (F.G / 8) + bx / 8 : bx;
    F.H = args.out; F.ws = args.ws;
    volatile LAS unsigned* MISC = (volatile LAS unsigned*)(F.lds + MISC_OFF);
    for (int u = F.tid; u < 128; u += 512) ((LAS unsigned*)(F.lds + MISC_OFF))[u] = 0u;
    __syncthreads();
    XcdBarrier bar; bar.bar = (unsigned*)(F.ws + WS_CTL) + 4096; bar.x = 0; bar.st = nullptr;
#if !MK_MULTI
    bar = xcd_barrier_post((unsigned*)(F.ws + WS_CTL) + 4096, MISC + 8);
#endif
    const int lo = args.ph_lo, hi = args.ph_hi;
    unsigned long long tA = 0, tB = 0;
    TS(100);
    if (IN(PH_P0)) { F.retid(); rows_p0(F); conv_win_even(F, 0); }
#if !MK_MULTI
    if (IN(0) && IN(1)) { VM_WAIT(); cg::this_grid().sync(); }
#endif
    TS(0);
    run_layer<0>(F, bar, lo, hi, bx, tA, tB);
    run_layer<1>(F, bar, lo, hi, bx, tA, tB);
    run_layer<2>(F, bar, lo, hi, bx, tA, tB);
    run_layer<3>(F, bar, lo, hi, bx, tA, tB);
    TS(PH_FINAL);
    if (IN(PH_FINAL)) { F.retid(); rows_final(F); }
    TS(PH_FINAL + 1);
    if ((MK_TPA >= 0 || MK_XA >= 0 || MK_GA >= 0) && blockIdx.x == 0 && F.wave == 0) { const unsigned long long t0 = __builtin_amdgcn_s_memrealtime(), span = 4ull * (MK_XA >= 0 ? ((volatile LAS unsigned long long*)(F.lds + MISC_OFF + 256))[1] : (tB - tA)); while (__builtin_amdgcn_s_memrealtime() - t0 < span) __builtin_amdgcn_s_sleep(8); }
}

extern "C" void kernel_launch(void* const* d_in, const int* in_sizes, int n_in, void* d_out, int out_size, void* d_ws, size_t ws_size, hipStream_t stream) {
    static int grid = 0;
    if (grid == 0) {
        int dev = 0, cus = 0, per_cu = 0;
        (void)hipGetDevice(&dev); (void)hipDeviceGetAttribute(&cus, hipDeviceAttributeMultiprocessorCount, dev);
        (void)hipFuncSetAttribute((const void*)mk_fwd, hipFuncAttributeMaxDynamicSharedMemorySize, LDS_BYTES);
        (void)hipOccupancyMaxActiveBlocksPerMultiprocessor(&per_cu, (const void*)mk_fwd, 512, LDS_BYTES);
        if (per_cu < 1) per_cu = 1;
        grid = cus * 1;
        if (n_in != 26 || ws_size < WS_END) fprintf(stderr, "kernel_launch: unexpected n_in %d / ws %zu\n", n_in, ws_size);
        (void)hipGetLastError();
    }
    (void)hipMemsetAsync((char*)d_ws + WS_CTL, 0, CTL_BYTES, stream);
    Args a{};
    for (int i = 0; i < 26; ++i) a.in[i] = (const float*)d_in[i];
    a.out = (float*)d_out; a.ws = (unsigned char*)d_ws;
#if MK_MULTI
    for (int ph = 0; ph < N_PHASES; ++ph) { a.ph_lo = ph; a.ph_hi = ph + 1; hipLaunchKernelGGL(mk_fwd, dim3(grid), dim3(512), LDS_BYTES, stream, a); }
#else
    a.ph_lo = 0; a.ph_hi = N_PHASES;
    void* kargs[] = {&a};
    hipError_t e = hipLaunchCooperativeKernel((const void*)mk_fwd, dim3(grid), dim3(512), kargs, LDS_BYTES, stream);
    if (e != hipSuccess) fprintf(stderr, "cooperative launch failed: %s (grid %d)\n", hipGetErrorString(e), grid);
#endif
}
```
